# Optimizing an MI355X kernel written in HIP

```python
import math
import jax, jax.numpy as jnp
from jax import lax
import numpy as np

D_MODEL = 1024
BATCH = 4
SEQ = 4096
DEPTH = 2
DEC_BATCH = 16
DEC_SEQ = 16
PAST_LEN = 4096

CHUNK = 64
N_A = DEPTH // 2
N_B = DEPTH - N_A
N_MEM = 256
DA_HEADS = 4
DA_QK = 64
DA_V = 2 * DA_QK
DA_W = DA_HEADS * DA_V
SW_HEADS = 8
SW_KV = 2
SW_GROUP = SW_HEADS // SW_KV
SW_HD = 64
SW_W = SW_HEADS * SW_HD
WINDOW = 128
MEM_HEADS = 4
MEM_HD = 128
MEM_W = MEM_HEADS * MEM_HD
MIX_W = DA_W + MEM_W
A_SIZES = (DA_HEADS * 2 * DA_QK, DA_HEADS * 2 * DA_QK, DA_W, DA_W, MEM_W, MEM_W)
B_SIZES = (SW_W, SW_W, MEM_W, MEM_W)
ROPE_THETA = 500000.0
ROT_FRAC = 4
Q_BLOCK = 128
DN_ALPHA = (2 * DEPTH) ** 0.25
DN_BETA = (8 * DEPTH) ** -0.25
LN_EPS = 1e-5
NEG = -1e30

kernel_name = "yoco_diffattn_swa_sink_stream_step"


def _split(h, sizes):
    return jnp.split(h, [int(c) for c in np.cumsum(sizes)[:-1]], axis=-1)


def rope_tables(pos):
    half = SW_HD // ROT_FRAC // 2
    inv = ROPE_THETA ** (-jnp.arange(half, dtype=jnp.float32) / half)
    ang = pos.astype(jnp.float32)[:, None] * inv[None, :]
    return jnp.cos(ang), jnp.sin(ang)


def apply_partial_rope(x, cos, sin):
    r = x.shape[-1] // ROT_FRAC
    half = r // 2
    shape = (1, cos.shape[0]) + (1,) * (x.ndim - 3) + (half,)
    c = cos.reshape(shape).astype(x.dtype)
    s = sin.reshape(shape).astype(x.dtype)
    x1, x2, xp = x[..., :half], x[..., half:r], x[..., r:]
    return jnp.concatenate([x1 * c - x2 * s, x2 * c + x1 * s, xp], axis=-1)


def layer_norm(x, g, b):
    xf = x.astype(jnp.float32)
    mu = jnp.mean(xf, -1, keepdims=True)
    var = jnp.mean(jnp.square(xf - mu), -1, keepdims=True)
    return ((xf - mu) * lax.rsqrt(var + LN_EPS) * g.astype(jnp.float32) + b.astype(jnp.float32)).astype(x.dtype)


def head_rms(o, g):
    of = o.astype(jnp.float32)
    return (of * lax.rsqrt(jnp.mean(of * of, -1, keepdims=True) + LN_EPS) * g.astype(jnp.float32)).astype(o.dtype)


def mem_kv(mem, w):
    B = mem.shape[0]
    k, v = jnp.split(mem @ w, 2, axis=-1)
    return k.reshape(B, N_MEM, MEM_HEADS, MEM_HD), v.reshape(B, N_MEM, MEM_HEADS, MEM_HD)


def mem_attend(q, mk, mv):
    s = jnp.einsum('bqhd,bkhd->bhqk', q, mk).astype(jnp.float32) * (MEM_HD ** -0.5)
    p = jax.nn.softmax(s, axis=-1)
    o = jnp.einsum('bhqk,bkhd->bqhd', p.astype(mv.dtype), mv)
    return o.reshape(q.shape[0], q.shape[1], MEM_W)


def diff_attend(q, k, v, mask, lam):
    s = jnp.einsum('bqhcd,bkhcd->bhcqk', q, k).astype(jnp.float32) * (DA_QK ** -0.5)
    if mask is not None:
        s = jnp.where(mask, s, NEG)
    p = jax.nn.softmax(s, axis=-1)
    a = p[:, :, 0] - lam * p[:, :, 1]
    return jnp.einsum('bhqk,bkhd->bqhd', a.astype(v.dtype), v)


def diff_prompt(q, k, v, lam):
    B, S = q.shape[:2]
    nb = S // Q_BLOCK
    qb = q.reshape((B, nb, Q_BLOCK) + q.shape[2:]).swapaxes(0, 1)
    kchunk = jnp.arange(S) // CHUNK

    def one(args):
        qi, i = args
        qchunk = (i * Q_BLOCK + jnp.arange(Q_BLOCK)) // CHUNK
        return diff_attend(qi, k, v, kchunk[None, :] <= qchunk[:, None], lam)

    out = lax.map(one, (qb, jnp.arange(nb)))
    return out.swapaxes(0, 1).reshape(B, S, DA_HEADS, DA_V)


def sink_softmax(s, sinks):
    sk = sinks.astype(jnp.float32).reshape(SW_KV, SW_GROUP)[:, :, None, None]
    sk = jnp.broadcast_to(sk, s.shape[:-1] + (1,))
    return jax.nn.softmax(jnp.concatenate([s, sk], axis=-1), axis=-1)[..., :-1]


def swa_prompt(q, k, v, sinks):
    B, S = q.shape[:2]
    nc = S // CHUNK
    nw = WINDOW // CHUNK
    qc = q.reshape(B, nc, CHUNK, SW_KV, SW_GROUP, SW_HD)
    pad = ((0, 0), (WINDOW, 0), (0, 0), (0, 0))
    kc = jnp.pad(k, pad).reshape(B, nc + nw, CHUNK, SW_KV, SW_HD)
    vc = jnp.pad(v, pad).reshape(B, nc + nw, CHUNK, SW_KV, SW_HD)
    kb = jnp.concatenate([kc[:, j:j + nc] for j in range(nw + 1)], axis=2)
    vb = jnp.concatenate([vc[:, j:j + nc] for j in range(nw + 1)], axis=2)
    s = jnp.einsum('bcqkgd,bcskd->bckgqs', qc, kb).astype(jnp.float32) * (SW_HD ** -0.5)
    blk = jnp.repeat(jnp.arange(nw + 1), CHUNK)[None, :]
    valid = (jnp.arange(nc)[:, None] + blk) >= nw
    s = jnp.where(valid[None, :, None, None, None, :], s, NEG)
    p = sink_softmax(s, sinks)
    o = jnp.einsum('bckgqs,bcskd->bcqkgd', p.astype(v.dtype), vb)
    return o.reshape(B, S, SW_W)


def swa_sample(q, k, v, sinks):
    B, T = q.shape[:2]
    s = jnp.einsum('bqkgd,bskd->bkgqs', q, k).astype(jnp.float32) * (SW_HD ** -0.5)
    p = sink_softmax(s, sinks)
    o = jnp.einsum('bkgqs,bskd->bqkgd', p.astype(v.dtype), v)
    return o.reshape(B, T, SW_W)


def a_project(x, w_in, cos, sin):
    B, T, _ = x.shape
    q, k, v, gd, mq, gm = _split(x @ w_in, A_SIZES)
    q = apply_partial_rope(q.reshape(B, T, DA_HEADS, 2, DA_QK), cos, sin)
    k = apply_partial_rope(k.reshape(B, T, DA_HEADS, 2, DA_QK), cos, sin)
    return q, k, v.reshape(B, T, DA_HEADS, DA_V), gd, mq.reshape(B, T, MEM_HEADS, MEM_HD), gm


def b_project(x, w_in, cos, sin):
    B, T, _ = x.shape
    q, gs, mq, gm = _split(x @ w_in, B_SIZES)
    q = apply_partial_rope(q.reshape(B, T, SW_KV, SW_GROUP, SW_HD), cos, sin)
    return q, gs, mq.reshape(B, T, MEM_HEADS, MEM_HD), gm


def shared_kv(h, w_kv, cos, sin):
    B, T, _ = h.shape
    k, v = jnp.split(h @ w_kv, 2, axis=-1)
    k = apply_partial_rope(k.reshape(B, T, SW_KV, SW_HD), cos, sin)
    return k, v.reshape(B, T, SW_KV, SW_HD)


def diff_finish(od, g, lam_init):
    B, T = od.shape[:2]
    return (head_rms(od, g) * (1.0 - lam_init)).reshape(B, T, DA_W)


def merge(x, o1, g1, o2, g2, w_out, ln_g, ln_b):
    mix = jnp.concatenate([o1 * jax.nn.silu(g1), o2 * jax.nn.silu(g2)], axis=-1)
    return layer_norm(DN_ALPHA * x + mix @ w_out, ln_g, ln_b)


def setup_inputs(seed: int = 0) -> dict:
    key = jax.random.key(seed)
    ks = jax.random.split(key, 24)

    def nrm(k, shape, scale=1.0):
        return jax.random.normal(k, shape, jnp.float32) * scale

    wr = min(WINDOW, PAST_LEN)
    return {
        "x_prompt": nrm(ks[0], (BATCH, SEQ, D_MODEL)),
        "x_sample": nrm(ks[1], (DEC_BATCH, DEC_SEQ, D_MODEL)),
        "mem_prompt": nrm(ks[2], (BATCH, N_MEM, D_MODEL)),
        "cache_diff_k": nrm(ks[3], (N_A, DEC_BATCH, PAST_LEN, DA_HEADS, 2, DA_QK)),
        "cache_diff_v": nrm(ks[4], (N_A, DEC_BATCH, PAST_LEN, DA_HEADS, DA_V)),
        "cache_swa_k": nrm(ks[5], (DEC_BATCH, wr, SW_KV, SW_HD)),
        "cache_swa_v": nrm(ks[6], (DEC_BATCH, wr, SW_KV, SW_HD)),
        "cache_mem_k": nrm(ks[7], (DEPTH, DEC_BATCH, N_MEM, MEM_HEADS, MEM_HD)),
        "cache_mem_v": nrm(ks[8], (DEPTH, DEC_BATCH, N_MEM, MEM_HEADS, MEM_HD)),
        "w_in_a": nrm(ks[9], (N_A, D_MODEL, sum(A_SIZES)), D_MODEL ** -0.5),
        "lam_q1": nrm(ks[10], (N_A, DA_QK), 0.1),
        "lam_k1": nrm(ks[11], (N_A, DA_QK), 0.1),
        "lam_q2": nrm(ks[12], (N_A, DA_QK), 0.1),
        "lam_k2": nrm(ks[13], (N_A, DA_QK), 0.1),
        "diff_norm_g": 1.0 + nrm(ks[14], (N_A, DA_V), 0.02),
        "w_in_b": nrm(ks[15], (N_B, D_MODEL, sum(B_SIZES)), D_MODEL ** -0.5),
        "sinks": nrm(ks[16], (N_B, SW_HEADS), 0.5),
        "w_kv_shared": nrm(ks[17], (D_MODEL, 2 * SW_KV * SW_HD), D_MODEL ** -0.5),
        "w_mem_kv": nrm(ks[18], (DEPTH, D_MODEL, 2 * MEM_W), D_MODEL ** -0.5),
        "w_out": nrm(ks[19], (DEPTH, MIX_W, D_MODEL), MIX_W ** -0.5 * DN_BETA),
        "ln_g": 1.0 + nrm(ks[20], (DEPTH, D_MODEL), 0.02),
        "ln_b": nrm(ks[21], (DEPTH, D_MODEL), 0.02),
    }


def reference(x_prompt, x_sample, mem_prompt, cache_diff_k, cache_diff_v, cache_swa_k, cache_swa_v,
              cache_mem_k, cache_mem_v, w_in_a, lam_q1, lam_k1, lam_q2, lam_k2, diff_norm_g,
              w_in_b, sinks, w_kv_shared, w_mem_kv, w_out, ln_g, ln_b):
    S = x_prompt.shape[1]
    T = x_sample.shape[1]
    P = cache_diff_k.shape[2]
    cos_p, sin_p = rope_tables(jnp.arange(S))
    cos_s, sin_s = rope_tables(P + jnp.arange(T))
    xp, xs = x_prompt, x_sample
    dkp, dvp, dks, dvs, mkp, mvp = [], [], [], [], [], []
    for l in range(DEPTH):
        mk_p, mv_p = mem_kv(mem_prompt, w_mem_kv[l])
        mkp.append(mk_p)
        mvp.append(mv_p)
        mk_s, mv_s = cache_mem_k[l], cache_mem_v[l]
        if l < N_A:
            lam_init = 0.8 - 0.6 * math.exp(-0.3 * l)
            lam = (jnp.exp(jnp.sum(lam_q1[l].astype(jnp.float32) * lam_k1[l].astype(jnp.float32)))
                   - jnp.exp(jnp.sum(lam_q2[l].astype(jnp.float32) * lam_k2[l].astype(jnp.float32)))
                   + lam_init)
            q, k, v, gd, mq, gm = a_project(xp, w_in_a[l], cos_p, sin_p)
            od = diff_finish(diff_prompt(q, k, v, lam), diff_norm_g[l], lam_init)
            om = mem_attend(mq, mk_p, mv_p)
            xp = merge(xp, od, gd, om, gm, w_out[l], ln_g[l], ln_b[l])
            dkp.append(k)
            dvp.append(v)
            q, k, v, gd, mq, gm = a_project(xs, w_in_a[l], cos_s, sin_s)
            kk = jnp.concatenate([cache_diff_k[l].astype(k.dtype), k], axis=1)
            vv = jnp.concatenate([cache_diff_v[l].astype(v.dtype), v], axis=1)
            od = diff_finish(diff_attend(q, kk, vv, None, lam), diff_norm_g[l], lam_init)
            om = mem_attend(mq, mk_s, mv_s)
            xs = merge(xs, od, gd, om, gm, w_out[l], ln_g[l], ln_b[l])
            dks.append(k)
            dvs.append(v)
        else:
            if l == N_A:
                skp, svp = shared_kv(xp, w_kv_shared, cos_p, sin_p)
                skn, svn = shared_kv(xs, w_kv_shared, cos_s, sin_s)
                sks = jnp.concatenate([cache_swa_k.astype(skn.dtype), skn], axis=1)
                svs = jnp.concatenate([cache_swa_v.astype(svn.dtype), svn], axis=1)
                wr_p = min(WINDOW, S)
                wr_s = cache_swa_k.shape[1]
                swa_kp, swa_vp = skp[:, S - wr_p:], svp[:, S - wr_p:]
                swa_ks, swa_vs = sks[:, sks.shape[1] - wr_s:], svs[:, svs.shape[1] - wr_s:]
            ib = l - N_A
            q, gs, mq, gm = b_project(xp, w_in_b[ib], cos_p, sin_p)
            os_ = swa_prompt(q, skp, svp, sinks[ib])
            om = mem_attend(mq, mk_p, mv_p)
            xp = merge(xp, os_, gs, om, gm, w_out[l], ln_g[l], ln_b[l])
            q, gs, mq, gm = b_project(xs, w_in_b[ib], cos_s, sin_s)
            os_ = swa_sample(q, sks, svs, sinks[ib])
            om = mem_attend(mq, mk_s, mv_s)
            xs = merge(xs, os_, gs, om, gm, w_out[l], ln_g[l], ln_b[l])
    diff_k_prompt = jnp.stack(dkp)
    diff_v_prompt = jnp.stack(dvp)
    diff_k_sample = jnp.stack(dks)
    diff_v_sample = jnp.stack(dvs)
    mem_k_prompt = jnp.stack(mkp)
    mem_v_prompt = jnp.stack(mvp)
    return (xp, xs, diff_k_prompt, diff_v_prompt, diff_k_sample, diff_v_sample,
            swa_kp, swa_vp, swa_ks, swa_vs, mem_k_prompt, mem_v_prompt)
```

```cpp
#include <hip/hip_runtime.h>
#include <hip/hip_cooperative_groups.h>
#include <cstdio>
#include <cstdint>
namespace cg = cooperative_groups;
namespace pg8 {
#define PG8_LAS __attribute__((address_space(3)))
typedef unsigned short bf16_t;
typedef short bf16x8 __attribute__((ext_vector_type(8)));
typedef float f32x4 __attribute__((ext_vector_type(4)));
typedef unsigned u32x4 __attribute__((ext_vector_type(4)));
constexpr int BM = 256, BK = 64, HALF = 128, HTB = HALF * BK * 2  , STAGE_BYTES = 8 * HTB, NXCD = 8, WGM = 8;

__host__ __device__ __forceinline__ int lds_byte(int r, int c) { const int st = (r >> 4) * 2 + (c >> 5), rr = r & 15, cc = c & 31, ob = rr * 64 + cc * 2; return st * 1024 + (ob ^ (((ob >> 9) & 1) << 5)); }
__host__ __device__ __forceinline__ void stage_rc(int b, int& R, int& C) { const int st = b / 1024, sb = b % 1024, swz = sb ^ (((sb >> 9) & 1) << 5); R = (st >> 1) * 16 + swz / 64; C = (st & 1) * 32 + (swz % 64) / 2; }
__host__ __device__ __forceinline__ int perm32(int rho) { const int n = rho >> 4, i = rho & 15; return 8 * (i >> 2) + 4 * n + (i & 3); }

struct Unit { int pm, pn; };
struct Gemm { const bf16_t* A; const bf16_t* Bt; int M, N, K; };

struct StaticOrder {
    int nM, nN, nwg, G, c;
    __host__ __device__ void init(int M, int N, int G_, int c_) { nM = M / BM; nN = N / BM; nwg = nM * nN; G = G_; c = c_; }
    __host__ __device__ bool next(int i, Unit& u) const {
        const long L = (long)i * G + c; if (L >= nwg) return false;
        int wgid = (int)L; { const int q = nwg / NXCD, r = nwg % NXCD, xcd = wgid % NXCD, off = wgid / NXCD; wgid = (xcd < r ? xcd * (q + 1) : r * (q + 1) + (xcd - r) * q) + off; }
        const int nig = WGM * nN, gid = wgid / nig, fm = gid * WGM, gsz = (nM - fm) < WGM ? (nM - fm) : WGM;
        u.pm = fm + ((wgid % nig) % gsz); u.pn = (wgid % nig) / gsz; return true;
    }
    __device__ __forceinline__ void a_ready(const Unit&) const {}
    __device__ __forceinline__ void done(const Unit&) const {}
};
__device__ __forceinline__ unsigned cvt_pk_bf16(float lo, float hi) { unsigned r; asm volatile("v_cvt_pk_bf16_f32 %0, %1, %2" : "=v"(r) : "v"(lo), "v"(hi)); return r; }
typedef float f32x2 __attribute__((ext_vector_type(2)));
template <class Epi, class Sched, bool ALIGN_EPI = false, bool SP2 = false>
__device__ __forceinline__ void gemm_phase(PG8_LAS unsigned char* lds, const Gemm g, const Sched& S, const Epi& E) {
    const int tid = threadIdx.x, wid = __builtin_amdgcn_readfirstlane(tid >> 6), lane = tid & 63, wr = wid >> 2, wc = wid & 3, fr = lane & 15, fq = lane >> 4;
    const int K = g.K, nt = K / BK;
    unsigned voffA[2], voffB[2];
#pragma unroll
    for (int i = 0; i < 2; ++i) { int R, C; stage_rc(tid * 16 + i * 8192, R, C); const int Rb = Epi::PERM ? ((R & ~31) + perm32(R & 31)) : R;
        voffA[i] = (unsigned)(R * K + C) * 2u; voffB[i] = (unsigned)(Rb * K + C) * 2u; }
    const size_t kstep = (size_t)(BK * 2);
    const size_t hstep = (size_t)HALF * K * 2;
    const size_t tstep = 2 * hstep;
    const unsigned ldsw = (unsigned)wid * 1024u;
    const int aoff = lds_byte(wr * 64 + fr, fq * 8), boff = lds_byte(wc * 32 + fr, fq * 8);
#define PG8_SA(b, h) (((b) * 2 + (h)) * HTB)
#define PG8_SB(b, h) ((4 + (b) * 2 + (h)) * HTB)
#define PG8_STAGE(bufoff, gbase, voff) do { _Pragma("unroll") for (int _i = 0; _i < 2; ++_i) \
        __builtin_amdgcn_global_load_lds((const unsigned*)((const char*)(gbase) + (voff)[_i]), (PG8_LAS unsigned*)(lds + (bufoff) + ldsw + _i * 8192), 16, 0, 0); } while (0)
#define PG8_LDA(dst, b, h) do { _Pragma("unroll") for (int m = 0; m < 4; ++m) _Pragma("unroll") for (int k = 0; k < 2; ++k) dst[m][k] = *(const PG8_LAS bf16x8*)(lds + PG8_SA(b, h) + aoff + m * 2048 + k * 1024); } while (0)
#define PG8_LDB(dst, b, h) do { _Pragma("unroll") for (int n = 0; n < 2; ++n) _Pragma("unroll") for (int k = 0; k < 2; ++k) dst[n][k] = *(const PG8_LAS bf16x8*)(lds + PG8_SB(b, h) + boff + n * 2048 + k * 1024); } while (0)
#define PG8_MMA(ai, bj, At, Bt) do { __builtin_amdgcn_s_setprio(1); _Pragma("unroll") for (int m = 0; m < 4; ++m) _Pragma("unroll") for (int n = 0; n < 2; ++n) _Pragma("unroll") for (int k = 0; k < 2; ++k) \
        acc[ai][bj][m][n] = __builtin_amdgcn_mfma_f32_16x16x32_bf16(Bt[n][k], At[m][k], acc[ai][bj][m][n], 0, 0, 0); __builtin_amdgcn_s_setprio(0); } while (0)
#define PG8_WAIT_V(n) asm volatile("s_waitcnt vmcnt(" #n ")" ::: "memory")
#define PG8_WAIT_L(n) asm volatile("s_waitcnt lgkmcnt(" #n ")" ::: "memory")
#define PG8_BAR __builtin_amdgcn_s_barrier()
#define PG8_SCHED __builtin_amdgcn_sched_barrier(0)
    Unit cur, nxt; int ui = 0;
    if (!S.next(0, cur)) return;
    f32x4 acc[2][2][4][2];
#pragma unroll
    for (int a = 0; a < 2; ++a)
#pragma unroll
        for (int b = 0; b < 2; ++b)
#pragma unroll
            for (int m = 0; m < 4; ++m)
#pragma unroll
                for (int n = 0; n < 2; ++n) acc[a][b][m][n] = (f32x4){0.f, 0.f, 0.f, 0.f};
    bf16x8 At[4][2], B0[2][2], B1[2][2];
    const char* cA = (const char*)g.A + (size_t)cur.pm * tstep; const char* cB = (const char*)g.Bt + (size_t)cur.pn * tstep;
    S.a_ready(cur);
    if constexpr (SP2) {
        PG8_STAGE(PG8_SB(0, 0), cB, voffB); PG8_STAGE(PG8_SB(0, 1), cB + hstep, voffB); PG8_STAGE(PG8_SA(0, 0), cA, voffA); PG8_STAGE(PG8_SA(0, 1), cA + hstep, voffA);
        if (wr == 1) PG8_BAR;
        PG8_WAIT_V(2); PG8_BAR;
        PG8_STAGE(PG8_SB(1, 0), cB + kstep, voffB); PG8_STAGE(PG8_SA(1, 0), cA + kstep, voffA); PG8_STAGE(PG8_SB(1, 1), cB + hstep + kstep, voffB);
        PG8_WAIT_V(6); PG8_BAR;
    } else {
        PG8_STAGE(PG8_SB(0, 0), cB, voffB); PG8_STAGE(PG8_SA(0, 0), cA, voffA); PG8_STAGE(PG8_SB(0, 1), cB + hstep, voffB); PG8_STAGE(PG8_SA(0, 1), cA + hstep, voffA);
        if (wr == 1) PG8_BAR;
        PG8_WAIT_V(4); PG8_BAR;
        PG8_STAGE(PG8_SB(1, 0), cB + kstep, voffB); PG8_STAGE(PG8_SA(1, 0), cA + kstep, voffA); PG8_STAGE(PG8_SB(1, 1), cB + hstep + kstep, voffB);
        PG8_WAIT_V(6); PG8_BAR;
    }
    for (;;) {
        const bool has_next = S.next(ui + 1, nxt);
        const char* nA = has_next ? (const char*)g.A + (size_t)nxt.pm * tstep : cA; const char* nB = has_next ? (const char*)g.Bt + (size_t)nxt.pn * tstep : cB;
        for (int t = 0; t < nt; t += 2) {
            const bool last = (t == nt - 2);
            const char* a1 = cA + (size_t)(t + 1) * kstep;
            const char* a2 = last ? nA : cA + (size_t)(t + 2) * kstep; const char* b2 = last ? nB : cB + (size_t)(t + 2) * kstep;
            const char* a3 = a2 + kstep; const char* b3 = b2 + kstep;
            if (last && has_next) S.a_ready(nxt);
            if constexpr (SP2) {
            PG8_LDB(B0, 0, 0); PG8_LDB(B1, 0, 1); PG8_SCHED; PG8_LDA(At, 0, 0); PG8_STAGE(PG8_SA(1, 1), a1 + hstep, voffA);
            PG8_WAIT_V(8); PG8_WAIT_L(0); PG8_BAR; PG8_MMA(0, 0, At, B0); PG8_MMA(0, 1, At, B1); PG8_BAR; PG8_SCHED;
            PG8_LDA(At, 0, 1); PG8_STAGE(PG8_SB(0, 0), b2, voffB); PG8_STAGE(PG8_SB(0, 1), b2 + hstep, voffB); PG8_STAGE(PG8_SA(0, 0), a2, voffA);
            PG8_WAIT_V(8); PG8_WAIT_L(0); PG8_BAR; PG8_MMA(1, 0, At, B0); PG8_MMA(1, 1, At, B1); PG8_BAR; PG8_SCHED;
            PG8_LDB(B0, 1, 0); PG8_LDB(B1, 1, 1); PG8_SCHED; PG8_LDA(At, 1, 0); PG8_STAGE(PG8_SA(0, 1), a2 + hstep, voffA);
            PG8_WAIT_V(8); PG8_WAIT_L(0); PG8_BAR; PG8_MMA(0, 0, At, B0); PG8_MMA(0, 1, At, B1); PG8_BAR; PG8_SCHED;
            PG8_LDA(At, 1, 1); PG8_STAGE(PG8_SB(1, 0), b3, voffB); PG8_STAGE(PG8_SB(1, 1), b3 + hstep, voffB); PG8_STAGE(PG8_SA(1, 0), a3, voffA);
            PG8_WAIT_V(8); PG8_WAIT_L(0); PG8_BAR; PG8_MMA(1, 0, At, B0); PG8_MMA(1, 1, At, B1); PG8_BAR; PG8_SCHED;
            } else {
            PG8_LDB(B0, 0, 0); PG8_SCHED; PG8_LDA(At, 0, 0); PG8_STAGE(PG8_SA(1, 1), a1 + hstep, voffA);
            PG8_WAIT_L(8); PG8_BAR; PG8_WAIT_L(0); PG8_MMA(0, 0, At, B0); PG8_BAR; PG8_SCHED;
            PG8_LDB(B1, 0, 1); PG8_STAGE(PG8_SB(0, 0), b2, voffB);
            PG8_BAR; PG8_WAIT_L(0); PG8_MMA(0, 1, At, B1); PG8_BAR;
            PG8_LDA(At, 0, 1); PG8_STAGE(PG8_SA(0, 0), a2, voffA);
            PG8_BAR; PG8_WAIT_L(0); PG8_MMA(1, 0, At, B0); PG8_BAR; PG8_SCHED;
            PG8_STAGE(PG8_SB(0, 1), b2 + hstep, voffB);
            PG8_WAIT_V(6); PG8_BAR; PG8_MMA(1, 1, At, B1); PG8_BAR;
            PG8_LDB(B0, 1, 0); PG8_SCHED; PG8_LDA(At, 1, 0); PG8_STAGE(PG8_SA(0, 1), a2 + hstep, voffA);
            PG8_WAIT_L(8); PG8_BAR; PG8_WAIT_L(0); PG8_MMA(0, 0, At, B0); PG8_BAR; PG8_SCHED;
            PG8_LDB(B1, 1, 1); PG8_STAGE(PG8_SB(1, 0), b3, voffB);
            PG8_BAR; PG8_WAIT_L(0); PG8_MMA(0, 1, At, B1); PG8_BAR;
            PG8_LDA(At, 1, 1); PG8_STAGE(PG8_SA(1, 0), a3, voffA);
            PG8_BAR; PG8_WAIT_L(0); PG8_MMA(1, 0, At, B0); PG8_BAR; PG8_SCHED;
            PG8_STAGE(PG8_SB(1, 1), b3 + hstep, voffB);
            PG8_WAIT_V(6); PG8_BAR; PG8_MMA(1, 1, At, B1); PG8_BAR;
            }
        }
        if constexpr (ALIGN_EPI) { if (wr == 0) PG8_BAR; }
        if constexpr (!Epi::AFTER_DRAIN) { E(acc, cur, wr, wc, fr, fq); S.done(cur); }
        if (!has_next) break;
#pragma unroll
        for (int a = 0; a < 2; ++a)
#pragma unroll
            for (int b = 0; b < 2; ++b)
#pragma unroll
                for (int m = 0; m < 4; ++m)
#pragma unroll
                    for (int n = 0; n < 2; ++n) acc[a][b][m][n] = (f32x4){0.f, 0.f, 0.f, 0.f};
        cur = nxt; cA = nA; cB = nB; ++ui;
        if constexpr (ALIGN_EPI) { if (wr == 1) PG8_BAR; }
    }
    PG8_WAIT_V(0);
    if constexpr (!ALIGN_EPI) { if (wr == 0) PG8_BAR; }
    PG8_BAR;
    if constexpr (Epi::AFTER_DRAIN) { E.fused(acc, cur, wr, wc, fr, fq, lds, wid, lane); S.done(cur); }
#undef PG8_SA
#undef PG8_SB
#undef PG8_STAGE
#undef PG8_LDA
#undef PG8_LDB
#undef PG8_MMA
#undef PG8_WAIT_V
#undef PG8_WAIT_L
#undef PG8_BAR
#undef PG8_SCHED
}
}

typedef unsigned short bf16_t;
typedef short bf16x8 __attribute__((ext_vector_type(8)));
typedef short s16x4 __attribute__((ext_vector_type(4)));
typedef float f32x4 __attribute__((ext_vector_type(4)));
typedef float f32x16 __attribute__((ext_vector_type(16)));
typedef unsigned u32x4 __attribute__((ext_vector_type(4)));
typedef unsigned u32x2 __attribute__((ext_vector_type(2)));
#define LAS __attribute__((address_space(3)))

constexpr int DM = 1024, NP = 16384, NS = 256, MA = NP + NS;
constexpr int NA = 3072, NB = 2304;
constexpr int KSROWS = 4160, SWROWS = 192;
constexpr float DN_ALPHA = 1.41421356237309515f;
constexpr float LOG2E = 1.4426950408889634f;
constexpr float C64 = 0.125f * LOG2E, THR64 = 64.f;
constexpr float C128 = 0.088388347648318440f * LOG2E, THR128 = 90.5f;
constexpr size_t OFF_DKP = 17039360, OFF_DVP = 25427968, OFF_DKS = 33816576, OFF_DVS = 33947648, OFF_SKP = 34078720, OFF_SVP = 34144256,
                 OFF_SKS = 34209792, OFF_SVS = 34471936, OFF_MKP = 34734080, OFF_MVP = 35782656;
constexpr size_t MiB = 1u << 20;
constexpr size_t WS_CTL = 0, WS_ROPE = 1 * MiB, WS_WA = 2 * MiB, WS_WB = 8 * MiB, WS_WM = 13 * MiB, WS_WO = 17 * MiB, WS_MEMB = 21 * MiB, WS_MKV = 23 * MiB,
                 WS_CMK = 27 * MiB, WS_CMV = 35 * MiB, WS_KSW = 43 * MiB, WS_VSW = 44 * MiB, WS_XA = 46 * MiB, WS_MIX = 79 * MiB, WS_Z0 = 112 * MiB,
                 WS_PA = 177 * MiB, WS_KS = 275 * MiB, WS_VS = 340 * MiB, WS_END = 405 * MiB;
constexpr int LDS_RING = 131072, LDS_BYTES = LDS_RING + 256;

__device__ __forceinline__ unsigned cvtpk(float lo, float hi) { unsigned r; asm volatile("v_cvt_pk_bf16_f32 %0, %1, %2" : "=v"(r) : "v"(lo), "v"(hi)); return r; }
__device__ __forceinline__ float bflo(unsigned w) { return __uint_as_float(w << 16); }
__device__ __forceinline__ float bfhi(unsigned w) { return __uint_as_float(w & 0xffff0000u); }
__device__ __forceinline__ float silu(float x) { return x * __builtin_amdgcn_rcpf(1.f + __expf(-x)); }
__device__ __forceinline__ void cvt8(const float* s, bf16_t* d) {
    const f32x4 a = *(const f32x4*)s, b = *(const f32x4*)(s + 4);
    u32x4 w; w.x = cvtpk(a.x, a.y); w.y = cvtpk(a.z, a.w); w.z = cvtpk(b.x, b.y); w.w = cvtpk(b.z, b.w); *(u32x4*)d = w;
}

template <class F> struct EpiWrap {
    static constexpr bool PERM = false, AFTER_DRAIN = false;
    F f;
    __device__ __forceinline__ void operator()(const f32x4 (&acc)[2][2][4][2], const pg8::Unit& u, int wr, int wc, int fr, int fq) const {
#pragma unroll
        for (int ai = 0; ai < 2; ++ai)
#pragma unroll
            for (int m = 0; m < 4; ++m) { const int row = u.pm * 256 + ai * 128 + wr * 64 + m * 16 + fr;
#pragma unroll
                for (int bj = 0; bj < 2; ++bj)
#pragma unroll
                    for (int n = 0; n < 2; ++n) f(row, u.pn * 256 + bj * 128 + wc * 32 + n * 16 + 4 * fq, acc[ai][bj][m][n]); }
    }
};
__device__ __forceinline__ f32x4 rope4(f32x4 v, int col, int pos, const float* rope) {
    f32x4 p; p.x = __shfl_xor(v.x, 32); p.y = __shfl_xor(v.y, 32); p.z = __shfl_xor(v.z, 32); p.w = __shfl_xor(v.w, 32);
    const float* t = rope + ((size_t)pos * 8 + (col & 4)) * 2;
    const f32x4 t0 = *(const f32x4*)t, t1 = *(const f32x4*)(t + 4);
    const float sg = (col & 8) ? 1.f : -1.f;
    f32x4 o; o.x = v.x * t0.x + sg * p.x * t0.y; o.y = v.y * t0.z + sg * p.y * t0.w; o.z = v.z * t1.x + sg * p.z * t1.y; o.w = v.w * t1.z + sg * p.w * t1.w;
    return o;
}
__device__ __forceinline__ void st_bf4(bf16_t* p, f32x4 v) { u32x2 w; w.x = cvtpk(v.x, v.y); w.y = cvtpk(v.z, v.w); *(u32x2*)p = w; }

struct EpiAF {
    bf16_t* PA; float* dout; bf16_t* KS; bf16_t* VS; const float* rope;
    __device__ __forceinline__ void operator()(int row, int col, f32x4 v) const {
        const bool samp = row >= NP; const int rs = row - NP;
        const int pos = samp ? 4096 + (rs & 15) : (row & 4095);
        const int region = col >> 9;
        if (region < 2 && ((col >> 4) & 3) == 0) v = rope4(v, col, pos, rope);
        st_bf4(PA + (size_t)row * NA + col, v);
        if (region == 1 || region == 2) {
            const int c = col & 511;
            if (!samp) *(f32x4*)(dout + (region == 1 ? OFF_DKP : OFF_DVP) + (size_t)row * 512 + c) = v;
            else { *(f32x4*)(dout + (region == 1 ? OFF_DKS : OFF_DVS) + (size_t)rs * 512 + c) = v;
                   st_bf4((region == 1 ? KS : VS) + ((size_t)(rs >> 4) * KSROWS + 4096 + (rs & 15)) * 512 + c, v); }
        }
    }
};
struct EpiMemF {
    bf16_t* MKV; float* dout;
    __device__ __forceinline__ void operator()(int row, int col, f32x4 v) const {
        st_bf4(MKV + (size_t)row * 2048 + col, v);
        const int l = col >> 10, c = col & 1023;
        *(f32x4*)(dout + (c < 512 ? OFF_MKP : OFF_MVP) + (size_t)l * 524288 + (size_t)row * 512 + (c & 511)) = v;
    }
};
struct EpiMergeF {
    const float* base_p; const float* base_s; float* out;
    __device__ __forceinline__ void operator()(int row, int col, f32x4 v) const {
        const float* bp = row < NP ? base_p + (size_t)row * DM + col : base_s + (size_t)(row - NP) * DM + col;
        const f32x4 x = *(const f32x4*)bp;
        *(f32x4*)(out + (size_t)row * DM + col) = x * DN_ALPHA + v;
    }
};
struct EpiBF {
    bf16_t* PB; float* dout; bf16_t* KSW; bf16_t* VSW; const float* rope;
    __device__ __forceinline__ void operator()(int row, int col, f32x4 v) const {
        const bool samp = row >= NP; const int rs = row - NP;
        const int t = samp ? (rs & 15) : (row & 4095);
        const int pos = samp ? 4096 + t : t;
        const bool isk = col >= 2048 && col < 2176;
        if ((col < 512 || isk) && ((col >> 4) & 3) == 0) v = rope4(v, col, pos, rope);
        st_bf4(PB + (size_t)row * NB + col, v);
        if (col >= 2048) {
            const int cc = col & 127;
            if (!samp) { if (t >= 3968) *(f32x4*)(dout + (isk ? OFF_SKP : OFF_SVP) + ((size_t)(row >> 12) * 128 + (t - 3968)) * 128 + cc) = v; }
            else { const int b = rs >> 4;
                   *(f32x4*)(dout + (isk ? OFF_SKS : OFF_SVS) + ((size_t)b * 128 + 112 + t) * 128 + cc) = v;
                   st_bf4((isk ? KSW : VSW) + ((size_t)b * SWROWS + 128 + t) * 128 + cc, v); }
        }
    }
};

namespace att {
constexpr int SHM_V = 16384, SHM_K = 16384;
#define KSWZ(row, colB) ((row) * 256 + ((colB) ^ (((row) & 7) << 4)))
#define SBAR() __builtin_amdgcn_sched_barrier(0)
__device__ __forceinline__ int v_st(int k, int c) { const int kk = (k & ~0xC) | ((k & 4) << 1) | ((k & 8) >> 1); return ((kk >> 3) * 4 + (c >> 5)) * 512 + ((kk & 7) * 32 + (c & 31)) * 2; }
__device__ __forceinline__ int v_rd_base(int lane) { return ((lane & 3) << 3) | (((lane >> 2) & 3) << 6) | (((lane >> 4) & 1) << 5) | (((lane >> 5) & 1) << 8); }
constexpr int v_rd_off(int d0, int ks, int half) { return d0 * 512 + ks * 4096 + half * 2048; }
template <int OFF> __device__ __forceinline__ s16x4 tr_read(int vb) {
    s16x4 r; asm volatile("ds_read_b64_tr_b16 %0, %1 offset:%2" : "=&v"(r) : "v"(vb), "i"(OFF) : "memory"); return r;
}
template <int D0> __device__ __forceinline__ void pv_one(f32x16& od, int vb, bf16x8 pa0, bf16x8 pa1, bf16x8 pa2, bf16x8 pa3) {
    const s16x4 l0 = tr_read<v_rd_off(D0, 0, 0)>(vb), h0 = tr_read<v_rd_off(D0, 0, 1)>(vb), l1 = tr_read<v_rd_off(D0, 1, 0)>(vb), h1 = tr_read<v_rd_off(D0, 1, 1)>(vb);
    const s16x4 l2 = tr_read<v_rd_off(D0, 2, 0)>(vb), h2 = tr_read<v_rd_off(D0, 2, 1)>(vb), l3 = tr_read<v_rd_off(D0, 3, 0)>(vb), h3 = tr_read<v_rd_off(D0, 3, 1)>(vb);
    asm volatile("s_waitcnt lgkmcnt(0)" ::: "memory"); SBAR();
#define PK(L, H) (bf16x8){L[0], L[1], L[2], L[3], H[0], H[1], H[2], H[3]}
    od = __builtin_amdgcn_mfma_f32_32x32x16_bf16(PK(l0, h0), pa0, od, 0, 0, 0);
    od = __builtin_amdgcn_mfma_f32_32x32x16_bf16(PK(l1, h1), pa1, od, 0, 0, 0);
    od = __builtin_amdgcn_mfma_f32_32x32x16_bf16(PK(l2, h2), pa2, od, 0, 0, 0);
    od = __builtin_amdgcn_mfma_f32_32x32x16_bf16(PK(l3, h3), pa3, od, 0, 0, 0);
#undef PK
}
__device__ __forceinline__ void partialSM(f32x16& p0, f32x16& p1, float& m_reg, float& alpha, float C, float thr) {
    float pmax = p0[0];
#pragma unroll
    for (int r = 1; r < 16; ++r) pmax = fmaxf(pmax, p0[r]);
#pragma unroll
    for (int r = 0; r < 16; ++r) pmax = fmaxf(pmax, p1[r]);
    { auto rr = __builtin_amdgcn_permlane32_swap(__float_as_uint(pmax), __float_as_uint(pmax), false, false);
      pmax = fmaxf(__uint_as_float(rr[0]), __uint_as_float(rr[1])); }
    float mn;
    if (__all(pmax - m_reg <= thr)) { mn = m_reg; alpha = 1.f; }
    else { mn = fmaxf(m_reg, pmax); alpha = __builtin_amdgcn_exp2f((m_reg - mn) * C); m_reg = mn; }
    const float mnC = -mn * C;
#pragma unroll
    for (int r = 0; r < 16; ++r) p0[r] = __builtin_amdgcn_exp2f(fmaf(p0[r], C, mnC));
#pragma unroll
    for (int r = 0; r < 16; ++r) p1[r] = __builtin_amdgcn_exp2f(fmaf(p1[r], C, mnC));
}
__device__ __forceinline__ void finishSM(f32x16& p0, f32x16& p1, float alpha, float& l_reg, bf16x8& pa0, bf16x8& pa1, bf16x8& pa2, bf16x8& pa3) {
    float ps = 0;
#pragma unroll
    for (int r = 0; r < 16; ++r) ps += p0[r];
#pragma unroll
    for (int r = 0; r < 16; ++r) ps += p1[r];
    { auto rr = __builtin_amdgcn_permlane32_swap(__float_as_uint(ps), __float_as_uint(ps), false, false);
      ps = __uint_as_float(rr[0]) + __uint_as_float(rr[1]); }
    l_reg = l_reg * alpha + ps;
#define PK4(P, BASE, OUT) do { unsigned a0 = cvtpk(P[BASE + 0], P[BASE + 1]), a1 = cvtpk(P[BASE + 2], P[BASE + 3]);   \
    unsigned b0 = cvtpk(P[BASE + 4], P[BASE + 5]), b1 = cvtpk(P[BASE + 6], P[BASE + 7]);                              \
    auto r0 = __builtin_amdgcn_permlane32_swap(a0, b0, false, false); auto r1 = __builtin_amdgcn_permlane32_swap(a1, b1, false, false); \
    u32x4 w = {r0[0], r1[0], r0[1], r1[1]}; OUT = *reinterpret_cast<bf16x8*>(&w); } while (0)
    PK4(p0, 0, pa0); PK4(p0, 8, pa1); PK4(p1, 0, pa2); PK4(p1, 8, pa3);
#undef PK4
}
template <int QS, bool PVHALF>
__device__ __forceinline__ void attn_core(LAS unsigned char* lds, const bf16_t* Kb, long ldk, const bf16_t* Vb, long ldv, int NT, int nkeys,
                                          const bf16_t* qptr, int wNT, int kcoffB, int pvsel, float C, float thr, f32x16 (&o)[4], float& m_reg, float& l_reg) {
    const int tid = threadIdx.x, lane = tid & 63, r32 = lane & 31, hi = lane >> 5;
    LAS unsigned char* V_lds = lds; LAS unsigned char* K_lds = lds + 2 * SHM_V;
    bf16x8 qr[QS];
#pragma unroll
    for (int d0 = 0; d0 < QS; ++d0) qr[d0] = *(const bf16x8*)(qptr + d0 * 16);
#pragma unroll
    for (int d = 0; d < 4; ++d) o[d] = f32x16{};
    m_reg = -1e30f; l_reg = 0.f;
    const int sr = tid >> 4, sc = (tid & 15) * 8;
    const int vst0 = v_st(sr, sc), vst1 = v_st(32 + sr, sc), kst0 = KSWZ(sr, sc * 2), kst1 = KSWZ(32 + sr, sc * 2);
    const int vb0 = (int)(uintptr_t)V_lds + v_rd_base(lane);
    const bf16_t* kg = Kb + (long)sr * ldk + sc; const bf16_t* vg = Vb + (long)sr * ldv + sc;
    bf16x8 sk0, sk1, sv0, sv1;
#define SLOAD(t) do { const bf16_t* kp_ = kg + (long)(t) * 64 * ldk; const bf16_t* vp_ = vg + (long)(t) * 64 * ldv; \
    sk0 = *(const bf16x8*)kp_; sk1 = *(const bf16x8*)(kp_ + 32 * ldk); sv0 = *(const bf16x8*)vp_; sv1 = *(const bf16x8*)(vp_ + 32 * ldv); } while (0)
#define SWRITE(bf) do { *(LAS bf16x8*)(V_lds + (bf) * SHM_V + vst0) = sv0; *(LAS bf16x8*)(V_lds + (bf) * SHM_V + vst1) = sv1; \
    *(LAS bf16x8*)(K_lds + (bf) * SHM_K + kst0) = sk0; *(LAS bf16x8*)(K_lds + (bf) * SHM_K + kst1) = sk1; } while (0)
    SLOAD(0); SWRITE(0); __syncthreads();
    for (int j = 0; j < NT; ++j) {
        const int cur = j & 1;
        if (j + 1 < NT) SLOAD(j + 1);
        if (j < wNT) {
            f32x16 p0 = f32x16{}, p1 = f32x16{};
            const LAS unsigned char* Ks = K_lds + cur * SHM_K;
#pragma unroll
            for (int d0 = 0; d0 < QS; ++d0) { const int cb = kcoffB + (d0 * 16 + hi * 8) * 2;
                const bf16x8 b0 = *(const LAS bf16x8*)(Ks + KSWZ(r32, cb));
                const bf16x8 b1 = *(const LAS bf16x8*)(Ks + KSWZ(32 + r32, cb));
                p0 = __builtin_amdgcn_mfma_f32_32x32x16_bf16(b0, qr[d0], p0, 0, 0, 0);
                p1 = __builtin_amdgcn_mfma_f32_32x32x16_bf16(b1, qr[d0], p1, 0, 0, 0); }
            if ((j + 1) * 64 > nkeys) { const int kb = j * 64 + 4 * hi;
#pragma unroll
                for (int r = 0; r < 16; ++r) { const int kv = kb + (r & 3) + 8 * (r >> 2); if (kv >= nkeys) p0[r] = -1e30f; if (kv + 32 >= nkeys) p1[r] = -1e30f; } }
            float alpha; bf16x8 pa0, pa1, pa2, pa3;
            partialSM(p0, p1, m_reg, alpha, C, thr);
            finishSM(p0, p1, alpha, l_reg, pa0, pa1, pa2, pa3);
            if (__any(alpha < 1.f)) {
#pragma unroll
                for (int d = 0; d < (PVHALF ? 2 : 4); ++d)
#pragma unroll
                    for (int r = 0; r < 16; ++r) o[d][r] *= alpha; }
            const int vb = vb0 + cur * SHM_V;
            if constexpr (!PVHALF) { pv_one<0>(o[0], vb, pa0, pa1, pa2, pa3); pv_one<1>(o[1], vb, pa0, pa1, pa2, pa3); pv_one<2>(o[2], vb, pa0, pa1, pa2, pa3); pv_one<3>(o[3], vb, pa0, pa1, pa2, pa3); }
            else { if (pvsel == 0) { pv_one<0>(o[0], vb, pa0, pa1, pa2, pa3); pv_one<1>(o[1], vb, pa0, pa1, pa2, pa3); }
                   else { pv_one<2>(o[0], vb, pa0, pa1, pa2, pa3); pv_one<3>(o[1], vb, pa0, pa1, pa2, pa3); } }
        }
        if (j + 1 < NT) SWRITE(cur ^ 1);
        __syncthreads();
    }
#undef SLOAD
#undef SWRITE
}

struct Ctx { LAS unsigned char* lds; int lane, wid, r32, hi; };

template <int ND> __device__ __forceinline__ void store_gated(const f32x16 (&o)[4], float scale, const bf16_t* gate, bf16_t* out, int hi) {
#pragma unroll
    for (int d = 0; d < ND; ++d)
#pragma unroll
        for (int g = 0; g < 4; ++g) { const int dv = 32 * d + 8 * g + 4 * hi;
            const u32x2 gt = *(const u32x2*)(gate + dv);
            f32x4 v; v.x = o[d][4 * g] * scale * silu(bflo(gt.x)); v.y = o[d][4 * g + 1] * scale * silu(bfhi(gt.x));
            v.z = o[d][4 * g + 2] * scale * silu(bflo(gt.y)); v.w = o[d][4 * g + 3] * scale * silu(bfhi(gt.y));
            st_bf4(out + dv, v); }
}

__device__ __forceinline__ void diff_unit(const Ctx& cx, bool samp, int b, int h, int qb, const bf16_t* PA, const bf16_t* KS, const bf16_t* VS, bf16_t* MIX, const float* gnorm, float lam) {
    const int c = cx.wid >> 2, rb = cx.wid & 3;
    long row; bool valid; int NT, wNT, nkeys; const bf16_t* Kb; const bf16_t* Vb; long ldk;
    if (!samp) { row = (long)b * 4096 + qb * 128 + rb * 32 + cx.r32; valid = true; NT = 2 * qb + 2; wNT = 2 * qb + 1 + (rb >> 1); nkeys = NT * 64;
                 Kb = PA + (size_t)b * 4096 * NA + 512 + h * 128; Vb = Kb + 512; ldk = NA; }
    else { row = NP + b * 16 + (cx.r32 < 15 ? cx.r32 : 15); valid = (rb == 0) && cx.r32 < 16; NT = 65; wNT = (rb == 0) ? 65 : 0; nkeys = 4112;
           Kb = KS + (size_t)b * KSROWS * 512 + h * 128; Vb = VS + (size_t)b * KSROWS * 512 + h * 128; ldk = 512; }
    const bf16_t* qptr = PA + (size_t)row * NA + h * 128 + c * 64 + cx.hi * 8;
    f32x16 o[4]; float m, l;
    attn_core<4, false>(cx.lds, Kb, ldk, Vb, ldk, NT, nkeys, qptr, wNT, c * 128, 0, C64, THR64, o, m, l);
    const float inv = l > 0.f ? 1.f / l : 0.f;
    LAS float* xch = (LAS float*)cx.lds + rb * 4096;
    if (c == 1) {
#pragma unroll
        for (int d = 0; d < 4; ++d)
#pragma unroll
            for (int r = 0; r < 16; ++r) xch[(d * 16 + r) * 64 + cx.lane] = o[d][r] * inv; }
    __syncthreads();
    if (c == 0) {
        float ss = 0.f;
#pragma unroll
        for (int d = 0; d < 4; ++d)
#pragma unroll
            for (int r = 0; r < 16; ++r) { const float od = o[d][r] * inv - lam * xch[(d * 16 + r) * 64 + cx.lane]; o[d][r] = od; ss += od * od; }
        ss += __shfl_xor(ss, 32);
        const float rms = rsqrtf(ss * (1.f / 128.f) + 1e-5f) * 0.8f;
        if (valid) {
            const bf16_t* gate = PA + (size_t)row * NA + 1536 + h * 128; bf16_t* out = MIX + (size_t)row * DM + h * 128;
#pragma unroll
            for (int d = 0; d < 4; ++d)
#pragma unroll
                for (int g = 0; g < 4; ++g) { const int dv = 32 * d + 8 * g + 4 * cx.hi;
                    const f32x4 gn = *(const f32x4*)(gnorm + dv); const u32x2 gt = *(const u32x2*)(gate + dv);
                    f32x4 v; v.x = o[d][4 * g] * rms * gn.x * silu(bflo(gt.x)); v.y = o[d][4 * g + 1] * rms * gn.y * silu(bfhi(gt.x));
                    v.z = o[d][4 * g + 2] * rms * gn.z * silu(bflo(gt.y)); v.w = o[d][4 * g + 3] * rms * gn.w * silu(bfhi(gt.y));
                    st_bf4(out + dv, v); }
        }
    }
    __syncthreads();
}
__device__ __forceinline__ void mem_unit(const Ctx& cx, bool samp, int b, int h, int qb, const bf16_t* P, int ldp, int qcol, int gcol,
                                         const bf16_t* Kb, const bf16_t* Vb, long ldk, bf16_t* MIX) {
    long row; bool valid; int wNT;
    if (!samp) { row = (long)b * 4096 + qb * 256 + cx.wid * 32 + cx.r32; valid = true; wNT = 4; }
    else { row = NP + b * 16 + (cx.r32 < 15 ? cx.r32 : 15); valid = (cx.wid == 0) && cx.r32 < 16; wNT = (cx.wid == 0) ? 4 : 0; }
    const bf16_t* qptr = P + (size_t)row * ldp + qcol + h * 128 + cx.hi * 8;
    f32x16 o[4]; float m, l;
    attn_core<8, false>(cx.lds, Kb, ldk, Vb, ldk, 4, 256, qptr, wNT, 0, 0, C128, THR128, o, m, l);
    const float inv = l > 0.f ? 1.f / l : 0.f;
    if (valid) store_gated<4>(o, inv, P + (size_t)row * ldp + gcol + h * 128, MIX + (size_t)row * DM + 512 + h * 128, cx.hi);
}
__device__ __forceinline__ void swa_unit(const Ctx& cx, bool samp, int b, int c, int half, const bf16_t* PB, const bf16_t* KSW, const bf16_t* VSW, bf16_t* MIX, const float* sinks) {
    const int head = cx.wid, kv = cx.wid >> 2;
    long row; bool valid; int NT, nkeys; const bf16_t* Kb; const bf16_t* Vb; long ldk;
    if (!samp) { row = (long)b * 4096 + c * 64 + half * 32 + cx.r32; valid = true; const int c0 = c > 2 ? c - 2 : 0; NT = c - c0 + 1; nkeys = NT * 64;
                 Kb = PB + ((size_t)b * 4096 + c0 * 64) * NB + 2048; Vb = Kb + 128; ldk = NB; }
    else { row = NP + b * 16 + (cx.r32 < 15 ? cx.r32 : 15); valid = cx.r32 < 16; NT = 3; nkeys = 144;
           Kb = KSW + (size_t)b * SWROWS * 128; Vb = VSW + (size_t)b * SWROWS * 128; ldk = 128; }
    const bf16_t* qptr = PB + (size_t)row * NB + head * 64 + cx.hi * 8;
    f32x16 o[4]; float m, l;
    attn_core<4, true>(cx.lds, Kb, ldk, Vb, ldk, NT, nkeys, qptr, NT, kv * 128, kv, C64, THR64, o, m, l);
    const float lt = l + __builtin_amdgcn_exp2f(sinks[head] * LOG2E - m * C64);
    const float inv = 1.f / lt;
    if (valid) store_gated<2>(o, inv, PB + (size_t)row * NB + 512 + head * 64, MIX + (size_t)row * DM + head * 64, cx.hi);
}
#undef KSWZ
#undef SBAR
}

__device__ __forceinline__ float wave_sum(float v) {
#pragma unroll
    for (int o = 1; o < 64; o <<= 1) v += __shfl_xor(v, o);
    return v;
}
__device__ __forceinline__ void p0_transpose_item(const float* W, int K, int N, bf16_t* WT, int row_off, LAS float* scr, int item, int lane) {
    const int nblk = N / 32, kb = item / nblk, nb = item % nblk, k0 = 64 * kb, n0 = 32 * nb;
#pragma unroll 8
    for (int i = 0; i < 32; ++i) { const int kk = 2 * i + (lane >> 5); scr[kk * 33 + (lane & 31)] = W[(size_t)(k0 + kk) * N + n0 + (lane & 31)]; }
    asm volatile("s_waitcnt lgkmcnt(0)" ::: "memory");
    const int c = lane & 7;
#pragma unroll
    for (int j = 0; j < 4; ++j) { const int n = (lane >> 3) + 8 * j; const LAS float* s = scr + (8 * c) * 33 + n;
        u32x4 o; o.x = cvtpk(s[0 * 33], s[1 * 33]); o.y = cvtpk(s[2 * 33], s[3 * 33]); o.z = cvtpk(s[4 * 33], s[5 * 33]); o.w = cvtpk(s[6 * 33], s[7 * 33]);
        *(u32x4*)(WT + (size_t)(row_off + n0 + n) * K + k0 + 8 * c) = o; }
    asm volatile("s_waitcnt lgkmcnt(0)" ::: "memory");
}
__device__ __forceinline__ void ln_rows(const float* zin, float* fout, bf16_t* bout, const float* g, const float* bta, int gw, int NGW, int lane) {
    f32x4 g4[4], b4[4];
#pragma unroll
    for (int j = 0; j < 4; ++j) { g4[j] = *(const f32x4*)(g + 4 * lane + 256 * j); b4[j] = *(const f32x4*)(bta + 4 * lane + 256 * j); }
    for (int m = gw; m < MA; m += NGW) {
        const float* zr = zin + (size_t)m * DM + 4 * lane;
        f32x4 v[4]; float s = 0.f;
#pragma unroll
        for (int j = 0; j < 4; ++j) { v[j] = *(const f32x4*)(zr + 256 * j); s += (v[j].x + v[j].y) + (v[j].z + v[j].w); }
        const float mean = wave_sum(s) * (1.f / DM); float s2 = 0.f;
#pragma unroll
        for (int j = 0; j < 4; ++j) { v[j] = v[j] - mean; s2 += (v[j].x * v[j].x + v[j].y * v[j].y) + (v[j].z * v[j].z + v[j].w * v[j].w); }
        const float rstd = rsqrtf(wave_sum(s2) * (1.f / DM) + 1e-5f);
#pragma unroll
        for (int j = 0; j < 4; ++j) { const f32x4 y = v[j] * rstd * g4[j] + b4[j];
            *(f32x4*)(fout + (size_t)m * DM + 4 * lane + 256 * j) = y;
            if (bout) st_bf4(bout + (size_t)m * DM + 4 * lane + 256 * j, y); }
    }
}

struct Args { const float* in[22]; float* out; unsigned char* ws; int ph_lo, ph_hi; };
constexpr int NWAVES = 8, NPHASE = 9;

__global__ void __launch_bounds__(NWAVES * 64, 2) yoco_fwd(Args a) {
    extern __shared__ __attribute__((aligned(16))) unsigned char lds_raw[];
    LAS unsigned char* lds = (LAS unsigned char*)lds_raw;
    volatile LAS unsigned* MISC = (volatile LAS unsigned*)(lds + LDS_RING);
    cg::grid_group grid = cg::this_grid();
    const int tid = threadIdx.x, lane = tid & 63, wave = __builtin_amdgcn_readfirstlane(tid >> 6);
    const int G = gridDim.x, gw = blockIdx.x * NWAVES + wave, NGW = G * NWAVES;
    const long gtid = (long)blockIdx.x * (NWAVES * 64) + tid, NTHR = (long)G * (NWAVES * 64);
    unsigned char* ws = a.ws; float* dout = a.out;
    unsigned* ctl = (unsigned*)(ws + WS_CTL);
    float* ROPE = (float*)(ws + WS_ROPE);
    bf16_t* WA_t = (bf16_t*)(ws + WS_WA); bf16_t* WB_t = (bf16_t*)(ws + WS_WB); bf16_t* WM_t = (bf16_t*)(ws + WS_WM); bf16_t* WO_t = (bf16_t*)(ws + WS_WO);
    bf16_t* MEMB = (bf16_t*)(ws + WS_MEMB); bf16_t* MKV = (bf16_t*)(ws + WS_MKV); bf16_t* CMK = (bf16_t*)(ws + WS_CMK); bf16_t* CMV = (bf16_t*)(ws + WS_CMV);
    bf16_t* KSW = (bf16_t*)(ws + WS_KSW); bf16_t* VSW = (bf16_t*)(ws + WS_VSW); bf16_t* XA = (bf16_t*)(ws + WS_XA); bf16_t* XB = XA;
    bf16_t* MIX = (bf16_t*)(ws + WS_MIX); float* Z0 = (float*)(ws + WS_Z0); bf16_t* PA = (bf16_t*)(ws + WS_PA); bf16_t* PB = PA;
    bf16_t* KS = (bf16_t*)(ws + WS_KS); bf16_t* VS = (bf16_t*)(ws + WS_VS);
    const int lo = a.ph_lo, hi_ph = a.ph_hi;
#define IN(k) (lo <= (k) && (k) < hi_ph)
#define SEAM(k) do { if (IN(k) && IN((k) + 1)) grid.sync(); } while (0)
    att::Ctx cx; cx.lds = lds; cx.lane = lane; cx.wid = wave; cx.r32 = lane & 31; cx.hi = lane >> 5;

    if (IN(0)) {
        LAS float* scr = (LAS float*)(lds + wave * 16384);
        for (int it = gw; it < 4736; it += NGW) {
            int r = it;
            if (r < 1536) { p0_transpose_item(a.in[9], DM, NA, WA_t, 0, scr, r, lane); continue; } r -= 1536;
            if (r < 1024) { p0_transpose_item(a.in[15], DM, 2048, WB_t, 0, scr, r, lane); continue; } r -= 1024;
            if (r < 128) { p0_transpose_item(a.in[17], DM, 256, WB_t, 2048, scr, r, lane); continue; } r -= 128;
            if (r < 1024) { const int l = r >> 9; p0_transpose_item(a.in[18] + (size_t)l * DM * DM, DM, DM, WM_t, l * 1024, scr, r & 511, lane); continue; } r -= 1024;
            { const int l = r >> 9; p0_transpose_item(a.in[19] + (size_t)l * DM * DM, DM, DM, WO_t, l * 1024, scr, r & 511, lane); }
        }
        for (long i = gtid; i < 2097152; i += NTHR) cvt8(a.in[0] + i * 8, XA + i * 8);
        for (long i = gtid; i < 32768; i += NTHR) cvt8(a.in[1] + i * 8, XA + (size_t)NP * DM + i * 8);
        for (long i = gtid; i < 131072; i += NTHR) cvt8(a.in[2] + i * 8, MEMB + i * 8);
        for (long i = gtid; i < 4194304; i += NTHR) { const long b = i >> 18, r = i & 262143; const size_t d = (size_t)b * KSROWS * 512 + r * 8;
            cvt8(a.in[3] + i * 8, KS + d); cvt8(a.in[4] + i * 8, VS + d); }
        for (long i = gtid; i < 524288; i += NTHR) { cvt8(a.in[7] + i * 8, CMK + i * 8); cvt8(a.in[8] + i * 8, CMV + i * 8); }
        for (long i = gtid; i < 32768; i += NTHR) { const long b = i >> 11, r = i & 2047; const size_t d = (size_t)b * SWROWS * 128 + r * 8;
            cvt8(a.in[5] + i * 8, KSW + d); cvt8(a.in[6] + i * 8, VSW + d);
            const int rw = (int)(r >> 4);
            if (rw >= 16) { const size_t od = ((size_t)b * 128 + rw - 16) * 128 + (r & 15) * 8;
                *(f32x4*)(dout + OFF_SKS + od) = *(const f32x4*)(a.in[5] + i * 8); *(f32x4*)(dout + OFF_SKS + od + 4) = *(const f32x4*)(a.in[5] + i * 8 + 4);
                *(f32x4*)(dout + OFF_SVS + od) = *(const f32x4*)(a.in[6] + i * 8); *(f32x4*)(dout + OFF_SVS + od + 4) = *(const f32x4*)(a.in[6] + i * 8 + 4); } }
        for (long i = gtid; i < 49152; i += NTHR) { const long b = i / 3072, r = i % 3072; const size_t d = ((size_t)b * KSROWS + 4112) * 512 + r * 8;
            *(u32x4*)(KS + d) = (u32x4){0u, 0u, 0u, 0u}; *(u32x4*)(VS + d) = (u32x4){0u, 0u, 0u, 0u}; }
        for (long i = gtid; i < 12288; i += NTHR) { const long b = i / 768, r = i % 768; const size_t d = ((size_t)b * SWROWS + 144) * 128 + r * 8;
            *(u32x4*)(KSW + d) = (u32x4){0u, 0u, 0u, 0u}; *(u32x4*)(VSW + d) = (u32x4){0u, 0u, 0u, 0u}; }
        for (long i = gtid; i < 4112 * 8; i += NTHR) { const int pos = (int)(i >> 3), fi = (int)(i & 7);
            const double inv = fi == 0 ? 1.0 : fi == 1 ? 0.19392274474868576 : fi == 2 ? 0.03760603093086393 : fi == 3 ? 0.007292664737217109 :
                               fi == 4 ? 0.001414213562373095 : fi == 5 ? 0.0002742481756762073 : fi == 6 ? 5.318295896944988e-05 : 1.031338537721246e-05;
            const double rev = (double)pos * inv * 0.15915494309189535; const float fr = (float)(rev - __builtin_rint(rev));
            ROPE[i * 2] = __builtin_amdgcn_cosf(fr); ROPE[i * 2 + 1] = __builtin_amdgcn_sinf(fr); }
    }
    SEAM(0);
    if (IN(1)) {
        { pg8::Gemm g{MEMB, WM_t, 1024, 2048, DM}; pg8::StaticOrder S; S.init(1024, 2048, G, (int)((blockIdx.x + G / 2) % G));
          EpiWrap<EpiMemF> E{{MKV, dout}};
          pg8::gemm_phase<EpiWrap<EpiMemF>, pg8::StaticOrder, true, true>(lds, g, S, E); }
        { pg8::Gemm g{XA, WA_t, MA, NA, DM}; pg8::StaticOrder S; S.init(MA, NA, G, (int)blockIdx.x);
          EpiWrap<EpiAF> E{{PA, dout, KS, VS, ROPE}};
          pg8::gemm_phase<EpiWrap<EpiAF>, pg8::StaticOrder, true, true>(lds, g, S, E); }
    }
    SEAM(1);
    if (IN(2)) {
        float s1 = 0.f, s2 = 0.f;
        for (int i = 0; i < 64; ++i) { s1 += a.in[10][i] * a.in[11][i]; s2 += a.in[12][i] * a.in[13][i]; }
        const float lam = __expf(s1) - __expf(s2) + 0.2f;
        for (;;) {
            if (tid == 0) MISC[0] = atomicAdd(ctl, 1u);
            __syncthreads(); const unsigned u = MISC[0]; __syncthreads();
            if (u >= 896u) break;
            if (u < 576u) { const bool samp = u < 64u; const unsigned v = samp ? u : u - 64u;
                const int b = samp ? (int)(v >> 2) : (int)((v & 15u) >> 2), h = (int)(v & 3u), qb = samp ? 0 : 31 - (int)(v >> 4);
                att::diff_unit(cx, samp, b, h, qb, PA, KS, VS, MIX, a.in[14], lam); }
            else { const bool samp = u >= 832u; const unsigned v = samp ? u - 832u : u - 576u;
                const int b = samp ? (int)(v >> 2) : (int)(v >> 6), h = samp ? (int)(v & 3u) : (int)((v >> 4) & 3u), qb = samp ? 0 : (int)(v & 15u);
                const bf16_t* Kb = samp ? CMK + ((size_t)b * 256) * 512 + h * 128 : MKV + ((size_t)b * 256) * 2048 + h * 128;
                const bf16_t* Vb = samp ? CMV + ((size_t)b * 256) * 512 + h * 128 : Kb + 512;
                att::mem_unit(cx, samp, b, h, qb, PA, NA, 2048, 2560, Kb, Vb, samp ? 512 : 2048, MIX); }
        }
    }
    SEAM(2);
    if (IN(3)) {
        pg8::Gemm g{MIX, WO_t, MA, DM, DM}; pg8::StaticOrder S; S.init(MA, DM, G, (int)blockIdx.x);
        EpiWrap<EpiMergeF> E{{a.in[0], a.in[1], Z0}};
        pg8::gemm_phase<EpiWrap<EpiMergeF>, pg8::StaticOrder, true, true>(lds, g, S, E);
    }
    SEAM(3);
    if (IN(4)) ln_rows(Z0, Z0, XB, a.in[20], a.in[21], gw, NGW, lane);
    SEAM(4);
    if (IN(5)) {
        pg8::Gemm g{XB, WB_t, MA, NB, DM}; pg8::StaticOrder S; S.init(MA, NB, G, (int)blockIdx.x);
        EpiWrap<EpiBF> E{{PB, dout, KSW, VSW, ROPE}};
        pg8::gemm_phase<EpiWrap<EpiBF>, pg8::StaticOrder, true, true>(lds, g, S, E);
    }
    SEAM(5);
    if (IN(6)) {
        for (;;) {
            if (tid == 0) MISC[0] = atomicAdd(ctl + 64, 1u);
            __syncthreads(); const unsigned u = MISC[0]; __syncthreads();
            if (u >= 848u) break;
            if (u < 320u) { const bool samp = u >= 256u; const unsigned v = samp ? u - 256u : u;
                const int b = samp ? (int)(v >> 2) : (int)(v >> 6), h = samp ? (int)(v & 3u) : (int)((v >> 4) & 3u), qb = samp ? 0 : (int)(v & 15u);
                const bf16_t* Kb = samp ? CMK + ((size_t)(16 + b) * 256) * 512 + h * 128 : MKV + ((size_t)b * 256) * 2048 + 1024 + h * 128;
                const bf16_t* Vb = samp ? CMV + ((size_t)(16 + b) * 256) * 512 + h * 128 : Kb + 512;
                att::mem_unit(cx, samp, b, h, qb, PB, NB, 1024, 1536, Kb, Vb, samp ? 512 : 2048, MIX); }
            else { const bool samp = u >= 832u; const unsigned v = samp ? u - 832u : u - 320u;
                const int b = samp ? (int)v : (int)(v >> 7), c = samp ? 0 : (int)((v >> 1) & 63u), half = samp ? 0 : (int)(v & 1u);
                att::swa_unit(cx, samp, b, c, half, PB, KSW, VSW, MIX, a.in[16]); }
        }
    }
    SEAM(6);
    if (IN(7)) {
        pg8::Gemm g{MIX, WO_t + (size_t)DM * DM, MA, DM, DM}; pg8::StaticOrder S; S.init(MA, DM, G, (int)blockIdx.x);
        EpiWrap<EpiMergeF> E{{Z0, Z0 + (size_t)NP * DM, dout}};
        pg8::gemm_phase<EpiWrap<EpiMergeF>, pg8::StaticOrder, true, true>(lds, g, S, E);
    }
    SEAM(7);
    if (IN(8)) ln_rows(dout, dout, nullptr, a.in[20] + DM, a.in[21] + DM, gw, NGW, lane);
#undef IN
#undef SEAM
}

#ifndef MK_N_LAUNCHES
#define MK_N_LAUNCHES 1
#endif
extern "C" void kernel_launch(void* const* d_in, const int* in_sizes, int n_in, void* d_out, int out_size, void* d_ws, size_t ws_size, hipStream_t stream) {
    static int grid = 0;
    if (grid == 0) {
        if (n_in != 22 || ws_size < WS_END) { fprintf(stderr, "kernel_launch: unexpected n_in %d / ws %zu\n", n_in, ws_size); grid = -1; return; }
        int dev = 0, cus = 0, per_cu = 0;
        if (hipGetDevice(&dev) != hipSuccess || hipDeviceGetAttribute(&cus, hipDeviceAttributeMultiprocessorCount, dev) != hipSuccess) { grid = -1; return; }
        if (hipFuncSetAttribute((const void*)yoco_fwd, hipFuncAttributeMaxDynamicSharedMemorySize, LDS_BYTES) != hipSuccess) { fprintf(stderr, "kernel_launch: hipFuncSetAttribute failed\n"); grid = -1; return; }
        if (hipOccupancyMaxActiveBlocksPerMultiprocessor(&per_cu, (const void*)yoco_fwd, NWAVES * 64, LDS_BYTES) != hipSuccess || per_cu < 1) { fprintf(stderr, "kernel_launch: occupancy query says %d\n", per_cu); per_cu = 1; }
        (void)hipGetLastError();
        grid = cus;
    }
    if (grid < 0) return;
    (void)hipMemsetAsync((char*)d_ws + WS_CTL, 0, 4096, stream);
    Args a{};
    for (int i = 0; i < 22; ++i) a.in[i] = (const float*)d_in[i];
    a.out = (float*)d_out; a.ws = (unsigned char*)d_ws;
#if MK_N_LAUNCHES == 1
    a.ph_lo = 0; a.ph_hi = NPHASE;
    void* args[] = {&a};
    hipError_t e = hipLaunchCooperativeKernel((const void*)yoco_fwd, dim3(grid), dim3(NWAVES * 64), args, LDS_BYTES, stream);
    if (e != hipSuccess) fprintf(stderr, "kernel_launch: cooperative launch failed: %s (grid %d)\n", hipGetErrorString(e), grid);
#else
    for (int p = 0; p < NPHASE; ++p) { a.ph_lo = p; a.ph_hi = p + 1; hipLaunchKernelGGL(yoco_fwd, dim3(grid), dim3(NWAVES * 64), LDS_BYTES, stream, a); }
#endif
}
```

```cpp
#include <hip/hip_runtime.h>
#include <hip/hip_cooperative_groups.h>
#include <cstdio>
#include <cstdint>
namespace cg = cooperative_groups;
namespace pg8 {
#define PG8_LAS __attribute__((address_space(3)))
typedef unsigned short bf16_t;
typedef short bf16x8 __attribute__((ext_vector_type(8)));
typedef float f32x4 __attribute__((ext_vector_type(4)));
typedef unsigned u32x4 __attribute__((ext_vector_type(4)));
constexpr int BM = 256, BK = 64, HALF = 128, HTB = HALF * BK * 2  , STAGE_BYTES = 8 * HTB, NXCD = 8, WGM = 8;

__host__ __device__ __forceinline__ int lds_byte(int r, int c) { const int st = (r >> 4) * 2 + (c >> 5), rr = r & 15, cc = c & 31, ob = rr * 64 + cc * 2; return st * 1024 + (ob ^ (((ob >> 9) & 1) << 5)); }
__host__ __device__ __forceinline__ void stage_rc(int b, int& R, int& C) { const int st = b / 1024, sb = b % 1024, swz = sb ^ (((sb >> 9) & 1) << 5); R = (st >> 1) * 16 + swz / 64; C = (st & 1) * 32 + (swz % 64) / 2; }
__host__ __device__ __forceinline__ int perm32(int rho) { const int n = rho >> 4, i = rho & 15; return 8 * (i >> 2) + 4 * n + (i & 3); }

struct Unit { int pm, pn; };
struct Gemm { const bf16_t* A; const bf16_t* Bt; int M, N, K; };

struct StaticOrder {
    int nM, nN, nwg, G, c;
    __host__ __device__ void init(int M, int N, int G_, int c_) { nM = M / BM; nN = N / BM; nwg = nM * nN; G = G_; c = c_; }
    __host__ __device__ bool next(int i, Unit& u) const {
        const long L = (long)i * G + c; if (L >= nwg) return false;
        int wgid = (int)L; { const int q = nwg / NXCD, r = nwg % NXCD, xcd = wgid % NXCD, off = wgid / NXCD; wgid = (xcd < r ? xcd * (q + 1) : r * (q + 1) + (xcd - r) * q) + off; }
        const int nig = WGM * nN, gid = wgid / nig, fm = gid * WGM, gsz = (nM - fm) < WGM ? (nM - fm) : WGM;
        u.pm = fm + ((wgid % nig) % gsz); u.pn = (wgid % nig) / gsz; return true;
    }
    __device__ __forceinline__ void a_ready(const Unit&) const {}
    __device__ __forceinline__ void done(const Unit&) const {}
};
__device__ __forceinline__ unsigned cvt_pk_bf16(float lo, float hi) { unsigned r; asm volatile("v_cvt_pk_bf16_f32 %0, %1, %2" : "=v"(r) : "v"(lo), "v"(hi)); return r; }
typedef float f32x2 __attribute__((ext_vector_type(2)));
template <class Epi, class Sched, bool ALIGN_EPI = false, bool SP2 = false>
__device__ __forceinline__ void gemm_phase(PG8_LAS unsigned char* lds, const Gemm g, const Sched& S, const Epi& E) {
    const int tid = threadIdx.x, wid = __builtin_amdgcn_readfirstlane(tid >> 6), lane = tid & 63, wr = wid >> 2, wc = wid & 3, fr = lane & 15, fq = lane >> 4;
    const int K = g.K, nt = K / BK;
    unsigned voffA[2], voffB[2];
#pragma unroll
    for (int i = 0; i < 2; ++i) { int R, C; stage_rc(tid * 16 + i * 8192, R, C); const int Rb = Epi::PERM ? ((R & ~31) + perm32(R & 31)) : R;
        voffA[i] = (unsigned)(R * K + C) * 2u; voffB[i] = (unsigned)(Rb * K + C) * 2u; }
    const size_t kstep = (size_t)(BK * 2);
    const size_t hstep = (size_t)HALF * K * 2;
    const size_t tstep = 2 * hstep;
    const unsigned ldsw = (unsigned)wid * 1024u;
    const int aoff = lds_byte(wr * 64 + fr, fq * 8), boff = lds_byte(wc * 32 + fr, fq * 8);
#define PG8_SA(b, h) (((b) * 2 + (h)) * HTB)
#define PG8_SB(b, h) ((4 + (b) * 2 + (h)) * HTB)
#define PG8_STAGE(bufoff, gbase, voff) do { _Pragma("unroll") for (int _i = 0; _i < 2; ++_i) \
        __builtin_amdgcn_global_load_lds((const unsigned*)((const char*)(gbase) + (voff)[_i]), (PG8_LAS unsigned*)(lds + (bufoff) + ldsw + _i * 8192), 16, 0, 0); } while (0)
#define PG8_LDA(dst, b, h) do { _Pragma("unroll") for (int m = 0; m < 4; ++m) _Pragma("unroll") for (int k = 0; k < 2; ++k) dst[m][k] = *(const PG8_LAS bf16x8*)(lds + PG8_SA(b, h) + aoff + m * 2048 + k * 1024); } while (0)
#define PG8_LDB(dst, b, h) do { _Pragma("unroll") for (int n = 0; n < 2; ++n) _Pragma("unroll") for (int k = 0; k < 2; ++k) dst[n][k] = *(const PG8_LAS bf16x8*)(lds + PG8_SB(b, h) + boff + n * 2048 + k * 1024); } while (0)
#define PG8_MMA(ai, bj, At, Bt) do { __builtin_amdgcn_s_setprio(1); _Pragma("unroll") for (int m = 0; m < 4; ++m) _Pragma("unroll") for (int n = 0; n < 2; ++n) _Pragma("unroll") for (int k = 0; k < 2; ++k) \
        acc[ai][bj][m][n] = __builtin_amdgcn_mfma_f32_16x16x32_bf16(Bt[n][k], At[m][k], acc[ai][bj][m][n], 0, 0, 0); __builtin_amdgcn_s_setprio(0); } while (0)
#define PG8_WAIT_V(n) asm volatile("s_waitcnt vmcnt(" #n ")" ::: "memory")
#define PG8_WAIT_L(n) asm volatile("s_waitcnt lgkmcnt(" #n ")" ::: "memory")
#define PG8_BAR __builtin_amdgcn_s_barrier()
#define PG8_SCHED __builtin_amdgcn_sched_barrier(0)
    Unit cur, nxt; int ui = 0;
    if (!S.next(0, cur)) return;
    f32x4 acc[2][2][4][2];
#pragma unroll
    for (int a = 0; a < 2; ++a)
#pragma unroll
        for (int b = 0; b < 2; ++b)
#pragma unroll
            for (int m = 0; m < 4; ++m)
#pragma unroll
                for (int n = 0; n < 2; ++n) acc[a][b][m][n] = (f32x4){0.f, 0.f, 0.f, 0.f};
    bf16x8 At[4][2], B0[2][2], B1[2][2];
    const char* cA = (const char*)g.A + (size_t)cur.pm * tstep; const char* cB = (const char*)g.Bt + (size_t)cur.pn * tstep;
    S.a_ready(cur);
    if constexpr (SP2) {
        PG8_STAGE(PG8_SB(0, 0), cB, voffB); PG8_STAGE(PG8_SB(0, 1), cB + hstep, voffB); PG8_STAGE(PG8_SA(0, 0), cA, voffA); PG8_STAGE(PG8_SA(0, 1), cA + hstep, voffA);
        if (wr == 1) PG8_BAR;
        PG8_WAIT_V(2); PG8_BAR;
        PG8_STAGE(PG8_SB(1, 0), cB + kstep, voffB); PG8_STAGE(PG8_SA(1, 0), cA + kstep, voffA); PG8_STAGE(PG8_SB(1, 1), cB + hstep + kstep, voffB);
        PG8_WAIT_V(6); PG8_BAR;
    } else {
        PG8_STAGE(PG8_SB(0, 0), cB, voffB); PG8_STAGE(PG8_SA(0, 0), cA, voffA); PG8_STAGE(PG8_SB(0, 1), cB + hstep, voffB); PG8_STAGE(PG8_SA(0, 1), cA + hstep, voffA);
        if (wr == 1) PG8_BAR;
        PG8_WAIT_V(4); PG8_BAR;
        PG8_STAGE(PG8_SB(1, 0), cB + kstep, voffB); PG8_STAGE(PG8_SA(1, 0), cA + kstep, voffA); PG8_STAGE(PG8_SB(1, 1), cB + hstep + kstep, voffB);
        PG8_WAIT_V(6); PG8_BAR;
    }
    for (;;) {
        const bool has_next = S.next(ui + 1, nxt);
        const char* nA = has_next ? (const char*)g.A + (size_t)nxt.pm * tstep : cA; const char* nB = has_next ? (const char*)g.Bt + (size_t)nxt.pn * tstep : cB;
        for (int t = 0; t < nt; t += 2) {
            const bool last = (t == nt - 2);
            const char* a1 = cA + (size_t)(t + 1) * kstep;
            const char* a2 = last ? nA : cA + (size_t)(t + 2) * kstep; const char* b2 = last ? nB : cB + (size_t)(t + 2) * kstep;
            const char* a3 = a2 + kstep; const char* b3 = b2 + kstep;
            if (last && has_next) S.a_ready(nxt);
            if constexpr (SP2) {
            PG8_LDB(B0, 0, 0); PG8_LDB(B1, 0, 1); PG8_SCHED; PG8_LDA(At, 0, 0); PG8_STAGE(PG8_SA(1, 1), a1 + hstep, voffA);
            PG8_WAIT_V(8); PG8_WAIT_L(0); PG8_BAR; PG8_MMA(0, 0, At, B0); PG8_MMA(0, 1, At, B1); PG8_BAR; PG8_SCHED;
            PG8_LDA(At, 0, 1); PG8_STAGE(PG8_SB(0, 0), b2, voffB); PG8_STAGE(PG8_SB(0, 1), b2 + hstep, voffB); PG8_STAGE(PG8_SA(0, 0), a2, voffA);
            PG8_WAIT_V(8); PG8_WAIT_L(0); PG8_BAR; PG8_MMA(1, 0, At, B0); PG8_MMA(1, 1, At, B1); PG8_BAR; PG8_SCHED;
            PG8_LDB(B0, 1, 0); PG8_LDB(B1, 1, 1); PG8_SCHED; PG8_LDA(At, 1, 0); PG8_STAGE(PG8_SA(0, 1), a2 + hstep, voffA);
            PG8_WAIT_V(8); PG8_WAIT_L(0); PG8_BAR; PG8_MMA(0, 0, At, B0); PG8_MMA(0, 1, At, B1); PG8_BAR; PG8_SCHED;
            PG8_LDA(At, 1, 1); PG8_STAGE(PG8_SB(1, 0), b3, voffB); PG8_STAGE(PG8_SB(1, 1), b3 + hstep, voffB); PG8_STAGE(PG8_SA(1, 0), a3, voffA);
            PG8_WAIT_V(8); PG8_WAIT_L(0); PG8_BAR; PG8_MMA(1, 0, At, B0); PG8_MMA(1, 1, At, B1); PG8_BAR; PG8_SCHED;
            } else {
            PG8_LDB(B0, 0, 0); PG8_SCHED; PG8_LDA(At, 0, 0); PG8_STAGE(PG8_SA(1, 1), a1 + hstep, voffA);
            PG8_WAIT_L(8); PG8_BAR; PG8_WAIT_L(0); PG8_MMA(0, 0, At, B0); PG8_BAR; PG8_SCHED;
            PG8_LDB(B1, 0, 1); PG8_STAGE(PG8_SB(0, 0), b2, voffB);
            PG8_BAR; PG8_WAIT_L(0); PG8_MMA(0, 1, At, B1); PG8_BAR;
            PG8_LDA(At, 0, 1); PG8_STAGE(PG8_SA(0, 0), a2, voffA);
            PG8_BAR; PG8_WAIT_L(0); PG8_MMA(1, 0, At, B0); PG8_BAR; PG8_SCHED;
            PG8_STAGE(PG8_SB(0, 1), b2 + hstep, voffB);
            PG8_WAIT_V(6); PG8_BAR; PG8_MMA(1, 1, At, B1); PG8_BAR;
            PG8_LDB(B0, 1, 0); PG8_SCHED; PG8_LDA(At, 1, 0); PG8_STAGE(PG8_SA(0, 1), a2 + hstep, voffA);
            PG8_WAIT_L(8); PG8_BAR; PG8_WAIT_L(0); PG8_MMA(0, 0, At, B0); PG8_BAR; PG8_SCHED;
            PG8_LDB(B1, 1, 1); PG8_STAGE(PG8_SB(1, 0), b3, voffB);
            PG8_BAR; PG8_WAIT_L(0); PG8_MMA(0, 1, At, B1); PG8_BAR;
            PG8_LDA(At, 1, 1); PG8_STAGE(PG8_SA(1, 0), a3, voffA);
            PG8_BAR; PG8_WAIT_L(0); PG8_MMA(1, 0, At, B0); PG8_BAR; PG8_SCHED;
            PG8_STAGE(PG8_SB(1, 1), b3 + hstep, voffB);
            PG8_WAIT_V(6); PG8_BAR; PG8_MMA(1, 1, At, B1); PG8_BAR;
            }
        }
        if constexpr (ALIGN_EPI) { if (wr == 0) PG8_BAR; }
        if constexpr (!Epi::AFTER_DRAIN) { E(acc, cur, wr, wc, fr, fq); S.done(cur); }
        if (!has_next) break;
#pragma unroll
        for (int a = 0; a < 2; ++a)
#pragma unroll
            for (int b = 0; b < 2; ++b)
#pragma unroll
                for (int m = 0; m < 4; ++m)
#pragma unroll
                    for (int n = 0; n < 2; ++n) acc[a][b][m][n] = (f32x4){0.f, 0.f, 0.f, 0.f};
        cur = nxt; cA = nA; cB = nB; ++ui;
        if constexpr (ALIGN_EPI) { if (wr == 1) PG8_BAR; }
    }
    PG8_WAIT_V(0);
    if constexpr (!ALIGN_EPI) { if (wr == 0) PG8_BAR; }
    PG8_BAR;
    if constexpr (Epi::AFTER_DRAIN) { E.fused(acc, cur, wr, wc, fr, fq, lds, wid, lane); S.done(cur); }
#undef PG8_SA
#undef PG8_SB
#undef PG8_STAGE
#undef PG8_LDA
#undef PG8_LDB
#undef PG8_MMA
#undef PG8_WAIT_V
#undef PG8_WAIT_L
#undef PG8_BAR
#undef PG8_SCHED
}
}

typedef unsigned short bf16_t;
typedef short bf16x8 __attribute__((ext_vector_type(8)));
typedef short s16x4 __attribute__((ext_vector_type(4)));
typedef float f32x4 __attribute__((ext_vector_type(4)));
typedef float f32x16 __attribute__((ext_vector_type(16)));
typedef unsigned u32x4 __attribute__((ext_vector_type(4)));
typedef unsigned u32x2 __attribute__((ext_vector_type(2)));
#define LAS __attribute__((address_space(3)))

constexpr int DM = 1024, NP = 16384, NS = 256, MA = NP + NS;
constexpr int NA = 3072, NB = 2304;
constexpr int KSROWS = 4160, SWROWS = 192;
constexpr float DN_ALPHA = 1.41421356237309515f;
constexpr float LOG2E = 1.4426950408889634f;
constexpr float C64 = 0.125f * LOG2E, THR64 = 64.f;
constexpr float C128 = 0.088388347648318440f * LOG2E, THR128 = 90.5f;
constexpr size_t OFF_DKP = 17039360, OFF_DVP = 25427968, OFF_DKS = 33816576, OFF_DVS = 33947648, OFF_SKP = 34078720, OFF_SVP = 34144256,
                 OFF_SKS = 34209792, OFF_SVS = 34471936, OFF_MKP = 34734080, OFF_MVP = 35782656;
constexpr size_t MiB = 1u << 20;
constexpr size_t WS_CTL = 0, WS_ROPE = 1 * MiB, WS_WA = 2 * MiB, WS_WB = 8 * MiB, WS_WM = 13 * MiB, WS_WO = 17 * MiB, WS_MEMB = 21 * MiB, WS_MKV = 23 * MiB,
                 WS_CMK = 27 * MiB, WS_CMV = 35 * MiB, WS_KSW = 43 * MiB, WS_VSW = 44 * MiB, WS_XA = 46 * MiB, WS_MIX = 79 * MiB, WS_Z0 = 112 * MiB,
                 WS_PA = 177 * MiB, WS_KS = 275 * MiB, WS_VS = 340 * MiB, WS_END = 405 * MiB;
constexpr int LDS_RING = 131072, LDS_BYTES = LDS_RING + 256;

__device__ __forceinline__ unsigned cvtpk(float lo, float hi) { unsigned r; asm volatile("v_cvt_pk_bf16_f32 %0, %1, %2" : "=v"(r) : "v"(lo), "v"(hi)); return r; }
__device__ __forceinline__ float bflo(unsigned w) { return __uint_as_float(w << 16); }
__device__ __forceinline__ float bfhi(unsigned w) { return __uint_as_float(w & 0xffff0000u); }
__device__ __forceinline__ float silu(float x) { return x * __builtin_amdgcn_rcpf(1.f + __expf(-x)); }
__device__ __forceinline__ void cvt8(const float* s, bf16_t* d) {
    const f32x4 a = *(const f32x4*)s, b = *(const f32x4*)(s + 4);
    u32x4 w; w.x = cvtpk(a.x, a.y); w.y = cvtpk(a.z, a.w); w.z = cvtpk(b.x, b.y); w.w = cvtpk(b.z, b.w); *(u32x4*)d = w;
}

template <class F> struct EpiWrap {
    static constexpr bool PERM = false, AFTER_DRAIN = false;
    F f;
    __device__ __forceinline__ void operator()(const f32x4 (&acc)[2][2][4][2], const pg8::Unit& u, int wr, int wc, int fr, int fq) const {
#pragma unroll
        for (int ai = 0; ai < 2; ++ai)
#pragma unroll
            for (int m = 0; m < 4; ++m) { const int row = u.pm * 256 + ai * 128 + wr * 64 + m * 16 + fr;
#pragma unroll
                for (int bj = 0; bj < 2; ++bj)
#pragma unroll
                    for (int n = 0; n < 2; ++n) f(row, u.pn * 256 + bj * 128 + wc * 32 + n * 16 + 4 * fq, acc[ai][bj][m][n]); }
    }
};
__device__ __forceinline__ f32x4 rope4(f32x4 v, int col, int pos, const float* rope) {
    f32x4 p; p.x = __shfl_xor(v.x, 32); p.y = __shfl_xor(v.y, 32); p.z = __shfl_xor(v.z, 32); p.w = __shfl_xor(v.w, 32);
    const float* t = rope + ((size_t)pos * 8 + (col & 4)) * 2;
    const f32x4 t0 = *(const f32x4*)t, t1 = *(const f32x4*)(t + 4);
    const float sg = (col & 8) ? 1.f : -1.f;
    f32x4 o; o.x = v.x * t0.x + sg * p.x * t0.y; o.y = v.y * t0.z + sg * p.y * t0.w; o.z = v.z * t1.x + sg * p.z * t1.y; o.w = v.w * t1.z + sg * p.w * t1.w;
    return o;
}
__device__ __forceinline__ void st_bf4(bf16_t* p, f32x4 v) { u32x2 w; w.x = cvtpk(v.x, v.y); w.y = cvtpk(v.z, v.w); *(u32x2*)p = w; }

struct EpiAF {
    bf16_t* PA; float* dout; bf16_t* KS; bf16_t* VS; const float* rope;
    __device__ __forceinline__ void operator()(int row, int col, f32x4 v) const {
        const bool samp = row >= NP; const int rs = row - NP;
        const int pos = samp ? 4096 + (rs & 15) : (row & 4095);
        const int region = col >> 9;
        if (region < 2 && ((col >> 4) & 3) == 0) v = rope4(v, col, pos, rope);
        st_bf4(PA + (size_t)row * NA + col, v);
        if (region == 1 || region == 2) {
            const int c = col & 511;
            if (!samp) *(f32x4*)(dout + (region == 1 ? OFF_DKP : OFF_DVP) + (size_t)row * 512 + c) = v;
            else { *(f32x4*)(dout + (region == 1 ? OFF_DKS : OFF_DVS) + (size_t)rs * 512 + c) = v;
                   st_bf4((region == 1 ? KS : VS) + ((size_t)(rs >> 4) * KSROWS + 4096 + (rs & 15)) * 512 + c, v); }
        }
    }
};
struct EpiMemF {
    bf16_t* MKV; float* dout;
    __device__ __forceinline__ void operator()(int row, int col, f32x4 v) const {
        st_bf4(MKV + (size_t)row * 2048 + col, v);
        const int l = col >> 10, c = col & 1023;
        *(f32x4*)(dout + (c < 512 ? OFF_MKP : OFF_MVP) + (size_t)l * 524288 + (size_t)row * 512 + (c & 511)) = v;
    }
};
struct EpiMergeF {
    const float* base_p; const float* base_s; float* out;
    __device__ __forceinline__ void operator()(int row, int col, f32x4 v) const {
        const float* bp = row < NP ? base_p + (size_t)row * DM + col : base_s + (size_t)(row - NP) * DM + col;
        const f32x4 x = *(const f32x4*)bp;
        *(f32x4*)(out + (size_t)row * DM + col) = x * DN_ALPHA + v;
    }
};
struct EpiBF {
    bf16_t* PB; float* dout; bf16_t* KSW; bf16_t* VSW; const float* rope;
    __device__ __forceinline__ void operator()(int row, int col, f32x4 v) const {
        const bool samp = row >= NP; const int rs = row - NP;
        const int t = samp ? (rs & 15) : (row & 4095);
        const int pos = samp ? 4096 + t : t;
        const bool isk = col >= 2048 && col < 2176;
        if ((col < 512 || isk) && ((col >> 4) & 3) == 0) v = rope4(v, col, pos, rope);
        st_bf4(PB + (size_t)row * NB + col, v);
        if (col >= 2048) {
            const int cc = col & 127;
            if (!samp) { if (t >= 3968) *(f32x4*)(dout + (isk ? OFF_SKP : OFF_SVP) + ((size_t)(row >> 12) * 128 + (t - 3968)) * 128 + cc) = v; }
            else { const int b = rs >> 4;
                   *(f32x4*)(dout + (isk ? OFF_SKS : OFF_SVS) + ((size_t)b * 128 + 112 + t) * 128 + cc) = v;
                   st_bf4((isk ? KSW : VSW) + ((size_t)b * SWROWS + 128 + t) * 128 + cc, v); }
        }
    }
};

namespace att {
constexpr int SHM_V = 16384, SHM_K = 16384;
#define KSWZ(row, colB) ((row) * 256 + ((colB) ^ (((row) & 7) << 4)))
#define SBAR() __builtin_amdgcn_sched_barrier(0)
__device__ __forceinline__ int v_st(int k, int c) { const int kk = (k & ~0xC) | ((k & 4) << 1) | ((k & 8) >> 1); return ((kk >> 3) * 4 + (c >> 5)) * 512 + ((kk & 7) * 32 + (c & 31)) * 2; }
__device__ __forceinline__ int v_rd_base(int lane) { return ((lane & 3) << 3) | (((lane >> 2) & 3) << 6) | (((lane >> 4) & 1) << 5) | (((lane >> 5) & 1) << 8); }
constexpr int v_rd_off(int d0, int ks, int half) { return d0 * 512 + ks * 4096 + half * 2048; }
template <int OFF> __device__ __forceinline__ s16x4 tr_read(int vb) {
    s16x4 r; asm volatile("ds_read_b64_tr_b16 %0, %1 offset:%2" : "=&v"(r) : "v"(vb), "i"(OFF) : "memory"); return r;
}
template <int D0> __device__ __forceinline__ void pv_one(f32x16& od, int vb, bf16x8 pa0, bf16x8 pa1, bf16x8 pa2, bf16x8 pa3) {
    const s16x4 l0 = tr_read<v_rd_off(D0, 0, 0)>(vb), h0 = tr_read<v_rd_off(D0, 0, 1)>(vb), l1 = tr_read<v_rd_off(D0, 1, 0)>(vb), h1 = tr_read<v_rd_off(D0, 1, 1)>(vb);
    const s16x4 l2 = tr_read<v_rd_off(D0, 2, 0)>(vb), h2 = tr_read<v_rd_off(D0, 2, 1)>(vb), l3 = tr_read<v_rd_off(D0, 3, 0)>(vb), h3 = tr_read<v_rd_off(D0, 3, 1)>(vb);
    asm volatile("s_waitcnt lgkmcnt(0)" ::: "memory"); SBAR();
#define PK(L, H) (bf16x8){L[0], L[1], L[2], L[3], H[0], H[1], H[2], H[3]}
    od = __builtin_amdgcn_mfma_f32_32x32x16_bf16(PK(l0, h0), pa0, od, 0, 0, 0);
    od = __builtin_amdgcn_mfma_f32_32x32x16_bf16(PK(l1, h1), pa1, od, 0, 0, 0);
    od = __builtin_amdgcn_mfma_f32_32x32x16_bf16(PK(l2, h2), pa2, od, 0, 0, 0);
    od = __builtin_amdgcn_mfma_f32_32x32x16_bf16(PK(l3, h3), pa3, od, 0, 0, 0);
#undef PK
}
__device__ __forceinline__ void partialSM(f32x16& p0, f32x16& p1, float& m_reg, float& alpha, float C, float thr) {
    float pmax = p0[0];
#pragma unroll
    for (int r = 1; r < 16; ++r) pmax = fmaxf(pmax, p0[r]);
#pragma unroll
    for (int r = 0; r < 16; ++r) pmax = fmaxf(pmax, p1[r]);
    { auto rr = __builtin_amdgcn_permlane32_swap(__float_as_uint(pmax), __float_as_uint(pmax), false, false);
      pmax = fmaxf(__uint_as_float(rr[0]), __uint_as_float(rr[1])); }
    float mn;
    if (__all(pmax - m_reg <= thr)) { mn = m_reg; alpha = 1.f; }
    else { mn = fmaxf(m_reg, pmax); alpha = __builtin_amdgcn_exp2f((m_reg - mn) * C); m_reg = mn; }
    const float mnC = -mn * C;
#pragma unroll
    for (int r = 0; r < 16; ++r) p0[r] = __builtin_amdgcn_exp2f(fmaf(p0[r], C, mnC));
#pragma unroll
    for (int r = 0; r < 16; ++r) p1[r] = __builtin_amdgcn_exp2f(fmaf(p1[r], C, mnC));
}
__device__ __forceinline__ void finishSM(f32x16& p0, f32x16& p1, float alpha, float& l_reg, bf16x8& pa0, bf16x8& pa1, bf16x8& pa2, bf16x8& pa3) {
    float ps = 0;
#pragma unroll
    for (int r = 0; r < 16; ++r) ps += p0[r];
#pragma unroll
    for (int r = 0; r < 16; ++r) ps += p1[r];
    { auto rr = __builtin_amdgcn_permlane32_swap(__float_as_uint(ps), __float_as_uint(ps), false, false);
      ps = __uint_as_float(rr[0]) + __uint_as_float(rr[1]); }
    l_reg = l_reg * alpha + ps;
#define PK4(P, BASE, OUT) do { unsigned a0 = cvtpk(P[BASE + 0], P[BASE + 1]), a1 = cvtpk(P[BASE + 2], P[BASE + 3]);   \
    unsigned b0 = cvtpk(P[BASE + 4], P[BASE + 5]), b1 = cvtpk(P[BASE + 6], P[BASE + 7]);                              \
    auto r0 = __builtin_amdgcn_permlane32_swap(a0, b0, false, false); auto r1 = __builtin_amdgcn_permlane32_swap(a1, b1, false, false); \
    u32x4 w = {r0[0], r1[0], r0[1], r1[1]}; OUT = *reinterpret_cast<bf16x8*>(&w); } while (0)
    PK4(p0, 0, pa0); PK4(p0, 8, pa1); PK4(p1, 0, pa2); PK4(p1, 8, pa3);
#undef PK4
}
template <int QS, bool PVHALF>
__device__ __forceinline__ void attn_core(LAS unsigned char* lds, const bf16_t* Kb, long ldk, const bf16_t* Vb, long ldv, int NT, int nkeys,
                                          const bf16_t* qptr, int wNT, int kcoffB, int pvsel, float C, float thr, f32x16 (&o)[4], float& m_reg, float& l_reg) {
    const int tid = threadIdx.x, lane = tid & 63, r32 = lane & 31, hi = lane >> 5;
    LAS unsigned char* V_lds = lds; LAS unsigned char* K_lds = lds + 2 * SHM_V;
    bf16x8 qr[QS];
#pragma unroll
    for (int d0 = 0; d0 < QS; ++d0) qr[d0] = *(const bf16x8*)(qptr + d0 * 16);
#pragma unroll
    for (int d = 0; d < 4; ++d) o[d] = f32x16{};
    m_reg = -1e30f; l_reg = 0.f;
    const int sr = tid >> 4, sc = (tid & 15) * 8;
    const int vst0 = v_st(sr, sc), vst1 = v_st(32 + sr, sc), kst0 = KSWZ(sr, sc * 2), kst1 = KSWZ(32 + sr, sc * 2);
    const int vb0 = (int)(uintptr_t)V_lds + v_rd_base(lane);
    const bf16_t* kg = Kb + (long)sr * ldk + sc; const bf16_t* vg = Vb + (long)sr * ldv + sc;
    bf16x8 sk0, sk1, sv0, sv1;
#define SLOAD(t) do { const bf16_t* kp_ = kg + (long)(t) * 64 * ldk; const bf16_t* vp_ = vg + (long)(t) * 64 * ldv; \
    sk0 = *(const bf16x8*)kp_; sk1 = *(const bf16x8*)(kp_ + 32 * ldk); sv0 = *(const bf16x8*)vp_; sv1 = *(const bf16x8*)(vp_ + 32 * ldv); } while (0)
#define SWRITE(bf) do { *(LAS bf16x8*)(V_lds + (bf) * SHM_V + vst0) = sv0; *(LAS bf16x8*)(V_lds + (bf) * SHM_V + vst1) = sv1; \
    *(LAS bf16x8*)(K_lds + (bf) * SHM_K + kst0) = sk0; *(LAS bf16x8*)(K_lds + (bf) * SHM_K + kst1) = sk1; } while (0)
    SLOAD(0); SWRITE(0); __syncthreads();
    for (int j = 0; j < NT; ++j) {
        const int cur = j & 1;
        if (j + 1 < NT) SLOAD(j + 1);
        if (j < wNT) {
            f32x16 p0 = f32x16{}, p1 = f32x16{};
            const LAS unsigned char* Ks = K_lds + cur * SHM_K;
#pragma unroll
            for (int d0 = 0; d0 < QS; ++d0) { const int cb = kcoffB + (d0 * 16 + hi * 8) * 2;
                const bf16x8 b0 = *(const LAS bf16x8*)(Ks + KSWZ(r32, cb));
                const bf16x8 b1 = *(const LAS bf16x8*)(Ks + KSWZ(32 + r32, cb));
                p0 = __builtin_amdgcn_mfma_f32_32x32x16_bf16(b0, qr[d0], p0, 0, 0, 0);
                p1 = __builtin_amdgcn_mfma_f32_32x32x16_bf16(b1, qr[d0], p1, 0, 0, 0); }
            if ((j + 1) * 64 > nkeys) { const int kb = j * 64 + 4 * hi;
#pragma unroll
                for (int r = 0; r < 16; ++r) { const int kv = kb + (r & 3) + 8 * (r >> 2); if (kv >= nkeys) p0[r] = -1e30f; if (kv + 32 >= nkeys) p1[r] = -1e30f; } }
            float alpha; bf16x8 pa0, pa1, pa2, pa3;
            partialSM(p0, p1, m_reg, alpha, C, thr);
            finishSM(p0, p1, alpha, l_reg, pa0, pa1, pa2, pa3);
            if (__any(alpha < 1.f)) {
#pragma unroll
                for (int d = 0; d < (PVHALF ? 2 : 4); ++d)
#pragma unroll
                    for (int r = 0; r < 16; ++r) o[d][r] *= alpha; }
            const int vb = vb0 + cur * SHM_V;
            if constexpr (!PVHALF) { pv_one<0>(o[0], vb, pa0, pa1, pa2, pa3); pv_one<1>(o[1], vb, pa0, pa1, pa2, pa3); pv_one<2>(o[2], vb, pa0, pa1, pa2, pa3); pv_one<3>(o[3], vb, pa0, pa1, pa2, pa3); }
            else { if (pvsel == 0) { pv_one<0>(o[0], vb, pa0, pa1, pa2, pa3); pv_one<1>(o[1], vb, pa0, pa1, pa2, pa3); }
                   else { pv_one<2>(o[0], vb, pa0, pa1, pa2, pa3); pv_one<3>(o[1], vb, pa0, pa1, pa2, pa3); } }
        }
        if (j + 1 < NT) SWRITE(cur ^ 1);
        __syncthreads();
    }
#undef SLOAD
#undef SWRITE
}

struct Ctx { LAS unsigned char* lds; int lane, wid, r32, hi; };

template <int ND> __device__ __forceinline__ void store_gated(const f32x16 (&o)[4], float scale, const bf16_t* gate, bf16_t* out, int hi) {
#pragma unroll
    for (int d = 0; d < ND; ++d)
#pragma unroll
        for (int g = 0; g < 4; ++g) { const int dv = 32 * d + 8 * g + 4 * hi;
            const u32x2 gt = *(const u32x2*)(gate + dv);
            f32x4 v; v.x = o[d][4 * g] * scale * silu(bflo(gt.x)); v.y = o[d][4 * g + 1] * scale * silu(bfhi(gt.x));
            v.z = o[d][4 * g + 2] * scale * silu(bflo(gt.y)); v.w = o[d][4 * g + 3] * scale * silu(bfhi(gt.y));
            st_bf4(out + dv, v); }
}

__device__ __forceinline__ void diff_unit(const Ctx& cx, bool samp, int b, int h, int qb, const bf16_t* PA, const bf16_t* KS, const bf16_t* VS, bf16_t* MIX, const float* gnorm, float lam) {
    const int c = cx.wid >> 2, rb = cx.wid & 3;
    long row; bool valid; int NT, wNT, nkeys; const bf16_t* Kb; const bf16_t* Vb; long ldk;
    if (!samp) { row = (long)b * 4096 + qb * 128 + rb * 32 + cx.r32; valid = true; NT = 2 * qb + 2; wNT = 2 * qb + 1 + (rb >> 1); nkeys = NT * 64;
                 Kb = PA + (size_t)b * 4096 * NA + 512 + h * 128; Vb = Kb + 512; ldk = NA; }
    else { row = NP + b * 16 + (cx.r32 < 15 ? cx.r32 : 15); valid = (rb == 0) && cx.r32 < 16; NT = 65; wNT = (rb == 0) ? 65 : 0; nkeys = 4112;
           Kb = KS + (size_t)b * KSROWS * 512 + h * 128; Vb = VS + (size_t)b * KSROWS * 512 + h * 128; ldk = 512; }
    const bf16_t* qptr = PA + (size_t)row * NA + h * 128 + c * 64 + cx.hi * 8;
    f32x16 o[4]; float m, l;
    attn_core<4, false>(cx.lds, Kb, ldk, Vb, ldk, NT, nkeys, qptr, wNT, c * 128, 0, C64, THR64, o, m, l);
    const float inv = l > 0.f ? 1.f / l : 0.f;
    LAS float* xch = (LAS float*)cx.lds + rb * 4096;
    if (c == 1) {
#pragma unroll
        for (int d = 0; d < 4; ++d)
#pragma unroll
            for (int r = 0; r < 16; ++r) xch[(d * 16 + r) * 64 + cx.lane] = o[d][r] * inv; }
    __syncthreads();
    if (c == 0) {
        float ss = 0.f;
#pragma unroll
        for (int d = 0; d < 4; ++d)
#pragma unroll
            for (int r = 0; r < 16; ++r) { const float od = o[d][r] * inv - lam * xch[(d * 16 + r) * 64 + cx.lane]; o[d][r] = od; ss += od * od; }
        ss += __shfl_xor(ss, 32);
        const float rms = rsqrtf(ss * (1.f / 128.f) + 1e-5f) * 0.8f;
        if (valid) {
            const bf16_t* gate = PA + (size_t)row * NA + 1536 + h * 128; bf16_t* out = MIX + (size_t)row * DM + h * 128;
#pragma unroll
            for (int d = 0; d < 4; ++d)
#pragma unroll
                for (int g = 0; g < 4; ++g) { const int dv = 32 * d + 8 * g + 4 * cx.hi;
                    const f32x4 gn = *(const f32x4*)(gnorm + dv); const u32x2 gt = *(const u32x2*)(gate + dv);
                    f32x4 v; v.x = o[d][4 * g] * rms * gn.x * silu(bflo(gt.x)); v.y = o[d][4 * g + 1] * rms * gn.y * silu(bfhi(gt.x));
                    v.z = o[d][4 * g + 2] * rms * gn.z * silu(bflo(gt.y)); v.w = o[d][4 * g + 3] * rms * gn.w * silu(bfhi(gt.y));
                    st_bf4(out + dv, v); }
        }
    }
    __syncthreads();
}
__device__ __forceinline__ void mem_unit(const Ctx& cx, bool samp, int b, int h, int qb, const bf16_t* P, int ldp, int qcol, int gcol,
                                         const bf16_t* Kb, const bf16_t* Vb, long ldk, bf16_t* MIX) {
    long row; bool valid; int wNT;
    if (!samp) { row = (long)b * 4096 + qb * 256 + cx.wid * 32 + cx.r32; valid = true; wNT = 4; }
    else { row = NP + b * 16 + (cx.r32 < 15 ? cx.r32 : 15); valid = (cx.wid == 0) && cx.r32 < 16; wNT = (cx.wid == 0) ? 4 : 0; }
    const bf16_t* qptr = P + (size_t)row * ldp + qcol + h * 128 + cx.hi * 8;
    f32x16 o[4]; float m, l;
    attn_core<8, false>(cx.lds, Kb, ldk, Vb, ldk, 4, 256, qptr, wNT, 0, 0, C128, THR128, o, m, l);
    const float inv = l > 0.f ? 1.f / l : 0.f;
    if (valid) store_gated<4>(o, inv, P + (size_t)row * ldp + gcol + h * 128, MIX + (size_t)row * DM + 512 + h * 128, cx.hi);
}
__device__ __forceinline__ void swa_unit(const Ctx& cx, bool samp, int b, int c, int half, const bf16_t* PB, const bf16_t* KSW, const bf16_t* VSW, bf16_t* MIX, const float* sinks) {
    const int head = cx.wid, kv = cx.wid >> 2;
    long row; bool valid; int NT, nkeys; const bf16_t* Kb; const bf16_t* Vb; long ldk;
    if (!samp) { row = (long)b * 4096 + c * 64 + half * 32 + cx.r32; valid = true; const int c0 = c > 2 ? c - 2 : 0; NT = c - c0 + 1; nkeys = NT * 64;
                 Kb = PB + ((size_t)b * 4096 + c0 * 64) * NB + 2048; Vb = Kb + 128; ldk = NB; }
    else { row = NP + b * 16 + (cx.r32 < 15 ? cx.r32 : 15); valid = cx.r32 < 16; NT = 3; nkeys = 144;
           Kb = KSW + (size_t)b * SWROWS * 128; Vb = VSW + (size_t)b * SWROWS * 128; ldk = 128; }
    const bf16_t* qptr = PB + (size_t)row * NB + head * 64 + cx.hi * 8;
    f32x16 o[4]; float m, l;
    attn_core<4, true>(cx.lds, Kb, ldk, Vb, ldk, NT, nkeys, qptr, NT, kv * 128, kv, C64, THR64, o, m, l);
    const float lt = l + __builtin_amdgcn_exp2f(sinks[head] * LOG2E - m * C64);
    const float inv = 1.f / lt;
    if (valid) store_gated<2>(o, inv, PB + (size_t)row * NB + 512 + head * 64, MIX + (size_t)row * DM + head * 64, cx.hi);
}
#undef KSWZ
#undef SBAR
}

__device__ __forceinline__ float wave_sum(float v) {
#pragma unroll
    for (int o = 1; o < 64; o <<= 1) v += __shfl_xor(v, o);
    return v;
}
__device__ __forceinline__ void p0_transpose_item(const float* W, int K, int N, bf16_t* WT, int row_off, LAS float* scr, int item, int lane) {
    const int nblk = N / 32, kb = item / nblk, nb = item % nblk, k0 = 64 * kb, n0 = 32 * nb;
#pragma unroll 8
    for (int i = 0; i < 32; ++i) { const int kk = 2 * i + (lane >> 5); scr[kk * 33 + (lane & 31)] = W[(size_t)(k0 + kk) * N + n0 + (lane & 31)]; }
    asm volatile("s_waitcnt lgkmcnt(0)" ::: "memory");
    const int c = lane & 7;
#pragma unroll
    for (int j = 0; j < 4; ++j) { const int n = (lane >> 3) + 8 * j; const LAS float* s = scr + (8 * c) * 33 + n;
        u32x4 o; o.x = cvtpk(s[0 * 33], s[1 * 33]); o.y = cvtpk(s[2 * 33], s[3 * 33]); o.z = cvtpk(s[4 * 33], s[5 * 33]); o.w = cvtpk(s[6 * 33], s[7 * 33]);
        *(u32x4*)(WT + (size_t)(row_off + n0 + n) * K + k0 + 8 * c) = o; }
    asm volatile("s_waitcnt lgkmcnt(0)" ::: "memory");
}
__device__ __forceinline__ void ln_rows(const float* zin, float* fout, bf16_t* bout, const float* g, const float* bta, int gw, int NGW, int lane) {
    f32x4 g4[4], b4[4];
#pragma unroll
    for (int j = 0; j < 4; ++j) { g4[j] = *(const f32x4*)(g + 4 * lane + 256 * j); b4[j] = *(const f32x4*)(bta + 4 * lane + 256 * j); }
    for (int m = gw; m < MA; m += NGW) {
        const float* zr = zin + (size_t)m * DM + 4 * lane;
        f32x4 v[4]; float s = 0.f;
#pragma unroll
        for (int j = 0; j < 4; ++j) { v[j] = *(const f32x4*)(zr + 256 * j); s += (v[j].x + v[j].y) + (v[j].z + v[j].w); }
        const float mean = wave_sum(s) * (1.f / DM); float s2 = 0.f;
#pragma unroll
        for (int j = 0; j < 4; ++j) { v[j] = v[j] - mean; s2 += (v[j].x * v[j].x + v[j].y * v[j].y) + (v[j].z * v[j].z + v[j].w * v[j].w); }
        const float rstd = rsqrtf(wave_sum(s2) * (1.f / DM) + 1e-5f);
#pragma unroll
        for (int j = 0; j < 4; ++j) { const f32x4 y = v[j] * rstd * g4[j] + b4[j];
            *(f32x4*)(fout + (size_t)m * DM + 4 * lane + 256 * j) = y;
            if (bout) st_bf4(bout + (size_t)m * DM + 4 * lane + 256 * j, y); }
    }
}

#define XB_TMO      128
#define XB_XCNT(j)  (256  + 64 * (j))
#define XB_XSUB(j)  (1280 + 64 * (j))
#define XB_XGEN(j)  (2304 + 64 * (j))
#define XB_TOP      3328
#define XB_TOPGEN   3392
#define XCD_BAR_WORDS 3456
#define XB_SPIN_CAP (1u << 18)

__device__ __forceinline__ unsigned xb_ld(unsigned* p)              { return __hip_atomic_load(p, __ATOMIC_RELAXED, __HIP_MEMORY_SCOPE_AGENT); }
__device__ __forceinline__ unsigned xb_add(unsigned* p, unsigned v) { return __hip_atomic_fetch_add(p, v, __ATOMIC_RELAXED, __HIP_MEMORY_SCOPE_AGENT); }
__device__ __forceinline__ unsigned xb_xcc_id() { return (unsigned)__builtin_amdgcn_s_getreg((3 << 11) | 20) & 0xFu; }
#define XB_SPIN(cond, bar) do { unsigned _sp = 0; while (cond) { __builtin_amdgcn_s_sleep(1); \
    if ((++_sp & 255u) == 0u) { if (xb_ld(&(bar)[XB_TMO])) break; if (_sp > XB_SPIN_CAP) { atomicAdd(&(bar)[XB_TMO], 1u); break; } } } } while (0)

struct XcdBarrier {
    unsigned* bar; unsigned x;
    volatile LAS unsigned* st;
};

__device__ __forceinline__ XcdBarrier xcd_barrier_post(unsigned* bar, volatile LAS unsigned* st) {
    XcdBarrier b; b.bar = bar; b.x = xb_xcc_id(); b.st = st;
    if (threadIdx.x == 0) (void)xb_add(&bar[XB_XCNT(b.x)], 1u);
    return b;
}
__device__ __forceinline__ void xcd_barrier_complete(unsigned* bar, unsigned x, unsigned& nloc, unsigned& nx) {
    const unsigned G = gridDim.x * gridDim.y * gridDim.z;
    unsigned sum, cnt, mine, sp = 0u;
    for (;;) {
        sum = 0u; cnt = 0u; mine = 0u;
#pragma unroll
        for (unsigned j = 0; j < 16; ++j) { const unsigned c = xb_ld(&bar[XB_XCNT(j)]); sum += c; cnt += (c > 0u) ? 1u : 0u; mine = (j == x) ? c : mine; }
        if (sum == G) break;
        __builtin_amdgcn_s_sleep(1);
        if ((++sp & 255u) == 0u) { if (xb_ld(&bar[XB_TMO])) break; if (sp > XB_SPIN_CAP) { atomicAdd(&bar[XB_TMO], 1u); break; } }
    }
    nloc = mine > 0u ? mine : 1u; nx = cnt > 0u ? cnt : 1u;
}

__device__ __forceinline__ void xcd_barrier(const XcdBarrier& b) {
    asm volatile("s_waitcnt vmcnt(0)" ::: "memory");
    __syncthreads();
    if (threadIdx.x == 0) {
        unsigned* bar = b.bar;
        __builtin_amdgcn_s_waitcnt(0);
        unsigned nloc = b.st[0], nx = b.st[1];
        if (nloc == 0u) { xcd_barrier_complete(bar, b.x, nloc, nx); b.st[0] = nloc; b.st[1] = nx; }
        const unsigned old = xb_add(&bar[XB_XSUB(b.x)], 1u);
        const unsigned gen = old / nloc;
        if (old + 1u == (gen + 1u) * nloc) {
            __builtin_amdgcn_fence(__ATOMIC_RELEASE, "agent");
            asm volatile("s_waitcnt vmcnt(0)" ::: "memory");
            const unsigned og = xb_add(&bar[XB_TOP], 1u);
            const unsigned tg = og / nx;
            if (og + 1u == (tg + 1u) * nx) xb_add(&bar[XB_TOPGEN], 1u);
            else XB_SPIN(xb_ld(&bar[XB_TOPGEN]) == tg, bar);
            __builtin_amdgcn_fence(__ATOMIC_ACQUIRE, "agent");
            xb_add(&bar[XB_XGEN(b.x)], 1u);
            asm volatile("s_waitcnt vmcnt(0)" ::: "memory");
        } else {
            XB_SPIN(xb_ld(&bar[XB_XGEN(b.x)]) == gen, bar);
            __builtin_amdgcn_fence(__ATOMIC_ACQUIRE, "agent");
            asm volatile("s_waitcnt vmcnt(0)" ::: "memory");
        }
    }
    __syncthreads();
}

struct Args { const float* in[22]; float* out; unsigned char* ws; int ph_lo, ph_hi, rep, pad; };
constexpr int NWAVES = 8, NPHASE = 9;

__global__ void __launch_bounds__(NWAVES * 64, 2) yoco_fwd(Args a) {
    extern __shared__ __attribute__((aligned(16))) unsigned char lds_raw[];
    LAS unsigned char* lds = (LAS unsigned char*)lds_raw;
    volatile LAS unsigned* MISC = (volatile LAS unsigned*)(lds + LDS_RING);
    cg::grid_group grid = cg::this_grid();
    const int tid = threadIdx.x, lane = tid & 63, wave = __builtin_amdgcn_readfirstlane(tid >> 6);
    const int G = gridDim.x, gw = blockIdx.x * NWAVES + wave, NGW = G * NWAVES;
    const long gtid = (long)blockIdx.x * (NWAVES * 64) + tid, NTHR = (long)G * (NWAVES * 64);
    unsigned char* ws = a.ws; float* dout = a.out;
    unsigned* ctl = (unsigned*)(ws + WS_CTL);
    float* ROPE = (float*)(ws + WS_ROPE);
    bf16_t* WA_t = (bf16_t*)(ws + WS_WA); bf16_t* WB_t = (bf16_t*)(ws + WS_WB); bf16_t* WM_t = (bf16_t*)(ws + WS_WM); bf16_t* WO_t = (bf16_t*)(ws + WS_WO);
    bf16_t* MEMB = (bf16_t*)(ws + WS_MEMB); bf16_t* MKV = (bf16_t*)(ws + WS_MKV); bf16_t* CMK = (bf16_t*)(ws + WS_CMK); bf16_t* CMV = (bf16_t*)(ws + WS_CMV);
    bf16_t* KSW = (bf16_t*)(ws + WS_KSW); bf16_t* VSW = (bf16_t*)(ws + WS_VSW); bf16_t* XA = (bf16_t*)(ws + WS_XA); bf16_t* XB = XA;
    bf16_t* MIX = (bf16_t*)(ws + WS_MIX); float* Z0 = (float*)(ws + WS_Z0); bf16_t* PA = (bf16_t*)(ws + WS_PA); bf16_t* PB = PA;
    bf16_t* KS = (bf16_t*)(ws + WS_KS); bf16_t* VS = (bf16_t*)(ws + WS_VS);
    const int lo = a.ph_lo, hi_ph = a.ph_hi;
#define IN(k) (lo <= (k) && (k) < hi_ph)
    if (tid < 64) MISC[tid] = 0u;
    __syncthreads();
    XcdBarrier xbar = xcd_barrier_post(ctl + 1024, MISC + 8);
#define SEAM(k) do { if (IN(k) && IN((k) + 1)) { if ((k) == 0) grid.sync(); else xcd_barrier(xbar); } } while (0)
    att::Ctx cx; cx.lds = lds; cx.lane = lane; cx.wid = wave; cx.r32 = lane & 31; cx.hi = lane >> 5;

    if (IN(0)) {
        LAS float* scr = (LAS float*)(lds + wave * 16384);
        for (int it = gw; it < 4736; it += NGW) {
            int r = it;
            if (r < 1536) { p0_transpose_item(a.in[9], DM, NA, WA_t, 0, scr, r, lane); continue; } r -= 1536;
            if (r < 1024) { p0_transpose_item(a.in[15], DM, 2048, WB_t, 0, scr, r, lane); continue; } r -= 1024;
            if (r < 128) { p0_transpose_item(a.in[17], DM, 256, WB_t, 2048, scr, r, lane); continue; } r -= 128;
            if (r < 1024) { const int l = r >> 9; p0_transpose_item(a.in[18] + (size_t)l * DM * DM, DM, DM, WM_t, l * 1024, scr, r & 511, lane); continue; } r -= 1024;
            { const int l = r >> 9; p0_transpose_item(a.in[19] + (size_t)l * DM * DM, DM, DM, WO_t, l * 1024, scr, r & 511, lane); }
        }
        for (long i = gtid; i < 2097152; i += NTHR) cvt8(a.in[0] + i * 8, XA + i * 8);
        for (long i = gtid; i < 32768; i += NTHR) cvt8(a.in[1] + i * 8, XA + (size_t)NP * DM + i * 8);
        for (long i = gtid; i < 131072; i += NTHR) cvt8(a.in[2] + i * 8, MEMB + i * 8);
        for (long i = gtid; i < 4194304; i += NTHR) { const long b = i >> 18, r = i & 262143; const size_t d = (size_t)b * KSROWS * 512 + r * 8;
            cvt8(a.in[3] + i * 8, KS + d); cvt8(a.in[4] + i * 8, VS + d); }
        for (long i = gtid; i < 524288; i += NTHR) { cvt8(a.in[7] + i * 8, CMK + i * 8); cvt8(a.in[8] + i * 8, CMV + i * 8); }
        for (long i = gtid; i < 32768; i += NTHR) { const long b = i >> 11, r = i & 2047; const size_t d = (size_t)b * SWROWS * 128 + r * 8;
            cvt8(a.in[5] + i * 8, KSW + d); cvt8(a.in[6] + i * 8, VSW + d);
            const int rw = (int)(r >> 4);
            if (rw >= 16) { const size_t od = ((size_t)b * 128 + rw - 16) * 128 + (r & 15) * 8;
                *(f32x4*)(dout + OFF_SKS + od) = *(const f32x4*)(a.in[5] + i * 8); *(f32x4*)(dout + OFF_SKS + od + 4) = *(const f32x4*)(a.in[5] + i * 8 + 4);
                *(f32x4*)(dout + OFF_SVS + od) = *(const f32x4*)(a.in[6] + i * 8); *(f32x4*)(dout + OFF_SVS + od + 4) = *(const f32x4*)(a.in[6] + i * 8 + 4); } }
        for (long i = gtid; i < 49152; i += NTHR) { const long b = i / 3072, r = i % 3072; const size_t d = ((size_t)b * KSROWS + 4112) * 512 + r * 8;
            *(u32x4*)(KS + d) = (u32x4){0u, 0u, 0u, 0u}; *(u32x4*)(VS + d) = (u32x4){0u, 0u, 0u, 0u}; }
        for (long i = gtid; i < 12288; i += NTHR) { const long b = i / 768, r = i % 768; const size_t d = ((size_t)b * SWROWS + 144) * 128 + r * 8;
            *(u32x4*)(KSW + d) = (u32x4){0u, 0u, 0u, 0u}; *(u32x4*)(VSW + d) = (u32x4){0u, 0u, 0u, 0u}; }
        for (long i = gtid; i < 4112 * 8; i += NTHR) { const int pos = (int)(i >> 3), fi = (int)(i & 7);
            const double inv = fi == 0 ? 1.0 : fi == 1 ? 0.19392274474868576 : fi == 2 ? 0.03760603093086393 : fi == 3 ? 0.007292664737217109 :
                               fi == 4 ? 0.001414213562373095 : fi == 5 ? 0.0002742481756762073 : fi == 6 ? 5.318295896944988e-05 : 1.031338537721246e-05;
            const double rev = (double)pos * inv * 0.15915494309189535; const float fr = (float)(rev - __builtin_rint(rev));
            ROPE[i * 2] = __builtin_amdgcn_cosf(fr); ROPE[i * 2 + 1] = __builtin_amdgcn_sinf(fr); }
    }
    SEAM(0);
    if (IN(1)) {
        { pg8::Gemm g{MEMB, WM_t, 1024, 2048, DM}; pg8::StaticOrder S; S.init(1024, 2048, G, (int)((blockIdx.x + G / 2) % G));
          EpiWrap<EpiMemF> E{{MKV, dout}};
          pg8::gemm_phase<EpiWrap<EpiMemF>, pg8::StaticOrder, true, true>(lds, g, S, E); }
        { pg8::Gemm g{XA, WA_t, MA, NA, DM}; pg8::StaticOrder S; S.init(MA, NA, G, (int)blockIdx.x);
          EpiWrap<EpiAF> E{{PA, dout, KS, VS, ROPE}};
          pg8::gemm_phase<EpiWrap<EpiAF>, pg8::StaticOrder, true, true>(lds, g, S, E); }
    }
    SEAM(1);
    if (IN(2)) {
        float s1 = 0.f, s2 = 0.f;
        for (int i = 0; i < 64; ++i) { s1 += a.in[10][i] * a.in[11][i]; s2 += a.in[12][i] * a.in[13][i]; }
        const float lam = __expf(s1) - __expf(s2) + 0.2f;
        for (;;) {
            if (tid == 0) MISC[0] = atomicAdd(ctl + 128 * a.rep, 1u);
            __syncthreads(); const unsigned u = MISC[0]; __syncthreads();
            if (u >= 896u) break;
            if (u < 576u) { const bool samp = u < 64u; const unsigned v = samp ? u : u - 64u;
                const int b = samp ? (int)(v >> 2) : (int)((v & 15u) >> 2), h = (int)(v & 3u), qb = samp ? 0 : 31 - (int)(v >> 4);
                att::diff_unit(cx, samp, b, h, qb, PA, KS, VS, MIX, a.in[14], lam); }
            else { const bool samp = u >= 832u; const unsigned v = samp ? u - 832u : u - 576u;
                const int b = samp ? (int)(v >> 2) : (int)(v >> 6), h = samp ? (int)(v & 3u) : (int)((v >> 4) & 3u), qb = samp ? 0 : (int)(v & 15u);
                const bf16_t* Kb = samp ? CMK + ((size_t)b * 256) * 512 + h * 128 : MKV + ((size_t)b * 256) * 2048 + h * 128;
                const bf16_t* Vb = samp ? CMV + ((size_t)b * 256) * 512 + h * 128 : Kb + 512;
                att::mem_unit(cx, samp, b, h, qb, PA, NA, 2048, 2560, Kb, Vb, samp ? 512 : 2048, MIX); }
        }
    }
    SEAM(2);
    if (IN(3)) {
        pg8::Gemm g{MIX, WO_t, MA, DM, DM}; pg8::StaticOrder S; S.init(MA, DM, G, (int)blockIdx.x);
        EpiWrap<EpiMergeF> E{{a.in[0], a.in[1], Z0}};
        pg8::gemm_phase<EpiWrap<EpiMergeF>, pg8::StaticOrder, true, true>(lds, g, S, E);
    }
    SEAM(3);
    if (IN(4)) ln_rows(Z0, Z0, XB, a.in[20], a.in[21], gw, NGW, lane);
    SEAM(4);
    if (IN(5)) {
        pg8::Gemm g{XB, WB_t, MA, NB, DM}; pg8::StaticOrder S; S.init(MA, NB, G, (int)blockIdx.x);
        EpiWrap<EpiBF> E{{PB, dout, KSW, VSW, ROPE}};
        pg8::gemm_phase<EpiWrap<EpiBF>, pg8::StaticOrder, true, true>(lds, g, S, E);
    }
    SEAM(5);
    if (IN(6)) {
        for (;;) {
            if (tid == 0) MISC[0] = atomicAdd(ctl + 64 + 128 * a.rep, 1u);
            __syncthreads(); const unsigned u = MISC[0]; __syncthreads();
            if (u >= 848u) break;
            if (u < 320u) { const bool samp = u >= 256u; const unsigned v = samp ? u - 256u : u;
                const int b = samp ? (int)(v >> 2) : (int)(v >> 6), h = samp ? (int)(v & 3u) : (int)((v >> 4) & 3u), qb = samp ? 0 : (int)(v & 15u);
                const bf16_t* Kb = samp ? CMK + ((size_t)(16 + b) * 256) * 512 + h * 128 : MKV + ((size_t)b * 256) * 2048 + 1024 + h * 128;
                const bf16_t* Vb = samp ? CMV + ((size_t)(16 + b) * 256) * 512 + h * 128 : Kb + 512;
                att::mem_unit(cx, samp, b, h, qb, PB, NB, 1024, 1536, Kb, Vb, samp ? 512 : 2048, MIX); }
            else { const bool samp = u >= 832u; const unsigned v = samp ? u - 832u : u - 320u;
                const int b = samp ? (int)v : (int)(v >> 7), c = samp ? 0 : (int)((v >> 1) & 63u), half = samp ? 0 : (int)(v & 1u);
                att::swa_unit(cx, samp, b, c, half, PB, KSW, VSW, MIX, a.in[16]); }
        }
    }
    SEAM(6);
    if (IN(7)) {
        pg8::Gemm g{MIX, WO_t + (size_t)DM * DM, MA, DM, DM}; pg8::StaticOrder S; S.init(MA, DM, G, (int)blockIdx.x);
        EpiWrap<EpiMergeF> E{{Z0, Z0 + (size_t)NP * DM, dout}};
        pg8::gemm_phase<EpiWrap<EpiMergeF>, pg8::StaticOrder, true, true>(lds, g, S, E);
    }
    SEAM(7);
    if (IN(8)) ln_rows(dout, dout, nullptr, a.in[20] + DM, a.in[21] + DM, gw, NGW, lane);
#undef IN
#undef SEAM
}

#ifndef MK_N_LAUNCHES
#define MK_N_LAUNCHES 1
#endif
#ifndef PROBE_DUP
#define PROBE_DUP 0
#endif
extern "C" void kernel_launch(void* const* d_in, const int* in_sizes, int n_in, void* d_out, int out_size, void* d_ws, size_t ws_size, hipStream_t stream) {
    static int grid = 0;
    if (grid == 0) {
        if (n_in != 22 || ws_size < WS_END) { fprintf(stderr, "kernel_launch: unexpected n_in %d / ws %zu\n", n_in, ws_size); grid = -1; return; }
        int dev = 0, cus = 0, per_cu = 0;
        if (hipGetDevice(&dev) != hipSuccess || hipDeviceGetAttribute(&cus, hipDeviceAttributeMultiprocessorCount, dev) != hipSuccess) { grid = -1; return; }
        if (hipFuncSetAttribute((const void*)yoco_fwd, hipFuncAttributeMaxDynamicSharedMemorySize, LDS_BYTES) != hipSuccess) { fprintf(stderr, "kernel_launch: hipFuncSetAttribute failed\n"); grid = -1; return; }
        if (hipOccupancyMaxActiveBlocksPerMultiprocessor(&per_cu, (const void*)yoco_fwd, NWAVES * 64, LDS_BYTES) != hipSuccess || per_cu < 1) { fprintf(stderr, "kernel_launch: occupancy query says %d\n", per_cu); per_cu = 1; }
        (void)hipGetLastError();
        grid = cus;
    }
    if (grid < 0) return;
    (void)hipMemsetAsync((char*)d_ws + WS_CTL, 0, 65536, stream);
    Args a{};
    for (int i = 0; i < 22; ++i) a.in[i] = (const float*)d_in[i];
    a.out = (float*)d_out; a.ws = (unsigned char*)d_ws;
#if MK_N_LAUNCHES == 1
    a.ph_lo = 0; a.ph_hi = NPHASE;
    void* args[] = {&a};
    hipError_t e = hipLaunchCooperativeKernel((const void*)yoco_fwd, dim3(grid), dim3(NWAVES * 64), args, LDS_BYTES, stream);
    if (e != hipSuccess) fprintf(stderr, "kernel_launch: cooperative launch failed: %s (grid %d)\n", hipGetErrorString(e), grid);
#else
    for (int p = 0; p < NPHASE; ++p) { a.ph_lo = p; a.ph_hi = p + 1;
        for (int r = 0; r < 1 + ((PROBE_DUP >> p) & 1); ++r) { a.rep = r; hipLaunchKernelGGL(yoco_fwd, dim3(grid), dim3(NWAVES * 64), LDS_BYTES, stream, a); } }
#endif
}
```

```cpp
#include <hip/hip_runtime.h>
#include <hip/hip_cooperative_groups.h>
#include <cstdio>
#include <cstdint>
namespace cg = cooperative_groups;
namespace pg8 {
#define PG8_LAS __attribute__((address_space(3)))
typedef unsigned short bf16_t;
typedef short bf16x8 __attribute__((ext_vector_type(8)));
typedef float f32x4 __attribute__((ext_vector_type(4)));
typedef unsigned u32x4 __attribute__((ext_vector_type(4)));
constexpr int BM = 256, BK = 64, HALF = 128, HTB = HALF * BK * 2  , STAGE_BYTES = 8 * HTB, NXCD = 8, WGM = 8;

__host__ __device__ __forceinline__ int lds_byte(int r, int c) { const int st = (r >> 4) * 2 + (c >> 5), rr = r & 15, cc = c & 31, ob = rr * 64 + cc * 2; return st * 1024 + (ob ^ (((ob >> 9) & 1) << 5)); }
__host__ __device__ __forceinline__ void stage_rc(int b, int& R, int& C) { const int st = b / 1024, sb = b % 1024, swz = sb ^ (((sb >> 9) & 1) << 5); R = (st >> 1) * 16 + swz / 64; C = (st & 1) * 32 + (swz % 64) / 2; }
__host__ __device__ __forceinline__ int perm32(int rho) { const int n = rho >> 4, i = rho & 15; return 8 * (i >> 2) + 4 * n + (i & 3); }

struct Unit { int pm, pn; };
struct Gemm { const bf16_t* A; const bf16_t* Bt; int M, N, K; };

struct StaticOrder {
    int nM, nN, nwg, G, c;
    __host__ __device__ void init(int M, int N, int G_, int c_) { nM = M / BM; nN = N / BM; nwg = nM * nN; G = G_; c = c_; }
    __host__ __device__ bool next(int i, Unit& u) const {
        const long L = (long)i * G + c; if (L >= nwg) return false;
        int wgid = (int)L; { const int q = nwg / NXCD, r = nwg % NXCD, xcd = wgid % NXCD, off = wgid / NXCD; wgid = (xcd < r ? xcd * (q + 1) : r * (q + 1) + (xcd - r) * q) + off; }
        const int nig = WGM * nN, gid = wgid / nig, fm = gid * WGM, gsz = (nM - fm) < WGM ? (nM - fm) : WGM;
        u.pm = fm + ((wgid % nig) % gsz); u.pn = (wgid % nig) / gsz; return true;
    }
    __device__ __forceinline__ void a_ready(const Unit&) const {}
    __device__ __forceinline__ void done(const Unit&) const {}
};
__device__ __forceinline__ unsigned cvt_pk_bf16(float lo, float hi) { unsigned r; asm volatile("v_cvt_pk_bf16_f32 %0, %1, %2" : "=v"(r) : "v"(lo), "v"(hi)); return r; }
typedef float f32x2 __attribute__((ext_vector_type(2)));
template <class Epi, class Sched, bool ALIGN_EPI = false, bool SP2 = false>
__device__ __forceinline__ void gemm_phase(PG8_LAS unsigned char* lds, const Gemm g, const Sched& S, const Epi& E) {
    const int tid = threadIdx.x, wid = __builtin_amdgcn_readfirstlane(tid >> 6), lane = tid & 63, wr = wid >> 2, wc = wid & 3, fr = lane & 15, fq = lane >> 4;
    const int K = g.K, nt = K / BK;
    unsigned voffA[2], voffB[2];
#pragma unroll
    for (int i = 0; i < 2; ++i) { int R, C; stage_rc(tid * 16 + i * 8192, R, C); const int Rb = Epi::PERM ? ((R & ~31) + perm32(R & 31)) : R;
        voffA[i] = (unsigned)(R * K + C) * 2u; voffB[i] = (unsigned)(Rb * K + C) * 2u; }
    const size_t kstep = (size_t)(BK * 2);
    const size_t hstep = (size_t)HALF * K * 2;
    const size_t tstep = 2 * hstep;
    const unsigned ldsw = (unsigned)wid * 1024u;
    const int aoff = lds_byte(wr * 64 + fr, fq * 8), boff = lds_byte(wc * 32 + fr, fq * 8);
#define PG8_SA(b, h) (((b) * 2 + (h)) * HTB)
#define PG8_SB(b, h) ((4 + (b) * 2 + (h)) * HTB)
#define PG8_STAGE(bufoff, gbase, voff) do { _Pragma("unroll") for (int _i = 0; _i < 2; ++_i) \
        __builtin_amdgcn_global_load_lds((const unsigned*)((const char*)(gbase) + (voff)[_i]), (PG8_LAS unsigned*)(lds + (bufoff) + ldsw + _i * 8192), 16, 0, 0); } while (0)
#define PG8_LDA(dst, b, h) do { _Pragma("unroll") for (int m = 0; m < 4; ++m) _Pragma("unroll") for (int k = 0; k < 2; ++k) dst[m][k] = *(const PG8_LAS bf16x8*)(lds + PG8_SA(b, h) + aoff + m * 2048 + k * 1024); } while (0)
#define PG8_LDB(dst, b, h) do { _Pragma("unroll") for (int n = 0; n < 2; ++n) _Pragma("unroll") for (int k = 0; k < 2; ++k) dst[n][k] = *(const PG8_LAS bf16x8*)(lds + PG8_SB(b, h) + boff + n * 2048 + k * 1024); } while (0)
#define PG8_MMA(ai, bj, At, Bt) do { __builtin_amdgcn_s_setprio(1); _Pragma("unroll") for (int m = 0; m < 4; ++m) _Pragma("unroll") for (int n = 0; n < 2; ++n) _Pragma("unroll") for (int k = 0; k < 2; ++k) \
        acc[ai][bj][m][n] = __builtin_amdgcn_mfma_f32_16x16x32_bf16(Bt[n][k], At[m][k], acc[ai][bj][m][n], 0, 0, 0); __builtin_amdgcn_s_setprio(0); } while (0)
#define PG8_WAIT_V(n) asm volatile("s_waitcnt vmcnt(" #n ")" ::: "memory")
#define PG8_WAIT_L(n) asm volatile("s_waitcnt lgkmcnt(" #n ")" ::: "memory")
#define PG8_BAR __builtin_amdgcn_s_barrier()
#define PG8_SCHED __builtin_amdgcn_sched_barrier(0)
    Unit cur, nxt; int ui = 0;
    if (!S.next(0, cur)) return;
    f32x4 acc[2][2][4][2];
#pragma unroll
    for (int a = 0; a < 2; ++a)
#pragma unroll
        for (int b = 0; b < 2; ++b)
#pragma unroll
            for (int m = 0; m < 4; ++m)
#pragma unroll
                for (int n = 0; n < 2; ++n) acc[a][b][m][n] = (f32x4){0.f, 0.f, 0.f, 0.f};
    bf16x8 At[4][2], B0[2][2], B1[2][2];
    const char* cA = (const char*)g.A + (size_t)cur.pm * tstep; const char* cB = (const char*)g.Bt + (size_t)cur.pn * tstep;
    S.a_ready(cur);
    if constexpr (SP2) {
        PG8_STAGE(PG8_SB(0, 0), cB, voffB); PG8_STAGE(PG8_SB(0, 1), cB + hstep, voffB); PG8_STAGE(PG8_SA(0, 0), cA, voffA); PG8_STAGE(PG8_SA(0, 1), cA + hstep, voffA);
        if (wr == 1) PG8_BAR;
        PG8_WAIT_V(2); PG8_BAR;
        PG8_STAGE(PG8_SB(1, 0), cB + kstep, voffB); PG8_STAGE(PG8_SA(1, 0), cA + kstep, voffA); PG8_STAGE(PG8_SB(1, 1), cB + hstep + kstep, voffB);
        PG8_WAIT_V(6); PG8_BAR;
    } else {
        PG8_STAGE(PG8_SB(0, 0), cB, voffB); PG8_STAGE(PG8_SA(0, 0), cA, voffA); PG8_STAGE(PG8_SB(0, 1), cB + hstep, voffB); PG8_STAGE(PG8_SA(0, 1), cA + hstep, voffA);
        if (wr == 1) PG8_BAR;
        PG8_WAIT_V(4); PG8_BAR;
        PG8_STAGE(PG8_SB(1, 0), cB + kstep, voffB); PG8_STAGE(PG8_SA(1, 0), cA + kstep, voffA); PG8_STAGE(PG8_SB(1, 1), cB + hstep + kstep, voffB);
        PG8_WAIT_V(6); PG8_BAR;
    }
    for (;;) {
        const bool has_next = S.next(ui + 1, nxt);
        const char* nA = has_next ? (const char*)g.A + (size_t)nxt.pm * tstep : cA; const char* nB = has_next ? (const char*)g.Bt + (size_t)nxt.pn * tstep : cB;
        for (int t = 0; t < nt; t += 2) {
            const bool last = (t == nt - 2);
            const char* a1 = cA + (size_t)(t + 1) * kstep;
            const char* a2 = last ? nA : cA + (size_t)(t + 2) * kstep; const char* b2 = last ? nB : cB + (size_t)(t + 2) * kstep;
            const char* a3 = a2 + kstep; const char* b3 = b2 + kstep;
            if (last && has_next) S.a_ready(nxt);
            if constexpr (SP2) {
            PG8_LDB(B0, 0, 0); PG8_LDB(B1, 0, 1); PG8_SCHED; PG8_LDA(At, 0, 0); PG8_STAGE(PG8_SA(1, 1), a1 + hstep, voffA);
            PG8_WAIT_V(8); PG8_WAIT_L(0); PG8_BAR; PG8_MMA(0, 0, At, B0); PG8_MMA(0, 1, At, B1); PG8_BAR; PG8_SCHED;
            PG8_LDA(At, 0, 1); PG8_STAGE(PG8_SB(0, 0), b2, voffB); PG8_STAGE(PG8_SB(0, 1), b2 + hstep, voffB); PG8_STAGE(PG8_SA(0, 0), a2, voffA);
            PG8_WAIT_V(8); PG8_WAIT_L(0); PG8_BAR; PG8_MMA(1, 0, At, B0); PG8_MMA(1, 1, At, B1); PG8_BAR; PG8_SCHED;
            PG8_LDB(B0, 1, 0); PG8_LDB(B1, 1, 1); PG8_SCHED; PG8_LDA(At, 1, 0); PG8_STAGE(PG8_SA(0, 1), a2 + hstep, voffA);
            PG8_WAIT_V(8); PG8_WAIT_L(0); PG8_BAR; PG8_MMA(0, 0, At, B0); PG8_MMA(0, 1, At, B1); PG8_BAR; PG8_SCHED;
            PG8_LDA(At, 1, 1); PG8_STAGE(PG8_SB(1, 0), b3, voffB); PG8_STAGE(PG8_SB(1, 1), b3 + hstep, voffB); PG8_STAGE(PG8_SA(1, 0), a3, voffA);
            PG8_WAIT_V(8); PG8_WAIT_L(0); PG8_BAR; PG8_MMA(1, 0, At, B0); PG8_MMA(1, 1, At, B1); PG8_BAR; PG8_SCHED;
            } else {
            PG8_LDB(B0, 0, 0); PG8_SCHED; PG8_LDA(At, 0, 0); PG8_STAGE(PG8_SA(1, 1), a1 + hstep, voffA);
            PG8_WAIT_L(8); PG8_BAR; PG8_WAIT_L(0); PG8_MMA(0, 0, At, B0); PG8_BAR; PG8_SCHED;
            PG8_LDB(B1, 0, 1); PG8_STAGE(PG8_SB(0, 0), b2, voffB);
            PG8_BAR; PG8_WAIT_L(0); PG8_MMA(0, 1, At, B1); PG8_BAR;
            PG8_LDA(At, 0, 1); PG8_STAGE(PG8_SA(0, 0), a2, voffA);
            PG8_BAR; PG8_WAIT_L(0); PG8_MMA(1, 0, At, B0); PG8_BAR; PG8_SCHED;
            PG8_STAGE(PG8_SB(0, 1), b2 + hstep, voffB);
            PG8_WAIT_V(6); PG8_BAR; PG8_MMA(1, 1, At, B1); PG8_BAR;
            PG8_LDB(B0, 1, 0); PG8_SCHED; PG8_LDA(At, 1, 0); PG8_STAGE(PG8_SA(0, 1), a2 + hstep, voffA);
            PG8_WAIT_L(8); PG8_BAR; PG8_WAIT_L(0); PG8_MMA(0, 0, At, B0); PG8_BAR; PG8_SCHED;
            PG8_LDB(B1, 1, 1); PG8_STAGE(PG8_SB(1, 0), b3, voffB);
            PG8_BAR; PG8_WAIT_L(0); PG8_MMA(0, 1, At, B1); PG8_BAR;
            PG8_LDA(At, 1, 1); PG8_STAGE(PG8_SA(1, 0), a3, voffA);
            PG8_BAR; PG8_WAIT_L(0); PG8_MMA(1, 0, At, B0); PG8_BAR; PG8_SCHED;
            PG8_STAGE(PG8_SB(1, 1), b3 + hstep, voffB);
            PG8_WAIT_V(6); PG8_BAR; PG8_MMA(1, 1, At, B1); PG8_BAR;
            }
        }
        if constexpr (ALIGN_EPI) { if (wr == 0) PG8_BAR; }
        if constexpr (!Epi::AFTER_DRAIN) { E(acc, cur, wr, wc, fr, fq); S.done(cur); }
        if (!has_next) break;
#pragma unroll
        for (int a = 0; a < 2; ++a)
#pragma unroll
            for (int b = 0; b < 2; ++b)
#pragma unroll
                for (int m = 0; m < 4; ++m)
#pragma unroll
                    for (int n = 0; n < 2; ++n) acc[a][b][m][n] = (f32x4){0.f, 0.f, 0.f, 0.f};
        cur = nxt; cA = nA; cB = nB; ++ui;
        if constexpr (ALIGN_EPI) { if (wr == 1) PG8_BAR; }
    }
    PG8_WAIT_V(0);
    if constexpr (!ALIGN_EPI) { if (wr == 0) PG8_BAR; }
    PG8_BAR;
    if constexpr (Epi::AFTER_DRAIN) { E.fused(acc, cur, wr, wc, fr, fq, lds, wid, lane); S.done(cur); }
#undef PG8_SA
#undef PG8_SB
#undef PG8_STAGE
#undef PG8_LDA
#undef PG8_LDB
#undef PG8_MMA
#undef PG8_WAIT_V
#undef PG8_WAIT_L
#undef PG8_BAR
#undef PG8_SCHED
}
}

typedef unsigned short bf16_t;
typedef short bf16x8 __attribute__((ext_vector_type(8)));
typedef short s16x4 __attribute__((ext_vector_type(4)));
typedef float f32x4 __attribute__((ext_vector_type(4)));
typedef float f32x16 __attribute__((ext_vector_type(16)));
typedef unsigned u32x4 __attribute__((ext_vector_type(4)));
typedef unsigned u32x2 __attribute__((ext_vector_type(2)));
#define LAS __attribute__((address_space(3)))

constexpr int DM = 1024, NP = 16384, NS = 256, MA = NP + NS;
constexpr int NA = 3072, NB = 2304;
constexpr int KSROWS = 4160, SWROWS = 192;
constexpr float DN_ALPHA = 1.41421356237309515f;
constexpr float LOG2E = 1.4426950408889634f;
constexpr float C64 = 0.125f * LOG2E, THR64 = 64.f;
constexpr float C128 = 0.088388347648318440f * LOG2E, THR128 = 90.5f;
constexpr size_t OFF_DKP = 17039360, OFF_DVP = 25427968, OFF_DKS = 33816576, OFF_DVS = 33947648, OFF_SKP = 34078720, OFF_SVP = 34144256,
                 OFF_SKS = 34209792, OFF_SVS = 34471936, OFF_MKP = 34734080, OFF_MVP = 35782656;
constexpr size_t MiB = 1u << 20;
constexpr size_t WS_CTL = 0, WS_ROPE = 1 * MiB, WS_WA = 2 * MiB, WS_WB = 8 * MiB, WS_WM = 13 * MiB, WS_WO = 17 * MiB, WS_MEMB = 21 * MiB, WS_MKV = 23 * MiB,
                 WS_CMK = 27 * MiB, WS_CMV = 35 * MiB, WS_KSW = 43 * MiB, WS_VSW = 44 * MiB, WS_XA = 46 * MiB, WS_MIX = 79 * MiB, WS_Z0 = 112 * MiB,
                 WS_PA = 177 * MiB, WS_KS = 275 * MiB, WS_VS = 340 * MiB, WS_END = 405 * MiB;
constexpr int LDS_RING = 131072, LDS_BYTES = LDS_RING + 256;

__device__ __forceinline__ unsigned cvtpk(float lo, float hi) { unsigned r; asm volatile("v_cvt_pk_bf16_f32 %0, %1, %2" : "=v"(r) : "v"(lo), "v"(hi)); return r; }
__device__ __forceinline__ float bflo(unsigned w) { return __uint_as_float(w << 16); }
__device__ __forceinline__ float bfhi(unsigned w) { return __uint_as_float(w & 0xffff0000u); }
__device__ __forceinline__ float silu(float x) { return x * __builtin_amdgcn_rcpf(1.f + __expf(-x)); }
__device__ __forceinline__ void cvt8(const float* s, bf16_t* d) {
    const f32x4 a = *(const f32x4*)s, b = *(const f32x4*)(s + 4);
    u32x4 w; w.x = cvtpk(a.x, a.y); w.y = cvtpk(a.z, a.w); w.z = cvtpk(b.x, b.y); w.w = cvtpk(b.z, b.w); *(u32x4*)d = w;
}

__device__ __forceinline__ f32x4 shfl4(f32x4 v, int m) { f32x4 p; p.x = __shfl_xor(v.x, m); p.y = __shfl_xor(v.y, m); p.z = __shfl_xor(v.z, m); p.w = __shfl_xor(v.w, m); return p; }
template <class F> struct EpiWrap {
    static constexpr bool PERM = false, AFTER_DRAIN = false;
    F f;
    __device__ __forceinline__ void operator()(const f32x4 (&acc)[2][2][4][2], const pg8::Unit& u, int wr, int wc, int fr, int fq) const {
        F lf = f;
#pragma unroll
        for (int ai = 0; ai < 2; ++ai)
#pragma unroll
            for (int m = 0; m < 4; ++m) { const int row = u.pm * 256 + ai * 128 + wr * 64 + m * 16 + fr;
                lf.row_begin(row);
#pragma unroll
                for (int bj = 0; bj < 2; ++bj)
#pragma unroll
                    for (int n = 0; n < 2; ++n) { const int col = u.pn * 256 + bj * 128 + wc * 32 + n * 16 + 4 * fq;
                        const f32x4 v = acc[ai][bj][m][n]; f32x4 p = v;
                        if constexpr (F::ROPE) { if (lf.need_rope(col)) p = shfl4(v, 32); }
                        lf.quad(row, col, v, p); }
                if constexpr (F::STATS) { float s = lf.s, q = lf.q; s += __shfl_xor(s, 16); s += __shfl_xor(s, 32); q += __shfl_xor(q, 16); q += __shfl_xor(q, 32);
                    if (fq == 0) lf.commit(row, s, q); } }
    }
};
__device__ __forceinline__ f32x4 rope_apply(f32x4 v, f32x4 p, int col, int pos, const float* rope) {
    const float* t = rope + ((size_t)pos * 8 + (col & 4)) * 2;
    const f32x4 t0 = *(const f32x4*)t, t1 = *(const f32x4*)(t + 4);
    const float sg = (col & 8) ? 1.f : -1.f;
    f32x4 o; o.x = v.x * t0.x + sg * p.x * t0.y; o.y = v.y * t0.z + sg * p.y * t0.w; o.z = v.z * t1.x + sg * p.z * t1.y; o.w = v.w * t1.z + sg * p.w * t1.w;
    return o;
}
__device__ __forceinline__ void st_bf4(bf16_t* p, f32x4 v) { u32x2 w; w.x = cvtpk(v.x, v.y); w.y = cvtpk(v.z, v.w); *(u32x2*)p = w; }
__device__ __forceinline__ void row_stats(const float* ST, int row, float& mu, float& rstd) {
    const float s = ST[2 * (size_t)row], q = ST[2 * (size_t)row + 1]; mu = s * (1.f / DM); rstd = rsqrtf(fmaxf(q * (1.f / DM) - mu * mu, 0.f) + 1e-5f);
}

struct EpiAF {
    static constexpr bool ROPE = true, STATS = false;
    bf16_t* PA; float* dout; bf16_t* KS; bf16_t* VS; const float* rope; float s, q;
    __device__ __forceinline__ void row_begin(int) {}
    __device__ __forceinline__ bool need_rope(int col) const { return (col >> 9) < 2 && ((col >> 4) & 3) == 0; }
    __device__ __forceinline__ void commit(int, float, float) {}
    __device__ __forceinline__ void quad(int row, int col, f32x4 v, f32x4 p) {
        const bool samp = row >= NP; const int rs = row - NP;
        const int pos = samp ? 4096 + (rs & 15) : (row & 4095);
        const int region = col >> 9;
        if (need_rope(col)) v = rope_apply(v, p, col, pos, rope);
        st_bf4(PA + (size_t)row * NA + col, v);
        if (region == 1 || region == 2) {
            const int c = col & 511;
            if (!samp) *(f32x4*)(dout + (region == 1 ? OFF_DKP : OFF_DVP) + (size_t)row * 512 + c) = v;
            else { *(f32x4*)(dout + (region == 1 ? OFF_DKS : OFF_DVS) + (size_t)rs * 512 + c) = v;
                   st_bf4((region == 1 ? KS : VS) + ((size_t)(rs >> 4) * KSROWS + 4096 + (rs & 15)) * 512 + c, v); }
        }
    }
};
struct EpiMemF {
    static constexpr bool ROPE = false, STATS = false;
    bf16_t* MKV; float* dout; float s, q;
    __device__ __forceinline__ void row_begin(int) {}
    __device__ __forceinline__ void commit(int, float, float) {}
    __device__ __forceinline__ void quad(int row, int col, f32x4 v, f32x4) {
        st_bf4(MKV + (size_t)row * 2048 + col, v);
        const int l = col >> 10, c = col & 1023;
        *(f32x4*)(dout + (c < 512 ? OFF_MKP : OFF_MVP) + (size_t)l * 524288 + (size_t)row * 512 + (c & 511)) = v;
    }
};
struct EpiMerge0F {
    static constexpr bool ROPE = false, STATS = true;
    const float* base_p; const float* base_s; float* Z; bf16_t* ZB; float* ST; float s, q;
    __device__ __forceinline__ void row_begin(int) { s = 0.f; q = 0.f; }
    __device__ __forceinline__ void commit(int row, float ss, float qq) { atomicAdd(ST + 2 * (size_t)row, ss); atomicAdd(ST + 2 * (size_t)row + 1, qq); }
    __device__ __forceinline__ void quad(int row, int col, f32x4 v, f32x4) {
        const float* bp = row < NP ? base_p + (size_t)row * DM + col : base_s + (size_t)(row - NP) * DM + col;
        const f32x4 z = *(const f32x4*)bp * DN_ALPHA + v;
        *(f32x4*)(Z + (size_t)row * DM + col) = z; st_bf4(ZB + (size_t)row * DM + col, z);
        s += (z.x + z.y) + (z.z + z.w); q += (z.x * z.x + z.y * z.y) + (z.z * z.z + z.w * z.w);
    }
};
struct EpiMerge1F {
    static constexpr bool ROPE = false, STATS = true;
    const float* Z0; const float* ST0; const float* g0; const float* b0; float* out; float* ST1; float s, q, mu, rstd;
    __device__ __forceinline__ void row_begin(int row) { s = 0.f; q = 0.f; row_stats(ST0, row, mu, rstd); }
    __device__ __forceinline__ void commit(int row, float ss, float qq) { atomicAdd(ST1 + 2 * (size_t)row, ss); atomicAdd(ST1 + 2 * (size_t)row + 1, qq); }
    __device__ __forceinline__ void quad(int row, int col, f32x4 v, f32x4) {
        const f32x4 z0 = *(const f32x4*)(Z0 + (size_t)row * DM + col), g = *(const f32x4*)(g0 + col), b = *(const f32x4*)(b0 + col);
        const f32x4 x1 = (z0 - mu) * rstd * g + b;
        const f32x4 z = x1 * DN_ALPHA + v;
        *(f32x4*)(out + (size_t)row * DM + col) = z;
        s += (z.x + z.y) + (z.z + z.w); q += (z.x * z.x + z.y * z.y) + (z.z * z.z + z.w * z.w);
    }
};
struct EpiBF {
    static constexpr bool ROPE = true, STATS = false;
    bf16_t* PB; float* dout; bf16_t* KSW; bf16_t* VSW; const float* rope; const float* ST0; const float* CS; const float* BW; float s, q, mu, rstd;
    __device__ __forceinline__ void row_begin(int row) { row_stats(ST0, row, mu, rstd); }
    __device__ __forceinline__ bool need_rope(int col) const { return (col < 512 || (col >= 2048 && col < 2176)) && ((col >> 4) & 3) == 0; }
    __device__ __forceinline__ void commit(int, float, float) {}
    __device__ __forceinline__ f32x4 fix(f32x4 v, int col) const { const f32x4 c = *(const f32x4*)(CS + col), b = *(const f32x4*)(BW + col); return (v - c * mu) * rstd + b; }
    __device__ __forceinline__ void quad(int row, int col, f32x4 v, f32x4 p) {
        const bool samp = row >= NP; const int rs = row - NP;
        const int t = samp ? (rs & 15) : (row & 4095);
        const int pos = samp ? 4096 + t : t;
        const bool isk = col >= 2048 && col < 2176;
        v = fix(v, col);
        if (need_rope(col)) { p = fix(p, col ^ 8); v = rope_apply(v, p, col, pos, rope); }
        st_bf4(PB + (size_t)row * NB + col, v);
        if (col >= 2048) {
            const int cc = col & 127;
            if (!samp) { if (t >= 3968) *(f32x4*)(dout + (isk ? OFF_SKP : OFF_SVP) + ((size_t)(row >> 12) * 128 + (t - 3968)) * 128 + cc) = v; }
            else { const int b = rs >> 4;
                   *(f32x4*)(dout + (isk ? OFF_SKS : OFF_SVS) + ((size_t)b * 128 + 112 + t) * 128 + cc) = v;
                   st_bf4((isk ? KSW : VSW) + ((size_t)b * SWROWS + 128 + t) * 128 + cc, v); }
        }
    }
};
template <class F> __device__ __forceinline__ void gemm_small(LAS unsigned char* lds, const bf16_t* A, const bf16_t* Bt, int N, int rowbase, int ustart, int G, const F& f) {
    const int tid = threadIdx.x, lane = tid & 63, r32 = lane & 31, hi = lane >> 5, wid = __builtin_amdgcn_readfirstlane(tid >> 6);
    const int nu = 8 * (N / 32);
    for (int u = ustart; u < nu; u += G) {
        const int row0 = (u & 7) * 32, col0 = (u >> 3) * 32;
        const bf16_t* ap = A + (size_t)(row0 + r32) * DM + wid * 128 + hi * 8; const bf16_t* bp = Bt + (size_t)(col0 + r32) * DM + wid * 128 + hi * 8;
        bf16x8 af[8], bfr[8];
#pragma unroll
        for (int k = 0; k < 8; ++k) { af[k] = *(const bf16x8*)(ap + 16 * k); bfr[k] = *(const bf16x8*)(bp + 16 * k); }
        f32x16 acc = f32x16{};
#pragma unroll
        for (int k = 0; k < 8; ++k) acc = __builtin_amdgcn_mfma_f32_32x32x16_bf16(bfr[k], af[k], acc, 0, 0, 0);
        LAS float* part = (LAS float*)lds + wid * 1024;
#pragma unroll
        for (int r = 0; r < 16; ++r) part[r * 64 + lane] = acc[r];
        __syncthreads();
        if (wid < 2) {
            F lf = f; f32x4 qd[2];
#pragma unroll
            for (int e = 0; e < 2; ++e) { float t[4];
#pragma unroll
                for (int c = 0; c < 4; ++c) { const int r = 4 * (2 * wid + e) + c; float a = 0.f;
#pragma unroll
                    for (int w = 0; w < 8; ++w) a += ((LAS float*)lds)[w * 1024 + r * 64 + lane];
                    t[c] = a; }
                qd[e] = (f32x4){t[0], t[1], t[2], t[3]}; }
            const int row = rowbase + row0 + r32;
            lf.row_begin(row);
#pragma unroll
            for (int e = 0; e < 2; ++e) lf.quad(row, col0 + 8 * (2 * wid + e) + 4 * hi, qd[e], qd[e ^ 1]);
            if constexpr (F::STATS) { float s = lf.s, q = lf.q; s += __shfl_xor(s, 32); q += __shfl_xor(q, 32); if (hi == 0) lf.commit(row, s, q); }
        }
        __syncthreads();
    }
}

namespace att {
#define KSWZ(row, colB) ((row) * 256 + ((colB) ^ (((row) & 7) << 4)))
#define SBAR() __builtin_amdgcn_sched_barrier(0)
__device__ __forceinline__ int v_st(int k, int c) { const int kk = (k & ~0xC) | ((k & 4) << 1) | ((k & 8) >> 1); return ((kk >> 3) * 4 + (c >> 5)) * 512 + ((kk & 7) * 32 + (c & 31)) * 2; }
__device__ __forceinline__ int v_rd_base(int lane) { return ((lane & 3) << 3) | (((lane >> 2) & 3) << 6) | (((lane >> 4) & 1) << 5) | (((lane >> 5) & 1) << 8); }
constexpr int v_rd_off(int d0, int ks, int half) { return d0 * 512 + ks * 4096 + half * 2048; }
template <int OFF> __device__ __forceinline__ s16x4 tr_read(int vb) {
    s16x4 r; asm volatile("ds_read_b64_tr_b16 %0, %1 offset:%2" : "=&v"(r) : "v"(vb), "i"(OFF) : "memory"); return r;
}
template <int OFF> __device__ __forceinline__ bf16x8 lds_read128(int ad) {
    bf16x8 r; asm volatile("ds_read_b128 %0, %1 offset:%2" : "=&v"(r) : "v"(ad), "i"(OFF) : "memory"); return r;
}
template <int D0> __device__ __forceinline__ void pv_one(f32x16& od, int vb, bf16x8 pa0, bf16x8 pa1, bf16x8 pa2, bf16x8 pa3) {
    const s16x4 l0 = tr_read<v_rd_off(D0, 0, 0)>(vb), h0 = tr_read<v_rd_off(D0, 0, 1)>(vb), l1 = tr_read<v_rd_off(D0, 1, 0)>(vb), h1 = tr_read<v_rd_off(D0, 1, 1)>(vb);
    const s16x4 l2 = tr_read<v_rd_off(D0, 2, 0)>(vb), h2 = tr_read<v_rd_off(D0, 2, 1)>(vb), l3 = tr_read<v_rd_off(D0, 3, 0)>(vb), h3 = tr_read<v_rd_off(D0, 3, 1)>(vb);
    asm volatile("s_waitcnt lgkmcnt(0)" ::: "memory"); SBAR();
#define PK(L, H) (bf16x8){L[0], L[1], L[2], L[3], H[0], H[1], H[2], H[3]}
    od = __builtin_amdgcn_mfma_f32_32x32x16_bf16(PK(l0, h0), pa0, od, 0, 0, 0);
    od = __builtin_amdgcn_mfma_f32_32x32x16_bf16(PK(l1, h1), pa1, od, 0, 0, 0);
    od = __builtin_amdgcn_mfma_f32_32x32x16_bf16(PK(l2, h2), pa2, od, 0, 0, 0);
    od = __builtin_amdgcn_mfma_f32_32x32x16_bf16(PK(l3, h3), pa3, od, 0, 0, 0);
#undef PK
}
__device__ __forceinline__ void partialSM(f32x16& p0, f32x16& p1, float& m_reg, float& alpha, float C, float thr) {
    float pmax = p0[0];
#pragma unroll
    for (int r = 1; r < 16; ++r) pmax = fmaxf(pmax, p0[r]);
#pragma unroll
    for (int r = 0; r < 16; ++r) pmax = fmaxf(pmax, p1[r]);
    { auto rr = __builtin_amdgcn_permlane32_swap(__float_as_uint(pmax), __float_as_uint(pmax), false, false);
      pmax = fmaxf(__uint_as_float(rr[0]), __uint_as_float(rr[1])); }
    float mn;
    if (__all(pmax - m_reg <= thr)) { mn = m_reg; alpha = 1.f; }
    else { mn = fmaxf(m_reg, pmax); alpha = __builtin_amdgcn_exp2f((m_reg - mn) * C); m_reg = mn; }
    const float mnC = -mn * C;
#pragma unroll
    for (int r = 0; r < 16; ++r) p0[r] = __builtin_amdgcn_exp2f(fmaf(p0[r], C, mnC));
#pragma unroll
    for (int r = 0; r < 16; ++r) p1[r] = __builtin_amdgcn_exp2f(fmaf(p1[r], C, mnC));
}
__device__ __forceinline__ void finishSM(f32x16& p0, f32x16& p1, float alpha, float& l_reg, bf16x8& pa0, bf16x8& pa1, bf16x8& pa2, bf16x8& pa3) {
    float ps = 0;
#pragma unroll
    for (int r = 0; r < 16; ++r) ps += p0[r];
#pragma unroll
    for (int r = 0; r < 16; ++r) ps += p1[r];
    { auto rr = __builtin_amdgcn_permlane32_swap(__float_as_uint(ps), __float_as_uint(ps), false, false);
      ps = __uint_as_float(rr[0]) + __uint_as_float(rr[1]); }
    l_reg = l_reg * alpha + ps;
#define PK4(P, BASE, OUT) do { unsigned a0 = cvtpk(P[BASE + 0], P[BASE + 1]), a1 = cvtpk(P[BASE + 2], P[BASE + 3]);   \
    unsigned b0 = cvtpk(P[BASE + 4], P[BASE + 5]), b1 = cvtpk(P[BASE + 6], P[BASE + 7]);                              \
    auto r0 = __builtin_amdgcn_permlane32_swap(a0, b0, false, false); auto r1 = __builtin_amdgcn_permlane32_swap(a1, b1, false, false); \
    u32x4 w = {r0[0], r1[0], r0[1], r1[1]}; OUT = *reinterpret_cast<bf16x8*>(&w); } while (0)
    PK4(p0, 0, pa0); PK4(p0, 8, pa1); PK4(p1, 0, pa2); PK4(p1, 8, pa3);
#undef PK4
}
constexpr int RING = 32768;
template <int QS, bool PVHALF>
__device__ __forceinline__ void attn_core(LAS unsigned char* lds, const bf16_t* Kb, long ldk, const bf16_t* Vb, long ldv, int NT, int nkeys,
                                          const bf16_t* qptr, int wNT, int kcoffB, int pvsel, float C, float thr, f32x16 (&o)[4], float& m_reg, float& l_reg) {
    const int tid = threadIdx.x, lane = tid & 63, r32 = lane & 31, hi = lane >> 5, wid = __builtin_amdgcn_readfirstlane(tid >> 6);
    bf16x8 qr[QS];
#pragma unroll
    for (int d0 = 0; d0 < QS; ++d0) qr[d0] = *(const bf16x8*)(qptr + d0 * 16);
#pragma unroll
    for (int d = 0; d < 4; ++d) o[d] = f32x16{};
    m_reg = -1e30f; l_reg = 0.f;
    long offK[2], offV[2];
#pragma unroll
    for (int i = 0; i < 2; ++i) { const int p = i * 8192 + wid * 1024 + lane * 16;
        const int row = p >> 8, colB = (p & 255) ^ ((row & 7) << 4); offK[i] = (long)row * ldk + (colB >> 1);
        const int sub = p >> 9, q = (p & 511) >> 1, kk = (sub >> 2) * 8 + (q >> 5), k = (kk & ~0xC) | ((kk & 4) << 1) | ((kk & 8) >> 1), c = (sub & 3) * 32 + (q & 31);
        offV[i] = (long)k * ldv + c; }
    const int vrb = v_rd_base(lane);
#define GLDS(t, bf) do { const bf16_t* kt_ = Kb + (long)(t) * 64 * ldk; const bf16_t* vt_ = Vb + (long)(t) * 64 * ldv; LAS unsigned char* b_ = lds + (bf) * RING + wid * 1024; \
    __builtin_amdgcn_global_load_lds((const unsigned*)(vt_ + offV[0]), (LAS unsigned*)(b_), 16, 0, 0); \
    __builtin_amdgcn_global_load_lds((const unsigned*)(vt_ + offV[1]), (LAS unsigned*)(b_ + 8192), 16, 0, 0); \
    __builtin_amdgcn_global_load_lds((const unsigned*)(kt_ + offK[0]), (LAS unsigned*)(b_ + 16384), 16, 0, 0); \
    __builtin_amdgcn_global_load_lds((const unsigned*)(kt_ + offK[1]), (LAS unsigned*)(b_ + 16384 + 8192), 16, 0, 0); } while (0)
    GLDS(0, 0);
#pragma unroll
    for (int d0 = 0; d0 < QS; ++d0) asm volatile("" :: "v"(qr[d0]));
    if (1 < NT) GLDS(1, 1); if (2 < NT) GLDS(2, 2);
    for (int j = 0; j < NT; ++j) {
        const int rem = NT - 1 - j;
        if (rem >= 2) asm volatile("s_waitcnt vmcnt(8)" ::: "memory"); else if (rem == 1) asm volatile("s_waitcnt vmcnt(4)" ::: "memory"); else asm volatile("s_waitcnt vmcnt(0)" ::: "memory");
        __builtin_amdgcn_s_barrier();
        asm volatile("" ::: "memory");
        if (j + 3 < NT) GLDS(j + 3, (j + 3) & 3);
        if (j < wNT) {
            const int cur = j & 3;
            f32x16 p0 = f32x16{}, p1 = f32x16{};
            const int kbase = (int)(uintptr_t)(lds + cur * RING + 16384) + r32 * 256;
            const int swz = (r32 & 7) << 4;
#pragma unroll
            for (int hq = 0; hq < QS / 4; ++hq) { bf16x8 b0[4], b1[4];
#pragma unroll
                for (int i = 0; i < 4; ++i) { const int cb = kcoffB + ((hq * 4 + i) * 16 + hi * 8) * 2; const int ad = kbase + (cb ^ swz);
                    b0[i] = lds_read128<0>(ad); b1[i] = lds_read128<8192>(ad); }
                asm volatile("s_waitcnt lgkmcnt(0)" ::: "memory"); SBAR();
#pragma unroll
                for (int i = 0; i < 4; ++i) { p0 = __builtin_amdgcn_mfma_f32_32x32x16_bf16(b0[i], qr[hq * 4 + i], p0, 0, 0, 0);
                    p1 = __builtin_amdgcn_mfma_f32_32x32x16_bf16(b1[i], qr[hq * 4 + i], p1, 0, 0, 0); } }
            if ((j + 1) * 64 > nkeys) { const int kb = j * 64 + 4 * hi;
#pragma unroll
                for (int r = 0; r < 16; ++r) { const int kv = kb + (r & 3) + 8 * (r >> 2); if (kv >= nkeys) p0[r] = -1e30f; if (kv + 32 >= nkeys) p1[r] = -1e30f; } }
            float alpha; bf16x8 pa0, pa1, pa2, pa3;
            partialSM(p0, p1, m_reg, alpha, C, thr);
            finishSM(p0, p1, alpha, l_reg, pa0, pa1, pa2, pa3);
            if (__any(alpha < 1.f)) {
#pragma unroll
                for (int d = 0; d < (PVHALF ? 2 : 4); ++d)
#pragma unroll
                    for (int r = 0; r < 16; ++r) o[d][r] *= alpha; }
            const int vb = (int)(uintptr_t)(lds + cur * RING) + vrb;
            if constexpr (!PVHALF) { pv_one<0>(o[0], vb, pa0, pa1, pa2, pa3); pv_one<1>(o[1], vb, pa0, pa1, pa2, pa3); pv_one<2>(o[2], vb, pa0, pa1, pa2, pa3); pv_one<3>(o[3], vb, pa0, pa1, pa2, pa3); }
            else { if (pvsel == 0) { pv_one<0>(o[0], vb, pa0, pa1, pa2, pa3); pv_one<1>(o[1], vb, pa0, pa1, pa2, pa3); }
                   else { pv_one<2>(o[0], vb, pa0, pa1, pa2, pa3); pv_one<3>(o[1], vb, pa0, pa1, pa2, pa3); } }
        }
    }
#undef GLDS
    __syncthreads();
}

struct Ctx { LAS unsigned char* lds; int lane, wid, r32, hi; };

template <int ND> __device__ __forceinline__ void store_gated(const f32x16 (&o)[4], float scale, const bf16_t* gate, bf16_t* out, int hi) {
#pragma unroll
    for (int d = 0; d < ND; ++d)
#pragma unroll
        for (int g = 0; g < 4; ++g) { const int dv = 32 * d + 8 * g + 4 * hi;
            const u32x2 gt = *(const u32x2*)(gate + dv);
            f32x4 v; v.x = o[d][4 * g] * scale * silu(bflo(gt.x)); v.y = o[d][4 * g + 1] * scale * silu(bfhi(gt.x));
            v.z = o[d][4 * g + 2] * scale * silu(bflo(gt.y)); v.w = o[d][4 * g + 3] * scale * silu(bfhi(gt.y));
            st_bf4(out + dv, v); }
}

__device__ __forceinline__ void diff_unit(const Ctx& cx, bool samp, int b, int h, int qb, const bf16_t* PA, const bf16_t* KS, const bf16_t* VS, bf16_t* MIX, const float* gnorm, float lam) {
    const int c = cx.wid >> 2, rb = cx.wid & 3;
    long row; bool valid; int NT, wNT, nkeys; const bf16_t* Kb; const bf16_t* Vb; long ldk;
    if (!samp) { row = (long)b * 4096 + qb * 128 + rb * 32 + cx.r32; valid = true; NT = 2 * qb + 2; wNT = 2 * qb + 1 + (rb >> 1); nkeys = NT * 64;
                 Kb = PA + (size_t)b * 4096 * NA + 512 + h * 128; Vb = Kb + 512; ldk = NA; }
    else { row = NP + b * 16 + (cx.r32 < 15 ? cx.r32 : 15); valid = (rb == 0) && cx.r32 < 16; NT = 65; wNT = (rb == 0) ? 65 : 0; nkeys = 4112;
           Kb = KS + (size_t)b * KSROWS * 512 + h * 128; Vb = VS + (size_t)b * KSROWS * 512 + h * 128; ldk = 512; }
    const bf16_t* qptr = PA + (size_t)row * NA + h * 128 + c * 64 + cx.hi * 8;
    f32x16 o[4]; float m, l;
    attn_core<4, false>(cx.lds, Kb, ldk, Vb, ldk, NT, nkeys, qptr, wNT, c * 128, 0, C64, THR64, o, m, l);
    const float inv = l > 0.f ? 1.f / l : 0.f;
    LAS float* xch = (LAS float*)cx.lds + rb * 4096;
    if (c == 1) {
#pragma unroll
        for (int d = 0; d < 4; ++d)
#pragma unroll
            for (int r = 0; r < 16; ++r) xch[(d * 16 + r) * 64 + cx.lane] = o[d][r] * inv; }
    __syncthreads();
    if (c == 0) {
        float ss = 0.f;
#pragma unroll
        for (int d = 0; d < 4; ++d)
#pragma unroll
            for (int r = 0; r < 16; ++r) { const float od = o[d][r] * inv - lam * xch[(d * 16 + r) * 64 + cx.lane]; o[d][r] = od; ss += od * od; }
        ss += __shfl_xor(ss, 32);
        const float rms = rsqrtf(ss * (1.f / 128.f) + 1e-5f) * 0.8f;
        if (valid) {
            const bf16_t* gate = PA + (size_t)row * NA + 1536 + h * 128; bf16_t* out = MIX + (size_t)row * DM + h * 128;
#pragma unroll
            for (int d = 0; d < 4; ++d)
#pragma unroll
                for (int g = 0; g < 4; ++g) { const int dv = 32 * d + 8 * g + 4 * cx.hi;
                    const f32x4 gn = *(const f32x4*)(gnorm + dv); const u32x2 gt = *(const u32x2*)(gate + dv);
                    f32x4 v; v.x = o[d][4 * g] * rms * gn.x * silu(bflo(gt.x)); v.y = o[d][4 * g + 1] * rms * gn.y * silu(bfhi(gt.x));
                    v.z = o[d][4 * g + 2] * rms * gn.z * silu(bflo(gt.y)); v.w = o[d][4 * g + 3] * rms * gn.w * silu(bfhi(gt.y));
                    st_bf4(out + dv, v); }
        }
    }
    __syncthreads();
}
__device__ __forceinline__ void mem_unit(const Ctx& cx, bool samp, int b, int h, int qb, const bf16_t* P, int ldp, int qcol, int gcol,
                                         const bf16_t* Kb, const bf16_t* Vb, long ldk, bf16_t* MIX) {
    long row; bool valid; int wNT;
    if (!samp) { row = (long)b * 4096 + qb * 256 + cx.wid * 32 + cx.r32; valid = true; wNT = 4; }
    else { row = NP + b * 16 + (cx.r32 < 15 ? cx.r32 : 15); valid = (cx.wid == 0) && cx.r32 < 16; wNT = (cx.wid == 0) ? 4 : 0; }
    const bf16_t* qptr = P + (size_t)row * ldp + qcol + h * 128 + cx.hi * 8;
    f32x16 o[4]; float m, l;
    attn_core<8, false>(cx.lds, Kb, ldk, Vb, ldk, 4, 256, qptr, wNT, 0, 0, C128, THR128, o, m, l);
    const float inv = l > 0.f ? 1.f / l : 0.f;
    if (valid) store_gated<4>(o, inv, P + (size_t)row * ldp + gcol + h * 128, MIX + (size_t)row * DM + 512 + h * 128, cx.hi);
}
__device__ __forceinline__ void swa_unit(const Ctx& cx, bool samp, int b, int c, int half, const bf16_t* PB, const bf16_t* KSW, const bf16_t* VSW, bf16_t* MIX, const float* sinks) {
    const int head = cx.wid, kv = cx.wid >> 2;
    long row; bool valid; int NT, nkeys; const bf16_t* Kb; const bf16_t* Vb; long ldk;
    if (!samp) { row = (long)b * 4096 + c * 64 + half * 32 + cx.r32; valid = true; const int c0 = c > 2 ? c - 2 : 0; NT = c - c0 + 1; nkeys = NT * 64;
                 Kb = PB + ((size_t)b * 4096 + c0 * 64) * NB + 2048; Vb = Kb + 128; ldk = NB; }
    else { row = NP + b * 16 + (cx.r32 < 15 ? cx.r32 : 15); valid = cx.r32 < 16; NT = 3; nkeys = 144;
           Kb = KSW + (size_t)b * SWROWS * 128; Vb = VSW + (size_t)b * SWROWS * 128; ldk = 128; }
    const bf16_t* qptr = PB + (size_t)row * NB + head * 64 + cx.hi * 8;
    f32x16 o[4]; float m, l;
    attn_core<4, true>(cx.lds, Kb, ldk, Vb, ldk, NT, nkeys, qptr, NT, kv * 128, kv, C64, THR64, o, m, l);
    const float lt = l + __builtin_amdgcn_exp2f(sinks[head] * LOG2E - m * C64);
    const float inv = 1.f / lt;
    if (valid) store_gated<2>(o, inv, PB + (size_t)row * NB + 512 + head * 64, MIX + (size_t)row * DM + head * 64, cx.hi);
}
#undef KSWZ
#undef SBAR
}

__device__ __forceinline__ float wave_sum(float v) {
#pragma unroll
    for (int o = 1; o < 64; o <<= 1) v += __shfl_xor(v, o);
    return v;
}
__device__ __forceinline__ void p0_transpose_item(const float* W, int K, int N, bf16_t* WT, int row_off, LAS float* scr, int item, int lane) {
    const int nblk = N / 32, kb = item / nblk, nb = item % nblk, k0 = 64 * kb, n0 = 32 * nb;
#pragma unroll 8
    for (int i = 0; i < 32; ++i) { const int kk = 2 * i + (lane >> 5); scr[kk * 33 + (lane & 31)] = W[(size_t)(k0 + kk) * N + n0 + (lane & 31)]; }
    asm volatile("s_waitcnt lgkmcnt(0)" ::: "memory");
    const int c = lane & 7;
#pragma unroll
    for (int j = 0; j < 4; ++j) { const int n = (lane >> 3) + 8 * j; const LAS float* s = scr + (8 * c) * 33 + n;
        u32x4 o; o.x = cvtpk(s[0 * 33], s[1 * 33]); o.y = cvtpk(s[2 * 33], s[3 * 33]); o.z = cvtpk(s[4 * 33], s[5 * 33]); o.w = cvtpk(s[6 * 33], s[7 * 33]);
        *(u32x4*)(WT + (size_t)(row_off + n0 + n) * K + k0 + 8 * c) = o; }
    asm volatile("s_waitcnt lgkmcnt(0)" ::: "memory");
}
__device__ __forceinline__ void p0_transpose_item_ln(const float* W, int K, int N, bf16_t* WT, int row_off, LAS float* scr, int item, int lane, const float* g, const float* b, float* CS, float* BW) {
    const int nblk = N / 32, kb = item / nblk, nb = item % nblk, k0 = 64 * kb, n0 = 32 * nb;
    float csp = 0.f, bwp = 0.f;
#pragma unroll 8
    for (int i = 0; i < 32; ++i) { const int kk = 2 * i + (lane >> 5); const float w = W[(size_t)(k0 + kk) * N + n0 + (lane & 31)]; const float gw = g[k0 + kk] * w;
        scr[kk * 33 + (lane & 31)] = gw; csp += bflo(cvtpk(gw, 0.f)); bwp += b[k0 + kk] * w; }
    csp += __shfl_xor(csp, 32); bwp += __shfl_xor(bwp, 32);
    if (lane < 32) { atomicAdd(CS + row_off + n0 + lane, csp); atomicAdd(BW + row_off + n0 + lane, bwp); }
    asm volatile("s_waitcnt lgkmcnt(0)" ::: "memory");
    const int c = lane & 7;
#pragma unroll
    for (int j = 0; j < 4; ++j) { const int n = (lane >> 3) + 8 * j; const LAS float* sp = scr + (8 * c) * 33 + n;
        u32x4 o; o.x = cvtpk(sp[0 * 33], sp[1 * 33]); o.y = cvtpk(sp[2 * 33], sp[3 * 33]); o.z = cvtpk(sp[4 * 33], sp[5 * 33]); o.w = cvtpk(sp[6 * 33], sp[7 * 33]);
        *(u32x4*)(WT + (size_t)(row_off + n0 + n) * K + k0 + 8 * c) = o; }
    asm volatile("s_waitcnt lgkmcnt(0)" ::: "memory");
}
__device__ __forceinline__ void ln_rows(const float* zin, float* fout, bf16_t* bout, const float* g, const float* bta, int gw, int NGW, int lane) {
    f32x4 g4[4], b4[4];
#pragma unroll
    for (int j = 0; j < 4; ++j) { g4[j] = *(const f32x4*)(g + 4 * lane + 256 * j); b4[j] = *(const f32x4*)(bta + 4 * lane + 256 * j); }
    for (int m = gw; m < MA; m += NGW) {
        const float* zr = zin + (size_t)m * DM + 4 * lane;
        f32x4 v[4]; float s = 0.f;
#pragma unroll
        for (int j = 0; j < 4; ++j) { v[j] = *(const f32x4*)(zr + 256 * j); s += (v[j].x + v[j].y) + (v[j].z + v[j].w); }
        const float mean = wave_sum(s) * (1.f / DM); float s2 = 0.f;
#pragma unroll
        for (int j = 0; j < 4; ++j) { v[j] = v[j] - mean; s2 += (v[j].x * v[j].x + v[j].y * v[j].y) + (v[j].z * v[j].z + v[j].w * v[j].w); }
        const float rstd = rsqrtf(wave_sum(s2) * (1.f / DM) + 1e-5f);
#pragma unroll
        for (int j = 0; j < 4; ++j) { const f32x4 y = v[j] * rstd * g4[j] + b4[j];
            *(f32x4*)(fout + (size_t)m * DM + 4 * lane + 256 * j) = y;
            if (bout) st_bf4(bout + (size_t)m * DM + 4 * lane + 256 * j, y); }
    }
}

#define XB_TMO      128
#define XB_XCNT(j)  (256  + 64 * (j))
#define XB_XSUB(j)  (1280 + 64 * (j))
#define XB_XGEN(j)  (2304 + 64 * (j))
#define XB_TOP      3328
#define XB_TOPGEN   3392
#define XCD_BAR_WORDS 3456
#define XB_SPIN_CAP (1u << 18)

__device__ __forceinline__ unsigned xb_ld(unsigned* p)              { return __hip_atomic_load(p, __ATOMIC_RELAXED, __HIP_MEMORY_SCOPE_AGENT); }
__device__ __forceinline__ unsigned xb_add(unsigned* p, unsigned v) { return __hip_atomic_fetch_add(p, v, __ATOMIC_RELAXED, __HIP_MEMORY_SCOPE_AGENT); }
__device__ __forceinline__ unsigned xb_xcc_id() { return (unsigned)__builtin_amdgcn_s_getreg((3 << 11) | 20) & 0xFu; }
#define XB_SPIN(cond, bar) do { unsigned _sp = 0; while (cond) { __builtin_amdgcn_s_sleep(1); \
    if ((++_sp & 255u) == 0u) { if (xb_ld(&(bar)[XB_TMO])) break; if (_sp > XB_SPIN_CAP) { atomicAdd(&(bar)[XB_TMO], 1u); break; } } } } while (0)

struct XcdBarrier {
    unsigned* bar; unsigned x;
    volatile LAS unsigned* st;
};

__device__ __forceinline__ XcdBarrier xcd_barrier_post(unsigned* bar, volatile LAS unsigned* st) {
    XcdBarrier b; b.bar = bar; b.x = xb_xcc_id(); b.st = st;
    if (threadIdx.x == 0) (void)xb_add(&bar[XB_XCNT(b.x)], 1u);
    return b;
}
__device__ __forceinline__ void xcd_barrier_complete(unsigned* bar, unsigned x, unsigned& nloc, unsigned& nx) {
    const unsigned G = gridDim.x * gridDim.y * gridDim.z;
    unsigned sum, cnt, mine, sp = 0u;
    for (;;) {
        sum = 0u; cnt = 0u; mine = 0u;
#pragma unroll
        for (unsigned j = 0; j < 16; ++j) { const unsigned c = xb_ld(&bar[XB_XCNT(j)]); sum += c; cnt += (c > 0u) ? 1u : 0u; mine = (j == x) ? c : mine; }
        if (sum == G) break;
        __builtin_amdgcn_s_sleep(1);
        if ((++sp & 255u) == 0u) { if (xb_ld(&bar[XB_TMO])) break; if (sp > XB_SPIN_CAP) { atomicAdd(&bar[XB_TMO], 1u); break; } }
    }
    nloc = mine > 0u ? mine : 1u; nx = cnt > 0u ? cnt : 1u;
}

__device__ __forceinline__ void xcd_barrier(const XcdBarrier& b) {
    asm volatile("s_waitcnt vmcnt(0)" ::: "memory");
    __syncthreads();
    if (threadIdx.x == 0) {
        unsigned* bar = b.bar;
        __builtin_amdgcn_s_waitcnt(0);
        unsigned nloc = b.st[0], nx = b.st[1];
        if (nloc == 0u) { xcd_barrier_complete(bar, b.x, nloc, nx); b.st[0] = nloc; b.st[1] = nx; }
        const unsigned old = xb_add(&bar[XB_XSUB(b.x)], 1u);
        const unsigned gen = old / nloc;
        if (old + 1u == (gen + 1u) * nloc) {
            __builtin_amdgcn_fence(__ATOMIC_RELEASE, "agent");
            asm volatile("s_waitcnt vmcnt(0)" ::: "memory");
            const unsigned og = xb_add(&bar[XB_TOP], 1u);
            const unsigned tg = og / nx;
            if (og + 1u == (tg + 1u) * nx) xb_add(&bar[XB_TOPGEN], 1u);
            else XB_SPIN(xb_ld(&bar[XB_TOPGEN]) == tg, bar);
            __builtin_amdgcn_fence(__ATOMIC_ACQUIRE, "agent");
            xb_add(&bar[XB_XGEN(b.x)], 1u);
            asm volatile("s_waitcnt vmcnt(0)" ::: "memory");
        } else {
            XB_SPIN(xb_ld(&bar[XB_XGEN(b.x)]) == gen, bar);
            __builtin_amdgcn_fence(__ATOMIC_ACQUIRE, "agent");
            asm volatile("s_waitcnt vmcnt(0)" ::: "memory");
        }
    }
    __syncthreads();
}

struct Args { const float* in[22]; float* out; unsigned char* ws; int ph_lo, ph_hi, rep, pad; };
constexpr int NWAVES = 8, NPHASE = 9;

__global__ void __launch_bounds__(NWAVES * 64, 2) yoco_fwd(Args a) {
    extern __shared__ __attribute__((aligned(16))) unsigned char lds_raw[];
    LAS unsigned char* lds = (LAS unsigned char*)lds_raw;
    volatile LAS unsigned* MISC = (volatile LAS unsigned*)(lds + LDS_RING);
    cg::grid_group grid = cg::this_grid();
    const int tid = threadIdx.x, lane = tid & 63, wave = __builtin_amdgcn_readfirstlane(tid >> 6);
    const int G = gridDim.x, gw = blockIdx.x * NWAVES + wave, NGW = G * NWAVES;
    const long gtid = (long)blockIdx.x * (NWAVES * 64) + tid, NTHR = (long)G * (NWAVES * 64);
    unsigned char* ws = a.ws; float* dout = a.out;
    unsigned* ctl = (unsigned*)(ws + WS_CTL);
    float* ROPE = (float*)(ws + WS_ROPE);
    float* CSV = (float*)(ws + 32768); float* BWV = (float*)(ws + 49152); float* ST0 = (float*)(ws + 262144); float* ST1 = (float*)(ws + 524288);
    bf16_t* WA_t = (bf16_t*)(ws + WS_WA); bf16_t* WB_t = (bf16_t*)(ws + WS_WB); bf16_t* WM_t = (bf16_t*)(ws + WS_WM); bf16_t* WO_t = (bf16_t*)(ws + WS_WO);
    bf16_t* MEMB = (bf16_t*)(ws + WS_MEMB); bf16_t* MKV = (bf16_t*)(ws + WS_MKV); bf16_t* CMK = (bf16_t*)(ws + WS_CMK); bf16_t* CMV = (bf16_t*)(ws + WS_CMV);
    bf16_t* KSW = (bf16_t*)(ws + WS_KSW); bf16_t* VSW = (bf16_t*)(ws + WS_VSW); bf16_t* XA = (bf16_t*)(ws + WS_XA); bf16_t* ZB = XA;
    bf16_t* MIX = (bf16_t*)(ws + WS_MIX); float* Z0 = (float*)(ws + WS_Z0); bf16_t* PA = (bf16_t*)(ws + WS_PA); bf16_t* PB = PA;
    bf16_t* KS = (bf16_t*)(ws + WS_KS); bf16_t* VS = (bf16_t*)(ws + WS_VS);
    const int lo = a.ph_lo, hi_ph = a.ph_hi;
#define IN(k) (lo <= (k) && (k) < hi_ph)
    if (tid < 64) MISC[tid] = 0u;
    __syncthreads();
    XcdBarrier xbar = xcd_barrier_post(ctl + 1024, MISC + 8);
#define SEAM(k) do { if (IN(k) && IN((k) + 1)) { if ((k) == 0) grid.sync(); else xcd_barrier(xbar); } } while (0)
    att::Ctx cx; cx.lds = lds; cx.lane = lane; cx.wid = wave; cx.r32 = lane & 31; cx.hi = lane >> 5;

    if (IN(0)) {
        LAS float* scr = (LAS float*)(lds + wave * 16384);
        for (int it = gw; it < 4736; it += NGW) {
            int r = it;
            if (r < 1536) { p0_transpose_item(a.in[9], DM, NA, WA_t, 0, scr, r, lane); continue; } r -= 1536;
            if (r < 1024) { p0_transpose_item_ln(a.in[15], DM, 2048, WB_t, 0, scr, r, lane, a.in[20], a.in[21], CSV, BWV); continue; } r -= 1024;
            if (r < 128) { p0_transpose_item_ln(a.in[17], DM, 256, WB_t, 2048, scr, r, lane, a.in[20], a.in[21], CSV, BWV); continue; } r -= 128;
            if (r < 1024) { const int l = r >> 9; p0_transpose_item(a.in[18] + (size_t)l * DM * DM, DM, DM, WM_t, l * 1024, scr, r & 511, lane); continue; } r -= 1024;
            { const int l = r >> 9; p0_transpose_item(a.in[19] + (size_t)l * DM * DM, DM, DM, WO_t, l * 1024, scr, r & 511, lane); }
        }
        for (long i = gtid; i < 2097152; i += NTHR) cvt8(a.in[0] + i * 8, XA + i * 8);
        for (long i = gtid; i < 32768; i += NTHR) cvt8(a.in[1] + i * 8, XA + (size_t)NP * DM + i * 8);
        for (long i = gtid; i < 131072; i += NTHR) cvt8(a.in[2] + i * 8, MEMB + i * 8);
        for (long i = gtid; i < 4194304; i += NTHR) { const long b = i >> 18, r = i & 262143; const size_t d = (size_t)b * KSROWS * 512 + r * 8;
            cvt8(a.in[3] + i * 8, KS + d); cvt8(a.in[4] + i * 8, VS + d); }
        for (long i = gtid; i < 524288; i += NTHR) { cvt8(a.in[7] + i * 8, CMK + i * 8); cvt8(a.in[8] + i * 8, CMV + i * 8); }
        for (long i = gtid; i < 32768; i += NTHR) { const long b = i >> 11, r = i & 2047; const size_t d = (size_t)b * SWROWS * 128 + r * 8;
            cvt8(a.in[5] + i * 8, KSW + d); cvt8(a.in[6] + i * 8, VSW + d);
            const int rw = (int)(r >> 4);
            if (rw >= 16) { const size_t od = ((size_t)b * 128 + rw - 16) * 128 + (r & 15) * 8;
                *(f32x4*)(dout + OFF_SKS + od) = *(const f32x4*)(a.in[5] + i * 8); *(f32x4*)(dout + OFF_SKS + od + 4) = *(const f32x4*)(a.in[5] + i * 8 + 4);
                *(f32x4*)(dout + OFF_SVS + od) = *(const f32x4*)(a.in[6] + i * 8); *(f32x4*)(dout + OFF_SVS + od + 4) = *(const f32x4*)(a.in[6] + i * 8 + 4); } }
        for (long i = gtid; i < 49152; i += NTHR) { const long b = i / 3072, r = i % 3072; const size_t d = ((size_t)b * KSROWS + 4112) * 512 + r * 8;
            *(u32x4*)(KS + d) = (u32x4){0u, 0u, 0u, 0u}; *(u32x4*)(VS + d) = (u32x4){0u, 0u, 0u, 0u}; }
        for (long i = gtid; i < 12288; i += NTHR) { const long b = i / 768, r = i % 768; const size_t d = ((size_t)b * SWROWS + 144) * 128 + r * 8;
            *(u32x4*)(KSW + d) = (u32x4){0u, 0u, 0u, 0u}; *(u32x4*)(VSW + d) = (u32x4){0u, 0u, 0u, 0u}; }
        for (long i = gtid; i < 4112 * 8; i += NTHR) { const int pos = (int)(i >> 3), fi = (int)(i & 7);
            const double inv = fi == 0 ? 1.0 : fi == 1 ? 0.19392274474868576 : fi == 2 ? 0.03760603093086393 : fi == 3 ? 0.007292664737217109 :
                               fi == 4 ? 0.001414213562373095 : fi == 5 ? 0.0002742481756762073 : fi == 6 ? 5.318295896944988e-05 : 1.031338537721246e-05;
            const double rev = (double)pos * inv * 0.15915494309189535; const float fr = (float)(rev - __builtin_rint(rev));
            ROPE[i * 2] = __builtin_amdgcn_cosf(fr); ROPE[i * 2 + 1] = __builtin_amdgcn_sinf(fr); }
    }
    SEAM(0);
    if (IN(1)) {
        { pg8::Gemm g{MEMB, WM_t, 1024, 2048, DM}; pg8::StaticOrder S; S.init(1024, 2048, G, (int)((blockIdx.x + G / 2) % G));
          EpiWrap<EpiMemF> E{{MKV, dout, 0.f, 0.f}};
          pg8::gemm_phase<EpiWrap<EpiMemF>, pg8::StaticOrder, true, true>(lds, g, S, E); }
        { pg8::Gemm g{XA, WA_t, MA, NA, DM}; pg8::StaticOrder S; S.init(MA, NA, G, (int)blockIdx.x);
          EpiWrap<EpiAF> E{{PA, dout, KS, VS, ROPE, 0.f, 0.f}};
          pg8::gemm_phase<EpiWrap<EpiAF>, pg8::StaticOrder, true, true>(lds, g, S, E); }
    }
    SEAM(1);
    if (IN(2)) {
        float s1 = 0.f, s2 = 0.f;
        for (int i = 0; i < 64; ++i) { s1 += a.in[10][i] * a.in[11][i]; s2 += a.in[12][i] * a.in[13][i]; }
        const float lam = __expf(s1) - __expf(s2) + 0.2f;
        for (;;) {
            if (tid == 0) MISC[0] = atomicAdd(ctl + 128 * a.rep, 1u);
            __syncthreads(); const unsigned u = MISC[0]; __syncthreads();
            if (u >= 896u) break;
            if (u < 576u) { const bool samp = u < 64u; const unsigned v = samp ? u : u - 64u;
                const int b = samp ? (int)(v >> 2) : (int)((v & 15u) >> 2), h = (int)(v & 3u), qb = samp ? 0 : 31 - (int)(v >> 4);
                att::diff_unit(cx, samp, b, h, qb, PA, KS, VS, MIX, a.in[14], lam); }
            else { const bool samp = u >= 832u; const unsigned v = samp ? u - 832u : u - 576u;
                const int b = samp ? (int)(v >> 2) : (int)(v >> 6), h = samp ? (int)(v & 3u) : (int)((v >> 4) & 3u), qb = samp ? 0 : (int)(v & 15u);
                const bf16_t* Kb = samp ? CMK + ((size_t)b * 256) * 512 + h * 128 : MKV + ((size_t)b * 256) * 2048 + h * 128;
                const bf16_t* Vb = samp ? CMV + ((size_t)b * 256) * 512 + h * 128 : Kb + 512;
                att::mem_unit(cx, samp, b, h, qb, PA, NA, 2048, 2560, Kb, Vb, samp ? 512 : 2048, MIX); }
        }
    }
    SEAM(2);
    if (IN(3)) {
        EpiMerge0F F0{a.in[0], a.in[1], Z0, ZB, ST0, 0.f, 0.f};
        { pg8::Gemm g{MIX, WO_t, NP, DM, DM}; pg8::StaticOrder S; S.init(NP, DM, G, (int)blockIdx.x);
          EpiWrap<EpiMerge0F> E{F0};
          pg8::gemm_phase<EpiWrap<EpiMerge0F>, pg8::StaticOrder, true, true>(lds, g, S, E); }
        gemm_small<EpiMerge0F>(lds, MIX + (size_t)NP * DM, WO_t, DM, NP, (int)blockIdx.x, G, F0);
    }
    SEAM(3);
    if (IN(5)) {
        EpiBF FB{PB, dout, KSW, VSW, ROPE, ST0, CSV, BWV, 0.f, 0.f, 0.f, 0.f};
        { pg8::Gemm g{ZB, WB_t, NP, NB, DM}; pg8::StaticOrder S; S.init(NP, NB, G, (int)blockIdx.x);
          EpiWrap<EpiBF> E{FB};
          pg8::gemm_phase<EpiWrap<EpiBF>, pg8::StaticOrder, true, true>(lds, g, S, E); }
        if (G == 256) { if (blockIdx.x >= 64) gemm_small<EpiBF>(lds, ZB + (size_t)NP * DM, WB_t, NB, NP, (int)blockIdx.x - 64, 192, FB); }
        else gemm_small<EpiBF>(lds, ZB + (size_t)NP * DM, WB_t, NB, NP, (int)blockIdx.x, G, FB);
    }
    SEAM(5);
    if (IN(6)) {
        for (;;) {
            if (tid == 0) MISC[0] = atomicAdd(ctl + 64 + 128 * a.rep, 1u);
            __syncthreads(); const unsigned u = MISC[0]; __syncthreads();
            if (u >= 848u) break;
            if (u < 320u) { const bool samp = u >= 256u; const unsigned v = samp ? u - 256u : u;
                const int b = samp ? (int)(v >> 2) : (int)(v >> 6), h = samp ? (int)(v & 3u) : (int)((v >> 4) & 3u), qb = samp ? 0 : (int)(v & 15u);
                const bf16_t* Kb = samp ? CMK + ((size_t)(16 + b) * 256) * 512 + h * 128 : MKV + ((size_t)b * 256) * 2048 + 1024 + h * 128;
                const bf16_t* Vb = samp ? CMV + ((size_t)(16 + b) * 256) * 512 + h * 128 : Kb + 512;
                att::mem_unit(cx, samp, b, h, qb, PB, NB, 1024, 1536, Kb, Vb, samp ? 512 : 2048, MIX); }
            else { const bool samp = u >= 832u; const unsigned v = samp ? u - 832u : u - 320u;
                const int b = samp ? (int)v : (int)(v >> 7), c = samp ? 0 : (int)((v >> 1) & 63u), half = samp ? 0 : (int)(v & 1u);
                att::swa_unit(cx, samp, b, c, half, PB, KSW, VSW, MIX, a.in[16]); }
        }
    }
    SEAM(6);
    if (IN(7)) {
        EpiMerge1F F1{Z0, ST0, a.in[20], a.in[21], dout, ST1, 0.f, 0.f, 0.f, 0.f};
        { pg8::Gemm g{MIX, WO_t + (size_t)DM * DM, NP, DM, DM}; pg8::StaticOrder S; S.init(NP, DM, G, (int)blockIdx.x);
          EpiWrap<EpiMerge1F> E{F1};
          pg8::gemm_phase<EpiWrap<EpiMerge1F>, pg8::StaticOrder, true, true>(lds, g, S, E); }
        gemm_small<EpiMerge1F>(lds, MIX + (size_t)NP * DM, WO_t + (size_t)DM * DM, DM, NP, (int)blockIdx.x, G, F1);
    }
    SEAM(7);
    if (IN(8)) {
        const float* g1 = a.in[20] + DM; const float* b1 = a.in[21] + DM;
#pragma unroll 4
        for (long i = gtid; i < (long)MA * 256; i += NTHR) { const int row = (int)(i >> 8), c4 = (int)(i & 255) * 4;
            float mu, rstd; row_stats(ST1, row, mu, rstd);
            float* zp = dout + (size_t)row * DM + c4;
            *(f32x4*)zp = (*(const f32x4*)zp - mu) * rstd * *(const f32x4*)(g1 + c4) + *(const f32x4*)(b1 + c4); }
    }
#undef IN
#undef SEAM
}

#ifndef MK_N_LAUNCHES
#define MK_N_LAUNCHES 1
#endif
#ifndef PROBE_DUP
#define PROBE_DUP 0
#endif
extern "C" void kernel_launch(void* const* d_in, const int* in_sizes, int n_in, void* d_out, int out_size, void* d_ws, size_t ws_size, hipStream_t stream) {
    static int grid = 0;
    if (grid == 0) {
        if (n_in != 22 || ws_size < WS_END) { fprintf(stderr, "kernel_launch: unexpected n_in %d / ws %zu\n", n_in, ws_size); grid = -1; return; }
        int dev = 0, cus = 0, per_cu = 0;
        if (hipGetDevice(&dev) != hipSuccess || hipDeviceGetAttribute(&cus, hipDeviceAttributeMultiprocessorCount, dev) != hipSuccess) { grid = -1; return; }
        if (hipFuncSetAttribute((const void*)yoco_fwd, hipFuncAttributeMaxDynamicSharedMemorySize, LDS_BYTES) != hipSuccess) { fprintf(stderr, "kernel_launch: hipFuncSetAttribute failed\n"); grid = -1; return; }
        if (hipOccupancyMaxActiveBlocksPerMultiprocessor(&per_cu, (const void*)yoco_fwd, NWAVES * 64, LDS_BYTES) != hipSuccess || per_cu < 1) { fprintf(stderr, "kernel_launch: occupancy query says %d\n", per_cu); per_cu = 1; }
        (void)hipGetLastError();
        grid = cus;
    }
    if (grid < 0) return;
    (void)hipMemsetAsync((char*)d_ws + WS_CTL, 0, 1048576, stream);
    Args a{};
    for (int i = 0; i < 22; ++i) a.in[i] = (const float*)d_in[i];
    a.out = (float*)d_out; a.ws = (unsigned char*)d_ws;
#if MK_N_LAUNCHES == 1
    a.ph_lo = 0; a.ph_hi = NPHASE;
    void* args[] = {&a};
    hipError_t e = hipLaunchCooperativeKernel((const void*)yoco_fwd, dim3(grid), dim3(NWAVES * 64), args, LDS_BYTES, stream);
    if (e != hipSuccess) fprintf(stderr, "kernel_launch: cooperative launch failed: %s (grid %d)\n", hipGetErrorString(e), grid);
#else
    for (int p = 0; p < NPHASE; ++p) { a.ph_lo = p; a.ph_hi = p + 1;
        for (int r = 0; r < 1 + ((PROBE_DUP >> p) & 1); ++r) { a.rep = r; hipLaunchKernelGGL(yoco_fwd, dim3(grid), dim3(NWAVES * 64), LDS_BYTES, stream, a); } }
#endif
}
```

```cpp
#include <hip/hip_runtime.h>
#include <hip/hip_cooperative_groups.h>
#include <cstdio>
#include <cstdint>
namespace cg = cooperative_groups;
namespace pg8 {
#define PG8_LAS __attribute__((address_space(3)))
typedef unsigned short bf16_t;
typedef short bf16x8 __attribute__((ext_vector_type(8)));
typedef float f32x4 __attribute__((ext_vector_type(4)));
typedef unsigned u32x4 __attribute__((ext_vector_type(4)));
constexpr int BM = 256, BK = 64, HALF = 128, HTB = HALF * BK * 2  , STAGE_BYTES = 8 * HTB, NXCD = 8, WGM = 8;

__host__ __device__ __forceinline__ int lds_byte(int r, int c) { const int st = (r >> 4) * 2 + (c >> 5), rr = r & 15, cc = c & 31, ob = rr * 64 + cc * 2; return st * 1024 + (ob ^ (((ob >> 9) & 1) << 5)); }
__host__ __device__ __forceinline__ void stage_rc(int b, int& R, int& C) { const int st = b / 1024, sb = b % 1024, swz = sb ^ (((sb >> 9) & 1) << 5); R = (st >> 1) * 16 + swz / 64; C = (st & 1) * 32 + (swz % 64) / 2; }
__host__ __device__ __forceinline__ int perm32(int rho) { const int n = rho >> 4, i = rho & 15; return 8 * (i >> 2) + 4 * n + (i & 3); }

struct Unit { int pm, pn; };
struct Gemm { const bf16_t* A; const bf16_t* Bt; int M, N, K; };

struct StaticOrder {
    int nM, nN, nwg, G, c;
    __host__ __device__ void init(int M, int N, int G_, int c_) { nM = M / BM; nN = N / BM; nwg = nM * nN; G = G_; c = c_; }
    __host__ __device__ bool next(int i, Unit& u) const {
        const long L = (long)i * G + c; if (L >= nwg) return false;
        int wgid = (int)L; { const int q = nwg / NXCD, r = nwg % NXCD, xcd = wgid % NXCD, off = wgid / NXCD; wgid = (xcd < r ? xcd * (q + 1) : r * (q + 1) + (xcd - r) * q) + off; }
        const int nig = WGM * nN, gid = wgid / nig, fm = gid * WGM, gsz = (nM - fm) < WGM ? (nM - fm) : WGM;
        u.pm = fm + ((wgid % nig) % gsz); u.pn = (wgid % nig) / gsz; return true;
    }
    __device__ __forceinline__ void a_ready(const Unit&) const {}
    __device__ __forceinline__ void done(const Unit&) const {}
};
__device__ __forceinline__ unsigned cvt_pk_bf16(float lo, float hi) { unsigned r; asm volatile("v_cvt_pk_bf16_f32 %0, %1, %2" : "=v"(r) : "v"(lo), "v"(hi)); return r; }
typedef float f32x2 __attribute__((ext_vector_type(2)));
template <class Epi, class Sched, bool ALIGN_EPI = false, bool SP2 = false>
__device__ __forceinline__ void gemm_phase(PG8_LAS unsigned char* lds, const Gemm g, const Sched& S, const Epi& E) {
    const int tid = threadIdx.x, wid = __builtin_amdgcn_readfirstlane(tid >> 6), lane = tid & 63, wr = wid >> 2, wc = wid & 3, fr = lane & 15, fq = lane >> 4;
    const int K = g.K, nt = K / BK;
    unsigned voffA[2], voffB[2];
#pragma unroll
    for (int i = 0; i < 2; ++i) { int R, C; stage_rc(tid * 16 + i * 8192, R, C); const int Rb = Epi::PERM ? ((R & ~31) + perm32(R & 31)) : R;
        voffA[i] = (unsigned)(R * K + C) * 2u; voffB[i] = (unsigned)(Rb * K + C) * 2u; }
    const size_t kstep = (size_t)(BK * 2);
    const size_t hstep = (size_t)HALF * K * 2;
    const size_t tstep = 2 * hstep;
    const unsigned ldsw = (unsigned)wid * 1024u;
    const int aoff = lds_byte(wr * 64 + fr, fq * 8), boff = lds_byte(wc * 32 + fr, fq * 8);
#define PG8_SA(b, h) (((b) * 2 + (h)) * HTB)
#define PG8_SB(b, h) ((4 + (b) * 2 + (h)) * HTB)
#define PG8_STAGE(bufoff, gbase, voff) do { _Pragma("unroll") for (int _i = 0; _i < 2; ++_i) \
        __builtin_amdgcn_global_load_lds((const unsigned*)((const char*)(gbase) + (voff)[_i]), (PG8_LAS unsigned*)(lds + (bufoff) + ldsw + _i * 8192), 16, 0, 0); } while (0)
#define PG8_LDA(dst, b, h) do { _Pragma("unroll") for (int m = 0; m < 4; ++m) _Pragma("unroll") for (int k = 0; k < 2; ++k) dst[m][k] = *(const PG8_LAS bf16x8*)(lds + PG8_SA(b, h) + aoff + m * 2048 + k * 1024); } while (0)
#define PG8_LDB(dst, b, h) do { _Pragma("unroll") for (int n = 0; n < 2; ++n) _Pragma("unroll") for (int k = 0; k < 2; ++k) dst[n][k] = *(const PG8_LAS bf16x8*)(lds + PG8_SB(b, h) + boff + n * 2048 + k * 1024); } while (0)
#define PG8_MMA(ai, bj, At, Bt) do { __builtin_amdgcn_s_setprio(1); _Pragma("unroll") for (int m = 0; m < 4; ++m) _Pragma("unroll") for (int n = 0; n < 2; ++n) _Pragma("unroll") for (int k = 0; k < 2; ++k) \
        acc[ai][bj][m][n] = __builtin_amdgcn_mfma_f32_16x16x32_bf16(Bt[n][k], At[m][k], acc[ai][bj][m][n], 0, 0, 0); __builtin_amdgcn_s_setprio(0); } while (0)
#define PG8_WAIT_V(n) asm volatile("s_waitcnt vmcnt(" #n ")" ::: "memory")
#define PG8_WAIT_L(n) asm volatile("s_waitcnt lgkmcnt(" #n ")" ::: "memory")
#define PG8_BAR __builtin_amdgcn_s_barrier()
#define PG8_SCHED __builtin_amdgcn_sched_barrier(0)
    Unit cur, nxt; int ui = 0;
    if (!S.next(0, cur)) return;
    f32x4 acc[2][2][4][2];
#pragma unroll
    for (int a = 0; a < 2; ++a)
#pragma unroll
        for (int b = 0; b < 2; ++b)
#pragma unroll
            for (int m = 0; m < 4; ++m)
#pragma unroll
                for (int n = 0; n < 2; ++n) acc[a][b][m][n] = (f32x4){0.f, 0.f, 0.f, 0.f};
    bf16x8 At[4][2], B0[2][2], B1[2][2];
    const char* cA = (const char*)g.A + (size_t)cur.pm * tstep; const char* cB = (const char*)g.Bt + (size_t)cur.pn * tstep;
    S.a_ready(cur);
    if constexpr (SP2) {
        PG8_STAGE(PG8_SB(0, 0), cB, voffB); PG8_STAGE(PG8_SB(0, 1), cB + hstep, voffB); PG8_STAGE(PG8_SA(0, 0), cA, voffA); PG8_STAGE(PG8_SA(0, 1), cA + hstep, voffA);
        if (wr == 1) PG8_BAR;
        PG8_WAIT_V(2); PG8_BAR;
        PG8_STAGE(PG8_SB(1, 0), cB + kstep, voffB); PG8_STAGE(PG8_SA(1, 0), cA + kstep, voffA); PG8_STAGE(PG8_SB(1, 1), cB + hstep + kstep, voffB);
        PG8_WAIT_V(6); PG8_BAR;
    } else {
        PG8_STAGE(PG8_SB(0, 0), cB, voffB); PG8_STAGE(PG8_SA(0, 0), cA, voffA); PG8_STAGE(PG8_SB(0, 1), cB + hstep, voffB); PG8_STAGE(PG8_SA(0, 1), cA + hstep, voffA);
        if (wr == 1) PG8_BAR;
        PG8_WAIT_V(4); PG8_BAR;
        PG8_STAGE(PG8_SB(1, 0), cB + kstep, voffB); PG8_STAGE(PG8_SA(1, 0), cA + kstep, voffA); PG8_STAGE(PG8_SB(1, 1), cB + hstep + kstep, voffB);
        PG8_WAIT_V(6); PG8_BAR;
    }
    for (;;) {
        const bool has_next = S.next(ui + 1, nxt);
        const char* nA = has_next ? (const char*)g.A + (size_t)nxt.pm * tstep : cA; const char* nB = has_next ? (const char*)g.Bt + (size_t)nxt.pn * tstep : cB;
        for (int t = 0; t < nt; t += 2) {
            const bool last = (t == nt - 2);
            const char* a1 = cA + (size_t)(t + 1) * kstep;
            const char* a2 = last ? nA : cA + (size_t)(t + 2) * kstep; const char* b2 = last ? nB : cB + (size_t)(t + 2) * kstep;
            const char* a3 = a2 + kstep; const char* b3 = b2 + kstep;
            if (last && has_next) S.a_ready(nxt);
            if constexpr (SP2) {
            PG8_LDB(B0, 0, 0); PG8_LDB(B1, 0, 1); PG8_SCHED; PG8_LDA(At, 0, 0); PG8_STAGE(PG8_SA(1, 1), a1 + hstep, voffA);
            PG8_WAIT_V(8); PG8_WAIT_L(0); PG8_BAR; PG8_MMA(0, 0, At, B0); PG8_MMA(0, 1, At, B1); PG8_BAR; PG8_SCHED;
            PG8_LDA(At, 0, 1); PG8_STAGE(PG8_SB(0, 0), b2, voffB); PG8_STAGE(PG8_SB(0, 1), b2 + hstep, voffB); PG8_STAGE(PG8_SA(0, 0), a2, voffA);
            PG8_WAIT_V(8); PG8_WAIT_L(0); PG8_BAR; PG8_MMA(1, 0, At, B0); PG8_MMA(1, 1, At, B1); PG8_BAR; PG8_SCHED;
            PG8_LDB(B0, 1, 0); PG8_LDB(B1, 1, 1); PG8_SCHED; PG8_LDA(At, 1, 0); PG8_STAGE(PG8_SA(0, 1), a2 + hstep, voffA);
            PG8_WAIT_V(8); PG8_WAIT_L(0); PG8_BAR; PG8_MMA(0, 0, At, B0); PG8_MMA(0, 1, At, B1); PG8_BAR; PG8_SCHED;
            PG8_LDA(At, 1, 1); PG8_STAGE(PG8_SB(1, 0), b3, voffB); PG8_STAGE(PG8_SB(1, 1), b3 + hstep, voffB); PG8_STAGE(PG8_SA(1, 0), a3, voffA);
            PG8_WAIT_V(8); PG8_WAIT_L(0); PG8_BAR; PG8_MMA(1, 0, At, B0); PG8_MMA(1, 1, At, B1); PG8_BAR; PG8_SCHED;
            } else {
            PG8_LDB(B0, 0, 0); PG8_SCHED; PG8_LDA(At, 0, 0); PG8_STAGE(PG8_SA(1, 1), a1 + hstep, voffA);
            PG8_WAIT_L(8); PG8_BAR; PG8_WAIT_L(0); PG8_MMA(0, 0, At, B0); PG8_BAR; PG8_SCHED;
            PG8_LDB(B1, 0, 1); PG8_STAGE(PG8_SB(0, 0), b2, voffB);
            PG8_BAR; PG8_WAIT_L(0); PG8_MMA(0, 1, At, B1); PG8_BAR;
            PG8_LDA(At, 0, 1); PG8_STAGE(PG8_SA(0, 0), a2, voffA);
            PG8_BAR; PG8_WAIT_L(0); PG8_MMA(1, 0, At, B0); PG8_BAR; PG8_SCHED;
            PG8_STAGE(PG8_SB(0, 1), b2 + hstep, voffB);
            PG8_WAIT_V(6); PG8_BAR; PG8_MMA(1, 1, At, B1); PG8_BAR;
            PG8_LDB(B0, 1, 0); PG8_SCHED; PG8_LDA(At, 1, 0); PG8_STAGE(PG8_SA(0, 1), a2 + hstep, voffA);
            PG8_WAIT_L(8); PG8_BAR; PG8_WAIT_L(0); PG8_MMA(0, 0, At, B0); PG8_BAR; PG8_SCHED;
            PG8_LDB(B1, 1, 1); PG8_STAGE(PG8_SB(1, 0), b3, voffB);
            PG8_BAR; PG8_WAIT_L(0); PG8_MMA(0, 1, At, B1); PG8_BAR;
            PG8_LDA(At, 1, 1); PG8_STAGE(PG8_SA(1, 0), a3, voffA);
            PG8_BAR; PG8_WAIT_L(0); PG8_MMA(1, 0, At, B0); PG8_BAR; PG8_SCHED;
            PG8_STAGE(PG8_SB(1, 1), b3 + hstep, voffB);
            PG8_WAIT_V(6); PG8_BAR; PG8_MMA(1, 1, At, B1); PG8_BAR;
            }
        }
        if constexpr (ALIGN_EPI) { if (wr == 0) PG8_BAR; }
        if constexpr (!Epi::AFTER_DRAIN) { E(acc, cur, wr, wc, fr, fq); S.done(cur); }
        if (!has_next) break;
#pragma unroll
        for (int a = 0; a < 2; ++a)
#pragma unroll
            for (int b = 0; b < 2; ++b)
#pragma unroll
                for (int m = 0; m < 4; ++m)
#pragma unroll
                    for (int n = 0; n < 2; ++n) acc[a][b][m][n] = (f32x4){0.f, 0.f, 0.f, 0.f};
        cur = nxt; cA = nA; cB = nB; ++ui;
        if constexpr (ALIGN_EPI) { if (wr == 1) PG8_BAR; }
    }
    PG8_WAIT_V(0);
    if constexpr (!ALIGN_EPI) { if (wr == 0) PG8_BAR; }
    PG8_BAR;
    if constexpr (Epi::AFTER_DRAIN) { E.fused(acc, cur, wr, wc, fr, fq, lds, wid, lane); S.done(cur); }
#undef PG8_SA
#undef PG8_SB
#undef PG8_STAGE
#undef PG8_LDA
#undef PG8_LDB
#undef PG8_MMA
#undef PG8_WAIT_V
#undef PG8_WAIT_L
#undef PG8_BAR
#undef PG8_SCHED
}
}

typedef unsigned short bf16_t;
typedef short bf16x8 __attribute__((ext_vector_type(8)));
typedef short s16x4 __attribute__((ext_vector_type(4)));
typedef float f32x4 __attribute__((ext_vector_type(4)));
typedef float f32x16 __attribute__((ext_vector_type(16)));
typedef unsigned u32x4 __attribute__((ext_vector_type(4)));
typedef unsigned u32x2 __attribute__((ext_vector_type(2)));
#define LAS __attribute__((address_space(3)))

constexpr int DM = 1024, NP = 16384, NS = 256, MA = NP + NS;
constexpr int NA = 3072, NB = 2304;
constexpr int KSROWS = 4160, SWROWS = 192;
constexpr float DN_ALPHA = 1.41421356237309515f;
constexpr float LOG2E = 1.4426950408889634f;
constexpr float C64 = 0.125f * LOG2E, THR64 = 64.f;
constexpr float C128 = 0.088388347648318440f * LOG2E, THR128 = 90.5f;
constexpr size_t OFF_DKP = 17039360, OFF_DVP = 25427968, OFF_DKS = 33816576, OFF_DVS = 33947648, OFF_SKP = 34078720, OFF_SVP = 34144256,
                 OFF_SKS = 34209792, OFF_SVS = 34471936, OFF_MKP = 34734080, OFF_MVP = 35782656;
constexpr size_t MiB = 1u << 20;
constexpr size_t WS_CTL = 0, WS_ROPE = 1 * MiB, WS_WA = 2 * MiB, WS_WB = 8 * MiB, WS_WM = 13 * MiB, WS_WO = 17 * MiB, WS_MEMB = 21 * MiB, WS_MKV = 23 * MiB,
                 WS_CMK = 27 * MiB, WS_CMV = 35 * MiB, WS_KSW = 43 * MiB, WS_VSW = 44 * MiB, WS_XA = 46 * MiB, WS_MIX = 79 * MiB, WS_Z0 = 112 * MiB,
                 WS_PA = 177 * MiB, WS_KS = 275 * MiB, WS_VS = 340 * MiB, WS_END = 405 * MiB;
constexpr int LDS_RING = 131072, LDS_BYTES = LDS_RING + 256;

__device__ __forceinline__ unsigned cvtpk(float lo, float hi) { unsigned r; asm volatile("v_cvt_pk_bf16_f32 %0, %1, %2" : "=v"(r) : "v"(lo), "v"(hi)); return r; }
__device__ __forceinline__ float bflo(unsigned w) { return __uint_as_float(w << 16); }
__device__ __forceinline__ float bfhi(unsigned w) { return __uint_as_float(w & 0xffff0000u); }
__device__ __forceinline__ float silu(float x) { return x * __builtin_amdgcn_rcpf(1.f + __expf(-x)); }
__device__ __forceinline__ void cvt8(const float* s, bf16_t* d) {
    const f32x4 a = *(const f32x4*)s, b = *(const f32x4*)(s + 4);
    u32x4 w; w.x = cvtpk(a.x, a.y); w.y = cvtpk(a.z, a.w); w.z = cvtpk(b.x, b.y); w.w = cvtpk(b.z, b.w); *(u32x4*)d = w;
}

__device__ __forceinline__ f32x4 shfl4(f32x4 v, int m) { f32x4 p; p.x = __shfl_xor(v.x, m); p.y = __shfl_xor(v.y, m); p.z = __shfl_xor(v.z, m); p.w = __shfl_xor(v.w, m); return p; }
struct NoPre {};
template <class F> struct EpiWrap {
    static constexpr bool PERM = false, AFTER_DRAIN = false;
    F f; int rowbase;
    __device__ __forceinline__ void operator()(const f32x4 (&acc)[2][2][4][2], const pg8::Unit& u, int wr, int wc, int fr, int fq) const {
        F lf = f;
#pragma unroll
        for (int ai = 0; ai < 2; ++ai)
#pragma unroll
            for (int mp = 0; mp < 2; ++mp) {
                typename F::Pre pr[2][2][2]; f32x4 vv[2][2][2];
                const int row0 = rowbase + u.pm * 256 + ai * 128 + wr * 64 + mp * 32 + fr, colb = u.pn * 256 + wc * 32 + 4 * fq;
#pragma unroll
                for (int mm = 0; mm < 2; ++mm) { lf.row_begin(mm, row0 + mm * 16);
#pragma unroll
                    for (int bj = 0; bj < 2; ++bj)
#pragma unroll
                        for (int n = 0; n < 2; ++n) pr[mm][bj][n] = lf.pre(row0 + mm * 16, colb + bj * 128 + n * 16); }
#pragma unroll
                for (int mm = 0; mm < 2; ++mm)
#pragma unroll
                    for (int bj = 0; bj < 2; ++bj)
#pragma unroll
                        for (int n = 0; n < 2; ++n) vv[mm][bj][n] = lf.fix(mm, colb + bj * 128 + n * 16, acc[ai][bj][mp * 2 + mm][n], pr[mm][bj][n]);
#pragma unroll
                for (int mm = 0; mm < 2; ++mm) { const int row = row0 + mm * 16; lf.s = 0.f; lf.q = 0.f;
#pragma unroll
                    for (int bj = 0; bj < 2; ++bj)
#pragma unroll
                        for (int n = 0; n < 2; ++n) { const int col = colb + bj * 128 + n * 16; f32x4 p = vv[mm][bj][n];
                            if constexpr (F::ROPE) { if (lf.need_rope(col)) p = shfl4(p, 32); }
                            lf.quad(row, col, vv[mm][bj][n], p); }
                    if constexpr (F::STATS) { float s = lf.s, q = lf.q; s += __shfl_xor(s, 16); s += __shfl_xor(s, 32); q += __shfl_xor(q, 16); q += __shfl_xor(q, 32);
                        if (fq == 0) lf.commit(row, s, q); } }
            }
    }
};
__device__ __forceinline__ f32x4 rope_apply(f32x4 v, f32x4 p, int col, int pos, const float* rope) {
    const float* t = rope + ((size_t)pos * 8 + (col & 4)) * 2;
    const f32x4 t0 = *(const f32x4*)t, t1 = *(const f32x4*)(t + 4);
    const float sg = (col & 8) ? 1.f : -1.f;
    f32x4 o; o.x = v.x * t0.x + sg * p.x * t0.y; o.y = v.y * t0.z + sg * p.y * t0.w; o.z = v.z * t1.x + sg * p.z * t1.y; o.w = v.w * t1.z + sg * p.w * t1.w;
    return o;
}
__device__ __forceinline__ void st_bf4(bf16_t* p, f32x4 v) { u32x2 w; w.x = cvtpk(v.x, v.y); w.y = cvtpk(v.z, v.w); *(u32x2*)p = w; }
__device__ __forceinline__ void row_stats(const float* ST, int row, float& mu, float& rstd) {
    const float s = ST[2 * (size_t)row], q = ST[2 * (size_t)row + 1]; mu = s * (1.f / DM); rstd = rsqrtf(fmaxf(q * (1.f / DM) - mu * mu, 0.f) + 1e-5f);
}

struct EpiAF {
    static constexpr bool ROPE = true, STATS = false; typedef NoPre Pre;
    bf16_t* PA; float* dout; bf16_t* KS; bf16_t* VS; const float* rope; float s, q;
    __device__ __forceinline__ void row_begin(int, int) {}
    __device__ __forceinline__ Pre pre(int, int) const { return Pre{}; }
    __device__ __forceinline__ f32x4 fix(int, int, f32x4 v, const Pre&) const { return v; }
    __device__ __forceinline__ bool need_rope(int col) const { return (col >> 9) < 2 && ((col >> 4) & 3) == 0; }
    __device__ __forceinline__ void commit(int, float, float) {}
    __device__ __forceinline__ void quad(int row, int col, f32x4 v, f32x4 p) {
        const bool samp = row >= NP; const int rs = row - NP;
        const int pos = samp ? 4096 + (rs & 15) : (row & 4095);
        const int region = col >> 9;
        if (need_rope(col)) v = rope_apply(v, p, col, pos, rope);
        st_bf4(PA + (size_t)row * NA + col, v);
        if (region == 1 || region == 2) {
            const int c = col & 511;
            if (!samp) *(f32x4*)(dout + (region == 1 ? OFF_DKP : OFF_DVP) + (size_t)row * 512 + c) = v;
            else { *(f32x4*)(dout + (region == 1 ? OFF_DKS : OFF_DVS) + (size_t)rs * 512 + c) = v;
                   st_bf4((region == 1 ? KS : VS) + ((size_t)(rs >> 4) * KSROWS + 4096 + (rs & 15)) * 512 + c, v); }
        }
    }
};
struct EpiMemF {
    static constexpr bool ROPE = false, STATS = false; typedef NoPre Pre;
    bf16_t* MKV; float* dout; float s, q;
    __device__ __forceinline__ void row_begin(int, int) {}
    __device__ __forceinline__ Pre pre(int, int) const { return Pre{}; }
    __device__ __forceinline__ f32x4 fix(int, int, f32x4 v, const Pre&) const { return v; }
    __device__ __forceinline__ void commit(int, float, float) {}
    __device__ __forceinline__ void quad(int row, int col, f32x4 v, f32x4) {
        st_bf4(MKV + (size_t)row * 2048 + col, v);
        const int l = col >> 10, c = col & 1023;
        *(f32x4*)(dout + (c < 512 ? OFF_MKP : OFF_MVP) + (size_t)l * 524288 + (size_t)row * 512 + (c & 511)) = v;
    }
};
struct EpiMerge0F {
    static constexpr bool ROPE = false, STATS = true; typedef u32x2 Pre;
    bf16_t* ZB; float* ST; float s, q;
    __device__ __forceinline__ void row_begin(int, int) {}
    __device__ __forceinline__ Pre pre(int row, int col) const { return *(const u32x2*)(ZB + (size_t)row * DM + col); }
    __device__ __forceinline__ f32x4 fix(int, int, f32x4 v, const Pre& x) const { return (f32x4){bflo(x.x), bfhi(x.x), bflo(x.y), bfhi(x.y)} * DN_ALPHA + v; }
    __device__ __forceinline__ void commit(int row, float ss, float qq) { atomicAdd(ST + 2 * (size_t)row, ss); atomicAdd(ST + 2 * (size_t)row + 1, qq); }
    __device__ __forceinline__ void quad(int row, int col, f32x4 z, f32x4) {
        st_bf4(ZB + (size_t)row * DM + col, z);
        s += (z.x + z.y) + (z.z + z.w); q += (z.x * z.x + z.y * z.y) + (z.z * z.z + z.w * z.w);
    }
};
struct EpiMerge1F {
    static constexpr bool ROPE = false, STATS = true; typedef u32x2 Pre;
    const bf16_t* ZB; const float* ST0; const float* g0; const float* b0; float* out; float* ST1; float s, q, mu[2], rstd[2];
    __device__ __forceinline__ void row_begin(int sl, int row) { row_stats(ST0, row, mu[sl], rstd[sl]); }
    __device__ __forceinline__ Pre pre(int row, int col) const { return *(const u32x2*)(ZB + (size_t)row * DM + col); }
    __device__ __forceinline__ f32x4 fix(int sl, int col, f32x4 v, const Pre& z) const {
        const f32x4 z0 = (f32x4){bflo(z.x), bfhi(z.x), bflo(z.y), bfhi(z.y)};
        const f32x4 g = *(const f32x4*)(g0 + col), b = *(const f32x4*)(b0 + col); return ((z0 - mu[sl]) * rstd[sl] * g + b) * DN_ALPHA + v; }
    __device__ __forceinline__ void commit(int row, float ss, float qq) { atomicAdd(ST1 + 2 * (size_t)row, ss); atomicAdd(ST1 + 2 * (size_t)row + 1, qq); }
    __device__ __forceinline__ void quad(int row, int col, f32x4 z, f32x4) {
        *(f32x4*)(out + (size_t)row * DM + col) = z;
        s += (z.x + z.y) + (z.z + z.w); q += (z.x * z.x + z.y * z.y) + (z.z * z.z + z.w * z.w);
    }
};
struct PreB { f32x4 c, b; };
struct EpiBF {
    static constexpr bool ROPE = true, STATS = false; typedef PreB Pre;
    bf16_t* PB; float* dout; bf16_t* KSW; bf16_t* VSW; const float* rope; const float* ST0; const float* CS; const float* BW; float s, q, mu[2], rstd[2];
    __device__ __forceinline__ void row_begin(int sl, int row) { row_stats(ST0, row, mu[sl], rstd[sl]); }
    __device__ __forceinline__ Pre pre(int, int col) const { Pre p; p.c = *(const f32x4*)(CS + col); p.b = *(const f32x4*)(BW + col); return p; }
    __device__ __forceinline__ f32x4 fix(int sl, int, f32x4 v, const Pre& p) const { return (v - p.c * mu[sl]) * rstd[sl] + p.b; }
    __device__ __forceinline__ bool need_rope(int col) const { return (col < 512 || (col >= 2048 && col < 2176)) && ((col >> 4) & 3) == 0; }
    __device__ __forceinline__ void commit(int, float, float) {}
    __device__ __forceinline__ void quad(int row, int col, f32x4 v, f32x4 p) {
        const bool samp = row >= NP; const int rs = row - NP;
        const int t = samp ? (rs & 15) : (row & 4095);
        const int pos = samp ? 4096 + t : t;
        const bool isk = col >= 2048 && col < 2176;
        if (need_rope(col)) v = rope_apply(v, p, col, pos, rope);
        st_bf4(PB + (size_t)row * NB + col, v);
        if (col >= 2048) {
            const int cc = col & 127;
            if (!samp) { if (t >= 3968) *(f32x4*)(dout + (isk ? OFF_SKP : OFF_SVP) + ((size_t)(row >> 12) * 128 + (t - 3968)) * 128 + cc) = v; }
            else { const int b = rs >> 4;
                   *(f32x4*)(dout + (isk ? OFF_SKS : OFF_SVS) + ((size_t)b * 128 + 112 + t) * 128 + cc) = v;
                   st_bf4((isk ? KSW : VSW) + ((size_t)b * SWROWS + 128 + t) * 128 + cc, v); }
        }
    }
};
template <class F> __device__ __forceinline__ void gemm_small(LAS unsigned char* lds, const bf16_t* A, const bf16_t* Bt, int N, int rowbase, int ustart, int G, const F& f) {
    const int tid = threadIdx.x, lane = tid & 63, r32 = lane & 31, hi = lane >> 5, wid = __builtin_amdgcn_readfirstlane(tid >> 6);
    const int nu = 8 * (N / 32);
    for (int u = ustart; u < nu; u += G) {
        const int row0 = (u & 7) * 32, col0 = (u >> 3) * 32;
        const bf16_t* ap = A + (size_t)(row0 + r32) * DM + wid * 128 + hi * 8; const bf16_t* bp = Bt + (size_t)(col0 + r32) * DM + wid * 128 + hi * 8;
        bf16x8 af[8], bfr[8];
#pragma unroll
        for (int k = 0; k < 8; ++k) { af[k] = *(const bf16x8*)(ap + 16 * k); bfr[k] = *(const bf16x8*)(bp + 16 * k); }
        f32x16 acc = f32x16{};
#pragma unroll
        for (int k = 0; k < 8; ++k) acc = __builtin_amdgcn_mfma_f32_32x32x16_bf16(bfr[k], af[k], acc, 0, 0, 0);
        LAS float* part = (LAS float*)lds + wid * 1024;
#pragma unroll
        for (int r = 0; r < 16; ++r) part[r * 64 + lane] = acc[r];
        __syncthreads();
        if (wid < 2) {
            F lf = f; f32x4 qd[2];
#pragma unroll
            for (int e = 0; e < 2; ++e) { float t[4];
#pragma unroll
                for (int c = 0; c < 4; ++c) { const int r = 4 * (2 * wid + e) + c; float a = 0.f;
#pragma unroll
                    for (int w = 0; w < 8; ++w) a += ((LAS float*)lds)[w * 1024 + r * 64 + lane];
                    t[c] = a; }
                qd[e] = (f32x4){t[0], t[1], t[2], t[3]}; }
            const int row = rowbase + row0 + r32; typename F::Pre pr[2];
            lf.row_begin(0, row);
#pragma unroll
            for (int e = 0; e < 2; ++e) pr[e] = lf.pre(row, col0 + 8 * (2 * wid + e) + 4 * hi);
#pragma unroll
            for (int e = 0; e < 2; ++e) qd[e] = lf.fix(0, col0 + 8 * (2 * wid + e) + 4 * hi, qd[e], pr[e]);
            lf.s = 0.f; lf.q = 0.f;
#pragma unroll
            for (int e = 0; e < 2; ++e) lf.quad(row, col0 + 8 * (2 * wid + e) + 4 * hi, qd[e], qd[e ^ 1]);
            if constexpr (F::STATS) { float s = lf.s, q = lf.q; s += __shfl_xor(s, 32); q += __shfl_xor(q, 32); if (hi == 0) lf.commit(row, s, q); }
        }
        __syncthreads();
    }
}

namespace att {
#define KSWZ(row, colB) ((row) * 256 + ((colB) ^ (((row) & 7) << 4)))
#define SBAR() __builtin_amdgcn_sched_barrier(0)
__device__ __forceinline__ int v_st(int k, int c) { const int kk = (k & ~0xC) | ((k & 4) << 1) | ((k & 8) >> 1); return ((kk >> 3) * 4 + (c >> 5)) * 512 + ((kk & 7) * 32 + (c & 31)) * 2; }
__device__ __forceinline__ int v_rd_base(int lane) { return ((lane & 3) << 3) | (((lane >> 2) & 3) << 6) | (((lane >> 4) & 1) << 5) | (((lane >> 5) & 1) << 8); }
constexpr int v_rd_off(int d0, int ks, int half) { return d0 * 512 + ks * 4096 + half * 2048; }
template <int OFF> __device__ __forceinline__ s16x4 tr_read(int vb) {
    s16x4 r; asm volatile("ds_read_b64_tr_b16 %0, %1 offset:%2" : "=&v"(r) : "v"(vb), "i"(OFF) : "memory"); return r;
}
template <int OFF> __device__ __forceinline__ bf16x8 lds_read128(int ad) {
    bf16x8 r; asm volatile("ds_read_b128 %0, %1 offset:%2" : "=&v"(r) : "v"(ad), "i"(OFF) : "memory"); return r;
}
template <int D0> __device__ __forceinline__ void pv_one(f32x16& od, int vb, bf16x8 pa0, bf16x8 pa1, bf16x8 pa2, bf16x8 pa3) {
    const s16x4 l0 = tr_read<v_rd_off(D0, 0, 0)>(vb), h0 = tr_read<v_rd_off(D0, 0, 1)>(vb), l1 = tr_read<v_rd_off(D0, 1, 0)>(vb), h1 = tr_read<v_rd_off(D0, 1, 1)>(vb);
    const s16x4 l2 = tr_read<v_rd_off(D0, 2, 0)>(vb), h2 = tr_read<v_rd_off(D0, 2, 1)>(vb), l3 = tr_read<v_rd_off(D0, 3, 0)>(vb), h3 = tr_read<v_rd_off(D0, 3, 1)>(vb);
    asm volatile("s_waitcnt lgkmcnt(0)" ::: "memory"); SBAR();
#define PK(L, H) (bf16x8){L[0], L[1], L[2], L[3], H[0], H[1], H[2], H[3]}
    od = __builtin_amdgcn_mfma_f32_32x32x16_bf16(PK(l0, h0), pa0, od, 0, 0, 0);
    od = __builtin_amdgcn_mfma_f32_32x32x16_bf16(PK(l1, h1), pa1, od, 0, 0, 0);
    od = __builtin_amdgcn_mfma_f32_32x32x16_bf16(PK(l2, h2), pa2, od, 0, 0, 0);
    od = __builtin_amdgcn_mfma_f32_32x32x16_bf16(PK(l3, h3), pa3, od, 0, 0, 0);
#undef PK
}
template <int KSI, int DB, int ND> __device__ __forceinline__ void v_read(int vb, s16x4 (&l)[4], s16x4 (&h)[4]) {
    l[0] = tr_read<v_rd_off(DB, KSI, 0)>(vb); h[0] = tr_read<v_rd_off(DB, KSI, 1)>(vb);
    l[1] = tr_read<v_rd_off(DB + 1, KSI, 0)>(vb); h[1] = tr_read<v_rd_off(DB + 1, KSI, 1)>(vb);
    if constexpr (ND == 4) { l[2] = tr_read<v_rd_off(DB + 2, KSI, 0)>(vb); h[2] = tr_read<v_rd_off(DB + 2, KSI, 1)>(vb);
                             l[3] = tr_read<v_rd_off(DB + 3, KSI, 0)>(vb); h[3] = tr_read<v_rd_off(DB + 3, KSI, 1)>(vb); }
}
template <int ND> __device__ __forceinline__ void pv_mf(f32x16 (&o)[4], bf16x8 pa, const s16x4 (&l)[4], const s16x4 (&h)[4]) {
#pragma unroll
    for (int d = 0; d < ND; ++d) o[d] = __builtin_amdgcn_mfma_f32_32x32x16_bf16((bf16x8){l[d][0], l[d][1], l[d][2], l[d][3], h[d][0], h[d][1], h[d][2], h[d][3]}, pa, o[d], 0, 0, 0);
}
template <int DB, int ND> __device__ __forceinline__ void pv_ks(f32x16 (&o)[4], int vb, bf16x8 pa0, bf16x8 pa1, bf16x8 pa2, bf16x8 pa3) {
    s16x4 la[4], ha[4];
    v_read<0, DB, ND>(vb, la, ha); asm volatile("s_waitcnt lgkmcnt(0)" ::: "memory"); SBAR(); pv_mf<ND>(o, pa0, la, ha); SBAR();
    v_read<1, DB, ND>(vb, la, ha); asm volatile("s_waitcnt lgkmcnt(0)" ::: "memory"); SBAR(); pv_mf<ND>(o, pa1, la, ha); SBAR();
    v_read<2, DB, ND>(vb, la, ha); asm volatile("s_waitcnt lgkmcnt(0)" ::: "memory"); SBAR(); pv_mf<ND>(o, pa2, la, ha); SBAR();
    v_read<3, DB, ND>(vb, la, ha); asm volatile("s_waitcnt lgkmcnt(0)" ::: "memory"); SBAR(); pv_mf<ND>(o, pa3, la, ha);
}
template <int DB, int ND> __device__ __forceinline__ void pv_rest(f32x16 (&o)[4], int vb, bf16x8 pa0, bf16x8 pa1, bf16x8 pa2, bf16x8 pa3, s16x4 (&la)[4], s16x4 (&ha)[4]) {
    s16x4 lb[4], hb[4];
    asm volatile("s_waitcnt lgkmcnt(0)" ::: "memory"); SBAR(); v_read<1, DB, ND>(vb, lb, hb); SBAR(); pv_mf<ND>(o, pa0, la, ha); SBAR();
    asm volatile("s_waitcnt lgkmcnt(0)" ::: "memory"); SBAR(); v_read<2, DB, ND>(vb, la, ha); SBAR(); pv_mf<ND>(o, pa1, lb, hb); SBAR();
    asm volatile("s_waitcnt lgkmcnt(0)" ::: "memory"); SBAR(); v_read<3, DB, ND>(vb, lb, hb); SBAR(); pv_mf<ND>(o, pa2, la, ha); SBAR();
    asm volatile("s_waitcnt lgkmcnt(0)" ::: "memory"); SBAR(); pv_mf<ND>(o, pa3, lb, hb);
}
__device__ __forceinline__ void partialSM(f32x16& p0, f32x16& p1, float& m_reg, float& alpha, float C, float thr) {
    float pmax = p0[0];
#pragma unroll
    for (int r = 1; r < 16; ++r) pmax = fmaxf(pmax, p0[r]);
#pragma unroll
    for (int r = 0; r < 16; ++r) pmax = fmaxf(pmax, p1[r]);
    { auto rr = __builtin_amdgcn_permlane32_swap(__float_as_uint(pmax), __float_as_uint(pmax), false, false);
      pmax = fmaxf(__uint_as_float(rr[0]), __uint_as_float(rr[1])); }
    float mn;
    if (__all(pmax - m_reg <= thr)) { mn = m_reg; alpha = 1.f; }
    else { mn = fmaxf(m_reg, pmax); alpha = __builtin_amdgcn_exp2f((m_reg - mn) * C); m_reg = mn; }
    const float mnC = -mn * C;
#pragma unroll
    for (int r = 0; r < 16; ++r) p0[r] = __builtin_amdgcn_exp2f(fmaf(p0[r], C, mnC));
#pragma unroll
    for (int r = 0; r < 16; ++r) p1[r] = __builtin_amdgcn_exp2f(fmaf(p1[r], C, mnC));
}
__device__ __forceinline__ void finishSM(f32x16& p0, f32x16& p1, float alpha, float& l_reg, bf16x8& pa0, bf16x8& pa1, bf16x8& pa2, bf16x8& pa3) {
    float ps = 0;
#pragma unroll
    for (int r = 0; r < 16; ++r) ps += p0[r];
#pragma unroll
    for (int r = 0; r < 16; ++r) ps += p1[r];
    { auto rr = __builtin_amdgcn_permlane32_swap(__float_as_uint(ps), __float_as_uint(ps), false, false);
      ps = __uint_as_float(rr[0]) + __uint_as_float(rr[1]); }
    l_reg = l_reg * alpha + ps;
#define PK4(P, BASE, OUT) do { unsigned a0 = cvtpk(P[BASE + 0], P[BASE + 1]), a1 = cvtpk(P[BASE + 2], P[BASE + 3]);   \
    unsigned b0 = cvtpk(P[BASE + 4], P[BASE + 5]), b1 = cvtpk(P[BASE + 6], P[BASE + 7]);                              \
    auto r0 = __builtin_amdgcn_permlane32_swap(a0, b0, false, false); auto r1 = __builtin_amdgcn_permlane32_swap(a1, b1, false, false); \
    u32x4 w = {r0[0], r1[0], r0[1], r1[1]}; OUT = *reinterpret_cast<bf16x8*>(&w); } while (0)
    PK4(p0, 0, pa0); PK4(p0, 8, pa1); PK4(p1, 0, pa2); PK4(p1, 8, pa3);
#undef PK4
}
constexpr int RING = 32768;
template <int QS, bool PVHALF>
__device__ __forceinline__ void attn_core(LAS unsigned char* lds, const bf16_t* Kb, long ldk, const bf16_t* Vb, long ldv, int NT, int nkeys,
                                          const bf16_t* qptr, int wNT, int kcoffB, int pvsel, float C, float thr, f32x16 (&o)[4], float& m_reg, float& l_reg) {
    int tid = threadIdx.x; asm volatile("" : "+v"(tid));
    const int lane = tid & 63, r32 = lane & 31, hi = lane >> 5, wid = __builtin_amdgcn_readfirstlane(tid >> 6);
    bf16x8 qr[QS];
#pragma unroll
    for (int d0 = 0; d0 < QS; ++d0) qr[d0] = *(const bf16x8*)(qptr + d0 * 16);
#pragma unroll
    for (int d = 0; d < 4; ++d) o[d] = f32x16{};
    m_reg = -1e30f; l_reg = 0.f;
    long offK[2], offV[2];
#pragma unroll
    for (int i = 0; i < 2; ++i) { const int p = i * 8192 + wid * 1024 + lane * 16;
        const int row = p >> 8, colB = (p & 255) ^ ((row & 7) << 4); offK[i] = (long)row * ldk + (colB >> 1);
        const int sub = p >> 9, q = (p & 511) >> 1, kk = (sub >> 2) * 8 + (q >> 5), k = (kk & ~0xC) | ((kk & 4) << 1) | ((kk & 8) >> 1), c = (sub & 3) * 32 + (q & 31);
        offV[i] = (long)k * ldv + c; }
    const int vrb = v_rd_base(lane);
#define GLDS(t, bf) do { const bf16_t* kt_ = Kb + (long)(t) * 64 * ldk; const bf16_t* vt_ = Vb + (long)(t) * 64 * ldv; LAS unsigned char* b_ = lds + (bf) * RING + wid * 1024; \
    __builtin_amdgcn_global_load_lds((const unsigned*)(vt_ + offV[0]), (LAS unsigned*)(b_), 16, 0, 0); \
    __builtin_amdgcn_global_load_lds((const unsigned*)(vt_ + offV[1]), (LAS unsigned*)(b_ + 8192), 16, 0, 0); \
    __builtin_amdgcn_global_load_lds((const unsigned*)(kt_ + offK[0]), (LAS unsigned*)(b_ + 16384), 16, 0, 0); \
    __builtin_amdgcn_global_load_lds((const unsigned*)(kt_ + offK[1]), (LAS unsigned*)(b_ + 16384 + 8192), 16, 0, 0); } while (0)
    GLDS(0, 0);
#pragma unroll
    for (int d0 = 0; d0 < QS; ++d0) asm volatile("" :: "v"(qr[d0]));
    if (1 < NT) GLDS(1, 1); if (2 < NT) GLDS(2, 2);
    for (int j = 0; j < NT; ++j) {
        const int rem = NT - 1 - j;
        if (rem >= 2) asm volatile("s_waitcnt vmcnt(8)" ::: "memory"); else if (rem == 1) asm volatile("s_waitcnt vmcnt(4)" ::: "memory"); else asm volatile("s_waitcnt vmcnt(0)" ::: "memory");
        __builtin_amdgcn_s_barrier();
        asm volatile("" ::: "memory");
        if (j + 3 < NT) GLDS(j + 3, (j + 3) & 3);
        if (j < wNT) {
            const int cur = j & 3;
            f32x16 p0 = f32x16{}, p1 = f32x16{};
            const int kbase = (int)(uintptr_t)(lds + cur * RING + 16384) + r32 * 256;
            const int swz = (r32 & 7) << 4;
#pragma unroll
            for (int hq = 0; hq < QS / 4; ++hq) { bf16x8 b0[4], b1[4];
#pragma unroll
                for (int i = 0; i < 4; ++i) { const int cb = kcoffB + ((hq * 4 + i) * 16 + hi * 8) * 2; const int ad = kbase + (cb ^ swz);
                    b0[i] = lds_read128<0>(ad); b1[i] = lds_read128<8192>(ad); }
                asm volatile("s_waitcnt lgkmcnt(0)" ::: "memory"); SBAR();
#pragma unroll
                for (int i = 0; i < 4; ++i) { p0 = __builtin_amdgcn_mfma_f32_32x32x16_bf16(b0[i], qr[hq * 4 + i], p0, 0, 0, 0);
                    p1 = __builtin_amdgcn_mfma_f32_32x32x16_bf16(b1[i], qr[hq * 4 + i], p1, 0, 0, 0); } }
            if (__builtin_expect((j + 1) * 64 > nkeys, 0)) { const int kb = j * 64 + 4 * hi; asm volatile("" ::: "memory");
#pragma unroll
                for (int r = 0; r < 16; ++r) { const int kv = kb + (r & 3) + 8 * (r >> 2); if (kv >= nkeys) p0[r] = -1e30f; if (kv + 32 >= nkeys) p1[r] = -1e30f; } }
            float alpha; bf16x8 pa0, pa1, pa2, pa3;
            const int vb = (int)(uintptr_t)(lds + cur * RING) + vrb;
            s16x4 la[4], ha[4];
            partialSM(p0, p1, m_reg, alpha, C, thr);
            finishSM(p0, p1, alpha, l_reg, pa0, pa1, pa2, pa3);
            SBAR();
            if constexpr (QS == 4) { if constexpr (!PVHALF) v_read<0, 0, 4>(vb, la, ha); else { if (pvsel == 0) v_read<0, 0, 2>(vb, la, ha); else v_read<0, 2, 2>(vb, la, ha); } }
            SBAR();
            if (__any(alpha < 1.f)) {
#pragma unroll
                for (int d = 0; d < (PVHALF ? 2 : 4); ++d)
#pragma unroll
                    for (int r = 0; r < 16; ++r) o[d][r] *= alpha; }
            if constexpr (QS == 8) { pv_one<0>(o[0], vb, pa0, pa1, pa2, pa3); pv_one<1>(o[1], vb, pa0, pa1, pa2, pa3); pv_one<2>(o[2], vb, pa0, pa1, pa2, pa3); pv_one<3>(o[3], vb, pa0, pa1, pa2, pa3); }
            else if constexpr (!PVHALF) pv_rest<0, 4>(o, vb, pa0, pa1, pa2, pa3, la, ha);
            else { if (pvsel == 0) pv_rest<0, 2>(o, vb, pa0, pa1, pa2, pa3, la, ha); else pv_rest<2, 2>(o, vb, pa0, pa1, pa2, pa3, la, ha); }
        }
    }
#undef GLDS
    __syncthreads();
}

template <bool PVHALF>
__device__ __forceinline__ void attn_core_pipe(LAS unsigned char* lds, const bf16_t* Kb, long ldk, const bf16_t* Vb, long ldv, int NT, int nkeys,
                                               const bf16_t* qptr, int wNT, int kcoffB, int pvsel, float C, float thr, f32x16 (&o)[4], float& m_reg, float& l_reg) {
    int tid = threadIdx.x; asm volatile("" : "+v"(tid));
    const int lane = tid & 63, r32 = lane & 31, hi = lane >> 5, wid = __builtin_amdgcn_readfirstlane(tid >> 6);
    bf16x8 qr[4];
#pragma unroll
    for (int d0 = 0; d0 < 4; ++d0) qr[d0] = *(const bf16x8*)(qptr + d0 * 16);
#pragma unroll
    for (int d = 0; d < 4; ++d) o[d] = f32x16{};
    m_reg = -1e30f; l_reg = 0.f;
    int offK[2], offV[2];
#pragma unroll
    for (int i = 0; i < 2; ++i) { const int p = i * 8192 + wid * 1024 + lane * 16;
        const int row = p >> 8, colB = (p & 255) ^ ((row & 7) << 4); offK[i] = row * (int)ldk + (colB >> 1);
        const int sub = p >> 9, q = (p & 511) >> 1, kk = (sub >> 2) * 8 + (q >> 5), k = (kk & ~0xC) | ((kk & 4) << 1) | ((kk & 8) >> 1), c = (sub & 3) * 32 + (q & 31);
        offV[i] = k * (int)ldv + c; }
    const int vrb = v_rd_base(lane);
    int kad[4];
#pragma unroll
    for (int i = 0; i < 4; ++i) kad[i] = 16384 + r32 * 256 + ((kcoffB + (i * 16 + hi * 8) * 2) ^ ((r32 & 7) << 4));
    const int lds0 = (int)(uintptr_t)lds;
#define GLDS(t, bf) do { const bf16_t* kt_ = Kb + (long)(t) * 64 * ldk; const bf16_t* vt_ = Vb + (long)(t) * 64 * ldv; LAS unsigned char* b_ = lds + (bf) * RING + wid * 1024; \
    __builtin_amdgcn_global_load_lds((const unsigned*)(vt_ + offV[0]), (LAS unsigned*)(b_), 16, 0, 0); \
    __builtin_amdgcn_global_load_lds((const unsigned*)(vt_ + offV[1]), (LAS unsigned*)(b_ + 8192), 16, 0, 0); \
    __builtin_amdgcn_global_load_lds((const unsigned*)(kt_ + offK[0]), (LAS unsigned*)(b_ + 16384), 16, 0, 0); \
    __builtin_amdgcn_global_load_lds((const unsigned*)(kt_ + offK[1]), (LAS unsigned*)(b_ + 16384 + 8192), 16, 0, 0); } while (0)
#define QK(P0, P1, bf) do { const int kb_ = lds0 + (bf) * RING; bf16x8 b0_[2], b1_[2]; \
    _Pragma("unroll") for (int i_ = 0; i_ < 2; ++i_) { b0_[i_] = lds_read128<0>(kb_ + kad[i_]); b1_[i_] = lds_read128<8192>(kb_ + kad[i_]); } \
    asm volatile("s_waitcnt lgkmcnt(0)" ::: "memory"); SBAR(); \
    P0 = __builtin_amdgcn_mfma_f32_32x32x16_bf16(b0_[0], qr[0], f32x16{}, 0, 0, 0); P1 = __builtin_amdgcn_mfma_f32_32x32x16_bf16(b1_[0], qr[0], f32x16{}, 0, 0, 0); \
    P0 = __builtin_amdgcn_mfma_f32_32x32x16_bf16(b0_[1], qr[1], P0, 0, 0, 0); P1 = __builtin_amdgcn_mfma_f32_32x32x16_bf16(b1_[1], qr[1], P1, 0, 0, 0); SBAR(); \
    _Pragma("unroll") for (int i_ = 0; i_ < 2; ++i_) { b0_[i_] = lds_read128<0>(kb_ + kad[2 + i_]); b1_[i_] = lds_read128<8192>(kb_ + kad[2 + i_]); } \
    asm volatile("s_waitcnt lgkmcnt(0)" ::: "memory"); SBAR(); \
    P0 = __builtin_amdgcn_mfma_f32_32x32x16_bf16(b0_[0], qr[2], P0, 0, 0, 0); P1 = __builtin_amdgcn_mfma_f32_32x32x16_bf16(b1_[0], qr[2], P1, 0, 0, 0); \
    P0 = __builtin_amdgcn_mfma_f32_32x32x16_bf16(b0_[1], qr[3], P0, 0, 0, 0); P1 = __builtin_amdgcn_mfma_f32_32x32x16_bf16(b1_[1], qr[3], P1, 0, 0, 0); \
    SBAR(); } while (0)
#define STEP(C0, C1, N0, N1, j) do { \
    if ((j) + 1 < NT) { \
        if ((j) + 2 < NT) asm volatile("s_waitcnt vmcnt(4)" ::: "memory"); else asm volatile("s_waitcnt vmcnt(0)" ::: "memory"); \
        __builtin_amdgcn_s_barrier(); asm volatile("" ::: "memory"); \
        if ((j) + 3 < NT) GLDS((j) + 3, ((j) + 3) & 3); \
        if ((j) + 1 < wNT) QK(N0, N1, ((j) + 1) & 3); } \
    if ((j) < wNT) { \
        if (__builtin_expect(((j) + 1) * 64 > nkeys, 0)) { const int kb = (j) * 64 + 4 * hi; asm volatile("" ::: "memory"); \
            _Pragma("unroll") for (int r = 0; r < 16; ++r) { const int kv = kb + (r & 3) + 8 * (r >> 2); if (kv >= nkeys) C0[r] = -1e30f; if (kv + 32 >= nkeys) C1[r] = -1e30f; } } \
        float alpha; bf16x8 pa0, pa1, pa2, pa3; const int vb = lds0 + ((j) & 3) * RING + vrb; \
        partialSM(C0, C1, m_reg, alpha, C, thr); \
        finishSM(C0, C1, alpha, l_reg, pa0, pa1, pa2, pa3); \
        SBAR(); \
        if (__any(alpha < 1.f)) { \
            _Pragma("unroll") for (int d = 0; d < (PVHALF ? 2 : 4); ++d) _Pragma("unroll") for (int r = 0; r < 16; ++r) o[d][r] *= alpha; } \
        if constexpr (!PVHALF) pv_ks<0, 4>(o, vb, pa0, pa1, pa2, pa3); \
        else { if (pvsel == 0) pv_ks<0, 2>(o, vb, pa0, pa1, pa2, pa3); else pv_ks<2, 2>(o, vb, pa0, pa1, pa2, pa3); } } \
    } while (0)
    GLDS(0, 0);
#pragma unroll
    for (int d0 = 0; d0 < 4; ++d0) asm volatile("" :: "v"(qr[d0]));
    if (1 < NT) GLDS(1, 1); if (2 < NT) GLDS(2, 2);
    if (NT > 2) asm volatile("s_waitcnt vmcnt(8)" ::: "memory"); else if (NT == 2) asm volatile("s_waitcnt vmcnt(4)" ::: "memory"); else asm volatile("s_waitcnt vmcnt(0)" ::: "memory");
    __builtin_amdgcn_s_barrier(); asm volatile("" ::: "memory");
    f32x16 pA0 = f32x16{}, pA1 = f32x16{}, pB0 = f32x16{}, pB1 = f32x16{};
    if (0 < wNT) QK(pA0, pA1, 0);
    for (int j = 0; j < NT; j += 2) {
        STEP(pA0, pA1, pB0, pB1, j);
        if (j + 1 < NT) STEP(pB0, pB1, pA0, pA1, j + 1);
    }
#undef STEP
#undef QK
#undef GLDS
    __syncthreads();
}

struct Ctx { LAS unsigned char* lds; int lane, wid, r32, hi; };

template <int ND> __device__ __forceinline__ void store_gated(const f32x16 (&o)[4], float scale, const bf16_t* gate, bf16_t* out, int hi) {
#pragma unroll
    for (int d = 0; d < ND; ++d)
#pragma unroll
        for (int g = 0; g < 4; ++g) { const int dv = 32 * d + 8 * g + 4 * hi;
            const u32x2 gt = *(const u32x2*)(gate + dv);
            f32x4 v; v.x = o[d][4 * g] * scale * silu(bflo(gt.x)); v.y = o[d][4 * g + 1] * scale * silu(bfhi(gt.x));
            v.z = o[d][4 * g + 2] * scale * silu(bflo(gt.y)); v.w = o[d][4 * g + 3] * scale * silu(bfhi(gt.y));
            st_bf4(out + dv, v); }
}

__device__ __forceinline__ void diff_unit(const Ctx& cx, bool samp, int b, int h, int qb, const bf16_t* PA, const bf16_t* KS, const bf16_t* VS, bf16_t* MIX, const float* gnorm, float lam) {
    const int c = cx.wid >> 2, rb = cx.wid & 3;
    long row; bool valid; int NT, wNT, nkeys; const bf16_t* Kb; const bf16_t* Vb; long ldk;
    if (!samp) { row = (long)b * 4096 + qb * 128 + rb * 32 + cx.r32; valid = true; NT = 2 * qb + 2; wNT = 2 * qb + 1 + (rb >> 1); nkeys = NT * 64;
                 Kb = PA + (size_t)b * 4096 * NA + 512 + h * 128; Vb = Kb + 512; ldk = NA; }
    else { row = NP + b * 16 + (cx.r32 < 15 ? cx.r32 : 15); valid = (rb == 0) && cx.r32 < 16; NT = 65; wNT = (rb == 0) ? 65 : 0; nkeys = 4112;
           Kb = KS + (size_t)b * KSROWS * 512 + h * 128; Vb = VS + (size_t)b * KSROWS * 512 + h * 128; ldk = 512; }
    const bf16_t* qptr = PA + (size_t)row * NA + h * 128 + c * 64 + cx.hi * 8;
    f32x16 o[4]; float m, l;
    attn_core_pipe<false>(cx.lds, Kb, ldk, Vb, ldk, NT, nkeys, qptr, wNT, c * 128, 0, C64, THR64, o, m, l);
    const float inv = l > 0.f ? 1.f / l : 0.f;
    LAS float* xch = (LAS float*)cx.lds + rb * 4096;
    if (c == 1) {
#pragma unroll
        for (int d = 0; d < 4; ++d)
#pragma unroll
            for (int r = 0; r < 16; ++r) xch[(d * 16 + r) * 64 + cx.lane] = o[d][r] * inv; }
    __syncthreads();
    if (c == 0) {
        float ss = 0.f;
#pragma unroll
        for (int d = 0; d < 4; ++d)
#pragma unroll
            for (int r = 0; r < 16; ++r) { const float od = o[d][r] * inv - lam * xch[(d * 16 + r) * 64 + cx.lane]; o[d][r] = od; ss += od * od; }
        ss += __shfl_xor(ss, 32);
        const float rms = rsqrtf(ss * (1.f / 128.f) + 1e-5f) * 0.8f;
        if (valid) {
            const bf16_t* gate = PA + (size_t)row * NA + 1536 + h * 128; bf16_t* out = MIX + (size_t)row * DM + h * 128;
#pragma unroll
            for (int d = 0; d < 4; ++d)
#pragma unroll
                for (int g = 0; g < 4; ++g) { const int dv = 32 * d + 8 * g + 4 * cx.hi;
                    const f32x4 gn = *(const f32x4*)(gnorm + dv); const u32x2 gt = *(const u32x2*)(gate + dv);
                    f32x4 v; v.x = o[d][4 * g] * rms * gn.x * silu(bflo(gt.x)); v.y = o[d][4 * g + 1] * rms * gn.y * silu(bfhi(gt.x));
                    v.z = o[d][4 * g + 2] * rms * gn.z * silu(bflo(gt.y)); v.w = o[d][4 * g + 3] * rms * gn.w * silu(bfhi(gt.y));
                    st_bf4(out + dv, v); }
        }
    }
    __syncthreads();
}
__device__ __forceinline__ void mem_unit(const Ctx& cx, bool samp, int b, int h, int qb, const bf16_t* P, int ldp, int qcol, int gcol,
                                         const bf16_t* Kb, const bf16_t* Vb, long ldk, bf16_t* MIX) {
    long row; bool valid; int wNT;
    if (!samp) { row = (long)b * 4096 + qb * 256 + cx.wid * 32 + cx.r32; valid = true; wNT = 4; }
    else { row = NP + b * 16 + (cx.r32 < 15 ? cx.r32 : 15); valid = (cx.wid == 0) && cx.r32 < 16; wNT = (cx.wid == 0) ? 4 : 0; }
    const bf16_t* qptr = P + (size_t)row * ldp + qcol + h * 128 + cx.hi * 8;
    f32x16 o[4]; float m, l;
    attn_core<8, false>(cx.lds, Kb, ldk, Vb, ldk, 4, 256, qptr, wNT, 0, 0, C128, THR128, o, m, l);
    const float inv = l > 0.f ? 1.f / l : 0.f;
    if (valid) store_gated<4>(o, inv, P + (size_t)row * ldp + gcol + h * 128, MIX + (size_t)row * DM + 512 + h * 128, cx.hi);
}
__device__ __forceinline__ void swa_unit(const Ctx& cx, bool samp, int b, int c, int half, const bf16_t* PB, const bf16_t* KSW, const bf16_t* VSW, bf16_t* MIX, const float* sinks) {
    const int head = cx.wid, kv = cx.wid >> 2;
    long row; bool valid; int NT, nkeys; const bf16_t* Kb; const bf16_t* Vb; long ldk;
    if (!samp) { row = (long)b * 4096 + c * 64 + half * 32 + cx.r32; valid = true; const int c0 = c > 2 ? c - 2 : 0; NT = c - c0 + 1; nkeys = NT * 64;
                 Kb = PB + ((size_t)b * 4096 + c0 * 64) * NB + 2048; Vb = Kb + 128; ldk = NB; }
    else { row = NP + b * 16 + (cx.r32 < 15 ? cx.r32 : 15); valid = cx.r32 < 16; NT = 3; nkeys = 144;
           Kb = KSW + (size_t)b * SWROWS * 128; Vb = VSW + (size_t)b * SWROWS * 128; ldk = 128; }
    const bf16_t* qptr = PB + (size_t)row * NB + head * 64 + cx.hi * 8;
    f32x16 o[4]; float m, l;
    attn_core_pipe<true>(cx.lds, Kb, ldk, Vb, ldk, NT, nkeys, qptr, NT, kv * 128, kv, C64, THR64, o, m, l);
    const float lt = l + __builtin_amdgcn_exp2f(sinks[head] * LOG2E - m * C64);
    const float inv = 1.f / lt;
    if (valid) store_gated<2>(o, inv, PB + (size_t)row * NB + 512 + head * 64, MIX + (size_t)row * DM + head * 64, cx.hi);
}
#undef KSWZ
#undef SBAR
}

__device__ __forceinline__ float wave_sum(float v) {
#pragma unroll
    for (int o = 1; o < 64; o <<= 1) v += __shfl_xor(v, o);
    return v;
}
__device__ __forceinline__ void p0_transpose_item(const float* W, int K, int N, bf16_t* WT, int row_off, LAS float* scr, int item, int lane) {
    const int nblk = N / 32, kb = item / nblk, nb = item % nblk, k0 = 64 * kb, n0 = 32 * nb;
#pragma unroll 8
    for (int i = 0; i < 32; ++i) { const int kk = 2 * i + (lane >> 5); scr[kk * 33 + (lane & 31)] = W[(size_t)(k0 + kk) * N + n0 + (lane & 31)]; }
    asm volatile("s_waitcnt lgkmcnt(0)" ::: "memory");
    const int c = lane & 7;
#pragma unroll
    for (int j = 0; j < 4; ++j) { const int n = (lane >> 3) + 8 * j; const LAS float* s = scr + (8 * c) * 33 + n;
        u32x4 o; o.x = cvtpk(s[0 * 33], s[1 * 33]); o.y = cvtpk(s[2 * 33], s[3 * 33]); o.z = cvtpk(s[4 * 33], s[5 * 33]); o.w = cvtpk(s[6 * 33], s[7 * 33]);
        *(u32x4*)(WT + (size_t)(row_off + n0 + n) * K + k0 + 8 * c) = o; }
    asm volatile("s_waitcnt lgkmcnt(0)" ::: "memory");
}
__device__ __forceinline__ void p0_transpose_item_ln(const float* W, int K, int N, bf16_t* WT, int row_off, LAS float* scr, int item, int lane, const float* g, const float* b, float* CS, float* BW) {
    const int nblk = N / 32, kb = item / nblk, nb = item % nblk, k0 = 64 * kb, n0 = 32 * nb;
    float csp = 0.f, bwp = 0.f;
#pragma unroll 8
    for (int i = 0; i < 32; ++i) { const int kk = 2 * i + (lane >> 5); const float w = W[(size_t)(k0 + kk) * N + n0 + (lane & 31)]; const float gw = g[k0 + kk] * w;
        scr[kk * 33 + (lane & 31)] = gw; csp += bflo(cvtpk(gw, 0.f)); bwp += b[k0 + kk] * w; }
    csp += __shfl_xor(csp, 32); bwp += __shfl_xor(bwp, 32);
    if (lane < 32) { atomicAdd(CS + row_off + n0 + lane, csp); atomicAdd(BW + row_off + n0 + lane, bwp); }
    asm volatile("s_waitcnt lgkmcnt(0)" ::: "memory");
    const int c = lane & 7;
#pragma unroll
    for (int j = 0; j < 4; ++j) { const int n = (lane >> 3) + 8 * j; const LAS float* sp = scr + (8 * c) * 33 + n;
        u32x4 o; o.x = cvtpk(sp[0 * 33], sp[1 * 33]); o.y = cvtpk(sp[2 * 33], sp[3 * 33]); o.z = cvtpk(sp[4 * 33], sp[5 * 33]); o.w = cvtpk(sp[6 * 33], sp[7 * 33]);
        *(u32x4*)(WT + (size_t)(row_off + n0 + n) * K + k0 + 8 * c) = o; }
    asm volatile("s_waitcnt lgkmcnt(0)" ::: "memory");
}
__device__ __forceinline__ void ln_rows(const float* zin, float* fout, bf16_t* bout, const float* g, const float* bta, int gw, int NGW, int lane) {
    f32x4 g4[4], b4[4];
#pragma unroll
    for (int j = 0; j < 4; ++j) { g4[j] = *(const f32x4*)(g + 4 * lane + 256 * j); b4[j] = *(const f32x4*)(bta + 4 * lane + 256 * j); }
    for (int m = gw; m < MA; m += NGW) {
        const float* zr = zin + (size_t)m * DM + 4 * lane;
        f32x4 v[4]; float s = 0.f;
#pragma unroll
        for (int j = 0; j < 4; ++j) { v[j] = *(const f32x4*)(zr + 256 * j); s += (v[j].x + v[j].y) + (v[j].z + v[j].w); }
        const float mean = wave_sum(s) * (1.f / DM); float s2 = 0.f;
#pragma unroll
        for (int j = 0; j < 4; ++j) { v[j] = v[j] - mean; s2 += (v[j].x * v[j].x + v[j].y * v[j].y) + (v[j].z * v[j].z + v[j].w * v[j].w); }
        const float rstd = rsqrtf(wave_sum(s2) * (1.f / DM) + 1e-5f);
#pragma unroll
        for (int j = 0; j < 4; ++j) { const f32x4 y = v[j] * rstd * g4[j] + b4[j];
            *(f32x4*)(fout + (size_t)m * DM + 4 * lane + 256 * j) = y;
            if (bout) st_bf4(bout + (size_t)m * DM + 4 * lane + 256 * j, y); }
    }
}

#define XB_TMO      128
#define XB_XCNT(j)  (256  + 64 * (j))
#define XB_XSUB(j)  (1280 + 64 * (j))
#define XB_XGEN(j)  (2304 + 64 * (j))
#define XB_TOP      3328
#define XB_TOPGEN   3392
#define XCD_BAR_WORDS 3456
#define XB_SPIN_CAP (1u << 18)

__device__ __forceinline__ unsigned xb_ld(unsigned* p)              { return __hip_atomic_load(p, __ATOMIC_RELAXED, __HIP_MEMORY_SCOPE_AGENT); }
__device__ __forceinline__ unsigned xb_add(unsigned* p, unsigned v) { return __hip_atomic_fetch_add(p, v, __ATOMIC_RELAXED, __HIP_MEMORY_SCOPE_AGENT); }
__device__ __forceinline__ unsigned xb_xcc_id() { return (unsigned)__builtin_amdgcn_s_getreg((3 << 11) | 20) & 0xFu; }
#define XB_SPIN(cond, bar) do { unsigned _sp = 0; while (cond) { __builtin_amdgcn_s_sleep(1); \
    if ((++_sp & 255u) == 0u) { if (xb_ld(&(bar)[XB_TMO])) break; if (_sp > XB_SPIN_CAP) { atomicAdd(&(bar)[XB_TMO], 1u); break; } } } } while (0)

struct XcdBarrier {
    unsigned* bar; unsigned x;
    volatile LAS unsigned* st;
};

__device__ __forceinline__ XcdBarrier xcd_barrier_post(unsigned* bar, volatile LAS unsigned* st) {
    XcdBarrier b; b.bar = bar; b.x = xb_xcc_id(); b.st = st;
    if (threadIdx.x == 0) (void)xb_add(&bar[XB_XCNT(b.x)], 1u);
    return b;
}
__device__ __forceinline__ void xcd_barrier_complete(unsigned* bar, unsigned x, unsigned& nloc, unsigned& nx) {
    const unsigned G = gridDim.x * gridDim.y * gridDim.z;
    unsigned sum, cnt, mine, sp = 0u;
    for (;;) {
        sum = 0u; cnt = 0u; mine = 0u;
#pragma unroll
        for (unsigned j = 0; j < 16; ++j) { const unsigned c = xb_ld(&bar[XB_XCNT(j)]); sum += c; cnt += (c > 0u) ? 1u : 0u; mine = (j == x) ? c : mine; }
        if (sum == G) break;
        __builtin_amdgcn_s_sleep(1);
        if ((++sp & 255u) == 0u) { if (xb_ld(&bar[XB_TMO])) break; if (sp > XB_SPIN_CAP) { atomicAdd(&bar[XB_TMO], 1u); break; } }
    }
    nloc = mine > 0u ? mine : 1u; nx = cnt > 0u ? cnt : 1u;
}

__device__ __forceinline__ void xcd_barrier(const XcdBarrier& b) {
    asm volatile("s_waitcnt vmcnt(0)" ::: "memory");
    __syncthreads();
    if (threadIdx.x == 0) {
        unsigned* bar = b.bar;
        __builtin_amdgcn_s_waitcnt(0);
        unsigned nloc = b.st[0], nx = b.st[1];
        if (nloc == 0u) { xcd_barrier_complete(bar, b.x, nloc, nx); b.st[0] = nloc; b.st[1] = nx; }
        const unsigned old = xb_add(&bar[XB_XSUB(b.x)], 1u);
        const unsigned gen = old / nloc;
        if (old + 1u == (gen + 1u) * nloc) {
            __builtin_amdgcn_fence(__ATOMIC_RELEASE, "agent");
            asm volatile("s_waitcnt vmcnt(0)" ::: "memory");
            const unsigned og = xb_add(&bar[XB_TOP], 1u);
            const unsigned tg = og / nx;
            if (og + 1u == (tg + 1u) * nx) xb_add(&bar[XB_TOPGEN], 1u);
            else XB_SPIN(xb_ld(&bar[XB_TOPGEN]) == tg, bar);
            __builtin_amdgcn_fence(__ATOMIC_ACQUIRE, "agent");
            xb_add(&bar[XB_XGEN(b.x)], 1u);
            asm volatile("s_waitcnt vmcnt(0)" ::: "memory");
        } else {
            XB_SPIN(xb_ld(&bar[XB_XGEN(b.x)]) == gen, bar);
            __builtin_amdgcn_fence(__ATOMIC_ACQUIRE, "agent");
            asm volatile("s_waitcnt vmcnt(0)" ::: "memory");
        }
    }
    __syncthreads();
}

struct Args { const float* in[22]; float* out; unsigned char* ws; int ph_lo, ph_hi, rep, pad; };
constexpr int NWAVES = 8, NPHASE = 9;

__global__ void __launch_bounds__(NWAVES * 64, 2) yoco_fwd(Args a) {
    extern __shared__ __attribute__((aligned(16))) unsigned char lds_raw[];
    LAS unsigned char* lds = (LAS unsigned char*)lds_raw;
    volatile LAS unsigned* MISC = (volatile LAS unsigned*)(lds + LDS_RING);
    cg::grid_group grid = cg::this_grid();
    const int tid = threadIdx.x, lane = tid & 63, wave = __builtin_amdgcn_readfirstlane(tid >> 6);
    const int G = gridDim.x, gw = blockIdx.x * NWAVES + wave, NGW = G * NWAVES;
    const long gtid = (long)blockIdx.x * (NWAVES * 64) + tid, NTHR = (long)G * (NWAVES * 64);
    unsigned char* ws = a.ws; float* dout = a.out;
    unsigned* ctl = (unsigned*)(ws + WS_CTL);
    float* ROPE = (float*)(ws + WS_ROPE);
    float* CSV = (float*)(ws + 32768); float* BWV = (float*)(ws + 49152); float* ST0 = (float*)(ws + 262144); float* ST1 = (float*)(ws + 524288);
    bf16_t* WA_t = (bf16_t*)(ws + WS_WA); bf16_t* WB_t = (bf16_t*)(ws + WS_WB); bf16_t* WM_t = (bf16_t*)(ws + WS_WM); bf16_t* WO_t = (bf16_t*)(ws + WS_WO);
    bf16_t* MEMB = (bf16_t*)(ws + WS_MEMB); bf16_t* MKV = (bf16_t*)(ws + WS_MKV); bf16_t* CMK = (bf16_t*)(ws + WS_CMK); bf16_t* CMV = (bf16_t*)(ws + WS_CMV);
    bf16_t* KSW = (bf16_t*)(ws + WS_KSW); bf16_t* VSW = (bf16_t*)(ws + WS_VSW); bf16_t* XA = (bf16_t*)(ws + WS_XA); bf16_t* ZB = XA;
    bf16_t* MIX = (bf16_t*)(ws + WS_MIX); bf16_t* PA = (bf16_t*)(ws + WS_PA); bf16_t* PB = PA;
    bf16_t* KS = (bf16_t*)(ws + WS_KS); bf16_t* VS = (bf16_t*)(ws + WS_VS);
    const int lo = a.ph_lo, hi_ph = a.ph_hi;
#define IN(k) (lo <= (k) && (k) < hi_ph)
    if (tid < 64) MISC[tid] = 0u;
    __syncthreads();
    XcdBarrier xbar = xcd_barrier_post(ctl + 1024, MISC + 8);
    if (a.ph_lo > 1000) grid.sync();
#define SEAM(k) do { if (IN(k) && IN((k) + 1)) xcd_barrier(xbar); } while (0)
    att::Ctx cx; cx.lds = lds; cx.lane = lane; cx.wid = wave; cx.r32 = lane & 31; cx.hi = lane >> 5;

    if (IN(0)) {
        LAS float* scr = (LAS float*)(lds + wave * 16384);
        for (int it = gw; it < 4736; it += NGW) {
            int r = it;
            if (r < 1536) { p0_transpose_item(a.in[9], DM, NA, WA_t, 0, scr, r, lane); continue; } r -= 1536;
            if (r < 1024) { p0_transpose_item_ln(a.in[15], DM, 2048, WB_t, 0, scr, r, lane, a.in[20], a.in[21], CSV, BWV); continue; } r -= 1024;
            if (r < 128) { p0_transpose_item_ln(a.in[17], DM, 256, WB_t, 2048, scr, r, lane, a.in[20], a.in[21], CSV, BWV); continue; } r -= 128;
            if (r < 1024) { const int l = r >> 9; p0_transpose_item(a.in[18] + (size_t)l * DM * DM, DM, DM, WM_t, l * 1024, scr, r & 511, lane); continue; } r -= 1024;
            { const int l = r >> 9; p0_transpose_item(a.in[19] + (size_t)l * DM * DM, DM, DM, WO_t, l * 1024, scr, r & 511, lane); }
        }
        for (long i = gtid; i < 2097152; i += NTHR) cvt8(a.in[0] + i * 8, XA + i * 8);
        for (long i = gtid; i < 32768; i += NTHR) cvt8(a.in[1] + i * 8, XA + (size_t)NP * DM + i * 8);
        for (long i = gtid; i < 131072; i += NTHR) cvt8(a.in[2] + i * 8, MEMB + i * 8);
        for (long i = gtid; i < 4194304; i += NTHR) { const long b = i >> 18, r = i & 262143; const size_t d = (size_t)b * KSROWS * 512 + r * 8;
            cvt8(a.in[3] + i * 8, KS + d); cvt8(a.in[4] + i * 8, VS + d); }
        for (long i = gtid; i < 524288; i += NTHR) { cvt8(a.in[7] + i * 8, CMK + i * 8); cvt8(a.in[8] + i * 8, CMV + i * 8); }
        for (long i = gtid; i < 32768; i += NTHR) { const long b = i >> 11, r = i & 2047; const size_t d = (size_t)b * SWROWS * 128 + r * 8;
            cvt8(a.in[5] + i * 8, KSW + d); cvt8(a.in[6] + i * 8, VSW + d);
            const int rw = (int)(r >> 4);
            if (rw >= 16) { const size_t od = ((size_t)b * 128 + rw - 16) * 128 + (r & 15) * 8;
                *(f32x4*)(dout + OFF_SKS + od) = *(const f32x4*)(a.in[5] + i * 8); *(f32x4*)(dout + OFF_SKS + od + 4) = *(const f32x4*)(a.in[5] + i * 8 + 4);
                *(f32x4*)(dout + OFF_SVS + od) = *(const f32x4*)(a.in[6] + i * 8); *(f32x4*)(dout + OFF_SVS + od + 4) = *(const f32x4*)(a.in[6] + i * 8 + 4); } }
        for (long i = gtid; i < 49152; i += NTHR) { const long b = i / 3072, r = i % 3072; const size_t d = ((size_t)b * KSROWS + 4112) * 512 + r * 8;
            *(u32x4*)(KS + d) = (u32x4){0u, 0u, 0u, 0u}; *(u32x4*)(VS + d) = (u32x4){0u, 0u, 0u, 0u}; }
        for (long i = gtid; i < 12288; i += NTHR) { const long b = i / 768, r = i % 768; const size_t d = ((size_t)b * SWROWS + 144) * 128 + r * 8;
            *(u32x4*)(KSW + d) = (u32x4){0u, 0u, 0u, 0u}; *(u32x4*)(VSW + d) = (u32x4){0u, 0u, 0u, 0u}; }
        for (long i = gtid; i < 4112 * 8; i += NTHR) { const int pos = (int)(i >> 3), fi = (int)(i & 7);
            const double inv = fi == 0 ? 1.0 : fi == 1 ? 0.19392274474868576 : fi == 2 ? 0.03760603093086393 : fi == 3 ? 0.007292664737217109 :
                               fi == 4 ? 0.001414213562373095 : fi == 5 ? 0.0002742481756762073 : fi == 6 ? 5.318295896944988e-05 : 1.031338537721246e-05;
            const double rev = (double)pos * inv * 0.15915494309189535; const float fr = (float)(rev - __builtin_rint(rev));
            ROPE[i * 2] = __builtin_amdgcn_cosf(fr); ROPE[i * 2 + 1] = __builtin_amdgcn_sinf(fr); }
    }
    SEAM(0);
    if (IN(1)) {
        pg8::Gemm g{XA, WA_t, NP, NA, DM}; pg8::StaticOrder S; S.init(NP, NA, G, (int)blockIdx.x);
        EpiWrap<EpiAF> E{{PA, dout, KS, VS, ROPE, 0.f, 0.f}, 0};
        pg8::gemm_phase<EpiWrap<EpiAF>, pg8::StaticOrder, true, true>(lds, g, S, E);
    }
    SEAM(1);
    if (IN(2)) {
        float s1 = 0.f, s2 = 0.f;
        for (int i = 0; i < 64; ++i) { s1 += a.in[10][i] * a.in[11][i]; s2 += a.in[12][i] * a.in[13][i]; }
        const float lam = __expf(s1) - __expf(s2) + 0.2f;
        unsigned* gdone = ctl + 256 + 64 * a.rep;
        if (blockIdx.x < 44) {
            if (blockIdx.x < 32) { pg8::Gemm g{MEMB, WM_t, 1024, 2048, DM}; pg8::StaticOrder S; S.init(1024, 2048, 32, (int)blockIdx.x);
                EpiWrap<EpiMemF> E{{MKV, dout, 0.f, 0.f}, 0};
                pg8::gemm_phase<EpiWrap<EpiMemF>, pg8::StaticOrder, true, true>(lds, g, S, E); }
            else { pg8::Gemm g{XA + (size_t)NP * DM, WA_t, 256, NA, DM}; pg8::StaticOrder S; S.init(256, NA, 12, (int)blockIdx.x - 32);
                EpiWrap<EpiAF> E{{PA, dout, KS, VS, ROPE, 0.f, 0.f}, NP};
                pg8::gemm_phase<EpiWrap<EpiAF>, pg8::StaticOrder, true, true>(lds, g, S, E); }
            asm volatile("s_waitcnt vmcnt(0)" ::: "memory"); __syncthreads();
            if (tid == 0) { __builtin_amdgcn_fence(__ATOMIC_RELEASE, "agent"); asm volatile("s_waitcnt vmcnt(0)" ::: "memory");
                            __hip_atomic_fetch_add(gdone, 1u, __ATOMIC_RELAXED, __HIP_MEMORY_SCOPE_AGENT); }
        }
        bool ready = false;
        for (;;) {
            if (tid == 0) MISC[0] = atomicAdd(ctl + 128 * a.rep, 1u);
            __syncthreads(); const unsigned u = MISC[0]; __syncthreads();
            if (u >= 896u) break;
            const bool needs = (u >= 256u && u < 320u) || u >= 576u;
            if (needs && !ready) {
                if (tid == 0) { unsigned sp = 0; while (__hip_atomic_load(gdone, __ATOMIC_RELAXED, __HIP_MEMORY_SCOPE_AGENT) < 44u && ++sp < (1u << 24)) __builtin_amdgcn_s_sleep(8);
                                __builtin_amdgcn_fence(__ATOMIC_ACQUIRE, "agent"); asm volatile("s_waitcnt vmcnt(0)" ::: "memory"); }
                __syncthreads(); ready = true;
            }
            if (u < 576u) { const bool samp = u >= 256u && u < 320u; const unsigned v = samp ? u - 256u : (u < 256u ? u : u - 64u);
                const int b = samp ? (int)(v >> 2) : (int)((v & 15u) >> 2), h = (int)(v & 3u), qb = samp ? 0 : 31 - (int)(v >> 4);
                att::diff_unit(cx, samp, b, h, qb, PA, KS, VS, MIX, a.in[14], lam); }
            else { const bool samp = u >= 832u; const unsigned v = samp ? u - 832u : u - 576u;
                const int b = samp ? (int)(v >> 2) : (int)(v >> 6), h = samp ? (int)(v & 3u) : (int)((v >> 4) & 3u), qb = samp ? 0 : (int)(v & 15u);
                const bf16_t* Kb = samp ? CMK + ((size_t)b * 256) * 512 + h * 128 : MKV + ((size_t)b * 256) * 2048 + h * 128;
                const bf16_t* Vb = samp ? CMV + ((size_t)b * 256) * 512 + h * 128 : Kb + 512;
                att::mem_unit(cx, samp, b, h, qb, PA, NA, 2048, 2560, Kb, Vb, samp ? 512 : 2048, MIX); }
        }
    }
    SEAM(2);
    if (IN(3)) {
        EpiMerge0F F0{ZB, ST0, 0.f, 0.f};
        { pg8::Gemm g{MIX, WO_t, NP, DM, DM}; pg8::StaticOrder S; S.init(NP, DM, G, (int)blockIdx.x);
          EpiWrap<EpiMerge0F> E{F0, 0};
          pg8::gemm_phase<EpiWrap<EpiMerge0F>, pg8::StaticOrder, true, true>(lds, g, S, E); }
        gemm_small<EpiMerge0F>(lds, MIX + (size_t)NP * DM, WO_t, DM, NP, (int)blockIdx.x, G, F0);
    }
    SEAM(3);
    if (IN(5)) {
        EpiBF FB{PB, dout, KSW, VSW, ROPE, ST0, CSV, BWV, 0.f, 0.f, {0.f, 0.f}, {0.f, 0.f}};
        { pg8::Gemm g{ZB, WB_t, NP, NB, DM}; pg8::StaticOrder S; S.init(NP, NB, G, (int)blockIdx.x);
          EpiWrap<EpiBF> E{FB, 0};
          pg8::gemm_phase<EpiWrap<EpiBF>, pg8::StaticOrder, true, true>(lds, g, S, E); }
        if (G == 256) { if (blockIdx.x >= 64) gemm_small<EpiBF>(lds, ZB + (size_t)NP * DM, WB_t, NB, NP, (int)blockIdx.x - 64, 192, FB); }
        else gemm_small<EpiBF>(lds, ZB + (size_t)NP * DM, WB_t, NB, NP, (int)blockIdx.x, G, FB);
    }
    SEAM(5);
    if (IN(6)) {
        for (;;) {
            if (tid == 0) MISC[0] = atomicAdd(ctl + 64 + 128 * a.rep, 1u);
            __syncthreads(); const unsigned u = MISC[0]; __syncthreads();
            if (u >= 848u) break;
            if (u < 320u) { const bool samp = u >= 256u; const unsigned v = samp ? u - 256u : u;
                const int b = samp ? (int)(v >> 2) : (int)(v >> 6), h = samp ? (int)(v & 3u) : (int)((v >> 4) & 3u), qb = samp ? 0 : (int)(v & 15u);
                const bf16_t* Kb = samp ? CMK + ((size_t)(16 + b) * 256) * 512 + h * 128 : MKV + ((size_t)b * 256) * 2048 + 1024 + h * 128;
                const bf16_t* Vb = samp ? CMV + ((size_t)(16 + b) * 256) * 512 + h * 128 : Kb + 512;
                att::mem_unit(cx, samp, b, h, qb, PB, NB, 1024, 1536, Kb, Vb, samp ? 512 : 2048, MIX); }
            else { const bool samp = u >= 832u; const unsigned v = samp ? u - 832u : u - 320u;
                const int b = samp ? (int)v : (int)(v >> 7), c = samp ? 0 : (int)((v >> 1) & 63u), half = samp ? 0 : (int)(v & 1u);
                att::swa_unit(cx, samp, b, c, half, PB, KSW, VSW, MIX, a.in[16]); }
        }
    }
    SEAM(6);
    if (IN(7)) {
        EpiMerge1F F1{ZB, ST0, a.in[20], a.in[21], dout, ST1, 0.f, 0.f, {0.f, 0.f}, {0.f, 0.f}};
        { pg8::Gemm g{MIX, WO_t + (size_t)DM * DM, NP, DM, DM}; pg8::StaticOrder S; S.init(NP, DM, G, (int)blockIdx.x);
          EpiWrap<EpiMerge1F> E{F1, 0};
          pg8::gemm_phase<EpiWrap<EpiMerge1F>, pg8::StaticOrder, true, true>(lds, g, S, E); }
        gemm_small<EpiMerge1F>(lds, MIX + (size_t)NP * DM, WO_t + (size_t)DM * DM, DM, NP, (int)blockIdx.x, G, F1);
    }
    SEAM(7);
    if (IN(8)) {
        const float* g1 = a.in[20] + DM; const float* b1 = a.in[21] + DM;
#pragma unroll 4
        for (long i = gtid; i < (long)MA * 256; i += NTHR) { const int row = (int)(i >> 8), c4 = (int)(i & 255) * 4;
            float mu, rstd; row_stats(ST1, row, mu, rstd);
            float* zp = dout + (size_t)row * DM + c4;
            *(f32x4*)zp = (*(const f32x4*)zp - mu) * rstd * *(const f32x4*)(g1 + c4) + *(const f32x4*)(b1 + c4); }
    }
#undef IN
#undef SEAM
}

#ifndef MK_N_LAUNCHES
#define MK_N_LAUNCHES 1
#endif
#ifndef PROBE_DUP
#define PROBE_DUP 0
#endif
extern "C" void kernel_launch(void* const* d_in, const int* in_sizes, int n_in, void* d_out, int out_size, void* d_ws, size_t ws_size, hipStream_t stream) {
    static int grid = 0;
    if (grid == 0) {
        if (n_in != 22 || ws_size < WS_END) { fprintf(stderr, "kernel_launch: unexpected n_in %d / ws %zu\n", n_in, ws_size); grid = -1; return; }
        int dev = 0, cus = 0, per_cu = 0;
        if (hipGetDevice(&dev) != hipSuccess || hipDeviceGetAttribute(&cus, hipDeviceAttributeMultiprocessorCount, dev) != hipSuccess) { grid = -1; return; }
        if (hipFuncSetAttribute((const void*)yoco_fwd, hipFuncAttributeMaxDynamicSharedMemorySize, LDS_BYTES) != hipSuccess) { fprintf(stderr, "kernel_launch: hipFuncSetAttribute failed\n"); grid = -1; return; }
        if (hipOccupancyMaxActiveBlocksPerMultiprocessor(&per_cu, (const void*)yoco_fwd, NWAVES * 64, LDS_BYTES) != hipSuccess || per_cu < 1) { fprintf(stderr, "kernel_launch: occupancy query says %d\n", per_cu); per_cu = 1; }
        (void)hipGetLastError();
        grid = cus;
    }
    if (grid < 0) return;
    (void)hipMemsetAsync((char*)d_ws + WS_CTL, 0, 1048576, stream);
    Args a{};
    for (int i = 0; i < 22; ++i) a.in[i] = (const float*)d_in[i];
    a.out = (float*)d_out; a.ws = (unsigned char*)d_ws;
#if MK_N_LAUNCHES == 1
    a.ph_lo = 0; a.ph_hi = NPHASE;
    void* args[] = {&a};
    hipError_t e = hipLaunchCooperativeKernel((const void*)yoco_fwd, dim3(grid), dim3(NWAVES * 64), args, LDS_BYTES, stream);
    if (e != hipSuccess) fprintf(stderr, "kernel_launch: cooperative launch failed: %s (grid %d)\n", hipGetErrorString(e), grid);
#else
    for (int p = 0; p < NPHASE; ++p) { a.ph_lo = p; a.ph_hi = p + 1;
        for (int r = 0; r < 1 + ((PROBE_DUP >> p) & 1); ++r) { a.rep = r; hipLaunchKernelGGL(yoco_fwd, dim3(grid), dim3(NWAVES * 64), LDS_BYTES, stream, a); } }
#endif
}
```

```cpp
#include <hip/hip_runtime.h>
#include <hip/hip_cooperative_groups.h>
#include <cstdio>
#include <cstdint>
namespace cg = cooperative_groups;
namespace pg8 {
#define PG8_LAS __attribute__((address_space(3)))
typedef unsigned short bf16_t;
typedef short bf16x8 __attribute__((ext_vector_type(8)));
typedef float f32x4 __attribute__((ext_vector_type(4)));
typedef unsigned u32x4 __attribute__((ext_vector_type(4)));
constexpr int BM = 256, BK = 64, HALF = 128, HTB = HALF * BK * 2  , STAGE_BYTES = 8 * HTB, NXCD = 8, WGM = 8;

__host__ __device__ __forceinline__ int lds_byte(int r, int c) { const int st = (r >> 4) * 2 + (c >> 5), rr = r & 15, cc = c & 31, ob = rr * 64 + cc * 2; return st * 1024 + (ob ^ (((ob >> 9) & 1) << 5)); }
__host__ __device__ __forceinline__ void stage_rc(int b, int& R, int& C) { const int st = b / 1024, sb = b % 1024, swz = sb ^ (((sb >> 9) & 1) << 5); R = (st >> 1) * 16 + swz / 64; C = (st & 1) * 32 + (swz % 64) / 2; }
__host__ __device__ __forceinline__ int perm32(int rho) { const int n = rho >> 4, i = rho & 15; return 8 * (i >> 2) + 4 * n + (i & 3); }

struct Unit { int pm, pn; };
struct Gemm { const bf16_t* A; const bf16_t* Bt; int M, N, K; };

struct StaticOrder {
    int nM, nN, nwg, G, c;
    __host__ __device__ void init(int M, int N, int G_, int c_) { nM = M / BM; nN = N / BM; nwg = nM * nN; G = G_; c = c_; }
    __host__ __device__ bool next(int i, Unit& u) const {
        const long L = (long)i * G + c; if (L >= nwg) return false;
        int wgid = (int)L; { const int q = nwg / NXCD, r = nwg % NXCD, xcd = wgid % NXCD, off = wgid / NXCD; wgid = (xcd < r ? xcd * (q + 1) : r * (q + 1) + (xcd - r) * q) + off; }
        const int nig = WGM * nN, gid = wgid / nig, fm = gid * WGM, gsz = (nM - fm) < WGM ? (nM - fm) : WGM;
        u.pm = fm + ((wgid % nig) % gsz); u.pn = (wgid % nig) / gsz; return true;
    }
    __device__ __forceinline__ void a_ready(const Unit&) const {}
    __device__ __forceinline__ void done(const Unit&) const {}
};
__device__ __forceinline__ unsigned cvt_pk_bf16(float lo, float hi) { unsigned r; asm volatile("v_cvt_pk_bf16_f32 %0, %1, %2" : "=v"(r) : "v"(lo), "v"(hi)); return r; }
typedef float f32x2 __attribute__((ext_vector_type(2)));
template <class Epi, class Sched, bool ALIGN_EPI = false, bool SP2 = false>
__device__ __forceinline__ void gemm_phase(PG8_LAS unsigned char* lds, const Gemm g, const Sched& S, const Epi& E) {
    const int tid = threadIdx.x, wid = __builtin_amdgcn_readfirstlane(tid >> 6), lane = tid & 63, wr = wid >> 2, wc = wid & 3, fr = lane & 15, fq = lane >> 4;
    const int K = g.K, nt = K / BK;
    unsigned voffA[2], voffB[2];
#pragma unroll
    for (int i = 0; i < 2; ++i) { int R, C; stage_rc(tid * 16 + i * 8192, R, C); const int Rb = Epi::PERM ? ((R & ~31) + perm32(R & 31)) : R;
        voffA[i] = (unsigned)(R * K + C) * 2u; voffB[i] = (unsigned)(Rb * K + C) * 2u; }
    const size_t kstep = (size_t)(BK * 2);
    const size_t hstep = (size_t)HALF * K * 2;
    const size_t tstep = 2 * hstep;
    const unsigned ldsw = (unsigned)wid * 1024u;
    const int aoff = lds_byte(wr * 64 + fr, fq * 8), boff = lds_byte(wc * 32 + fr, fq * 8);
#define PG8_SA(b, h) (((b) * 2 + (h)) * HTB)
#define PG8_SB(b, h) ((4 + (b) * 2 + (h)) * HTB)
#define PG8_STAGE(bufoff, gbase, voff) do { _Pragma("unroll") for (int _i = 0; _i < 2; ++_i) \
        __builtin_amdgcn_global_load_lds((const unsigned*)((const char*)(gbase) + (voff)[_i]), (PG8_LAS unsigned*)(lds + (bufoff) + ldsw + _i * 8192), 16, 0, 0); } while (0)
#define PG8_LDA(dst, b, h) do { _Pragma("unroll") for (int m = 0; m < 4; ++m) _Pragma("unroll") for (int k = 0; k < 2; ++k) dst[m][k] = *(const PG8_LAS bf16x8*)(lds + PG8_SA(b, h) + aoff + m * 2048 + k * 1024); } while (0)
#define PG8_LDB(dst, b, h) do { _Pragma("unroll") for (int n = 0; n < 2; ++n) _Pragma("unroll") for (int k = 0; k < 2; ++k) dst[n][k] = *(const PG8_LAS bf16x8*)(lds + PG8_SB(b, h) + boff + n * 2048 + k * 1024); } while (0)
#define PG8_MMA(ai, bj, At, Bt) do { __builtin_amdgcn_s_setprio(1); _Pragma("unroll") for (int m = 0; m < 4; ++m) _Pragma("unroll") for (int n = 0; n < 2; ++n) _Pragma("unroll") for (int k = 0; k < 2; ++k) \
        acc[ai][bj][m][n] = __builtin_amdgcn_mfma_f32_16x16x32_bf16(Bt[n][k], At[m][k], acc[ai][bj][m][n], 0, 0, 0); __builtin_amdgcn_s_setprio(0); } while (0)
#define PG8_WAIT_V(n) asm volatile("s_waitcnt vmcnt(" #n ")" ::: "memory")
#define PG8_WAIT_L(n) asm volatile("s_waitcnt lgkmcnt(" #n ")" ::: "memory")
#define PG8_BAR __builtin_amdgcn_s_barrier()
#define PG8_SCHED __builtin_amdgcn_sched_barrier(0)
    Unit cur, nxt; int ui = 0;
    if (!S.next(0, cur)) return;
    f32x4 acc[2][2][4][2];
#pragma unroll
    for (int a = 0; a < 2; ++a)
#pragma unroll
        for (int b = 0; b < 2; ++b)
#pragma unroll
            for (int m = 0; m < 4; ++m)
#pragma unroll
                for (int n = 0; n < 2; ++n) acc[a][b][m][n] = (f32x4){0.f, 0.f, 0.f, 0.f};
    bf16x8 At[4][2], B0[2][2], B1[2][2];
    const char* cA = (const char*)g.A + (size_t)cur.pm * tstep; const char* cB = (const char*)g.Bt + (size_t)cur.pn * tstep;
    S.a_ready(cur);
    if constexpr (SP2) {
        PG8_STAGE(PG8_SB(0, 0), cB, voffB); PG8_STAGE(PG8_SB(0, 1), cB + hstep, voffB); PG8_STAGE(PG8_SA(0, 0), cA, voffA); PG8_STAGE(PG8_SA(0, 1), cA + hstep, voffA);
        if (wr == 1) PG8_BAR;
        PG8_WAIT_V(2); PG8_BAR;
        PG8_STAGE(PG8_SB(1, 0), cB + kstep, voffB); PG8_STAGE(PG8_SA(1, 0), cA + kstep, voffA); PG8_STAGE(PG8_SB(1, 1), cB + hstep + kstep, voffB);
        PG8_WAIT_V(6); PG8_BAR;
    } else {
        PG8_STAGE(PG8_SB(0, 0), cB, voffB); PG8_STAGE(PG8_SA(0, 0), cA, voffA); PG8_STAGE(PG8_SB(0, 1), cB + hstep, voffB); PG8_STAGE(PG8_SA(0, 1), cA + hstep, voffA);
        if (wr == 1) PG8_BAR;
        PG8_WAIT_V(4); PG8_BAR;
        PG8_STAGE(PG8_SB(1, 0), cB + kstep, voffB); PG8_STAGE(PG8_SA(1, 0), cA + kstep, voffA); PG8_STAGE(PG8_SB(1, 1), cB + hstep + kstep, voffB);
        PG8_WAIT_V(6); PG8_BAR;
    }
    for (;;) {
        const bool has_next = S.next(ui + 1, nxt);
        const char* nA = has_next ? (const char*)g.A + (size_t)nxt.pm * tstep : cA; const char* nB = has_next ? (const char*)g.Bt + (size_t)nxt.pn * tstep : cB;
        for (int t = 0; t < nt; t += 2) {
            const bool last = (t == nt - 2);
            const char* a1 = cA + (size_t)(t + 1) * kstep;
            const char* a2 = last ? nA : cA + (size_t)(t + 2) * kstep; const char* b2 = last ? nB : cB + (size_t)(t + 2) * kstep;
            const char* a3 = a2 + kstep; const char* b3 = b2 + kstep;
            if (last && has_next) S.a_ready(nxt);
            if constexpr (SP2) {
            PG8_LDB(B0, 0, 0); PG8_LDB(B1, 0, 1); PG8_SCHED; PG8_LDA(At, 0, 0); PG8_STAGE(PG8_SA(1, 1), a1 + hstep, voffA);
            PG8_WAIT_V(8); PG8_WAIT_L(0); PG8_BAR; PG8_MMA(0, 0, At, B0); PG8_MMA(0, 1, At, B1); PG8_BAR; PG8_SCHED;
            PG8_LDA(At, 0, 1); PG8_STAGE(PG8_SB(0, 0), b2, voffB); PG8_STAGE(PG8_SB(0, 1), b2 + hstep, voffB); PG8_STAGE(PG8_SA(0, 0), a2, voffA);
            PG8_WAIT_V(8); PG8_WAIT_L(0); PG8_BAR; PG8_MMA(1, 0, At, B0); PG8_MMA(1, 1, At, B1); PG8_BAR; PG8_SCHED;
            PG8_LDB(B0, 1, 0); PG8_LDB(B1, 1, 1); PG8_SCHED; PG8_LDA(At, 1, 0); PG8_STAGE(PG8_SA(0, 1), a2 + hstep, voffA);
            PG8_WAIT_V(8); PG8_WAIT_L(0); PG8_BAR; PG8_MMA(0, 0, At, B0); PG8_MMA(0, 1, At, B1); PG8_BAR; PG8_SCHED;
            PG8_LDA(At, 1, 1); PG8_STAGE(PG8_SB(1, 0), b3, voffB); PG8_STAGE(PG8_SB(1, 1), b3 + hstep, voffB); PG8_STAGE(PG8_SA(1, 0), a3, voffA);
            PG8_WAIT_V(8); PG8_WAIT_L(0); PG8_BAR; PG8_MMA(1, 0, At, B0); PG8_MMA(1, 1, At, B1); PG8_BAR; PG8_SCHED;
            } else {
            PG8_LDB(B0, 0, 0); PG8_SCHED; PG8_LDA(At, 0, 0); PG8_STAGE(PG8_SA(1, 1), a1 + hstep, voffA);
            PG8_WAIT_L(8); PG8_BAR; PG8_WAIT_L(0); PG8_MMA(0, 0, At, B0); PG8_BAR; PG8_SCHED;
            PG8_LDB(B1, 0, 1); PG8_STAGE(PG8_SB(0, 0), b2, voffB);
            PG8_BAR; PG8_WAIT_L(0); PG8_MMA(0, 1, At, B1); PG8_BAR;
            PG8_LDA(At, 0, 1); PG8_STAGE(PG8_SA(0, 0), a2, voffA);
            PG8_BAR; PG8_WAIT_L(0); PG8_MMA(1, 0, At, B0); PG8_BAR; PG8_SCHED;
            PG8_STAGE(PG8_SB(0, 1), b2 + hstep, voffB);
            PG8_WAIT_V(6); PG8_BAR; PG8_MMA(1, 1, At, B1); PG8_BAR;
            PG8_LDB(B0, 1, 0); PG8_SCHED; PG8_LDA(At, 1, 0); PG8_STAGE(PG8_SA(0, 1), a2 + hstep, voffA);
            PG8_WAIT_L(8); PG8_BAR; PG8_WAIT_L(0); PG8_MMA(0, 0, At, B0); PG8_BAR; PG8_SCHED;
            PG8_LDB(B1, 1, 1); PG8_STAGE(PG8_SB(1, 0), b3, voffB);
            PG8_BAR; PG8_WAIT_L(0); PG8_MMA(0, 1, At, B1); PG8_BAR;
            PG8_LDA(At, 1, 1); PG8_STAGE(PG8_SA(1, 0), a3, voffA);
            PG8_BAR; PG8_WAIT_L(0); PG8_MMA(1, 0, At, B0); PG8_BAR; PG8_SCHED;
            PG8_STAGE(PG8_SB(1, 1), b3 + hstep, voffB);
            PG8_WAIT_V(6); PG8_BAR; PG8_MMA(1, 1, At, B1); PG8_BAR;
            }
        }
        if constexpr (ALIGN_EPI) { if (wr == 0) PG8_BAR; }
        if constexpr (!Epi::AFTER_DRAIN) { E(acc, cur, wr, wc, fr, fq); S.done(cur); }
        if (!has_next) break;
#pragma unroll
        for (int a = 0; a < 2; ++a)
#pragma unroll
            for (int b = 0; b < 2; ++b)
#pragma unroll
                for (int m = 0; m < 4; ++m)
#pragma unroll
                    for (int n = 0; n < 2; ++n) acc[a][b][m][n] = (f32x4){0.f, 0.f, 0.f, 0.f};
        cur = nxt; cA = nA; cB = nB; ++ui;
        if constexpr (ALIGN_EPI) { if (wr == 1) PG8_BAR; }
    }
    PG8_WAIT_V(0);
    if constexpr (!ALIGN_EPI) { if (wr == 0) PG8_BAR; }
    PG8_BAR;
    if constexpr (Epi::AFTER_DRAIN) { E.fused(acc, cur, wr, wc, fr, fq, lds, wid, lane); S.done(cur); }
#undef PG8_SA
#undef PG8_SB
#undef PG8_STAGE
#undef PG8_LDA
#undef PG8_LDB
#undef PG8_MMA
#undef PG8_WAIT_V
#undef PG8_WAIT_L
#undef PG8_BAR
#undef PG8_SCHED
}
}

typedef unsigned short bf16_t;
typedef short bf16x8 __attribute__((ext_vector_type(8)));
typedef short s16x4 __attribute__((ext_vector_type(4)));
typedef float f32x4 __attribute__((ext_vector_type(4)));
typedef float f32x16 __attribute__((ext_vector_type(16)));
typedef unsigned u32x4 __attribute__((ext_vector_type(4)));
typedef unsigned u32x2 __attribute__((ext_vector_type(2)));
#define LAS __attribute__((address_space(3)))

constexpr int DM = 1024, NP = 16384, NS = 256, MA = NP + NS;
constexpr int NA = 3072, NB = 2304;
constexpr int KSROWS = 4160, SWROWS = 192;
constexpr float DN_ALPHA = 1.41421356237309515f;
constexpr float LOG2E = 1.4426950408889634f;
constexpr float C64 = 0.125f * LOG2E, THR64 = 64.f;
constexpr float C128 = 0.088388347648318440f * LOG2E, THR128 = 90.5f;
constexpr size_t OFF_DKP = 17039360, OFF_DVP = 25427968, OFF_DKS = 33816576, OFF_DVS = 33947648, OFF_SKP = 34078720, OFF_SVP = 34144256,
                 OFF_SKS = 34209792, OFF_SVS = 34471936, OFF_MKP = 34734080, OFF_MVP = 35782656;
constexpr size_t MiB = 1u << 20;
constexpr size_t WS_CTL = 0, WS_ROPE = 1 * MiB, WS_WA = 2 * MiB, WS_WB = 8 * MiB, WS_WM = 13 * MiB, WS_WO = 17 * MiB, WS_MEMB = 21 * MiB, WS_MKV = 23 * MiB,
                 WS_CMK = 27 * MiB, WS_CMV = 35 * MiB, WS_KSW = 43 * MiB, WS_VSW = 44 * MiB, WS_XA = 46 * MiB, WS_MIX = 79 * MiB, WS_Z0 = 112 * MiB,
                 WS_PA = 177 * MiB, WS_KS = 275 * MiB, WS_VS = 340 * MiB, WS_END = 405 * MiB;
constexpr int LDS_RING = 131072, LDS_BYTES = LDS_RING + 256;

__device__ __forceinline__ unsigned cvtpk(float lo, float hi) { unsigned r; asm volatile("v_cvt_pk_bf16_f32 %0, %1, %2" : "=v"(r) : "v"(lo), "v"(hi)); return r; }
__device__ __forceinline__ float bflo(unsigned w) { return __uint_as_float(w << 16); }
__device__ __forceinline__ float bfhi(unsigned w) { return __uint_as_float(w & 0xffff0000u); }
__device__ __forceinline__ float silu(float x) { return x * __builtin_amdgcn_rcpf(1.f + __expf(-x)); }
__device__ __forceinline__ void cvt8(const float* s, bf16_t* d) {
    const f32x4 a = *(const f32x4*)s, b = *(const f32x4*)(s + 4);
    u32x4 w; w.x = cvtpk(a.x, a.y); w.y = cvtpk(a.z, a.w); w.z = cvtpk(b.x, b.y); w.w = cvtpk(b.z, b.w); *(u32x4*)d = w;
}

__device__ __forceinline__ f32x4 shfl4(f32x4 v, int m) { f32x4 p; p.x = __shfl_xor(v.x, m); p.y = __shfl_xor(v.y, m); p.z = __shfl_xor(v.z, m); p.w = __shfl_xor(v.w, m); return p; }
struct NoPre {};
template <class F> struct EpiWrap {
    static constexpr bool PERM = false, AFTER_DRAIN = false;
    F f; int rowbase, colbase;
    __device__ __forceinline__ void operator()(const f32x4 (&acc)[2][2][4][2], const pg8::Unit& u, int wr, int wc, int fr, int fq) const {
        F lf = f;
#pragma unroll
        for (int ai = 0; ai < 2; ++ai)
#pragma unroll
            for (int mp = 0; mp < 2; ++mp) {
                typename F::Pre pr[2][2][2]; f32x4 vv[2][2][2];
                const int row0 = rowbase + u.pm * 256 + ai * 128 + wr * 64 + mp * 32 + fr, colb = colbase + u.pn * 256 + wc * 32 + 4 * fq;
#pragma unroll
                for (int mm = 0; mm < 2; ++mm) { lf.row_begin(mm, row0 + mm * 16);
#pragma unroll
                    for (int bj = 0; bj < 2; ++bj)
#pragma unroll
                        for (int n = 0; n < 2; ++n) pr[mm][bj][n] = lf.pre(row0 + mm * 16, colb + bj * 128 + n * 16); }
#pragma unroll
                for (int mm = 0; mm < 2; ++mm)
#pragma unroll
                    for (int bj = 0; bj < 2; ++bj)
#pragma unroll
                        for (int n = 0; n < 2; ++n) vv[mm][bj][n] = lf.fix(mm, colb + bj * 128 + n * 16, acc[ai][bj][mp * 2 + mm][n], pr[mm][bj][n]);
#pragma unroll
                for (int mm = 0; mm < 2; ++mm) { const int row = row0 + mm * 16; lf.s = 0.f; lf.q = 0.f;
#pragma unroll
                    for (int bj = 0; bj < 2; ++bj)
#pragma unroll
                        for (int n = 0; n < 2; ++n) { const int col = colb + bj * 128 + n * 16; f32x4 p = vv[mm][bj][n];
                            if constexpr (F::ROPE) { if (lf.need_rope(col)) p = shfl4(p, 32); }
                            lf.quad(row, col, vv[mm][bj][n], p); }
                    if constexpr (F::STATS) { float s = lf.s, q = lf.q; s += __shfl_xor(s, 16); s += __shfl_xor(s, 32); q += __shfl_xor(q, 16); q += __shfl_xor(q, 32);
                        if (fq == 0) lf.commit(row, s, q); } }
            }
    }
};
__device__ __forceinline__ f32x4 rope_apply(f32x4 v, f32x4 p, int col, int pos, const float* rope) {
    const float* t = rope + ((size_t)pos * 8 + (col & 4)) * 2;
    const f32x4 t0 = *(const f32x4*)t, t1 = *(const f32x4*)(t + 4);
    const float sg = (col & 8) ? 1.f : -1.f;
    f32x4 o; o.x = v.x * t0.x + sg * p.x * t0.y; o.y = v.y * t0.z + sg * p.y * t0.w; o.z = v.z * t1.x + sg * p.z * t1.y; o.w = v.w * t1.z + sg * p.w * t1.w;
    return o;
}
__device__ __forceinline__ void st_bf4(bf16_t* p, f32x4 v) { u32x2 w; w.x = cvtpk(v.x, v.y); w.y = cvtpk(v.z, v.w); *(u32x2*)p = w; }
__device__ __forceinline__ void row_stats(const float* ST, int row, float& mu, float& rstd) {
    const float s = ST[2 * (size_t)row], q = ST[2 * (size_t)row + 1]; mu = s * (1.f / DM); rstd = rsqrtf(fmaxf(q * (1.f / DM) - mu * mu, 0.f) + 1e-5f);
}

struct EpiAF {
    static constexpr bool ROPE = true, STATS = false; typedef NoPre Pre;
    bf16_t* PA; float* dout; bf16_t* KS; bf16_t* VS; const float* rope; float s, q;
    __device__ __forceinline__ void row_begin(int, int) {}
    __device__ __forceinline__ Pre pre(int, int) const { return Pre{}; }
    __device__ __forceinline__ f32x4 fix(int, int, f32x4 v, const Pre&) const { return v; }
    __device__ __forceinline__ bool need_rope(int col) const { return (col >> 9) < 2 && ((col >> 4) & 3) == 0; }
    __device__ __forceinline__ void commit(int, float, float) {}
    __device__ __forceinline__ void quad(int row, int col, f32x4 v, f32x4 p) {
        const bool samp = row >= NP; const int rs = row - NP;
        const int pos = samp ? 4096 + (rs & 15) : (row & 4095);
        const int region = col >> 9;
        if (need_rope(col)) v = rope_apply(v, p, col, pos, rope);
        st_bf4(PA + (size_t)row * NA + col, v);
        if (region == 1 || region == 2) {
            const int c = col & 511;
            if (!samp) *(f32x4*)(dout + (region == 1 ? OFF_DKP : OFF_DVP) + (size_t)row * 512 + c) = v;
            else { *(f32x4*)(dout + (region == 1 ? OFF_DKS : OFF_DVS) + (size_t)rs * 512 + c) = v;
                   st_bf4((region == 1 ? KS : VS) + ((size_t)(rs >> 4) * KSROWS + 4096 + (rs & 15)) * 512 + c, v); }
        }
    }
};
struct EpiMemF {
    static constexpr bool ROPE = false, STATS = false; typedef NoPre Pre;
    bf16_t* MKV; float* dout; float s, q;
    __device__ __forceinline__ void row_begin(int, int) {}
    __device__ __forceinline__ Pre pre(int, int) const { return Pre{}; }
    __device__ __forceinline__ f32x4 fix(int, int, f32x4 v, const Pre&) const { return v; }
    __device__ __forceinline__ void commit(int, float, float) {}
    __device__ __forceinline__ void quad(int row, int col, f32x4 v, f32x4) {
        st_bf4(MKV + (size_t)row * 2048 + col, v);
        const int l = col >> 10, c = col & 1023;
        *(f32x4*)(dout + (c < 512 ? OFF_MKP : OFF_MVP) + (size_t)l * 524288 + (size_t)row * 512 + (c & 511)) = v;
    }
};
struct EpiMerge0F {
    static constexpr bool ROPE = false, STATS = true; typedef u32x2 Pre;
    bf16_t* ZB; float* ST; float s, q;
    __device__ __forceinline__ void row_begin(int, int) {}
    __device__ __forceinline__ Pre pre(int row, int col) const { return *(const u32x2*)(ZB + (size_t)row * DM + col); }
    __device__ __forceinline__ f32x4 fix(int, int, f32x4 v, const Pre& x) const { return (f32x4){bflo(x.x), bfhi(x.x), bflo(x.y), bfhi(x.y)} * DN_ALPHA + v; }
    __device__ __forceinline__ void commit(int row, float ss, float qq) { atomicAdd(ST + 2 * (size_t)row, ss); atomicAdd(ST + 2 * (size_t)row + 1, qq); }
    __device__ __forceinline__ void quad(int row, int col, f32x4 z, f32x4) {
        st_bf4(ZB + (size_t)row * DM + col, z);
        s += (z.x + z.y) + (z.z + z.w); q += (z.x * z.x + z.y * z.y) + (z.z * z.z + z.w * z.w);
    }
};
struct EpiMerge1F {
    static constexpr bool ROPE = false, STATS = true; typedef u32x2 Pre;
    const bf16_t* ZB; const float* ST0; const float* g0; const float* b0; bf16_t* out; float* ST1; float s, q, mu[2], rstd[2];
    __device__ __forceinline__ void row_begin(int sl, int row) { row_stats(ST0, row, mu[sl], rstd[sl]); }
    __device__ __forceinline__ Pre pre(int row, int col) const { return *(const u32x2*)(ZB + (size_t)row * DM + col); }
    __device__ __forceinline__ f32x4 fix(int sl, int col, f32x4 v, const Pre& z) const {
        const f32x4 z0 = (f32x4){bflo(z.x), bfhi(z.x), bflo(z.y), bfhi(z.y)};
        const f32x4 g = *(const f32x4*)(g0 + col), b = *(const f32x4*)(b0 + col); return ((z0 - mu[sl]) * rstd[sl] * g + b) * DN_ALPHA + v; }
    __device__ __forceinline__ void commit(int row, float ss, float qq) { atomicAdd(ST1 + 2 * (size_t)row, ss); atomicAdd(ST1 + 2 * (size_t)row + 1, qq); }
    __device__ __forceinline__ void quad(int row, int col, f32x4 z, f32x4) {
        st_bf4(out + (size_t)row * DM + col, z);
        s += (z.x + z.y) + (z.z + z.w); q += (z.x * z.x + z.y * z.y) + (z.z * z.z + z.w * z.w);
    }
};
struct PreB { f32x4 c, b; };
struct EpiBF {
    static constexpr bool ROPE = true, STATS = false; typedef PreB Pre;
    bf16_t* PB; float* dout; bf16_t* KSW; bf16_t* VSW; const float* rope; const float* ST0; const float* CS; const float* BW; float s, q, mu[2], rstd[2];
    __device__ __forceinline__ void row_begin(int sl, int row) { row_stats(ST0, row, mu[sl], rstd[sl]); }
    __device__ __forceinline__ Pre pre(int, int col) const { Pre p; p.c = *(const f32x4*)(CS + col); p.b = *(const f32x4*)(BW + col); return p; }
    __device__ __forceinline__ f32x4 fix(int sl, int, f32x4 v, const Pre& p) const { return (v - p.c * mu[sl]) * rstd[sl] + p.b; }
    __device__ __forceinline__ bool need_rope(int col) const { return (col < 512 || (col >= 2048 && col < 2176)) && ((col >> 4) & 3) == 0; }
    __device__ __forceinline__ void commit(int, float, float) {}
    __device__ __forceinline__ void quad(int row, int col, f32x4 v, f32x4 p) {
        const bool samp = row >= NP; const int rs = row - NP;
        const int t = samp ? (rs & 15) : (row & 4095);
        const int pos = samp ? 4096 + t : t;
        const bool isk = col >= 2048 && col < 2176;
        if (need_rope(col)) v = rope_apply(v, p, col, pos, rope);
        st_bf4(PB + (size_t)row * NB + col, v);
        if (col >= 2048) {
            const int cc = col & 127;
            if (!samp) { if (t >= 3968) *(f32x4*)(dout + (isk ? OFF_SKP : OFF_SVP) + ((size_t)(row >> 12) * 128 + (t - 3968)) * 128 + cc) = v; }
            else { const int b = rs >> 4;
                   *(f32x4*)(dout + (isk ? OFF_SKS : OFF_SVS) + ((size_t)b * 128 + 112 + t) * 128 + cc) = v;
                   st_bf4((isk ? KSW : VSW) + ((size_t)b * SWROWS + 128 + t) * 128 + cc, v); }
        }
    }
};
template <class F> __device__ __forceinline__ void gemm_small(LAS unsigned char* lds, const bf16_t* A, const bf16_t* Bt, int N, int rowbase, int ustart, int G, const F& f, int colbase = 0) {
    const int tid = threadIdx.x, lane = tid & 63, r32 = lane & 31, hi = lane >> 5, wid = __builtin_amdgcn_readfirstlane(tid >> 6);
    const int nu = 8 * (N / 32);
    for (int u = ustart; u < nu; u += G) {
        const int row0 = (u & 7) * 32, colw = (u >> 3) * 32, col0 = colbase + colw;
        const bf16_t* ap = A + (size_t)(row0 + r32) * DM + wid * 128 + hi * 8; const bf16_t* bp = Bt + (size_t)(colw + r32) * DM + wid * 128 + hi * 8;
        bf16x8 af[8], bfr[8];
#pragma unroll
        for (int k = 0; k < 8; ++k) { af[k] = *(const bf16x8*)(ap + 16 * k); bfr[k] = *(const bf16x8*)(bp + 16 * k); }
        f32x16 acc = f32x16{};
#pragma unroll
        for (int k = 0; k < 8; ++k) acc = __builtin_amdgcn_mfma_f32_32x32x16_bf16(bfr[k], af[k], acc, 0, 0, 0);
        LAS float* part = (LAS float*)lds + wid * 1024;
#pragma unroll
        for (int r = 0; r < 16; ++r) part[r * 64 + lane] = acc[r];
        __syncthreads();
        if (wid < 2) {
            F lf = f; f32x4 qd[2];
#pragma unroll
            for (int e = 0; e < 2; ++e) { float t[4];
#pragma unroll
                for (int c = 0; c < 4; ++c) { const int r = 4 * (2 * wid + e) + c; float a = 0.f;
#pragma unroll
                    for (int w = 0; w < 8; ++w) a += ((LAS float*)lds)[w * 1024 + r * 64 + lane];
                    t[c] = a; }
                qd[e] = (f32x4){t[0], t[1], t[2], t[3]}; }
            const int row = rowbase + row0 + r32; typename F::Pre pr[2];
            lf.row_begin(0, row);
#pragma unroll
            for (int e = 0; e < 2; ++e) pr[e] = lf.pre(row, col0 + 8 * (2 * wid + e) + 4 * hi);
#pragma unroll
            for (int e = 0; e < 2; ++e) qd[e] = lf.fix(0, col0 + 8 * (2 * wid + e) + 4 * hi, qd[e], pr[e]);
            lf.s = 0.f; lf.q = 0.f;
#pragma unroll
            for (int e = 0; e < 2; ++e) lf.quad(row, col0 + 8 * (2 * wid + e) + 4 * hi, qd[e], qd[e ^ 1]);
            if constexpr (F::STATS) { float s = lf.s, q = lf.q; s += __shfl_xor(s, 32); q += __shfl_xor(q, 32); if (hi == 0) lf.commit(row, s, q); }
        }
        __syncthreads();
    }
}

namespace att {
#define KSWZ(row, colB) ((row) * 256 + ((colB) ^ (((row) & 7) << 4)))
#define SBAR() __builtin_amdgcn_sched_barrier(0)
__device__ __forceinline__ int v_st(int k, int c) { const int kk = (k & ~0xC) | ((k & 4) << 1) | ((k & 8) >> 1); return ((kk >> 3) * 4 + (c >> 5)) * 512 + ((kk & 7) * 32 + (c & 31)) * 2; }
__device__ __forceinline__ int v_rd_base(int lane) { return ((lane & 3) << 3) | (((lane >> 2) & 3) << 6) | (((lane >> 4) & 1) << 5) | (((lane >> 5) & 1) << 8); }
constexpr int v_rd_off(int d0, int ks, int half) { return d0 * 512 + ks * 4096 + half * 2048; }
template <int OFF> __device__ __forceinline__ s16x4 tr_read(int vb) {
    s16x4 r; asm volatile("ds_read_b64_tr_b16 %0, %1 offset:%2" : "=&v"(r) : "v"(vb), "i"(OFF) : "memory"); return r;
}
template <int OFF> __device__ __forceinline__ bf16x8 lds_read128(int ad) {
    bf16x8 r; asm volatile("ds_read_b128 %0, %1 offset:%2" : "=&v"(r) : "v"(ad), "i"(OFF) : "memory"); return r;
}
template <int D0> __device__ __forceinline__ void pv_one(f32x16& od, int vb, bf16x8 pa0, bf16x8 pa1, bf16x8 pa2, bf16x8 pa3) {
    const s16x4 l0 = tr_read<v_rd_off(D0, 0, 0)>(vb), h0 = tr_read<v_rd_off(D0, 0, 1)>(vb), l1 = tr_read<v_rd_off(D0, 1, 0)>(vb), h1 = tr_read<v_rd_off(D0, 1, 1)>(vb);
    const s16x4 l2 = tr_read<v_rd_off(D0, 2, 0)>(vb), h2 = tr_read<v_rd_off(D0, 2, 1)>(vb), l3 = tr_read<v_rd_off(D0, 3, 0)>(vb), h3 = tr_read<v_rd_off(D0, 3, 1)>(vb);
    asm volatile("s_waitcnt lgkmcnt(0)" ::: "memory"); SBAR();
#define PK(L, H) (bf16x8){L[0], L[1], L[2], L[3], H[0], H[1], H[2], H[3]}
    od = __builtin_amdgcn_mfma_f32_32x32x16_bf16(PK(l0, h0), pa0, od, 0, 0, 0);
    od = __builtin_amdgcn_mfma_f32_32x32x16_bf16(PK(l1, h1), pa1, od, 0, 0, 0);
    od = __builtin_amdgcn_mfma_f32_32x32x16_bf16(PK(l2, h2), pa2, od, 0, 0, 0);
    od = __builtin_amdgcn_mfma_f32_32x32x16_bf16(PK(l3, h3), pa3, od, 0, 0, 0);
#undef PK
}
template <int KSI, int DB, int ND> __device__ __forceinline__ void v_read(int vb, s16x4 (&l)[4], s16x4 (&h)[4]) {
    l[0] = tr_read<v_rd_off(DB, KSI, 0)>(vb); h[0] = tr_read<v_rd_off(DB, KSI, 1)>(vb);
    l[1] = tr_read<v_rd_off(DB + 1, KSI, 0)>(vb); h[1] = tr_read<v_rd_off(DB + 1, KSI, 1)>(vb);
    if constexpr (ND == 4) { l[2] = tr_read<v_rd_off(DB + 2, KSI, 0)>(vb); h[2] = tr_read<v_rd_off(DB + 2, KSI, 1)>(vb);
                             l[3] = tr_read<v_rd_off(DB + 3, KSI, 0)>(vb); h[3] = tr_read<v_rd_off(DB + 3, KSI, 1)>(vb); }
}
template <int ND> __device__ __forceinline__ void pv_mf(f32x16 (&o)[4], bf16x8 pa, const s16x4 (&l)[4], const s16x4 (&h)[4]) {
#pragma unroll
    for (int d = 0; d < ND; ++d) o[d] = __builtin_amdgcn_mfma_f32_32x32x16_bf16((bf16x8){l[d][0], l[d][1], l[d][2], l[d][3], h[d][0], h[d][1], h[d][2], h[d][3]}, pa, o[d], 0, 0, 0);
}
template <int DB, int ND> __device__ __forceinline__ void pv_ks(f32x16 (&o)[4], int vb, bf16x8 pa0, bf16x8 pa1, bf16x8 pa2, bf16x8 pa3) {
    s16x4 la[4], ha[4];
    v_read<0, DB, ND>(vb, la, ha); asm volatile("s_waitcnt lgkmcnt(0)" ::: "memory"); SBAR(); pv_mf<ND>(o, pa0, la, ha); SBAR();
    v_read<1, DB, ND>(vb, la, ha); asm volatile("s_waitcnt lgkmcnt(0)" ::: "memory"); SBAR(); pv_mf<ND>(o, pa1, la, ha); SBAR();
    v_read<2, DB, ND>(vb, la, ha); asm volatile("s_waitcnt lgkmcnt(0)" ::: "memory"); SBAR(); pv_mf<ND>(o, pa2, la, ha); SBAR();
    v_read<3, DB, ND>(vb, la, ha); asm volatile("s_waitcnt lgkmcnt(0)" ::: "memory"); SBAR(); pv_mf<ND>(o, pa3, la, ha);
}
template <int DB, int ND> __device__ __forceinline__ void pv_rest(f32x16 (&o)[4], int vb, bf16x8 pa0, bf16x8 pa1, bf16x8 pa2, bf16x8 pa3, s16x4 (&la)[4], s16x4 (&ha)[4]) {
    s16x4 lb[4], hb[4];
    asm volatile("s_waitcnt lgkmcnt(0)" ::: "memory"); SBAR(); v_read<1, DB, ND>(vb, lb, hb); SBAR(); pv_mf<ND>(o, pa0, la, ha); SBAR();
    asm volatile("s_waitcnt lgkmcnt(0)" ::: "memory"); SBAR(); v_read<2, DB, ND>(vb, la, ha); SBAR(); pv_mf<ND>(o, pa1, lb, hb); SBAR();
    asm volatile("s_waitcnt lgkmcnt(0)" ::: "memory"); SBAR(); v_read<3, DB, ND>(vb, lb, hb); SBAR(); pv_mf<ND>(o, pa2, la, ha); SBAR();
    asm volatile("s_waitcnt lgkmcnt(0)" ::: "memory"); SBAR(); pv_mf<ND>(o, pa3, lb, hb);
}
__device__ __forceinline__ void partialSM(f32x16& p0, f32x16& p1, float& m_reg, float& alpha, float C, float thr) {
    float pmax = p0[0];
#pragma unroll
    for (int r = 1; r < 16; ++r) pmax = fmaxf(pmax, p0[r]);
#pragma unroll
    for (int r = 0; r < 16; ++r) pmax = fmaxf(pmax, p1[r]);
    { auto rr = __builtin_amdgcn_permlane32_swap(__float_as_uint(pmax), __float_as_uint(pmax), false, false);
      pmax = fmaxf(__uint_as_float(rr[0]), __uint_as_float(rr[1])); }
    float mn;
    if (__all(pmax - m_reg <= thr)) { mn = m_reg; alpha = 1.f; }
    else { mn = fmaxf(m_reg, pmax); alpha = __builtin_amdgcn_exp2f((m_reg - mn) * C); m_reg = mn; }
    const float mnC = -mn * C;
#pragma unroll
    for (int r = 0; r < 16; ++r) p0[r] = __builtin_amdgcn_exp2f(fmaf(p0[r], C, mnC));
#pragma unroll
    for (int r = 0; r < 16; ++r) p1[r] = __builtin_amdgcn_exp2f(fmaf(p1[r], C, mnC));
}
__device__ __forceinline__ void finishSM(f32x16& p0, f32x16& p1, float alpha, float& l_reg, bf16x8& pa0, bf16x8& pa1, bf16x8& pa2, bf16x8& pa3) {
    float ps = 0;
#pragma unroll
    for (int r = 0; r < 16; ++r) ps += p0[r];
#pragma unroll
    for (int r = 0; r < 16; ++r) ps += p1[r];
    { auto rr = __builtin_amdgcn_permlane32_swap(__float_as_uint(ps), __float_as_uint(ps), false, false);
      ps = __uint_as_float(rr[0]) + __uint_as_float(rr[1]); }
    l_reg = l_reg * alpha + ps;
#define PK4(P, BASE, OUT) do { unsigned a0 = cvtpk(P[BASE + 0], P[BASE + 1]), a1 = cvtpk(P[BASE + 2], P[BASE + 3]);   \
    unsigned b0 = cvtpk(P[BASE + 4], P[BASE + 5]), b1 = cvtpk(P[BASE + 6], P[BASE + 7]);                              \
    auto r0 = __builtin_amdgcn_permlane32_swap(a0, b0, false, false); auto r1 = __builtin_amdgcn_permlane32_swap(a1, b1, false, false); \
    u32x4 w = {r0[0], r1[0], r0[1], r1[1]}; OUT = *reinterpret_cast<bf16x8*>(&w); } while (0)
    PK4(p0, 0, pa0); PK4(p0, 8, pa1); PK4(p1, 0, pa2); PK4(p1, 8, pa3);
#undef PK4
}
constexpr int RING = 32768;
template <int QS, bool PVHALF>
__device__ __forceinline__ void attn_core(LAS unsigned char* lds, const bf16_t* Kb, long ldk, const bf16_t* Vb, long ldv, int NT, int nkeys,
                                          const bf16_t* qptr, int wNT, int kcoffB, int pvsel, float C, float thr, f32x16 (&o)[4], float& m_reg, float& l_reg) {
    int tid = threadIdx.x; asm volatile("" : "+v"(tid));
    const int lane = tid & 63, r32 = lane & 31, hi = lane >> 5, wid = __builtin_amdgcn_readfirstlane(tid >> 6);
    bf16x8 qr[QS];
#pragma unroll
    for (int d0 = 0; d0 < QS; ++d0) qr[d0] = *(const bf16x8*)(qptr + d0 * 16);
#pragma unroll
    for (int d = 0; d < 4; ++d) o[d] = f32x16{};
    m_reg = -1e30f; l_reg = 0.f;
    long offK[2], offV[2];
#pragma unroll
    for (int i = 0; i < 2; ++i) { const int p = i * 8192 + wid * 1024 + lane * 16;
        const int row = p >> 8, colB = (p & 255) ^ ((row & 7) << 4); offK[i] = (long)row * ldk + (colB >> 1);
        const int sub = p >> 9, q = (p & 511) >> 1, kk = (sub >> 2) * 8 + (q >> 5), k = (kk & ~0xC) | ((kk & 4) << 1) | ((kk & 8) >> 1), c = (sub & 3) * 32 + (q & 31);
        offV[i] = (long)k * ldv + c; }
    const int vrb = v_rd_base(lane);
#define GLDS(t, bf) do { const bf16_t* kt_ = Kb + (long)(t) * 64 * ldk; const bf16_t* vt_ = Vb + (long)(t) * 64 * ldv; LAS unsigned char* b_ = lds + (bf) * RING + wid * 1024; \
    __builtin_amdgcn_global_load_lds((const unsigned*)(vt_ + offV[0]), (LAS unsigned*)(b_), 16, 0, 0); \
    __builtin_amdgcn_global_load_lds((const unsigned*)(vt_ + offV[1]), (LAS unsigned*)(b_ + 8192), 16, 0, 0); \
    __builtin_amdgcn_global_load_lds((const unsigned*)(kt_ + offK[0]), (LAS unsigned*)(b_ + 16384), 16, 0, 0); \
    __builtin_amdgcn_global_load_lds((const unsigned*)(kt_ + offK[1]), (LAS unsigned*)(b_ + 16384 + 8192), 16, 0, 0); } while (0)
    GLDS(0, 0);
#pragma unroll
    for (int d0 = 0; d0 < QS; ++d0) asm volatile("" :: "v"(qr[d0]));
    if (1 < NT) GLDS(1, 1); if (2 < NT) GLDS(2, 2);
    for (int j = 0; j < NT; ++j) {
        const int rem = NT - 1 - j;
        if (rem >= 2) asm volatile("s_waitcnt vmcnt(8)" ::: "memory"); else if (rem == 1) asm volatile("s_waitcnt vmcnt(4)" ::: "memory"); else asm volatile("s_waitcnt vmcnt(0)" ::: "memory");
        __builtin_amdgcn_s_barrier();
        asm volatile("" ::: "memory");
        if (j + 3 < NT) GLDS(j + 3, (j + 3) & 3);
        if (j < wNT) {
            const int cur = j & 3;
            f32x16 p0 = f32x16{}, p1 = f32x16{};
            const int kbase = (int)(uintptr_t)(lds + cur * RING + 16384) + r32 * 256;
            const int swz = (r32 & 7) << 4;
#pragma unroll
            for (int hq = 0; hq < QS / 4; ++hq) { bf16x8 b0[4], b1[4];
#pragma unroll
                for (int i = 0; i < 4; ++i) { const int cb = kcoffB + ((hq * 4 + i) * 16 + hi * 8) * 2; const int ad = kbase + (cb ^ swz);
                    b0[i] = lds_read128<0>(ad); b1[i] = lds_read128<8192>(ad); }
                asm volatile("s_waitcnt lgkmcnt(0)" ::: "memory"); SBAR();
#pragma unroll
                for (int i = 0; i < 4; ++i) { p0 = __builtin_amdgcn_mfma_f32_32x32x16_bf16(b0[i], qr[hq * 4 + i], p0, 0, 0, 0);
                    p1 = __builtin_amdgcn_mfma_f32_32x32x16_bf16(b1[i], qr[hq * 4 + i], p1, 0, 0, 0); } }
            if (__builtin_expect((j + 1) * 64 > nkeys, 0)) { const int kb = j * 64 + 4 * hi; asm volatile("" ::: "memory");
#pragma unroll
                for (int r = 0; r < 16; ++r) { const int kv = kb + (r & 3) + 8 * (r >> 2); if (kv >= nkeys) p0[r] = -1e30f; if (kv + 32 >= nkeys) p1[r] = -1e30f; } }
            float alpha; bf16x8 pa0, pa1, pa2, pa3;
            const int vb = (int)(uintptr_t)(lds + cur * RING) + vrb;
            s16x4 la[4], ha[4];
            partialSM(p0, p1, m_reg, alpha, C, thr);
            finishSM(p0, p1, alpha, l_reg, pa0, pa1, pa2, pa3);
            SBAR();
            if constexpr (QS == 4) { if constexpr (!PVHALF) v_read<0, 0, 4>(vb, la, ha); else { if (pvsel == 0) v_read<0, 0, 2>(vb, la, ha); else v_read<0, 2, 2>(vb, la, ha); } }
            SBAR();
            if (__any(alpha < 1.f)) {
#pragma unroll
                for (int d = 0; d < (PVHALF ? 2 : 4); ++d)
#pragma unroll
                    for (int r = 0; r < 16; ++r) o[d][r] *= alpha; }
            if constexpr (QS == 8) { pv_one<0>(o[0], vb, pa0, pa1, pa2, pa3); pv_one<1>(o[1], vb, pa0, pa1, pa2, pa3); pv_one<2>(o[2], vb, pa0, pa1, pa2, pa3); pv_one<3>(o[3], vb, pa0, pa1, pa2, pa3); }
            else if constexpr (!PVHALF) pv_rest<0, 4>(o, vb, pa0, pa1, pa2, pa3, la, ha);
            else { if (pvsel == 0) pv_rest<0, 2>(o, vb, pa0, pa1, pa2, pa3, la, ha); else pv_rest<2, 2>(o, vb, pa0, pa1, pa2, pa3, la, ha); }
        }
    }
#undef GLDS
    __syncthreads();
}

template <bool PVHALF>
__device__ __forceinline__ void attn_core_pipe(LAS unsigned char* lds, const bf16_t* Kb, long ldk, const bf16_t* Vb, long ldv, int NT, int nkeys,
                                               const bf16_t* qptr, int wNT, int kcoffB, int pvsel, float C, float thr, f32x16 (&o)[4], float& m_reg, float& l_reg) {
    int tid = threadIdx.x; asm volatile("" : "+v"(tid));
    const int lane = tid & 63, r32 = lane & 31, hi = lane >> 5, wid = __builtin_amdgcn_readfirstlane(tid >> 6);
    bf16x8 qr[4];
#pragma unroll
    for (int d0 = 0; d0 < 4; ++d0) qr[d0] = *(const bf16x8*)(qptr + d0 * 16);
#pragma unroll
    for (int d = 0; d < 4; ++d) o[d] = f32x16{};
    m_reg = -1e30f; l_reg = 0.f;
    int offK[2], offV[2];
#pragma unroll
    for (int i = 0; i < 2; ++i) { const int p = i * 8192 + wid * 1024 + lane * 16;
        const int row = p >> 8, colB = (p & 255) ^ ((row & 7) << 4); offK[i] = row * (int)ldk + (colB >> 1);
        const int sub = p >> 9, q = (p & 511) >> 1, kk = (sub >> 2) * 8 + (q >> 5), k = (kk & ~0xC) | ((kk & 4) << 1) | ((kk & 8) >> 1), c = (sub & 3) * 32 + (q & 31);
        offV[i] = k * (int)ldv + c; }
    const int vrb = v_rd_base(lane);
    int kad[4];
#pragma unroll
    for (int i = 0; i < 4; ++i) kad[i] = 16384 + r32 * 256 + ((kcoffB + (i * 16 + hi * 8) * 2) ^ ((r32 & 7) << 4));
    const int lds0 = (int)(uintptr_t)lds;
#define GLDS(t, bf) do { const bf16_t* kt_ = Kb + (long)(t) * 64 * ldk; const bf16_t* vt_ = Vb + (long)(t) * 64 * ldv; LAS unsigned char* b_ = lds + (bf) * RING + wid * 1024; \
    __builtin_amdgcn_global_load_lds((const unsigned*)(vt_ + offV[0]), (LAS unsigned*)(b_), 16, 0, 0); \
    __builtin_amdgcn_global_load_lds((const unsigned*)(vt_ + offV[1]), (LAS unsigned*)(b_ + 8192), 16, 0, 0); \
    __builtin_amdgcn_global_load_lds((const unsigned*)(kt_ + offK[0]), (LAS unsigned*)(b_ + 16384), 16, 0, 0); \
    __builtin_amdgcn_global_load_lds((const unsigned*)(kt_ + offK[1]), (LAS unsigned*)(b_ + 16384 + 8192), 16, 0, 0); } while (0)
#define QK(P0, P1, bf) do { const int kb_ = lds0 + (bf) * RING; bf16x8 b0_[2], b1_[2]; \
    _Pragma("unroll") for (int i_ = 0; i_ < 2; ++i_) { b0_[i_] = lds_read128<0>(kb_ + kad[i_]); b1_[i_] = lds_read128<8192>(kb_ + kad[i_]); } \
    asm volatile("s_waitcnt lgkmcnt(0)" ::: "memory"); SBAR(); \
    P0 = __builtin_amdgcn_mfma_f32_32x32x16_bf16(b0_[0], qr[0], f32x16{}, 0, 0, 0); P1 = __builtin_amdgcn_mfma_f32_32x32x16_bf16(b1_[0], qr[0], f32x16{}, 0, 0, 0); \
    P0 = __builtin_amdgcn_mfma_f32_32x32x16_bf16(b0_[1], qr[1], P0, 0, 0, 0); P1 = __builtin_amdgcn_mfma_f32_32x32x16_bf16(b1_[1], qr[1], P1, 0, 0, 0); SBAR(); \
    _Pragma("unroll") for (int i_ = 0; i_ < 2; ++i_) { b0_[i_] = lds_read128<0>(kb_ + kad[2 + i_]); b1_[i_] = lds_read128<8192>(kb_ + kad[2 + i_]); } \
    asm volatile("s_waitcnt lgkmcnt(0)" ::: "memory"); SBAR(); \
    P0 = __builtin_amdgcn_mfma_f32_32x32x16_bf16(b0_[0], qr[2], P0, 0, 0, 0); P1 = __builtin_amdgcn_mfma_f32_32x32x16_bf16(b1_[0], qr[2], P1, 0, 0, 0); \
    P0 = __builtin_amdgcn_mfma_f32_32x32x16_bf16(b0_[1], qr[3], P0, 0, 0, 0); P1 = __builtin_amdgcn_mfma_f32_32x32x16_bf16(b1_[1], qr[3], P1, 0, 0, 0); \
    SBAR(); } while (0)
#define STEP(C0, C1, N0, N1, j) do { \
    if ((j) + 1 < NT) { \
        if ((j) + 2 < NT) asm volatile("s_waitcnt vmcnt(4)" ::: "memory"); else asm volatile("s_waitcnt vmcnt(0)" ::: "memory"); \
        __builtin_amdgcn_s_barrier(); asm volatile("" ::: "memory"); \
        if ((j) + 3 < NT) GLDS((j) + 3, ((j) + 3) & 3); \
        if ((j) + 1 < wNT) QK(N0, N1, ((j) + 1) & 3); } \
    if ((j) < wNT) { \
        if (__builtin_expect(((j) + 1) * 64 > nkeys, 0)) { const int kb = (j) * 64 + 4 * hi; asm volatile("" ::: "memory"); \
            _Pragma("unroll") for (int r = 0; r < 16; ++r) { const int kv = kb + (r & 3) + 8 * (r >> 2); if (kv >= nkeys) C0[r] = -1e30f; if (kv + 32 >= nkeys) C1[r] = -1e30f; } } \
        float alpha; bf16x8 pa0, pa1, pa2, pa3; const int vb = lds0 + ((j) & 3) * RING + vrb; \
        partialSM(C0, C1, m_reg, alpha, C, thr); \
        finishSM(C0, C1, alpha, l_reg, pa0, pa1, pa2, pa3); \
        SBAR(); \
        if (__any(alpha < 1.f)) { \
            _Pragma("unroll") for (int d = 0; d < (PVHALF ? 2 : 4); ++d) _Pragma("unroll") for (int r = 0; r < 16; ++r) o[d][r] *= alpha; } \
        if constexpr (!PVHALF) pv_ks<0, 4>(o, vb, pa0, pa1, pa2, pa3); \
        else { if (pvsel == 0) pv_ks<0, 2>(o, vb, pa0, pa1, pa2, pa3); else pv_ks<2, 2>(o, vb, pa0, pa1, pa2, pa3); } } \
    } while (0)
    GLDS(0, 0);
#pragma unroll
    for (int d0 = 0; d0 < 4; ++d0) asm volatile("" :: "v"(qr[d0]));
    if (1 < NT) GLDS(1, 1); if (2 < NT) GLDS(2, 2);
    if (NT > 2) asm volatile("s_waitcnt vmcnt(8)" ::: "memory"); else if (NT == 2) asm volatile("s_waitcnt vmcnt(4)" ::: "memory"); else asm volatile("s_waitcnt vmcnt(0)" ::: "memory");
    __builtin_amdgcn_s_barrier(); asm volatile("" ::: "memory");
    f32x16 pA0 = f32x16{}, pA1 = f32x16{}, pB0 = f32x16{}, pB1 = f32x16{};
    if (0 < wNT) QK(pA0, pA1, 0);
    for (int j = 0; j < NT; j += 2) {
        STEP(pA0, pA1, pB0, pB1, j);
        if (j + 1 < NT) STEP(pB0, pB1, pA0, pA1, j + 1);
    }
#undef STEP
#undef QK
#undef GLDS
    __syncthreads();
}

struct Ctx { LAS unsigned char* lds; int lane, wid, r32, hi; };

template <int ND> __device__ __forceinline__ void store_gated(const f32x16 (&o)[4], float scale, const bf16_t* gate, bf16_t* out, int hi) {
#pragma unroll
    for (int d = 0; d < ND; ++d)
#pragma unroll
        for (int g = 0; g < 4; ++g) { const int dv = 32 * d + 8 * g + 4 * hi;
            const u32x2 gt = *(const u32x2*)(gate + dv);
            f32x4 v; v.x = o[d][4 * g] * scale * silu(bflo(gt.x)); v.y = o[d][4 * g + 1] * scale * silu(bfhi(gt.x));
            v.z = o[d][4 * g + 2] * scale * silu(bflo(gt.y)); v.w = o[d][4 * g + 3] * scale * silu(bfhi(gt.y));
            st_bf4(out + dv, v); }
}

__device__ __forceinline__ void diff_unit(const Ctx& cx, bool samp, int b, int h, int qb, const bf16_t* PA, const bf16_t* KS, const bf16_t* VS, bf16_t* MIX, const float* gnorm, float lam) {
    const int c = cx.wid >> 2, rb = cx.wid & 3;
    long row; bool valid; int NT, wNT, nkeys; const bf16_t* Kb; const bf16_t* Vb; long ldk;
    if (!samp) { row = (long)b * 4096 + qb * 128 + rb * 32 + cx.r32; valid = true; NT = 2 * qb + 2; wNT = 2 * qb + 1 + (rb >> 1); nkeys = NT * 64;
                 Kb = PA + (size_t)b * 4096 * NA + 512 + h * 128; Vb = Kb + 512; ldk = NA; }
    else { row = NP + b * 16 + (cx.r32 < 15 ? cx.r32 : 15); valid = (rb == 0) && cx.r32 < 16; NT = 65; wNT = (rb == 0) ? 65 : 0; nkeys = 4112;
           Kb = KS + (size_t)b * KSROWS * 512 + h * 128; Vb = VS + (size_t)b * KSROWS * 512 + h * 128; ldk = 512; }
    const bf16_t* qptr = PA + (size_t)row * NA + h * 128 + c * 64 + cx.hi * 8;
    f32x16 o[4]; float m, l;
    attn_core_pipe<false>(cx.lds, Kb, ldk, Vb, ldk, NT, nkeys, qptr, wNT, c * 128, 0, C64, THR64, o, m, l);
    const float inv = l > 0.f ? 1.f / l : 0.f;
    LAS float* xch = (LAS float*)cx.lds + rb * 4096;
    if (c == 1) {
#pragma unroll
        for (int d = 0; d < 4; ++d)
#pragma unroll
            for (int r = 0; r < 16; ++r) xch[(d * 16 + r) * 64 + cx.lane] = o[d][r] * inv; }
    __syncthreads();
    if (c == 0) {
        float ss = 0.f;
#pragma unroll
        for (int d = 0; d < 4; ++d)
#pragma unroll
            for (int r = 0; r < 16; ++r) { const float od = o[d][r] * inv - lam * xch[(d * 16 + r) * 64 + cx.lane]; o[d][r] = od; ss += od * od; }
        ss += __shfl_xor(ss, 32);
        const float rms = rsqrtf(ss * (1.f / 128.f) + 1e-5f) * 0.8f;
        if (valid) {
            const bf16_t* gate = PA + (size_t)row * NA + 1536 + h * 128; bf16_t* out = MIX + (size_t)row * DM + h * 128;
#pragma unroll
            for (int d = 0; d < 4; ++d)
#pragma unroll
                for (int g = 0; g < 4; ++g) { const int dv = 32 * d + 8 * g + 4 * cx.hi;
                    const f32x4 gn = *(const f32x4*)(gnorm + dv); const u32x2 gt = *(const u32x2*)(gate + dv);
                    f32x4 v; v.x = o[d][4 * g] * rms * gn.x * silu(bflo(gt.x)); v.y = o[d][4 * g + 1] * rms * gn.y * silu(bfhi(gt.x));
                    v.z = o[d][4 * g + 2] * rms * gn.z * silu(bflo(gt.y)); v.w = o[d][4 * g + 3] * rms * gn.w * silu(bfhi(gt.y));
                    st_bf4(out + dv, v); }
        }
    }
    __syncthreads();
}
__device__ __forceinline__ void diff_sample_item(const Ctx& cx, int b, int h, int sp, const float* CK, const float* CV, const bf16_t* PA, const bf16_t* KS, const bf16_t* VS,
                                                 bf16_t* MIX, const float* gnorm, float lam, float* PART, unsigned* cnt, volatile LAS unsigned* MISC) {
    int tid = threadIdx.x; asm volatile("" : "+v"(tid));
    const int lane = tid & 63, r32 = lane & 31, hi = lane >> 5, wid = __builtin_amdgcn_readfirstlane(tid >> 6);
    const int c = wid >> 2; const bool active = (wid & 3) == 0;
    const size_t row = NP + b * 16 + (r32 < 15 ? r32 : 15);
    bf16x8 qr[4];
    { const bf16_t* qptr = PA + row * NA + h * 128 + c * 64 + hi * 8;
#pragma unroll
      for (int d0 = 0; d0 < 4; ++d0) qr[d0] = *(const bf16x8*)(qptr + d0 * 16); }
    f32x16 o[4];
#pragma unroll
    for (int d = 0; d < 4; ++d) o[d] = f32x16{};
    float m_reg = -1e30f, l_reg = 0.f;
    const int ntl = 16 + (sp == 3 ? 1 : 0);
    const int sr = tid >> 4, sc = (tid & 15) * 8;
    const float* kg = CK + ((size_t)(b * 4096 + sp * 1024 + sr) * 4 + h) * 128 + sc;
    const float* vg = CV + ((size_t)(b * 4096 + sp * 1024 + sr) * 4 + h) * 128 + sc;
    const bf16_t* kn = KS + ((size_t)b * KSROWS + 4096 + sr) * 512 + h * 128 + sc;
    const bf16_t* vn = VS + ((size_t)b * KSROWS + 4096 + sr) * 512 + h * 128 + sc;
    const int vst0 = v_st(sr, sc), vst1 = v_st(32 + sr, sc), kst0 = 16384 + KSWZ(sr, sc * 2), kst1 = 16384 + KSWZ(32 + sr, sc * 2);
    int kad[4];
#pragma unroll
    for (int i = 0; i < 4; ++i) kad[i] = 16384 + r32 * 256 + ((c * 128 + (i * 16 + hi * 8) * 2) ^ ((r32 & 7) << 4));
    const int lds0 = (int)(uintptr_t)cx.lds, vrb = v_rd_base(lane);
    f32x4 kf[4], vf[4];
#define LOADT(t) do { if ((t) < 16) { const float* kp_ = kg + (size_t)(t) * 64 * 512; const float* vp_ = vg + (size_t)(t) * 64 * 512; \
        kf[0] = *(const f32x4*)kp_; kf[1] = *(const f32x4*)(kp_ + 4); kf[2] = *(const f32x4*)(kp_ + 32 * 512); kf[3] = *(const f32x4*)(kp_ + 32 * 512 + 4); \
        vf[0] = *(const f32x4*)vp_; vf[1] = *(const f32x4*)(vp_ + 4); vf[2] = *(const f32x4*)(vp_ + 32 * 512); vf[3] = *(const f32x4*)(vp_ + 32 * 512 + 4); } \
    else { kf[0] = *(const f32x4*)kn; kf[2] = *(const f32x4*)(kn + 32 * 512); vf[0] = *(const f32x4*)vn; vf[2] = *(const f32x4*)(vn + 32 * 512); } } while (0)
#define CV8(A, B) ((u32x4){cvtpk(A.x, A.y), cvtpk(A.z, A.w), cvtpk(B.x, B.y), cvtpk(B.z, B.w)})
#define WRITET(t, bf) do { u32x4 k0_, k1_, v0_, v1_; \
    if ((t) < 16) { k0_ = CV8(kf[0], kf[1]); k1_ = CV8(kf[2], kf[3]); v0_ = CV8(vf[0], vf[1]); v1_ = CV8(vf[2], vf[3]); } \
    else { k0_ = __builtin_bit_cast(u32x4, kf[0]); k1_ = __builtin_bit_cast(u32x4, kf[2]); v0_ = __builtin_bit_cast(u32x4, vf[0]); v1_ = __builtin_bit_cast(u32x4, vf[2]); } \
    LAS unsigned char* b_ = cx.lds + (bf) * RING; \
    *(LAS u32x4*)(b_ + vst0) = v0_; *(LAS u32x4*)(b_ + vst1) = v1_; *(LAS u32x4*)(b_ + kst0) = k0_; *(LAS u32x4*)(b_ + kst1) = k1_; } while (0)
    LOADT(0); WRITET(0, 0); __syncthreads();
    for (int t = 0; t < ntl; ++t) {
        const int cur = t & 1;
        if (t + 1 < ntl) LOADT(t + 1);
        if (active) {
            f32x16 p0, p1;
            { const int kb_ = lds0 + cur * RING; bf16x8 b0_[4], b1_[4];
#pragma unroll
              for (int i = 0; i < 4; ++i) { b0_[i] = lds_read128<0>(kb_ + kad[i]); b1_[i] = lds_read128<8192>(kb_ + kad[i]); }
              asm volatile("s_waitcnt lgkmcnt(0)" ::: "memory"); SBAR();
              p0 = __builtin_amdgcn_mfma_f32_32x32x16_bf16(b0_[0], qr[0], f32x16{}, 0, 0, 0); p1 = __builtin_amdgcn_mfma_f32_32x32x16_bf16(b1_[0], qr[0], f32x16{}, 0, 0, 0);
#pragma unroll
              for (int i = 1; i < 4; ++i) { p0 = __builtin_amdgcn_mfma_f32_32x32x16_bf16(b0_[i], qr[i], p0, 0, 0, 0); p1 = __builtin_amdgcn_mfma_f32_32x32x16_bf16(b1_[i], qr[i], p1, 0, 0, 0); } }
            if (t >= 16) {
#pragma unroll
                for (int r = 0; r < 16; ++r) { const int kv = 4 * hi + (r & 3) + 8 * (r >> 2); if (kv >= 16) p0[r] = -1e30f; p1[r] = -1e30f; } }
            float alpha; bf16x8 pa0, pa1, pa2, pa3;
            partialSM(p0, p1, m_reg, alpha, C64, THR64);
            finishSM(p0, p1, alpha, l_reg, pa0, pa1, pa2, pa3);
            SBAR();
            if (__any(alpha < 1.f)) {
#pragma unroll
                for (int d = 0; d < 4; ++d)
#pragma unroll
                    for (int r = 0; r < 16; ++r) o[d][r] *= alpha; }
            pv_ks<0, 4>(o, lds0 + cur * RING + vrb, pa0, pa1, pa2, pa3);
        }
        if (t + 1 < ntl) WRITET(t + 1, cur ^ 1);
        __syncthreads();
    }
#undef LOADT
#undef WRITET
#undef CV8
    const int bh = b * 4 + h;
    if (active) { float* pb = PART + ((size_t)(bh * 4 + sp) * 2 + c) * (66 * 64) + lane;
#pragma unroll
        for (int d = 0; d < 4; ++d)
#pragma unroll
            for (int r = 0; r < 16; ++r) pb[(d * 16 + r) * 64] = o[d][r];
        pb[64 * 64] = m_reg; pb[65 * 64] = l_reg; }
    asm volatile("s_waitcnt vmcnt(0)" ::: "memory"); __syncthreads();
    if (tid == 0) { __builtin_amdgcn_fence(__ATOMIC_RELEASE, "agent"); asm volatile("s_waitcnt vmcnt(0)" ::: "memory");
                    const unsigned old = __hip_atomic_fetch_add(cnt + bh, 1u, __ATOMIC_RELAXED, __HIP_MEMORY_SCOPE_AGENT);
                    if (old == 3u) { __builtin_amdgcn_fence(__ATOMIC_ACQUIRE, "agent"); asm volatile("s_waitcnt vmcnt(0)" ::: "memory"); }
                    MISC[1] = old; }
    __syncthreads();
    const bool last = MISC[1] == 3u;
    if (last && wid == 0) {
        const float* pp = PART + (size_t)(bh * 4) * 2 * (66 * 64) + lane;
        float e0[4], e1[4], L0 = 0.f, L1 = 0.f;
        { float m0[4], m1[4], M0 = -1e30f, M1 = -1e30f;
#pragma unroll
          for (int q = 0; q < 4; ++q) { m0[q] = pp[(size_t)(q * 2) * (66 * 64) + 64 * 64]; m1[q] = pp[(size_t)(q * 2 + 1) * (66 * 64) + 64 * 64]; M0 = fmaxf(M0, m0[q]); M1 = fmaxf(M1, m1[q]); }
#pragma unroll
          for (int q = 0; q < 4; ++q) { e0[q] = __builtin_amdgcn_exp2f((m0[q] - M0) * C64); e1[q] = __builtin_amdgcn_exp2f((m1[q] - M1) * C64);
              L0 += e0[q] * pp[(size_t)(q * 2) * (66 * 64) + 65 * 64]; L1 += e1[q] * pp[(size_t)(q * 2 + 1) * (66 * 64) + 65 * 64]; } }
        const float i0 = 1.f / L0, i1 = lam / L1;
#pragma unroll
        for (int q = 0; q < 4; ++q) { e0[q] *= i0; e1[q] *= i1; }
        float ss = 0.f;
#pragma unroll
        for (int d = 0; d < 4; ++d)
#pragma unroll
            for (int r = 0; r < 16; ++r) { float od = 0.f;
#pragma unroll
                for (int q = 0; q < 4; ++q) od += e0[q] * pp[(size_t)(q * 2) * (66 * 64) + (d * 16 + r) * 64] - e1[q] * pp[(size_t)(q * 2 + 1) * (66 * 64) + (d * 16 + r) * 64];
                o[d][r] = od; ss += od * od; }
        ss += __shfl_xor(ss, 32);
        const float rms = rsqrtf(ss * (1.f / 128.f) + 1e-5f) * 0.8f;
        if (r32 < 16) {
            const bf16_t* gate = PA + row * NA + 1536 + h * 128; bf16_t* out = MIX + row * DM + h * 128;
#pragma unroll
            for (int d = 0; d < 4; ++d)
#pragma unroll
                for (int g = 0; g < 4; ++g) { const int dv = 32 * d + 8 * g + 4 * hi;
                    const f32x4 gn = *(const f32x4*)(gnorm + dv); const u32x2 gt = *(const u32x2*)(gate + dv);
                    f32x4 v; v.x = o[d][4 * g] * rms * gn.x * silu(bflo(gt.x)); v.y = o[d][4 * g + 1] * rms * gn.y * silu(bfhi(gt.x));
                    v.z = o[d][4 * g + 2] * rms * gn.z * silu(bflo(gt.y)); v.w = o[d][4 * g + 3] * rms * gn.w * silu(bfhi(gt.y));
                    st_bf4(out + dv, v); }
        }
    }
    __syncthreads();
}
__device__ __forceinline__ void mem_unit(const Ctx& cx, bool samp, int b, int h, int qb, const bf16_t* P, int ldp, int qcol, int gcol,
                                         const bf16_t* Kb, const bf16_t* Vb, long ldk, bf16_t* MIX) {
    long row; bool valid; int wNT;
    if (!samp) { row = (long)b * 4096 + qb * 256 + cx.wid * 32 + cx.r32; valid = true; wNT = 4; }
    else { row = NP + b * 16 + (cx.r32 < 15 ? cx.r32 : 15); valid = (cx.wid == 0) && cx.r32 < 16; wNT = (cx.wid == 0) ? 4 : 0; }
    const bf16_t* qptr = P + (size_t)row * ldp + qcol + h * 128 + cx.hi * 8;
    f32x16 o[4]; float m, l;
    attn_core<8, false>(cx.lds, Kb, ldk, Vb, ldk, 4, 256, qptr, wNT, 0, 0, C128, THR128, o, m, l);
    const float inv = l > 0.f ? 1.f / l : 0.f;
    if (valid) store_gated<4>(o, inv, P + (size_t)row * ldp + gcol + h * 128, MIX + (size_t)row * DM + 512 + h * 128, cx.hi);
}
__device__ __forceinline__ void swa_unit(const Ctx& cx, bool samp, int b, int c, int half, const bf16_t* PB, const bf16_t* KSW, const bf16_t* VSW, bf16_t* MIX, const float* sinks) {
    const int head = cx.wid, kv = cx.wid >> 2;
    long row; bool valid; int NT, nkeys; const bf16_t* Kb; const bf16_t* Vb; long ldk;
    if (!samp) { row = (long)b * 4096 + c * 64 + half * 32 + cx.r32; valid = true; const int c0 = c > 2 ? c - 2 : 0; NT = c - c0 + 1; nkeys = NT * 64;
                 Kb = PB + ((size_t)b * 4096 + c0 * 64) * NB + 2048; Vb = Kb + 128; ldk = NB; }
    else { row = NP + b * 16 + (cx.r32 < 15 ? cx.r32 : 15); valid = cx.r32 < 16; NT = 3; nkeys = 144;
           Kb = KSW + (size_t)b * SWROWS * 128; Vb = VSW + (size_t)b * SWROWS * 128; ldk = 128; }
    const bf16_t* qptr = PB + (size_t)row * NB + head * 64 + cx.hi * 8;
    f32x16 o[4]; float m, l;
    attn_core_pipe<true>(cx.lds, Kb, ldk, Vb, ldk, NT, nkeys, qptr, NT, kv * 128, kv, C64, THR64, o, m, l);
    const float lt = l + __builtin_amdgcn_exp2f(sinks[head] * LOG2E - m * C64);
    const float inv = 1.f / lt;
    if (valid) store_gated<2>(o, inv, PB + (size_t)row * NB + 512 + head * 64, MIX + (size_t)row * DM + head * 64, cx.hi);
}
#undef KSWZ
#undef SBAR
}

__device__ __forceinline__ float wave_sum(float v) {
#pragma unroll
    for (int o = 1; o < 64; o <<= 1) v += __shfl_xor(v, o);
    return v;
}
__device__ __forceinline__ void p0_transpose_item(const float* W, int K, int N, bf16_t* WT, int row_off, LAS float* scr, int item, int lane) {
    const int nblk = N / 32, kb = item / nblk, nb = item % nblk, k0 = 64 * kb, n0 = 32 * nb;
#pragma unroll 8
    for (int i = 0; i < 32; ++i) { const int kk = 2 * i + (lane >> 5); scr[kk * 33 + (lane & 31)] = W[(size_t)(k0 + kk) * N + n0 + (lane & 31)]; }
    asm volatile("s_waitcnt lgkmcnt(0)" ::: "memory");
    const int c = lane & 7;
#pragma unroll
    for (int j = 0; j < 4; ++j) { const int n = (lane >> 3) + 8 * j; const LAS float* s = scr + (8 * c) * 33 + n;
        u32x4 o; o.x = cvtpk(s[0 * 33], s[1 * 33]); o.y = cvtpk(s[2 * 33], s[3 * 33]); o.z = cvtpk(s[4 * 33], s[5 * 33]); o.w = cvtpk(s[6 * 33], s[7 * 33]);
        *(u32x4*)(WT + (size_t)(row_off + n0 + n) * K + k0 + 8 * c) = o; }
    asm volatile("s_waitcnt lgkmcnt(0)" ::: "memory");
}
__device__ __forceinline__ void p0_transpose_item_ln(const float* W, int K, int N, bf16_t* WT, int row_off, LAS float* scr, int item, int lane, const float* g, const float* b, float* CS, float* BW) {
    const int nblk = N / 32, kb = item / nblk, nb = item % nblk, k0 = 64 * kb, n0 = 32 * nb;
    float csp = 0.f, bwp = 0.f;
#pragma unroll 8
    for (int i = 0; i < 32; ++i) { const int kk = 2 * i + (lane >> 5); const float w = W[(size_t)(k0 + kk) * N + n0 + (lane & 31)]; const float gw = g[k0 + kk] * w;
        scr[kk * 33 + (lane & 31)] = gw; csp += bflo(cvtpk(gw, 0.f)); bwp += b[k0 + kk] * w; }
    csp += __shfl_xor(csp, 32); bwp += __shfl_xor(bwp, 32);
    if (lane < 32) { atomicAdd(CS + row_off + n0 + lane, csp); atomicAdd(BW + row_off + n0 + lane, bwp); }
    asm volatile("s_waitcnt lgkmcnt(0)" ::: "memory");
    const int c = lane & 7;
#pragma unroll
    for (int j = 0; j < 4; ++j) { const int n = (lane >> 3) + 8 * j; const LAS float* sp = scr + (8 * c) * 33 + n;
        u32x4 o; o.x = cvtpk(sp[0 * 33], sp[1 * 33]); o.y = cvtpk(sp[2 * 33], sp[3 * 33]); o.z = cvtpk(sp[4 * 33], sp[5 * 33]); o.w = cvtpk(sp[6 * 33], sp[7 * 33]);
        *(u32x4*)(WT + (size_t)(row_off + n0 + n) * K + k0 + 8 * c) = o; }
    asm volatile("s_waitcnt lgkmcnt(0)" ::: "memory");
}
__device__ __forceinline__ void ln_rows(const float* zin, float* fout, bf16_t* bout, const float* g, const float* bta, int gw, int NGW, int lane) {
    f32x4 g4[4], b4[4];
#pragma unroll
    for (int j = 0; j < 4; ++j) { g4[j] = *(const f32x4*)(g + 4 * lane + 256 * j); b4[j] = *(const f32x4*)(bta + 4 * lane + 256 * j); }
    for (int m = gw; m < MA; m += NGW) {
        const float* zr = zin + (size_t)m * DM + 4 * lane;
        f32x4 v[4]; float s = 0.f;
#pragma unroll
        for (int j = 0; j < 4; ++j) { v[j] = *(const f32x4*)(zr + 256 * j); s += (v[j].x + v[j].y) + (v[j].z + v[j].w); }
        const float mean = wave_sum(s) * (1.f / DM); float s2 = 0.f;
#pragma unroll
        for (int j = 0; j < 4; ++j) { v[j] = v[j] - mean; s2 += (v[j].x * v[j].x + v[j].y * v[j].y) + (v[j].z * v[j].z + v[j].w * v[j].w); }
        const float rstd = rsqrtf(wave_sum(s2) * (1.f / DM) + 1e-5f);
#pragma unroll
        for (int j = 0; j < 4; ++j) { const f32x4 y = v[j] * rstd * g4[j] + b4[j];
            *(f32x4*)(fout + (size_t)m * DM + 4 * lane + 256 * j) = y;
            if (bout) st_bf4(bout + (size_t)m * DM + 4 * lane + 256 * j, y); }
    }
}

#define XB_TMO      128
#define XB_XCNT(j)  (256  + 64 * (j))
#define XB_XSUB(j)  (1280 + 64 * (j))
#define XB_XGEN(j)  (2304 + 64 * (j))
#define XB_TOP      3328
#define XB_TOPGEN   3392
#define XCD_BAR_WORDS 3456
#define XB_SPIN_CAP (1u << 18)

__device__ __forceinline__ unsigned xb_ld(unsigned* p)              { return __hip_atomic_load(p, __ATOMIC_RELAXED, __HIP_MEMORY_SCOPE_AGENT); }
__device__ __forceinline__ unsigned xb_add(unsigned* p, unsigned v) { return __hip_atomic_fetch_add(p, v, __ATOMIC_RELAXED, __HIP_MEMORY_SCOPE_AGENT); }
__device__ __forceinline__ unsigned xb_xcc_id() { return (unsigned)__builtin_amdgcn_s_getreg((3 << 11) | 20) & 0xFu; }
#define XB_SPIN(cond, bar) do { unsigned _sp = 0; while (cond) { __builtin_amdgcn_s_sleep(1); \
    if ((++_sp & 255u) == 0u) { if (xb_ld(&(bar)[XB_TMO])) break; if (_sp > XB_SPIN_CAP) { atomicAdd(&(bar)[XB_TMO], 1u); break; } } } } while (0)

struct XcdBarrier {
    unsigned* bar; unsigned x;
    volatile LAS unsigned* st;
};

__device__ __forceinline__ XcdBarrier xcd_barrier_post(unsigned* bar, volatile LAS unsigned* st) {
    XcdBarrier b; b.bar = bar; b.x = xb_xcc_id(); b.st = st;
    if (threadIdx.x == 0) (void)xb_add(&bar[XB_XCNT(b.x)], 1u);
    return b;
}
__device__ __forceinline__ void xcd_barrier_complete(unsigned* bar, unsigned x, unsigned& nloc, unsigned& nx) {
    const unsigned G = gridDim.x * gridDim.y * gridDim.z;
    unsigned sum, cnt, mine, sp = 0u;
    for (;;) {
        sum = 0u; cnt = 0u; mine = 0u;
#pragma unroll
        for (unsigned j = 0; j < 16; ++j) { const unsigned c = xb_ld(&bar[XB_XCNT(j)]); sum += c; cnt += (c > 0u) ? 1u : 0u; mine = (j == x) ? c : mine; }
        if (sum == G) break;
        __builtin_amdgcn_s_sleep(1);
        if ((++sp & 255u) == 0u) { if (xb_ld(&bar[XB_TMO])) break; if (sp > XB_SPIN_CAP) { atomicAdd(&bar[XB_TMO], 1u); break; } }
    }
    nloc = mine > 0u ? mine : 1u; nx = cnt > 0u ? cnt : 1u;
}

__device__ __forceinline__ void xcd_barrier(const XcdBarrier& b) {
    asm volatile("s_waitcnt vmcnt(0)" ::: "memory");
    __syncthreads();
    if (threadIdx.x == 0) {
        unsigned* bar = b.bar;
        __builtin_amdgcn_s_waitcnt(0);
        unsigned nloc = b.st[0], nx = b.st[1];
        if (nloc == 0u) { xcd_barrier_complete(bar, b.x, nloc, nx); b.st[0] = nloc; b.st[1] = nx; }
        const unsigned old = xb_add(&bar[XB_XSUB(b.x)], 1u);
        const unsigned gen = old / nloc;
        if (old + 1u == (gen + 1u) * nloc) {
            __builtin_amdgcn_fence(__ATOMIC_RELEASE, "agent");
            asm volatile("s_waitcnt vmcnt(0)" ::: "memory");
            const unsigned og = xb_add(&bar[XB_TOP], 1u);
            const unsigned tg = og / nx;
            if (og + 1u == (tg + 1u) * nx) xb_add(&bar[XB_TOPGEN], 1u);
            else XB_SPIN(xb_ld(&bar[XB_TOPGEN]) == tg, bar);
            __builtin_amdgcn_fence(__ATOMIC_ACQUIRE, "agent");
            xb_add(&bar[XB_XGEN(b.x)], 1u);
            asm volatile("s_waitcnt vmcnt(0)" ::: "memory");
        } else {
            XB_SPIN(xb_ld(&bar[XB_XGEN(b.x)]) == gen, bar);
            __builtin_amdgcn_fence(__ATOMIC_ACQUIRE, "agent");
            asm volatile("s_waitcnt vmcnt(0)" ::: "memory");
        }
    }
    __syncthreads();
}

struct Args { const float* in[22]; float* out; unsigned char* ws; int ph_lo, ph_hi, rep, pad; };
constexpr int NWAVES = 8, NPHASE = 9;

__global__ void __launch_bounds__(NWAVES * 64, 2) yoco_fwd(Args a) {
    extern __shared__ __attribute__((aligned(16))) unsigned char lds_raw[];
    LAS unsigned char* lds = (LAS unsigned char*)lds_raw;
    volatile LAS unsigned* MISC = (volatile LAS unsigned*)(lds + LDS_RING);
    cg::grid_group grid = cg::this_grid();
    const int tid = threadIdx.x, lane = tid & 63, wave = __builtin_amdgcn_readfirstlane(tid >> 6);
    const int G = gridDim.x, gw = blockIdx.x * NWAVES + wave, NGW = G * NWAVES;
    const long gtid = (long)blockIdx.x * (NWAVES * 64) + tid, NTHR = (long)G * (NWAVES * 64);
    unsigned char* ws = a.ws; float* dout = a.out;
    unsigned* ctl = (unsigned*)(ws + WS_CTL);
    float* ROPE = (float*)(ws + WS_ROPE);
    float* CSV = (float*)(ws + 32768); float* BWV = (float*)(ws + 49152); float* ST0 = (float*)(ws + 262144); float* ST1 = (float*)(ws + 524288);
    bf16_t* WA_t = (bf16_t*)(ws + WS_WA); bf16_t* WB_t = (bf16_t*)(ws + WS_WB); bf16_t* WM_t = (bf16_t*)(ws + WS_WM); bf16_t* WO_t = (bf16_t*)(ws + WS_WO);
    bf16_t* MEMB = (bf16_t*)(ws + WS_MEMB); bf16_t* MKV = (bf16_t*)(ws + WS_MKV); bf16_t* CMK = (bf16_t*)(ws + WS_CMK); bf16_t* CMV = (bf16_t*)(ws + WS_CMV);
    bf16_t* KSW = (bf16_t*)(ws + WS_KSW); bf16_t* VSW = (bf16_t*)(ws + WS_VSW); bf16_t* XA = (bf16_t*)(ws + WS_XA); bf16_t* ZB = XA;
    bf16_t* MIX = (bf16_t*)(ws + WS_MIX); bf16_t* Z1B = (bf16_t*)(ws + WS_Z0); bf16_t* PA = (bf16_t*)(ws + WS_PA); bf16_t* PB = PA;
    bf16_t* KS = (bf16_t*)(ws + WS_KS); bf16_t* VS = (bf16_t*)(ws + WS_VS);
    const int lo = a.ph_lo, hi_ph = a.ph_hi;
#define IN(k) (lo <= (k) && (k) < hi_ph)
    if (tid < 64) MISC[tid] = 0u;
    __syncthreads();
    XcdBarrier xbar = xcd_barrier_post(ctl + 1024, MISC + 8);
    if (a.ph_lo > 1000) grid.sync();
#define SEAM(k) do { if (IN(k) && IN((k) + 1)) xcd_barrier(xbar); } while (0)
    att::Ctx cx; cx.lds = lds; cx.lane = lane; cx.wid = wave; cx.r32 = lane & 31; cx.hi = lane >> 5;

    if (IN(0)) {
        LAS float* scr = (LAS float*)(lds + wave * 16384);
        for (int it = gw; it < 4736; it += NGW) {
            int r = it;
            if (r < 1536) { p0_transpose_item(a.in[9], DM, NA, WA_t, 0, scr, r, lane); continue; } r -= 1536;
            if (r < 1024) { p0_transpose_item_ln(a.in[15], DM, 2048, WB_t, 0, scr, r, lane, a.in[20], a.in[21], CSV, BWV); continue; } r -= 1024;
            if (r < 128) { p0_transpose_item_ln(a.in[17], DM, 256, WB_t, 2048, scr, r, lane, a.in[20], a.in[21], CSV, BWV); continue; } r -= 128;
            if (r < 1024) { const int l = r >> 9; p0_transpose_item(a.in[18] + (size_t)l * DM * DM, DM, DM, WM_t, l * 1024, scr, r & 511, lane); continue; } r -= 1024;
            { const int l = r >> 9; p0_transpose_item(a.in[19] + (size_t)l * DM * DM, DM, DM, WO_t, l * 1024, scr, r & 511, lane); }
        }
        for (long i = gtid; i < 2097152; i += NTHR) cvt8(a.in[0] + i * 8, XA + i * 8);
        for (long i = gtid; i < 32768; i += NTHR) cvt8(a.in[1] + i * 8, XA + (size_t)NP * DM + i * 8);
        for (long i = gtid; i < 131072; i += NTHR) cvt8(a.in[2] + i * 8, MEMB + i * 8);
        for (long i = gtid; i < 524288; i += NTHR) { cvt8(a.in[7] + i * 8, CMK + i * 8); cvt8(a.in[8] + i * 8, CMV + i * 8); }
        for (long i = gtid; i < 32768; i += NTHR) { const long b = i >> 11, r = i & 2047; const size_t d = (size_t)b * SWROWS * 128 + r * 8;
            cvt8(a.in[5] + i * 8, KSW + d); cvt8(a.in[6] + i * 8, VSW + d);
            const int rw = (int)(r >> 4);
            if (rw >= 16) { const size_t od = ((size_t)b * 128 + rw - 16) * 128 + (r & 15) * 8;
                *(f32x4*)(dout + OFF_SKS + od) = *(const f32x4*)(a.in[5] + i * 8); *(f32x4*)(dout + OFF_SKS + od + 4) = *(const f32x4*)(a.in[5] + i * 8 + 4);
                *(f32x4*)(dout + OFF_SVS + od) = *(const f32x4*)(a.in[6] + i * 8); *(f32x4*)(dout + OFF_SVS + od + 4) = *(const f32x4*)(a.in[6] + i * 8 + 4); } }
        for (long i = gtid; i < 49152; i += NTHR) { const long b = i / 3072, r = i % 3072; const size_t d = ((size_t)b * KSROWS + 4112) * 512 + r * 8;
            *(u32x4*)(KS + d) = (u32x4){0u, 0u, 0u, 0u}; *(u32x4*)(VS + d) = (u32x4){0u, 0u, 0u, 0u}; }
        for (long i = gtid; i < 12288; i += NTHR) { const long b = i / 768, r = i % 768; const size_t d = ((size_t)b * SWROWS + 144) * 128 + r * 8;
            *(u32x4*)(KSW + d) = (u32x4){0u, 0u, 0u, 0u}; *(u32x4*)(VSW + d) = (u32x4){0u, 0u, 0u, 0u}; }
        for (long i = gtid; i < 4112 * 8; i += NTHR) { const int pos = (int)(i >> 3), fi = (int)(i & 7);
            const double inv = fi == 0 ? 1.0 : fi == 1 ? 0.19392274474868576 : fi == 2 ? 0.03760603093086393 : fi == 3 ? 0.007292664737217109 :
                               fi == 4 ? 0.001414213562373095 : fi == 5 ? 0.0002742481756762073 : fi == 6 ? 5.318295896944988e-05 : 1.031338537721246e-05;
            const double rev = (double)pos * inv * 0.15915494309189535; const float fr = (float)(rev - __builtin_rint(rev));
            ROPE[i * 2] = __builtin_amdgcn_cosf(fr); ROPE[i * 2 + 1] = __builtin_amdgcn_sinf(fr); }
    }
    SEAM(0);
    if (IN(1)) {
        pg8::Gemm g{XA, WA_t, NP, NA, DM}; pg8::StaticOrder S; S.init(NP, NA, G, (int)blockIdx.x);
        EpiWrap<EpiAF> E{{PA, dout, KS, VS, ROPE, 0.f, 0.f}, 0, 0};
        pg8::gemm_phase<EpiWrap<EpiAF>, pg8::StaticOrder, true, true>(lds, g, S, E);
    }
    SEAM(1);
    if (IN(2)) {
        float s1 = 0.f, s2 = 0.f;
        for (int i = 0; i < 64; ++i) { s1 += a.in[10][i] * a.in[11][i]; s2 += a.in[12][i] * a.in[13][i]; }
        const float lam = __expf(s1) - __expf(s2) + 0.2f;
        unsigned* gdone = ctl + 256 + 64 * a.rep;
        if (blockIdx.x < 44) {
            if (blockIdx.x < 32) { pg8::Gemm g{MEMB, WM_t, 1024, 2048, DM}; pg8::StaticOrder S; S.init(1024, 2048, 32, (int)blockIdx.x);
                EpiWrap<EpiMemF> E{{MKV, dout, 0.f, 0.f}, 0, 0};
                pg8::gemm_phase<EpiWrap<EpiMemF>, pg8::StaticOrder, true, true>(lds, g, S, E); }
            else { pg8::Gemm g{XA + (size_t)NP * DM, WA_t, 256, NA, DM}; pg8::StaticOrder S; S.init(256, NA, 12, (int)blockIdx.x - 32);
                EpiWrap<EpiAF> E{{PA, dout, KS, VS, ROPE, 0.f, 0.f}, NP, 0};
                pg8::gemm_phase<EpiWrap<EpiAF>, pg8::StaticOrder, true, true>(lds, g, S, E); }
            asm volatile("s_waitcnt vmcnt(0)" ::: "memory"); __syncthreads();
            if (tid == 0) { __builtin_amdgcn_fence(__ATOMIC_RELEASE, "agent"); asm volatile("s_waitcnt vmcnt(0)" ::: "memory");
                            __hip_atomic_fetch_add(gdone, 1u, __ATOMIC_RELAXED, __HIP_MEMORY_SCOPE_AGENT); }
        }
        bool ready = false;
        float* PART = (float*)(ws + WS_Z0 + 40 * MiB + (size_t)a.rep * (10 * MiB));
        for (;;) {
            if (tid == 0) MISC[0] = atomicAdd(ctl + 128 * a.rep, 1u);
            __syncthreads(); const unsigned u = MISC[0]; __syncthreads();
            if (u >= 1088u) break;
            const bool needs = (u >= 256u && u < 512u) || u >= 768u;
            if (needs && !ready) {
                if (tid == 0) { unsigned sp = 0; while (__hip_atomic_load(gdone, __ATOMIC_RELAXED, __HIP_MEMORY_SCOPE_AGENT) < 44u && ++sp < (1u << 24)) __builtin_amdgcn_s_sleep(8);
                                __builtin_amdgcn_fence(__ATOMIC_ACQUIRE, "agent"); asm volatile("s_waitcnt vmcnt(0)" ::: "memory"); }
                __syncthreads(); ready = true;
            }
            if (u < 768u) {
                if (u >= 256u && u < 512u) { const unsigned v = u - 256u;
                    att::diff_sample_item(cx, (int)(v >> 4), (int)((v >> 2) & 3u), (int)(v & 3u), a.in[3], a.in[4], PA, KS, VS, MIX, a.in[14], lam, PART, ctl + 512 + 64 * a.rep, MISC); }
                else { const unsigned v = u < 256u ? u : u - 256u;
                    att::diff_unit(cx, false, (int)((v & 15u) >> 2), (int)(v & 3u), 31 - (int)(v >> 4), PA, KS, VS, MIX, a.in[14], lam); } }
            else { const bool samp = u >= 1024u; const unsigned v = samp ? u - 1024u : u - 768u;
                const int b = samp ? (int)(v >> 2) : (int)(v >> 6), h = samp ? (int)(v & 3u) : (int)((v >> 4) & 3u), qb = samp ? 0 : (int)(v & 15u);
                const bf16_t* Kb = samp ? CMK + ((size_t)b * 256) * 512 + h * 128 : MKV + ((size_t)b * 256) * 2048 + h * 128;
                const bf16_t* Vb = samp ? CMV + ((size_t)b * 256) * 512 + h * 128 : Kb + 512;
                att::mem_unit(cx, samp, b, h, qb, PA, NA, 2048, 2560, Kb, Vb, samp ? 512 : 2048, MIX); }
        }
    }
    SEAM(2);
    if (IN(3)) {
        EpiMerge0F F0{ZB, ST0, 0.f, 0.f};
        { pg8::Gemm g{MIX, WO_t, NP, DM, DM}; pg8::StaticOrder S; S.init(NP, DM, G, (int)blockIdx.x);
          EpiWrap<EpiMerge0F> E{F0, 0, 0};
          pg8::gemm_phase<EpiWrap<EpiMerge0F>, pg8::StaticOrder, true, true>(lds, g, S, E); }
        gemm_small<EpiMerge0F>(lds, MIX + (size_t)NP * DM, WO_t, DM, NP, (int)blockIdx.x, G, F0);
    }
    SEAM(3);
    if (IN(5)) {
        EpiBF FB{PB, dout, KSW, VSW, ROPE, ST0, CSV, BWV, 0.f, 0.f, {0.f, 0.f}, {0.f, 0.f}};
        { pg8::Gemm g{ZB, WB_t, NP, 2048, DM}; pg8::StaticOrder S; S.init(NP, 2048, G, (int)blockIdx.x);
          EpiWrap<EpiBF> E{FB, 0, 0};
          pg8::gemm_phase<EpiWrap<EpiBF>, pg8::StaticOrder, true, true>(lds, g, S, E); }
        gemm_small<EpiBF>(lds, ZB + (size_t)NP * DM, WB_t, 2048, NP, (int)blockIdx.x, G, FB);
    }
    SEAM(5);
    if (IN(6)) {
        unsigned* gdone = ctl + 384 + 64 * a.rep;
        if (blockIdx.x < 128) {
            EpiBF FB{PB, dout, KSW, VSW, ROPE, ST0, CSV, BWV, 0.f, 0.f, {0.f, 0.f}, {0.f, 0.f}};
            if (blockIdx.x < 64) { pg8::Gemm g{ZB, WB_t + (size_t)2048 * DM, NP, 256, DM}; pg8::StaticOrder S; S.init(NP, 256, 64, (int)blockIdx.x);
                EpiWrap<EpiBF> E{FB, 0, 2048};
                pg8::gemm_phase<EpiWrap<EpiBF>, pg8::StaticOrder, true, true>(lds, g, S, E); }
            else gemm_small<EpiBF>(lds, ZB + (size_t)NP * DM, WB_t + (size_t)2048 * DM, 256, NP, (int)blockIdx.x - 64, 64, FB, 2048);
            asm volatile("s_waitcnt vmcnt(0)" ::: "memory"); __syncthreads();
            if (tid == 0) { __builtin_amdgcn_fence(__ATOMIC_RELEASE, "agent"); asm volatile("s_waitcnt vmcnt(0)" ::: "memory");
                            __hip_atomic_fetch_add(gdone, 1u, __ATOMIC_RELAXED, __HIP_MEMORY_SCOPE_AGENT); }
        }
        bool ready = false;
        for (;;) {
            if (tid == 0) MISC[0] = atomicAdd(ctl + 64 + 128 * a.rep, 1u);
            __syncthreads(); const unsigned u = MISC[0]; __syncthreads();
            if (u >= 848u) break;
            if (u >= 320u && !ready) {
                if (tid == 0) { unsigned sp = 0; while (__hip_atomic_load(gdone, __ATOMIC_RELAXED, __HIP_MEMORY_SCOPE_AGENT) < 128u && ++sp < (1u << 24)) __builtin_amdgcn_s_sleep(8);
                                __builtin_amdgcn_fence(__ATOMIC_ACQUIRE, "agent"); asm volatile("s_waitcnt vmcnt(0)" ::: "memory"); }
                __syncthreads(); ready = true;
            }
            if (u < 320u) { const bool samp = u >= 256u; const unsigned v = samp ? u - 256u : u;
                const int b = samp ? (int)(v >> 2) : (int)(v >> 6), h = samp ? (int)(v & 3u) : (int)((v >> 4) & 3u), qb = samp ? 0 : (int)(v & 15u);
                const bf16_t* Kb = samp ? CMK + ((size_t)(16 + b) * 256) * 512 + h * 128 : MKV + ((size_t)b * 256) * 2048 + 1024 + h * 128;
                const bf16_t* Vb = samp ? CMV + ((size_t)(16 + b) * 256) * 512 + h * 128 : Kb + 512;
                att::mem_unit(cx, samp, b, h, qb, PB, NB, 1024, 1536, Kb, Vb, samp ? 512 : 2048, MIX); }
            else { const bool samp = u >= 832u; const unsigned v = samp ? u - 832u : u - 320u;
                const int b = samp ? (int)v : (int)(v >> 7), c = samp ? 0 : (int)((v >> 1) & 63u), half = samp ? 0 : (int)(v & 1u);
                att::swa_unit(cx, samp, b, c, half, PB, KSW, VSW, MIX, a.in[16]); }
        }
    }
    SEAM(6);
    if (IN(7)) {
        EpiMerge1F F1{ZB, ST0, a.in[20], a.in[21], Z1B, ST1, 0.f, 0.f, {0.f, 0.f}, {0.f, 0.f}};
        { pg8::Gemm g{MIX, WO_t + (size_t)DM * DM, NP, DM, DM}; pg8::StaticOrder S; S.init(NP, DM, G, (int)blockIdx.x);
          EpiWrap<EpiMerge1F> E{F1, 0, 0};
          pg8::gemm_phase<EpiWrap<EpiMerge1F>, pg8::StaticOrder, true, true>(lds, g, S, E); }
        gemm_small<EpiMerge1F>(lds, MIX + (size_t)NP * DM, WO_t + (size_t)DM * DM, DM, NP, (int)blockIdx.x, G, F1);
    }
    SEAM(7);
    if (IN(8)) {
        const float* g1 = a.in[20] + DM; const float* b1 = a.in[21] + DM;
#pragma unroll 4
        for (long i = gtid; i < (long)MA * 256; i += NTHR) { const int row = (int)(i >> 8), c4 = (int)(i & 255) * 4;
            float mu, rstd; row_stats(ST1, row, mu, rstd);
            const u32x2 zz = *(const u32x2*)(Z1B + (size_t)row * DM + c4);
            const f32x4 z = (f32x4){bflo(zz.x), bfhi(zz.x), bflo(zz.y), bfhi(zz.y)};
            *(f32x4*)(dout + (size_t)row * DM + c4) = (z - mu) * rstd * *(const f32x4*)(g1 + c4) + *(const f32x4*)(b1 + c4); }
    }
#undef IN
#undef SEAM
}

#ifndef MK_N_LAUNCHES
#define MK_N_LAUNCHES 1
#endif
#ifndef PROBE_DUP
#define PROBE_DUP 0
#endif
extern "C" void kernel_launch(void* const* d_in, const int* in_sizes, int n_in, void* d_out, int out_size, void* d_ws, size_t ws_size, hipStream_t stream) {
    static int grid = 0;
    if (grid == 0) {
        if (n_in != 22 || ws_size < WS_END) { fprintf(stderr, "kernel_launch: unexpected n_in %d / ws %zu\n", n_in, ws_size); grid = -1; return; }
        int dev = 0, cus = 0, per_cu = 0;
        if (hipGetDevice(&dev) != hipSuccess || hipDeviceGetAttribute(&cus, hipDeviceAttributeMultiprocessorCount, dev) != hipSuccess) { grid = -1; return; }
        if (hipFuncSetAttribute((const void*)yoco_fwd, hipFuncAttributeMaxDynamicSharedMemorySize, LDS_BYTES) != hipSuccess) { fprintf(stderr, "kernel_launch: hipFuncSetAttribute failed\n"); grid = -1; return; }
        if (hipOccupancyMaxActiveBlocksPerMultiprocessor(&per_cu, (const void*)yoco_fwd, NWAVES * 64, LDS_BYTES) != hipSuccess || per_cu < 1) { fprintf(stderr, "kernel_launch: occupancy query says %d\n", per_cu); per_cu = 1; }
        (void)hipGetLastError();
        grid = cus;
    }
    if (grid < 0) return;
    (void)hipMemsetAsync((char*)d_ws + WS_CTL, 0, 1048576, stream);
    Args a{};
    for (int i = 0; i < 22; ++i) a.in[i] = (const float*)d_in[i];
    a.out = (float*)d_out; a.ws = (unsigned char*)d_ws;
#if MK_N_LAUNCHES == 1
    a.ph_lo = 0; a.ph_hi = NPHASE;
    void* args[] = {&a};
    hipError_t e = hipLaunchCooperativeKernel((const void*)yoco_fwd, dim3(grid), dim3(NWAVES * 64), args, LDS_BYTES, stream);
    if (e != hipSuccess) fprintf(stderr, "kernel_launch: cooperative launch failed: %s (grid %d)\n", hipGetErrorString(e), grid);
#else
    for (int p = 0; p < NPHASE; ++p) { a.ph_lo = p; a.ph_hi = p + 1;
        for (int r = 0; r < 1 + ((PROBE_DUP >> p) & 1); ++r) { a.rep = r; hipLaunchKernelGGL(yoco_fwd, dim3(grid), dim3(NWAVES * 64), LDS_BYTES, stream, a); } }
#endif
}
```

```cpp
#include <hip/hip_runtime.h>
#include <hip/hip_cooperative_groups.h>
#include <cstdio>
#include <cstdint>
namespace cg = cooperative_groups;
namespace pg8 {
#define PG8_LAS __attribute__((address_space(3)))
typedef unsigned short bf16_t;
typedef short bf16x8 __attribute__((ext_vector_type(8)));
typedef float f32x4 __attribute__((ext_vector_type(4)));
typedef unsigned u32x4 __attribute__((ext_vector_type(4)));
constexpr int BM = 256, BK = 64, HALF = 128, HTB = HALF * BK * 2  , STAGE_BYTES = 8 * HTB, NXCD = 8, WGM = 8;

__host__ __device__ __forceinline__ int lds_byte(int r, int c) { const int st = (r >> 4) * 2 + (c >> 5), rr = r & 15, cc = c & 31, ob = rr * 64 + cc * 2; return st * 1024 + (ob ^ (((ob >> 9) & 1) << 5)); }
__host__ __device__ __forceinline__ void stage_rc(int b, int& R, int& C) { const int st = b / 1024, sb = b % 1024, swz = sb ^ (((sb >> 9) & 1) << 5); R = (st >> 1) * 16 + swz / 64; C = (st & 1) * 32 + (swz % 64) / 2; }
__host__ __device__ __forceinline__ int perm32(int rho) { const int n = rho >> 4, i = rho & 15; return 8 * (i >> 2) + 4 * n + (i & 3); }

struct Unit { int pm, pn; };
struct Gemm { const bf16_t* A; const bf16_t* Bt; int M, N, K; };

struct StaticOrder {
    int nM, nN, nwg, G, c;
    __host__ __device__ void init(int M, int N, int G_, int c_) { nM = M / BM; nN = N / BM; nwg = nM * nN; G = G_; c = c_; }
    __host__ __device__ bool next(int i, Unit& u) const {
        const long L = (long)i * G + c; if (L >= nwg) return false;
        int wgid = (int)L; { const int q = nwg / NXCD, r = nwg % NXCD, xcd = wgid % NXCD, off = wgid / NXCD; wgid = (xcd < r ? xcd * (q + 1) : r * (q + 1) + (xcd - r) * q) + off; }
        const int nig = WGM * nN, gid = wgid / nig, fm = gid * WGM, gsz = (nM - fm) < WGM ? (nM - fm) : WGM;
        u.pm = fm + ((wgid % nig) % gsz); u.pn = (wgid % nig) / gsz; return true;
    }
    __device__ __forceinline__ void a_ready(const Unit&) const {}
    __device__ __forceinline__ void done(const Unit&) const {}
};
__device__ __forceinline__ unsigned cvt_pk_bf16(float lo, float hi) { unsigned r; asm volatile("v_cvt_pk_bf16_f32 %0, %1, %2" : "=v"(r) : "v"(lo), "v"(hi)); return r; }
typedef float f32x2 __attribute__((ext_vector_type(2)));
template <class Epi, class Sched, bool ALIGN_EPI = false, bool SP2 = false>
__device__ __forceinline__ void gemm_phase(PG8_LAS unsigned char* lds, const Gemm g, const Sched& S, const Epi& E) {
    const int tid = threadIdx.x, wid = __builtin_amdgcn_readfirstlane(tid >> 6), lane = tid & 63, wr = wid >> 2, wc = wid & 3, fr = lane & 15, fq = lane >> 4;
    const int K = g.K, nt = K / BK;
    unsigned voffA[2], voffB[2];
#pragma unroll
    for (int i = 0; i < 2; ++i) { int R, C; stage_rc(tid * 16 + i * 8192, R, C); const int Rb = Epi::PERM ? ((R & ~31) + perm32(R & 31)) : R;
        voffA[i] = (unsigned)(R * K + C) * 2u; voffB[i] = (unsigned)(Rb * K + C) * 2u; }
    const size_t kstep = (size_t)(BK * 2);
    const size_t hstep = (size_t)HALF * K * 2;
    const size_t tstep = 2 * hstep;
    const unsigned ldsw = (unsigned)wid * 1024u;
    const int aoff = lds_byte(wr * 64 + fr, fq * 8), boff = lds_byte(wc * 32 + fr, fq * 8);
#define PG8_SA(b, h) (((b) * 2 + (h)) * HTB)
#define PG8_SB(b, h) ((4 + (b) * 2 + (h)) * HTB)
#define PG8_STAGE(bufoff, gbase, voff) do { _Pragma("unroll") for (int _i = 0; _i < 2; ++_i) \
        __builtin_amdgcn_global_load_lds((const unsigned*)((const char*)(gbase) + (voff)[_i]), (PG8_LAS unsigned*)(lds + (bufoff) + ldsw + _i * 8192), 16, 0, 0); } while (0)
#define PG8_LDA(dst, b, h) do { _Pragma("unroll") for (int m = 0; m < 4; ++m) _Pragma("unroll") for (int k = 0; k < 2; ++k) dst[m][k] = *(const PG8_LAS bf16x8*)(lds + PG8_SA(b, h) + aoff + m * 2048 + k * 1024); } while (0)
#define PG8_LDB(dst, b, h) do { _Pragma("unroll") for (int n = 0; n < 2; ++n) _Pragma("unroll") for (int k = 0; k < 2; ++k) dst[n][k] = *(const PG8_LAS bf16x8*)(lds + PG8_SB(b, h) + boff + n * 2048 + k * 1024); } while (0)
#define PG8_MMA(ai, bj, At, Bt) do { __builtin_amdgcn_s_setprio(1); _Pragma("unroll") for (int m = 0; m < 4; ++m) _Pragma("unroll") for (int n = 0; n < 2; ++n) _Pragma("unroll") for (int k = 0; k < 2; ++k) \
        acc[ai][bj][m][n] = __builtin_amdgcn_mfma_f32_16x16x32_bf16(Bt[n][k], At[m][k], acc[ai][bj][m][n], 0, 0, 0); __builtin_amdgcn_s_setprio(0); } while (0)
#define PG8_WAIT_V(n) asm volatile("s_waitcnt vmcnt(" #n ")" ::: "memory")
#define PG8_WAIT_L(n) asm volatile("s_waitcnt lgkmcnt(" #n ")" ::: "memory")
#define PG8_BAR __builtin_amdgcn_s_barrier()
#define PG8_SCHED __builtin_amdgcn_sched_barrier(0)
    Unit cur, nxt; int ui = 0;
    if (!S.next(0, cur)) return;
    f32x4 acc[2][2][4][2];
#pragma unroll
    for (int a = 0; a < 2; ++a)
#pragma unroll
        for (int b = 0; b < 2; ++b)
#pragma unroll
            for (int m = 0; m < 4; ++m)
#pragma unroll
                for (int n = 0; n < 2; ++n) acc[a][b][m][n] = (f32x4){0.f, 0.f, 0.f, 0.f};
    bf16x8 At[4][2], B0[2][2], B1[2][2];
    const char* cA = (const char*)g.A + (size_t)cur.pm * tstep; const char* cB = (const char*)g.Bt + (size_t)cur.pn * tstep;
    S.a_ready(cur);
    if constexpr (SP2) {
        PG8_STAGE(PG8_SB(0, 0), cB, voffB); PG8_STAGE(PG8_SB(0, 1), cB + hstep, voffB); PG8_STAGE(PG8_SA(0, 0), cA, voffA); PG8_STAGE(PG8_SA(0, 1), cA + hstep, voffA);
        if (wr == 1) PG8_BAR;
        PG8_WAIT_V(2); PG8_BAR;
        PG8_STAGE(PG8_SB(1, 0), cB + kstep, voffB); PG8_STAGE(PG8_SA(1, 0), cA + kstep, voffA); PG8_STAGE(PG8_SB(1, 1), cB + hstep + kstep, voffB);
        PG8_WAIT_V(6); PG8_BAR;
    } else {
        PG8_STAGE(PG8_SB(0, 0), cB, voffB); PG8_STAGE(PG8_SA(0, 0), cA, voffA); PG8_STAGE(PG8_SB(0, 1), cB + hstep, voffB); PG8_STAGE(PG8_SA(0, 1), cA + hstep, voffA);
        if (wr == 1) PG8_BAR;
        PG8_WAIT_V(4); PG8_BAR;
        PG8_STAGE(PG8_SB(1, 0), cB + kstep, voffB); PG8_STAGE(PG8_SA(1, 0), cA + kstep, voffA); PG8_STAGE(PG8_SB(1, 1), cB + hstep + kstep, voffB);
        PG8_WAIT_V(6); PG8_BAR;
    }
    for (;;) {
        const bool has_next = S.next(ui + 1, nxt);
        const char* nA = has_next ? (const char*)g.A + (size_t)nxt.pm * tstep : cA; const char* nB = has_next ? (const char*)g.Bt + (size_t)nxt.pn * tstep : cB;
        for (int t = 0; t < nt; t += 2) {
            const bool last = (t == nt - 2);
            const char* a1 = cA + (size_t)(t + 1) * kstep;
            const char* a2 = last ? nA : cA + (size_t)(t + 2) * kstep; const char* b2 = last ? nB : cB + (size_t)(t + 2) * kstep;
            const char* a3 = a2 + kstep; const char* b3 = b2 + kstep;
            if (last && has_next) S.a_ready(nxt);
            if constexpr (SP2) {
            PG8_LDB(B0, 0, 0); PG8_LDB(B1, 0, 1); PG8_SCHED; PG8_LDA(At, 0, 0); PG8_STAGE(PG8_SA(1, 1), a1 + hstep, voffA);
            PG8_WAIT_V(8); PG8_WAIT_L(0); PG8_BAR; PG8_MMA(0, 0, At, B0); PG8_MMA(0, 1, At, B1); PG8_BAR; PG8_SCHED;
            PG8_LDA(At, 0, 1); PG8_STAGE(PG8_SB(0, 0), b2, voffB); PG8_STAGE(PG8_SB(0, 1), b2 + hstep, voffB); PG8_STAGE(PG8_SA(0, 0), a2, voffA);
            PG8_WAIT_V(8); PG8_WAIT_L(0); PG8_BAR; PG8_MMA(1, 0, At, B0); PG8_MMA(1, 1, At, B1); PG8_BAR; PG8_SCHED;
            PG8_LDB(B0, 1, 0); PG8_LDB(B1, 1, 1); PG8_SCHED; PG8_LDA(At, 1, 0); PG8_STAGE(PG8_SA(0, 1), a2 + hstep, voffA);
            PG8_WAIT_V(8); PG8_WAIT_L(0); PG8_BAR; PG8_MMA(0, 0, At, B0); PG8_MMA(0, 1, At, B1); PG8_BAR; PG8_SCHED;
            PG8_LDA(At, 1, 1); PG8_STAGE(PG8_SB(1, 0), b3, voffB); PG8_STAGE(PG8_SB(1, 1), b3 + hstep, voffB); PG8_STAGE(PG8_SA(1, 0), a3, voffA);
            PG8_WAIT_V(8); PG8_WAIT_L(0); PG8_BAR; PG8_MMA(1, 0, At, B0); PG8_MMA(1, 1, At, B1); PG8_BAR; PG8_SCHED;
            } else {
            PG8_LDB(B0, 0, 0); PG8_SCHED; PG8_LDA(At, 0, 0); PG8_STAGE(PG8_SA(1, 1), a1 + hstep, voffA);
            PG8_WAIT_L(8); PG8_BAR; PG8_WAIT_L(0); PG8_MMA(0, 0, At, B0); PG8_BAR; PG8_SCHED;
            PG8_LDB(B1, 0, 1); PG8_STAGE(PG8_SB(0, 0), b2, voffB);
            PG8_BAR; PG8_WAIT_L(0); PG8_MMA(0, 1, At, B1); PG8_BAR;
            PG8_LDA(At, 0, 1); PG8_STAGE(PG8_SA(0, 0), a2, voffA);
            PG8_BAR; PG8_WAIT_L(0); PG8_MMA(1, 0, At, B0); PG8_BAR; PG8_SCHED;
            PG8_STAGE(PG8_SB(0, 1), b2 + hstep, voffB);
            PG8_WAIT_V(6); PG8_BAR; PG8_MMA(1, 1, At, B1); PG8_BAR;
            PG8_LDB(B0, 1, 0); PG8_SCHED; PG8_LDA(At, 1, 0); PG8_STAGE(PG8_SA(0, 1), a2 + hstep, voffA);
            PG8_WAIT_L(8); PG8_BAR; PG8_WAIT_L(0); PG8_MMA(0, 0, At, B0); PG8_BAR; PG8_SCHED;
            PG8_LDB(B1, 1, 1); PG8_STAGE(PG8_SB(1, 0), b3, voffB);
            PG8_BAR; PG8_WAIT_L(0); PG8_MMA(0, 1, At, B1); PG8_BAR;
            PG8_LDA(At, 1, 1); PG8_STAGE(PG8_SA(1, 0), a3, voffA);
            PG8_BAR; PG8_WAIT_L(0); PG8_MMA(1, 0, At, B0); PG8_BAR; PG8_SCHED;
            PG8_STAGE(PG8_SB(1, 1), b3 + hstep, voffB);
            PG8_WAIT_V(6); PG8_BAR; PG8_MMA(1, 1, At, B1); PG8_BAR;
            }
        }
        if constexpr (ALIGN_EPI) { if (wr == 0) PG8_BAR; }
        if constexpr (!Epi::AFTER_DRAIN) { E(acc, cur, wr, wc, fr, fq); S.done(cur); }
        if (!has_next) break;
#pragma unroll
        for (int a = 0; a < 2; ++a)
#pragma unroll
            for (int b = 0; b < 2; ++b)
#pragma unroll
                for (int m = 0; m < 4; ++m)
#pragma unroll
                    for (int n = 0; n < 2; ++n) acc[a][b][m][n] = (f32x4){0.f, 0.f, 0.f, 0.f};
        cur = nxt; cA = nA; cB = nB; ++ui;
        if constexpr (ALIGN_EPI) { if (wr == 1) PG8_BAR; }
    }
    PG8_WAIT_V(0);
    if constexpr (!ALIGN_EPI) { if (wr == 0) PG8_BAR; }
    PG8_BAR;
    if constexpr (Epi::AFTER_DRAIN) { E.fused(acc, cur, wr, wc, fr, fq, lds, wid, lane); S.done(cur); }
#undef PG8_SA
#undef PG8_SB
#undef PG8_STAGE
#undef PG8_LDA
#undef PG8_LDB
#undef PG8_MMA
#undef PG8_WAIT_V
#undef PG8_WAIT_L
#undef PG8_BAR
#undef PG8_SCHED
}
}

typedef unsigned short bf16_t;
typedef short bf16x8 __attribute__((ext_vector_type(8)));
typedef short s16x4 __attribute__((ext_vector_type(4)));
typedef float f32x4 __attribute__((ext_vector_type(4)));
typedef float f32x16 __attribute__((ext_vector_type(16)));
typedef unsigned u32x4 __attribute__((ext_vector_type(4)));
typedef unsigned u32x2 __attribute__((ext_vector_type(2)));
#define LAS __attribute__((address_space(3)))

constexpr int DM = 1024, NP = 16384, NS = 256, MA = NP + NS;
constexpr int NA = 3072, NB = 2304;
constexpr int KSROWS = 4160, SWROWS = 192;
constexpr float DN_ALPHA = 1.41421356237309515f;
constexpr float LOG2E = 1.4426950408889634f;
constexpr float C64 = 0.125f * LOG2E, THR64 = 64.f;
constexpr float C128 = 0.088388347648318440f * LOG2E, THR128 = 90.5f;
constexpr size_t OFF_DKP = 17039360, OFF_DVP = 25427968, OFF_DKS = 33816576, OFF_DVS = 33947648, OFF_SKP = 34078720, OFF_SVP = 34144256,
                 OFF_SKS = 34209792, OFF_SVS = 34471936, OFF_MKP = 34734080, OFF_MVP = 35782656;
constexpr size_t MiB = 1u << 20;
constexpr size_t WS_CTL = 0, WS_ROPE = 1 * MiB, WS_WA = 2 * MiB, WS_WB = 8 * MiB, WS_WM = 13 * MiB, WS_WO = 17 * MiB, WS_MEMB = 21 * MiB, WS_MKV = 23 * MiB,
                 WS_CMK = 27 * MiB, WS_CMV = 35 * MiB, WS_KSW = 43 * MiB, WS_VSW = 44 * MiB, WS_XA = 46 * MiB, WS_MIX = 79 * MiB, WS_Z0 = 112 * MiB,
                 WS_PA = 177 * MiB, WS_KS = 275 * MiB, WS_VS = 340 * MiB, WS_END = 405 * MiB;
constexpr int LDS_RING = 131072, LDS_BYTES = LDS_RING + 256;

__device__ __forceinline__ unsigned cvtpk(float lo, float hi) { unsigned r; asm volatile("v_cvt_pk_bf16_f32 %0, %1, %2" : "=v"(r) : "v"(lo), "v"(hi)); return r; }
__device__ __forceinline__ float bflo(unsigned w) { return __uint_as_float(w << 16); }
__device__ __forceinline__ float bfhi(unsigned w) { return __uint_as_float(w & 0xffff0000u); }
__device__ __forceinline__ float silu(float x) { return x * __builtin_amdgcn_rcpf(1.f + __expf(-x)); }
__device__ __forceinline__ void cvt8(const float* s, bf16_t* d) {
    const f32x4 a = *(const f32x4*)s, b = *(const f32x4*)(s + 4);
    u32x4 w; w.x = cvtpk(a.x, a.y); w.y = cvtpk(a.z, a.w); w.z = cvtpk(b.x, b.y); w.w = cvtpk(b.z, b.w); *(u32x4*)d = w;
}

__device__ __forceinline__ f32x4 shfl4(f32x4 v, int m) { f32x4 p; p.x = __shfl_xor(v.x, m); p.y = __shfl_xor(v.y, m); p.z = __shfl_xor(v.z, m); p.w = __shfl_xor(v.w, m); return p; }
struct NoPre {};
template <class F> struct EpiWrap {
    static constexpr bool PERM = false, AFTER_DRAIN = false;
    F f; int rowbase, colbase;
    __device__ __forceinline__ void operator()(const f32x4 (&acc)[2][2][4][2], const pg8::Unit& u, int wr, int wc, int fr, int fq) const {
        F lf = f;
#pragma unroll
        for (int ai = 0; ai < 2; ++ai)
#pragma unroll
            for (int mp = 0; mp < 2; ++mp) {
                typename F::Pre pr[2][2][2]; f32x4 vv[2][2][2];
                const int row0 = rowbase + u.pm * 256 + ai * 128 + wr * 64 + mp * 32 + fr, colb = colbase + u.pn * 256 + wc * 32 + 4 * fq;
#pragma unroll
                for (int mm = 0; mm < 2; ++mm) { lf.row_begin(mm, row0 + mm * 16);
#pragma unroll
                    for (int bj = 0; bj < 2; ++bj)
#pragma unroll
                        for (int n = 0; n < 2; ++n) pr[mm][bj][n] = lf.pre(row0 + mm * 16, colb + bj * 128 + n * 16); }
#pragma unroll
                for (int mm = 0; mm < 2; ++mm)
#pragma unroll
                    for (int bj = 0; bj < 2; ++bj)
#pragma unroll
                        for (int n = 0; n < 2; ++n) vv[mm][bj][n] = lf.fix(mm, colb + bj * 128 + n * 16, acc[ai][bj][mp * 2 + mm][n], pr[mm][bj][n]);
#pragma unroll
                for (int mm = 0; mm < 2; ++mm) { const int row = row0 + mm * 16; lf.s = 0.f; lf.q = 0.f;
#pragma unroll
                    for (int bj = 0; bj < 2; ++bj)
#pragma unroll
                        for (int n = 0; n < 2; ++n) { const int col = colb + bj * 128 + n * 16; f32x4 p = vv[mm][bj][n];
                            if constexpr (F::ROPE) { if (lf.need_rope(col)) p = shfl4(p, 32); }
                            lf.quad(row, col, vv[mm][bj][n], p); }
                    if constexpr (F::STATS) { float s = lf.s, q = lf.q; s += __shfl_xor(s, 16); s += __shfl_xor(s, 32); q += __shfl_xor(q, 16); q += __shfl_xor(q, 32);
                        if (fq == 0) lf.commit(row, s, q); } }
            }
    }
};
__device__ __forceinline__ f32x4 rope_apply(f32x4 v, f32x4 p, int col, int pos, const float* rope) {
    const float* t = rope + ((size_t)pos * 8 + (col & 4)) * 2;
    const f32x4 t0 = *(const f32x4*)t, t1 = *(const f32x4*)(t + 4);
    const float sg = (col & 8) ? 1.f : -1.f;
    f32x4 o; o.x = v.x * t0.x + sg * p.x * t0.y; o.y = v.y * t0.z + sg * p.y * t0.w; o.z = v.z * t1.x + sg * p.z * t1.y; o.w = v.w * t1.z + sg * p.w * t1.w;
    return o;
}
__device__ __forceinline__ void st_bf4(bf16_t* p, f32x4 v) { u32x2 w; w.x = cvtpk(v.x, v.y); w.y = cvtpk(v.z, v.w); *(u32x2*)p = w; }
__device__ __forceinline__ void row_stats(const float* ST, int row, float& mu, float& rstd) {
    const float s = ST[2 * (size_t)row], q = ST[2 * (size_t)row + 1]; mu = s * (1.f / DM); rstd = rsqrtf(fmaxf(q * (1.f / DM) - mu * mu, 0.f) + 1e-5f);
}

struct EpiAF {
    static constexpr bool ROPE = true, STATS = false; typedef NoPre Pre;
    bf16_t* PA; float* dout; bf16_t* KS; bf16_t* VS; const float* rope; float s, q;
    __device__ __forceinline__ void row_begin(int, int) {}
    __device__ __forceinline__ Pre pre(int, int) const { return Pre{}; }
    __device__ __forceinline__ f32x4 fix(int, int, f32x4 v, const Pre&) const { return v; }
    __device__ __forceinline__ bool need_rope(int col) const { return (col >> 9) < 2 && ((col >> 4) & 3) == 0; }
    __device__ __forceinline__ void commit(int, float, float) {}
    __device__ __forceinline__ void quad(int row, int col, f32x4 v, f32x4 p) {
        const bool samp = row >= NP; const int rs = row - NP;
        const int pos = samp ? 4096 + (rs & 15) : (row & 4095);
        const int region = col >> 9;
        if (need_rope(col)) v = rope_apply(v, p, col, pos, rope);
        st_bf4(PA + (size_t)row * NA + col, v);
        if (region == 1 || region == 2) {
            const int c = col & 511;
            if (!samp) *(f32x4*)(dout + (region == 1 ? OFF_DKP : OFF_DVP) + (size_t)row * 512 + c) = v;
            else { *(f32x4*)(dout + (region == 1 ? OFF_DKS : OFF_DVS) + (size_t)rs * 512 + c) = v;
                   st_bf4((region == 1 ? KS : VS) + ((size_t)(rs >> 4) * KSROWS + 4096 + (rs & 15)) * 512 + c, v); }
        }
    }
};
struct EpiMemF {
    static constexpr bool ROPE = false, STATS = false; typedef NoPre Pre;
    bf16_t* MKV; float* dout; float s, q;
    __device__ __forceinline__ void row_begin(int, int) {}
    __device__ __forceinline__ Pre pre(int, int) const { return Pre{}; }
    __device__ __forceinline__ f32x4 fix(int, int, f32x4 v, const Pre&) const { return v; }
    __device__ __forceinline__ void commit(int, float, float) {}
    __device__ __forceinline__ void quad(int row, int col, f32x4 v, f32x4) {
        st_bf4(MKV + (size_t)row * 2048 + col, v);
        const int l = col >> 10, c = col & 1023;
        *(f32x4*)(dout + (c < 512 ? OFF_MKP : OFF_MVP) + (size_t)l * 524288 + (size_t)row * 512 + (c & 511)) = v;
    }
};
struct EpiMerge0F {
    static constexpr bool ROPE = false, STATS = true; typedef u32x2 Pre;
    bf16_t* ZB; float* ST; float s, q;
    __device__ __forceinline__ void row_begin(int, int) {}
    __device__ __forceinline__ Pre pre(int row, int col) const { return *(const u32x2*)(ZB + (size_t)row * DM + col); }
    __device__ __forceinline__ f32x4 fix(int, int, f32x4 v, const Pre& x) const { return (f32x4){bflo(x.x), bfhi(x.x), bflo(x.y), bfhi(x.y)} * DN_ALPHA + v; }
    __device__ __forceinline__ void commit(int row, float ss, float qq) { atomicAdd(ST + 2 * (size_t)row, ss); atomicAdd(ST + 2 * (size_t)row + 1, qq); }
    __device__ __forceinline__ void quad(int row, int col, f32x4 z, f32x4) {
        st_bf4(ZB + (size_t)row * DM + col, z);
        s += (z.x + z.y) + (z.z + z.w); q += (z.x * z.x + z.y * z.y) + (z.z * z.z + z.w * z.w);
    }
};
struct EpiMerge1F {
    static constexpr bool ROPE = false, STATS = true; typedef u32x2 Pre;
    const bf16_t* ZB; const float* ST0; const float* g0; const float* b0; bf16_t* out; float* ST1; float s, q, mu[2], rstd[2];
    __device__ __forceinline__ void row_begin(int sl, int row) { row_stats(ST0, row, mu[sl], rstd[sl]); }
    __device__ __forceinline__ Pre pre(int row, int col) const { return *(const u32x2*)(ZB + (size_t)row * DM + col); }
    __device__ __forceinline__ f32x4 fix(int sl, int col, f32x4 v, const Pre& z) const {
        const f32x4 z0 = (f32x4){bflo(z.x), bfhi(z.x), bflo(z.y), bfhi(z.y)};
        const f32x4 g = *(const f32x4*)(g0 + col), b = *(const f32x4*)(b0 + col); return ((z0 - mu[sl]) * rstd[sl] * g + b) * DN_ALPHA + v; }
    __device__ __forceinline__ void commit(int row, float ss, float qq) { atomicAdd(ST1 + 2 * (size_t)row, ss); atomicAdd(ST1 + 2 * (size_t)row + 1, qq); }
    __device__ __forceinline__ void quad(int row, int col, f32x4 z, f32x4) {
        st_bf4(out + (size_t)row * DM + col, z);
        s += (z.x + z.y) + (z.z + z.w); q += (z.x * z.x + z.y * z.y) + (z.z * z.z + z.w * z.w);
    }
};
struct PreB { f32x4 c, b; };
struct EpiBF {
    static constexpr bool ROPE = true, STATS = false; typedef PreB Pre;
    bf16_t* PB; float* dout; bf16_t* KSW; bf16_t* VSW; const float* rope; const float* ST0; const float* CS; const float* BW; float s, q, mu[2], rstd[2];
    __device__ __forceinline__ void row_begin(int sl, int row) { row_stats(ST0, row, mu[sl], rstd[sl]); }
    __device__ __forceinline__ Pre pre(int, int col) const { Pre p; p.c = *(const f32x4*)(CS + col); p.b = *(const f32x4*)(BW + col); return p; }
    __device__ __forceinline__ f32x4 fix(int sl, int, f32x4 v, const Pre& p) const { return (v - p.c * mu[sl]) * rstd[sl] + p.b; }
    __device__ __forceinline__ bool need_rope(int col) const { return (col < 512 || (col >= 2048 && col < 2176)) && ((col >> 4) & 3) == 0; }
    __device__ __forceinline__ void commit(int, float, float) {}
    __device__ __forceinline__ void quad(int row, int col, f32x4 v, f32x4 p) {
        const bool samp = row >= NP; const int rs = row - NP;
        const int t = samp ? (rs & 15) : (row & 4095);
        const int pos = samp ? 4096 + t : t;
        const bool isk = col >= 2048 && col < 2176;
        if (need_rope(col)) v = rope_apply(v, p, col, pos, rope);
        st_bf4(PB + (size_t)row * NB + col, v);
        if (col >= 2048) {
            const int cc = col & 127;
            if (!samp) { if (t >= 3968) *(f32x4*)(dout + (isk ? OFF_SKP : OFF_SVP) + ((size_t)(row >> 12) * 128 + (t - 3968)) * 128 + cc) = v; }
            else { const int b = rs >> 4;
                   *(f32x4*)(dout + (isk ? OFF_SKS : OFF_SVS) + ((size_t)b * 128 + 112 + t) * 128 + cc) = v;
                   st_bf4((isk ? KSW : VSW) + ((size_t)b * SWROWS + 128 + t) * 128 + cc, v); }
        }
    }
};
template <class F> __device__ __forceinline__ void gemm_small(LAS unsigned char* lds, const bf16_t* A, const bf16_t* Bt, int N, int rowbase, int ustart, int G, const F& f, int colbase = 0) {
    const int tid = threadIdx.x, lane = tid & 63, r32 = lane & 31, hi = lane >> 5, wid = __builtin_amdgcn_readfirstlane(tid >> 6);
    const int nu = 8 * (N / 32);
    for (int u = ustart; u < nu; u += G) {
        const int row0 = (u & 7) * 32, colw = (u >> 3) * 32, col0 = colbase + colw;
        const bf16_t* ap = A + (size_t)(row0 + r32) * DM + wid * 128 + hi * 8; const bf16_t* bp = Bt + (size_t)(colw + r32) * DM + wid * 128 + hi * 8;
        bf16x8 af[8], bfr[8];
#pragma unroll
        for (int k = 0; k < 8; ++k) { af[k] = *(const bf16x8*)(ap + 16 * k); bfr[k] = *(const bf16x8*)(bp + 16 * k); }
        f32x16 acc = f32x16{};
#pragma unroll
        for (int k = 0; k < 8; ++k) acc = __builtin_amdgcn_mfma_f32_32x32x16_bf16(bfr[k], af[k], acc, 0, 0, 0);
        LAS float* part = (LAS float*)lds + wid * 1024;
#pragma unroll
        for (int r = 0; r < 16; ++r) part[r * 64 + lane] = acc[r];
        __syncthreads();
        if (wid < 2) {
            F lf = f; f32x4 qd[2];
#pragma unroll
            for (int e = 0; e < 2; ++e) { float t[4];
#pragma unroll
                for (int c = 0; c < 4; ++c) { const int r = 4 * (2 * wid + e) + c; float a = 0.f;
#pragma unroll
                    for (int w = 0; w < 8; ++w) a += ((LAS float*)lds)[w * 1024 + r * 64 + lane];
                    t[c] = a; }
                qd[e] = (f32x4){t[0], t[1], t[2], t[3]}; }
            const int row = rowbase + row0 + r32; typename F::Pre pr[2];
            lf.row_begin(0, row);
#pragma unroll
            for (int e = 0; e < 2; ++e) pr[e] = lf.pre(row, col0 + 8 * (2 * wid + e) + 4 * hi);
#pragma unroll
            for (int e = 0; e < 2; ++e) qd[e] = lf.fix(0, col0 + 8 * (2 * wid + e) + 4 * hi, qd[e], pr[e]);
            lf.s = 0.f; lf.q = 0.f;
#pragma unroll
            for (int e = 0; e < 2; ++e) lf.quad(row, col0 + 8 * (2 * wid + e) + 4 * hi, qd[e], qd[e ^ 1]);
            if constexpr (F::STATS) { float s = lf.s, q = lf.q; s += __shfl_xor(s, 32); q += __shfl_xor(q, 32); if (hi == 0) lf.commit(row, s, q); }
        }
        __syncthreads();
    }
}

namespace att {
#define KSWZ(row, colB) ((row) * 256 + ((colB) ^ (((row) & 7) << 4)))
#define SBAR() __builtin_amdgcn_sched_barrier(0)
__device__ __forceinline__ int v_st(int k, int c) { const int kk = (k & ~0xC) | ((k & 4) << 1) | ((k & 8) >> 1); return ((kk >> 3) * 4 + (c >> 5)) * 512 + ((kk & 7) * 32 + (c & 31)) * 2; }
__device__ __forceinline__ int v_rd_base(int lane) { return ((lane & 3) << 3) | (((lane >> 2) & 3) << 6) | (((lane >> 4) & 1) << 5) | (((lane >> 5) & 1) << 8); }
constexpr int v_rd_off(int d0, int ks, int half) { return d0 * 512 + ks * 4096 + half * 2048; }
template <int OFF> __device__ __forceinline__ s16x4 tr_read(int vb) {
    s16x4 r; asm volatile("ds_read_b64_tr_b16 %0, %1 offset:%2" : "=&v"(r) : "v"(vb), "i"(OFF) : "memory"); return r;
}
template <int OFF> __device__ __forceinline__ bf16x8 lds_read128(int ad) {
    bf16x8 r; asm volatile("ds_read_b128 %0, %1 offset:%2" : "=&v"(r) : "v"(ad), "i"(OFF) : "memory"); return r;
}
template <int D0> __device__ __forceinline__ void pv_one(f32x16& od, int vb, bf16x8 pa0, bf16x8 pa1, bf16x8 pa2, bf16x8 pa3) {
    const s16x4 l0 = tr_read<v_rd_off(D0, 0, 0)>(vb), h0 = tr_read<v_rd_off(D0, 0, 1)>(vb), l1 = tr_read<v_rd_off(D0, 1, 0)>(vb), h1 = tr_read<v_rd_off(D0, 1, 1)>(vb);
    const s16x4 l2 = tr_read<v_rd_off(D0, 2, 0)>(vb), h2 = tr_read<v_rd_off(D0, 2, 1)>(vb), l3 = tr_read<v_rd_off(D0, 3, 0)>(vb), h3 = tr_read<v_rd_off(D0, 3, 1)>(vb);
    asm volatile("s_waitcnt lgkmcnt(0)" ::: "memory"); SBAR();
#define PK(L, H) (bf16x8){L[0], L[1], L[2], L[3], H[0], H[1], H[2], H[3]}
    od = __builtin_amdgcn_mfma_f32_32x32x16_bf16(PK(l0, h0), pa0, od, 0, 0, 0);
    od = __builtin_amdgcn_mfma_f32_32x32x16_bf16(PK(l1, h1), pa1, od, 0, 0, 0);
    od = __builtin_amdgcn_mfma_f32_32x32x16_bf16(PK(l2, h2), pa2, od, 0, 0, 0);
    od = __builtin_amdgcn_mfma_f32_32x32x16_bf16(PK(l3, h3), pa3, od, 0, 0, 0);
#undef PK
}
template <int KSI, int DB, int ND> __device__ __forceinline__ void v_read(int vb, s16x4 (&l)[4], s16x4 (&h)[4]) {
    l[0] = tr_read<v_rd_off(DB, KSI, 0)>(vb); h[0] = tr_read<v_rd_off(DB, KSI, 1)>(vb);
    l[1] = tr_read<v_rd_off(DB + 1, KSI, 0)>(vb); h[1] = tr_read<v_rd_off(DB + 1, KSI, 1)>(vb);
    if constexpr (ND == 4) { l[2] = tr_read<v_rd_off(DB + 2, KSI, 0)>(vb); h[2] = tr_read<v_rd_off(DB + 2, KSI, 1)>(vb);
                             l[3] = tr_read<v_rd_off(DB + 3, KSI, 0)>(vb); h[3] = tr_read<v_rd_off(DB + 3, KSI, 1)>(vb); }
}
template <int ND> __device__ __forceinline__ void pv_mf(f32x16 (&o)[4], bf16x8 pa, const s16x4 (&l)[4], const s16x4 (&h)[4]) {
    __builtin_amdgcn_s_setprio(1);
#pragma unroll
    for (int d = 0; d < ND; ++d) o[d] = __builtin_amdgcn_mfma_f32_32x32x16_bf16((bf16x8){l[d][0], l[d][1], l[d][2], l[d][3], h[d][0], h[d][1], h[d][2], h[d][3]}, pa, o[d], 0, 0, 0);
    __builtin_amdgcn_s_setprio(0);
}
template <int DB, int ND> __device__ __forceinline__ void pv_ks(f32x16 (&o)[4], int vb, bf16x8 pa0, bf16x8 pa1, bf16x8 pa2, bf16x8 pa3) {
    s16x4 la[4], ha[4];
    v_read<0, DB, ND>(vb, la, ha); asm volatile("s_waitcnt lgkmcnt(0)" ::: "memory"); SBAR(); pv_mf<ND>(o, pa0, la, ha); SBAR();
    v_read<1, DB, ND>(vb, la, ha); asm volatile("s_waitcnt lgkmcnt(0)" ::: "memory"); SBAR(); pv_mf<ND>(o, pa1, la, ha); SBAR();
    v_read<2, DB, ND>(vb, la, ha); asm volatile("s_waitcnt lgkmcnt(0)" ::: "memory"); SBAR(); pv_mf<ND>(o, pa2, la, ha); SBAR();
    v_read<3, DB, ND>(vb, la, ha); asm volatile("s_waitcnt lgkmcnt(0)" ::: "memory"); SBAR(); pv_mf<ND>(o, pa3, la, ha);
}
template <int DB, int ND> __device__ __forceinline__ void pv_rest(f32x16 (&o)[4], int vb, bf16x8 pa0, bf16x8 pa1, bf16x8 pa2, bf16x8 pa3, s16x4 (&la)[4], s16x4 (&ha)[4]) {
    s16x4 lb[4], hb[4];
    asm volatile("s_waitcnt lgkmcnt(0)" ::: "memory"); SBAR(); v_read<1, DB, ND>(vb, lb, hb); SBAR(); pv_mf<ND>(o, pa0, la, ha); SBAR();
    asm volatile("s_waitcnt lgkmcnt(0)" ::: "memory"); SBAR(); v_read<2, DB, ND>(vb, la, ha); SBAR(); pv_mf<ND>(o, pa1, lb, hb); SBAR();
    asm volatile("s_waitcnt lgkmcnt(0)" ::: "memory"); SBAR(); v_read<3, DB, ND>(vb, lb, hb); SBAR(); pv_mf<ND>(o, pa2, la, ha); SBAR();
    asm volatile("s_waitcnt lgkmcnt(0)" ::: "memory"); SBAR(); pv_mf<ND>(o, pa3, lb, hb);
}
__device__ __forceinline__ void partialSM(f32x16& p0, f32x16& p1, float& m_reg, float& alpha, float C, float thr) {
    float pmax = p0[0];
#pragma unroll
    for (int r = 1; r < 16; ++r) pmax = fmaxf(pmax, p0[r]);
#pragma unroll
    for (int r = 0; r < 16; ++r) pmax = fmaxf(pmax, p1[r]);
    { auto rr = __builtin_amdgcn_permlane32_swap(__float_as_uint(pmax), __float_as_uint(pmax), false, false);
      pmax = fmaxf(__uint_as_float(rr[0]), __uint_as_float(rr[1])); }
    float mn;
    if (__all(pmax - m_reg <= thr)) { mn = m_reg; alpha = 1.f; }
    else { mn = fmaxf(m_reg, pmax); alpha = __builtin_amdgcn_exp2f((m_reg - mn) * C); m_reg = mn; }
    const float mnC = -mn * C;
#pragma unroll
    for (int r = 0; r < 16; ++r) p0[r] = __builtin_amdgcn_exp2f(fmaf(p0[r], C, mnC));
#pragma unroll
    for (int r = 0; r < 16; ++r) p1[r] = __builtin_amdgcn_exp2f(fmaf(p1[r], C, mnC));
}
__device__ __forceinline__ void finishSM(f32x16& p0, f32x16& p1, float alpha, float& l_reg, bf16x8& pa0, bf16x8& pa1, bf16x8& pa2, bf16x8& pa3) {
    float ps = 0;
#pragma unroll
    for (int r = 0; r < 16; ++r) ps += p0[r];
#pragma unroll
    for (int r = 0; r < 16; ++r) ps += p1[r];
    { auto rr = __builtin_amdgcn_permlane32_swap(__float_as_uint(ps), __float_as_uint(ps), false, false);
      ps = __uint_as_float(rr[0]) + __uint_as_float(rr[1]); }
    l_reg = l_reg * alpha + ps;
#define PK4(P, BASE, OUT) do { unsigned a0 = cvtpk(P[BASE + 0], P[BASE + 1]), a1 = cvtpk(P[BASE + 2], P[BASE + 3]);   \
    unsigned b0 = cvtpk(P[BASE + 4], P[BASE + 5]), b1 = cvtpk(P[BASE + 6], P[BASE + 7]);                              \
    auto r0 = __builtin_amdgcn_permlane32_swap(a0, b0, false, false); auto r1 = __builtin_amdgcn_permlane32_swap(a1, b1, false, false); \
    u32x4 w = {r0[0], r1[0], r0[1], r1[1]}; OUT = *reinterpret_cast<bf16x8*>(&w); } while (0)
    PK4(p0, 0, pa0); PK4(p0, 8, pa1); PK4(p1, 0, pa2); PK4(p1, 8, pa3);
#undef PK4
}
constexpr int RING = 32768;
template <int QS, bool PVHALF>
__device__ __forceinline__ void attn_core(LAS unsigned char* lds, const bf16_t* Kb, long ldk, const bf16_t* Vb, long ldv, int NT, int nkeys,
                                          const bf16_t* qptr, int wNT, int kcoffB, int pvsel, float C, float thr, f32x16 (&o)[4], float& m_reg, float& l_reg) {
    int tid = threadIdx.x; asm volatile("" : "+v"(tid));
    const int lane = tid & 63, r32 = lane & 31, hi = lane >> 5, wid = __builtin_amdgcn_readfirstlane(tid >> 6);
    bf16x8 qr[QS];
#pragma unroll
    for (int d0 = 0; d0 < QS; ++d0) qr[d0] = *(const bf16x8*)(qptr + d0 * 16);
#pragma unroll
    for (int d = 0; d < 4; ++d) o[d] = f32x16{};
    m_reg = -1e30f; l_reg = 0.f;
    long offK[2], offV[2];
#pragma unroll
    for (int i = 0; i < 2; ++i) { const int p = i * 8192 + wid * 1024 + lane * 16;
        const int row = p >> 8, colB = (p & 255) ^ ((row & 7) << 4); offK[i] = (long)row * ldk + (colB >> 1);
        const int sub = p >> 9, q = (p & 511) >> 1, kk = (sub >> 2) * 8 + (q >> 5), k = (kk & ~0xC) | ((kk & 4) << 1) | ((kk & 8) >> 1), c = (sub & 3) * 32 + (q & 31);
        offV[i] = (long)k * ldv + c; }
    const int vrb = v_rd_base(lane);
#define GLDS(t, bf) do { const bf16_t* kt_ = Kb + (long)(t) * 64 * ldk; const bf16_t* vt_ = Vb + (long)(t) * 64 * ldv; LAS unsigned char* b_ = lds + (bf) * RING + wid * 1024; \
    __builtin_amdgcn_global_load_lds((const unsigned*)(vt_ + offV[0]), (LAS unsigned*)(b_), 16, 0, 0); \
    __builtin_amdgcn_global_load_lds((const unsigned*)(vt_ + offV[1]), (LAS unsigned*)(b_ + 8192), 16, 0, 0); \
    __builtin_amdgcn_global_load_lds((const unsigned*)(kt_ + offK[0]), (LAS unsigned*)(b_ + 16384), 16, 0, 0); \
    __builtin_amdgcn_global_load_lds((const unsigned*)(kt_ + offK[1]), (LAS unsigned*)(b_ + 16384 + 8192), 16, 0, 0); } while (0)
    GLDS(0, 0);
#pragma unroll
    for (int d0 = 0; d0 < QS; ++d0) asm volatile("" :: "v"(qr[d0]));
    if (1 < NT) GLDS(1, 1); if (2 < NT) GLDS(2, 2);
    for (int j = 0; j < NT; ++j) {
        const int rem = NT - 1 - j;
        if (rem >= 2) asm volatile("s_waitcnt vmcnt(8)" ::: "memory"); else if (rem == 1) asm volatile("s_waitcnt vmcnt(4)" ::: "memory"); else asm volatile("s_waitcnt vmcnt(0)" ::: "memory");
        __builtin_amdgcn_s_barrier();
        asm volatile("" ::: "memory");
        if (j + 3 < NT) GLDS(j + 3, (j + 3) & 3);
        if (j < wNT) {
            const int cur = j & 3;
            f32x16 p0 = f32x16{}, p1 = f32x16{};
            const int kbase = (int)(uintptr_t)(lds + cur * RING + 16384) + r32 * 256;
            const int swz = (r32 & 7) << 4;
#pragma unroll
            for (int hq = 0; hq < QS / 4; ++hq) { bf16x8 b0[4], b1[4];
#pragma unroll
                for (int i = 0; i < 4; ++i) { const int cb = kcoffB + ((hq * 4 + i) * 16 + hi * 8) * 2; const int ad = kbase + (cb ^ swz);
                    b0[i] = lds_read128<0>(ad); b1[i] = lds_read128<8192>(ad); }
                asm volatile("s_waitcnt lgkmcnt(0)" ::: "memory"); SBAR();
#pragma unroll
                for (int i = 0; i < 4; ++i) { p0 = __builtin_amdgcn_mfma_f32_32x32x16_bf16(b0[i], qr[hq * 4 + i], p0, 0, 0, 0);
                    p1 = __builtin_amdgcn_mfma_f32_32x32x16_bf16(b1[i], qr[hq * 4 + i], p1, 0, 0, 0); } }
            if (__builtin_expect((j + 1) * 64 > nkeys, 0)) { const int kb = j * 64 + 4 * hi; asm volatile("" ::: "memory");
#pragma unroll
                for (int r = 0; r < 16; ++r) { const int kv = kb + (r & 3) + 8 * (r >> 2); if (kv >= nkeys) p0[r] = -1e30f; if (kv + 32 >= nkeys) p1[r] = -1e30f; } }
            float alpha; bf16x8 pa0, pa1, pa2, pa3;
            const int vb = (int)(uintptr_t)(lds + cur * RING) + vrb;
            s16x4 la[4], ha[4];
            partialSM(p0, p1, m_reg, alpha, C, thr);
            finishSM(p0, p1, alpha, l_reg, pa0, pa1, pa2, pa3);
            SBAR();
            if constexpr (QS == 4) { if constexpr (!PVHALF) v_read<0, 0, 4>(vb, la, ha); else { if (pvsel == 0) v_read<0, 0, 2>(vb, la, ha); else v_read<0, 2, 2>(vb, la, ha); } }
            SBAR();
            if (__any(alpha < 1.f)) {
#pragma unroll
                for (int d = 0; d < (PVHALF ? 2 : 4); ++d)
#pragma unroll
                    for (int r = 0; r < 16; ++r) o[d][r] *= alpha; }
            if constexpr (QS == 8) { pv_one<0>(o[0], vb, pa0, pa1, pa2, pa3); pv_one<1>(o[1], vb, pa0, pa1, pa2, pa3); pv_one<2>(o[2], vb, pa0, pa1, pa2, pa3); pv_one<3>(o[3], vb, pa0, pa1, pa2, pa3); }
            else if constexpr (!PVHALF) pv_rest<0, 4>(o, vb, pa0, pa1, pa2, pa3, la, ha);
            else { if (pvsel == 0) pv_rest<0, 2>(o, vb, pa0, pa1, pa2, pa3, la, ha); else pv_rest<2, 2>(o, vb, pa0, pa1, pa2, pa3, la, ha); }
        }
    }
#undef GLDS
    __syncthreads();
}

template <bool PVHALF>
__device__ __forceinline__ void attn_core_pipe(LAS unsigned char* lds, const bf16_t* Kb, long ldk, const bf16_t* Vb, long ldv, int NT, int nkeys,
                                               const bf16_t* qptr, int wNT, int kcoffB, int pvsel, float C, float thr, f32x16 (&o)[4], float& m_reg, float& l_reg) {
    int tid = threadIdx.x; asm volatile("" : "+v"(tid));
    const int lane = tid & 63, r32 = lane & 31, hi = lane >> 5, wid = __builtin_amdgcn_readfirstlane(tid >> 6);
    bf16x8 qr[4];
#pragma unroll
    for (int d0 = 0; d0 < 4; ++d0) qr[d0] = *(const bf16x8*)(qptr + d0 * 16);
#pragma unroll
    for (int d = 0; d < 4; ++d) o[d] = f32x16{};
    m_reg = -1e30f; l_reg = 0.f;
    int offK[2], offV[2];
#pragma unroll
    for (int i = 0; i < 2; ++i) { const int p = i * 8192 + wid * 1024 + lane * 16;
        const int row = p >> 8, colB = (p & 255) ^ ((row & 7) << 4); offK[i] = row * (int)ldk + (colB >> 1);
        const int sub = p >> 9, q = (p & 511) >> 1, kk = (sub >> 2) * 8 + (q >> 5), k = (kk & ~0xC) | ((kk & 4) << 1) | ((kk & 8) >> 1), c = (sub & 3) * 32 + (q & 31);
        offV[i] = k * (int)ldv + c; }
    const int vrb = v_rd_base(lane);
    int kad[4];
#pragma unroll
    for (int i = 0; i < 4; ++i) kad[i] = 16384 + r32 * 256 + ((kcoffB + (i * 16 + hi * 8) * 2) ^ ((r32 & 7) << 4));
    const int lds0 = (int)(uintptr_t)lds;
#define GLDS_V(t, bf) do { const bf16_t* vt_ = Vb + (long)(t) * 64 * ldv; LAS unsigned char* b_ = lds + (bf) * RING + wid * 1024; \
    __builtin_amdgcn_global_load_lds((const unsigned*)(vt_ + offV[0]), (LAS unsigned*)(b_), 16, 0, 0); \
    __builtin_amdgcn_global_load_lds((const unsigned*)(vt_ + offV[1]), (LAS unsigned*)(b_ + 8192), 16, 0, 0); } while (0)
#define GLDS_K(t, bf) do { const bf16_t* kt_ = Kb + (long)(t) * 64 * ldk; LAS unsigned char* b_ = lds + (bf) * RING + wid * 1024; \
    __builtin_amdgcn_global_load_lds((const unsigned*)(kt_ + offK[0]), (LAS unsigned*)(b_ + 16384), 16, 0, 0); \
    __builtin_amdgcn_global_load_lds((const unsigned*)(kt_ + offK[1]), (LAS unsigned*)(b_ + 16384 + 8192), 16, 0, 0); } while (0)
#define GLDS(t, bf) do { GLDS_V(t, bf); GLDS_K(t, bf); } while (0)
#define QK(P0, P1, bf) do { const int kb_ = lds0 + (bf) * RING; bf16x8 b0_[2], b1_[2]; \
    _Pragma("unroll") for (int i_ = 0; i_ < 2; ++i_) { b0_[i_] = lds_read128<0>(kb_ + kad[i_]); b1_[i_] = lds_read128<8192>(kb_ + kad[i_]); } \
    asm volatile("s_waitcnt lgkmcnt(0)" ::: "memory"); SBAR(); \
    P0 = __builtin_amdgcn_mfma_f32_32x32x16_bf16(b0_[0], qr[0], f32x16{}, 0, 0, 0); P1 = __builtin_amdgcn_mfma_f32_32x32x16_bf16(b1_[0], qr[0], f32x16{}, 0, 0, 0); \
    P0 = __builtin_amdgcn_mfma_f32_32x32x16_bf16(b0_[1], qr[1], P0, 0, 0, 0); P1 = __builtin_amdgcn_mfma_f32_32x32x16_bf16(b1_[1], qr[1], P1, 0, 0, 0); SBAR(); \
    _Pragma("unroll") for (int i_ = 0; i_ < 2; ++i_) { b0_[i_] = lds_read128<0>(kb_ + kad[2 + i_]); b1_[i_] = lds_read128<8192>(kb_ + kad[2 + i_]); } \
    asm volatile("s_waitcnt lgkmcnt(0)" ::: "memory"); SBAR(); \
    P0 = __builtin_amdgcn_mfma_f32_32x32x16_bf16(b0_[0], qr[2], P0, 0, 0, 0); P1 = __builtin_amdgcn_mfma_f32_32x32x16_bf16(b1_[0], qr[2], P1, 0, 0, 0); \
    P0 = __builtin_amdgcn_mfma_f32_32x32x16_bf16(b0_[1], qr[3], P0, 0, 0, 0); P1 = __builtin_amdgcn_mfma_f32_32x32x16_bf16(b1_[1], qr[3], P1, 0, 0, 0); \
    SBAR(); } while (0)
#define STEP(C0, C1, N0, N1, j) do { \
    if ((j) + 1 < NT) { \
        if ((j) + 2 < NT) asm volatile("s_waitcnt vmcnt(4)" ::: "memory"); else asm volatile("s_waitcnt vmcnt(0)" ::: "memory"); \
        __builtin_amdgcn_s_barrier(); asm volatile("" ::: "memory"); \
        if ((j) + 1 < wNT) QK(N0, N1, ((j) + 1) & 3); } \
    const bool iss_ = (j) + 3 < NT;                                 \
    if ((j) < wNT) { \
        if (__builtin_expect(((j) + 1) * 64 > nkeys, 0)) { const int kb = (j) * 64 + 4 * hi; asm volatile("" ::: "memory"); \
            _Pragma("unroll") for (int r = 0; r < 16; ++r) { const int kv = kb + (r & 3) + 8 * (r >> 2); if (kv >= nkeys) C0[r] = -1e30f; if (kv + 32 >= nkeys) C1[r] = -1e30f; } } \
        float alpha; bf16x8 pa0, pa1, pa2, pa3; const int vb = lds0 + ((j) & 3) * RING + vrb; \
        partialSM(C0, C1, m_reg, alpha, C, thr); \
        SBAR(); if (iss_) GLDS_V((j) + 3, ((j) + 3) & 3); SBAR(); \
        finishSM(C0, C1, alpha, l_reg, pa0, pa1, pa2, pa3); \
        SBAR(); if (iss_) GLDS_K((j) + 3, ((j) + 3) & 3); SBAR(); \
        if (__any(alpha < 1.f)) { \
            _Pragma("unroll") for (int d = 0; d < (PVHALF ? 2 : 4); ++d) _Pragma("unroll") for (int r = 0; r < 16; ++r) o[d][r] *= alpha; } \
        if constexpr (!PVHALF) pv_ks<0, 4>(o, vb, pa0, pa1, pa2, pa3); \
        else { if (pvsel == 0) pv_ks<0, 2>(o, vb, pa0, pa1, pa2, pa3); else pv_ks<2, 2>(o, vb, pa0, pa1, pa2, pa3); } } \
    else if (iss_) GLDS((j) + 3, ((j) + 3) & 3); \
    } while (0)
    GLDS(0, 0);
#pragma unroll
    for (int d0 = 0; d0 < 4; ++d0) asm volatile("" :: "v"(qr[d0]));
    if (1 < NT) GLDS(1, 1); if (2 < NT) GLDS(2, 2);
    if (NT > 2) asm volatile("s_waitcnt vmcnt(8)" ::: "memory"); else if (NT == 2) asm volatile("s_waitcnt vmcnt(4)" ::: "memory"); else asm volatile("s_waitcnt vmcnt(0)" ::: "memory");
    __builtin_amdgcn_s_barrier(); asm volatile("" ::: "memory");
    f32x16 pA0 = f32x16{}, pA1 = f32x16{}, pB0 = f32x16{}, pB1 = f32x16{};
    if (0 < wNT) QK(pA0, pA1, 0);
    for (int j = 0; j < NT; j += 2) {
        STEP(pA0, pA1, pB0, pB1, j);
        if (j + 1 < NT) STEP(pB0, pB1, pA0, pA1, j + 1);
    }
#undef STEP
#undef QK
#undef GLDS
#undef GLDS_V
#undef GLDS_K
    __syncthreads();
}

struct Ctx { LAS unsigned char* lds; int lane, wid, r32, hi; };

template <int ND> __device__ __forceinline__ void store_gated(const f32x16 (&o)[4], float scale, const bf16_t* gate, bf16_t* out, int hi) {
#pragma unroll
    for (int d = 0; d < ND; ++d)
#pragma unroll
        for (int g = 0; g < 4; ++g) { const int dv = 32 * d + 8 * g + 4 * hi;
            const u32x2 gt = *(const u32x2*)(gate + dv);
            f32x4 v; v.x = o[d][4 * g] * scale * silu(bflo(gt.x)); v.y = o[d][4 * g + 1] * scale * silu(bfhi(gt.x));
            v.z = o[d][4 * g + 2] * scale * silu(bflo(gt.y)); v.w = o[d][4 * g + 3] * scale * silu(bfhi(gt.y));
            st_bf4(out + dv, v); }
}

__device__ __forceinline__ void diff_unit(const Ctx& cx, bool samp, int b, int h, int qb, const bf16_t* PA, const bf16_t* KS, const bf16_t* VS, bf16_t* MIX, const float* gnorm, float lam) {
    const int c = cx.wid >> 2, rb = cx.wid & 3;
    long row; bool valid; int NT, wNT, nkeys; const bf16_t* Kb; const bf16_t* Vb; long ldk;
    if (!samp) { row = (long)b * 4096 + qb * 128 + rb * 32 + cx.r32; valid = true; NT = 2 * qb + 2; wNT = 2 * qb + 1 + (rb >> 1); nkeys = NT * 64;
                 Kb = PA + (size_t)b * 4096 * NA + 512 + h * 128; Vb = Kb + 512; ldk = NA; }
    else { row = NP + b * 16 + (cx.r32 < 15 ? cx.r32 : 15); valid = (rb == 0) && cx.r32 < 16; NT = 65; wNT = (rb == 0) ? 65 : 0; nkeys = 4112;
           Kb = KS + (size_t)b * KSROWS * 512 + h * 128; Vb = VS + (size_t)b * KSROWS * 512 + h * 128; ldk = 512; }
    const bf16_t* qptr = PA + (size_t)row * NA + h * 128 + c * 64 + cx.hi * 8;
    f32x16 o[4]; float m, l;
    attn_core_pipe<false>(cx.lds, Kb, ldk, Vb, ldk, NT, nkeys, qptr, wNT, c * 128, 0, C64, THR64, o, m, l);
    const float inv = l > 0.f ? 1.f / l : 0.f;
    LAS float* xch = (LAS float*)cx.lds + rb * 4096;
    if (c == 1) {
#pragma unroll
        for (int d = 0; d < 4; ++d)
#pragma unroll
            for (int r = 0; r < 16; ++r) xch[(d * 16 + r) * 64 + cx.lane] = o[d][r] * inv; }
    __syncthreads();
    if (c == 0) {
        float ss = 0.f;
#pragma unroll
        for (int d = 0; d < 4; ++d)
#pragma unroll
            for (int r = 0; r < 16; ++r) { const float od = o[d][r] * inv - lam * xch[(d * 16 + r) * 64 + cx.lane]; o[d][r] = od; ss += od * od; }
        ss += __shfl_xor(ss, 32);
        const float rms = rsqrtf(ss * (1.f / 128.f) + 1e-5f) * 0.8f;
        if (valid) {
            const bf16_t* gate = PA + (size_t)row * NA + 1536 + h * 128; bf16_t* out = MIX + (size_t)row * DM + h * 128;
#pragma unroll
            for (int d = 0; d < 4; ++d)
#pragma unroll
                for (int g = 0; g < 4; ++g) { const int dv = 32 * d + 8 * g + 4 * cx.hi;
                    const f32x4 gn = *(const f32x4*)(gnorm + dv); const u32x2 gt = *(const u32x2*)(gate + dv);
                    f32x4 v; v.x = o[d][4 * g] * rms * gn.x * silu(bflo(gt.x)); v.y = o[d][4 * g + 1] * rms * gn.y * silu(bfhi(gt.x));
                    v.z = o[d][4 * g + 2] * rms * gn.z * silu(bflo(gt.y)); v.w = o[d][4 * g + 3] * rms * gn.w * silu(bfhi(gt.y));
                    st_bf4(out + dv, v); }
        }
    }
    __syncthreads();
}
__device__ __forceinline__ void diff_sample_item(const Ctx& cx, int b, int h, int sp, const float* CK, const float* CV, const bf16_t* PA, const bf16_t* KS, const bf16_t* VS,
                                                 bf16_t* MIX, const float* gnorm, float lam, float* PART, unsigned* cnt, volatile LAS unsigned* MISC) {
    int tid = threadIdx.x; asm volatile("" : "+v"(tid));
    const int lane = tid & 63, r32 = lane & 31, hi = lane >> 5, wid = __builtin_amdgcn_readfirstlane(tid >> 6);
    const int c = wid >> 2; const bool active = (wid & 3) == 0;
    const size_t row = NP + b * 16 + (r32 < 15 ? r32 : 15);
    bf16x8 qr[4];
    { const bf16_t* qptr = PA + row * NA + h * 128 + c * 64 + hi * 8;
#pragma unroll
      for (int d0 = 0; d0 < 4; ++d0) qr[d0] = *(const bf16x8*)(qptr + d0 * 16); }
    f32x16 o[4];
#pragma unroll
    for (int d = 0; d < 4; ++d) o[d] = f32x16{};
    float m_reg = -1e30f, l_reg = 0.f;
    const int ntl = 16 + (sp == 3 ? 1 : 0);
    const int sr = tid >> 4, sc = (tid & 15) * 8;
    const float* kg = CK + ((size_t)(b * 4096 + sp * 1024 + sr) * 4 + h) * 128 + sc;
    const float* vg = CV + ((size_t)(b * 4096 + sp * 1024 + sr) * 4 + h) * 128 + sc;
    const bf16_t* kn = KS + ((size_t)b * KSROWS + 4096 + sr) * 512 + h * 128 + sc;
    const bf16_t* vn = VS + ((size_t)b * KSROWS + 4096 + sr) * 512 + h * 128 + sc;
    const int vst0 = v_st(sr, sc), vst1 = v_st(32 + sr, sc), kst0 = 16384 + KSWZ(sr, sc * 2), kst1 = 16384 + KSWZ(32 + sr, sc * 2);
    int kad[4];
#pragma unroll
    for (int i = 0; i < 4; ++i) kad[i] = 16384 + r32 * 256 + ((c * 128 + (i * 16 + hi * 8) * 2) ^ ((r32 & 7) << 4));
    const int lds0 = (int)(uintptr_t)cx.lds, vrb = v_rd_base(lane);
    f32x4 kfA[4], vfA[4], kfB[4], vfB[4];
#define LOADT(t, kf, vf) do { if ((t) < 16) { const float* kp_ = kg + (size_t)(t) * 64 * 512; const float* vp_ = vg + (size_t)(t) * 64 * 512; \
        kf[0] = *(const f32x4*)kp_; kf[1] = *(const f32x4*)(kp_ + 4); kf[2] = *(const f32x4*)(kp_ + 32 * 512); kf[3] = *(const f32x4*)(kp_ + 32 * 512 + 4); \
        vf[0] = *(const f32x4*)vp_; vf[1] = *(const f32x4*)(vp_ + 4); vf[2] = *(const f32x4*)(vp_ + 32 * 512); vf[3] = *(const f32x4*)(vp_ + 32 * 512 + 4); } \
    else { kf[0] = *(const f32x4*)kn; kf[2] = *(const f32x4*)(kn + 32 * 512); vf[0] = *(const f32x4*)vn; vf[2] = *(const f32x4*)(vn + 32 * 512); } } while (0)
#define CV8(A, B) ((u32x4){cvtpk(A.x, A.y), cvtpk(A.z, A.w), cvtpk(B.x, B.y), cvtpk(B.z, B.w)})
#define WRITET(t, bf, kf, vf) do { u32x4 k0_, k1_, v0_, v1_; \
    if ((t) < 16) { k0_ = CV8(kf[0], kf[1]); k1_ = CV8(kf[2], kf[3]); v0_ = CV8(vf[0], vf[1]); v1_ = CV8(vf[2], vf[3]); } \
    else { k0_ = __builtin_bit_cast(u32x4, kf[0]); k1_ = __builtin_bit_cast(u32x4, kf[2]); v0_ = __builtin_bit_cast(u32x4, vf[0]); v1_ = __builtin_bit_cast(u32x4, vf[2]); } \
    LAS unsigned char* b_ = cx.lds + (bf) * RING; \
    *(LAS u32x4*)(b_ + vst0) = v0_; *(LAS u32x4*)(b_ + vst1) = v1_; *(LAS u32x4*)(b_ + kst0) = k0_; *(LAS u32x4*)(b_ + kst1) = k1_; } while (0)
#define SCORE(t, cur) do { if (active) { \
            f32x16 p0, p1; \
            { const int kb_ = lds0 + (cur) * RING; bf16x8 b0_[2], b1_[2]; \
              _Pragma("unroll") for (int i = 0; i < 2; ++i) { b0_[i] = lds_read128<0>(kb_ + kad[i]); b1_[i] = lds_read128<8192>(kb_ + kad[i]); } \
              asm volatile("s_waitcnt lgkmcnt(0)" ::: "memory"); SBAR(); \
              p0 = __builtin_amdgcn_mfma_f32_32x32x16_bf16(b0_[0], qr[0], f32x16{}, 0, 0, 0); p1 = __builtin_amdgcn_mfma_f32_32x32x16_bf16(b1_[0], qr[0], f32x16{}, 0, 0, 0); \
              p0 = __builtin_amdgcn_mfma_f32_32x32x16_bf16(b0_[1], qr[1], p0, 0, 0, 0); p1 = __builtin_amdgcn_mfma_f32_32x32x16_bf16(b1_[1], qr[1], p1, 0, 0, 0); SBAR(); \
              _Pragma("unroll") for (int i = 0; i < 2; ++i) { b0_[i] = lds_read128<0>(kb_ + kad[2 + i]); b1_[i] = lds_read128<8192>(kb_ + kad[2 + i]); } \
              asm volatile("s_waitcnt lgkmcnt(0)" ::: "memory"); SBAR(); \
              p0 = __builtin_amdgcn_mfma_f32_32x32x16_bf16(b0_[0], qr[2], p0, 0, 0, 0); p1 = __builtin_amdgcn_mfma_f32_32x32x16_bf16(b1_[0], qr[2], p1, 0, 0, 0); \
              p0 = __builtin_amdgcn_mfma_f32_32x32x16_bf16(b0_[1], qr[3], p0, 0, 0, 0); p1 = __builtin_amdgcn_mfma_f32_32x32x16_bf16(b1_[1], qr[3], p1, 0, 0, 0); } \
            if ((t) >= 16) { \
                _Pragma("unroll") for (int r = 0; r < 16; ++r) { const int kv = 4 * hi + (r & 3) + 8 * (r >> 2); if (kv >= 16) p0[r] = -1e30f; p1[r] = -1e30f; } } \
            float alpha; bf16x8 pa0, pa1, pa2, pa3; \
            partialSM(p0, p1, m_reg, alpha, C64, THR64); \
            finishSM(p0, p1, alpha, l_reg, pa0, pa1, pa2, pa3); \
            SBAR(); \
            if (__any(alpha < 1.f)) { \
                _Pragma("unroll") for (int d = 0; d < 4; ++d) _Pragma("unroll") for (int r = 0; r < 16; ++r) o[d][r] *= alpha; } \
            pv_ks<0, 4>(o, lds0 + (cur) * RING + vrb, pa0, pa1, pa2, pa3); } } while (0)
    LOADT(0, kfA, vfA); LOADT(1, kfB, vfB); WRITET(0, 0, kfA, vfA); __syncthreads();
    for (int t = 0; t < ntl; t += 2) {
        if (t + 2 < ntl) LOADT(t + 2, kfA, vfA);
        SCORE(t, 0);
        if (t + 1 < ntl) WRITET(t + 1, 1, kfB, vfB);
        __syncthreads();
        if (t + 1 < ntl) {
            if (t + 3 < ntl) LOADT(t + 3, kfB, vfB);
            SCORE(t + 1, 1);
            if (t + 2 < ntl) WRITET(t + 2, 0, kfA, vfA);
            __syncthreads();
        }
    }
#undef SCORE
#undef LOADT
#undef WRITET
#undef CV8
    const int bh = b * 4 + h;
    if (active) { float* pb = PART + ((size_t)(bh * 4 + sp) * 2 + c) * (66 * 64) + lane;
#pragma unroll
        for (int d = 0; d < 4; ++d)
#pragma unroll
            for (int r = 0; r < 16; ++r) pb[(d * 16 + r) * 64] = o[d][r];
        pb[64 * 64] = m_reg; pb[65 * 64] = l_reg; }
    asm volatile("s_waitcnt vmcnt(0)" ::: "memory"); __syncthreads();
    if (tid == 0) { __builtin_amdgcn_fence(__ATOMIC_RELEASE, "agent"); asm volatile("s_waitcnt vmcnt(0)" ::: "memory");
                    const unsigned old = __hip_atomic_fetch_add(cnt + bh, 1u, __ATOMIC_RELAXED, __HIP_MEMORY_SCOPE_AGENT);
                    if (old == 3u) { __builtin_amdgcn_fence(__ATOMIC_ACQUIRE, "agent"); asm volatile("s_waitcnt vmcnt(0)" ::: "memory"); }
                    MISC[1] = old; }
    __syncthreads();
    const bool last = MISC[1] == 3u;
    if (last && wid == 0) {
        const float* pp = PART + (size_t)(bh * 4) * 2 * (66 * 64) + lane;
        float e0[4], e1[4], L0 = 0.f, L1 = 0.f;
        { float m0[4], m1[4], M0 = -1e30f, M1 = -1e30f;
#pragma unroll
          for (int q = 0; q < 4; ++q) { m0[q] = pp[(size_t)(q * 2) * (66 * 64) + 64 * 64]; m1[q] = pp[(size_t)(q * 2 + 1) * (66 * 64) + 64 * 64]; M0 = fmaxf(M0, m0[q]); M1 = fmaxf(M1, m1[q]); }
#pragma unroll
          for (int q = 0; q < 4; ++q) { e0[q] = __builtin_amdgcn_exp2f((m0[q] - M0) * C64); e1[q] = __builtin_amdgcn_exp2f((m1[q] - M1) * C64);
              L0 += e0[q] * pp[(size_t)(q * 2) * (66 * 64) + 65 * 64]; L1 += e1[q] * pp[(size_t)(q * 2 + 1) * (66 * 64) + 65 * 64]; } }
        const float i0 = 1.f / L0, i1 = lam / L1;
#pragma unroll
        for (int q = 0; q < 4; ++q) { e0[q] *= i0; e1[q] *= i1; }
        float ss = 0.f;
#pragma unroll
        for (int d = 0; d < 4; ++d)
#pragma unroll
            for (int r = 0; r < 16; ++r) { float od = 0.f;
#pragma unroll
                for (int q = 0; q < 4; ++q) od += e0[q] * pp[(size_t)(q * 2) * (66 * 64) + (d * 16 + r) * 64] - e1[q] * pp[(size_t)(q * 2 + 1) * (66 * 64) + (d * 16 + r) * 64];
                o[d][r] = od; ss += od * od; }
        ss += __shfl_xor(ss, 32);
        const float rms = rsqrtf(ss * (1.f / 128.f) + 1e-5f) * 0.8f;
        if (r32 < 16) {
            const bf16_t* gate = PA + row * NA + 1536 + h * 128; bf16_t* out = MIX + row * DM + h * 128;
#pragma unroll
            for (int d = 0; d < 4; ++d)
#pragma unroll
                for (int g = 0; g < 4; ++g) { const int dv = 32 * d + 8 * g + 4 * hi;
                    const f32x4 gn = *(const f32x4*)(gnorm + dv); const u32x2 gt = *(const u32x2*)(gate + dv);
                    f32x4 v; v.x = o[d][4 * g] * rms * gn.x * silu(bflo(gt.x)); v.y = o[d][4 * g + 1] * rms * gn.y * silu(bfhi(gt.x));
                    v.z = o[d][4 * g + 2] * rms * gn.z * silu(bflo(gt.y)); v.w = o[d][4 * g + 3] * rms * gn.w * silu(bfhi(gt.y));
                    st_bf4(out + dv, v); }
        }
    }
    __syncthreads();
}
__device__ __forceinline__ void mem_unit(const Ctx& cx, bool samp, int b, int h, int qb, const bf16_t* P, int ldp, int qcol, int gcol,
                                         const bf16_t* Kb, const bf16_t* Vb, long ldk, bf16_t* MIX) {
    long row; bool valid; int wNT;
    if (!samp) { row = (long)b * 4096 + qb * 256 + cx.wid * 32 + cx.r32; valid = true; wNT = 4; }
    else { row = NP + b * 16 + (cx.r32 < 15 ? cx.r32 : 15); valid = (cx.wid == 0) && cx.r32 < 16; wNT = (cx.wid == 0) ? 4 : 0; }
    const bf16_t* qptr = P + (size_t)row * ldp + qcol + h * 128 + cx.hi * 8;
    f32x16 o[4]; float m, l;
    attn_core<8, false>(cx.lds, Kb, ldk, Vb, ldk, 4, 256, qptr, wNT, 0, 0, C128, THR128, o, m, l);
    const float inv = l > 0.f ? 1.f / l : 0.f;
    if (valid) store_gated<4>(o, inv, P + (size_t)row * ldp + gcol + h * 128, MIX + (size_t)row * DM + 512 + h * 128, cx.hi);
}
__device__ __forceinline__ void swa_unit(const Ctx& cx, bool samp, int b, int c, int half, const bf16_t* PB, const bf16_t* KSW, const bf16_t* VSW, bf16_t* MIX, const float* sinks) {
    const int head = cx.wid, kv = cx.wid >> 2;
    long row; bool valid; int NT, nkeys; const bf16_t* Kb; const bf16_t* Vb; long ldk;
    if (!samp) { row = (long)b * 4096 + c * 64 + half * 32 + cx.r32; valid = true; const int c0 = c > 2 ? c - 2 : 0; NT = c - c0 + 1; nkeys = NT * 64;
                 Kb = PB + ((size_t)b * 4096 + c0 * 64) * NB + 2048; Vb = Kb + 128; ldk = NB; }
    else { row = NP + b * 16 + (cx.r32 < 15 ? cx.r32 : 15); valid = cx.r32 < 16; NT = 3; nkeys = 144;
           Kb = KSW + (size_t)b * SWROWS * 128; Vb = VSW + (size_t)b * SWROWS * 128; ldk = 128; }
    const bf16_t* qptr = PB + (size_t)row * NB + head * 64 + cx.hi * 8;
    f32x16 o[4]; float m, l;
    attn_core_pipe<true>(cx.lds, Kb, ldk, Vb, ldk, NT, nkeys, qptr, NT, kv * 128, kv, C64, THR64, o, m, l);
    const float lt = l + __builtin_amdgcn_exp2f(sinks[head] * LOG2E - m * C64);
    const float inv = 1.f / lt;
    if (valid) store_gated<2>(o, inv, PB + (size_t)row * NB + 512 + head * 64, MIX + (size_t)row * DM + head * 64, cx.hi);
}
#undef KSWZ
#undef SBAR
}

__device__ __forceinline__ float wave_sum(float v) {
#pragma unroll
    for (int o = 1; o < 64; o <<= 1) v += __shfl_xor(v, o);
    return v;
}
__device__ __forceinline__ void p0_transpose_item(const float* W, int K, int N, bf16_t* WT, int row_off, LAS float* scr, int item, int lane) {
    const int nblk = N / 32, kb = item / nblk, nb = item % nblk, k0 = 64 * kb, n0 = 32 * nb;
#pragma unroll 8
    for (int i = 0; i < 32; ++i) { const int kk = 2 * i + (lane >> 5); scr[kk * 33 + (lane & 31)] = W[(size_t)(k0 + kk) * N + n0 + (lane & 31)]; }
    asm volatile("s_waitcnt lgkmcnt(0)" ::: "memory");
    const int c = lane & 7;
#pragma unroll
    for (int j = 0; j < 4; ++j) { const int n = (lane >> 3) + 8 * j; const LAS float* s = scr + (8 * c) * 33 + n;
        u32x4 o; o.x = cvtpk(s[0 * 33], s[1 * 33]); o.y = cvtpk(s[2 * 33], s[3 * 33]); o.z = cvtpk(s[4 * 33], s[5 * 33]); o.w = cvtpk(s[6 * 33], s[7 * 33]);
        *(u32x4*)(WT + (size_t)(row_off + n0 + n) * K + k0 + 8 * c) = o; }
    asm volatile("s_waitcnt lgkmcnt(0)" ::: "memory");
}
__device__ __forceinline__ void p0_transpose_item_ln(const float* W, int K, int N, bf16_t* WT, int row_off, LAS float* scr, int item, int lane, const float* g, const float* b, float* CS, float* BW) {
    const int nblk = N / 32, kb = item / nblk, nb = item % nblk, k0 = 64 * kb, n0 = 32 * nb;
    float csp = 0.f, bwp = 0.f;
#pragma unroll 8
    for (int i = 0; i < 32; ++i) { const int kk = 2 * i + (lane >> 5); const float w = W[(size_t)(k0 + kk) * N + n0 + (lane & 31)]; const float gw = g[k0 + kk] * w;
        scr[kk * 33 + (lane & 31)] = gw; csp += bflo(cvtpk(gw, 0.f)); bwp += b[k0 + kk] * w; }
    csp += __shfl_xor(csp, 32); bwp += __shfl_xor(bwp, 32);
    if (lane < 32) { atomicAdd(CS + row_off + n0 + lane, csp); atomicAdd(BW + row_off + n0 + lane, bwp); }
    asm volatile("s_waitcnt lgkmcnt(0)" ::: "memory");
    const int c = lane & 7;
#pragma unroll
    for (int j = 0; j < 4; ++j) { const int n = (lane >> 3) + 8 * j; const LAS float* sp = scr + (8 * c) * 33 + n;
        u32x4 o; o.x = cvtpk(sp[0 * 33], sp[1 * 33]); o.y = cvtpk(sp[2 * 33], sp[3 * 33]); o.z = cvtpk(sp[4 * 33], sp[5 * 33]); o.w = cvtpk(sp[6 * 33], sp[7 * 33]);
        *(u32x4*)(WT + (size_t)(row_off + n0 + n) * K + k0 + 8 * c) = o; }
    asm volatile("s_waitcnt lgkmcnt(0)" ::: "memory");
}
__device__ __forceinline__ void ln_rows(const float* zin, float* fout, bf16_t* bout, const float* g, const float* bta, int gw, int NGW, int lane) {
    f32x4 g4[4], b4[4];
#pragma unroll
    for (int j = 0; j < 4; ++j) { g4[j] = *(const f32x4*)(g + 4 * lane + 256 * j); b4[j] = *(const f32x4*)(bta + 4 * lane + 256 * j); }
    for (int m = gw; m < MA; m += NGW) {
        const float* zr = zin + (size_t)m * DM + 4 * lane;
        f32x4 v[4]; float s = 0.f;
#pragma unroll
        for (int j = 0; j < 4; ++j) { v[j] = *(const f32x4*)(zr + 256 * j); s += (v[j].x + v[j].y) + (v[j].z + v[j].w); }
        const float mean = wave_sum(s) * (1.f / DM); float s2 = 0.f;
#pragma unroll
        for (int j = 0; j < 4; ++j) { v[j] = v[j] - mean; s2 += (v[j].x * v[j].x + v[j].y * v[j].y) + (v[j].z * v[j].z + v[j].w * v[j].w); }
        const float rstd = rsqrtf(wave_sum(s2) * (1.f / DM) + 1e-5f);
#pragma unroll
        for (int j = 0; j < 4; ++j) { const f32x4 y = v[j] * rstd * g4[j] + b4[j];
            *(f32x4*)(fout + (size_t)m * DM + 4 * lane + 256 * j) = y;
            if (bout) st_bf4(bout + (size_t)m * DM + 4 * lane + 256 * j, y); }
    }
}

#define XB_TMO      128
#define XB_XCNT(j)  (256  + 64 * (j))
#define XB_XSUB(j)  (1280 + 64 * (j))
#define XB_XGEN(j)  (2304 + 64 * (j))
#define XB_TOP      3328
#define XB_TOPGEN   3392
#define XCD_BAR_WORDS 3456
#define XB_SPIN_CAP (1u << 18)

__device__ __forceinline__ unsigned xb_ld(unsigned* p)              { return __hip_atomic_load(p, __ATOMIC_RELAXED, __HIP_MEMORY_SCOPE_AGENT); }
__device__ __forceinline__ unsigned xb_add(unsigned* p, unsigned v) { return __hip_atomic_fetch_add(p, v, __ATOMIC_RELAXED, __HIP_MEMORY_SCOPE_AGENT); }
__device__ __forceinline__ unsigned xb_xcc_id() { return (unsigned)__builtin_amdgcn_s_getreg((3 << 11) | 20) & 0xFu; }
#define XB_SPIN(cond, bar) do { unsigned _sp = 0; while (cond) { __builtin_amdgcn_s_sleep(1); \
    if ((++_sp & 255u) == 0u) { if (xb_ld(&(bar)[XB_TMO])) break; if (_sp > XB_SPIN_CAP) { atomicAdd(&(bar)[XB_TMO], 1u); break; } } } } while (0)

struct XcdBarrier {
    unsigned* bar; unsigned x;
    volatile LAS unsigned* st;
};

__device__ __forceinline__ XcdBarrier xcd_barrier_post(unsigned* bar, volatile LAS unsigned* st) {
    XcdBarrier b; b.bar = bar; b.x = xb_xcc_id(); b.st = st;
    if (threadIdx.x == 0) (void)xb_add(&bar[XB_XCNT(b.x)], 1u);
    return b;
}
__device__ __forceinline__ void xcd_barrier_complete(unsigned* bar, unsigned x, unsigned& nloc, unsigned& nx) {
    const unsigned G = gridDim.x * gridDim.y * gridDim.z;
    unsigned sum, cnt, mine, sp = 0u;
    for (;;) {
        sum = 0u; cnt = 0u; mine = 0u;
#pragma unroll
        for (unsigned j = 0; j < 16; ++j) { const unsigned c = xb_ld(&bar[XB_XCNT(j)]); sum += c; cnt += (c > 0u) ? 1u : 0u; mine = (j == x) ? c : mine; }
        if (sum == G) break;
        __builtin_amdgcn_s_sleep(1);
        if ((++sp & 255u) == 0u) { if (xb_ld(&bar[XB_TMO])) break; if (sp > XB_SPIN_CAP) { atomicAdd(&bar[XB_TMO], 1u); break; } }
    }
    nloc = mine > 0u ? mine : 1u; nx = cnt > 0u ? cnt : 1u;
}

__device__ __forceinline__ void xcd_barrier(const XcdBarrier& b) {
    asm volatile("s_waitcnt vmcnt(0)" ::: "memory");
    __syncthreads();
    if (threadIdx.x == 0) {
        unsigned* bar = b.bar;
        __builtin_amdgcn_s_waitcnt(0);
        unsigned nloc = b.st[0], nx = b.st[1];
        if (nloc == 0u) { xcd_barrier_complete(bar, b.x, nloc, nx); b.st[0] = nloc; b.st[1] = nx; }
        const unsigned old = xb_add(&bar[XB_XSUB(b.x)], 1u);
        const unsigned gen = old / nloc;
        if (old + 1u == (gen + 1u) * nloc) {
            __builtin_amdgcn_fence(__ATOMIC_RELEASE, "agent");
            asm volatile("s_waitcnt vmcnt(0)" ::: "memory");
            const unsigned og = xb_add(&bar[XB_TOP], 1u);
            const unsigned tg = og / nx;
            if (og + 1u == (tg + 1u) * nx) xb_add(&bar[XB_TOPGEN], 1u);
            else XB_SPIN(xb_ld(&bar[XB_TOPGEN]) == tg, bar);
            __builtin_amdgcn_fence(__ATOMIC_ACQUIRE, "agent");
            xb_add(&bar[XB_XGEN(b.x)], 1u);
            asm volatile("s_waitcnt vmcnt(0)" ::: "memory");
        } else {
            XB_SPIN(xb_ld(&bar[XB_XGEN(b.x)]) == gen, bar);
            __builtin_amdgcn_fence(__ATOMIC_ACQUIRE, "agent");
            asm volatile("s_waitcnt vmcnt(0)" ::: "memory");
        }
    }
    __syncthreads();
}

struct Args { const float* in[22]; float* out; unsigned char* ws; int ph_lo, ph_hi, rep, pad; };
constexpr int NWAVES = 8, NPHASE = 9;

__global__ void __launch_bounds__(NWAVES * 64, 2) yoco_fwd(Args a) {
    extern __shared__ __attribute__((aligned(16))) unsigned char lds_raw[];
    LAS unsigned char* lds = (LAS unsigned char*)lds_raw;
    volatile LAS unsigned* MISC = (volatile LAS unsigned*)(lds + LDS_RING);
    cg::grid_group grid = cg::this_grid();
    const int tid = threadIdx.x, lane = tid & 63, wave = __builtin_amdgcn_readfirstlane(tid >> 6);
    const int G = gridDim.x, gw = blockIdx.x * NWAVES + wave, NGW = G * NWAVES;
    const long gtid = (long)blockIdx.x * (NWAVES * 64) + tid, NTHR = (long)G * (NWAVES * 64);
    unsigned char* ws = a.ws; float* dout = a.out;
    unsigned* ctl = (unsigned*)(ws + WS_CTL);
    float* ROPE = (float*)(ws + WS_ROPE);
    float* CSV = (float*)(ws + 32768); float* BWV = (float*)(ws + 49152); float* ST0 = (float*)(ws + 262144); float* ST1 = (float*)(ws + 524288);
    bf16_t* WA_t = (bf16_t*)(ws + WS_WA); bf16_t* WB_t = (bf16_t*)(ws + WS_WB); bf16_t* WM_t = (bf16_t*)(ws + WS_WM); bf16_t* WO_t = (bf16_t*)(ws + WS_WO);
    bf16_t* MEMB = (bf16_t*)(ws + WS_MEMB); bf16_t* MKV = (bf16_t*)(ws + WS_MKV); bf16_t* CMK = (bf16_t*)(ws + WS_CMK); bf16_t* CMV = (bf16_t*)(ws + WS_CMV);
    bf16_t* KSW = (bf16_t*)(ws + WS_KSW); bf16_t* VSW = (bf16_t*)(ws + WS_VSW); bf16_t* XA = (bf16_t*)(ws + WS_XA); bf16_t* ZB = XA;
    bf16_t* MIX = (bf16_t*)(ws + WS_MIX); bf16_t* Z1B = (bf16_t*)(ws + WS_Z0); bf16_t* PA = (bf16_t*)(ws + WS_PA); bf16_t* PB = PA;
    bf16_t* KS = (bf16_t*)(ws + WS_KS); bf16_t* VS = (bf16_t*)(ws + WS_VS);
    const int lo = a.ph_lo, hi_ph = a.ph_hi;
#define IN(k) (lo <= (k) && (k) < hi_ph)
    if (tid < 64) MISC[tid] = 0u;
    __syncthreads();
    XcdBarrier xbar = xcd_barrier_post(ctl + 1024, MISC + 8);
    if (a.ph_lo > 1000) grid.sync();
#define SEAM(k) do { if (IN(k) && IN((k) + 1)) xcd_barrier(xbar); } while (0)
    att::Ctx cx; cx.lds = lds; cx.lane = lane; cx.wid = wave; cx.r32 = lane & 31; cx.hi = lane >> 5;

    if (IN(0)) {
        LAS float* scr = (LAS float*)(lds + wave * 16384);
        for (int it = gw; it < 4736; it += NGW) {
            int r = it;
            if (r < 1536) { p0_transpose_item(a.in[9], DM, NA, WA_t, 0, scr, r, lane); continue; } r -= 1536;
            if (r < 1024) { p0_transpose_item_ln(a.in[15], DM, 2048, WB_t, 0, scr, r, lane, a.in[20], a.in[21], CSV, BWV); continue; } r -= 1024;
            if (r < 128) { p0_transpose_item_ln(a.in[17], DM, 256, WB_t, 2048, scr, r, lane, a.in[20], a.in[21], CSV, BWV); continue; } r -= 128;
            if (r < 1024) { const int l = r >> 9; p0_transpose_item(a.in[18] + (size_t)l * DM * DM, DM, DM, WM_t, l * 1024, scr, r & 511, lane); continue; } r -= 1024;
            { const int l = r >> 9; p0_transpose_item(a.in[19] + (size_t)l * DM * DM, DM, DM, WO_t, l * 1024, scr, r & 511, lane); }
        }
        for (long i = gtid; i < 2097152; i += NTHR) cvt8(a.in[0] + i * 8, XA + i * 8);
        for (long i = gtid; i < 32768; i += NTHR) cvt8(a.in[1] + i * 8, XA + (size_t)NP * DM + i * 8);
        for (long i = gtid; i < 131072; i += NTHR) cvt8(a.in[2] + i * 8, MEMB + i * 8);
        for (long i = gtid; i < 524288; i += NTHR) { cvt8(a.in[7] + i * 8, CMK + i * 8); cvt8(a.in[8] + i * 8, CMV + i * 8); }
        for (long i = gtid; i < 32768; i += NTHR) { const long b = i >> 11, r = i & 2047; const size_t d = (size_t)b * SWROWS * 128 + r * 8;
            cvt8(a.in[5] + i * 8, KSW + d); cvt8(a.in[6] + i * 8, VSW + d);
            const int rw = (int)(r >> 4);
            if (rw >= 16) { const size_t od = ((size_t)b * 128 + rw - 16) * 128 + (r & 15) * 8;
                *(f32x4*)(dout + OFF_SKS + od) = *(const f32x4*)(a.in[5] + i * 8); *(f32x4*)(dout + OFF_SKS + od + 4) = *(const f32x4*)(a.in[5] + i * 8 + 4);
                *(f32x4*)(dout + OFF_SVS + od) = *(const f32x4*)(a.in[6] + i * 8); *(f32x4*)(dout + OFF_SVS + od + 4) = *(const f32x4*)(a.in[6] + i * 8 + 4); } }
        for (long i = gtid; i < 49152; i += NTHR) { const long b = i / 3072, r = i % 3072; const size_t d = ((size_t)b * KSROWS + 4112) * 512 + r * 8;
            *(u32x4*)(KS + d) = (u32x4){0u, 0u, 0u, 0u}; *(u32x4*)(VS + d) = (u32x4){0u, 0u, 0u, 0u}; }
        for (long i = gtid; i < 12288; i += NTHR) { const long b = i / 768, r = i % 768; const size_t d = ((size_t)b * SWROWS + 144) * 128 + r * 8;
            *(u32x4*)(KSW + d) = (u32x4){0u, 0u, 0u, 0u}; *(u32x4*)(VSW + d) = (u32x4){0u, 0u, 0u, 0u}; }
        for (long i = gtid; i < 4112 * 8; i += NTHR) { const int pos = (int)(i >> 3), fi = (int)(i & 7);
            const double inv = fi == 0 ? 1.0 : fi == 1 ? 0.19392274474868576 : fi == 2 ? 0.03760603093086393 : fi == 3 ? 0.007292664737217109 :
                               fi == 4 ? 0.001414213562373095 : fi == 5 ? 0.0002742481756762073 : fi == 6 ? 5.318295896944988e-05 : 1.031338537721246e-05;
            const double rev = (double)pos * inv * 0.15915494309189535; const float fr = (float)(rev - __builtin_rint(rev));
            ROPE[i * 2] = __builtin_amdgcn_cosf(fr); ROPE[i * 2 + 1] = __builtin_amdgcn_sinf(fr); }
    }
    SEAM(0);
    if (IN(1)) {
        pg8::Gemm g{XA, WA_t, NP, NA, DM}; pg8::StaticOrder S; S.init(NP, NA, G, (int)blockIdx.x);
        EpiWrap<EpiAF> E{{PA, dout, KS, VS, ROPE, 0.f, 0.f}, 0, 0};
        pg8::gemm_phase<EpiWrap<EpiAF>, pg8::StaticOrder, true, true>(lds, g, S, E);
    }
    SEAM(1);
    if (IN(2)) {
        float s1 = 0.f, s2 = 0.f;
        for (int i = 0; i < 64; ++i) { s1 += a.in[10][i] * a.in[11][i]; s2 += a.in[12][i] * a.in[13][i]; }
        if (tid == 0) MISC[2] = __float_as_uint(__expf(s1) - __expf(s2) + 0.2f);
        __syncthreads();
        unsigned* gdone = ctl + 256 + 64 * a.rep;
        if (blockIdx.x < 44) {
            if (blockIdx.x < 32) { pg8::Gemm g{MEMB, WM_t, 1024, 2048, DM}; pg8::StaticOrder S; S.init(1024, 2048, 32, (int)blockIdx.x);
                EpiWrap<EpiMemF> E{{MKV, dout, 0.f, 0.f}, 0, 0};
                pg8::gemm_phase<EpiWrap<EpiMemF>, pg8::StaticOrder, true, true>(lds, g, S, E); }
            else { pg8::Gemm g{XA + (size_t)NP * DM, WA_t, 256, NA, DM}; pg8::StaticOrder S; S.init(256, NA, 12, (int)blockIdx.x - 32);
                EpiWrap<EpiAF> E{{PA, dout, KS, VS, ROPE, 0.f, 0.f}, NP, 0};
                pg8::gemm_phase<EpiWrap<EpiAF>, pg8::StaticOrder, true, true>(lds, g, S, E); }
            asm volatile("s_waitcnt vmcnt(0)" ::: "memory"); __syncthreads();
            if (tid == 0) { __builtin_amdgcn_fence(__ATOMIC_RELEASE, "agent"); asm volatile("s_waitcnt vmcnt(0)" ::: "memory");
                            __hip_atomic_fetch_add(gdone, 1u, __ATOMIC_RELAXED, __HIP_MEMORY_SCOPE_AGENT); }
        }
        bool ready = false;
        float* PART = (float*)(ws + WS_Z0 + 40 * MiB + (size_t)a.rep * (10 * MiB));
        for (;;) {
            if (tid == 0) MISC[0] = atomicAdd(ctl + 128 * a.rep, 1u);
            __syncthreads(); const unsigned u = MISC[0]; __syncthreads();
            if (u >= 1088u) break;
            const bool needs = (u >= 256u && u < 512u) || u >= 768u;
            if (needs && !ready) {
                if (tid == 0) { unsigned sp = 0; while (__hip_atomic_load(gdone, __ATOMIC_RELAXED, __HIP_MEMORY_SCOPE_AGENT) < 44u && ++sp < (1u << 24)) __builtin_amdgcn_s_sleep(8);
                                __builtin_amdgcn_fence(__ATOMIC_ACQUIRE, "agent"); asm volatile("s_waitcnt vmcnt(0)" ::: "memory"); }
                __syncthreads(); ready = true;
            }
            if (u < 768u) {
                const float lam = __uint_as_float(MISC[2]);
                if (u >= 256u && u < 512u) { const unsigned v = u - 256u;
                    att::diff_sample_item(cx, (int)(v >> 4), (int)((v >> 2) & 3u), (int)(v & 3u), a.in[3], a.in[4], PA, KS, VS, MIX, a.in[14], lam, PART, ctl + 512 + 64 * a.rep, MISC); }
                else { const unsigned v = u < 256u ? u : u - 256u;
                    att::diff_unit(cx, false, (int)((v & 15u) >> 2), (int)(v & 3u), 31 - (int)(v >> 4), PA, KS, VS, MIX, a.in[14], lam); } }
            else { const bool samp = u >= 1024u; const unsigned v = samp ? u - 1024u : u - 768u;
                const int b = samp ? (int)(v >> 2) : (int)(v >> 6), h = samp ? (int)(v & 3u) : (int)((v >> 4) & 3u), qb = samp ? 0 : (int)(v & 15u);
                const bf16_t* Kb = samp ? CMK + ((size_t)b * 256) * 512 + h * 128 : MKV + ((size_t)b * 256) * 2048 + h * 128;
                const bf16_t* Vb = samp ? CMV + ((size_t)b * 256) * 512 + h * 128 : Kb + 512;
                att::mem_unit(cx, samp, b, h, qb, PA, NA, 2048, 2560, Kb, Vb, samp ? 512 : 2048, MIX); }
        }
    }
    SEAM(2);
    if (IN(3)) {
        EpiMerge0F F0{ZB, ST0, 0.f, 0.f};
        { pg8::Gemm g{MIX, WO_t, NP, DM, DM}; pg8::StaticOrder S; S.init(NP, DM, G, (int)blockIdx.x);
          EpiWrap<EpiMerge0F> E{F0, 0, 0};
          pg8::gemm_phase<EpiWrap<EpiMerge0F>, pg8::StaticOrder, true, true>(lds, g, S, E); }
        gemm_small<EpiMerge0F>(lds, MIX + (size_t)NP * DM, WO_t, DM, NP, (int)blockIdx.x, G, F0);
    }
    SEAM(3);
    if (IN(5)) {
        EpiBF FB{PB, dout, KSW, VSW, ROPE, ST0, CSV, BWV, 0.f, 0.f, {0.f, 0.f}, {0.f, 0.f}};
        { pg8::Gemm g{ZB, WB_t, NP, 2048, DM}; pg8::StaticOrder S; S.init(NP, 2048, G, (int)blockIdx.x);
          EpiWrap<EpiBF> E{FB, 0, 0};
          pg8::gemm_phase<EpiWrap<EpiBF>, pg8::StaticOrder, true, true>(lds, g, S, E); }
    }
    SEAM(5);
    if (IN(6)) {
        unsigned* gdone = ctl + 384 + 64 * a.rep;
        {
            EpiBF FB{PB, dout, KSW, VSW, ROPE, ST0, CSV, BWV, 0.f, 0.f, {0.f, 0.f}, {0.f, 0.f}};
            if (blockIdx.x < 64) { pg8::Gemm g{ZB, WB_t + (size_t)2048 * DM, NP, 256, DM}; pg8::StaticOrder S; S.init(NP, 256, 64, (int)blockIdx.x);
                EpiWrap<EpiBF> E{FB, 0, 2048};
                pg8::gemm_phase<EpiWrap<EpiBF>, pg8::StaticOrder, true, true>(lds, g, S, E); }
            else { gemm_small<EpiBF>(lds, ZB + (size_t)NP * DM, WB_t, 2048, NP, (int)blockIdx.x - 64, 192, FB);
                   if (blockIdx.x >= 192) gemm_small<EpiBF>(lds, ZB + (size_t)NP * DM, WB_t + (size_t)2048 * DM, 256, NP, (int)blockIdx.x - 192, 64, FB, 2048); }
            asm volatile("s_waitcnt vmcnt(0)" ::: "memory"); __syncthreads();
            if (tid == 0) { __builtin_amdgcn_fence(__ATOMIC_RELEASE, "agent"); asm volatile("s_waitcnt vmcnt(0)" ::: "memory");
                            __hip_atomic_fetch_add(gdone + (blockIdx.x < 64 ? 0 : 16), 1u, __ATOMIC_RELAXED, __HIP_MEMORY_SCOPE_AGENT); }
        }
        bool ready1 = false, ready2 = false;
        for (;;) {
            if (tid == 0) MISC[0] = atomicAdd(ctl + 64 + 128 * a.rep, 1u);
            __syncthreads(); const unsigned u = MISC[0]; __syncthreads();
            if (u >= 848u) break;
            const bool need1 = u >= 256u && u < 768u, need2 = u >= 768u;
            if ((need1 && !ready1) || (need2 && !ready2)) {
                if (tid == 0) { unsigned sp = 0; unsigned* w = need1 ? gdone : gdone + 16; const unsigned want = need1 ? 64u : 192u;
                                while (__hip_atomic_load(w, __ATOMIC_RELAXED, __HIP_MEMORY_SCOPE_AGENT) < want && ++sp < (1u << 24)) __builtin_amdgcn_s_sleep(8);
                                __builtin_amdgcn_fence(__ATOMIC_ACQUIRE, "agent"); asm volatile("s_waitcnt vmcnt(0)" ::: "memory"); }
                __syncthreads(); if (need1) ready1 = true; else ready2 = true;
            }
            const bool is_mem = u < 256u || (u >= 768u && u < 832u);
            if (is_mem) { const bool samp = u >= 768u; const unsigned v = samp ? u - 768u : u;
                const int b = samp ? (int)(v >> 2) : (int)(v >> 6), h = samp ? (int)(v & 3u) : (int)((v >> 4) & 3u), qb = samp ? 0 : (int)(v & 15u);
                const bf16_t* Kb = samp ? CMK + ((size_t)(16 + b) * 256) * 512 + h * 128 : MKV + ((size_t)b * 256) * 2048 + 1024 + h * 128;
                const bf16_t* Vb = samp ? CMV + ((size_t)(16 + b) * 256) * 512 + h * 128 : Kb + 512;
                att::mem_unit(cx, samp, b, h, qb, PB, NB, 1024, 1536, Kb, Vb, samp ? 512 : 2048, MIX); }
            else { const bool samp = u >= 832u; const unsigned v = samp ? u - 832u : u - 256u;
                const int b = samp ? (int)v : (int)(v >> 7), c = samp ? 0 : (int)((v >> 1) & 63u), half = samp ? 0 : (int)(v & 1u);
                att::swa_unit(cx, samp, b, c, half, PB, KSW, VSW, MIX, a.in[16]); }
        }
    }
    SEAM(6);
    if (IN(7)) {
        EpiMerge1F F1{ZB, ST0, a.in[20], a.in[21], Z1B, ST1, 0.f, 0.f, {0.f, 0.f}, {0.f, 0.f}};
        { pg8::Gemm g{MIX, WO_t + (size_t)DM * DM, NP, DM, DM}; pg8::StaticOrder S; S.init(NP, DM, G, (int)blockIdx.x);
          EpiWrap<EpiMerge1F> E{F1, 0, 0};
          pg8::gemm_phase<EpiWrap<EpiMerge1F>, pg8::StaticOrder, true, true>(lds, g, S, E); }
        gemm_small<EpiMerge1F>(lds, MIX + (size_t)NP * DM, WO_t + (size_t)DM * DM, DM, NP, (int)blockIdx.x, G, F1);
    }
    SEAM(7);
    if (IN(8)) {
        const float* g1 = a.in[20] + DM; const float* b1 = a.in[21] + DM;
#pragma unroll 4
        for (long i = gtid; i < (long)MA * 256; i += NTHR) { const int row = (int)(i >> 8), c4 = (int)(i & 255) * 4;
            float mu, rstd; row_stats(ST1, row, mu, rstd);
            const u32x2 zz = *(const u32x2*)(Z1B + (size_t)row * DM + c4);
            const f32x4 z = (f32x4){bflo(zz.x), bfhi(zz.x), bflo(zz.y), bfhi(zz.y)};
            *(f32x4*)(dout + (size_t)row * DM + c4) = (z - mu) * rstd * *(const f32x4*)(g1 + c4) + *(const f32x4*)(b1 + c4); }
    }
#undef IN
#undef SEAM
}

#ifndef MK_N_LAUNCHES
#define MK_N_LAUNCHES 1
#endif
#ifndef PROBE_DUP
#define PROBE_DUP 0
#endif
extern "C" void kernel_launch(void* const* d_in, const int* in_sizes, int n_in, void* d_out, int out_size, void* d_ws, size_t ws_size, hipStream_t stream) {
    static int grid = 0;
    if (grid == 0) {
        if (n_in != 22 || ws_size < WS_END) { fprintf(stderr, "kernel_launch: unexpected n_in %d / ws %zu\n", n_in, ws_size); grid = -1; return; }
        int dev = 0, cus = 0, per_cu = 0;
        if (hipGetDevice(&dev) != hipSuccess || hipDeviceGetAttribute(&cus, hipDeviceAttributeMultiprocessorCount, dev) != hipSuccess) { grid = -1; return; }
        if (hipFuncSetAttribute((const void*)yoco_fwd, hipFuncAttributeMaxDynamicSharedMemorySize, LDS_BYTES) != hipSuccess) { fprintf(stderr, "kernel_launch: hipFuncSetAttribute failed\n"); grid = -1; return; }
        if (hipOccupancyMaxActiveBlocksPerMultiprocessor(&per_cu, (const void*)yoco_fwd, NWAVES * 64, LDS_BYTES) != hipSuccess || per_cu < 1) { fprintf(stderr, "kernel_launch: occupancy query says %d\n", per_cu); per_cu = 1; }
        (void)hipGetLastError();
        grid = cus;
    }
    if (grid < 0) return;
    (void)hipMemsetAsync((char*)d_ws + WS_CTL, 0, 1048576, stream);
    Args a{};
    for (int i = 0; i < 22; ++i) a.in[i] = (const float*)d_in[i];
    a.out = (float*)d_out; a.ws = (unsigned char*)d_ws;
#if MK_N_LAUNCHES == 1
    a.ph_lo = 0; a.ph_hi = NPHASE;
    void* args[] = {&a};
    hipError_t e = hipLaunchCooperativeKernel((const void*)yoco_fwd, dim3(grid), dim3(NWAVES * 64), args, LDS_BYTES, stream);
    if (e != hipSuccess) fprintf(stderr, "kernel_launch: cooperative launch failed: %s (grid %d)\n", hipGetErrorString(e), grid);
#else
    for (int p = 0; p < NPHASE; ++p) { a.ph_lo = p; a.ph_hi = p + 1;
        for (int r = 0; r < 1 + ((PROBE_DUP >> p) & 1); ++r) { a.rep = r; hipLaunchKernelGGL(yoco_fwd, dim3(grid), dim3(NWAVES * 64), LDS_BYTES, stream, a); } }
#endif
}
```

```cpp
#include <hip/hip_runtime.h>
#include <hip/hip_cooperative_groups.h>
#include <cstdio>
#include <cstdint>
namespace cg = cooperative_groups;
namespace pg8 {
#define PG8_LAS __attribute__((address_space(3)))
typedef unsigned short bf16_t;
typedef short bf16x8 __attribute__((ext_vector_type(8)));
typedef float f32x4 __attribute__((ext_vector_type(4)));
typedef unsigned u32x4 __attribute__((ext_vector_type(4)));
constexpr int BM = 256, BK = 64, HALF = 128, HTB = HALF * BK * 2  , STAGE_BYTES = 8 * HTB, NXCD = 8, WGM = 8;

__host__ __device__ __forceinline__ int lds_byte(int r, int c) { const int st = (r >> 4) * 2 + (c >> 5), rr = r & 15, cc = c & 31, ob = rr * 64 + cc * 2; return st * 1024 + (ob ^ (((ob >> 9) & 1) << 5)); }
__host__ __device__ __forceinline__ void stage_rc(int b, int& R, int& C) { const int st = b / 1024, sb = b % 1024, swz = sb ^ (((sb >> 9) & 1) << 5); R = (st >> 1) * 16 + swz / 64; C = (st & 1) * 32 + (swz % 64) / 2; }
__host__ __device__ __forceinline__ int perm32(int rho) { const int n = rho >> 4, i = rho & 15; return 8 * (i >> 2) + 4 * n + (i & 3); }

struct Unit { int pm, pn; };
struct Gemm { const bf16_t* A; const bf16_t* Bt; int M, N, K; };

struct StaticOrder {
    int nM, nN, nwg, G, c;
    __host__ __device__ void init(int M, int N, int G_, int c_) { nM = M / BM; nN = N / BM; nwg = nM * nN; G = G_; c = c_; }
    __host__ __device__ bool next(int i, Unit& u) const {
        const long L = (long)i * G + c; if (L >= nwg) return false;
        int wgid = (int)L; { const int q = nwg / NXCD, r = nwg % NXCD, xcd = wgid % NXCD, off = wgid / NXCD; wgid = (xcd < r ? xcd * (q + 1) : r * (q + 1) + (xcd - r) * q) + off; }
        const int nig = WGM * nN, gid = wgid / nig, fm = gid * WGM, gsz = (nM - fm) < WGM ? (nM - fm) : WGM;
        u.pm = fm + ((wgid % nig) % gsz); u.pn = (wgid % nig) / gsz; return true;
    }
    __device__ __forceinline__ void a_ready(const Unit&) const {}
    __device__ __forceinline__ void done(const Unit&) const {}
};
__device__ __forceinline__ unsigned cvt_pk_bf16(float lo, float hi) { unsigned r; asm volatile("v_cvt_pk_bf16_f32 %0, %1, %2" : "=v"(r) : "v"(lo), "v"(hi)); return r; }
typedef float f32x2 __attribute__((ext_vector_type(2)));
template <class Epi, class Sched, bool ALIGN_EPI = false, bool SP2 = false>
__device__ __forceinline__ void gemm_phase(PG8_LAS unsigned char* lds, const Gemm g, const Sched& S, const Epi& E) {
    const int tid = threadIdx.x, wid = __builtin_amdgcn_readfirstlane(tid >> 6), lane = tid & 63, wr = wid >> 2, wc = wid & 3, fr = lane & 15, fq = lane >> 4;
    const int K = g.K, nt = K / BK;
    unsigned voffA[2], voffB[2];
#pragma unroll
    for (int i = 0; i < 2; ++i) { int R, C; stage_rc(tid * 16 + i * 8192, R, C); const int Rb = Epi::PERM ? ((R & ~31) + perm32(R & 31)) : R;
        voffA[i] = (unsigned)(R * K + C) * 2u; voffB[i] = (unsigned)(Rb * K + C) * 2u; }
    const size_t kstep = (size_t)(BK * 2);
    const size_t hstep = (size_t)HALF * K * 2;
    const size_t tstep = 2 * hstep;
    const unsigned ldsw = (unsigned)wid * 1024u;
    const int aoff = lds_byte(wr * 64 + fr, fq * 8), boff = lds_byte(wc * 32 + fr, fq * 8);
#define PG8_SA(b, h) (((b) * 2 + (h)) * HTB)
#define PG8_SB(b, h) ((4 + (b) * 2 + (h)) * HTB)
#define PG8_STAGE(bufoff, gbase, voff) do { _Pragma("unroll") for (int _i = 0; _i < 2; ++_i) \
        __builtin_amdgcn_global_load_lds((const unsigned*)((const char*)(gbase) + (voff)[_i]), (PG8_LAS unsigned*)(lds + (bufoff) + ldsw + _i * 8192), 16, 0, 0); } while (0)
#define PG8_LDA(dst, b, h) do { _Pragma("unroll") for (int m = 0; m < 4; ++m) _Pragma("unroll") for (int k = 0; k < 2; ++k) dst[m][k] = *(const PG8_LAS bf16x8*)(lds + PG8_SA(b, h) + aoff + m * 2048 + k * 1024); } while (0)
#define PG8_LDB(dst, b, h) do { _Pragma("unroll") for (int n = 0; n < 2; ++n) _Pragma("unroll") for (int k = 0; k < 2; ++k) dst[n][k] = *(const PG8_LAS bf16x8*)(lds + PG8_SB(b, h) + boff + n * 2048 + k * 1024); } while (0)
#define PG8_MMA(ai, bj, At, Bt) do { __builtin_amdgcn_s_setprio(1); _Pragma("unroll") for (int m = 0; m < 4; ++m) _Pragma("unroll") for (int n = 0; n < 2; ++n) _Pragma("unroll") for (int k = 0; k < 2; ++k) \
        acc[ai][bj][m][n] = __builtin_amdgcn_mfma_f32_16x16x32_bf16(Bt[n][k], At[m][k], acc[ai][bj][m][n], 0, 0, 0); __builtin_amdgcn_s_setprio(0); } while (0)
#define PG8_WAIT_V(n) asm volatile("s_waitcnt vmcnt(" #n ")" ::: "memory")
#define PG8_WAIT_L(n) asm volatile("s_waitcnt lgkmcnt(" #n ")" ::: "memory")
#define PG8_BAR __builtin_amdgcn_s_barrier()
#define PG8_SCHED __builtin_amdgcn_sched_barrier(0)
    Unit cur, nxt; int ui = 0;
    if (!S.next(0, cur)) return;
    f32x4 acc[2][2][4][2];
#pragma unroll
    for (int a = 0; a < 2; ++a)
#pragma unroll
        for (int b = 0; b < 2; ++b)
#pragma unroll
            for (int m = 0; m < 4; ++m)
#pragma unroll
                for (int n = 0; n < 2; ++n) acc[a][b][m][n] = (f32x4){0.f, 0.f, 0.f, 0.f};
    bf16x8 At[4][2], B0[2][2], B1[2][2];
    const char* cA = (const char*)g.A + (size_t)cur.pm * tstep; const char* cB = (const char*)g.Bt + (size_t)cur.pn * tstep;
    S.a_ready(cur);
    if constexpr (SP2) {
        PG8_STAGE(PG8_SB(0, 0), cB, voffB); PG8_STAGE(PG8_SB(0, 1), cB + hstep, voffB); PG8_STAGE(PG8_SA(0, 0), cA, voffA); PG8_STAGE(PG8_SA(0, 1), cA + hstep, voffA);
        if (wr == 1) PG8_BAR;
        PG8_WAIT_V(2); PG8_BAR;
        PG8_STAGE(PG8_SB(1, 0), cB + kstep, voffB); PG8_STAGE(PG8_SA(1, 0), cA + kstep, voffA); PG8_STAGE(PG8_SB(1, 1), cB + hstep + kstep, voffB);
        PG8_WAIT_V(6); PG8_BAR;
    } else {
        PG8_STAGE(PG8_SB(0, 0), cB, voffB); PG8_STAGE(PG8_SA(0, 0), cA, voffA); PG8_STAGE(PG8_SB(0, 1), cB + hstep, voffB); PG8_STAGE(PG8_SA(0, 1), cA + hstep, voffA);
        if (wr == 1) PG8_BAR;
        PG8_WAIT_V(4); PG8_BAR;
        PG8_STAGE(PG8_SB(1, 0), cB + kstep, voffB); PG8_STAGE(PG8_SA(1, 0), cA + kstep, voffA); PG8_STAGE(PG8_SB(1, 1), cB + hstep + kstep, voffB);
        PG8_WAIT_V(6); PG8_BAR;
    }
    for (;;) {
        const bool has_next = S.next(ui + 1, nxt);
        const char* nA = has_next ? (const char*)g.A + (size_t)nxt.pm * tstep : cA; const char* nB = has_next ? (const char*)g.Bt + (size_t)nxt.pn * tstep : cB;
        for (int t = 0; t < nt; t += 2) {
            const bool last = (t == nt - 2);
            const char* a1 = cA + (size_t)(t + 1) * kstep;
            const char* a2 = last ? nA : cA + (size_t)(t + 2) * kstep; const char* b2 = last ? nB : cB + (size_t)(t + 2) * kstep;
            const char* a3 = a2 + kstep; const char* b3 = b2 + kstep;
            if (last && has_next) S.a_ready(nxt);
            if constexpr (SP2) {
            PG8_LDB(B0, 0, 0); PG8_LDB(B1, 0, 1); PG8_SCHED; PG8_LDA(At, 0, 0); PG8_STAGE(PG8_SA(1, 1), a1 + hstep, voffA);
            PG8_WAIT_V(8); PG8_WAIT_L(0); PG8_BAR; PG8_MMA(0, 0, At, B0); PG8_MMA(0, 1, At, B1); PG8_BAR; PG8_SCHED;
            PG8_LDA(At, 0, 1); PG8_STAGE(PG8_SB(0, 0), b2, voffB); PG8_STAGE(PG8_SB(0, 1), b2 + hstep, voffB); PG8_STAGE(PG8_SA(0, 0), a2, voffA);
            PG8_WAIT_V(8); PG8_WAIT_L(0); PG8_BAR; PG8_MMA(1, 0, At, B0); PG8_MMA(1, 1, At, B1); PG8_BAR; PG8_SCHED;
            PG8_LDB(B0, 1, 0); PG8_LDB(B1, 1, 1); PG8_SCHED; PG8_LDA(At, 1, 0); PG8_STAGE(PG8_SA(0, 1), a2 + hstep, voffA);
            PG8_WAIT_V(8); PG8_WAIT_L(0); PG8_BAR; PG8_MMA(0, 0, At, B0); PG8_MMA(0, 1, At, B1); PG8_BAR; PG8_SCHED;
            PG8_LDA(At, 1, 1); PG8_STAGE(PG8_SB(1, 0), b3, voffB); PG8_STAGE(PG8_SB(1, 1), b3 + hstep, voffB); PG8_STAGE(PG8_SA(1, 0), a3, voffA);
            PG8_WAIT_V(8); PG8_WAIT_L(0); PG8_BAR; PG8_MMA(1, 0, At, B0); PG8_MMA(1, 1, At, B1); PG8_BAR; PG8_SCHED;
            } else {
            PG8_LDB(B0, 0, 0); PG8_SCHED; PG8_LDA(At, 0, 0); PG8_STAGE(PG8_SA(1, 1), a1 + hstep, voffA);
            PG8_WAIT_L(8); PG8_BAR; PG8_WAIT_L(0); PG8_MMA(0, 0, At, B0); PG8_BAR; PG8_SCHED;
            PG8_LDB(B1, 0, 1); PG8_STAGE(PG8_SB(0, 0), b2, voffB);
            PG8_BAR; PG8_WAIT_L(0); PG8_MMA(0, 1, At, B1); PG8_BAR;
            PG8_LDA(At, 0, 1); PG8_STAGE(PG8_SA(0, 0), a2, voffA);
            PG8_BAR; PG8_WAIT_L(0); PG8_MMA(1, 0, At, B0); PG8_BAR; PG8_SCHED;
            PG8_STAGE(PG8_SB(0, 1), b2 + hstep, voffB);
            PG8_WAIT_V(6); PG8_BAR; PG8_MMA(1, 1, At, B1); PG8_BAR;
            PG8_LDB(B0, 1, 0); PG8_SCHED; PG8_LDA(At, 1, 0); PG8_STAGE(PG8_SA(0, 1), a2 + hstep, voffA);
            PG8_WAIT_L(8); PG8_BAR; PG8_WAIT_L(0); PG8_MMA(0, 0, At, B0); PG8_BAR; PG8_SCHED;
            PG8_LDB(B1, 1, 1); PG8_STAGE(PG8_SB(1, 0), b3, voffB);
            PG8_BAR; PG8_WAIT_L(0); PG8_MMA(0, 1, At, B1); PG8_BAR;
            PG8_LDA(At, 1, 1); PG8_STAGE(PG8_SA(1, 0), a3, voffA);
            PG8_BAR; PG8_WAIT_L(0); PG8_MMA(1, 0, At, B0); PG8_BAR; PG8_SCHED;
            PG8_STAGE(PG8_SB(1, 1), b3 + hstep, voffB);
            PG8_WAIT_V(6); PG8_BAR; PG8_MMA(1, 1, At, B1); PG8_BAR;
            }
        }
        if constexpr (ALIGN_EPI) { if (wr == 0) PG8_BAR; }
        if constexpr (!Epi::AFTER_DRAIN) { E(acc, cur, wr, wc, fr, fq); S.done(cur); }
        if (!has_next) break;
#pragma unroll
        for (int a = 0; a < 2; ++a)
#pragma unroll
            for (int b = 0; b < 2; ++b)
#pragma unroll
                for (int m = 0; m < 4; ++m)
#pragma unroll
                    for (int n = 0; n < 2; ++n) acc[a][b][m][n] = (f32x4){0.f, 0.f, 0.f, 0.f};
        cur = nxt; cA = nA; cB = nB; ++ui;
        if constexpr (ALIGN_EPI) { if (wr == 1) PG8_BAR; }
    }
    PG8_WAIT_V(0);
    if constexpr (!ALIGN_EPI) { if (wr == 0) PG8_BAR; }
    PG8_BAR;
    if constexpr (Epi::AFTER_DRAIN) { E.fused(acc, cur, wr, wc, fr, fq, lds, wid, lane); S.done(cur); }
#undef PG8_SA
#undef PG8_SB
#undef PG8_STAGE
#undef PG8_LDA
#undef PG8_LDB
#undef PG8_MMA
#undef PG8_WAIT_V
#undef PG8_WAIT_L
#undef PG8_BAR
#undef PG8_SCHED
}
}

typedef unsigned short bf16_t;
typedef short bf16x8 __attribute__((ext_vector_type(8)));
typedef short s16x4 __attribute__((ext_vector_type(4)));
typedef float f32x4 __attribute__((ext_vector_type(4)));
typedef float f32x16 __attribute__((ext_vector_type(16)));
typedef unsigned u32x4 __attribute__((ext_vector_type(4)));
typedef unsigned u32x2 __attribute__((ext_vector_type(2)));
#define LAS __attribute__((address_space(3)))

constexpr int DM = 1024, NP = 16384, NS = 256, MA = NP + NS;
constexpr int NA = 3072, NB = 2304;
constexpr int KSROWS = 4160, SWROWS = 192;
constexpr float DN_ALPHA = 1.41421356237309515f;
constexpr float LOG2E = 1.4426950408889634f;
constexpr float C64 = 0.125f * LOG2E, THR64 = 64.f;
constexpr float C128 = 0.088388347648318440f * LOG2E, THR128 = 90.5f;
constexpr size_t OFF_DKP = 17039360, OFF_DVP = 25427968, OFF_DKS = 33816576, OFF_DVS = 33947648, OFF_SKP = 34078720, OFF_SVP = 34144256,
                 OFF_SKS = 34209792, OFF_SVS = 34471936, OFF_MKP = 34734080, OFF_MVP = 35782656;
constexpr size_t MiB = 1u << 20;
constexpr size_t WS_CTL = 0, WS_ROPE = 1 * MiB, WS_WA = 2 * MiB, WS_WB = 8 * MiB, WS_WM = 13 * MiB, WS_WO = 17 * MiB, WS_MEMB = 21 * MiB, WS_MKV = 23 * MiB,
                 WS_CMK = 27 * MiB, WS_CMV = 35 * MiB, WS_KSW = 43 * MiB, WS_VSW = 44 * MiB, WS_XA = 46 * MiB, WS_MIX = 79 * MiB, WS_Z0 = 112 * MiB,
                 WS_PA = 177 * MiB, WS_KS = 275 * MiB, WS_VS = 340 * MiB, WS_END = 405 * MiB;
constexpr int LDS_RING = 131072, LDS_BYTES = LDS_RING + 256;

__device__ __forceinline__ unsigned cvtpk(float lo, float hi) { unsigned r; asm volatile("v_cvt_pk_bf16_f32 %0, %1, %2" : "=v"(r) : "v"(lo), "v"(hi)); return r; }
__device__ __forceinline__ float bflo(unsigned w) { return __uint_as_float(w << 16); }
__device__ __forceinline__ float bfhi(unsigned w) { return __uint_as_float(w & 0xffff0000u); }
__device__ __forceinline__ float silu(float x) { return x * __builtin_amdgcn_rcpf(1.f + __expf(-x)); }
__device__ __forceinline__ void cvt8(const float* s, bf16_t* d) {
    const f32x4 a = __builtin_nontemporal_load((const f32x4*)s), b = __builtin_nontemporal_load((const f32x4*)(s + 4));
    u32x4 w; w.x = cvtpk(a.x, a.y); w.y = cvtpk(a.z, a.w); w.z = cvtpk(b.x, b.y); w.w = cvtpk(b.z, b.w); *(u32x4*)d = w;
}

__device__ __forceinline__ f32x4 shfl4(f32x4 v, int m) { f32x4 p; p.x = __shfl_xor(v.x, m); p.y = __shfl_xor(v.y, m); p.z = __shfl_xor(v.z, m); p.w = __shfl_xor(v.w, m); return p; }
struct NoPre {};
template <class F> struct EpiWrap {
    static constexpr bool PERM = false, AFTER_DRAIN = false;
    F f; int rowbase, colbase;
    __device__ __forceinline__ void operator()(const f32x4 (&acc)[2][2][4][2], const pg8::Unit& u, int wr, int wc, int fr, int fq) const {
        F lf = f;
#pragma unroll
        for (int ai = 0; ai < 2; ++ai)
#pragma unroll
            for (int mp = 0; mp < 2; ++mp) {
                typename F::Pre pr[2][2][2]; f32x4 vv[2][2][2];
                const int row0 = rowbase + u.pm * 256 + ai * 128 + wr * 64 + mp * 32 + fr, colb = colbase + u.pn * 256 + wc * 32 + 4 * fq;
#pragma unroll
                for (int mm = 0; mm < 2; ++mm) { lf.row_begin(mm, row0 + mm * 16);
#pragma unroll
                    for (int bj = 0; bj < 2; ++bj)
#pragma unroll
                        for (int n = 0; n < 2; ++n) pr[mm][bj][n] = lf.pre(row0 + mm * 16, colb + bj * 128 + n * 16); }
#pragma unroll
                for (int mm = 0; mm < 2; ++mm)
#pragma unroll
                    for (int bj = 0; bj < 2; ++bj)
#pragma unroll
                        for (int n = 0; n < 2; ++n) vv[mm][bj][n] = lf.fix(mm, colb + bj * 128 + n * 16, acc[ai][bj][mp * 2 + mm][n], pr[mm][bj][n]);
#pragma unroll
                for (int mm = 0; mm < 2; ++mm) { const int row = row0 + mm * 16; lf.s = 0.f; lf.q = 0.f;
#pragma unroll
                    for (int bj = 0; bj < 2; ++bj)
#pragma unroll
                        for (int n = 0; n < 2; ++n) { const int col = colb + bj * 128 + n * 16; f32x4 p = vv[mm][bj][n];
                            if constexpr (F::ROPE) { if (lf.need_rope(col)) p = shfl4(p, 32); }
                            lf.quad(row, col, vv[mm][bj][n], p); }
                    if constexpr (F::STATS) { float s = lf.s, q = lf.q; s += __shfl_xor(s, 16); s += __shfl_xor(s, 32); q += __shfl_xor(q, 16); q += __shfl_xor(q, 32);
                        if (fq == 0) lf.commit(row, s, q); } }
            }
    }
};
__device__ __forceinline__ f32x4 rope_apply(f32x4 v, f32x4 p, int col, int pos, const float* rope) {
    const float* t = rope + ((size_t)pos * 8 + (col & 4)) * 2;
    const f32x4 t0 = *(const f32x4*)t, t1 = *(const f32x4*)(t + 4);
    const float sg = (col & 8) ? 1.f : -1.f;
    f32x4 o; o.x = v.x * t0.x + sg * p.x * t0.y; o.y = v.y * t0.z + sg * p.y * t0.w; o.z = v.z * t1.x + sg * p.z * t1.y; o.w = v.w * t1.z + sg * p.w * t1.w;
    return o;
}
__device__ __forceinline__ void st_bf4(bf16_t* p, f32x4 v) { u32x2 w; w.x = cvtpk(v.x, v.y); w.y = cvtpk(v.z, v.w); *(u32x2*)p = w; }
__device__ __forceinline__ void row_stats(const float* ST, int row, float& mu, float& rstd) {
    const float s = ST[2 * (size_t)row], q = ST[2 * (size_t)row + 1]; mu = s * (1.f / DM); rstd = rsqrtf(fmaxf(q * (1.f / DM) - mu * mu, 0.f) + 1e-5f);
}

struct EpiAF {
    static constexpr bool ROPE = true, STATS = false; typedef NoPre Pre;
    bf16_t* PA; float* dout; bf16_t* KS; bf16_t* VS; const float* rope; float s, q;
    __device__ __forceinline__ void row_begin(int, int) {}
    __device__ __forceinline__ Pre pre(int, int) const { return Pre{}; }
    __device__ __forceinline__ f32x4 fix(int, int, f32x4 v, const Pre&) const { return v; }
    __device__ __forceinline__ bool need_rope(int col) const { return (col >> 9) < 2 && ((col >> 4) & 3) == 0; }
    __device__ __forceinline__ void commit(int, float, float) {}
    __device__ __forceinline__ void quad(int row, int col, f32x4 v, f32x4 p) {
        const bool samp = row >= NP; const int rs = row - NP;
        const int pos = samp ? 4096 + (rs & 15) : (row & 4095);
        const int region = col >> 9;
        if (need_rope(col)) v = rope_apply(v, p, col, pos, rope);
        st_bf4(PA + (size_t)row * NA + col, v);
        if (region == 1 || region == 2) {
            const int c = col & 511;
            if (!samp) __builtin_nontemporal_store(v, (f32x4*)(dout + (region == 1 ? OFF_DKP : OFF_DVP) + (size_t)row * 512 + c));
            else { *(f32x4*)(dout + (region == 1 ? OFF_DKS : OFF_DVS) + (size_t)rs * 512 + c) = v;
                   st_bf4((region == 1 ? KS : VS) + ((size_t)(rs >> 4) * KSROWS + 4096 + (rs & 15)) * 512 + c, v); }
        }
    }
};
struct EpiMemF {
    static constexpr bool ROPE = false, STATS = false; typedef NoPre Pre;
    bf16_t* MKV; float* dout; float s, q;
    __device__ __forceinline__ void row_begin(int, int) {}
    __device__ __forceinline__ Pre pre(int, int) const { return Pre{}; }
    __device__ __forceinline__ f32x4 fix(int, int, f32x4 v, const Pre&) const { return v; }
    __device__ __forceinline__ void commit(int, float, float) {}
    __device__ __forceinline__ void quad(int row, int col, f32x4 v, f32x4) {
        st_bf4(MKV + (size_t)row * 2048 + col, v);
        const int l = col >> 10, c = col & 1023;
        __builtin_nontemporal_store(v, (f32x4*)(dout + (c < 512 ? OFF_MKP : OFF_MVP) + (size_t)l * 524288 + (size_t)row * 512 + (c & 511)));
    }
};
struct EpiMerge0F {
    static constexpr bool ROPE = false, STATS = true; typedef u32x2 Pre;
    bf16_t* ZB; float* ST; float s, q;
    __device__ __forceinline__ void row_begin(int, int) {}
    __device__ __forceinline__ Pre pre(int row, int col) const { return *(const u32x2*)(ZB + (size_t)row * DM + col); }
    __device__ __forceinline__ f32x4 fix(int, int, f32x4 v, const Pre& x) const { return (f32x4){bflo(x.x), bfhi(x.x), bflo(x.y), bfhi(x.y)} * DN_ALPHA + v; }
    __device__ __forceinline__ void commit(int row, float ss, float qq) { atomicAdd(ST + 2 * (size_t)row, ss); atomicAdd(ST + 2 * (size_t)row + 1, qq); }
    __device__ __forceinline__ void quad(int row, int col, f32x4 z, f32x4) {
        st_bf4(ZB + (size_t)row * DM + col, z);
        s += (z.x + z.y) + (z.z + z.w); q += (z.x * z.x + z.y * z.y) + (z.z * z.z + z.w * z.w);
    }
};
struct EpiMerge1F {
    static constexpr bool ROPE = false, STATS = true; typedef u32x2 Pre;
    const bf16_t* ZB; const float* ST0; const float* g0; const float* b0; bf16_t* out; float* ST1; float s, q, mu[2], rstd[2];
    __device__ __forceinline__ void row_begin(int sl, int row) { row_stats(ST0, row, mu[sl], rstd[sl]); }
    __device__ __forceinline__ Pre pre(int row, int col) const { return *(const u32x2*)(ZB + (size_t)row * DM + col); }
    __device__ __forceinline__ f32x4 fix(int sl, int col, f32x4 v, const Pre& z) const {
        const f32x4 z0 = (f32x4){bflo(z.x), bfhi(z.x), bflo(z.y), bfhi(z.y)};
        const f32x4 g = *(const f32x4*)(g0 + col), b = *(const f32x4*)(b0 + col); return ((z0 - mu[sl]) * rstd[sl] * g + b) * DN_ALPHA + v; }
    __device__ __forceinline__ void commit(int row, float ss, float qq) { atomicAdd(ST1 + 2 * (size_t)row, ss); atomicAdd(ST1 + 2 * (size_t)row + 1, qq); }
    __device__ __forceinline__ void quad(int row, int col, f32x4 z, f32x4) {
        st_bf4(out + (size_t)row * DM + col, z);
        s += (z.x + z.y) + (z.z + z.w); q += (z.x * z.x + z.y * z.y) + (z.z * z.z + z.w * z.w);
    }
};
struct PreB { f32x4 c, b; };
struct EpiBF {
    static constexpr bool ROPE = true, STATS = false; typedef PreB Pre;
    bf16_t* PB; float* dout; bf16_t* KSW; bf16_t* VSW; const float* rope; const float* ST0; const float* CS; const float* BW; float s, q, mu[2], rstd[2];
    __device__ __forceinline__ void row_begin(int sl, int row) { row_stats(ST0, row, mu[sl], rstd[sl]); }
    __device__ __forceinline__ Pre pre(int, int col) const { Pre p; p.c = *(const f32x4*)(CS + col); p.b = *(const f32x4*)(BW + col); return p; }
    __device__ __forceinline__ f32x4 fix(int sl, int, f32x4 v, const Pre& p) const { return (v - p.c * mu[sl]) * rstd[sl] + p.b; }
    __device__ __forceinline__ bool need_rope(int col) const { return (col < 512 || (col >= 2048 && col < 2176)) && ((col >> 4) & 3) == 0; }
    __device__ __forceinline__ void commit(int, float, float) {}
    __device__ __forceinline__ void quad(int row, int col, f32x4 v, f32x4 p) {
        const bool samp = row >= NP; const int rs = row - NP;
        const int t = samp ? (rs & 15) : (row & 4095);
        const int pos = samp ? 4096 + t : t;
        const bool isk = col >= 2048 && col < 2176;
        if (need_rope(col)) v = rope_apply(v, p, col, pos, rope);
        st_bf4(PB + (size_t)row * NB + col, v);
        if (col >= 2048) {
            const int cc = col & 127;
            if (!samp) { if (t >= 3968) *(f32x4*)(dout + (isk ? OFF_SKP : OFF_SVP) + ((size_t)(row >> 12) * 128 + (t - 3968)) * 128 + cc) = v; }
            else { const int b = rs >> 4;
                   *(f32x4*)(dout + (isk ? OFF_SKS : OFF_SVS) + ((size_t)b * 128 + 112 + t) * 128 + cc) = v;
                   st_bf4((isk ? KSW : VSW) + ((size_t)b * SWROWS + 128 + t) * 128 + cc, v); }
        }
    }
};
template <class F> __device__ __forceinline__ void gemm_small(LAS unsigned char* lds, const bf16_t* A, const bf16_t* Bt, int N, int rowbase, int ustart, int G, const F& f, int colbase = 0) {
    const int tid = threadIdx.x, lane = tid & 63, r32 = lane & 31, hi = lane >> 5, wid = __builtin_amdgcn_readfirstlane(tid >> 6);
    const int nu = 8 * (N / 32);
    for (int u = ustart; u < nu; u += G) {
        const int row0 = (u & 7) * 32, colw = (u >> 3) * 32, col0 = colbase + colw;
        const bf16_t* ap = A + (size_t)(row0 + r32) * DM + wid * 128 + hi * 8; const bf16_t* bp = Bt + (size_t)(colw + r32) * DM + wid * 128 + hi * 8;
        bf16x8 af[8], bfr[8];
#pragma unroll
        for (int k = 0; k < 8; ++k) { af[k] = *(const bf16x8*)(ap + 16 * k); bfr[k] = *(const bf16x8*)(bp + 16 * k); }
        f32x16 acc = f32x16{};
#pragma unroll
        for (int k = 0; k < 8; ++k) acc = __builtin_amdgcn_mfma_f32_32x32x16_bf16(bfr[k], af[k], acc, 0, 0, 0);
        LAS float* part = (LAS float*)lds + wid * 1024;
#pragma unroll
        for (int r = 0; r < 16; ++r) part[r * 64 + lane] = acc[r];
        __syncthreads();
        if (wid < 2) {
            F lf = f; f32x4 qd[2];
#pragma unroll
            for (int e = 0; e < 2; ++e) { float t[4];
#pragma unroll
                for (int c = 0; c < 4; ++c) { const int r = 4 * (2 * wid + e) + c; float a = 0.f;
#pragma unroll
                    for (int w = 0; w < 8; ++w) a += ((LAS float*)lds)[w * 1024 + r * 64 + lane];
                    t[c] = a; }
                qd[e] = (f32x4){t[0], t[1], t[2], t[3]}; }
            const int row = rowbase + row0 + r32; typename F::Pre pr[2];
            lf.row_begin(0, row);
#pragma unroll
            for (int e = 0; e < 2; ++e) pr[e] = lf.pre(row, col0 + 8 * (2 * wid + e) + 4 * hi);
#pragma unroll
            for (int e = 0; e < 2; ++e) qd[e] = lf.fix(0, col0 + 8 * (2 * wid + e) + 4 * hi, qd[e], pr[e]);
            lf.s = 0.f; lf.q = 0.f;
#pragma unroll
            for (int e = 0; e < 2; ++e) lf.quad(row, col0 + 8 * (2 * wid + e) + 4 * hi, qd[e], qd[e ^ 1]);
            if constexpr (F::STATS) { float s = lf.s, q = lf.q; s += __shfl_xor(s, 32); q += __shfl_xor(q, 32); if (hi == 0) lf.commit(row, s, q); }
        }
        __syncthreads();
    }
}

namespace att {
#define KSWZ(row, colB) ((row) * 256 + ((colB) ^ (((row) & 7) << 4)))
#define SBAR() __builtin_amdgcn_sched_barrier(0)
__device__ __forceinline__ int v_st(int k, int c) { const int kk = (k & ~0xC) | ((k & 4) << 1) | ((k & 8) >> 1); return ((kk >> 3) * 4 + (c >> 5)) * 512 + ((kk & 7) * 32 + (c & 31)) * 2; }
__device__ __forceinline__ int v_rd_base(int lane) { return ((lane & 3) << 3) | (((lane >> 2) & 3) << 6) | (((lane >> 4) & 1) << 5) | (((lane >> 5) & 1) << 8); }
constexpr int v_rd_off(int d0, int ks, int half) { return d0 * 512 + ks * 4096 + half * 2048; }
template <int OFF> __device__ __forceinline__ s16x4 tr_read(int vb) {
    s16x4 r; asm volatile("ds_read_b64_tr_b16 %0, %1 offset:%2" : "=&v"(r) : "v"(vb), "i"(OFF) : "memory"); return r;
}
template <int OFF> __device__ __forceinline__ bf16x8 lds_read128(int ad) {
    bf16x8 r; asm volatile("ds_read_b128 %0, %1 offset:%2" : "=&v"(r) : "v"(ad), "i"(OFF) : "memory"); return r;
}
template <int D0> __device__ __forceinline__ void pv_one(f32x16& od, int vb, bf16x8 pa0, bf16x8 pa1, bf16x8 pa2, bf16x8 pa3) {
    const s16x4 l0 = tr_read<v_rd_off(D0, 0, 0)>(vb), h0 = tr_read<v_rd_off(D0, 0, 1)>(vb), l1 = tr_read<v_rd_off(D0, 1, 0)>(vb), h1 = tr_read<v_rd_off(D0, 1, 1)>(vb);
    const s16x4 l2 = tr_read<v_rd_off(D0, 2, 0)>(vb), h2 = tr_read<v_rd_off(D0, 2, 1)>(vb), l3 = tr_read<v_rd_off(D0, 3, 0)>(vb), h3 = tr_read<v_rd_off(D0, 3, 1)>(vb);
    asm volatile("s_waitcnt lgkmcnt(0)" ::: "memory"); SBAR();
#define PK(L, H) (bf16x8){L[0], L[1], L[2], L[3], H[0], H[1], H[2], H[3]}
    od = __builtin_amdgcn_mfma_f32_32x32x16_bf16(PK(l0, h0), pa0, od, 0, 0, 0);
    od = __builtin_amdgcn_mfma_f32_32x32x16_bf16(PK(l1, h1), pa1, od, 0, 0, 0);
    od = __builtin_amdgcn_mfma_f32_32x32x16_bf16(PK(l2, h2), pa2, od, 0, 0, 0);
    od = __builtin_amdgcn_mfma_f32_32x32x16_bf16(PK(l3, h3), pa3, od, 0, 0, 0);
#undef PK
}
template <int KSI, int DB, int ND> __device__ __forceinline__ void v_read(int vb, s16x4 (&l)[4], s16x4 (&h)[4]) {
    l[0] = tr_read<v_rd_off(DB, KSI, 0)>(vb); h[0] = tr_read<v_rd_off(DB, KSI, 1)>(vb);
    l[1] = tr_read<v_rd_off(DB + 1, KSI, 0)>(vb); h[1] = tr_read<v_rd_off(DB + 1, KSI, 1)>(vb);
    if constexpr (ND == 4) { l[2] = tr_read<v_rd_off(DB + 2, KSI, 0)>(vb); h[2] = tr_read<v_rd_off(DB + 2, KSI, 1)>(vb);
                             l[3] = tr_read<v_rd_off(DB + 3, KSI, 0)>(vb); h[3] = tr_read<v_rd_off(DB + 3, KSI, 1)>(vb); }
}
template <int ND> __device__ __forceinline__ void pv_mf(f32x16 (&o)[4], bf16x8 pa, const s16x4 (&l)[4], const s16x4 (&h)[4]) {
    __builtin_amdgcn_s_setprio(1);
#pragma unroll
    for (int d = 0; d < ND; ++d) o[d] = __builtin_amdgcn_mfma_f32_32x32x16_bf16((bf16x8){l[d][0], l[d][1], l[d][2], l[d][3], h[d][0], h[d][1], h[d][2], h[d][3]}, pa, o[d], 0, 0, 0);
    __builtin_amdgcn_s_setprio(0);
}
template <int DB, int ND> __device__ __forceinline__ void pv_ks(f32x16 (&o)[4], int vb, bf16x8 pa0, bf16x8 pa1, bf16x8 pa2, bf16x8 pa3) {
    s16x4 la[4], ha[4];
    v_read<0, DB, ND>(vb, la, ha); asm volatile("s_waitcnt lgkmcnt(0)" ::: "memory"); SBAR(); pv_mf<ND>(o, pa0, la, ha); SBAR();
    v_read<1, DB, ND>(vb, la, ha); asm volatile("s_waitcnt lgkmcnt(0)" ::: "memory"); SBAR(); pv_mf<ND>(o, pa1, la, ha); SBAR();
    v_read<2, DB, ND>(vb, la, ha); asm volatile("s_waitcnt lgkmcnt(0)" ::: "memory"); SBAR(); pv_mf<ND>(o, pa2, la, ha); SBAR();
    v_read<3, DB, ND>(vb, la, ha); asm volatile("s_waitcnt lgkmcnt(0)" ::: "memory"); SBAR(); pv_mf<ND>(o, pa3, la, ha);
}
template <int DB, int ND> __device__ __forceinline__ void pv_rest(f32x16 (&o)[4], int vb, bf16x8 pa0, bf16x8 pa1, bf16x8 pa2, bf16x8 pa3, s16x4 (&la)[4], s16x4 (&ha)[4]) {
    s16x4 lb[4], hb[4];
    asm volatile("s_waitcnt lgkmcnt(0)" ::: "memory"); SBAR(); v_read<1, DB, ND>(vb, lb, hb); SBAR(); pv_mf<ND>(o, pa0, la, ha); SBAR();
    asm volatile("s_waitcnt lgkmcnt(0)" ::: "memory"); SBAR(); v_read<2, DB, ND>(vb, la, ha); SBAR(); pv_mf<ND>(o, pa1, lb, hb); SBAR();
    asm volatile("s_waitcnt lgkmcnt(0)" ::: "memory"); SBAR(); v_read<3, DB, ND>(vb, lb, hb); SBAR(); pv_mf<ND>(o, pa2, la, ha); SBAR();
    asm volatile("s_waitcnt lgkmcnt(0)" ::: "memory"); SBAR(); pv_mf<ND>(o, pa3, lb, hb);
}
__device__ __forceinline__ void partialSM(f32x16& p0, f32x16& p1, float& m_reg, float& alpha, float C, float thr) {
    float pmax = p0[0];
#pragma unroll
    for (int r = 1; r < 16; ++r) pmax = fmaxf(pmax, p0[r]);
#pragma unroll
    for (int r = 0; r < 16; ++r) pmax = fmaxf(pmax, p1[r]);
    { auto rr = __builtin_amdgcn_permlane32_swap(__float_as_uint(pmax), __float_as_uint(pmax), false, false);
      pmax = fmaxf(__uint_as_float(rr[0]), __uint_as_float(rr[1])); }
    float mn;
    if (__all(pmax - m_reg <= thr)) { mn = m_reg; alpha = 1.f; }
    else { mn = fmaxf(m_reg, pmax); alpha = __builtin_amdgcn_exp2f((m_reg - mn) * C); m_reg = mn; }
    const float mnC = -mn * C;
#pragma unroll
    for (int r = 0; r < 16; ++r) p0[r] = __builtin_amdgcn_exp2f(fmaf(p0[r], C, mnC));
#pragma unroll
    for (int r = 0; r < 16; ++r) p1[r] = __builtin_amdgcn_exp2f(fmaf(p1[r], C, mnC));
}
__device__ __forceinline__ void finishSM(f32x16& p0, f32x16& p1, float alpha, float& l_reg, bf16x8& pa0, bf16x8& pa1, bf16x8& pa2, bf16x8& pa3) {
    float ps = 0;
#pragma unroll
    for (int r = 0; r < 16; ++r) ps += p0[r];
#pragma unroll
    for (int r = 0; r < 16; ++r) ps += p1[r];
    { auto rr = __builtin_amdgcn_permlane32_swap(__float_as_uint(ps), __float_as_uint(ps), false, false);
      ps = __uint_as_float(rr[0]) + __uint_as_float(rr[1]); }
    l_reg = l_reg * alpha + ps;
#define PK4(P, BASE, OUT) do { unsigned a0 = cvtpk(P[BASE + 0], P[BASE + 1]), a1 = cvtpk(P[BASE + 2], P[BASE + 3]);   \
    unsigned b0 = cvtpk(P[BASE + 4], P[BASE + 5]), b1 = cvtpk(P[BASE + 6], P[BASE + 7]);                              \
    auto r0 = __builtin_amdgcn_permlane32_swap(a0, b0, false, false); auto r1 = __builtin_amdgcn_permlane32_swap(a1, b1, false, false); \
    u32x4 w = {r0[0], r1[0], r0[1], r1[1]}; OUT = *reinterpret_cast<bf16x8*>(&w); } while (0)
    PK4(p0, 0, pa0); PK4(p0, 8, pa1); PK4(p1, 0, pa2); PK4(p1, 8, pa3);
#undef PK4
}
constexpr int RING = 32768;
template <int QS, bool PVHALF>
__device__ __forceinline__ void attn_core(LAS unsigned char* lds, const bf16_t* Kb, long ldk, const bf16_t* Vb, long ldv, int NT, int nkeys,
                                          const bf16_t* qptr, int wNT, int kcoffB, int pvsel, float C, float thr, f32x16 (&o)[4], float& m_reg, float& l_reg) {
    int tid = threadIdx.x; asm volatile("" : "+v"(tid));
    const int lane = tid & 63, r32 = lane & 31, hi = lane >> 5, wid = __builtin_amdgcn_readfirstlane(tid >> 6);
    bf16x8 qr[QS];
#pragma unroll
    for (int d0 = 0; d0 < QS; ++d0) qr[d0] = *(const bf16x8*)(qptr + d0 * 16);
#pragma unroll
    for (int d = 0; d < 4; ++d) o[d] = f32x16{};
    m_reg = -1e30f; l_reg = 0.f;
    long offK[2], offV[2];
#pragma unroll
    for (int i = 0; i < 2; ++i) { const int p = i * 8192 + wid * 1024 + lane * 16;
        const int row = p >> 8, colB = (p & 255) ^ ((row & 7) << 4); offK[i] = (long)row * ldk + (colB >> 1);
        const int sub = p >> 9, q = (p & 511) >> 1, kk = (sub >> 2) * 8 + (q >> 5), k = (kk & ~0xC) | ((kk & 4) << 1) | ((kk & 8) >> 1), c = (sub & 3) * 32 + (q & 31);
        offV[i] = (long)k * ldv + c; }
    const int vrb = v_rd_base(lane);
#define GLDS(t, bf) do { const bf16_t* kt_ = Kb + (long)(t) * 64 * ldk; const bf16_t* vt_ = Vb + (long)(t) * 64 * ldv; LAS unsigned char* b_ = lds + (bf) * RING + wid * 1024; \
    __builtin_amdgcn_global_load_lds((const unsigned*)(vt_ + offV[0]), (LAS unsigned*)(b_), 16, 0, 0); \
    __builtin_amdgcn_global_load_lds((const unsigned*)(vt_ + offV[1]), (LAS unsigned*)(b_ + 8192), 16, 0, 0); \
    __builtin_amdgcn_global_load_lds((const unsigned*)(kt_ + offK[0]), (LAS unsigned*)(b_ + 16384), 16, 0, 0); \
    __builtin_amdgcn_global_load_lds((const unsigned*)(kt_ + offK[1]), (LAS unsigned*)(b_ + 16384 + 8192), 16, 0, 0); } while (0)
    GLDS(0, 0);
#pragma unroll
    for (int d0 = 0; d0 < QS; ++d0) asm volatile("" :: "v"(qr[d0]));
    if (1 < NT) GLDS(1, 1); if (2 < NT) GLDS(2, 2);
    for (int j = 0; j < NT; ++j) {
        const int rem = NT - 1 - j;
        if (rem >= 2) asm volatile("s_waitcnt vmcnt(8)" ::: "memory"); else if (rem == 1) asm volatile("s_waitcnt vmcnt(4)" ::: "memory"); else asm volatile("s_waitcnt vmcnt(0)" ::: "memory");
        __builtin_amdgcn_s_barrier();
        asm volatile("" ::: "memory");
        if (j + 3 < NT) GLDS(j + 3, (j + 3) & 3);
        if (j < wNT) {
            const int cur = j & 3;
            f32x16 p0 = f32x16{}, p1 = f32x16{};
            const int kbase = (int)(uintptr_t)(lds + cur * RING + 16384) + r32 * 256;
            const int swz = (r32 & 7) << 4;
#pragma unroll
            for (int hq = 0; hq < QS / 4; ++hq) { bf16x8 b0[4], b1[4];
#pragma unroll
                for (int i = 0; i < 4; ++i) { const int cb = kcoffB + ((hq * 4 + i) * 16 + hi * 8) * 2; const int ad = kbase + (cb ^ swz);
                    b0[i] = lds_read128<0>(ad); b1[i] = lds_read128<8192>(ad); }
                asm volatile("s_waitcnt lgkmcnt(0)" ::: "memory"); SBAR();
#pragma unroll
                for (int i = 0; i < 4; ++i) { p0 = __builtin_amdgcn_mfma_f32_32x32x16_bf16(b0[i], qr[hq * 4 + i], p0, 0, 0, 0);
                    p1 = __builtin_amdgcn_mfma_f32_32x32x16_bf16(b1[i], qr[hq * 4 + i], p1, 0, 0, 0); } }
            if (__builtin_expect((j + 1) * 64 > nkeys, 0)) { const int kb = j * 64 + 4 * hi; asm volatile("" ::: "memory");
#pragma unroll
                for (int r = 0; r < 16; ++r) { const int kv = kb + (r & 3) + 8 * (r >> 2); if (kv >= nkeys) p0[r] = -1e30f; if (kv + 32 >= nkeys) p1[r] = -1e30f; } }
            float alpha; bf16x8 pa0, pa1, pa2, pa3;
            const int vb = (int)(uintptr_t)(lds + cur * RING) + vrb;
            s16x4 la[4], ha[4];
            partialSM(p0, p1, m_reg, alpha, C, thr);
            finishSM(p0, p1, alpha, l_reg, pa0, pa1, pa2, pa3);
            SBAR();
            if constexpr (QS == 4) { if constexpr (!PVHALF) v_read<0, 0, 4>(vb, la, ha); else { if (pvsel == 0) v_read<0, 0, 2>(vb, la, ha); else v_read<0, 2, 2>(vb, la, ha); } }
            SBAR();
            if (__any(alpha < 1.f)) {
#pragma unroll
                for (int d = 0; d < (PVHALF ? 2 : 4); ++d)
#pragma unroll
                    for (int r = 0; r < 16; ++r) o[d][r] *= alpha; }
            if constexpr (QS == 8) { pv_one<0>(o[0], vb, pa0, pa1, pa2, pa3); pv_one<1>(o[1], vb, pa0, pa1, pa2, pa3); pv_one<2>(o[2], vb, pa0, pa1, pa2, pa3); pv_one<3>(o[3], vb, pa0, pa1, pa2, pa3); }
            else if constexpr (!PVHALF) pv_rest<0, 4>(o, vb, pa0, pa1, pa2, pa3, la, ha);
            else { if (pvsel == 0) pv_rest<0, 2>(o, vb, pa0, pa1, pa2, pa3, la, ha); else pv_rest<2, 2>(o, vb, pa0, pa1, pa2, pa3, la, ha); }
        }
    }
#undef GLDS
    __syncthreads();
}

template <bool PVHALF>
__device__ __forceinline__ void attn_core_pipe(LAS unsigned char* lds, const bf16_t* Kb, long ldk, const bf16_t* Vb, long ldv, int NT, int nkeys,
                                               const bf16_t* qptr, int wNT, int kcoffB, int pvsel, float C, float thr, f32x16 (&o)[4], float& m_reg, float& l_reg) {
    int tid = threadIdx.x; asm volatile("" : "+v"(tid));
    const int lane = tid & 63, r32 = lane & 31, hi = lane >> 5, wid = __builtin_amdgcn_readfirstlane(tid >> 6);
    bf16x8 qr[4];
#pragma unroll
    for (int d0 = 0; d0 < 4; ++d0) qr[d0] = *(const bf16x8*)(qptr + d0 * 16);
#pragma unroll
    for (int d = 0; d < 4; ++d) o[d] = f32x16{};
    m_reg = -1e30f; l_reg = 0.f;
    int offK[2], offV[2];
#pragma unroll
    for (int i = 0; i < 2; ++i) { const int p = i * 8192 + wid * 1024 + lane * 16;
        const int row = p >> 8, colB = (p & 255) ^ ((row & 7) << 4); offK[i] = row * (int)ldk + (colB >> 1);
        const int sub = p >> 9, q = (p & 511) >> 1, kk = (sub >> 2) * 8 + (q >> 5), k = (kk & ~0xC) | ((kk & 4) << 1) | ((kk & 8) >> 1), c = (sub & 3) * 32 + (q & 31);
        offV[i] = k * (int)ldv + c; }
    const int vrb = v_rd_base(lane);
    int kad[4];
#pragma unroll
    for (int i = 0; i < 4; ++i) kad[i] = 16384 + r32 * 256 + ((kcoffB + (i * 16 + hi * 8) * 2) ^ ((r32 & 7) << 4));
    const int lds0 = (int)(uintptr_t)lds;
#define GLDS_V(t, bf) do { const bf16_t* vt_ = Vb + (long)(t) * 64 * ldv; LAS unsigned char* b_ = lds + (bf) * RING + wid * 1024; \
    __builtin_amdgcn_global_load_lds((const unsigned*)(vt_ + offV[0]), (LAS unsigned*)(b_), 16, 0, 0); \
    __builtin_amdgcn_global_load_lds((const unsigned*)(vt_ + offV[1]), (LAS unsigned*)(b_ + 8192), 16, 0, 0); } while (0)
#define GLDS_K(t, bf) do { const bf16_t* kt_ = Kb + (long)(t) * 64 * ldk; LAS unsigned char* b_ = lds + (bf) * RING + wid * 1024; \
    __builtin_amdgcn_global_load_lds((const unsigned*)(kt_ + offK[0]), (LAS unsigned*)(b_ + 16384), 16, 0, 0); \
    __builtin_amdgcn_global_load_lds((const unsigned*)(kt_ + offK[1]), (LAS unsigned*)(b_ + 16384 + 8192), 16, 0, 0); } while (0)
#define GLDS(t, bf) do { GLDS_V(t, bf); GLDS_K(t, bf); } while (0)
#define QK(P0, P1, bf) do { const int kb_ = lds0 + (bf) * RING; bf16x8 b0_[2], b1_[2]; \
    _Pragma("unroll") for (int i_ = 0; i_ < 2; ++i_) { b0_[i_] = lds_read128<0>(kb_ + kad[i_]); b1_[i_] = lds_read128<8192>(kb_ + kad[i_]); } \
    asm volatile("s_waitcnt lgkmcnt(0)" ::: "memory"); SBAR(); \
    P0 = __builtin_amdgcn_mfma_f32_32x32x16_bf16(b0_[0], qr[0], f32x16{}, 0, 0, 0); P1 = __builtin_amdgcn_mfma_f32_32x32x16_bf16(b1_[0], qr[0], f32x16{}, 0, 0, 0); \
    P0 = __builtin_amdgcn_mfma_f32_32x32x16_bf16(b0_[1], qr[1], P0, 0, 0, 0); P1 = __builtin_amdgcn_mfma_f32_32x32x16_bf16(b1_[1], qr[1], P1, 0, 0, 0); SBAR(); \
    _Pragma("unroll") for (int i_ = 0; i_ < 2; ++i_) { b0_[i_] = lds_read128<0>(kb_ + kad[2 + i_]); b1_[i_] = lds_read128<8192>(kb_ + kad[2 + i_]); } \
    asm volatile("s_waitcnt lgkmcnt(0)" ::: "memory"); SBAR(); \
    P0 = __builtin_amdgcn_mfma_f32_32x32x16_bf16(b0_[0], qr[2], P0, 0, 0, 0); P1 = __builtin_amdgcn_mfma_f32_32x32x16_bf16(b1_[0], qr[2], P1, 0, 0, 0); \
    P0 = __builtin_amdgcn_mfma_f32_32x32x16_bf16(b0_[1], qr[3], P0, 0, 0, 0); P1 = __builtin_amdgcn_mfma_f32_32x32x16_bf16(b1_[1], qr[3], P1, 0, 0, 0); \
    SBAR(); } while (0)
#define STEP(C0, C1, N0, N1, j) do { \
    if ((j) + 1 < NT) { \
        if ((j) + 2 < NT) asm volatile("s_waitcnt vmcnt(4)" ::: "memory"); else asm volatile("s_waitcnt vmcnt(0)" ::: "memory"); \
        __builtin_amdgcn_s_barrier(); asm volatile("" ::: "memory"); \
        if ((j) + 1 < wNT) QK(N0, N1, ((j) + 1) & 3); } \
    const bool iss_ = (j) + 3 < NT;                                 \
    if ((j) < wNT) { \
        if (__builtin_expect(((j) + 1) * 64 > nkeys, 0)) { const int kb = (j) * 64 + 4 * hi; asm volatile("" ::: "memory"); \
            _Pragma("unroll") for (int r = 0; r < 16; ++r) { const int kv = kb + (r & 3) + 8 * (r >> 2); if (kv >= nkeys) C0[r] = -1e30f; if (kv + 32 >= nkeys) C1[r] = -1e30f; } } \
        float alpha; bf16x8 pa0, pa1, pa2, pa3; const int vb = lds0 + ((j) & 3) * RING + vrb; \
        partialSM(C0, C1, m_reg, alpha, C, thr); \
        SBAR(); if (iss_) GLDS_V((j) + 3, ((j) + 3) & 3); SBAR(); \
        finishSM(C0, C1, alpha, l_reg, pa0, pa1, pa2, pa3); \
        SBAR(); if (iss_) GLDS_K((j) + 3, ((j) + 3) & 3); SBAR(); \
        if (__any(alpha < 1.f)) { \
            _Pragma("unroll") for (int d = 0; d < (PVHALF ? 2 : 4); ++d) _Pragma("unroll") for (int r = 0; r < 16; ++r) o[d][r] *= alpha; } \
        if constexpr (!PVHALF) pv_ks<0, 4>(o, vb, pa0, pa1, pa2, pa3); \
        else { if (pvsel == 0) pv_ks<0, 2>(o, vb, pa0, pa1, pa2, pa3); else pv_ks<2, 2>(o, vb, pa0, pa1, pa2, pa3); } } \
    else if (iss_) GLDS((j) + 3, ((j) + 3) & 3); \
    } while (0)
    GLDS(0, 0);
#pragma unroll
    for (int d0 = 0; d0 < 4; ++d0) asm volatile("" :: "v"(qr[d0]));
    if (1 < NT) GLDS(1, 1); if (2 < NT) GLDS(2, 2);
    if (NT > 2) asm volatile("s_waitcnt vmcnt(8)" ::: "memory"); else if (NT == 2) asm volatile("s_waitcnt vmcnt(4)" ::: "memory"); else asm volatile("s_waitcnt vmcnt(0)" ::: "memory");
    __builtin_amdgcn_s_barrier(); asm volatile("" ::: "memory");
    f32x16 pA0 = f32x16{}, pA1 = f32x16{}, pB0 = f32x16{}, pB1 = f32x16{};
    if (0 < wNT) QK(pA0, pA1, 0);
    for (int j = 0; j < NT; j += 2) {
        STEP(pA0, pA1, pB0, pB1, j);
        if (j + 1 < NT) STEP(pB0, pB1, pA0, pA1, j + 1);
    }
#undef STEP
#undef QK
#undef GLDS
#undef GLDS_V
#undef GLDS_K
    __syncthreads();
}

struct Ctx { LAS unsigned char* lds; int lane, wid, r32, hi; };

template <int ND> __device__ __forceinline__ void store_gated(const f32x16 (&o)[4], float scale, const bf16_t* gate, bf16_t* out, int hi) {
#pragma unroll
    for (int d = 0; d < ND; ++d)
#pragma unroll
        for (int g = 0; g < 4; ++g) { const int dv = 32 * d + 8 * g + 4 * hi;
            const u32x2 gt = *(const u32x2*)(gate + dv);
            f32x4 v; v.x = o[d][4 * g] * scale * silu(bflo(gt.x)); v.y = o[d][4 * g + 1] * scale * silu(bfhi(gt.x));
            v.z = o[d][4 * g + 2] * scale * silu(bflo(gt.y)); v.w = o[d][4 * g + 3] * scale * silu(bfhi(gt.y));
            st_bf4(out + dv, v); }
}

__device__ __forceinline__ void diff_unit(const Ctx& cx, bool samp, int b, int h, int qb, const bf16_t* PA, const bf16_t* KS, const bf16_t* VS, bf16_t* MIX, const float* gnorm, float lam) {
    const int c = cx.wid >> 2, rb = cx.wid & 3;
    long row; bool valid; int NT, wNT, nkeys; const bf16_t* Kb; const bf16_t* Vb; long ldk;
    if (!samp) { row = (long)b * 4096 + qb * 128 + rb * 32 + cx.r32; valid = true; NT = 2 * qb + 2; wNT = 2 * qb + 1 + (rb >> 1); nkeys = NT * 64;
                 Kb = PA + (size_t)b * 4096 * NA + 512 + h * 128; Vb = Kb + 512; ldk = NA; }
    else { row = NP + b * 16 + (cx.r32 < 15 ? cx.r32 : 15); valid = (rb == 0) && cx.r32 < 16; NT = 65; wNT = (rb == 0) ? 65 : 0; nkeys = 4112;
           Kb = KS + (size_t)b * KSROWS * 512 + h * 128; Vb = VS + (size_t)b * KSROWS * 512 + h * 128; ldk = 512; }
    const bf16_t* qptr = PA + (size_t)row * NA + h * 128 + c * 64 + cx.hi * 8;
    f32x16 o[4]; float m, l;
    attn_core_pipe<false>(cx.lds, Kb, ldk, Vb, ldk, NT, nkeys, qptr, wNT, c * 128, 0, C64, THR64, o, m, l);
    const float inv = l > 0.f ? 1.f / l : 0.f;
    LAS float* xch = (LAS float*)cx.lds + rb * 4096;
    if (c == 1) {
#pragma unroll
        for (int d = 0; d < 4; ++d)
#pragma unroll
            for (int r = 0; r < 16; ++r) xch[(d * 16 + r) * 64 + cx.lane] = o[d][r] * inv; }
    __syncthreads();
    if (c == 0) {
        float ss = 0.f;
#pragma unroll
        for (int d = 0; d < 4; ++d)
#pragma unroll
            for (int r = 0; r < 16; ++r) { const float od = o[d][r] * inv - lam * xch[(d * 16 + r) * 64 + cx.lane]; o[d][r] = od; ss += od * od; }
        ss += __shfl_xor(ss, 32);
        const float rms = rsqrtf(ss * (1.f / 128.f) + 1e-5f) * 0.8f;
        if (valid) {
            const bf16_t* gate = PA + (size_t)row * NA + 1536 + h * 128; bf16_t* out = MIX + (size_t)row * DM + h * 128;
#pragma unroll
            for (int d = 0; d < 4; ++d)
#pragma unroll
                for (int g = 0; g < 4; ++g) { const int dv = 32 * d + 8 * g + 4 * cx.hi;
                    const f32x4 gn = *(const f32x4*)(gnorm + dv); const u32x2 gt = *(const u32x2*)(gate + dv);
                    f32x4 v; v.x = o[d][4 * g] * rms * gn.x * silu(bflo(gt.x)); v.y = o[d][4 * g + 1] * rms * gn.y * silu(bfhi(gt.x));
                    v.z = o[d][4 * g + 2] * rms * gn.z * silu(bflo(gt.y)); v.w = o[d][4 * g + 3] * rms * gn.w * silu(bfhi(gt.y));
                    st_bf4(out + dv, v); }
        }
    }
    __syncthreads();
}
__device__ __forceinline__ void diff_sample_item(const Ctx& cx, int b, int h, int sp, const float* CK, const float* CV, const bf16_t* PA, const bf16_t* KS, const bf16_t* VS,
                                                 bf16_t* MIX, const float* gnorm, float lam, float* PART, unsigned* cnt, volatile LAS unsigned* MISC) {
    int tid = threadIdx.x; asm volatile("" : "+v"(tid));
    const int lane = tid & 63, r32 = lane & 31, hi = lane >> 5, wid = __builtin_amdgcn_readfirstlane(tid >> 6);
    const int c = wid >> 2; const bool active = (wid & 3) == 0;
    const size_t row = NP + b * 16 + (r32 < 15 ? r32 : 15);
    bf16x8 qr[4];
    { const bf16_t* qptr = PA + row * NA + h * 128 + c * 64 + hi * 8;
#pragma unroll
      for (int d0 = 0; d0 < 4; ++d0) qr[d0] = *(const bf16x8*)(qptr + d0 * 16); }
    f32x16 o[4];
#pragma unroll
    for (int d = 0; d < 4; ++d) o[d] = f32x16{};
    float m_reg = -1e30f, l_reg = 0.f;
    const int ntl = 16 + (sp == 3 ? 1 : 0);
    const int sr = tid >> 4, sc = (tid & 15) * 8;
    const float* kg = CK + ((size_t)(b * 4096 + sp * 1024 + sr) * 4 + h) * 128 + sc;
    const float* vg = CV + ((size_t)(b * 4096 + sp * 1024 + sr) * 4 + h) * 128 + sc;
    const bf16_t* kn = KS + ((size_t)b * KSROWS + 4096 + sr) * 512 + h * 128 + sc;
    const bf16_t* vn = VS + ((size_t)b * KSROWS + 4096 + sr) * 512 + h * 128 + sc;
    const int vst0 = v_st(sr, sc), vst1 = v_st(32 + sr, sc), kst0 = 16384 + KSWZ(sr, sc * 2), kst1 = 16384 + KSWZ(32 + sr, sc * 2);
    int kad[4];
#pragma unroll
    for (int i = 0; i < 4; ++i) kad[i] = 16384 + r32 * 256 + ((c * 128 + (i * 16 + hi * 8) * 2) ^ ((r32 & 7) << 4));
    const int lds0 = (int)(uintptr_t)cx.lds, vrb = v_rd_base(lane);
    f32x4 kfA[4], vfA[4], kfB[4], vfB[4];
#define LOADT(t, kf, vf) do { if ((t) < 16) { const float* kp_ = kg + (size_t)(t) * 64 * 512; const float* vp_ = vg + (size_t)(t) * 64 * 512; \
        kf[0] = __builtin_nontemporal_load((const f32x4*)kp_); kf[1] = __builtin_nontemporal_load((const f32x4*)(kp_ + 4)); kf[2] = __builtin_nontemporal_load((const f32x4*)(kp_ + 32 * 512)); kf[3] = __builtin_nontemporal_load((const f32x4*)(kp_ + 32 * 512 + 4)); \
        vf[0] = __builtin_nontemporal_load((const f32x4*)vp_); vf[1] = __builtin_nontemporal_load((const f32x4*)(vp_ + 4)); vf[2] = __builtin_nontemporal_load((const f32x4*)(vp_ + 32 * 512)); vf[3] = __builtin_nontemporal_load((const f32x4*)(vp_ + 32 * 512 + 4)); } \
    else { kf[0] = *(const f32x4*)kn; kf[2] = *(const f32x4*)(kn + 32 * 512); vf[0] = *(const f32x4*)vn; vf[2] = *(const f32x4*)(vn + 32 * 512); } } while (0)
#define CV8(A, B) ((u32x4){cvtpk(A.x, A.y), cvtpk(A.z, A.w), cvtpk(B.x, B.y), cvtpk(B.z, B.w)})
#define WRITET(t, bf, kf, vf) do { u32x4 k0_, k1_, v0_, v1_; \
    if ((t) < 16) { k0_ = CV8(kf[0], kf[1]); k1_ = CV8(kf[2], kf[3]); v0_ = CV8(vf[0], vf[1]); v1_ = CV8(vf[2], vf[3]); } \
    else { k0_ = __builtin_bit_cast(u32x4, kf[0]); k1_ = __builtin_bit_cast(u32x4, kf[2]); v0_ = __builtin_bit_cast(u32x4, vf[0]); v1_ = __builtin_bit_cast(u32x4, vf[2]); } \
    LAS unsigned char* b_ = cx.lds + (bf) * RING; \
    *(LAS u32x4*)(b_ + vst0) = v0_; *(LAS u32x4*)(b_ + vst1) = v1_; *(LAS u32x4*)(b_ + kst0) = k0_; *(LAS u32x4*)(b_ + kst1) = k1_; } while (0)
#define SCORE(t, cur) do { if (active) { \
            f32x16 p0, p1; \
            { const int kb_ = lds0 + (cur) * RING; bf16x8 b0_[2], b1_[2]; \
              _Pragma("unroll") for (int i = 0; i < 2; ++i) { b0_[i] = lds_read128<0>(kb_ + kad[i]); b1_[i] = lds_read128<8192>(kb_ + kad[i]); } \
              asm volatile("s_waitcnt lgkmcnt(0)" ::: "memory"); SBAR(); \
              p0 = __builtin_amdgcn_mfma_f32_32x32x16_bf16(b0_[0], qr[0], f32x16{}, 0, 0, 0); p1 = __builtin_amdgcn_mfma_f32_32x32x16_bf16(b1_[0], qr[0], f32x16{}, 0, 0, 0); \
              p0 = __builtin_amdgcn_mfma_f32_32x32x16_bf16(b0_[1], qr[1], p0, 0, 0, 0); p1 = __builtin_amdgcn_mfma_f32_32x32x16_bf16(b1_[1], qr[1], p1, 0, 0, 0); SBAR(); \
              _Pragma("unroll") for (int i = 0; i < 2; ++i) { b0_[i] = lds_read128<0>(kb_ + kad[2 + i]); b1_[i] = lds_read128<8192>(kb_ + kad[2 + i]); } \
              asm volatile("s_waitcnt lgkmcnt(0)" ::: "memory"); SBAR(); \
              p0 = __builtin_amdgcn_mfma_f32_32x32x16_bf16(b0_[0], qr[2], p0, 0, 0, 0); p1 = __builtin_amdgcn_mfma_f32_32x32x16_bf16(b1_[0], qr[2], p1, 0, 0, 0); \
              p0 = __builtin_amdgcn_mfma_f32_32x32x16_bf16(b0_[1], qr[3], p0, 0, 0, 0); p1 = __builtin_amdgcn_mfma_f32_32x32x16_bf16(b1_[1], qr[3], p1, 0, 0, 0); } \
            if ((t) >= 16) { \
                _Pragma("unroll") for (int r = 0; r < 16; ++r) { const int kv = 4 * hi + (r & 3) + 8 * (r >> 2); if (kv >= 16) p0[r] = -1e30f; p1[r] = -1e30f; } } \
            float alpha; bf16x8 pa0, pa1, pa2, pa3; \
            partialSM(p0, p1, m_reg, alpha, C64, THR64); \
            finishSM(p0, p1, alpha, l_reg, pa0, pa1, pa2, pa3); \
            SBAR(); \
            if (__any(alpha < 1.f)) { \
                _Pragma("unroll") for (int d = 0; d < 4; ++d) _Pragma("unroll") for (int r = 0; r < 16; ++r) o[d][r] *= alpha; } \
            pv_ks<0, 4>(o, lds0 + (cur) * RING + vrb, pa0, pa1, pa2, pa3); } } while (0)
    LOADT(0, kfA, vfA); LOADT(1, kfB, vfB); WRITET(0, 0, kfA, vfA); __syncthreads();
    for (int t = 0; t < ntl; t += 2) {
        if (t + 2 < ntl) LOADT(t + 2, kfA, vfA);
        SCORE(t, 0);
        if (t + 1 < ntl) WRITET(t + 1, 1, kfB, vfB);
        __syncthreads();
        if (t + 1 < ntl) {
            if (t + 3 < ntl) LOADT(t + 3, kfB, vfB);
            SCORE(t + 1, 1);
            if (t + 2 < ntl) WRITET(t + 2, 0, kfA, vfA);
            __syncthreads();
        }
    }
#undef SCORE
#undef LOADT
#undef WRITET
#undef CV8
    const int bh = b * 4 + h;
    if (active) { float* pb = PART + ((size_t)(bh * 4 + sp) * 2 + c) * (66 * 64) + lane;
#pragma unroll
        for (int d = 0; d < 4; ++d)
#pragma unroll
            for (int r = 0; r < 16; ++r) pb[(d * 16 + r) * 64] = o[d][r];
        pb[64 * 64] = m_reg; pb[65 * 64] = l_reg; }
    asm volatile("s_waitcnt vmcnt(0)" ::: "memory"); __syncthreads();
    if (tid == 0) { __builtin_amdgcn_fence(__ATOMIC_RELEASE, "agent"); asm volatile("s_waitcnt vmcnt(0)" ::: "memory");
                    const unsigned old = __hip_atomic_fetch_add(cnt + bh, 1u, __ATOMIC_RELAXED, __HIP_MEMORY_SCOPE_AGENT);
                    if (old == 3u) { __builtin_amdgcn_fence(__ATOMIC_ACQUIRE, "agent"); asm volatile("s_waitcnt vmcnt(0)" ::: "memory"); }
                    MISC[1] = old; }
    __syncthreads();
    const bool last = MISC[1] == 3u;
    if (last && wid == 0) {
        const float* pp = PART + (size_t)(bh * 4) * 2 * (66 * 64) + lane;
        float e0[4], e1[4], L0 = 0.f, L1 = 0.f;
        { float m0[4], m1[4], M0 = -1e30f, M1 = -1e30f;
#pragma unroll
          for (int q = 0; q < 4; ++q) { m0[q] = pp[(size_t)(q * 2) * (66 * 64) + 64 * 64]; m1[q] = pp[(size_t)(q * 2 + 1) * (66 * 64) + 64 * 64]; M0 = fmaxf(M0, m0[q]); M1 = fmaxf(M1, m1[q]); }
#pragma unroll
          for (int q = 0; q < 4; ++q) { e0[q] = __builtin_amdgcn_exp2f((m0[q] - M0) * C64); e1[q] = __builtin_amdgcn_exp2f((m1[q] - M1) * C64);
              L0 += e0[q] * pp[(size_t)(q * 2) * (66 * 64) + 65 * 64]; L1 += e1[q] * pp[(size_t)(q * 2 + 1) * (66 * 64) + 65 * 64]; } }
        const float i0 = 1.f / L0, i1 = lam / L1;
#pragma unroll
        for (int q = 0; q < 4; ++q) { e0[q] *= i0; e1[q] *= i1; }
        float ss = 0.f;
#pragma unroll
        for (int d = 0; d < 4; ++d)
#pragma unroll
            for (int r = 0; r < 16; ++r) { float od = 0.f;
#pragma unroll
                for (int q = 0; q < 4; ++q) od += e0[q] * pp[(size_t)(q * 2) * (66 * 64) + (d * 16 + r) * 64] - e1[q] * pp[(size_t)(q * 2 + 1) * (66 * 64) + (d * 16 + r) * 64];
                o[d][r] = od; ss += od * od; }
        ss += __shfl_xor(ss, 32);
        const float rms = rsqrtf(ss * (1.f / 128.f) + 1e-5f) * 0.8f;
        if (r32 < 16) {
            const bf16_t* gate = PA + row * NA + 1536 + h * 128; bf16_t* out = MIX + row * DM + h * 128;
#pragma unroll
            for (int d = 0; d < 4; ++d)
#pragma unroll
                for (int g = 0; g < 4; ++g) { const int dv = 32 * d + 8 * g + 4 * hi;
                    const f32x4 gn = *(const f32x4*)(gnorm + dv); const u32x2 gt = *(const u32x2*)(gate + dv);
                    f32x4 v; v.x = o[d][4 * g] * rms * gn.x * silu(bflo(gt.x)); v.y = o[d][4 * g + 1] * rms * gn.y * silu(bfhi(gt.x));
                    v.z = o[d][4 * g + 2] * rms * gn.z * silu(bflo(gt.y)); v.w = o[d][4 * g + 3] * rms * gn.w * silu(bfhi(gt.y));
                    st_bf4(out + dv, v); }
        }
    }
    __syncthreads();
}
__device__ __forceinline__ void mem_unit(const Ctx& cx, bool samp, int b, int h, int qb, const bf16_t* P, int ldp, int qcol, int gcol,
                                         const bf16_t* Kb, const bf16_t* Vb, long ldk, bf16_t* MIX) {
    long row; bool valid; int wNT;
    if (!samp) { row = (long)b * 4096 + qb * 256 + cx.wid * 32 + cx.r32; valid = true; wNT = 4; }
    else { row = NP + b * 16 + (cx.r32 < 15 ? cx.r32 : 15); valid = (cx.wid == 0) && cx.r32 < 16; wNT = (cx.wid == 0) ? 4 : 0; }
    const bf16_t* qptr = P + (size_t)row * ldp + qcol + h * 128 + cx.hi * 8;
    f32x16 o[4]; float m, l;
    attn_core<8, false>(cx.lds, Kb, ldk, Vb, ldk, 4, 256, qptr, wNT, 0, 0, C128, THR128, o, m, l);
    const float inv = l > 0.f ? 1.f / l : 0.f;
    if (valid) store_gated<4>(o, inv, P + (size_t)row * ldp + gcol + h * 128, MIX + (size_t)row * DM + 512 + h * 128, cx.hi);
}
__device__ __forceinline__ void swa_unit(const Ctx& cx, bool samp, int b, int c, int half, const bf16_t* PB, const bf16_t* KSW, const bf16_t* VSW, bf16_t* MIX, const float* sinks) {
    const int head = cx.wid, kv = cx.wid >> 2;
    long row; bool valid; int NT, nkeys; const bf16_t* Kb; const bf16_t* Vb; long ldk;
    if (!samp) { row = (long)b * 4096 + c * 64 + half * 32 + cx.r32; valid = true; const int c0 = c > 2 ? c - 2 : 0; NT = c - c0 + 1; nkeys = NT * 64;
                 Kb = PB + ((size_t)b * 4096 + c0 * 64) * NB + 2048; Vb = Kb + 128; ldk = NB; }
    else { row = NP + b * 16 + (cx.r32 < 15 ? cx.r32 : 15); valid = cx.r32 < 16; NT = 3; nkeys = 144;
           Kb = KSW + (size_t)b * SWROWS * 128; Vb = VSW + (size_t)b * SWROWS * 128; ldk = 128; }
    const bf16_t* qptr = PB + (size_t)row * NB + head * 64 + cx.hi * 8;
    f32x16 o[4]; float m, l;
    attn_core_pipe<true>(cx.lds, Kb, ldk, Vb, ldk, NT, nkeys, qptr, NT, kv * 128, kv, C64, THR64, o, m, l);
    const float lt = l + __builtin_amdgcn_exp2f(sinks[head] * LOG2E - m * C64);
    const float inv = 1.f / lt;
    if (valid) store_gated<2>(o, inv, PB + (size_t)row * NB + 512 + head * 64, MIX + (size_t)row * DM + head * 64, cx.hi);
}
#undef KSWZ
#undef SBAR
}

__device__ __forceinline__ float wave_sum(float v) {
#pragma unroll
    for (int o = 1; o < 64; o <<= 1) v += __shfl_xor(v, o);
    return v;
}
__device__ __forceinline__ void p0_transpose_item(const float* W, int K, int N, bf16_t* WT, int row_off, LAS float* scr, int item, int lane) {
    const int nblk = N / 32, kb = item / nblk, nb = item % nblk, k0 = 64 * kb, n0 = 32 * nb;
#pragma unroll 8
    for (int i = 0; i < 32; ++i) { const int kk = 2 * i + (lane >> 5); scr[kk * 33 + (lane & 31)] = __builtin_nontemporal_load(W + (size_t)(k0 + kk) * N + n0 + (lane & 31)); }
    asm volatile("s_waitcnt lgkmcnt(0)" ::: "memory");
    const int c = lane & 7;
#pragma unroll
    for (int j = 0; j < 4; ++j) { const int n = (lane >> 3) + 8 * j; const LAS float* s = scr + (8 * c) * 33 + n;
        u32x4 o; o.x = cvtpk(s[0 * 33], s[1 * 33]); o.y = cvtpk(s[2 * 33], s[3 * 33]); o.z = cvtpk(s[4 * 33], s[5 * 33]); o.w = cvtpk(s[6 * 33], s[7 * 33]);
        *(u32x4*)(WT + (size_t)(row_off + n0 + n) * K + k0 + 8 * c) = o; }
    asm volatile("s_waitcnt lgkmcnt(0)" ::: "memory");
}
__device__ __forceinline__ void p0_transpose_item_ln(const float* W, int K, int N, bf16_t* WT, int row_off, LAS float* scr, int item, int lane, const float* g, const float* b, float* CS, float* BW) {
    const int nblk = N / 32, kb = item / nblk, nb = item % nblk, k0 = 64 * kb, n0 = 32 * nb;
    float csp = 0.f, bwp = 0.f;
#pragma unroll 8
    for (int i = 0; i < 32; ++i) { const int kk = 2 * i + (lane >> 5); const float w = __builtin_nontemporal_load(W + (size_t)(k0 + kk) * N + n0 + (lane & 31)); const float gw = g[k0 + kk] * w;
        scr[kk * 33 + (lane & 31)] = gw; csp += bflo(cvtpk(gw, 0.f)); bwp += b[k0 + kk] * w; }
    csp += __shfl_xor(csp, 32); bwp += __shfl_xor(bwp, 32);
    if (lane < 32) { atomicAdd(CS + row_off + n0 + lane, csp); atomicAdd(BW + row_off + n0 + lane, bwp); }
    asm volatile("s_waitcnt lgkmcnt(0)" ::: "memory");
    const int c = lane & 7;
#pragma unroll
    for (int j = 0; j < 4; ++j) { const int n = (lane >> 3) + 8 * j; const LAS float* sp = scr + (8 * c) * 33 + n;
        u32x4 o; o.x = cvtpk(sp[0 * 33], sp[1 * 33]); o.y = cvtpk(sp[2 * 33], sp[3 * 33]); o.z = cvtpk(sp[4 * 33], sp[5 * 33]); o.w = cvtpk(sp[6 * 33], sp[7 * 33]);
        *(u32x4*)(WT + (size_t)(row_off + n0 + n) * K + k0 + 8 * c) = o; }
    asm volatile("s_waitcnt lgkmcnt(0)" ::: "memory");
}
__device__ __forceinline__ void ln_rows(const float* zin, float* fout, bf16_t* bout, const float* g, const float* bta, int gw, int NGW, int lane) {
    f32x4 g4[4], b4[4];
#pragma unroll
    for (int j = 0; j < 4; ++j) { g4[j] = *(const f32x4*)(g + 4 * lane + 256 * j); b4[j] = *(const f32x4*)(bta + 4 * lane + 256 * j); }
    for (int m = gw; m < MA; m += NGW) {
        const float* zr = zin + (size_t)m * DM + 4 * lane;
        f32x4 v[4]; float s = 0.f;
#pragma unroll
        for (int j = 0; j < 4; ++j) { v[j] = *(const f32x4*)(zr + 256 * j); s += (v[j].x + v[j].y) + (v[j].z + v[j].w); }
        const float mean = wave_sum(s) * (1.f / DM); float s2 = 0.f;
#pragma unroll
        for (int j = 0; j < 4; ++j) { v[j] = v[j] - mean; s2 += (v[j].x * v[j].x + v[j].y * v[j].y) + (v[j].z * v[j].z + v[j].w * v[j].w); }
        const float rstd = rsqrtf(wave_sum(s2) * (1.f / DM) + 1e-5f);
#pragma unroll
        for (int j = 0; j < 4; ++j) { const f32x4 y = v[j] * rstd * g4[j] + b4[j];
            *(f32x4*)(fout + (size_t)m * DM + 4 * lane + 256 * j) = y;
            if (bout) st_bf4(bout + (size_t)m * DM + 4 * lane + 256 * j, y); }
    }
}

#define XB_TMO      128
#define XB_XCNT(j)  (256  + 64 * (j))
#define XB_XSUB(j)  (1280 + 64 * (j))
#define XB_XGEN(j)  (2304 + 64 * (j))
#define XB_TOP      3328
#define XB_TOPGEN   3392
#define XCD_BAR_WORDS 3456
#define XB_SPIN_CAP (1u << 18)

__device__ __forceinline__ unsigned xb_ld(unsigned* p)              { return __hip_atomic_load(p, __ATOMIC_RELAXED, __HIP_MEMORY_SCOPE_AGENT); }
__device__ __forceinline__ unsigned xb_add(unsigned* p, unsigned v) { return __hip_atomic_fetch_add(p, v, __ATOMIC_RELAXED, __HIP_MEMORY_SCOPE_AGENT); }
__device__ __forceinline__ unsigned xb_xcc_id() { return (unsigned)__builtin_amdgcn_s_getreg((3 << 11) | 20) & 0xFu; }
#define XB_SPIN(cond, bar) do { unsigned _sp = 0; while (cond) { __builtin_amdgcn_s_sleep(1); \
    if ((++_sp & 255u) == 0u) { if (xb_ld(&(bar)[XB_TMO])) break; if (_sp > XB_SPIN_CAP) { atomicAdd(&(bar)[XB_TMO], 1u); break; } } } } while (0)

struct XcdBarrier {
    unsigned* bar; unsigned x;
    volatile LAS unsigned* st;
};

__device__ __forceinline__ XcdBarrier xcd_barrier_post(unsigned* bar, volatile LAS unsigned* st) {
    XcdBarrier b; b.bar = bar; b.x = xb_xcc_id(); b.st = st;
    if (threadIdx.x == 0) (void)xb_add(&bar[XB_XCNT(b.x)], 1u);
    return b;
}
__device__ __forceinline__ void xcd_barrier_complete(unsigned* bar, unsigned x, unsigned& nloc, unsigned& nx) {
    const unsigned G = gridDim.x * gridDim.y * gridDim.z;
    unsigned sum, cnt, mine, sp = 0u;
    for (;;) {
        sum = 0u; cnt = 0u; mine = 0u;
#pragma unroll
        for (unsigned j = 0; j < 16; ++j) { const unsigned c = xb_ld(&bar[XB_XCNT(j)]); sum += c; cnt += (c > 0u) ? 1u : 0u; mine = (j == x) ? c : mine; }
        if (sum == G) break;
        __builtin_amdgcn_s_sleep(1);
        if ((++sp & 255u) == 0u) { if (xb_ld(&bar[XB_TMO])) break; if (sp > XB_SPIN_CAP) { atomicAdd(&bar[XB_TMO], 1u); break; } }
    }
    nloc = mine > 0u ? mine : 1u; nx = cnt > 0u ? cnt : 1u;
}

__device__ __forceinline__ void xcd_barrier(const XcdBarrier& b) {
    asm volatile("s_waitcnt vmcnt(0)" ::: "memory");
    __syncthreads();
    if (threadIdx.x == 0) {
        unsigned* bar = b.bar;
        __builtin_amdgcn_s_waitcnt(0);
        unsigned nloc = b.st[0], nx = b.st[1];
        if (nloc == 0u) { xcd_barrier_complete(bar, b.x, nloc, nx); b.st[0] = nloc; b.st[1] = nx; }
        const unsigned old = xb_add(&bar[XB_XSUB(b.x)], 1u);
        const unsigned gen = old / nloc;
        if (old + 1u == (gen + 1u) * nloc) {
            __builtin_amdgcn_fence(__ATOMIC_RELEASE, "agent");
            asm volatile("s_waitcnt vmcnt(0)" ::: "memory");
            const unsigned og = xb_add(&bar[XB_TOP], 1u);
            const unsigned tg = og / nx;
            if (og + 1u == (tg + 1u) * nx) xb_add(&bar[XB_TOPGEN], 1u);
            else XB_SPIN(xb_ld(&bar[XB_TOPGEN]) == tg, bar);
            __builtin_amdgcn_fence(__ATOMIC_ACQUIRE, "agent");
            xb_add(&bar[XB_XGEN(b.x)], 1u);
            asm volatile("s_waitcnt vmcnt(0)" ::: "memory");
        } else {
            XB_SPIN(xb_ld(&bar[XB_XGEN(b.x)]) == gen, bar);
            __builtin_amdgcn_fence(__ATOMIC_ACQUIRE, "agent");
            asm volatile("s_waitcnt vmcnt(0)" ::: "memory");
        }
    }
    __syncthreads();
}

struct Args { const float* in[22]; float* out; unsigned char* ws; int ph_lo, ph_hi, rep, pad; };
constexpr int NWAVES = 8, NPHASE = 9;

__global__ void __launch_bounds__(NWAVES * 64, 2) yoco_fwd(Args a) {
    extern __shared__ __attribute__((aligned(16))) unsigned char lds_raw[];
    LAS unsigned char* lds = (LAS unsigned char*)lds_raw;
    volatile LAS unsigned* MISC = (volatile LAS unsigned*)(lds + LDS_RING);
    cg::grid_group grid = cg::this_grid();
    const int tid = threadIdx.x, lane = tid & 63, wave = __builtin_amdgcn_readfirstlane(tid >> 6);
    const int G = gridDim.x, gw = blockIdx.x * NWAVES + wave, NGW = G * NWAVES;
    const long gtid = (long)blockIdx.x * (NWAVES * 64) + tid, NTHR = (long)G * (NWAVES * 64);
    unsigned char* ws = a.ws; float* dout = a.out;
    unsigned* ctl = (unsigned*)(ws + WS_CTL);
    float* ROPE = (float*)(ws + WS_ROPE);
    float* CSV = (float*)(ws + 32768); float* BWV = (float*)(ws + 49152); float* ST0 = (float*)(ws + 262144); float* ST1 = (float*)(ws + 524288);
    bf16_t* WA_t = (bf16_t*)(ws + WS_WA); bf16_t* WB_t = (bf16_t*)(ws + WS_WB); bf16_t* WM_t = (bf16_t*)(ws + WS_WM); bf16_t* WO_t = (bf16_t*)(ws + WS_WO);
    bf16_t* MEMB = (bf16_t*)(ws + WS_MEMB); bf16_t* MKV = (bf16_t*)(ws + WS_MKV); bf16_t* CMK = (bf16_t*)(ws + WS_CMK); bf16_t* CMV = (bf16_t*)(ws + WS_CMV);
    bf16_t* KSW = (bf16_t*)(ws + WS_KSW); bf16_t* VSW = (bf16_t*)(ws + WS_VSW); bf16_t* XA = (bf16_t*)(ws + WS_XA); bf16_t* ZB = XA;
    bf16_t* MIX = (bf16_t*)(ws + WS_MIX); bf16_t* Z1B = (bf16_t*)(ws + WS_Z0); bf16_t* PA = (bf16_t*)(ws + WS_PA); bf16_t* PB = PA;
    bf16_t* KS = (bf16_t*)(ws + WS_KS); bf16_t* VS = (bf16_t*)(ws + WS_VS);
    const int lo = a.ph_lo, hi_ph = a.ph_hi;
#define IN(k) (lo <= (k) && (k) < hi_ph)
    if (tid < 64) MISC[tid] = 0u;
    __syncthreads();
    XcdBarrier xbar = xcd_barrier_post(ctl + 1024, MISC + 8);
    if (a.ph_lo > 1000) grid.sync();
#define SEAM(k) do { if (IN(k) && IN((k) + 1)) xcd_barrier(xbar); } while (0)
    att::Ctx cx; cx.lds = lds; cx.lane = lane; cx.wid = wave; cx.r32 = lane & 31; cx.hi = lane >> 5;

    if (IN(0)) {
        LAS float* scr = (LAS float*)(lds + wave * 16384);
        for (int it = gw; it < 4736; it += NGW) {
            int r = it;
            if (r < 1536) { p0_transpose_item(a.in[9], DM, NA, WA_t, 0, scr, r, lane); continue; } r -= 1536;
            if (r < 1024) { p0_transpose_item_ln(a.in[15], DM, 2048, WB_t, 0, scr, r, lane, a.in[20], a.in[21], CSV, BWV); continue; } r -= 1024;
            if (r < 128) { p0_transpose_item_ln(a.in[17], DM, 256, WB_t, 2048, scr, r, lane, a.in[20], a.in[21], CSV, BWV); continue; } r -= 128;
            if (r < 1024) { const int l = r >> 9; p0_transpose_item(a.in[18] + (size_t)l * DM * DM, DM, DM, WM_t, l * 1024, scr, r & 511, lane); continue; } r -= 1024;
            { const int l = r >> 9; p0_transpose_item(a.in[19] + (size_t)l * DM * DM, DM, DM, WO_t, l * 1024, scr, r & 511, lane); }
        }
        for (long i = gtid; i < 2097152; i += NTHR) cvt8(a.in[0] + i * 8, XA + i * 8);
        for (long i = gtid; i < 32768; i += NTHR) cvt8(a.in[1] + i * 8, XA + (size_t)NP * DM + i * 8);
        for (long i = gtid; i < 131072; i += NTHR) cvt8(a.in[2] + i * 8, MEMB + i * 8);
        for (long i = gtid; i < 524288; i += NTHR) { cvt8(a.in[7] + i * 8, CMK + i * 8); cvt8(a.in[8] + i * 8, CMV + i * 8); }
        for (long i = gtid; i < 32768; i += NTHR) { const long b = i >> 11, r = i & 2047; const size_t d = (size_t)b * SWROWS * 128 + r * 8;
            cvt8(a.in[5] + i * 8, KSW + d); cvt8(a.in[6] + i * 8, VSW + d);
            const int rw = (int)(r >> 4);
            if (rw >= 16) { const size_t od = ((size_t)b * 128 + rw - 16) * 128 + (r & 15) * 8;
                *(f32x4*)(dout + OFF_SKS + od) = *(const f32x4*)(a.in[5] + i * 8); *(f32x4*)(dout + OFF_SKS + od + 4) = *(const f32x4*)(a.in[5] + i * 8 + 4);
                *(f32x4*)(dout + OFF_SVS + od) = *(const f32x4*)(a.in[6] + i * 8); *(f32x4*)(dout + OFF_SVS + od + 4) = *(const f32x4*)(a.in[6] + i * 8 + 4); } }
        for (long i = gtid; i < 49152; i += NTHR) { const long b = i / 3072, r = i % 3072; const size_t d = ((size_t)b * KSROWS + 4112) * 512 + r * 8;
            *(u32x4*)(KS + d) = (u32x4){0u, 0u, 0u, 0u}; *(u32x4*)(VS + d) = (u32x4){0u, 0u, 0u, 0u}; }
        for (long i = gtid; i < 12288; i += NTHR) { const long b = i / 768, r = i % 768; const size_t d = ((size_t)b * SWROWS + 144) * 128 + r * 8;
            *(u32x4*)(KSW + d) = (u32x4){0u, 0u, 0u, 0u}; *(u32x4*)(VSW + d) = (u32x4){0u, 0u, 0u, 0u}; }
        for (long i = gtid; i < 4112 * 8; i += NTHR) { const int pos = (int)(i >> 3), fi = (int)(i & 7);
            const double inv = fi == 0 ? 1.0 : fi == 1 ? 0.19392274474868576 : fi == 2 ? 0.03760603093086393 : fi == 3 ? 0.007292664737217109 :
                               fi == 4 ? 0.001414213562373095 : fi == 5 ? 0.0002742481756762073 : fi == 6 ? 5.318295896944988e-05 : 1.031338537721246e-05;
            const double rev = (double)pos * inv * 0.15915494309189535; const float fr = (float)(rev - __builtin_rint(rev));
            ROPE[i * 2] = __builtin_amdgcn_cosf(fr); ROPE[i * 2 + 1] = __builtin_amdgcn_sinf(fr); }
    }
    SEAM(0);
    if (IN(1)) {
        pg8::Gemm g{XA, WA_t, NP, NA, DM}; pg8::StaticOrder S; S.init(NP, NA, G, (int)blockIdx.x);
        EpiWrap<EpiAF> E{{PA, dout, KS, VS, ROPE, 0.f, 0.f}, 0, 0};
        pg8::gemm_phase<EpiWrap<EpiAF>, pg8::StaticOrder, true, true>(lds, g, S, E);
    }
    SEAM(1);
    if (IN(2)) {
        float s1 = 0.f, s2 = 0.f;
        for (int i = 0; i < 64; ++i) { s1 += a.in[10][i] * a.in[11][i]; s2 += a.in[12][i] * a.in[13][i]; }
        if (tid == 0) MISC[2] = __float_as_uint(__expf(s1) - __expf(s2) + 0.2f);
        __syncthreads();
        unsigned* gdone = ctl + 256 + 64 * a.rep;
        if (blockIdx.x < 44) {
            if (blockIdx.x < 32) { pg8::Gemm g{MEMB, WM_t, 1024, 2048, DM}; pg8::StaticOrder S; S.init(1024, 2048, 32, (int)blockIdx.x);
                EpiWrap<EpiMemF> E{{MKV, dout, 0.f, 0.f}, 0, 0};
                pg8::gemm_phase<EpiWrap<EpiMemF>, pg8::StaticOrder, true, true>(lds, g, S, E); }
            else { pg8::Gemm g{XA + (size_t)NP * DM, WA_t, 256, NA, DM}; pg8::StaticOrder S; S.init(256, NA, 12, (int)blockIdx.x - 32);
                EpiWrap<EpiAF> E{{PA, dout, KS, VS, ROPE, 0.f, 0.f}, NP, 0};
                pg8::gemm_phase<EpiWrap<EpiAF>, pg8::StaticOrder, true, true>(lds, g, S, E); }
            asm volatile("s_waitcnt vmcnt(0)" ::: "memory"); __syncthreads();
            if (tid == 0) { __builtin_amdgcn_fence(__ATOMIC_RELEASE, "agent"); asm volatile("s_waitcnt vmcnt(0)" ::: "memory");
                            __hip_atomic_fetch_add(gdone, 1u, __ATOMIC_RELAXED, __HIP_MEMORY_SCOPE_AGENT); }
        }
        bool ready = false;
        float* PART = (float*)(ws + WS_Z0 + 40 * MiB + (size_t)a.rep * (10 * MiB));
        for (;;) {
            if (tid == 0) MISC[0] = atomicAdd(ctl + 128 * a.rep, 1u);
            __syncthreads(); const unsigned u = MISC[0]; __syncthreads();
            if (u >= 1088u) break;
            const bool needs = (u >= 256u && u < 512u) || u >= 768u;
            if (needs && !ready) {
                if (tid == 0) { unsigned sp = 0; while (__hip_atomic_load(gdone, __ATOMIC_RELAXED, __HIP_MEMORY_SCOPE_AGENT) < 44u && ++sp < (1u << 24)) __builtin_amdgcn_s_sleep(8);
                                __builtin_amdgcn_fence(__ATOMIC_ACQUIRE, "agent"); asm volatile("s_waitcnt vmcnt(0)" ::: "memory"); }
                __syncthreads(); ready = true;
            }
            if (u < 768u) {
                const float lam = __uint_as_float(MISC[2]);
                if (u >= 256u && u < 512u) { const unsigned v = u - 256u;
                    att::diff_sample_item(cx, (int)(v >> 4), (int)((v >> 2) & 3u), (int)(v & 3u), a.in[3], a.in[4], PA, KS, VS, MIX, a.in[14], lam, PART, ctl + 512 + 64 * a.rep, MISC); }
                else { const unsigned v = u < 256u ? u : u - 256u;
                    att::diff_unit(cx, false, (int)((v & 15u) >> 2), (int)(v & 3u), 31 - (int)(v >> 4), PA, KS, VS, MIX, a.in[14], lam); } }
            else { const bool samp = u >= 1024u; const unsigned v = samp ? u - 1024u : u - 768u;
                const int b = samp ? (int)(v >> 2) : (int)(v >> 6), h = samp ? (int)(v & 3u) : (int)((v >> 4) & 3u), qb = samp ? 0 : (int)(v & 15u);
                const bf16_t* Kb = samp ? CMK + ((size_t)b * 256) * 512 + h * 128 : MKV + ((size_t)b * 256) * 2048 + h * 128;
                const bf16_t* Vb = samp ? CMV + ((size_t)b * 256) * 512 + h * 128 : Kb + 512;
                att::mem_unit(cx, samp, b, h, qb, PA, NA, 2048, 2560, Kb, Vb, samp ? 512 : 2048, MIX); }
        }
    }
    SEAM(2);
    if (IN(3)) {
        EpiMerge0F F0{ZB, ST0, 0.f, 0.f};
        { pg8::Gemm g{MIX, WO_t, NP, DM, DM}; pg8::StaticOrder S; S.init(NP, DM, G, (int)blockIdx.x);
          EpiWrap<EpiMerge0F> E{F0, 0, 0};
          pg8::gemm_phase<EpiWrap<EpiMerge0F>, pg8::StaticOrder, true, true>(lds, g, S, E); }
        gemm_small<EpiMerge0F>(lds, MIX + (size_t)NP * DM, WO_t, DM, NP, (int)blockIdx.x, G, F0);
    }
    SEAM(3);
    if (IN(5)) {
        EpiBF FB{PB, dout, KSW, VSW, ROPE, ST0, CSV, BWV, 0.f, 0.f, {0.f, 0.f}, {0.f, 0.f}};
        { pg8::Gemm g{ZB, WB_t, NP, 2048, DM}; pg8::StaticOrder S; S.init(NP, 2048, G, (int)blockIdx.x);
          EpiWrap<EpiBF> E{FB, 0, 0};
          pg8::gemm_phase<EpiWrap<EpiBF>, pg8::StaticOrder, true, true>(lds, g, S, E); }
    }
    SEAM(5);
    if (IN(6)) {
        unsigned* gdone = ctl + 384 + 64 * a.rep;
        {
            EpiBF FB{PB, dout, KSW, VSW, ROPE, ST0, CSV, BWV, 0.f, 0.f, {0.f, 0.f}, {0.f, 0.f}};
            if (blockIdx.x < 64) { pg8::Gemm g{ZB, WB_t + (size_t)2048 * DM, NP, 256, DM}; pg8::StaticOrder S; S.init(NP, 256, 64, (int)blockIdx.x);
                EpiWrap<EpiBF> E{FB, 0, 2048};
                pg8::gemm_phase<EpiWrap<EpiBF>, pg8::StaticOrder, true, true>(lds, g, S, E); }
            else { gemm_small<EpiBF>(lds, ZB + (size_t)NP * DM, WB_t, 2048, NP, (int)blockIdx.x - 64, 192, FB);
                   if (blockIdx.x >= 192) gemm_small<EpiBF>(lds, ZB + (size_t)NP * DM, WB_t + (size_t)2048 * DM, 256, NP, (int)blockIdx.x - 192, 64, FB, 2048); }
            asm volatile("s_waitcnt vmcnt(0)" ::: "memory"); __syncthreads();
            if (tid == 0) { __builtin_amdgcn_fence(__ATOMIC_RELEASE, "agent"); asm volatile("s_waitcnt vmcnt(0)" ::: "memory");
                            __hip_atomic_fetch_add(gdone + (blockIdx.x < 64 ? 0 : 16), 1u, __ATOMIC_RELAXED, __HIP_MEMORY_SCOPE_AGENT); }
        }
        bool ready1 = false, ready2 = false;
        for (;;) {
            if (tid == 0) MISC[0] = atomicAdd(ctl + 64 + 128 * a.rep, 1u);
            __syncthreads(); const unsigned u = MISC[0]; __syncthreads();
            if (u >= 848u) break;
            const bool need1 = u >= 256u && u < 768u, need2 = u >= 768u;
            if ((need1 && !ready1) || (need2 && !ready2)) {
                if (tid == 0) { unsigned sp = 0; unsigned* w = need1 ? gdone : gdone + 16; const unsigned want = need1 ? 64u : 192u;
                                while (__hip_atomic_load(w, __ATOMIC_RELAXED, __HIP_MEMORY_SCOPE_AGENT) < want && ++sp < (1u << 24)) __builtin_amdgcn_s_sleep(8);
                                __builtin_amdgcn_fence(__ATOMIC_ACQUIRE, "agent"); asm volatile("s_waitcnt vmcnt(0)" ::: "memory"); }
                __syncthreads(); if (need1) ready1 = true; else ready2 = true;
            }
            const bool is_mem = u < 256u || (u >= 768u && u < 832u);
            if (is_mem) { const bool samp = u >= 768u; const unsigned v = samp ? u - 768u : u;
                const int b = samp ? (int)(v >> 2) : (int)(v >> 6), h = samp ? (int)(v & 3u) : (int)((v >> 4) & 3u), qb = samp ? 0 : (int)(v & 15u);
                const bf16_t* Kb = samp ? CMK + ((size_t)(16 + b) * 256) * 512 + h * 128 : MKV + ((size_t)b * 256) * 2048 + 1024 + h * 128;
                const bf16_t* Vb = samp ? CMV + ((size_t)(16 + b) * 256) * 512 + h * 128 : Kb + 512;
                att::mem_unit(cx, samp, b, h, qb, PB, NB, 1024, 1536, Kb, Vb, samp ? 512 : 2048, MIX); }
            else { const bool samp = u >= 832u; const unsigned v = samp ? u - 832u : u - 256u;
                const int b = samp ? (int)v : (int)(v >> 7), c = samp ? 0 : (int)((v >> 1) & 63u), half = samp ? 0 : (int)(v & 1u);
                att::swa_unit(cx, samp, b, c, half, PB, KSW, VSW, MIX, a.in[16]); }
        }
    }
    SEAM(6);
    if (IN(7)) {
        EpiMerge1F F1{ZB, ST0, a.in[20], a.in[21], Z1B, ST1, 0.f, 0.f, {0.f, 0.f}, {0.f, 0.f}};
        { pg8::Gemm g{MIX, WO_t + (size_t)DM * DM, NP, DM, DM}; pg8::StaticOrder S; S.init(NP, DM, G, (int)blockIdx.x);
          EpiWrap<EpiMerge1F> E{F1, 0, 0};
          pg8::gemm_phase<EpiWrap<EpiMerge1F>, pg8::StaticOrder, true, true>(lds, g, S, E); }
        gemm_small<EpiMerge1F>(lds, MIX + (size_t)NP * DM, WO_t + (size_t)DM * DM, DM, NP, (int)blockIdx.x, G, F1);
    }
    SEAM(7);
    if (IN(8)) {
        const float* g1 = a.in[20] + DM; const float* b1 = a.in[21] + DM;
#pragma unroll 4
        for (long i = gtid; i < (long)MA * 256; i += NTHR) { const int row = (int)(i >> 8), c4 = (int)(i & 255) * 4;
            float mu, rstd; row_stats(ST1, row, mu, rstd);
            const u32x2 zz = __builtin_nontemporal_load((const u32x2*)(Z1B + (size_t)row * DM + c4));
            const f32x4 z = (f32x4){bflo(zz.x), bfhi(zz.x), bflo(zz.y), bfhi(zz.y)};
            __builtin_nontemporal_store((z - mu) * rstd * *(const f32x4*)(g1 + c4) + *(const f32x4*)(b1 + c4), (f32x4*)(dout + (size_t)row * DM + c4)); }
    }
#undef IN
#undef SEAM
}

#ifndef MK_N_LAUNCHES
#define MK_N_LAUNCHES 1
#endif
#ifndef PROBE_DUP
#define PROBE_DUP 0
#endif
extern "C" void kernel_launch(void* const* d_in, const int* in_sizes, int n_in, void* d_out, int out_size, void* d_ws, size_t ws_size, hipStream_t stream) {
    static int grid = 0;
    if (grid == 0) {
        if (n_in != 22 || ws_size < WS_END) { fprintf(stderr, "kernel_launch: unexpected n_in %d / ws %zu\n", n_in, ws_size); grid = -1; return; }
        int dev = 0, cus = 0, per_cu = 0;
        if (hipGetDevice(&dev) != hipSuccess || hipDeviceGetAttribute(&cus, hipDeviceAttributeMultiprocessorCount, dev) != hipSuccess) { grid = -1; return; }
        if (hipFuncSetAttribute((const void*)yoco_fwd, hipFuncAttributeMaxDynamicSharedMemorySize, LDS_BYTES) != hipSuccess) { fprintf(stderr, "kernel_launch: hipFuncSetAttribute failed\n"); grid = -1; return; }
        if (hipOccupancyMaxActiveBlocksPerMultiprocessor(&per_cu, (const void*)yoco_fwd, NWAVES * 64, LDS_BYTES) != hipSuccess || per_cu < 1) { fprintf(stderr, "kernel_launch: occupancy query says %d\n", per_cu); per_cu = 1; }
        (void)hipGetLastError();
        grid = cus;
    }
    if (grid < 0) return;
    (void)hipMemsetAsync((char*)d_ws + WS_CTL, 0, 1048576, stream);
    Args a{};
    for (int i = 0; i < 22; ++i) a.in[i] = (const float*)d_in[i];
    a.out = (float*)d_out; a.ws = (unsigned char*)d_ws;
#if MK_N_LAUNCHES == 1
    a.ph_lo = 0; a.ph_hi = NPHASE;
    void* args[] = {&a};
    hipError_t e = hipLaunchCooperativeKernel((const void*)yoco_fwd, dim3(grid), dim3(NWAVES * 64), args, LDS_BYTES, stream);
    if (e != hipSuccess) fprintf(stderr, "kernel_launch: cooperative launch failed: %s (grid %d)\n", hipGetErrorString(e), grid);
#else
    for (int p = 0; p < NPHASE; ++p) { a.ph_lo = p; a.ph_hi = p + 1;
        for (int r = 0; r < 1 + ((PROBE_DUP >> p) & 1); ++r) { a.rep = r; hipLaunchKernelGGL(yoco_fwd, dim3(grid), dim3(NWAVES * 64), LDS_BYTES, stream, a); } }
#endif
}
```

```cpp
#include <hip/hip_runtime.h>
#include <hip/hip_cooperative_groups.h>
#include <cstdio>
#include <cstdint>
namespace cg = cooperative_groups;
namespace pg8 {
#define PG8_LAS __attribute__((address_space(3)))
typedef unsigned short bf16_t;
typedef short bf16x8 __attribute__((ext_vector_type(8)));
typedef float f32x4 __attribute__((ext_vector_type(4)));
typedef unsigned u32x4 __attribute__((ext_vector_type(4)));
constexpr int BM = 256, BK = 64, HALF = 128, HTB = HALF * BK * 2  , STAGE_BYTES = 8 * HTB, NXCD = 8, WGM = 8;

__host__ __device__ __forceinline__ int lds_byte(int r, int c) { const int st = (r >> 4) * 2 + (c >> 5), rr = r & 15, cc = c & 31, ob = rr * 64 + cc * 2; return st * 1024 + (ob ^ (((ob >> 9) & 1) << 5)); }
__host__ __device__ __forceinline__ void stage_rc(int b, int& R, int& C) { const int st = b / 1024, sb = b % 1024, swz = sb ^ (((sb >> 9) & 1) << 5); R = (st >> 1) * 16 + swz / 64; C = (st & 1) * 32 + (swz % 64) / 2; }
__host__ __device__ __forceinline__ int perm32(int rho) { const int n = rho >> 4, i = rho & 15; return 8 * (i >> 2) + 4 * n + (i & 3); }

struct Unit { int pm, pn; };
struct Gemm { const bf16_t* A; const bf16_t* Bt; int M, N, K; };

struct StaticOrder {
    int nM, nN, nwg, G, c;
    __host__ __device__ void init(int M, int N, int G_, int c_) { nM = M / BM; nN = N / BM; nwg = nM * nN; G = G_; c = c_; }
    __host__ __device__ bool next(int i, Unit& u) const {
        const long L = (long)i * G + c; if (L >= nwg) return false;
        int wgid = (int)L; { const int q = nwg / NXCD, r = nwg % NXCD, xcd = wgid % NXCD, off = wgid / NXCD; wgid = (xcd < r ? xcd * (q + 1) : r * (q + 1) + (xcd - r) * q) + off; }
        const int nig = WGM * nN, gid = wgid / nig, fm = gid * WGM, gsz = (nM - fm) < WGM ? (nM - fm) : WGM;
        u.pm = fm + ((wgid % nig) % gsz); u.pn = (wgid % nig) / gsz; return true;
    }
    __device__ __forceinline__ void a_ready(const Unit&) const {}
    __device__ __forceinline__ void done(const Unit&) const {}
};
__device__ __forceinline__ unsigned cvt_pk_bf16(float lo, float hi) { unsigned r; asm volatile("v_cvt_pk_bf16_f32 %0, %1, %2" : "=v"(r) : "v"(lo), "v"(hi)); return r; }
typedef float f32x2 __attribute__((ext_vector_type(2)));
template <class Epi, class Sched, bool ALIGN_EPI = false, bool SP2 = false>
__device__ __forceinline__ void gemm_phase(PG8_LAS unsigned char* lds, const Gemm g, const Sched& S, const Epi& E) {
    const int tid = threadIdx.x, wid = __builtin_amdgcn_readfirstlane(tid >> 6), lane = tid & 63, wr = wid >> 2, wc = wid & 3, fr = lane & 15, fq = lane >> 4;
    const int K = g.K, nt = K / BK;
    unsigned voffA[2], voffB[2];
#pragma unroll
    for (int i = 0; i < 2; ++i) { int R, C; stage_rc(tid * 16 + i * 8192, R, C); const int Rb = Epi::PERM ? ((R & ~31) + perm32(R & 31)) : R;
        voffA[i] = (unsigned)(R * K + C) * 2u; voffB[i] = (unsigned)(Rb * K + C) * 2u; }
    const size_t kstep = (size_t)(BK * 2);
    const size_t hstep = (size_t)HALF * K * 2;
    const size_t tstep = 2 * hstep;
    const unsigned ldsw = (unsigned)wid * 1024u;
    const int aoff = lds_byte(wr * 64 + fr, fq * 8), boff = lds_byte(wc * 32 + fr, fq * 8);
#define PG8_SA(b, h) (((b) * 2 + (h)) * HTB)
#define PG8_SB(b, h) ((4 + (b) * 2 + (h)) * HTB)
#define PG8_STAGE(bufoff, gbase, voff) do { _Pragma("unroll") for (int _i = 0; _i < 2; ++_i) \
        __builtin_amdgcn_global_load_lds((const unsigned*)((const char*)(gbase) + (voff)[_i]), (PG8_LAS unsigned*)(lds + (bufoff) + ldsw + _i * 8192), 16, 0, 0); } while (0)
#define PG8_LDA(dst, b, h) do { _Pragma("unroll") for (int m = 0; m < 4; ++m) _Pragma("unroll") for (int k = 0; k < 2; ++k) dst[m][k] = *(const PG8_LAS bf16x8*)(lds + PG8_SA(b, h) + aoff + m * 2048 + k * 1024); } while (0)
#define PG8_LDB(dst, b, h) do { _Pragma("unroll") for (int n = 0; n < 2; ++n) _Pragma("unroll") for (int k = 0; k < 2; ++k) dst[n][k] = *(const PG8_LAS bf16x8*)(lds + PG8_SB(b, h) + boff + n * 2048 + k * 1024); } while (0)
#define PG8_MMA(ai, bj, At, Bt) do { __builtin_amdgcn_s_setprio(1); _Pragma("unroll") for (int m = 0; m < 4; ++m) _Pragma("unroll") for (int n = 0; n < 2; ++n) _Pragma("unroll") for (int k = 0; k < 2; ++k) \
        acc[ai][bj][m][n] = __builtin_amdgcn_mfma_f32_16x16x32_bf16(Bt[n][k], At[m][k], acc[ai][bj][m][n], 0, 0, 0); __builtin_amdgcn_s_setprio(0); } while (0)
#define PG8_WAIT_V(n) asm volatile("s_waitcnt vmcnt(" #n ")" ::: "memory")
#define PG8_WAIT_L(n) asm volatile("s_waitcnt lgkmcnt(" #n ")" ::: "memory")
#define PG8_BAR __builtin_amdgcn_s_barrier()
#define PG8_SCHED __builtin_amdgcn_sched_barrier(0)
    Unit cur, nxt; int ui = 0;
    if (!S.next(0, cur)) return;
    f32x4 acc[2][2][4][2];
#pragma unroll
    for (int a = 0; a < 2; ++a)
#pragma unroll
        for (int b = 0; b < 2; ++b)
#pragma unroll
            for (int m = 0; m < 4; ++m)
#pragma unroll
                for (int n = 0; n < 2; ++n) acc[a][b][m][n] = (f32x4){0.f, 0.f, 0.f, 0.f};
    bf16x8 At[4][2], B0[2][2], B1[2][2];
    const char* cA = (const char*)g.A + (size_t)cur.pm * tstep; const char* cB = (const char*)g.Bt + (size_t)cur.pn * tstep;
    S.a_ready(cur);
    if constexpr (SP2) {
        PG8_STAGE(PG8_SB(0, 0), cB, voffB); PG8_STAGE(PG8_SB(0, 1), cB + hstep, voffB); PG8_STAGE(PG8_SA(0, 0), cA, voffA); PG8_STAGE(PG8_SA(0, 1), cA + hstep, voffA);
        if (wr == 1) PG8_BAR;
        PG8_WAIT_V(2); PG8_BAR;
        PG8_STAGE(PG8_SB(1, 0), cB + kstep, voffB); PG8_STAGE(PG8_SA(1, 0), cA + kstep, voffA); PG8_STAGE(PG8_SB(1, 1), cB + hstep + kstep, voffB);
        PG8_WAIT_V(6); PG8_BAR;
    } else {
        PG8_STAGE(PG8_SB(0, 0), cB, voffB); PG8_STAGE(PG8_SA(0, 0), cA, voffA); PG8_STAGE(PG8_SB(0, 1), cB + hstep, voffB); PG8_STAGE(PG8_SA(0, 1), cA + hstep, voffA);
        if (wr == 1) PG8_BAR;
        PG8_WAIT_V(4); PG8_BAR;
        PG8_STAGE(PG8_SB(1, 0), cB + kstep, voffB); PG8_STAGE(PG8_SA(1, 0), cA + kstep, voffA); PG8_STAGE(PG8_SB(1, 1), cB + hstep + kstep, voffB);
        PG8_WAIT_V(6); PG8_BAR;
    }
    for (;;) {
        const bool has_next = S.next(ui + 1, nxt);
        const char* nA = has_next ? (const char*)g.A + (size_t)nxt.pm * tstep : cA; const char* nB = has_next ? (const char*)g.Bt + (size_t)nxt.pn * tstep : cB;
        for (int t = 0; t < nt; t += 2) {
            const bool last = (t == nt - 2);
            const char* a1 = cA + (size_t)(t + 1) * kstep;
            const char* a2 = last ? nA : cA + (size_t)(t + 2) * kstep; const char* b2 = last ? nB : cB + (size_t)(t + 2) * kstep;
            const char* a3 = a2 + kstep; const char* b3 = b2 + kstep;
            if (last && has_next) S.a_ready(nxt);
            if constexpr (SP2) {
            PG8_LDB(B0, 0, 0); PG8_LDB(B1, 0, 1); PG8_SCHED; PG8_LDA(At, 0, 0); PG8_STAGE(PG8_SA(1, 1), a1 + hstep, voffA);
            PG8_WAIT_V(8); PG8_WAIT_L(0); PG8_BAR; PG8_MMA(0, 0, At, B0); PG8_MMA(0, 1, At, B1); PG8_BAR; PG8_SCHED;
            PG8_LDA(At, 0, 1); PG8_STAGE(PG8_SB(0, 0), b2, voffB); PG8_STAGE(PG8_SB(0, 1), b2 + hstep, voffB); PG8_STAGE(PG8_SA(0, 0), a2, voffA);
            PG8_WAIT_V(8); PG8_WAIT_L(0); PG8_BAR; PG8_MMA(1, 0, At, B0); PG8_MMA(1, 1, At, B1); PG8_BAR; PG8_SCHED;
            PG8_LDB(B0, 1, 0); PG8_LDB(B1, 1, 1); PG8_SCHED; PG8_LDA(At, 1, 0); PG8_STAGE(PG8_SA(0, 1), a2 + hstep, voffA);
            PG8_WAIT_V(8); PG8_WAIT_L(0); PG8_BAR; PG8_MMA(0, 0, At, B0); PG8_MMA(0, 1, At, B1); PG8_BAR; PG8_SCHED;
            PG8_LDA(At, 1, 1); PG8_STAGE(PG8_SB(1, 0), b3, voffB); PG8_STAGE(PG8_SB(1, 1), b3 + hstep, voffB); PG8_STAGE(PG8_SA(1, 0), a3, voffA);
            PG8_WAIT_V(8); PG8_WAIT_L(0); PG8_BAR; PG8_MMA(1, 0, At, B0); PG8_MMA(1, 1, At, B1); PG8_BAR; PG8_SCHED;
            } else {
            PG8_LDB(B0, 0, 0); PG8_SCHED; PG8_LDA(At, 0, 0); PG8_STAGE(PG8_SA(1, 1), a1 + hstep, voffA);
            PG8_WAIT_L(8); PG8_BAR; PG8_WAIT_L(0); PG8_MMA(0, 0, At, B0); PG8_BAR; PG8_SCHED;
            PG8_LDB(B1, 0, 1); PG8_STAGE(PG8_SB(0, 0), b2, voffB);
            PG8_BAR; PG8_WAIT_L(0); PG8_MMA(0, 1, At, B1); PG8_BAR;
            PG8_LDA(At, 0, 1); PG8_STAGE(PG8_SA(0, 0), a2, voffA);
            PG8_BAR; PG8_WAIT_L(0); PG8_MMA(1, 0, At, B0); PG8_BAR; PG8_SCHED;
            PG8_STAGE(PG8_SB(0, 1), b2 + hstep, voffB);
            PG8_WAIT_V(6); PG8_BAR; PG8_MMA(1, 1, At, B1); PG8_BAR;
            PG8_LDB(B0, 1, 0); PG8_SCHED; PG8_LDA(At, 1, 0); PG8_STAGE(PG8_SA(0, 1), a2 + hstep, voffA);
            PG8_WAIT_L(8); PG8_BAR; PG8_WAIT_L(0); PG8_MMA(0, 0, At, B0); PG8_BAR; PG8_SCHED;
            PG8_LDB(B1, 1, 1); PG8_STAGE(PG8_SB(1, 0), b3, voffB);
            PG8_BAR; PG8_WAIT_L(0); PG8_MMA(0, 1, At, B1); PG8_BAR;
            PG8_LDA(At, 1, 1); PG8_STAGE(PG8_SA(1, 0), a3, voffA);
            PG8_BAR; PG8_WAIT_L(0); PG8_MMA(1, 0, At, B0); PG8_BAR; PG8_SCHED;
            PG8_STAGE(PG8_SB(1, 1), b3 + hstep, voffB);
            PG8_WAIT_V(6); PG8_BAR; PG8_MMA(1, 1, At, B1); PG8_BAR;
            }
        }
        if constexpr (ALIGN_EPI) { if (wr == 0) PG8_BAR; }
        if constexpr (!Epi::AFTER_DRAIN) { E(acc, cur, wr, wc, fr, fq); S.done(cur); }
        if (!has_next) break;
#pragma unroll
        for (int a = 0; a < 2; ++a)
#pragma unroll
            for (int b = 0; b < 2; ++b)
#pragma unroll
                for (int m = 0; m < 4; ++m)
#pragma unroll
                    for (int n = 0; n < 2; ++n) acc[a][b][m][n] = (f32x4){0.f, 0.f, 0.f, 0.f};
        cur = nxt; cA = nA; cB = nB; ++ui;
        if constexpr (ALIGN_EPI) { if (wr == 1) PG8_BAR; }
    }
    PG8_WAIT_V(0);
    if constexpr (!ALIGN_EPI) { if (wr == 0) PG8_BAR; }
    PG8_BAR;
    if constexpr (Epi::AFTER_DRAIN) { E.fused(acc, cur, wr, wc, fr, fq, lds, wid, lane); S.done(cur); }
#undef PG8_SA
#undef PG8_SB
#undef PG8_STAGE
#undef PG8_LDA
#undef PG8_LDB
#undef PG8_MMA
#undef PG8_WAIT_V
#undef PG8_WAIT_L
#undef PG8_BAR
#undef PG8_SCHED
}
}

typedef unsigned short bf16_t;
typedef short bf16x8 __attribute__((ext_vector_type(8)));
typedef short s16x4 __attribute__((ext_vector_type(4)));
typedef float f32x4 __attribute__((ext_vector_type(4)));
typedef float f32x16 __attribute__((ext_vector_type(16)));
typedef unsigned u32x4 __attribute__((ext_vector_type(4)));
typedef unsigned u32x2 __attribute__((ext_vector_type(2)));
#define LAS __attribute__((address_space(3)))

constexpr int DM = 1024, NP = 16384, NS = 256, MA = NP + NS;
constexpr int NA = 3072, NB = 2304;
constexpr int KSROWS = 4160, SWROWS = 192;
constexpr float DN_ALPHA = 1.41421356237309515f;
constexpr float LOG2E = 1.4426950408889634f;
constexpr float C64 = 0.125f * LOG2E, THR64 = 64.f;
constexpr float C128 = 0.088388347648318440f * LOG2E, THR128 = 90.5f;
constexpr size_t OFF_DKP = 17039360, OFF_DVP = 25427968, OFF_DKS = 33816576, OFF_DVS = 33947648, OFF_SKP = 34078720, OFF_SVP = 34144256,
                 OFF_SKS = 34209792, OFF_SVS = 34471936, OFF_MKP = 34734080, OFF_MVP = 35782656;
constexpr size_t MiB = 1u << 20;
constexpr size_t WS_CTL = 0, WS_ROPE = 1 * MiB, WS_WA = 2 * MiB, WS_WB = 8 * MiB, WS_WM = 13 * MiB, WS_WO = 17 * MiB, WS_MEMB = 21 * MiB, WS_MKV = 23 * MiB,
                 WS_CMK = 27 * MiB, WS_CMV = 35 * MiB, WS_KSW = 43 * MiB, WS_VSW = 44 * MiB, WS_XA = 46 * MiB, WS_MIX = 79 * MiB, WS_Z0 = 112 * MiB,
                 WS_PA = 177 * MiB, WS_KS = 275 * MiB, WS_VS = 340 * MiB, WS_END = 405 * MiB;
constexpr int LDS_RING = 131072, LDS_BYTES = LDS_RING + 256;

__device__ __forceinline__ unsigned cvtpk(float lo, float hi) { unsigned r; asm volatile("v_cvt_pk_bf16_f32 %0, %1, %2" : "=v"(r) : "v"(lo), "v"(hi)); return r; }
__device__ __forceinline__ float bflo(unsigned w) { return __uint_as_float(w << 16); }
__device__ __forceinline__ float bfhi(unsigned w) { return __uint_as_float(w & 0xffff0000u); }
__device__ __forceinline__ float silu(float x) { return x * __builtin_amdgcn_rcpf(1.f + __expf(-x)); }
__device__ __forceinline__ void cvt8(const float* s, bf16_t* d) {
    const f32x4 a = __builtin_nontemporal_load((const f32x4*)s), b = __builtin_nontemporal_load((const f32x4*)(s + 4));
    u32x4 w; w.x = cvtpk(a.x, a.y); w.y = cvtpk(a.z, a.w); w.z = cvtpk(b.x, b.y); w.w = cvtpk(b.z, b.w); __builtin_nontemporal_store(w, (u32x4*)d);
}

__device__ __forceinline__ f32x4 shfl4(f32x4 v, int m) { f32x4 p; p.x = __shfl_xor(v.x, m); p.y = __shfl_xor(v.y, m); p.z = __shfl_xor(v.z, m); p.w = __shfl_xor(v.w, m); return p; }
struct NoPre {};
template <class F> struct EpiWrap {
    static constexpr bool PERM = false, AFTER_DRAIN = false;
    F f; int rowbase, colbase;
    __device__ __forceinline__ void operator()(const f32x4 (&acc)[2][2][4][2], const pg8::Unit& u, int wr, int wc, int fr, int fq) const {
        F lf = f;
#pragma unroll
        for (int ai = 0; ai < 2; ++ai)
#pragma unroll
            for (int mp = 0; mp < 2; ++mp) {
                typename F::Pre pr[2][2][2]; f32x4 vv[2][2][2];
                const int row0 = rowbase + u.pm * 256 + ai * 128 + wr * 64 + mp * 32 + fr, colb = colbase + u.pn * 256 + wc * 32 + 4 * fq;
#pragma unroll
                for (int mm = 0; mm < 2; ++mm) { lf.row_begin(mm, row0 + mm * 16);
#pragma unroll
                    for (int bj = 0; bj < 2; ++bj)
#pragma unroll
                        for (int n = 0; n < 2; ++n) pr[mm][bj][n] = lf.pre(row0 + mm * 16, colb + bj * 128 + n * 16); }
#pragma unroll
                for (int mm = 0; mm < 2; ++mm)
#pragma unroll
                    for (int bj = 0; bj < 2; ++bj)
#pragma unroll
                        for (int n = 0; n < 2; ++n) vv[mm][bj][n] = lf.fix(mm, colb + bj * 128 + n * 16, acc[ai][bj][mp * 2 + mm][n], pr[mm][bj][n]);
#pragma unroll
                for (int mm = 0; mm < 2; ++mm) { const int row = row0 + mm * 16; lf.s = 0.f; lf.q = 0.f;
#pragma unroll
                    for (int bj = 0; bj < 2; ++bj)
#pragma unroll
                        for (int n = 0; n < 2; ++n) { const int col = colb + bj * 128 + n * 16; f32x4 p = vv[mm][bj][n];
                            if constexpr (F::ROPE) { if (lf.need_rope(col)) p = shfl4(p, 32); }
                            lf.quad(row, col, vv[mm][bj][n], p); }
                    if constexpr (F::STATS) { float s = lf.s, q = lf.q; s += __shfl_xor(s, 16); s += __shfl_xor(s, 32); q += __shfl_xor(q, 16); q += __shfl_xor(q, 32);
                        if (fq == 0) lf.commit(row, s, q); } }
            }
    }
};
__device__ __forceinline__ f32x4 rope_apply(f32x4 v, f32x4 p, int col, int pos, const float* rope) {
    const float* t = rope + ((size_t)pos * 8 + (col & 4)) * 2;
    const f32x4 t0 = *(const f32x4*)t, t1 = *(const f32x4*)(t + 4);
    const float sg = (col & 8) ? 1.f : -1.f;
    f32x4 o; o.x = v.x * t0.x + sg * p.x * t0.y; o.y = v.y * t0.z + sg * p.y * t0.w; o.z = v.z * t1.x + sg * p.z * t1.y; o.w = v.w * t1.z + sg * p.w * t1.w;
    return o;
}
__device__ __forceinline__ void st_bf4(bf16_t* p, f32x4 v) { u32x2 w; w.x = cvtpk(v.x, v.y); w.y = cvtpk(v.z, v.w); *(u32x2*)p = w; }
__device__ __forceinline__ void row_stats(const float* ST, int row, float& mu, float& rstd) {
    const float s = ST[2 * (size_t)row], q = ST[2 * (size_t)row + 1]; mu = s * (1.f / DM); rstd = rsqrtf(fmaxf(q * (1.f / DM) - mu * mu, 0.f) + 1e-5f);
}

struct EpiAF {
    static constexpr bool ROPE = true, STATS = false; typedef NoPre Pre;
    bf16_t* PA; float* dout; bf16_t* KS; bf16_t* VS; const float* rope; float s, q;
    __device__ __forceinline__ void row_begin(int, int) {}
    __device__ __forceinline__ Pre pre(int, int) const { return Pre{}; }
    __device__ __forceinline__ f32x4 fix(int, int, f32x4 v, const Pre&) const { return v; }
    __device__ __forceinline__ bool need_rope(int col) const { return (col >> 9) < 2 && ((col >> 4) & 3) == 0; }
    __device__ __forceinline__ void commit(int, float, float) {}
    __device__ __forceinline__ void quad(int row, int col, f32x4 v, f32x4 p) {
        const bool samp = row >= NP; const int rs = row - NP;
        const int pos = samp ? 4096 + (rs & 15) : (row & 4095);
        const int region = col >> 9;
        if (need_rope(col)) v = rope_apply(v, p, col, pos, rope);
        st_bf4(PA + (size_t)row * NA + col, v);
        if (region == 1 || region == 2) {
            const int c = col & 511;
            if (!samp) __builtin_nontemporal_store(v, (f32x4*)(dout + (region == 1 ? OFF_DKP : OFF_DVP) + (size_t)row * 512 + c));
            else { *(f32x4*)(dout + (region == 1 ? OFF_DKS : OFF_DVS) + (size_t)rs * 512 + c) = v;
                   st_bf4((region == 1 ? KS : VS) + ((size_t)(rs >> 4) * KSROWS + 4096 + (rs & 15)) * 512 + c, v); }
        }
    }
};
struct EpiMemF {
    static constexpr bool ROPE = false, STATS = false; typedef NoPre Pre;
    bf16_t* MKV; float* dout; float s, q;
    __device__ __forceinline__ void row_begin(int, int) {}
    __device__ __forceinline__ Pre pre(int, int) const { return Pre{}; }
    __device__ __forceinline__ f32x4 fix(int, int, f32x4 v, const Pre&) const { return v; }
    __device__ __forceinline__ void commit(int, float, float) {}
    __device__ __forceinline__ void quad(int row, int col, f32x4 v, f32x4) {
        st_bf4(MKV + (size_t)row * 2048 + col, v);
        const int l = col >> 10, c = col & 1023;
        __builtin_nontemporal_store(v, (f32x4*)(dout + (c < 512 ? OFF_MKP : OFF_MVP) + (size_t)l * 524288 + (size_t)row * 512 + (c & 511)));
    }
};
struct EpiMerge0F {
    static constexpr bool ROPE = false, STATS = true; typedef u32x2 Pre;
    bf16_t* ZB; float* ST; float s, q;
    __device__ __forceinline__ void row_begin(int, int) {}
    __device__ __forceinline__ Pre pre(int row, int col) const { return *(const u32x2*)(ZB + (size_t)row * DM + col); }
    __device__ __forceinline__ f32x4 fix(int, int, f32x4 v, const Pre& x) const { return (f32x4){bflo(x.x), bfhi(x.x), bflo(x.y), bfhi(x.y)} * DN_ALPHA + v; }
    __device__ __forceinline__ void commit(int row, float ss, float qq) { atomicAdd(ST + 2 * (size_t)row, ss); atomicAdd(ST + 2 * (size_t)row + 1, qq); }
    __device__ __forceinline__ void quad(int row, int col, f32x4 z, f32x4) {
        st_bf4(ZB + (size_t)row * DM + col, z);
        s += (z.x + z.y) + (z.z + z.w); q += (z.x * z.x + z.y * z.y) + (z.z * z.z + z.w * z.w);
    }
};
struct EpiMerge1F {
    static constexpr bool ROPE = false, STATS = true; typedef u32x2 Pre;
    const bf16_t* ZB; const float* ST0; const float* g0; const float* b0; bf16_t* out; float* ST1; float s, q, mu[2], rstd[2];
    __device__ __forceinline__ void row_begin(int sl, int row) { row_stats(ST0, row, mu[sl], rstd[sl]); }
    __device__ __forceinline__ Pre pre(int row, int col) const { return *(const u32x2*)(ZB + (size_t)row * DM + col); }
    __device__ __forceinline__ f32x4 fix(int sl, int col, f32x4 v, const Pre& z) const {
        const f32x4 z0 = (f32x4){bflo(z.x), bfhi(z.x), bflo(z.y), bfhi(z.y)};
        const f32x4 g = *(const f32x4*)(g0 + col), b = *(const f32x4*)(b0 + col); return ((z0 - mu[sl]) * rstd[sl] * g + b) * DN_ALPHA + v; }
    __device__ __forceinline__ void commit(int row, float ss, float qq) { atomicAdd(ST1 + 2 * (size_t)row, ss); atomicAdd(ST1 + 2 * (size_t)row + 1, qq); }
    __device__ __forceinline__ void quad(int row, int col, f32x4 z, f32x4) {
        st_bf4(out + (size_t)row * DM + col, z);
        s += (z.x + z.y) + (z.z + z.w); q += (z.x * z.x + z.y * z.y) + (z.z * z.z + z.w * z.w);
    }
};
struct PreB { f32x4 c, b; };
struct EpiBF {
    static constexpr bool ROPE = true, STATS = false; typedef PreB Pre;
    bf16_t* PB; float* dout; bf16_t* KSW; bf16_t* VSW; const float* rope; const float* ST0; const float* CS; const float* BW; float s, q, mu[2], rstd[2];
    __device__ __forceinline__ void row_begin(int sl, int row) { row_stats(ST0, row, mu[sl], rstd[sl]); }
    __device__ __forceinline__ Pre pre(int, int col) const { Pre p; p.c = *(const f32x4*)(CS + col); p.b = *(const f32x4*)(BW + col); return p; }
    __device__ __forceinline__ f32x4 fix(int sl, int, f32x4 v, const Pre& p) const { return (v - p.c * mu[sl]) * rstd[sl] + p.b; }
    __device__ __forceinline__ bool need_rope(int col) const { return (col < 512 || (col >= 2048 && col < 2176)) && ((col >> 4) & 3) == 0; }
    __device__ __forceinline__ void commit(int, float, float) {}
    __device__ __forceinline__ void quad(int row, int col, f32x4 v, f32x4 p) {
        const bool samp = row >= NP; const int rs = row - NP;
        const int t = samp ? (rs & 15) : (row & 4095);
        const int pos = samp ? 4096 + t : t;
        const bool isk = col >= 2048 && col < 2176;
        if (need_rope(col)) v = rope_apply(v, p, col, pos, rope);
        st_bf4(PB + (size_t)row * NB + col, v);
        if (col >= 2048) {
            const int cc = col & 127;
            if (!samp) { if (t >= 3968) *(f32x4*)(dout + (isk ? OFF_SKP : OFF_SVP) + ((size_t)(row >> 12) * 128 + (t - 3968)) * 128 + cc) = v; }
            else { const int b = rs >> 4;
                   *(f32x4*)(dout + (isk ? OFF_SKS : OFF_SVS) + ((size_t)b * 128 + 112 + t) * 128 + cc) = v;
                   st_bf4((isk ? KSW : VSW) + ((size_t)b * SWROWS + 128 + t) * 128 + cc, v); }
        }
    }
};
template <class F> __device__ __forceinline__ void gemm_small(LAS unsigned char* lds, const bf16_t* A, const bf16_t* Bt, int N, int rowbase, int ustart, int G, const F& f, int colbase = 0) {
    const int tid = threadIdx.x, lane = tid & 63, r32 = lane & 31, hi = lane >> 5, wid = __builtin_amdgcn_readfirstlane(tid >> 6);
    const int nu = 8 * (N / 32);
    for (int u = ustart; u < nu; u += G) {
        const int row0 = (u & 7) * 32, colw = (u >> 3) * 32, col0 = colbase + colw;
        const bf16_t* ap = A + (size_t)(row0 + r32) * DM + wid * 128 + hi * 8; const bf16_t* bp = Bt + (size_t)(colw + r32) * DM + wid * 128 + hi * 8;
        bf16x8 af[8], bfr[8];
#pragma unroll
        for (int k = 0; k < 8; ++k) { af[k] = *(const bf16x8*)(ap + 16 * k); bfr[k] = *(const bf16x8*)(bp + 16 * k); }
        f32x16 acc = f32x16{};
#pragma unroll
        for (int k = 0; k < 8; ++k) acc = __builtin_amdgcn_mfma_f32_32x32x16_bf16(bfr[k], af[k], acc, 0, 0, 0);
        LAS float* part = (LAS float*)lds + wid * 1024;
#pragma unroll
        for (int r = 0; r < 16; ++r) part[r * 64 + lane] = acc[r];
        __syncthreads();
        if (wid < 2) {
            F lf = f; f32x4 qd[2];
#pragma unroll
            for (int e = 0; e < 2; ++e) { float t[4];
#pragma unroll
                for (int c = 0; c < 4; ++c) { const int r = 4 * (2 * wid + e) + c; float a = 0.f;
#pragma unroll
                    for (int w = 0; w < 8; ++w) a += ((LAS float*)lds)[w * 1024 + r * 64 + lane];
                    t[c] = a; }
                qd[e] = (f32x4){t[0], t[1], t[2], t[3]}; }
            const int row = rowbase + row0 + r32; typename F::Pre pr[2];
            lf.row_begin(0, row);
#pragma unroll
            for (int e = 0; e < 2; ++e) pr[e] = lf.pre(row, col0 + 8 * (2 * wid + e) + 4 * hi);
#pragma unroll
            for (int e = 0; e < 2; ++e) qd[e] = lf.fix(0, col0 + 8 * (2 * wid + e) + 4 * hi, qd[e], pr[e]);
            lf.s = 0.f; lf.q = 0.f;
#pragma unroll
            for (int e = 0; e < 2; ++e) lf.quad(row, col0 + 8 * (2 * wid + e) + 4 * hi, qd[e], qd[e ^ 1]);
            if constexpr (F::STATS) { float s = lf.s, q = lf.q; s += __shfl_xor(s, 32); q += __shfl_xor(q, 32); if (hi == 0) lf.commit(row, s, q); }
        }
        __syncthreads();
    }
}

namespace att {
#define KSWZ(row, colB) ((row) * 256 + ((colB) ^ (((row) & 7) << 4)))
#define SBAR() __builtin_amdgcn_sched_barrier(0)
__device__ __forceinline__ int v_st(int k, int c) { const int kk = (k & ~0xC) | ((k & 4) << 1) | ((k & 8) >> 1); return ((kk >> 3) * 4 + (c >> 5)) * 512 + ((kk & 7) * 32 + (c & 31)) * 2; }
__device__ __forceinline__ int v_rd_base(int lane) { return ((lane & 3) << 3) | (((lane >> 2) & 3) << 6) | (((lane >> 4) & 1) << 5) | (((lane >> 5) & 1) << 8); }
constexpr int v_rd_off(int d0, int ks, int half) { return d0 * 512 + ks * 4096 + half * 2048; }
template <int OFF> __device__ __forceinline__ s16x4 tr_read(int vb) {
    s16x4 r; asm volatile("ds_read_b64_tr_b16 %0, %1 offset:%2" : "=&v"(r) : "v"(vb), "i"(OFF) : "memory"); return r;
}
template <int OFF> __device__ __forceinline__ bf16x8 lds_read128(int ad) {
    bf16x8 r; asm volatile("ds_read_b128 %0, %1 offset:%2" : "=&v"(r) : "v"(ad), "i"(OFF) : "memory"); return r;
}
template <int D0> __device__ __forceinline__ void pv_one(f32x16& od, int vb, bf16x8 pa0, bf16x8 pa1, bf16x8 pa2, bf16x8 pa3) {
    const s16x4 l0 = tr_read<v_rd_off(D0, 0, 0)>(vb), h0 = tr_read<v_rd_off(D0, 0, 1)>(vb), l1 = tr_read<v_rd_off(D0, 1, 0)>(vb), h1 = tr_read<v_rd_off(D0, 1, 1)>(vb);
    const s16x4 l2 = tr_read<v_rd_off(D0, 2, 0)>(vb), h2 = tr_read<v_rd_off(D0, 2, 1)>(vb), l3 = tr_read<v_rd_off(D0, 3, 0)>(vb), h3 = tr_read<v_rd_off(D0, 3, 1)>(vb);
    asm volatile("s_waitcnt lgkmcnt(0)" ::: "memory"); SBAR();
#define PK(L, H) (bf16x8){L[0], L[1], L[2], L[3], H[0], H[1], H[2], H[3]}
    od = __builtin_amdgcn_mfma_f32_32x32x16_bf16(PK(l0, h0), pa0, od, 0, 0, 0);
    od = __builtin_amdgcn_mfma_f32_32x32x16_bf16(PK(l1, h1), pa1, od, 0, 0, 0);
    od = __builtin_amdgcn_mfma_f32_32x32x16_bf16(PK(l2, h2), pa2, od, 0, 0, 0);
    od = __builtin_amdgcn_mfma_f32_32x32x16_bf16(PK(l3, h3), pa3, od, 0, 0, 0);
#undef PK
}
template <int KSI, int DB, int ND> __device__ __forceinline__ void v_read(int vb, s16x4 (&l)[4], s16x4 (&h)[4]) {
    l[0] = tr_read<v_rd_off(DB, KSI, 0)>(vb); h[0] = tr_read<v_rd_off(DB, KSI, 1)>(vb);
    l[1] = tr_read<v_rd_off(DB + 1, KSI, 0)>(vb); h[1] = tr_read<v_rd_off(DB + 1, KSI, 1)>(vb);
    if constexpr (ND == 4) { l[2] = tr_read<v_rd_off(DB + 2, KSI, 0)>(vb); h[2] = tr_read<v_rd_off(DB + 2, KSI, 1)>(vb);
                             l[3] = tr_read<v_rd_off(DB + 3, KSI, 0)>(vb); h[3] = tr_read<v_rd_off(DB + 3, KSI, 1)>(vb); }
}
template <int ND> __device__ __forceinline__ void pv_mf(f32x16 (&o)[4], bf16x8 pa, const s16x4 (&l)[4], const s16x4 (&h)[4]) {
    __builtin_amdgcn_s_setprio(1);
#pragma unroll
    for (int d = 0; d < ND; ++d) o[d] = __builtin_amdgcn_mfma_f32_32x32x16_bf16((bf16x8){l[d][0], l[d][1], l[d][2], l[d][3], h[d][0], h[d][1], h[d][2], h[d][3]}, pa, o[d], 0, 0, 0);
    __builtin_amdgcn_s_setprio(0);
}
template <int DB, int ND> __device__ __forceinline__ void pv_ks(f32x16 (&o)[4], int vb, bf16x8 pa0, bf16x8 pa1, bf16x8 pa2, bf16x8 pa3) {
    s16x4 la[4], ha[4];
    v_read<0, DB, ND>(vb, la, ha); asm volatile("s_waitcnt lgkmcnt(0)" ::: "memory"); SBAR(); pv_mf<ND>(o, pa0, la, ha); SBAR();
    v_read<1, DB, ND>(vb, la, ha); asm volatile("s_waitcnt lgkmcnt(0)" ::: "memory"); SBAR(); pv_mf<ND>(o, pa1, la, ha); SBAR();
    v_read<2, DB, ND>(vb, la, ha); asm volatile("s_waitcnt lgkmcnt(0)" ::: "memory"); SBAR(); pv_mf<ND>(o, pa2, la, ha); SBAR();
    v_read<3, DB, ND>(vb, la, ha); asm volatile("s_waitcnt lgkmcnt(0)" ::: "memory"); SBAR(); pv_mf<ND>(o, pa3, la, ha);
}
template <int DB, int ND> __device__ __forceinline__ void pv_rest(f32x16 (&o)[4], int vb, bf16x8 pa0, bf16x8 pa1, bf16x8 pa2, bf16x8 pa3, s16x4 (&la)[4], s16x4 (&ha)[4]) {
    s16x4 lb[4], hb[4];
    asm volatile("s_waitcnt lgkmcnt(0)" ::: "memory"); SBAR(); v_read<1, DB, ND>(vb, lb, hb); SBAR(); pv_mf<ND>(o, pa0, la, ha); SBAR();
    asm volatile("s_waitcnt lgkmcnt(0)" ::: "memory"); SBAR(); v_read<2, DB, ND>(vb, la, ha); SBAR(); pv_mf<ND>(o, pa1, lb, hb); SBAR();
    asm volatile("s_waitcnt lgkmcnt(0)" ::: "memory"); SBAR(); v_read<3, DB, ND>(vb, lb, hb); SBAR(); pv_mf<ND>(o, pa2, la, ha); SBAR();
    asm volatile("s_waitcnt lgkmcnt(0)" ::: "memory"); SBAR(); pv_mf<ND>(o, pa3, lb, hb);
}
__device__ __forceinline__ void partialSM(f32x16& p0, f32x16& p1, float& m_reg, float& alpha, float C, float thr) {
    float pmax = p0[0];
#pragma unroll
    for (int r = 1; r < 16; ++r) pmax = fmaxf(pmax, p0[r]);
#pragma unroll
    for (int r = 0; r < 16; ++r) pmax = fmaxf(pmax, p1[r]);
    { auto rr = __builtin_amdgcn_permlane32_swap(__float_as_uint(pmax), __float_as_uint(pmax), false, false);
      pmax = fmaxf(__uint_as_float(rr[0]), __uint_as_float(rr[1])); }
    float mn;
    if (__all(pmax - m_reg <= thr)) { mn = m_reg; alpha = 1.f; }
    else { mn = fmaxf(m_reg, pmax); alpha = __builtin_amdgcn_exp2f((m_reg - mn) * C); m_reg = mn; }
    const float mnC = -mn * C;
#pragma unroll
    for (int r = 0; r < 16; ++r) p0[r] = __builtin_amdgcn_exp2f(fmaf(p0[r], C, mnC));
#pragma unroll
    for (int r = 0; r < 16; ++r) p1[r] = __builtin_amdgcn_exp2f(fmaf(p1[r], C, mnC));
}
__device__ __forceinline__ void finishSM(f32x16& p0, f32x16& p1, float alpha, float& l_reg, bf16x8& pa0, bf16x8& pa1, bf16x8& pa2, bf16x8& pa3) {
    float ps = 0;
#pragma unroll
    for (int r = 0; r < 16; ++r) ps += p0[r];
#pragma unroll
    for (int r = 0; r < 16; ++r) ps += p1[r];
    { auto rr = __builtin_amdgcn_permlane32_swap(__float_as_uint(ps), __float_as_uint(ps), false, false);
      ps = __uint_as_float(rr[0]) + __uint_as_float(rr[1]); }
    l_reg = l_reg * alpha + ps;
#define PK4(P, BASE, OUT) do { unsigned a0 = cvtpk(P[BASE + 0], P[BASE + 1]), a1 = cvtpk(P[BASE + 2], P[BASE + 3]);   \
    unsigned b0 = cvtpk(P[BASE + 4], P[BASE + 5]), b1 = cvtpk(P[BASE + 6], P[BASE + 7]);                              \
    auto r0 = __builtin_amdgcn_permlane32_swap(a0, b0, false, false); auto r1 = __builtin_amdgcn_permlane32_swap(a1, b1, false, false); \
    u32x4 w = {r0[0], r1[0], r0[1], r1[1]}; OUT = *reinterpret_cast<bf16x8*>(&w); } while (0)
    PK4(p0, 0, pa0); PK4(p0, 8, pa1); PK4(p1, 0, pa2); PK4(p1, 8, pa3);
#undef PK4
}
constexpr int RING = 32768;
template <int QS, bool PVHALF>
__device__ __forceinline__ void attn_core(LAS unsigned char* lds, const bf16_t* Kb, long ldk, const bf16_t* Vb, long ldv, int NT, int nkeys,
                                          const bf16_t* qptr, int wNT, int kcoffB, int pvsel, float C, float thr, f32x16 (&o)[4], float& m_reg, float& l_reg) {
    int tid = threadIdx.x; asm volatile("" : "+v"(tid));
    const int lane = tid & 63, r32 = lane & 31, hi = lane >> 5, wid = __builtin_amdgcn_readfirstlane(tid >> 6);
    bf16x8 qr[QS];
#pragma unroll
    for (int d0 = 0; d0 < QS; ++d0) qr[d0] = *(const bf16x8*)(qptr + d0 * 16);
#pragma unroll
    for (int d = 0; d < 4; ++d) o[d] = f32x16{};
    m_reg = -1e30f; l_reg = 0.f;
    long offK[2], offV[2];
#pragma unroll
    for (int i = 0; i < 2; ++i) { const int p = i * 8192 + wid * 1024 + lane * 16;
        const int row = p >> 8, colB = (p & 255) ^ ((row & 7) << 4); offK[i] = (long)row * ldk + (colB >> 1);
        const int sub = p >> 9, q = (p & 511) >> 1, kk = (sub >> 2) * 8 + (q >> 5), k = (kk & ~0xC) | ((kk & 4) << 1) | ((kk & 8) >> 1), c = (sub & 3) * 32 + (q & 31);
        offV[i] = (long)k * ldv + c; }
    const int vrb = v_rd_base(lane);
#define GLDS(t, bf) do { const bf16_t* kt_ = Kb + (long)(t) * 64 * ldk; const bf16_t* vt_ = Vb + (long)(t) * 64 * ldv; LAS unsigned char* b_ = lds + (bf) * RING + wid * 1024; \
    __builtin_amdgcn_global_load_lds((const unsigned*)(vt_ + offV[0]), (LAS unsigned*)(b_), 16, 0, 0); \
    __builtin_amdgcn_global_load_lds((const unsigned*)(vt_ + offV[1]), (LAS unsigned*)(b_ + 8192), 16, 0, 0); \
    __builtin_amdgcn_global_load_lds((const unsigned*)(kt_ + offK[0]), (LAS unsigned*)(b_ + 16384), 16, 0, 0); \
    __builtin_amdgcn_global_load_lds((const unsigned*)(kt_ + offK[1]), (LAS unsigned*)(b_ + 16384 + 8192), 16, 0, 0); } while (0)
    GLDS(0, 0);
#pragma unroll
    for (int d0 = 0; d0 < QS; ++d0) asm volatile("" :: "v"(qr[d0]));
    if (1 < NT) GLDS(1, 1); if (2 < NT) GLDS(2, 2);
    for (int j = 0; j < NT; ++j) {
        const int rem = NT - 1 - j;
        if (rem >= 2) asm volatile("s_waitcnt vmcnt(8)" ::: "memory"); else if (rem == 1) asm volatile("s_waitcnt vmcnt(4)" ::: "memory"); else asm volatile("s_waitcnt vmcnt(0)" ::: "memory");
        __builtin_amdgcn_s_barrier();
        asm volatile("" ::: "memory");
        if (j + 3 < NT) GLDS(j + 3, (j + 3) & 3);
        if (j < wNT) {
            const int cur = j & 3;
            f32x16 p0 = f32x16{}, p1 = f32x16{};
            const int kbase = (int)(uintptr_t)(lds + cur * RING + 16384) + r32 * 256;
            const int swz = (r32 & 7) << 4;
#pragma unroll
            for (int hq = 0; hq < QS / 4; ++hq) { bf16x8 b0[4], b1[4];
#pragma unroll
                for (int i = 0; i < 4; ++i) { const int cb = kcoffB + ((hq * 4 + i) * 16 + hi * 8) * 2; const int ad = kbase + (cb ^ swz);
                    b0[i] = lds_read128<0>(ad); b1[i] = lds_read128<8192>(ad); }
                asm volatile("s_waitcnt lgkmcnt(0)" ::: "memory"); SBAR();
#pragma unroll
                for (int i = 0; i < 4; ++i) { p0 = __builtin_amdgcn_mfma_f32_32x32x16_bf16(b0[i], qr[hq * 4 + i], p0, 0, 0, 0);
                    p1 = __builtin_amdgcn_mfma_f32_32x32x16_bf16(b1[i], qr[hq * 4 + i], p1, 0, 0, 0); } }
            if (__builtin_expect((j + 1) * 64 > nkeys, 0)) { const int kb = j * 64 + 4 * hi; asm volatile("" ::: "memory");
#pragma unroll
                for (int r = 0; r < 16; ++r) { const int kv = kb + (r & 3) + 8 * (r >> 2); if (kv >= nkeys) p0[r] = -1e30f; if (kv + 32 >= nkeys) p1[r] = -1e30f; } }
            float alpha; bf16x8 pa0, pa1, pa2, pa3;
            const int vb = (int)(uintptr_t)(lds + cur * RING) + vrb;
            s16x4 la[4], ha[4];
            partialSM(p0, p1, m_reg, alpha, C, thr);
            finishSM(p0, p1, alpha, l_reg, pa0, pa1, pa2, pa3);
            SBAR();
            if constexpr (QS == 4) { if constexpr (!PVHALF) v_read<0, 0, 4>(vb, la, ha); else { if (pvsel == 0) v_read<0, 0, 2>(vb, la, ha); else v_read<0, 2, 2>(vb, la, ha); } }
            SBAR();
            if (__any(alpha < 1.f)) {
#pragma unroll
                for (int d = 0; d < (PVHALF ? 2 : 4); ++d)
#pragma unroll
                    for (int r = 0; r < 16; ++r) o[d][r] *= alpha; }
            if constexpr (QS == 8) { pv_one<0>(o[0], vb, pa0, pa1, pa2, pa3); pv_one<1>(o[1], vb, pa0, pa1, pa2, pa3); pv_one<2>(o[2], vb, pa0, pa1, pa2, pa3); pv_one<3>(o[3], vb, pa0, pa1, pa2, pa3); }
            else if constexpr (!PVHALF) pv_rest<0, 4>(o, vb, pa0, pa1, pa2, pa3, la, ha);
            else { if (pvsel == 0) pv_rest<0, 2>(o, vb, pa0, pa1, pa2, pa3, la, ha); else pv_rest<2, 2>(o, vb, pa0, pa1, pa2, pa3, la, ha); }
        }
    }
#undef GLDS
    __syncthreads();
}

template <bool PVHALF>
__device__ __forceinline__ void attn_core_pipe(LAS unsigned char* lds, const bf16_t* Kb, long ldk, const bf16_t* Vb, long ldv, int NT, int nkeys,
                                               const bf16_t* qptr, int wNT, int kcoffB, int pvsel, float C, float thr, f32x16 (&o)[4], float& m_reg, float& l_reg) {
    int tid = threadIdx.x; asm volatile("" : "+v"(tid));
    const int lane = tid & 63, r32 = lane & 31, hi = lane >> 5, wid = __builtin_amdgcn_readfirstlane(tid >> 6);
    bf16x8 qr[4];
#pragma unroll
    for (int d0 = 0; d0 < 4; ++d0) qr[d0] = *(const bf16x8*)(qptr + d0 * 16);
#pragma unroll
    for (int d = 0; d < 4; ++d) o[d] = f32x16{};
    m_reg = -1e30f; l_reg = 0.f;
    int offK[2], offV[2];
#pragma unroll
    for (int i = 0; i < 2; ++i) { const int p = i * 8192 + wid * 1024 + lane * 16;
        const int row = p >> 8, colB = (p & 255) ^ ((row & 7) << 4); offK[i] = row * (int)ldk + (colB >> 1);
        const int sub = p >> 9, q = (p & 511) >> 1, kk = (sub >> 2) * 8 + (q >> 5), k = (kk & ~0xC) | ((kk & 4) << 1) | ((kk & 8) >> 1), c = (sub & 3) * 32 + (q & 31);
        offV[i] = k * (int)ldv + c; }
    const int vrb = v_rd_base(lane);
    int kad[4];
#pragma unroll
    for (int i = 0; i < 4; ++i) kad[i] = 16384 + r32 * 256 + ((kcoffB + (i * 16 + hi * 8) * 2) ^ ((r32 & 7) << 4));
    const int lds0 = (int)(uintptr_t)lds;
#define GLDS_V(t, bf) do { const bf16_t* vt_ = Vb + (long)(t) * 64 * ldv; LAS unsigned char* b_ = lds + (bf) * RING + wid * 1024; \
    __builtin_amdgcn_global_load_lds((const unsigned*)(vt_ + offV[0]), (LAS unsigned*)(b_), 16, 0, 0); \
    __builtin_amdgcn_global_load_lds((const unsigned*)(vt_ + offV[1]), (LAS unsigned*)(b_ + 8192), 16, 0, 0); } while (0)
#define GLDS_K(t, bf) do { const bf16_t* kt_ = Kb + (long)(t) * 64 * ldk; LAS unsigned char* b_ = lds + (bf) * RING + wid * 1024; \
    __builtin_amdgcn_global_load_lds((const unsigned*)(kt_ + offK[0]), (LAS unsigned*)(b_ + 16384), 16, 0, 0); \
    __builtin_amdgcn_global_load_lds((const unsigned*)(kt_ + offK[1]), (LAS unsigned*)(b_ + 16384 + 8192), 16, 0, 0); } while (0)
#define GLDS(t, bf) do { GLDS_V(t, bf); GLDS_K(t, bf); } while (0)
#define QK(P0, P1, bf) do { const int kb_ = lds0 + (bf) * RING; bf16x8 b0_[2], b1_[2]; \
    _Pragma("unroll") for (int i_ = 0; i_ < 2; ++i_) { b0_[i_] = lds_read128<0>(kb_ + kad[i_]); b1_[i_] = lds_read128<8192>(kb_ + kad[i_]); } \
    asm volatile("s_waitcnt lgkmcnt(0)" ::: "memory"); SBAR(); \
    P0 = __builtin_amdgcn_mfma_f32_32x32x16_bf16(b0_[0], qr[0], f32x16{}, 0, 0, 0); P1 = __builtin_amdgcn_mfma_f32_32x32x16_bf16(b1_[0], qr[0], f32x16{}, 0, 0, 0); \
    P0 = __builtin_amdgcn_mfma_f32_32x32x16_bf16(b0_[1], qr[1], P0, 0, 0, 0); P1 = __builtin_amdgcn_mfma_f32_32x32x16_bf16(b1_[1], qr[1], P1, 0, 0, 0); SBAR(); \
    _Pragma("unroll") for (int i_ = 0; i_ < 2; ++i_) { b0_[i_] = lds_read128<0>(kb_ + kad[2 + i_]); b1_[i_] = lds_read128<8192>(kb_ + kad[2 + i_]); } \
    asm volatile("s_waitcnt lgkmcnt(0)" ::: "memory"); SBAR(); \
    P0 = __builtin_amdgcn_mfma_f32_32x32x16_bf16(b0_[0], qr[2], P0, 0, 0, 0); P1 = __builtin_amdgcn_mfma_f32_32x32x16_bf16(b1_[0], qr[2], P1, 0, 0, 0); \
    P0 = __builtin_amdgcn_mfma_f32_32x32x16_bf16(b0_[1], qr[3], P0, 0, 0, 0); P1 = __builtin_amdgcn_mfma_f32_32x32x16_bf16(b1_[1], qr[3], P1, 0, 0, 0); \
    SBAR(); } while (0)
#define STEP(C0, C1, N0, N1, j) do { \
    if ((j) + 1 < NT) { \
        if ((j) + 2 < NT) asm volatile("s_waitcnt vmcnt(4)" ::: "memory"); else asm volatile("s_waitcnt vmcnt(0)" ::: "memory"); \
        __builtin_amdgcn_s_barrier(); asm volatile("" ::: "memory"); \
        if ((j) + 1 < wNT) QK(N0, N1, ((j) + 1) & 3); } \
    const bool iss_ = (j) + 3 < NT;                                 \
    if ((j) < wNT) { \
        if (__builtin_expect(((j) + 1) * 64 > nkeys, 0)) { const int kb = (j) * 64 + 4 * hi; asm volatile("" ::: "memory"); \
            _Pragma("unroll") for (int r = 0; r < 16; ++r) { const int kv = kb + (r & 3) + 8 * (r >> 2); if (kv >= nkeys) C0[r] = -1e30f; if (kv + 32 >= nkeys) C1[r] = -1e30f; } } \
        float alpha; bf16x8 pa0, pa1, pa2, pa3; const int vb = lds0 + ((j) & 3) * RING + vrb; \
        partialSM(C0, C1, m_reg, alpha, C, thr); \
        SBAR(); if (iss_) GLDS_V((j) + 3, ((j) + 3) & 3); SBAR(); \
        finishSM(C0, C1, alpha, l_reg, pa0, pa1, pa2, pa3); \
        SBAR(); if (iss_) GLDS_K((j) + 3, ((j) + 3) & 3); SBAR(); \
        if (__any(alpha < 1.f)) { \
            _Pragma("unroll") for (int d = 0; d < (PVHALF ? 2 : 4); ++d) _Pragma("unroll") for (int r = 0; r < 16; ++r) o[d][r] *= alpha; } \
        if constexpr (!PVHALF) pv_ks<0, 4>(o, vb, pa0, pa1, pa2, pa3); \
        else { if (pvsel == 0) pv_ks<0, 2>(o, vb, pa0, pa1, pa2, pa3); else pv_ks<2, 2>(o, vb, pa0, pa1, pa2, pa3); } } \
    else if (iss_) GLDS((j) + 3, ((j) + 3) & 3); \
    } while (0)
    GLDS(0, 0);
#pragma unroll
    for (int d0 = 0; d0 < 4; ++d0) asm volatile("" :: "v"(qr[d0]));
    if (1 < NT) GLDS(1, 1); if (2 < NT) GLDS(2, 2);
    if (NT > 2) asm volatile("s_waitcnt vmcnt(8)" ::: "memory"); else if (NT == 2) asm volatile("s_waitcnt vmcnt(4)" ::: "memory"); else asm volatile("s_waitcnt vmcnt(0)" ::: "memory");
    __builtin_amdgcn_s_barrier(); asm volatile("" ::: "memory");
    f32x16 pA0 = f32x16{}, pA1 = f32x16{}, pB0 = f32x16{}, pB1 = f32x16{};
    if (0 < wNT) QK(pA0, pA1, 0);
    for (int j = 0; j < NT; j += 2) {
        STEP(pA0, pA1, pB0, pB1, j);
        if (j + 1 < NT) STEP(pB0, pB1, pA0, pA1, j + 1);
    }
#undef STEP
#undef QK
#undef GLDS
#undef GLDS_V
#undef GLDS_K
    __syncthreads();
}

struct Ctx { LAS unsigned char* lds; int lane, wid, r32, hi; };

template <int ND> __device__ __forceinline__ void store_gated(const f32x16 (&o)[4], float scale, const bf16_t* gate, bf16_t* out, int hi) {
#pragma unroll
    for (int d = 0; d < ND; ++d)
#pragma unroll
        for (int g = 0; g < 4; ++g) { const int dv = 32 * d + 8 * g + 4 * hi;
            const u32x2 gt = *(const u32x2*)(gate + dv);
            f32x4 v; v.x = o[d][4 * g] * scale * silu(bflo(gt.x)); v.y = o[d][4 * g + 1] * scale * silu(bfhi(gt.x));
            v.z = o[d][4 * g + 2] * scale * silu(bflo(gt.y)); v.w = o[d][4 * g + 3] * scale * silu(bfhi(gt.y));
            st_bf4(out + dv, v); }
}

__device__ __forceinline__ void diff_unit(const Ctx& cx, bool samp, int b, int h, int qb, const bf16_t* PA, const bf16_t* KS, const bf16_t* VS, bf16_t* MIX, const float* gnorm, float lam) {
    const int c = cx.wid >> 2, rb = cx.wid & 3;
    long row; bool valid; int NT, wNT, nkeys; const bf16_t* Kb; const bf16_t* Vb; long ldk;
    if (!samp) { row = (long)b * 4096 + qb * 128 + rb * 32 + cx.r32; valid = true; NT = 2 * qb + 2; wNT = 2 * qb + 1 + (rb >> 1); nkeys = NT * 64;
                 Kb = PA + (size_t)b * 4096 * NA + 512 + h * 128; Vb = Kb + 512; ldk = NA; }
    else { row = NP + b * 16 + (cx.r32 < 15 ? cx.r32 : 15); valid = (rb == 0) && cx.r32 < 16; NT = 65; wNT = (rb == 0) ? 65 : 0; nkeys = 4112;
           Kb = KS + (size_t)b * KSROWS * 512 + h * 128; Vb = VS + (size_t)b * KSROWS * 512 + h * 128; ldk = 512; }
    const bf16_t* qptr = PA + (size_t)row * NA + h * 128 + c * 64 + cx.hi * 8;
    f32x16 o[4]; float m, l;
    attn_core_pipe<false>(cx.lds, Kb, ldk, Vb, ldk, NT, nkeys, qptr, wNT, c * 128, 0, C64, THR64, o, m, l);
    const float inv = l > 0.f ? 1.f / l : 0.f;
    LAS float* xch = (LAS float*)cx.lds + rb * 4096;
    if (c == 1) {
#pragma unroll
        for (int d = 0; d < 4; ++d)
#pragma unroll
            for (int r = 0; r < 16; ++r) xch[(d * 16 + r) * 64 + cx.lane] = o[d][r] * inv; }
    __syncthreads();
    if (c == 0) {
        float ss = 0.f;
#pragma unroll
        for (int d = 0; d < 4; ++d)
#pragma unroll
            for (int r = 0; r < 16; ++r) { const float od = o[d][r] * inv - lam * xch[(d * 16 + r) * 64 + cx.lane]; o[d][r] = od; ss += od * od; }
        ss += __shfl_xor(ss, 32);
        const float rms = rsqrtf(ss * (1.f / 128.f) + 1e-5f) * 0.8f;
        if (valid) {
            const bf16_t* gate = PA + (size_t)row * NA + 1536 + h * 128; bf16_t* out = MIX + (size_t)row * DM + h * 128;
#pragma unroll
            for (int d = 0; d < 4; ++d)
#pragma unroll
                for (int g = 0; g < 4; ++g) { const int dv = 32 * d + 8 * g + 4 * cx.hi;
                    const f32x4 gn = *(const f32x4*)(gnorm + dv); const u32x2 gt = *(const u32x2*)(gate + dv);
                    f32x4 v; v.x = o[d][4 * g] * rms * gn.x * silu(bflo(gt.x)); v.y = o[d][4 * g + 1] * rms * gn.y * silu(bfhi(gt.x));
                    v.z = o[d][4 * g + 2] * rms * gn.z * silu(bflo(gt.y)); v.w = o[d][4 * g + 3] * rms * gn.w * silu(bfhi(gt.y));
                    st_bf4(out + dv, v); }
        }
    }
    __syncthreads();
}
__device__ __forceinline__ void diff_sample_item(const Ctx& cx, int b, int h, int sp, const float* CK, const float* CV, const bf16_t* PA, const bf16_t* KS, const bf16_t* VS,
                                                 bf16_t* MIX, const float* gnorm, float lam, float* PART, unsigned* cnt, volatile LAS unsigned* MISC) {
    int tid = threadIdx.x; asm volatile("" : "+v"(tid));
    const int lane = tid & 63, r32 = lane & 31, hi = lane >> 5, wid = __builtin_amdgcn_readfirstlane(tid >> 6);
    const int c = wid >> 2; const bool active = (wid & 3) == 0;
    const size_t row = NP + b * 16 + (r32 < 15 ? r32 : 15);
    bf16x8 qr[4];
    { const bf16_t* qptr = PA + row * NA + h * 128 + c * 64 + hi * 8;
#pragma unroll
      for (int d0 = 0; d0 < 4; ++d0) qr[d0] = *(const bf16x8*)(qptr + d0 * 16); }
    f32x16 o[4];
#pragma unroll
    for (int d = 0; d < 4; ++d) o[d] = f32x16{};
    float m_reg = -1e30f, l_reg = 0.f;
    const int ntl = 16 + (sp == 3 ? 1 : 0);
    const int sr = tid >> 4, sc = (tid & 15) * 8;
    const float* kg = CK + ((size_t)(b * 4096 + sp * 1024 + sr) * 4 + h) * 128 + sc;
    const float* vg = CV + ((size_t)(b * 4096 + sp * 1024 + sr) * 4 + h) * 128 + sc;
    const bf16_t* kn = KS + ((size_t)b * KSROWS + 4096 + sr) * 512 + h * 128 + sc;
    const bf16_t* vn = VS + ((size_t)b * KSROWS + 4096 + sr) * 512 + h * 128 + sc;
    const int vst0 = v_st(sr, sc), vst1 = v_st(32 + sr, sc), kst0 = 16384 + KSWZ(sr, sc * 2), kst1 = 16384 + KSWZ(32 + sr, sc * 2);
    int kad[4];
#pragma unroll
    for (int i = 0; i < 4; ++i) kad[i] = 16384 + r32 * 256 + ((c * 128 + (i * 16 + hi * 8) * 2) ^ ((r32 & 7) << 4));
    const int lds0 = (int)(uintptr_t)cx.lds, vrb = v_rd_base(lane);
    f32x4 kfA[4], vfA[4], kfB[4], vfB[4];
#define LOADT(t, kf, vf) do { if ((t) < 16) { const float* kp_ = kg + (size_t)(t) * 64 * 512; const float* vp_ = vg + (size_t)(t) * 64 * 512; \
        kf[0] = __builtin_nontemporal_load((const f32x4*)kp_); kf[1] = __builtin_nontemporal_load((const f32x4*)(kp_ + 4)); kf[2] = __builtin_nontemporal_load((const f32x4*)(kp_ + 32 * 512)); kf[3] = __builtin_nontemporal_load((const f32x4*)(kp_ + 32 * 512 + 4)); \
        vf[0] = __builtin_nontemporal_load((const f32x4*)vp_); vf[1] = __builtin_nontemporal_load((const f32x4*)(vp_ + 4)); vf[2] = __builtin_nontemporal_load((const f32x4*)(vp_ + 32 * 512)); vf[3] = __builtin_nontemporal_load((const f32x4*)(vp_ + 32 * 512 + 4)); } \
    else { kf[0] = *(const f32x4*)kn; kf[2] = *(const f32x4*)(kn + 32 * 512); vf[0] = *(const f32x4*)vn; vf[2] = *(const f32x4*)(vn + 32 * 512); } } while (0)
#define CV8(A, B) ((u32x4){cvtpk(A.x, A.y), cvtpk(A.z, A.w), cvtpk(B.x, B.y), cvtpk(B.z, B.w)})
#define WRITET(t, bf, kf, vf) do { u32x4 k0_, k1_, v0_, v1_; \
    if ((t) < 16) { k0_ = CV8(kf[0], kf[1]); k1_ = CV8(kf[2], kf[3]); v0_ = CV8(vf[0], vf[1]); v1_ = CV8(vf[2], vf[3]); } \
    else { k0_ = __builtin_bit_cast(u32x4, kf[0]); k1_ = __builtin_bit_cast(u32x4, kf[2]); v0_ = __builtin_bit_cast(u32x4, vf[0]); v1_ = __builtin_bit_cast(u32x4, vf[2]); } \
    LAS unsigned char* b_ = cx.lds + (bf) * RING; \
    *(LAS u32x4*)(b_ + vst0) = v0_; *(LAS u32x4*)(b_ + vst1) = v1_; *(LAS u32x4*)(b_ + kst0) = k0_; *(LAS u32x4*)(b_ + kst1) = k1_; } while (0)
#define SCORE(t, cur) do { if (active) { \
            f32x16 p0, p1; \
            { const int kb_ = lds0 + (cur) * RING; bf16x8 b0_[2], b1_[2]; \
              _Pragma("unroll") for (int i = 0; i < 2; ++i) { b0_[i] = lds_read128<0>(kb_ + kad[i]); b1_[i] = lds_read128<8192>(kb_ + kad[i]); } \
              asm volatile("s_waitcnt lgkmcnt(0)" ::: "memory"); SBAR(); \
              p0 = __builtin_amdgcn_mfma_f32_32x32x16_bf16(b0_[0], qr[0], f32x16{}, 0, 0, 0); p1 = __builtin_amdgcn_mfma_f32_32x32x16_bf16(b1_[0], qr[0], f32x16{}, 0, 0, 0); \
              p0 = __builtin_amdgcn_mfma_f32_32x32x16_bf16(b0_[1], qr[1], p0, 0, 0, 0); p1 = __builtin_amdgcn_mfma_f32_32x32x16_bf16(b1_[1], qr[1], p1, 0, 0, 0); SBAR(); \
              _Pragma("unroll") for (int i = 0; i < 2; ++i) { b0_[i] = lds_read128<0>(kb_ + kad[2 + i]); b1_[i] = lds_read128<8192>(kb_ + kad[2 + i]); } \
              asm volatile("s_waitcnt lgkmcnt(0)" ::: "memory"); SBAR(); \
              p0 = __builtin_amdgcn_mfma_f32_32x32x16_bf16(b0_[0], qr[2], p0, 0, 0, 0); p1 = __builtin_amdgcn_mfma_f32_32x32x16_bf16(b1_[0], qr[2], p1, 0, 0, 0); \
              p0 = __builtin_amdgcn_mfma_f32_32x32x16_bf16(b0_[1], qr[3], p0, 0, 0, 0); p1 = __builtin_amdgcn_mfma_f32_32x32x16_bf16(b1_[1], qr[3], p1, 0, 0, 0); } \
            if ((t) >= 16) { \
                _Pragma("unroll") for (int r = 0; r < 16; ++r) { const int kv = 4 * hi + (r & 3) + 8 * (r >> 2); if (kv >= 16) p0[r] = -1e30f; p1[r] = -1e30f; } } \
            float alpha; bf16x8 pa0, pa1, pa2, pa3; \
            partialSM(p0, p1, m_reg, alpha, C64, THR64); \
            finishSM(p0, p1, alpha, l_reg, pa0, pa1, pa2, pa3); \
            SBAR(); \
            if (__any(alpha < 1.f)) { \
                _Pragma("unroll") for (int d = 0; d < 4; ++d) _Pragma("unroll") for (int r = 0; r < 16; ++r) o[d][r] *= alpha; } \
            pv_ks<0, 4>(o, lds0 + (cur) * RING + vrb, pa0, pa1, pa2, pa3); } } while (0)
    LOADT(0, kfA, vfA); LOADT(1, kfB, vfB); WRITET(0, 0, kfA, vfA); __syncthreads();
    for (int t = 0; t < ntl; t += 2) {
        if (t + 2 < ntl) LOADT(t + 2, kfA, vfA);
        SCORE(t, 0);
        if (t + 1 < ntl) WRITET(t + 1, 1, kfB, vfB);
        __syncthreads();
        if (t + 1 < ntl) {
            if (t + 3 < ntl) LOADT(t + 3, kfB, vfB);
            SCORE(t + 1, 1);
            if (t + 2 < ntl) WRITET(t + 2, 0, kfA, vfA);
            __syncthreads();
        }
    }
#undef SCORE
#undef LOADT
#undef WRITET
#undef CV8
    const int bh = b * 4 + h;
    if (active) { float* pb = PART + ((size_t)(bh * 4 + sp) * 2 + c) * (66 * 64) + lane;
#pragma unroll
        for (int d = 0; d < 4; ++d)
#pragma unroll
            for (int r = 0; r < 16; ++r) pb[(d * 16 + r) * 64] = o[d][r];
        pb[64 * 64] = m_reg; pb[65 * 64] = l_reg; }
    asm volatile("s_waitcnt vmcnt(0)" ::: "memory"); __syncthreads();
    if (tid == 0) { __builtin_amdgcn_fence(__ATOMIC_RELEASE, "agent"); asm volatile("s_waitcnt vmcnt(0)" ::: "memory");
                    const unsigned old = __hip_atomic_fetch_add(cnt + bh, 1u, __ATOMIC_RELAXED, __HIP_MEMORY_SCOPE_AGENT);
                    if (old == 3u) { __builtin_amdgcn_fence(__ATOMIC_ACQUIRE, "agent"); asm volatile("s_waitcnt vmcnt(0)" ::: "memory"); }
                    MISC[1] = old; }
    __syncthreads();
    const bool last = MISC[1] == 3u;
    if (last && wid == 0) {
        const float* pp = PART + (size_t)(bh * 4) * 2 * (66 * 64) + lane;
        float e0[4], e1[4], L0 = 0.f, L1 = 0.f;
        { float m0[4], m1[4], M0 = -1e30f, M1 = -1e30f;
#pragma unroll
          for (int q = 0; q < 4; ++q) { m0[q] = pp[(size_t)(q * 2) * (66 * 64) + 64 * 64]; m1[q] = pp[(size_t)(q * 2 + 1) * (66 * 64) + 64 * 64]; M0 = fmaxf(M0, m0[q]); M1 = fmaxf(M1, m1[q]); }
#pragma unroll
          for (int q = 0; q < 4; ++q) { e0[q] = __builtin_amdgcn_exp2f((m0[q] - M0) * C64); e1[q] = __builtin_amdgcn_exp2f((m1[q] - M1) * C64);
              L0 += e0[q] * pp[(size_t)(q * 2) * (66 * 64) + 65 * 64]; L1 += e1[q] * pp[(size_t)(q * 2 + 1) * (66 * 64) + 65 * 64]; } }
        const float i0 = 1.f / L0, i1 = lam / L1;
#pragma unroll
        for (int q = 0; q < 4; ++q) { e0[q] *= i0; e1[q] *= i1; }
        float ss = 0.f;
#pragma unroll
        for (int d = 0; d < 4; ++d)
#pragma unroll
            for (int r = 0; r < 16; ++r) { float od = 0.f;
#pragma unroll
                for (int q = 0; q < 4; ++q) od += e0[q] * pp[(size_t)(q * 2) * (66 * 64) + (d * 16 + r) * 64] - e1[q] * pp[(size_t)(q * 2 + 1) * (66 * 64) + (d * 16 + r) * 64];
                o[d][r] = od; ss += od * od; }
        ss += __shfl_xor(ss, 32);
        const float rms = rsqrtf(ss * (1.f / 128.f) + 1e-5f) * 0.8f;
        if (r32 < 16) {
            const bf16_t* gate = PA + row * NA + 1536 + h * 128; bf16_t* out = MIX + row * DM + h * 128;
#pragma unroll
            for (int d = 0; d < 4; ++d)
#pragma unroll
                for (int g = 0; g < 4; ++g) { const int dv = 32 * d + 8 * g + 4 * hi;
                    const f32x4 gn = *(const f32x4*)(gnorm + dv); const u32x2 gt = *(const u32x2*)(gate + dv);
                    f32x4 v; v.x = o[d][4 * g] * rms * gn.x * silu(bflo(gt.x)); v.y = o[d][4 * g + 1] * rms * gn.y * silu(bfhi(gt.x));
                    v.z = o[d][4 * g + 2] * rms * gn.z * silu(bflo(gt.y)); v.w = o[d][4 * g + 3] * rms * gn.w * silu(bfhi(gt.y));
                    st_bf4(out + dv, v); }
        }
    }
    __syncthreads();
}
__device__ __forceinline__ void mem_unit(const Ctx& cx, bool samp, int b, int h, int qb, const bf16_t* P, int ldp, int qcol, int gcol,
                                         const bf16_t* Kb, const bf16_t* Vb, long ldk, bf16_t* MIX) {
    long row; bool valid; int wNT;
    if (!samp) { row = (long)b * 4096 + qb * 256 + cx.wid * 32 + cx.r32; valid = true; wNT = 4; }
    else { row = NP + b * 16 + (cx.r32 < 15 ? cx.r32 : 15); valid = (cx.wid == 0) && cx.r32 < 16; wNT = (cx.wid == 0) ? 4 : 0; }
    const bf16_t* qptr = P + (size_t)row * ldp + qcol + h * 128 + cx.hi * 8;
    f32x16 o[4]; float m, l;
    attn_core<8, false>(cx.lds, Kb, ldk, Vb, ldk, 4, 256, qptr, wNT, 0, 0, C128, THR128, o, m, l);
    const float inv = l > 0.f ? 1.f / l : 0.f;
    if (valid) store_gated<4>(o, inv, P + (size_t)row * ldp + gcol + h * 128, MIX + (size_t)row * DM + 512 + h * 128, cx.hi);
}
__device__ __forceinline__ void swa_unit(const Ctx& cx, bool samp, int b, int c, int half, const bf16_t* PB, const bf16_t* KSW, const bf16_t* VSW, bf16_t* MIX, const float* sinks) {
    const int head = cx.wid, kv = cx.wid >> 2;
    long row; bool valid; int NT, nkeys; const bf16_t* Kb; const bf16_t* Vb; long ldk;
    if (!samp) { row = (long)b * 4096 + c * 64 + half * 32 + cx.r32; valid = true; const int c0 = c > 2 ? c - 2 : 0; NT = c - c0 + 1; nkeys = NT * 64;
                 Kb = PB + ((size_t)b * 4096 + c0 * 64) * NB + 2048; Vb = Kb + 128; ldk = NB; }
    else { row = NP + b * 16 + (cx.r32 < 15 ? cx.r32 : 15); valid = cx.r32 < 16; NT = 3; nkeys = 144;
           Kb = KSW + (size_t)b * SWROWS * 128; Vb = VSW + (size_t)b * SWROWS * 128; ldk = 128; }
    const bf16_t* qptr = PB + (size_t)row * NB + head * 64 + cx.hi * 8;
    f32x16 o[4]; float m, l;
    attn_core_pipe<true>(cx.lds, Kb, ldk, Vb, ldk, NT, nkeys, qptr, NT, kv * 128, kv, C64, THR64, o, m, l);
    const float lt = l + __builtin_amdgcn_exp2f(sinks[head] * LOG2E - m * C64);
    const float inv = 1.f / lt;
    if (valid) store_gated<2>(o, inv, PB + (size_t)row * NB + 512 + head * 64, MIX + (size_t)row * DM + head * 64, cx.hi);
}
#undef KSWZ
#undef SBAR
}

__device__ __forceinline__ float wave_sum(float v) {
#pragma unroll
    for (int o = 1; o < 64; o <<= 1) v += __shfl_xor(v, o);
    return v;
}
__device__ __forceinline__ void p0_transpose_item(const float* W, int K, int N, bf16_t* WT, int row_off, LAS float* scr, int item, int lane) {
    const int nblk = N / 32, kb = item / nblk, nb = item % nblk, k0 = 64 * kb, n0 = 32 * nb;
#pragma unroll 8
    for (int i = 0; i < 32; ++i) { const int kk = 2 * i + (lane >> 5); scr[kk * 33 + (lane & 31)] = __builtin_nontemporal_load(W + (size_t)(k0 + kk) * N + n0 + (lane & 31)); }
    asm volatile("s_waitcnt lgkmcnt(0)" ::: "memory");
    const int c = lane & 7;
#pragma unroll
    for (int j = 0; j < 4; ++j) { const int n = (lane >> 3) + 8 * j; const LAS float* s = scr + (8 * c) * 33 + n;
        u32x4 o; o.x = cvtpk(s[0 * 33], s[1 * 33]); o.y = cvtpk(s[2 * 33], s[3 * 33]); o.z = cvtpk(s[4 * 33], s[5 * 33]); o.w = cvtpk(s[6 * 33], s[7 * 33]);
        *(u32x4*)(WT + (size_t)(row_off + n0 + n) * K + k0 + 8 * c) = o; }
    asm volatile("s_waitcnt lgkmcnt(0)" ::: "memory");
}
__device__ __forceinline__ void p0_transpose_item_ln(const float* W, int K, int N, bf16_t* WT, int row_off, LAS float* scr, int item, int lane, const float* g, const float* b, float* CS, float* BW) {
    const int nblk = N / 32, kb = item / nblk, nb = item % nblk, k0 = 64 * kb, n0 = 32 * nb;
    float csp = 0.f, bwp = 0.f;
#pragma unroll 8
    for (int i = 0; i < 32; ++i) { const int kk = 2 * i + (lane >> 5); const float w = __builtin_nontemporal_load(W + (size_t)(k0 + kk) * N + n0 + (lane & 31)); const float gw = g[k0 + kk] * w;
        scr[kk * 33 + (lane & 31)] = gw; csp += bflo(cvtpk(gw, 0.f)); bwp += b[k0 + kk] * w; }
    csp += __shfl_xor(csp, 32); bwp += __shfl_xor(bwp, 32);
    if (lane < 32) { atomicAdd(CS + row_off + n0 + lane, csp); atomicAdd(BW + row_off + n0 + lane, bwp); }
    asm volatile("s_waitcnt lgkmcnt(0)" ::: "memory");
    const int c = lane & 7;
#pragma unroll
    for (int j = 0; j < 4; ++j) { const int n = (lane >> 3) + 8 * j; const LAS float* sp = scr + (8 * c) * 33 + n;
        u32x4 o; o.x = cvtpk(sp[0 * 33], sp[1 * 33]); o.y = cvtpk(sp[2 * 33], sp[3 * 33]); o.z = cvtpk(sp[4 * 33], sp[5 * 33]); o.w = cvtpk(sp[6 * 33], sp[7 * 33]);
        *(u32x4*)(WT + (size_t)(row_off + n0 + n) * K + k0 + 8 * c) = o; }
    asm volatile("s_waitcnt lgkmcnt(0)" ::: "memory");
}
__device__ __forceinline__ void ln_rows(const float* zin, float* fout, bf16_t* bout, const float* g, const float* bta, int gw, int NGW, int lane) {
    f32x4 g4[4], b4[4];
#pragma unroll
    for (int j = 0; j < 4; ++j) { g4[j] = *(const f32x4*)(g + 4 * lane + 256 * j); b4[j] = *(const f32x4*)(bta + 4 * lane + 256 * j); }
    for (int m = gw; m < MA; m += NGW) {
        const float* zr = zin + (size_t)m * DM + 4 * lane;
        f32x4 v[4]; float s = 0.f;
#pragma unroll
        for (int j = 0; j < 4; ++j) { v[j] = *(const f32x4*)(zr + 256 * j); s += (v[j].x + v[j].y) + (v[j].z + v[j].w); }
        const float mean = wave_sum(s) * (1.f / DM); float s2 = 0.f;
#pragma unroll
        for (int j = 0; j < 4; ++j) { v[j] = v[j] - mean; s2 += (v[j].x * v[j].x + v[j].y * v[j].y) + (v[j].z * v[j].z + v[j].w * v[j].w); }
        const float rstd = rsqrtf(wave_sum(s2) * (1.f / DM) + 1e-5f);
#pragma unroll
        for (int j = 0; j < 4; ++j) { const f32x4 y = v[j] * rstd * g4[j] + b4[j];
            *(f32x4*)(fout + (size_t)m * DM + 4 * lane + 256 * j) = y;
            if (bout) st_bf4(bout + (size_t)m * DM + 4 * lane + 256 * j, y); }
    }
}

#define XB_TMO      128
#define XB_XCNT(j)  (256  + 64 * (j))
#define XB_XSUB(j)  (1280 + 64 * (j))
#define XB_XGEN(j)  (2304 + 64 * (j))
#define XB_TOP      3328
#define XB_TOPGEN   3392
#define XCD_BAR_WORDS 3456
#define XB_SPIN_CAP (1u << 18)

__device__ __forceinline__ unsigned xb_ld(unsigned* p)              { return __hip_atomic_load(p, __ATOMIC_RELAXED, __HIP_MEMORY_SCOPE_AGENT); }
__device__ __forceinline__ unsigned xb_add(unsigned* p, unsigned v) { return __hip_atomic_fetch_add(p, v, __ATOMIC_RELAXED, __HIP_MEMORY_SCOPE_AGENT); }
__device__ __forceinline__ unsigned xb_xcc_id() { return (unsigned)__builtin_amdgcn_s_getreg((3 << 11) | 20) & 0xFu; }
#define XB_SPIN(cond, bar) do { unsigned _sp = 0; while (cond) { __builtin_amdgcn_s_sleep(1); \
    if ((++_sp & 255u) == 0u) { if (xb_ld(&(bar)[XB_TMO])) break; if (_sp > XB_SPIN_CAP) { atomicAdd(&(bar)[XB_TMO], 1u); break; } } } } while (0)

struct XcdBarrier {
    unsigned* bar; unsigned x;
    volatile LAS unsigned* st;
};

__device__ __forceinline__ XcdBarrier xcd_barrier_post(unsigned* bar, volatile LAS unsigned* st) {
    XcdBarrier b; b.bar = bar; b.x = xb_xcc_id(); b.st = st;
    if (threadIdx.x == 0) (void)xb_add(&bar[XB_XCNT(b.x)], 1u);
    return b;
}
__device__ __forceinline__ void xcd_barrier_complete(unsigned* bar, unsigned x, unsigned& nloc, unsigned& nx) {
    const unsigned G = gridDim.x * gridDim.y * gridDim.z;
    unsigned sum, cnt, mine, sp = 0u;
    for (;;) {
        sum = 0u; cnt = 0u; mine = 0u;
#pragma unroll
        for (unsigned j = 0; j < 16; ++j) { const unsigned c = xb_ld(&bar[XB_XCNT(j)]); sum += c; cnt += (c > 0u) ? 1u : 0u; mine = (j == x) ? c : mine; }
        if (sum == G) break;
        __builtin_amdgcn_s_sleep(1);
        if ((++sp & 255u) == 0u) { if (xb_ld(&bar[XB_TMO])) break; if (sp > XB_SPIN_CAP) { atomicAdd(&bar[XB_TMO], 1u); break; } }
    }
    nloc = mine > 0u ? mine : 1u; nx = cnt > 0u ? cnt : 1u;
}

__device__ __forceinline__ void xcd_barrier(const XcdBarrier& b) {
    asm volatile("s_waitcnt vmcnt(0)" ::: "memory");
    __syncthreads();
    if (threadIdx.x == 0) {
        unsigned* bar = b.bar;
        __builtin_amdgcn_s_waitcnt(0);
        unsigned nloc = b.st[0], nx = b.st[1];
        if (nloc == 0u) { xcd_barrier_complete(bar, b.x, nloc, nx); b.st[0] = nloc; b.st[1] = nx; }
        const unsigned old = xb_add(&bar[XB_XSUB(b.x)], 1u);
        const unsigned gen = old / nloc;
        if (old + 1u == (gen + 1u) * nloc) {
            __builtin_amdgcn_fence(__ATOMIC_RELEASE, "agent");
            asm volatile("s_waitcnt vmcnt(0)" ::: "memory");
            const unsigned og = xb_add(&bar[XB_TOP], 1u);
            const unsigned tg = og / nx;
            if (og + 1u == (tg + 1u) * nx) xb_add(&bar[XB_TOPGEN], 1u);
            else XB_SPIN(xb_ld(&bar[XB_TOPGEN]) == tg, bar);
            __builtin_amdgcn_fence(__ATOMIC_ACQUIRE, "agent");
            xb_add(&bar[XB_XGEN(b.x)], 1u);
            asm volatile("s_waitcnt vmcnt(0)" ::: "memory");
        } else {
            XB_SPIN(xb_ld(&bar[XB_XGEN(b.x)]) == gen, bar);
            __builtin_amdgcn_fence(__ATOMIC_ACQUIRE, "agent");
            asm volatile("s_waitcnt vmcnt(0)" ::: "memory");
        }
    }
    __syncthreads();
}

struct Args { const float* in[22]; float* out; unsigned char* ws; int ph_lo, ph_hi, rep, pad; };
constexpr int NWAVES = 8, NPHASE = 9;

__global__ void __launch_bounds__(NWAVES * 64, 2) yoco_fwd(Args a) {
    extern __shared__ __attribute__((aligned(16))) unsigned char lds_raw[];
    LAS unsigned char* lds = (LAS unsigned char*)lds_raw;
    volatile LAS unsigned* MISC = (volatile LAS unsigned*)(lds + LDS_RING);
    cg::grid_group grid = cg::this_grid();
    const int tid = threadIdx.x, lane = tid & 63, wave = __builtin_amdgcn_readfirstlane(tid >> 6);
    const int G = gridDim.x, gw = blockIdx.x * NWAVES + wave, NGW = G * NWAVES;
    const long gtid = (long)blockIdx.x * (NWAVES * 64) + tid, NTHR = (long)G * (NWAVES * 64);
    unsigned char* ws = a.ws; float* dout = a.out;
    unsigned* ctl = (unsigned*)(ws + WS_CTL);
    float* ROPE = (float*)(ws + WS_ROPE);
    float* CSV = (float*)(ws + 32768); float* BWV = (float*)(ws + 49152); float* ST0 = (float*)(ws + 262144); float* ST1 = (float*)(ws + 524288);
    bf16_t* WA_t = (bf16_t*)(ws + WS_WA); bf16_t* WB_t = (bf16_t*)(ws + WS_WB); bf16_t* WM_t = (bf16_t*)(ws + WS_WM); bf16_t* WO_t = (bf16_t*)(ws + WS_WO);
    bf16_t* MEMB = (bf16_t*)(ws + WS_MEMB); bf16_t* MKV = (bf16_t*)(ws + WS_MKV); bf16_t* CMK = (bf16_t*)(ws + WS_CMK); bf16_t* CMV = (bf16_t*)(ws + WS_CMV);
    bf16_t* KSW = (bf16_t*)(ws + WS_KSW); bf16_t* VSW = (bf16_t*)(ws + WS_VSW); bf16_t* XA = (bf16_t*)(ws + WS_XA); bf16_t* ZB = XA;
    bf16_t* MIX = (bf16_t*)(ws + WS_MIX); bf16_t* Z1B = (bf16_t*)(ws + WS_Z0); bf16_t* PA = (bf16_t*)(ws + WS_PA); bf16_t* PB = PA;
    bf16_t* KS = (bf16_t*)(ws + WS_KS); bf16_t* VS = (bf16_t*)(ws + WS_VS);
    const int lo = a.ph_lo, hi_ph = a.ph_hi;
#define IN(k) (lo <= (k) && (k) < hi_ph)
    if (tid < 64) MISC[tid] = 0u;
    __syncthreads();
    XcdBarrier xbar = xcd_barrier_post(ctl + 1024, MISC + 8);
    if (a.ph_lo > 1000) grid.sync();
#define SEAM(k) do { if (IN(k) && IN((k) + 1)) xcd_barrier(xbar); } while (0)
    att::Ctx cx; cx.lds = lds; cx.lane = lane; cx.wid = wave; cx.r32 = lane & 31; cx.hi = lane >> 5;

    if (IN(0)) {
        LAS float* scr = (LAS float*)(lds + wave * 16384);
        for (int it = gw; it < 4736; it += NGW) {
            int r = it;
            if (r < 1536) { p0_transpose_item(a.in[9], DM, NA, WA_t, 0, scr, r, lane); continue; } r -= 1536;
            if (r < 1024) { p0_transpose_item_ln(a.in[15], DM, 2048, WB_t, 0, scr, r, lane, a.in[20], a.in[21], CSV, BWV); continue; } r -= 1024;
            if (r < 128) { p0_transpose_item_ln(a.in[17], DM, 256, WB_t, 2048, scr, r, lane, a.in[20], a.in[21], CSV, BWV); continue; } r -= 128;
            if (r < 1024) { const int l = r >> 9; p0_transpose_item(a.in[18] + (size_t)l * DM * DM, DM, DM, WM_t, l * 1024, scr, r & 511, lane); continue; } r -= 1024;
            { const int l = r >> 9; p0_transpose_item(a.in[19] + (size_t)l * DM * DM, DM, DM, WO_t, l * 1024, scr, r & 511, lane); }
        }
        for (long i = gtid; i < 2097152; i += NTHR) cvt8(a.in[0] + i * 8, XA + i * 8);
        for (long i = gtid; i < 32768; i += NTHR) cvt8(a.in[1] + i * 8, XA + (size_t)NP * DM + i * 8);
        for (long i = gtid; i < 131072; i += NTHR) cvt8(a.in[2] + i * 8, MEMB + i * 8);
        for (long i = gtid; i < 524288; i += NTHR) { cvt8(a.in[7] + i * 8, CMK + i * 8); cvt8(a.in[8] + i * 8, CMV + i * 8); }
        for (long i = gtid; i < 32768; i += NTHR) { const long b = i >> 11, r = i & 2047; const size_t d = (size_t)b * SWROWS * 128 + r * 8;
            cvt8(a.in[5] + i * 8, KSW + d); cvt8(a.in[6] + i * 8, VSW + d);
            const int rw = (int)(r >> 4);
            if (rw >= 16) { const size_t od = ((size_t)b * 128 + rw - 16) * 128 + (r & 15) * 8;
                *(f32x4*)(dout + OFF_SKS + od) = *(const f32x4*)(a.in[5] + i * 8); *(f32x4*)(dout + OFF_SKS + od + 4) = *(const f32x4*)(a.in[5] + i * 8 + 4);
                *(f32x4*)(dout + OFF_SVS + od) = *(const f32x4*)(a.in[6] + i * 8); *(f32x4*)(dout + OFF_SVS + od + 4) = *(const f32x4*)(a.in[6] + i * 8 + 4); } }
        for (long i = gtid; i < 49152; i += NTHR) { const long b = i / 3072, r = i % 3072; const size_t d = ((size_t)b * KSROWS + 4112) * 512 + r * 8;
            *(u32x4*)(KS + d) = (u32x4){0u, 0u, 0u, 0u}; *(u32x4*)(VS + d) = (u32x4){0u, 0u, 0u, 0u}; }
        for (long i = gtid; i < 12288; i += NTHR) { const long b = i / 768, r = i % 768; const size_t d = ((size_t)b * SWROWS + 144) * 128 + r * 8;
            *(u32x4*)(KSW + d) = (u32x4){0u, 0u, 0u, 0u}; *(u32x4*)(VSW + d) = (u32x4){0u, 0u, 0u, 0u}; }
        for (long i = gtid; i < 4112 * 8; i += NTHR) { const int pos = (int)(i >> 3), fi = (int)(i & 7);
            const double inv = fi == 0 ? 1.0 : fi == 1 ? 0.19392274474868576 : fi == 2 ? 0.03760603093086393 : fi == 3 ? 0.007292664737217109 :
                               fi == 4 ? 0.001414213562373095 : fi == 5 ? 0.0002742481756762073 : fi == 6 ? 5.318295896944988e-05 : 1.031338537721246e-05;
            const double rev = (double)pos * inv * 0.15915494309189535; const float fr = (float)(rev - __builtin_rint(rev));
            ROPE[i * 2] = __builtin_amdgcn_cosf(fr); ROPE[i * 2 + 1] = __builtin_amdgcn_sinf(fr); }
    }
    SEAM(0);
    if (IN(1)) {
        pg8::Gemm g{XA, WA_t, NP, NA, DM}; pg8::StaticOrder S; S.init(NP, NA, G, (int)blockIdx.x);
        EpiWrap<EpiAF> E{{PA, dout, KS, VS, ROPE, 0.f, 0.f}, 0, 0};
        pg8::gemm_phase<EpiWrap<EpiAF>, pg8::StaticOrder, true, true>(lds, g, S, E);
    }
    SEAM(1);
    if (IN(2)) {
        float s1 = 0.f, s2 = 0.f;
        for (int i = 0; i < 64; ++i) { s1 += a.in[10][i] * a.in[11][i]; s2 += a.in[12][i] * a.in[13][i]; }
        if (tid == 0) MISC[2] = __float_as_uint(__expf(s1) - __expf(s2) + 0.2f);
        __syncthreads();
        unsigned* gdone = ctl + 256 + 64 * a.rep;
        if (blockIdx.x < 44) {
            if (blockIdx.x < 32) { pg8::Gemm g{MEMB, WM_t, 1024, 2048, DM}; pg8::StaticOrder S; S.init(1024, 2048, 32, (int)blockIdx.x);
                EpiWrap<EpiMemF> E{{MKV, dout, 0.f, 0.f}, 0, 0};
                pg8::gemm_phase<EpiWrap<EpiMemF>, pg8::StaticOrder, true, true>(lds, g, S, E); }
            else { pg8::Gemm g{XA + (size_t)NP * DM, WA_t, 256, NA, DM}; pg8::StaticOrder S; S.init(256, NA, 12, (int)blockIdx.x - 32);
                EpiWrap<EpiAF> E{{PA, dout, KS, VS, ROPE, 0.f, 0.f}, NP, 0};
                pg8::gemm_phase<EpiWrap<EpiAF>, pg8::StaticOrder, true, true>(lds, g, S, E); }
            asm volatile("s_waitcnt vmcnt(0)" ::: "memory"); __syncthreads();
            if (tid == 0) { __builtin_amdgcn_fence(__ATOMIC_RELEASE, "agent"); asm volatile("s_waitcnt vmcnt(0)" ::: "memory");
                            __hip_atomic_fetch_add(gdone, 1u, __ATOMIC_RELAXED, __HIP_MEMORY_SCOPE_AGENT); }
        }
        bool ready = false;
        float* PART = (float*)(ws + WS_Z0 + 40 * MiB + (size_t)a.rep * (10 * MiB));
        for (;;) {
            if (tid == 0) MISC[0] = atomicAdd(ctl + 128 * a.rep, 1u);
            __syncthreads(); const unsigned u = MISC[0]; __syncthreads();
            if (u >= 1088u) break;
            const bool needs = (u >= 256u && u < 512u) || u >= 768u;
            if (needs && !ready) {
                if (tid == 0) { unsigned sp = 0; while (__hip_atomic_load(gdone, __ATOMIC_RELAXED, __HIP_MEMORY_SCOPE_AGENT) < 44u && ++sp < (1u << 24)) __builtin_amdgcn_s_sleep(8);
                                __builtin_amdgcn_fence(__ATOMIC_ACQUIRE, "agent"); asm volatile("s_waitcnt vmcnt(0)" ::: "memory"); }
                __syncthreads(); ready = true;
            }
            if (u < 768u) {
                const float lam = __uint_as_float(MISC[2]);
                if (u >= 256u && u < 512u) { const unsigned v = u - 256u;
                    att::diff_sample_item(cx, (int)(v >> 4), (int)((v >> 2) & 3u), (int)(v & 3u), a.in[3], a.in[4], PA, KS, VS, MIX, a.in[14], lam, PART, ctl + 512 + 64 * a.rep, MISC); }
                else { const unsigned v = u < 256u ? u : u - 256u;
                    att::diff_unit(cx, false, (int)((v & 15u) >> 2), (int)(v & 3u), 31 - (int)(v >> 4), PA, KS, VS, MIX, a.in[14], lam); } }
            else { const bool samp = u >= 1024u; const unsigned v = samp ? u - 1024u : u - 768u;
                const int b = samp ? (int)(v >> 2) : (int)(v >> 6), h = samp ? (int)(v & 3u) : (int)((v >> 4) & 3u), qb = samp ? 0 : (int)(v & 15u);
                const bf16_t* Kb = samp ? CMK + ((size_t)b * 256) * 512 + h * 128 : MKV + ((size_t)b * 256) * 2048 + h * 128;
                const bf16_t* Vb = samp ? CMV + ((size_t)b * 256) * 512 + h * 128 : Kb + 512;
                att::mem_unit(cx, samp, b, h, qb, PA, NA, 2048, 2560, Kb, Vb, samp ? 512 : 2048, MIX); }
        }
    }
    SEAM(2);
    if (IN(3)) {
        EpiMerge0F F0{ZB, ST0, 0.f, 0.f};
        { pg8::Gemm g{MIX, WO_t, NP, DM, DM}; pg8::StaticOrder S; S.init(NP, DM, G, (int)blockIdx.x);
          EpiWrap<EpiMerge0F> E{F0, 0, 0};
          pg8::gemm_phase<EpiWrap<EpiMerge0F>, pg8::StaticOrder, true, true>(lds, g, S, E); }
        gemm_small<EpiMerge0F>(lds, MIX + (size_t)NP * DM, WO_t, DM, NP, (int)blockIdx.x, G, F0);
    }
    SEAM(3);
    if (IN(5)) {
        EpiBF FB{PB, dout, KSW, VSW, ROPE, ST0, CSV, BWV, 0.f, 0.f, {0.f, 0.f}, {0.f, 0.f}};
        { pg8::Gemm g{ZB, WB_t, NP, 2048, DM}; pg8::StaticOrder S; S.init(NP, 2048, G, (int)blockIdx.x);
          EpiWrap<EpiBF> E{FB, 0, 0};
          pg8::gemm_phase<EpiWrap<EpiBF>, pg8::StaticOrder, true, true>(lds, g, S, E); }
    }
    SEAM(5);
    if (IN(6)) {
        unsigned* gdone = ctl + 384 + 64 * a.rep;
        {
            EpiBF FB{PB, dout, KSW, VSW, ROPE, ST0, CSV, BWV, 0.f, 0.f, {0.f, 0.f}, {0.f, 0.f}};
            if (blockIdx.x < 64) { pg8::Gemm g{ZB, WB_t + (size_t)2048 * DM, NP, 256, DM}; pg8::StaticOrder S; S.init(NP, 256, 64, (int)blockIdx.x);
                EpiWrap<EpiBF> E{FB, 0, 2048};
                pg8::gemm_phase<EpiWrap<EpiBF>, pg8::StaticOrder, true, true>(lds, g, S, E); }
            else { gemm_small<EpiBF>(lds, ZB + (size_t)NP * DM, WB_t, 2048, NP, (int)blockIdx.x - 64, 192, FB);
                   if (blockIdx.x >= 192) gemm_small<EpiBF>(lds, ZB + (size_t)NP * DM, WB_t + (size_t)2048 * DM, 256, NP, (int)blockIdx.x - 192, 64, FB, 2048); }
            asm volatile("s_waitcnt vmcnt(0)" ::: "memory"); __syncthreads();
            if (tid == 0) { __builtin_amdgcn_fence(__ATOMIC_RELEASE, "agent"); asm volatile("s_waitcnt vmcnt(0)" ::: "memory");
                            __hip_atomic_fetch_add(gdone + (blockIdx.x < 64 ? 0 : 16), 1u, __ATOMIC_RELAXED, __HIP_MEMORY_SCOPE_AGENT); }
        }
        bool ready1 = false, ready2 = false;
        for (;;) {
            if (tid == 0) MISC[0] = atomicAdd(ctl + 64 + 128 * a.rep, 1u);
            __syncthreads(); const unsigned u = MISC[0]; __syncthreads();
            if (u >= 848u) break;
            const bool need1 = u >= 256u && u < 768u, need2 = u >= 768u;
            if ((need1 && !ready1) || (need2 && !ready2)) {
                if (tid == 0) { unsigned sp = 0; unsigned* w = need1 ? gdone : gdone + 16; const unsigned want = need1 ? 64u : 192u;
                                while (__hip_atomic_load(w, __ATOMIC_RELAXED, __HIP_MEMORY_SCOPE_AGENT) < want && ++sp < (1u << 24)) __builtin_amdgcn_s_sleep(8);
                                __builtin_amdgcn_fence(__ATOMIC_ACQUIRE, "agent"); asm volatile("s_waitcnt vmcnt(0)" ::: "memory"); }
                __syncthreads(); if (need1) ready1 = true; else ready2 = true;
            }
            const bool is_mem = u < 256u || (u >= 768u && u < 832u);
            if (is_mem) { const bool samp = u >= 768u; const unsigned v = samp ? u - 768u : u;
                const int b = samp ? (int)(v >> 2) : (int)(v >> 6), h = samp ? (int)(v & 3u) : (int)((v >> 4) & 3u), qb = samp ? 0 : (int)(v & 15u);
                const bf16_t* Kb = samp ? CMK + ((size_t)(16 + b) * 256) * 512 + h * 128 : MKV + ((size_t)b * 256) * 2048 + 1024 + h * 128;
                const bf16_t* Vb = samp ? CMV + ((size_t)(16 + b) * 256) * 512 + h * 128 : Kb + 512;
                att::mem_unit(cx, samp, b, h, qb, PB, NB, 1024, 1536, Kb, Vb, samp ? 512 : 2048, MIX); }
            else { const bool samp = u >= 832u; const unsigned v = samp ? u - 832u : u - 256u;
                const int b = samp ? (int)v : (int)(v >> 7), c = samp ? 0 : (int)((v >> 1) & 63u), half = samp ? 0 : (int)(v & 1u);
                att::swa_unit(cx, samp, b, c, half, PB, KSW, VSW, MIX, a.in[16]); }
        }
    }
    SEAM(6);
    if (IN(7)) {
        EpiMerge1F F1{ZB, ST0, a.in[20], a.in[21], Z1B, ST1, 0.f, 0.f, {0.f, 0.f}, {0.f, 0.f}};
        { pg8::Gemm g{MIX, WO_t + (size_t)DM * DM, NP, DM, DM}; pg8::StaticOrder S; S.init(NP, DM, G, (int)blockIdx.x);
          EpiWrap<EpiMerge1F> E{F1, 0, 0};
          pg8::gemm_phase<EpiWrap<EpiMerge1F>, pg8::StaticOrder, true, true>(lds, g, S, E); }
        gemm_small<EpiMerge1F>(lds, MIX + (size_t)NP * DM, WO_t + (size_t)DM * DM, DM, NP, (int)blockIdx.x, G, F1);
    }
    SEAM(7);
    if (IN(8)) {
        const float* g1 = a.in[20] + DM; const float* b1 = a.in[21] + DM;
#pragma unroll 4
        for (long i = gtid; i < (long)MA * 256; i += NTHR) { const int row = (int)(i >> 8), c4 = (int)(i & 255) * 4;
            float mu, rstd; row_stats(ST1, row, mu, rstd);
            const u32x2 zz = __builtin_nontemporal_load((const u32x2*)(Z1B + (size_t)row * DM + c4));
            const f32x4 z = (f32x4){bflo(zz.x), bfhi(zz.x), bflo(zz.y), bfhi(zz.y)};
            __builtin_nontemporal_store((z - mu) * rstd * *(const f32x4*)(g1 + c4) + *(const f32x4*)(b1 + c4), (f32x4*)(dout + (size_t)row * DM + c4)); }
    }
#undef IN
#undef SEAM
}

#ifndef MK_N_LAUNCHES
#define MK_N_LAUNCHES 1
#endif
#ifndef PROBE_DUP
#define PROBE_DUP 0
#endif
extern "C" void kernel_launch(void* const* d_in, const int* in_sizes, int n_in, void* d_out, int out_size, void* d_ws, size_t ws_size, hipStream_t stream) {
    static int grid = 0;
    if (grid == 0) {
        if (n_in != 22 || ws_size < WS_END) { fprintf(stderr, "kernel_launch: unexpected n_in %d / ws %zu\n", n_in, ws_size); grid = -1; return; }
        int dev = 0, cus = 0, per_cu = 0;
        if (hipGetDevice(&dev) != hipSuccess || hipDeviceGetAttribute(&cus, hipDeviceAttributeMultiprocessorCount, dev) != hipSuccess) { grid = -1; return; }
        if (hipFuncSetAttribute((const void*)yoco_fwd, hipFuncAttributeMaxDynamicSharedMemorySize, LDS_BYTES) != hipSuccess) { fprintf(stderr, "kernel_launch: hipFuncSetAttribute failed\n"); grid = -1; return; }
        if (hipOccupancyMaxActiveBlocksPerMultiprocessor(&per_cu, (const void*)yoco_fwd, NWAVES * 64, LDS_BYTES) != hipSuccess || per_cu < 1) { fprintf(stderr, "kernel_launch: occupancy query says %d\n", per_cu); per_cu = 1; }
        (void)hipGetLastError();
        grid = cus;
    }
    if (grid < 0) return;
    (void)hipMemsetAsync((char*)d_ws + WS_CTL, 0, 1048576, stream);
    Args a{};
    for (int i = 0; i < 22; ++i) a.in[i] = (const float*)d_in[i];
    a.out = (float*)d_out; a.ws = (unsigned char*)d_ws;
#if MK_N_LAUNCHES == 1
    a.ph_lo = 0; a.ph_hi = NPHASE;
    void* args[] = {&a};
    hipError_t e = hipLaunchCooperativeKernel((const void*)yoco_fwd, dim3(grid), dim3(NWAVES * 64), args, LDS_BYTES, stream);
    if (e != hipSuccess) fprintf(stderr, "kernel_launch: cooperative launch failed: %s (grid %d)\n", hipGetErrorString(e), grid);
#else
    for (int p = 0; p < NPHASE; ++p) { a.ph_lo = p; a.ph_hi = p + 1;
        for (int r = 0; r < 1 + ((PROBE_DUP >> p) & 1); ++r) { a.rep = r; hipLaunchKernelGGL(yoco_fwd, dim3(grid), dim3(NWAVES * 64), LDS_BYTES, stream, a); } }
#endif
}
```

```cpp
#include <hip/hip_runtime.h>
#include <hip/hip_cooperative_groups.h>
#include <cstdio>
#include <cstdint>
namespace cg = cooperative_groups;
namespace pg8 {
#define PG8_LAS __attribute__((address_space(3)))
typedef unsigned short bf16_t;
typedef short bf16x8 __attribute__((ext_vector_type(8)));
typedef float f32x4 __attribute__((ext_vector_type(4)));
typedef unsigned u32x4 __attribute__((ext_vector_type(4)));
constexpr int BM = 256, BK = 64, HALF = 128, HTB = HALF * BK * 2  , STAGE_BYTES = 8 * HTB, NXCD = 8, WGM = 8;

__host__ __device__ __forceinline__ int lds_byte(int r, int c) { const int st = (r >> 4) * 2 + (c >> 5), rr = r & 15, cc = c & 31, ob = rr * 64 + cc * 2; return st * 1024 + (ob ^ (((ob >> 9) & 1) << 5)); }
__host__ __device__ __forceinline__ void stage_rc(int b, int& R, int& C) { const int st = b / 1024, sb = b % 1024, swz = sb ^ (((sb >> 9) & 1) << 5); R = (st >> 1) * 16 + swz / 64; C = (st & 1) * 32 + (swz % 64) / 2; }
__host__ __device__ __forceinline__ int perm32(int rho) { const int n = rho >> 4, i = rho & 15; return 8 * (i >> 2) + 4 * n + (i & 3); }

struct Unit { int pm, pn; };
struct Gemm { const bf16_t* A; const bf16_t* Bt; int M, N, K; };

struct StaticOrder {
    int nM, nN, nwg, G, c;
    __host__ __device__ void init(int M, int N, int G_, int c_) { nM = M / BM; nN = N / BM; nwg = nM * nN; G = G_; c = c_; }
    __host__ __device__ bool next(int i, Unit& u) const {
        const long L = (long)i * G + c; if (L >= nwg) return false;
        int wgid = (int)L; { const int q = nwg / NXCD, r = nwg % NXCD, xcd = wgid % NXCD, off = wgid / NXCD; wgid = (xcd < r ? xcd * (q + 1) : r * (q + 1) + (xcd - r) * q) + off; }
        const int nig = WGM * nN, gid = wgid / nig, fm = gid * WGM, gsz = (nM - fm) < WGM ? (nM - fm) : WGM;
        u.pm = fm + ((wgid % nig) % gsz); u.pn = (wgid % nig) / gsz; return true;
    }
    __device__ __forceinline__ void a_ready(const Unit&) const {}
    __device__ __forceinline__ void done(const Unit&) const {}
};
__device__ __forceinline__ unsigned cvt_pk_bf16(float lo, float hi) { unsigned r; asm volatile("v_cvt_pk_bf16_f32 %0, %1, %2" : "=v"(r) : "v"(lo), "v"(hi)); return r; }
typedef float f32x2 __attribute__((ext_vector_type(2)));
template <class Epi, class Sched, bool ALIGN_EPI = false, bool SP2 = false>
__device__ __forceinline__ void gemm_phase(PG8_LAS unsigned char* lds, const Gemm g, const Sched& S, const Epi& E) {
    const int tid = threadIdx.x, wid = __builtin_amdgcn_readfirstlane(tid >> 6), lane = tid & 63, wr = wid >> 2, wc = wid & 3, fr = lane & 15, fq = lane >> 4;
    const int K = g.K, nt = K / BK;
    unsigned voffA[2], voffB[2];
#pragma unroll
    for (int i = 0; i < 2; ++i) { int R, C; stage_rc(tid * 16 + i * 8192, R, C); const int Rb = Epi::PERM ? ((R & ~31) + perm32(R & 31)) : R;
        voffA[i] = (unsigned)(R * K + C) * 2u; voffB[i] = (unsigned)(Rb * K + C) * 2u; }
    const size_t kstep = (size_t)(BK * 2);
    const size_t hstep = (size_t)HALF * K * 2;
    const size_t tstep = 2 * hstep;
    const unsigned ldsw = (unsigned)wid * 1024u;
    const int aoff = lds_byte(wr * 64 + fr, fq * 8), boff = lds_byte(wc * 32 + fr, fq * 8);
#define PG8_SA(b, h) (((b) * 2 + (h)) * HTB)
#define PG8_SB(b, h) ((4 + (b) * 2 + (h)) * HTB)
#define PG8_STAGE(bufoff, gbase, voff) do { _Pragma("unroll") for (int _i = 0; _i < 2; ++_i) \
        __builtin_amdgcn_global_load_lds((const unsigned*)((const char*)(gbase) + (voff)[_i]), (PG8_LAS unsigned*)(lds + (bufoff) + ldsw + _i * 8192), 16, 0, 0); } while (0)
#define PG8_LDA(dst, b, h) do { _Pragma("unroll") for (int m = 0; m < 4; ++m) _Pragma("unroll") for (int k = 0; k < 2; ++k) dst[m][k] = *(const PG8_LAS bf16x8*)(lds + PG8_SA(b, h) + aoff + m * 2048 + k * 1024); } while (0)
#define PG8_LDB(dst, b, h) do { _Pragma("unroll") for (int n = 0; n < 2; ++n) _Pragma("unroll") for (int k = 0; k < 2; ++k) dst[n][k] = *(const PG8_LAS bf16x8*)(lds + PG8_SB(b, h) + boff + n * 2048 + k * 1024); } while (0)
#define PG8_MMA(ai, bj, At, Bt) do { __builtin_amdgcn_s_setprio(1); _Pragma("unroll") for (int m = 0; m < 4; ++m) _Pragma("unroll") for (int n = 0; n < 2; ++n) _Pragma("unroll") for (int k = 0; k < 2; ++k) \
        acc[ai][bj][m][n] = __builtin_amdgcn_mfma_f32_16x16x32_bf16(Bt[n][k], At[m][k], acc[ai][bj][m][n], 0, 0, 0); __builtin_amdgcn_s_setprio(0); } while (0)
#define PG8_WAIT_V(n) asm volatile("s_waitcnt vmcnt(" #n ")" ::: "memory")
#define PG8_WAIT_L(n) asm volatile("s_waitcnt lgkmcnt(" #n ")" ::: "memory")
#define PG8_BAR __builtin_amdgcn_s_barrier()
#define PG8_SCHED __builtin_amdgcn_sched_barrier(0)
    Unit cur, nxt; int ui = 0;
    if (!S.next(0, cur)) return;
    f32x4 acc[2][2][4][2];
#pragma unroll
    for (int a = 0; a < 2; ++a)
#pragma unroll
        for (int b = 0; b < 2; ++b)
#pragma unroll
            for (int m = 0; m < 4; ++m)
#pragma unroll
                for (int n = 0; n < 2; ++n) acc[a][b][m][n] = (f32x4){0.f, 0.f, 0.f, 0.f};
    bf16x8 At[4][2], B0[2][2], B1[2][2];
    const char* cA = (const char*)g.A + (size_t)cur.pm * tstep; const char* cB = (const char*)g.Bt + (size_t)cur.pn * tstep;
    S.a_ready(cur);
    if constexpr (SP2) {
        PG8_STAGE(PG8_SB(0, 0), cB, voffB); PG8_STAGE(PG8_SB(0, 1), cB + hstep, voffB); PG8_STAGE(PG8_SA(0, 0), cA, voffA); PG8_STAGE(PG8_SA(0, 1), cA + hstep, voffA);
        if (wr == 1) PG8_BAR;
        PG8_WAIT_V(2); PG8_BAR;
        PG8_STAGE(PG8_SB(1, 0), cB + kstep, voffB); PG8_STAGE(PG8_SA(1, 0), cA + kstep, voffA); PG8_STAGE(PG8_SB(1, 1), cB + hstep + kstep, voffB);
        PG8_WAIT_V(6); PG8_BAR;
    } else {
        PG8_STAGE(PG8_SB(0, 0), cB, voffB); PG8_STAGE(PG8_SA(0, 0), cA, voffA); PG8_STAGE(PG8_SB(0, 1), cB + hstep, voffB); PG8_STAGE(PG8_SA(0, 1), cA + hstep, voffA);
        if (wr == 1) PG8_BAR;
        PG8_WAIT_V(4); PG8_BAR;
        PG8_STAGE(PG8_SB(1, 0), cB + kstep, voffB); PG8_STAGE(PG8_SA(1, 0), cA + kstep, voffA); PG8_STAGE(PG8_SB(1, 1), cB + hstep + kstep, voffB);
        PG8_WAIT_V(6); PG8_BAR;
    }
    for (;;) {
        const bool has_next = S.next(ui + 1, nxt);
        const char* nA = has_next ? (const char*)g.A + (size_t)nxt.pm * tstep : cA; const char* nB = has_next ? (const char*)g.Bt + (size_t)nxt.pn * tstep : cB;
        for (int t = 0; t < nt; t += 2) {
            const bool last = (t == nt - 2);
            const char* a1 = cA + (size_t)(t + 1) * kstep;
            const char* a2 = last ? nA : cA + (size_t)(t + 2) * kstep; const char* b2 = last ? nB : cB + (size_t)(t + 2) * kstep;
            const char* a3 = a2 + kstep; const char* b3 = b2 + kstep;
            if (last && has_next) S.a_ready(nxt);
            if constexpr (SP2) {
            PG8_LDB(B0, 0, 0); PG8_LDB(B1, 0, 1); PG8_SCHED; PG8_LDA(At, 0, 0); PG8_STAGE(PG8_SA(1, 1), a1 + hstep, voffA);
            PG8_WAIT_V(8); PG8_WAIT_L(0); PG8_BAR; PG8_MMA(0, 0, At, B0); PG8_MMA(0, 1, At, B1); PG8_BAR; PG8_SCHED;
            PG8_LDA(At, 0, 1); PG8_STAGE(PG8_SB(0, 0), b2, voffB); PG8_STAGE(PG8_SB(0, 1), b2 + hstep, voffB); PG8_STAGE(PG8_SA(0, 0), a2, voffA);
            PG8_WAIT_V(8); PG8_WAIT_L(0); PG8_BAR; PG8_MMA(1, 0, At, B0); PG8_MMA(1, 1, At, B1); PG8_BAR; PG8_SCHED;
            PG8_LDB(B0, 1, 0); PG8_LDB(B1, 1, 1); PG8_SCHED; PG8_LDA(At, 1, 0); PG8_STAGE(PG8_SA(0, 1), a2 + hstep, voffA);
            PG8_WAIT_V(8); PG8_WAIT_L(0); PG8_BAR; PG8_MMA(0, 0, At, B0); PG8_MMA(0, 1, At, B1); PG8_BAR; PG8_SCHED;
            PG8_LDA(At, 1, 1); PG8_STAGE(PG8_SB(1, 0), b3, voffB); PG8_STAGE(PG8_SB(1, 1), b3 + hstep, voffB); PG8_STAGE(PG8_SA(1, 0), a3, voffA);
            PG8_WAIT_V(8); PG8_WAIT_L(0); PG8_BAR; PG8_MMA(1, 0, At, B0); PG8_MMA(1, 1, At, B1); PG8_BAR; PG8_SCHED;
            } else {
            PG8_LDB(B0, 0, 0); PG8_SCHED; PG8_LDA(At, 0, 0); PG8_STAGE(PG8_SA(1, 1), a1 + hstep, voffA);
            PG8_WAIT_L(8); PG8_BAR; PG8_WAIT_L(0); PG8_MMA(0, 0, At, B0); PG8_BAR; PG8_SCHED;
            PG8_LDB(B1, 0, 1); PG8_STAGE(PG8_SB(0, 0), b2, voffB);
            PG8_BAR; PG8_WAIT_L(0); PG8_MMA(0, 1, At, B1); PG8_BAR;
            PG8_LDA(At, 0, 1); PG8_STAGE(PG8_SA(0, 0), a2, voffA);
            PG8_BAR; PG8_WAIT_L(0); PG8_MMA(1, 0, At, B0); PG8_BAR; PG8_SCHED;
            PG8_STAGE(PG8_SB(0, 1), b2 + hstep, voffB);
            PG8_WAIT_V(6); PG8_BAR; PG8_MMA(1, 1, At, B1); PG8_BAR;
            PG8_LDB(B0, 1, 0); PG8_SCHED; PG8_LDA(At, 1, 0); PG8_STAGE(PG8_SA(0, 1), a2 + hstep, voffA);
            PG8_WAIT_L(8); PG8_BAR; PG8_WAIT_L(0); PG8_MMA(0, 0, At, B0); PG8_BAR; PG8_SCHED;
            PG8_LDB(B1, 1, 1); PG8_STAGE(PG8_SB(1, 0), b3, voffB);
            PG8_BAR; PG8_WAIT_L(0); PG8_MMA(0, 1, At, B1); PG8_BAR;
            PG8_LDA(At, 1, 1); PG8_STAGE(PG8_SA(1, 0), a3, voffA);
            PG8_BAR; PG8_WAIT_L(0); PG8_MMA(1, 0, At, B0); PG8_BAR; PG8_SCHED;
            PG8_STAGE(PG8_SB(1, 1), b3 + hstep, voffB);
            PG8_WAIT_V(6); PG8_BAR; PG8_MMA(1, 1, At, B1); PG8_BAR;
            }
        }
        if constexpr (ALIGN_EPI) { if (wr == 0) PG8_BAR; }
        if constexpr (!Epi::AFTER_DRAIN) { E(acc, cur, wr, wc, fr, fq); S.done(cur); }
        if (!has_next) break;
#pragma unroll
        for (int a = 0; a < 2; ++a)
#pragma unroll
            for (int b = 0; b < 2; ++b)
#pragma unroll
                for (int m = 0; m < 4; ++m)
#pragma unroll
                    for (int n = 0; n < 2; ++n) acc[a][b][m][n] = (f32x4){0.f, 0.f, 0.f, 0.f};
        cur = nxt; cA = nA; cB = nB; ++ui;
        if constexpr (ALIGN_EPI) { if (wr == 1) PG8_BAR; }
    }
    PG8_WAIT_V(0);
    if constexpr (!ALIGN_EPI) { if (wr == 0) PG8_BAR; }
    PG8_BAR;
    if constexpr (Epi::AFTER_DRAIN) { E.fused(acc, cur, wr, wc, fr, fq, lds, wid, lane); S.done(cur); }
#undef PG8_SA
#undef PG8_SB
#undef PG8_STAGE
#undef PG8_LDA
#undef PG8_LDB
#undef PG8_MMA
#undef PG8_WAIT_V
#undef PG8_WAIT_L
#undef PG8_BAR
#undef PG8_SCHED
}
}

typedef unsigned short bf16_t;
typedef short bf16x8 __attribute__((ext_vector_type(8)));
typedef short s16x4 __attribute__((ext_vector_type(4)));
typedef float f32x4 __attribute__((ext_vector_type(4)));
typedef float f32x16 __attribute__((ext_vector_type(16)));
typedef unsigned u32x4 __attribute__((ext_vector_type(4)));
typedef unsigned u32x2 __attribute__((ext_vector_type(2)));
#define LAS __attribute__((address_space(3)))

constexpr int DM = 1024, NP = 16384, NS = 256, MA = NP + NS;
constexpr int NA = 3072, NB = 2304;
constexpr int KSROWS = 4160, SWROWS = 192;
constexpr float DN_ALPHA = 1.41421356237309515f;
constexpr float LOG2E = 1.4426950408889634f;
constexpr float C64 = 0.125f * LOG2E, THR64 = 64.f;
constexpr float C128 = 0.088388347648318440f * LOG2E, THR128 = 90.5f;
constexpr size_t OFF_DKP = 17039360, OFF_DVP = 25427968, OFF_DKS = 33816576, OFF_DVS = 33947648, OFF_SKP = 34078720, OFF_SVP = 34144256,
                 OFF_SKS = 34209792, OFF_SVS = 34471936, OFF_MKP = 34734080, OFF_MVP = 35782656;
constexpr size_t MiB = 1u << 20;
constexpr size_t WS_CTL = 0, WS_ROPE = 1 * MiB, WS_WA = 2 * MiB, WS_WB = 8 * MiB, WS_WM = 13 * MiB, WS_WO = 17 * MiB, WS_MEMB = 21 * MiB, WS_MKV = 23 * MiB,
                 WS_CMK = 27 * MiB, WS_CMV = 35 * MiB, WS_KSW = 43 * MiB, WS_VSW = 44 * MiB, WS_XA = 46 * MiB, WS_MIX = 79 * MiB, WS_Z0 = 112 * MiB,
                 WS_PA = 177 * MiB, WS_KS = 275 * MiB, WS_VS = 340 * MiB, WS_END = 405 * MiB;
constexpr int LDS_RING = 131072, LDS_BYTES = LDS_RING + 256;

__device__ __forceinline__ unsigned cvtpk(float lo, float hi) { unsigned r; asm volatile("v_cvt_pk_bf16_f32 %0, %1, %2" : "=v"(r) : "v"(lo), "v"(hi)); return r; }
__device__ __forceinline__ float bflo(unsigned w) { return __uint_as_float(w << 16); }
__device__ __forceinline__ float bfhi(unsigned w) { return __uint_as_float(w & 0xffff0000u); }
__device__ __forceinline__ float silu(float x) { return x * __builtin_amdgcn_rcpf(1.f + __expf(-x)); }
__device__ __forceinline__ void cvt8(const float* s, bf16_t* d) {
    const f32x4 a = __builtin_nontemporal_load((const f32x4*)s), b = __builtin_nontemporal_load((const f32x4*)(s + 4));
    u32x4 w; w.x = cvtpk(a.x, a.y); w.y = cvtpk(a.z, a.w); w.z = cvtpk(b.x, b.y); w.w = cvtpk(b.z, b.w); __builtin_nontemporal_store(w, (u32x4*)d);
}

__device__ __forceinline__ f32x4 shfl4(f32x4 v, int m) { f32x4 p; p.x = __shfl_xor(v.x, m); p.y = __shfl_xor(v.y, m); p.z = __shfl_xor(v.z, m); p.w = __shfl_xor(v.w, m); return p; }
struct NoPre {};
template <class F> struct EpiWrap {
    static constexpr bool PERM = true, AFTER_DRAIN = false;
    F f; int rowbase, colbase;
    __device__ __forceinline__ void operator()(const f32x4 (&acc)[2][2][4][2], const pg8::Unit& u, int wr, int wc, int fr, int fq) const {
        F lf = f;
#pragma unroll
        for (int ai = 0; ai < 2; ++ai)
#pragma unroll
            for (int mp = 0; mp < 2; ++mp) {
                typename F::Pre pr[2][2][2]; f32x4 vv[2][2][2];
                const int row0 = rowbase + u.pm * 256 + ai * 128 + wr * 64 + mp * 32 + fr, colb = colbase + u.pn * 256 + wc * 32 + 8 * fq;
#pragma unroll
                for (int mm = 0; mm < 2; ++mm) { lf.row_begin(mm, row0 + mm * 16);
#pragma unroll
                    for (int bj = 0; bj < 2; ++bj)
#pragma unroll
                        for (int n = 0; n < 2; ++n) pr[mm][bj][n] = lf.pre(row0 + mm * 16, colb + bj * 128 + n * 4); }
#pragma unroll
                for (int mm = 0; mm < 2; ++mm)
#pragma unroll
                    for (int bj = 0; bj < 2; ++bj)
#pragma unroll
                        for (int n = 0; n < 2; ++n) vv[mm][bj][n] = lf.fix(mm, colb + bj * 128 + n * 4, acc[ai][bj][mp * 2 + mm][n], pr[mm][bj][n]);
#pragma unroll
                for (int mm = 0; mm < 2; ++mm) { const int row = row0 + mm * 16; lf.s = 0.f; lf.q = 0.f;
#pragma unroll
                    for (int bj = 0; bj < 2; ++bj) { const int col = colb + bj * 128; f32x4 p0 = vv[mm][bj][0], p1 = vv[mm][bj][1];
                        if constexpr (F::ROPE) { if (lf.need_rope(col - 8 * fq)) { p0 = shfl4(p0, 16); p1 = shfl4(p1, 16); } }
                        lf.oct(row, col, vv[mm][bj][0], vv[mm][bj][1], p0, p1); }
                    if constexpr (F::STATS) { float s = lf.s, q = lf.q; s += __shfl_xor(s, 16); s += __shfl_xor(s, 32); q += __shfl_xor(q, 16); q += __shfl_xor(q, 32);
                        if (fq == 0) lf.commit(row, s, q); } }
            }
    }
};
__device__ __forceinline__ f32x4 rope_apply(f32x4 v, f32x4 p, int col, int pos, const float* rope) {
    const float* t = rope + ((size_t)pos * 8 + (col & 4)) * 2;
    const f32x4 t0 = *(const f32x4*)t, t1 = *(const f32x4*)(t + 4);
    const float sg = (col & 8) ? 1.f : -1.f;
    f32x4 o; o.x = v.x * t0.x + sg * p.x * t0.y; o.y = v.y * t0.z + sg * p.y * t0.w; o.z = v.z * t1.x + sg * p.z * t1.y; o.w = v.w * t1.z + sg * p.w * t1.w;
    return o;
}
__device__ __forceinline__ void st_bf4(bf16_t* p, f32x4 v) { u32x2 w; w.x = cvtpk(v.x, v.y); w.y = cvtpk(v.z, v.w); *(u32x2*)p = w; }
__device__ __forceinline__ void st_bf8_nt(bf16_t* p, f32x4 a, f32x4 b) { u32x4 w; w.x = cvtpk(a.x, a.y); w.y = cvtpk(a.z, a.w); w.z = cvtpk(b.x, b.y); w.w = cvtpk(b.z, b.w); __builtin_nontemporal_store(w, (u32x4*)p); }
__device__ __forceinline__ void st_bf8(bf16_t* p, f32x4 a, f32x4 b) { u32x4 w; w.x = cvtpk(a.x, a.y); w.y = cvtpk(a.z, a.w); w.z = cvtpk(b.x, b.y); w.w = cvtpk(b.z, b.w); *(u32x4*)p = w; }
__device__ __forceinline__ void row_stats(const float* ST, int row, float& mu, float& rstd) {
    const float s = ST[2 * (size_t)row], q = ST[2 * (size_t)row + 1]; mu = s * (1.f / DM); rstd = rsqrtf(fmaxf(q * (1.f / DM) - mu * mu, 0.f) + 1e-5f);
}

struct EpiAF {
    static constexpr bool ROPE = true, STATS = false; typedef NoPre Pre;
    bf16_t* PA; float* dout; bf16_t* KS; bf16_t* VS; const float* rope; float s, q;
    __device__ __forceinline__ void row_begin(int, int) {}
    __device__ __forceinline__ Pre pre(int, int) const { return Pre{}; }
    __device__ __forceinline__ f32x4 fix(int, int, f32x4 v, const Pre&) const { return v; }
    __device__ __forceinline__ bool need_rope(int col) const { return (col >> 9) < 2 && ((col >> 4) & 3) == 0; }
    __device__ __forceinline__ void commit(int, float, float) {}
    __device__ __forceinline__ void oct(int row, int col, f32x4 v0, f32x4 v1, f32x4 p0, f32x4 p1) {
        const bool samp = row >= NP; const int rs = row - NP;
        const int pos = samp ? 4096 + (rs & 15) : (row & 4095);
        const int region = col >> 9;
        if (need_rope(col)) { v0 = rope_apply(v0, p0, col, pos, rope); v1 = rope_apply(v1, p1, col + 4, pos, rope); }
        st_bf8(PA + (size_t)row * NA + col, v0, v1);
        if (region == 1 || region == 2) {
            const int c = col & 511;
            if (!samp) { float* o = dout + (region == 1 ? OFF_DKP : OFF_DVP) + (size_t)row * 512 + c; __builtin_nontemporal_store(v0, (f32x4*)o); __builtin_nontemporal_store(v1, (f32x4*)(o + 4)); }
            else { float* o = dout + (region == 1 ? OFF_DKS : OFF_DVS) + (size_t)rs * 512 + c; *(f32x4*)o = v0; *(f32x4*)(o + 4) = v1;
                   st_bf8((region == 1 ? KS : VS) + ((size_t)(rs >> 4) * KSROWS + 4096 + (rs & 15)) * 512 + c, v0, v1); }
        }
    }
    __device__ __forceinline__ void quad(int row, int col, f32x4 v, f32x4 p) {
        const bool samp = row >= NP; const int rs = row - NP;
        const int pos = samp ? 4096 + (rs & 15) : (row & 4095);
        const int region = col >> 9;
        if (need_rope(col)) v = rope_apply(v, p, col, pos, rope);
        st_bf4(PA + (size_t)row * NA + col, v);
        if (region == 1 || region == 2) {
            const int c = col & 511;
            if (!samp) __builtin_nontemporal_store(v, (f32x4*)(dout + (region == 1 ? OFF_DKP : OFF_DVP) + (size_t)row * 512 + c));
            else { *(f32x4*)(dout + (region == 1 ? OFF_DKS : OFF_DVS) + (size_t)rs * 512 + c) = v;
                   st_bf4((region == 1 ? KS : VS) + ((size_t)(rs >> 4) * KSROWS + 4096 + (rs & 15)) * 512 + c, v); }
        }
    }
};
struct EpiMemF {
    static constexpr bool ROPE = false, STATS = false; typedef NoPre Pre;
    bf16_t* MKV; float* dout; float s, q;
    __device__ __forceinline__ void row_begin(int, int) {}
    __device__ __forceinline__ Pre pre(int, int) const { return Pre{}; }
    __device__ __forceinline__ f32x4 fix(int, int, f32x4 v, const Pre&) const { return v; }
    __device__ __forceinline__ void commit(int, float, float) {}
    __device__ __forceinline__ void oct(int row, int col, f32x4 v0, f32x4 v1, f32x4, f32x4) {
        st_bf8(MKV + (size_t)row * 2048 + col, v0, v1);
        const int l = col >> 10, c = col & 1023;
        float* o = dout + (c < 512 ? OFF_MKP : OFF_MVP) + (size_t)l * 524288 + (size_t)row * 512 + (c & 511);
        __builtin_nontemporal_store(v0, (f32x4*)o); __builtin_nontemporal_store(v1, (f32x4*)(o + 4));
    }
    __device__ __forceinline__ void quad(int row, int col, f32x4 v, f32x4) {
        st_bf4(MKV + (size_t)row * 2048 + col, v);
        const int l = col >> 10, c = col & 1023;
        __builtin_nontemporal_store(v, (f32x4*)(dout + (c < 512 ? OFF_MKP : OFF_MVP) + (size_t)l * 524288 + (size_t)row * 512 + (c & 511)));
    }
};
struct EpiMerge0F {
    static constexpr bool ROPE = false, STATS = true; typedef u32x2 Pre;
    bf16_t* ZB; float* ST; float s, q;
    __device__ __forceinline__ void row_begin(int, int) {}
    __device__ __forceinline__ Pre pre(int row, int col) const { return *(const u32x2*)(ZB + (size_t)row * DM + col); }
    __device__ __forceinline__ f32x4 fix(int, int, f32x4 v, const Pre& x) const { return (f32x4){bflo(x.x), bfhi(x.x), bflo(x.y), bfhi(x.y)} * DN_ALPHA + v; }
    __device__ __forceinline__ void commit(int row, float ss, float qq) { atomicAdd(ST + 2 * (size_t)row, ss); atomicAdd(ST + 2 * (size_t)row + 1, qq); }
    __device__ __forceinline__ void oct(int row, int col, f32x4 z0, f32x4 z1, f32x4, f32x4) {
        st_bf8(ZB + (size_t)row * DM + col, z0, z1);
        s += ((z0.x + z0.y) + (z0.z + z0.w)) + ((z1.x + z1.y) + (z1.z + z1.w));
        q += ((z0.x * z0.x + z0.y * z0.y) + (z0.z * z0.z + z0.w * z0.w)) + ((z1.x * z1.x + z1.y * z1.y) + (z1.z * z1.z + z1.w * z1.w));
    }
    __device__ __forceinline__ void quad(int row, int col, f32x4 z, f32x4) {
        st_bf4(ZB + (size_t)row * DM + col, z);
        s += (z.x + z.y) + (z.z + z.w); q += (z.x * z.x + z.y * z.y) + (z.z * z.z + z.w * z.w);
    }
};
struct EpiMerge1F {
    static constexpr bool ROPE = false, STATS = true; typedef u32x2 Pre;
    const bf16_t* ZB; const float* ST0; const float* g0; const float* b0; bf16_t* out; float* ST1; float s, q, mu[2], rstd[2];
    __device__ __forceinline__ void row_begin(int sl, int row) { row_stats(ST0, row, mu[sl], rstd[sl]); }
    __device__ __forceinline__ Pre pre(int row, int col) const { return *(const u32x2*)(ZB + (size_t)row * DM + col); }
    __device__ __forceinline__ f32x4 fix(int sl, int col, f32x4 v, const Pre& z) const {
        const f32x4 z0 = (f32x4){bflo(z.x), bfhi(z.x), bflo(z.y), bfhi(z.y)};
        const f32x4 g = *(const f32x4*)(g0 + col), b = *(const f32x4*)(b0 + col); return ((z0 - mu[sl]) * rstd[sl] * g + b) * DN_ALPHA + v; }
    __device__ __forceinline__ void commit(int row, float ss, float qq) { atomicAdd(ST1 + 2 * (size_t)row, ss); atomicAdd(ST1 + 2 * (size_t)row + 1, qq); }
    __device__ __forceinline__ void oct(int row, int col, f32x4 z0, f32x4 z1, f32x4, f32x4) {
        st_bf8(out + (size_t)row * DM + col, z0, z1);
        s += ((z0.x + z0.y) + (z0.z + z0.w)) + ((z1.x + z1.y) + (z1.z + z1.w));
        q += ((z0.x * z0.x + z0.y * z0.y) + (z0.z * z0.z + z0.w * z0.w)) + ((z1.x * z1.x + z1.y * z1.y) + (z1.z * z1.z + z1.w * z1.w));
    }
    __device__ __forceinline__ void quad(int row, int col, f32x4 z, f32x4) {
        st_bf4(out + (size_t)row * DM + col, z);
        s += (z.x + z.y) + (z.z + z.w); q += (z.x * z.x + z.y * z.y) + (z.z * z.z + z.w * z.w);
    }
};
struct PreB { f32x4 c, b; };
struct EpiBF {
    static constexpr bool ROPE = true, STATS = false; typedef PreB Pre;
    bf16_t* PB; float* dout; bf16_t* KSW; bf16_t* VSW; const float* rope; const float* ST0; const float* CS; const float* BW; float s, q, mu[2], rstd[2];
    __device__ __forceinline__ void row_begin(int sl, int row) { row_stats(ST0, row, mu[sl], rstd[sl]); }
    __device__ __forceinline__ Pre pre(int, int col) const { Pre p; p.c = *(const f32x4*)(CS + col); p.b = *(const f32x4*)(BW + col); return p; }
    __device__ __forceinline__ f32x4 fix(int sl, int, f32x4 v, const Pre& p) const { return (v - p.c * mu[sl]) * rstd[sl] + p.b; }
    __device__ __forceinline__ bool need_rope(int col) const { return (col < 512 || (col >= 2048 && col < 2176)) && ((col >> 4) & 3) == 0; }
    __device__ __forceinline__ void commit(int, float, float) {}
    __device__ __forceinline__ void oct(int row, int col, f32x4 v0, f32x4 v1, f32x4 p0, f32x4 p1) {
        const bool samp = row >= NP; const int rs = row - NP;
        const int t = samp ? (rs & 15) : (row & 4095);
        const int pos = samp ? 4096 + t : t;
        const bool isk = col >= 2048 && col < 2176;
        if (need_rope(col)) { v0 = rope_apply(v0, p0, col, pos, rope); v1 = rope_apply(v1, p1, col + 4, pos, rope); }
        st_bf8(PB + (size_t)row * NB + col, v0, v1);
        if (col >= 2048) {
            const int cc = col & 127;
            if (!samp) { if (t >= 3968) { float* o = dout + (isk ? OFF_SKP : OFF_SVP) + ((size_t)(row >> 12) * 128 + (t - 3968)) * 128 + cc; *(f32x4*)o = v0; *(f32x4*)(o + 4) = v1; } }
            else { const int b = rs >> 4;
                   float* o = dout + (isk ? OFF_SKS : OFF_SVS) + ((size_t)b * 128 + 112 + t) * 128 + cc; *(f32x4*)o = v0; *(f32x4*)(o + 4) = v1;
                   st_bf8((isk ? KSW : VSW) + ((size_t)b * SWROWS + 128 + t) * 128 + cc, v0, v1); }
        }
    }
    __device__ __forceinline__ void quad(int row, int col, f32x4 v, f32x4 p) {
        const bool samp = row >= NP; const int rs = row - NP;
        const int t = samp ? (rs & 15) : (row & 4095);
        const int pos = samp ? 4096 + t : t;
        const bool isk = col >= 2048 && col < 2176;
        if (need_rope(col)) v = rope_apply(v, p, col, pos, rope);
        st_bf4(PB + (size_t)row * NB + col, v);
        if (col >= 2048) {
            const int cc = col & 127;
            if (!samp) { if (t >= 3968) *(f32x4*)(dout + (isk ? OFF_SKP : OFF_SVP) + ((size_t)(row >> 12) * 128 + (t - 3968)) * 128 + cc) = v; }
            else { const int b = rs >> 4;
                   *(f32x4*)(dout + (isk ? OFF_SKS : OFF_SVS) + ((size_t)b * 128 + 112 + t) * 128 + cc) = v;
                   st_bf4((isk ? KSW : VSW) + ((size_t)b * SWROWS + 128 + t) * 128 + cc, v); }
        }
    }
};
template <class F> __device__ __forceinline__ void gemm_small(LAS unsigned char* lds, const bf16_t* A, const bf16_t* Bt, int N, int rowbase, int ustart, int G, const F& f, int colbase = 0) {
    const int tid = threadIdx.x, lane = tid & 63, r32 = lane & 31, hi = lane >> 5, wid = __builtin_amdgcn_readfirstlane(tid >> 6);
    const int nu = 8 * (N / 32);
    for (int u = ustart; u < nu; u += G) {
        const int row0 = (u & 7) * 32, colw = (u >> 3) * 32, col0 = colbase + colw;
        const bf16_t* ap = A + (size_t)(row0 + r32) * DM + wid * 128 + hi * 8; const bf16_t* bp = Bt + (size_t)(colw + r32) * DM + wid * 128 + hi * 8;
        bf16x8 af[8], bfr[8];
#pragma unroll
        for (int k = 0; k < 8; ++k) { af[k] = *(const bf16x8*)(ap + 16 * k); bfr[k] = *(const bf16x8*)(bp + 16 * k); }
        f32x16 acc = f32x16{};
#pragma unroll
        for (int k = 0; k < 8; ++k) acc = __builtin_amdgcn_mfma_f32_32x32x16_bf16(bfr[k], af[k], acc, 0, 0, 0);
        LAS float* part = (LAS float*)lds + wid * 1024;
#pragma unroll
        for (int r = 0; r < 16; ++r) part[r * 64 + lane] = acc[r];
        __syncthreads();
        if (wid < 2) {
            F lf = f; f32x4 qd[2];
#pragma unroll
            for (int e = 0; e < 2; ++e) { float t[4];
#pragma unroll
                for (int c = 0; c < 4; ++c) { const int r = 4 * (2 * wid + e) + c; float a = 0.f;
#pragma unroll
                    for (int w = 0; w < 8; ++w) a += ((LAS float*)lds)[w * 1024 + r * 64 + lane];
                    t[c] = a; }
                qd[e] = (f32x4){t[0], t[1], t[2], t[3]}; }
            const int row = rowbase + row0 + r32; typename F::Pre pr[2];
            lf.row_begin(0, row);
#pragma unroll
            for (int e = 0; e < 2; ++e) pr[e] = lf.pre(row, col0 + 8 * (2 * wid + e) + 4 * hi);
#pragma unroll
            for (int e = 0; e < 2; ++e) qd[e] = lf.fix(0, col0 + 8 * (2 * wid + e) + 4 * hi, qd[e], pr[e]);
            lf.s = 0.f; lf.q = 0.f;
#pragma unroll
            for (int e = 0; e < 2; ++e) lf.quad(row, col0 + 8 * (2 * wid + e) + 4 * hi, qd[e], qd[e ^ 1]);
            if constexpr (F::STATS) { float s = lf.s, q = lf.q; s += __shfl_xor(s, 32); q += __shfl_xor(q, 32); if (hi == 0) lf.commit(row, s, q); }
        }
        __syncthreads();
    }
}

namespace att {
#define KSWZ(row, colB) ((row) * 256 + ((colB) ^ (((row) & 7) << 4)))
#define SBAR() __builtin_amdgcn_sched_barrier(0)
__device__ __forceinline__ int v_st(int k, int c) { const int kk = (k & ~0xC) | ((k & 4) << 1) | ((k & 8) >> 1); return ((kk >> 3) * 4 + (c >> 5)) * 512 + ((kk & 7) * 32 + (c & 31)) * 2; }
__device__ __forceinline__ int v_rd_base(int lane) { return ((lane & 3) << 3) | (((lane >> 2) & 3) << 6) | (((lane >> 4) & 1) << 5) | (((lane >> 5) & 1) << 8); }
constexpr int v_rd_off(int d0, int ks, int half) { return d0 * 512 + ks * 4096 + half * 2048; }
template <int OFF> __device__ __forceinline__ s16x4 tr_read(int vb) {
    s16x4 r; asm volatile("ds_read_b64_tr_b16 %0, %1 offset:%2" : "=&v"(r) : "v"(vb), "i"(OFF) : "memory"); return r;
}
template <int OFF> __device__ __forceinline__ bf16x8 lds_read128(int ad) {
    bf16x8 r; asm volatile("ds_read_b128 %0, %1 offset:%2" : "=&v"(r) : "v"(ad), "i"(OFF) : "memory"); return r;
}
template <int D0> __device__ __forceinline__ void pv_one(f32x16& od, int vb, bf16x8 pa0, bf16x8 pa1, bf16x8 pa2, bf16x8 pa3) {
    const s16x4 l0 = tr_read<v_rd_off(D0, 0, 0)>(vb), h0 = tr_read<v_rd_off(D0, 0, 1)>(vb), l1 = tr_read<v_rd_off(D0, 1, 0)>(vb), h1 = tr_read<v_rd_off(D0, 1, 1)>(vb);
    const s16x4 l2 = tr_read<v_rd_off(D0, 2, 0)>(vb), h2 = tr_read<v_rd_off(D0, 2, 1)>(vb), l3 = tr_read<v_rd_off(D0, 3, 0)>(vb), h3 = tr_read<v_rd_off(D0, 3, 1)>(vb);
    asm volatile("s_waitcnt lgkmcnt(0)" ::: "memory"); SBAR();
#define PK(L, H) (bf16x8){L[0], L[1], L[2], L[3], H[0], H[1], H[2], H[3]}
    od = __builtin_amdgcn_mfma_f32_32x32x16_bf16(PK(l0, h0), pa0, od, 0, 0, 0);
    od = __builtin_amdgcn_mfma_f32_32x32x16_bf16(PK(l1, h1), pa1, od, 0, 0, 0);
    od = __builtin_amdgcn_mfma_f32_32x32x16_bf16(PK(l2, h2), pa2, od, 0, 0, 0);
    od = __builtin_amdgcn_mfma_f32_32x32x16_bf16(PK(l3, h3), pa3, od, 0, 0, 0);
#undef PK
}
template <int KSI, int DB, int ND> __device__ __forceinline__ void v_read(int vb, s16x4 (&l)[4], s16x4 (&h)[4]) {
    l[0] = tr_read<v_rd_off(DB, KSI, 0)>(vb); h[0] = tr_read<v_rd_off(DB, KSI, 1)>(vb);
    l[1] = tr_read<v_rd_off(DB + 1, KSI, 0)>(vb); h[1] = tr_read<v_rd_off(DB + 1, KSI, 1)>(vb);
    if constexpr (ND == 4) { l[2] = tr_read<v_rd_off(DB + 2, KSI, 0)>(vb); h[2] = tr_read<v_rd_off(DB + 2, KSI, 1)>(vb);
                             l[3] = tr_read<v_rd_off(DB + 3, KSI, 0)>(vb); h[3] = tr_read<v_rd_off(DB + 3, KSI, 1)>(vb); }
}
template <int ND> __device__ __forceinline__ void pv_mf(f32x16 (&o)[4], bf16x8 pa, const s16x4 (&l)[4], const s16x4 (&h)[4]) {
    __builtin_amdgcn_s_setprio(1);
#pragma unroll
    for (int d = 0; d < ND; ++d) o[d] = __builtin_amdgcn_mfma_f32_32x32x16_bf16((bf16x8){l[d][0], l[d][1], l[d][2], l[d][3], h[d][0], h[d][1], h[d][2], h[d][3]}, pa, o[d], 0, 0, 0);
    __builtin_amdgcn_s_setprio(0);
}
template <int DB, int ND> __device__ __forceinline__ void pv_ks(f32x16 (&o)[4], int vb, bf16x8 pa0, bf16x8 pa1, bf16x8 pa2, bf16x8 pa3) {
    s16x4 la[4], ha[4];
    v_read<0, DB, ND>(vb, la, ha); asm volatile("s_waitcnt lgkmcnt(0)" ::: "memory"); SBAR(); pv_mf<ND>(o, pa0, la, ha); SBAR();
    v_read<1, DB, ND>(vb, la, ha); asm volatile("s_waitcnt lgkmcnt(0)" ::: "memory"); SBAR(); pv_mf<ND>(o, pa1, la, ha); SBAR();
    v_read<2, DB, ND>(vb, la, ha); asm volatile("s_waitcnt lgkmcnt(0)" ::: "memory"); SBAR(); pv_mf<ND>(o, pa2, la, ha); SBAR();
    v_read<3, DB, ND>(vb, la, ha); asm volatile("s_waitcnt lgkmcnt(0)" ::: "memory"); SBAR(); pv_mf<ND>(o, pa3, la, ha);
}
template <int DB, int ND> __device__ __forceinline__ void pv_rest(f32x16 (&o)[4], int vb, bf16x8 pa0, bf16x8 pa1, bf16x8 pa2, bf16x8 pa3, s16x4 (&la)[4], s16x4 (&ha)[4]) {
    s16x4 lb[4], hb[4];
    asm volatile("s_waitcnt lgkmcnt(0)" ::: "memory"); SBAR(); v_read<1, DB, ND>(vb, lb, hb); SBAR(); pv_mf<ND>(o, pa0, la, ha); SBAR();
    asm volatile("s_waitcnt lgkmcnt(0)" ::: "memory"); SBAR(); v_read<2, DB, ND>(vb, la, ha); SBAR(); pv_mf<ND>(o, pa1, lb, hb); SBAR();
    asm volatile("s_waitcnt lgkmcnt(0)" ::: "memory"); SBAR(); v_read<3, DB, ND>(vb, lb, hb); SBAR(); pv_mf<ND>(o, pa2, la, ha); SBAR();
    asm volatile("s_waitcnt lgkmcnt(0)" ::: "memory"); SBAR(); pv_mf<ND>(o, pa3, lb, hb);
}
__device__ __forceinline__ void partialSM(f32x16& p0, f32x16& p1, float& m_reg, float& alpha, float C, float thr) {
    float pmax = p0[0];
#pragma unroll
    for (int r = 1; r < 16; ++r) pmax = fmaxf(pmax, p0[r]);
#pragma unroll
    for (int r = 0; r < 16; ++r) pmax = fmaxf(pmax, p1[r]);
    { auto rr = __builtin_amdgcn_permlane32_swap(__float_as_uint(pmax), __float_as_uint(pmax), false, false);
      pmax = fmaxf(__uint_as_float(rr[0]), __uint_as_float(rr[1])); }
    float mn;
    if (__all(pmax - m_reg <= thr)) { mn = m_reg; alpha = 1.f; }
    else { mn = fmaxf(m_reg, pmax); alpha = __builtin_amdgcn_exp2f((m_reg - mn) * C); m_reg = mn; }
    const float mnC = -mn * C;
#pragma unroll
    for (int r = 0; r < 16; ++r) p0[r] = __builtin_amdgcn_exp2f(fmaf(p0[r], C, mnC));
#pragma unroll
    for (int r = 0; r < 16; ++r) p1[r] = __builtin_amdgcn_exp2f(fmaf(p1[r], C, mnC));
}
__device__ __forceinline__ void finishSM(f32x16& p0, f32x16& p1, float alpha, float& l_reg, bf16x8& pa0, bf16x8& pa1, bf16x8& pa2, bf16x8& pa3) {
    float ps = 0;
#pragma unroll
    for (int r = 0; r < 16; ++r) ps += p0[r];
#pragma unroll
    for (int r = 0; r < 16; ++r) ps += p1[r];
    { auto rr = __builtin_amdgcn_permlane32_swap(__float_as_uint(ps), __float_as_uint(ps), false, false);
      ps = __uint_as_float(rr[0]) + __uint_as_float(rr[1]); }
    l_reg = l_reg * alpha + ps;
#define PK4(P, BASE, OUT) do { unsigned a0 = cvtpk(P[BASE + 0], P[BASE + 1]), a1 = cvtpk(P[BASE + 2], P[BASE + 3]);   \
    unsigned b0 = cvtpk(P[BASE + 4], P[BASE + 5]), b1 = cvtpk(P[BASE + 6], P[BASE + 7]);                              \
    auto r0 = __builtin_amdgcn_permlane32_swap(a0, b0, false, false); auto r1 = __builtin_amdgcn_permlane32_swap(a1, b1, false, false); \
    u32x4 w = {r0[0], r1[0], r0[1], r1[1]}; OUT = *reinterpret_cast<bf16x8*>(&w); } while (0)
    PK4(p0, 0, pa0); PK4(p0, 8, pa1); PK4(p1, 0, pa2); PK4(p1, 8, pa3);
#undef PK4
}
constexpr int RING = 32768;
template <int QS, bool PVHALF>
__device__ __forceinline__ void attn_core(LAS unsigned char* lds, const bf16_t* Kb, long ldk, const bf16_t* Vb, long ldv, int NT, int nkeys,
                                          const bf16_t* qptr, int wNT, int kcoffB, int pvsel, float C, float thr, f32x16 (&o)[4], float& m_reg, float& l_reg) {
    int tid = threadIdx.x; asm volatile("" : "+v"(tid));
    const int lane = tid & 63, r32 = lane & 31, hi = lane >> 5, wid = __builtin_amdgcn_readfirstlane(tid >> 6);
    bf16x8 qr[QS];
#pragma unroll
    for (int d0 = 0; d0 < QS; ++d0) qr[d0] = *(const bf16x8*)(qptr + d0 * 16);
#pragma unroll
    for (int d = 0; d < 4; ++d) o[d] = f32x16{};
    m_reg = -1e30f; l_reg = 0.f;
    long offK[2], offV[2];
#pragma unroll
    for (int i = 0; i < 2; ++i) { const int p = i * 8192 + wid * 1024 + lane * 16;
        const int row = p >> 8, colB = (p & 255) ^ ((row & 7) << 4); offK[i] = (long)row * ldk + (colB >> 1);
        const int sub = p >> 9, q = (p & 511) >> 1, kk = (sub >> 2) * 8 + (q >> 5), k = (kk & ~0xC) | ((kk & 4) << 1) | ((kk & 8) >> 1), c = (sub & 3) * 32 + (q & 31);
        offV[i] = (long)k * ldv + c; }
    const int vrb = v_rd_base(lane);
#define GLDS(t, bf) do { const bf16_t* kt_ = Kb + (long)(t) * 64 * ldk; const bf16_t* vt_ = Vb + (long)(t) * 64 * ldv; LAS unsigned char* b_ = lds + (bf) * RING + wid * 1024; \
    __builtin_amdgcn_global_load_lds((const unsigned*)(vt_ + offV[0]), (LAS unsigned*)(b_), 16, 0, 0); \
    __builtin_amdgcn_global_load_lds((const unsigned*)(vt_ + offV[1]), (LAS unsigned*)(b_ + 8192), 16, 0, 0); \
    __builtin_amdgcn_global_load_lds((const unsigned*)(kt_ + offK[0]), (LAS unsigned*)(b_ + 16384), 16, 0, 0); \
    __builtin_amdgcn_global_load_lds((const unsigned*)(kt_ + offK[1]), (LAS unsigned*)(b_ + 16384 + 8192), 16, 0, 0); } while (0)
    GLDS(0, 0);
#pragma unroll
    for (int d0 = 0; d0 < QS; ++d0) asm volatile("" :: "v"(qr[d0]));
    if (1 < NT) GLDS(1, 1); if (2 < NT) GLDS(2, 2);
    for (int j = 0; j < NT; ++j) {
        const int rem = NT - 1 - j;
        if (rem >= 2) asm volatile("s_waitcnt vmcnt(8)" ::: "memory"); else if (rem == 1) asm volatile("s_waitcnt vmcnt(4)" ::: "memory"); else asm volatile("s_waitcnt vmcnt(0)" ::: "memory");
        __builtin_amdgcn_s_barrier();
        asm volatile("" ::: "memory");
        if (j + 3 < NT) GLDS(j + 3, (j + 3) & 3);
        if (j < wNT) {
            const int cur = j & 3;
            f32x16 p0 = f32x16{}, p1 = f32x16{};
            const int kbase = (int)(uintptr_t)(lds + cur * RING + 16384) + r32 * 256;
            const int swz = (r32 & 7) << 4;
#pragma unroll
            for (int hq = 0; hq < QS / 4; ++hq) { bf16x8 b0[4], b1[4];
#pragma unroll
                for (int i = 0; i < 4; ++i) { const int cb = kcoffB + ((hq * 4 + i) * 16 + hi * 8) * 2; const int ad = kbase + (cb ^ swz);
                    b0[i] = lds_read128<0>(ad); b1[i] = lds_read128<8192>(ad); }
                asm volatile("s_waitcnt lgkmcnt(0)" ::: "memory"); SBAR();
#pragma unroll
                for (int i = 0; i < 4; ++i) { p0 = __builtin_amdgcn_mfma_f32_32x32x16_bf16(b0[i], qr[hq * 4 + i], p0, 0, 0, 0);
                    p1 = __builtin_amdgcn_mfma_f32_32x32x16_bf16(b1[i], qr[hq * 4 + i], p1, 0, 0, 0); } }
            if (__builtin_expect((j + 1) * 64 > nkeys, 0)) { const int kb = j * 64 + 4 * hi; asm volatile("" ::: "memory");
#pragma unroll
                for (int r = 0; r < 16; ++r) { const int kv = kb + (r & 3) + 8 * (r >> 2); if (kv >= nkeys) p0[r] = -1e30f; if (kv + 32 >= nkeys) p1[r] = -1e30f; } }
            float alpha; bf16x8 pa0, pa1, pa2, pa3;
            const int vb = (int)(uintptr_t)(lds + cur * RING) + vrb;
            s16x4 la[4], ha[4];
            partialSM(p0, p1, m_reg, alpha, C, thr);
            finishSM(p0, p1, alpha, l_reg, pa0, pa1, pa2, pa3);
            SBAR();
            if constexpr (QS == 4) { if constexpr (!PVHALF) v_read<0, 0, 4>(vb, la, ha); else { if (pvsel == 0) v_read<0, 0, 2>(vb, la, ha); else v_read<0, 2, 2>(vb, la, ha); } }
            SBAR();
            if (__any(alpha < 1.f)) {
#pragma unroll
                for (int d = 0; d < (PVHALF ? 2 : 4); ++d)
#pragma unroll
                    for (int r = 0; r < 16; ++r) o[d][r] *= alpha; }
            if constexpr (QS == 8) { pv_one<0>(o[0], vb, pa0, pa1, pa2, pa3); pv_one<1>(o[1], vb, pa0, pa1, pa2, pa3); pv_one<2>(o[2], vb, pa0, pa1, pa2, pa3); pv_one<3>(o[3], vb, pa0, pa1, pa2, pa3); }
            else if constexpr (!PVHALF) pv_rest<0, 4>(o, vb, pa0, pa1, pa2, pa3, la, ha);
            else { if (pvsel == 0) pv_rest<0, 2>(o, vb, pa0, pa1, pa2, pa3, la, ha); else pv_rest<2, 2>(o, vb, pa0, pa1, pa2, pa3, la, ha); }
        }
    }
#undef GLDS
    __syncthreads();
}

template <bool PVHALF>
__device__ __forceinline__ void attn_core_pipe(LAS unsigned char* lds, const bf16_t* Kb, long ldk, const bf16_t* Vb, long ldv, int NT, int nkeys,
                                               const bf16_t* qptr, int wNT, int kcoffB, int pvsel, float C, float thr, f32x16 (&o)[4], float& m_reg, float& l_reg) {
    int tid = threadIdx.x; asm volatile("" : "+v"(tid));
    const int lane = tid & 63, r32 = lane & 31, hi = lane >> 5, wid = __builtin_amdgcn_readfirstlane(tid >> 6);
    bf16x8 qr[4];
#pragma unroll
    for (int d0 = 0; d0 < 4; ++d0) qr[d0] = *(const bf16x8*)(qptr + d0 * 16);
#pragma unroll
    for (int d = 0; d < 4; ++d) o[d] = f32x16{};
    m_reg = -1e30f; l_reg = 0.f;
    int offK[2], offV[2];
#pragma unroll
    for (int i = 0; i < 2; ++i) { const int p = i * 8192 + wid * 1024 + lane * 16;
        const int row = p >> 8, colB = (p & 255) ^ ((row & 7) << 4); offK[i] = row * (int)ldk + (colB >> 1);
        const int sub = p >> 9, q = (p & 511) >> 1, kk = (sub >> 2) * 8 + (q >> 5), k = (kk & ~0xC) | ((kk & 4) << 1) | ((kk & 8) >> 1), c = (sub & 3) * 32 + (q & 31);
        offV[i] = k * (int)ldv + c; }
    const int vrb = v_rd_base(lane);
    int kad[4];
#pragma unroll
    for (int i = 0; i < 4; ++i) kad[i] = 16384 + r32 * 256 + ((kcoffB + (i * 16 + hi * 8) * 2) ^ ((r32 & 7) << 4));
    const int lds0 = (int)(uintptr_t)lds;
#define GLDS_V(t, bf) do { const bf16_t* vt_ = Vb + (long)(t) * 64 * ldv; LAS unsigned char* b_ = lds + (bf) * RING + wid * 1024; \
    __builtin_amdgcn_global_load_lds((const unsigned*)(vt_ + offV[0]), (LAS unsigned*)(b_), 16, 0, 0); \
    __builtin_amdgcn_global_load_lds((const unsigned*)(vt_ + offV[1]), (LAS unsigned*)(b_ + 8192), 16, 0, 0); } while (0)
#define GLDS_K(t, bf) do { const bf16_t* kt_ = Kb + (long)(t) * 64 * ldk; LAS unsigned char* b_ = lds + (bf) * RING + wid * 1024; \
    __builtin_amdgcn_global_load_lds((const unsigned*)(kt_ + offK[0]), (LAS unsigned*)(b_ + 16384), 16, 0, 0); \
    __builtin_amdgcn_global_load_lds((const unsigned*)(kt_ + offK[1]), (LAS unsigned*)(b_ + 16384 + 8192), 16, 0, 0); } while (0)
#define GLDS(t, bf) do { GLDS_V(t, bf); GLDS_K(t, bf); } while (0)
#define QK(P0, P1, bf) do { const int kb_ = lds0 + (bf) * RING; bf16x8 b0_[2], b1_[2]; \
    _Pragma("unroll") for (int i_ = 0; i_ < 2; ++i_) { b0_[i_] = lds_read128<0>(kb_ + kad[i_]); b1_[i_] = lds_read128<8192>(kb_ + kad[i_]); } \
    asm volatile("s_waitcnt lgkmcnt(0)" ::: "memory"); SBAR(); \
    P0 = __builtin_amdgcn_mfma_f32_32x32x16_bf16(b0_[0], qr[0], f32x16{}, 0, 0, 0); P1 = __builtin_amdgcn_mfma_f32_32x32x16_bf16(b1_[0], qr[0], f32x16{}, 0, 0, 0); \
    P0 = __builtin_amdgcn_mfma_f32_32x32x16_bf16(b0_[1], qr[1], P0, 0, 0, 0); P1 = __builtin_amdgcn_mfma_f32_32x32x16_bf16(b1_[1], qr[1], P1, 0, 0, 0); SBAR(); \
    _Pragma("unroll") for (int i_ = 0; i_ < 2; ++i_) { b0_[i_] = lds_read128<0>(kb_ + kad[2 + i_]); b1_[i_] = lds_read128<8192>(kb_ + kad[2 + i_]); } \
    asm volatile("s_waitcnt lgkmcnt(0)" ::: "memory"); SBAR(); \
    P0 = __builtin_amdgcn_mfma_f32_32x32x16_bf16(b0_[0], qr[2], P0, 0, 0, 0); P1 = __builtin_amdgcn_mfma_f32_32x32x16_bf16(b1_[0], qr[2], P1, 0, 0, 0); \
    P0 = __builtin_amdgcn_mfma_f32_32x32x16_bf16(b0_[1], qr[3], P0, 0, 0, 0); P1 = __builtin_amdgcn_mfma_f32_32x32x16_bf16(b1_[1], qr[3], P1, 0, 0, 0); \
    SBAR(); } while (0)
#define STEP(C0, C1, N0, N1, j) do { \
    if ((j) + 1 < NT) { \
        if ((j) + 2 < NT) asm volatile("s_waitcnt vmcnt(4)" ::: "memory"); else asm volatile("s_waitcnt vmcnt(0)" ::: "memory"); \
        __builtin_amdgcn_s_barrier(); asm volatile("" ::: "memory"); \
        if ((j) + 1 < wNT) QK(N0, N1, ((j) + 1) & 3); } \
    const bool iss_ = (j) + 3 < NT;                                 \
    if ((j) < wNT) { \
        if (__builtin_expect(((j) + 1) * 64 > nkeys, 0)) { const int kb = (j) * 64 + 4 * hi; asm volatile("" ::: "memory"); \
            _Pragma("unroll") for (int r = 0; r < 16; ++r) { const int kv = kb + (r & 3) + 8 * (r >> 2); if (kv >= nkeys) C0[r] = -1e30f; if (kv + 32 >= nkeys) C1[r] = -1e30f; } } \
        float alpha; bf16x8 pa0, pa1, pa2, pa3; const int vb = lds0 + ((j) & 3) * RING + vrb; \
        partialSM(C0, C1, m_reg, alpha, C, thr); \
        SBAR(); if (iss_) GLDS_V((j) + 3, ((j) + 3) & 3); SBAR(); \
        finishSM(C0, C1, alpha, l_reg, pa0, pa1, pa2, pa3); \
        SBAR(); if (iss_) GLDS_K((j) + 3, ((j) + 3) & 3); SBAR(); \
        if (__any(alpha < 1.f)) { \
            _Pragma("unroll") for (int d = 0; d < (PVHALF ? 2 : 4); ++d) _Pragma("unroll") for (int r = 0; r < 16; ++r) o[d][r] *= alpha; } \
        if constexpr (!PVHALF) pv_ks<0, 4>(o, vb, pa0, pa1, pa2, pa3); \
        else { if (pvsel == 0) pv_ks<0, 2>(o, vb, pa0, pa1, pa2, pa3); else pv_ks<2, 2>(o, vb, pa0, pa1, pa2, pa3); } } \
    else if (iss_) GLDS((j) + 3, ((j) + 3) & 3); \
    } while (0)
    GLDS(0, 0);
#pragma unroll
    for (int d0 = 0; d0 < 4; ++d0) asm volatile("" :: "v"(qr[d0]));
    if (1 < NT) GLDS(1, 1); if (2 < NT) GLDS(2, 2);
    if (NT > 2) asm volatile("s_waitcnt vmcnt(8)" ::: "memory"); else if (NT == 2) asm volatile("s_waitcnt vmcnt(4)" ::: "memory"); else asm volatile("s_waitcnt vmcnt(0)" ::: "memory");
    __builtin_amdgcn_s_barrier(); asm volatile("" ::: "memory");
    f32x16 pA0 = f32x16{}, pA1 = f32x16{}, pB0 = f32x16{}, pB1 = f32x16{};
    if (0 < wNT) QK(pA0, pA1, 0);
    for (int j = 0; j < NT; j += 2) {
        STEP(pA0, pA1, pB0, pB1, j);
        if (j + 1 < NT) STEP(pB0, pB1, pA0, pA1, j + 1);
    }
#undef STEP
#undef QK
#undef GLDS
#undef GLDS_V
#undef GLDS_K
    __syncthreads();
}

struct Ctx { LAS unsigned char* lds; int lane, wid, r32, hi; };

template <int ND> __device__ __forceinline__ void store_gated(const f32x16 (&o)[4], float scale, const bf16_t* gate, bf16_t* out, int hi) {
#pragma unroll
    for (int d = 0; d < ND; ++d)
#pragma unroll
        for (int g = 0; g < 4; ++g) { const int dv = 32 * d + 8 * g + 4 * hi;
            const u32x2 gt = *(const u32x2*)(gate + dv);
            f32x4 v; v.x = o[d][4 * g] * scale * silu(bflo(gt.x)); v.y = o[d][4 * g + 1] * scale * silu(bfhi(gt.x));
            v.z = o[d][4 * g + 2] * scale * silu(bflo(gt.y)); v.w = o[d][4 * g + 3] * scale * silu(bfhi(gt.y));
            st_bf4(out + dv, v); }
}

__device__ __forceinline__ void diff_unit(const Ctx& cx, bool samp, int b, int h, int qb, const bf16_t* PA, const bf16_t* KS, const bf16_t* VS, bf16_t* MIX, const float* gnorm, float lam) {
    const int c = cx.wid >> 2, rb = cx.wid & 3;
    long row; bool valid; int NT, wNT, nkeys; const bf16_t* Kb; const bf16_t* Vb; long ldk;
    if (!samp) { row = (long)b * 4096 + qb * 128 + rb * 32 + cx.r32; valid = true; NT = 2 * qb + 2; wNT = 2 * qb + 1 + (rb >> 1); nkeys = NT * 64;
                 Kb = PA + (size_t)b * 4096 * NA + 512 + h * 128; Vb = Kb + 512; ldk = NA; }
    else { row = NP + b * 16 + (cx.r32 < 15 ? cx.r32 : 15); valid = (rb == 0) && cx.r32 < 16; NT = 65; wNT = (rb == 0) ? 65 : 0; nkeys = 4112;
           Kb = KS + (size_t)b * KSROWS * 512 + h * 128; Vb = VS + (size_t)b * KSROWS * 512 + h * 128; ldk = 512; }
    const bf16_t* qptr = PA + (size_t)row * NA + h * 128 + c * 64 + cx.hi * 8;
    f32x16 o[4]; float m, l;
    attn_core_pipe<false>(cx.lds, Kb, ldk, Vb, ldk, NT, nkeys, qptr, wNT, c * 128, 0, C64, THR64, o, m, l);
    const float inv = l > 0.f ? 1.f / l : 0.f;
    LAS float* xch = (LAS float*)cx.lds + rb * 4096;
    if (c == 1) {
#pragma unroll
        for (int d = 0; d < 4; ++d)
#pragma unroll
            for (int r = 0; r < 16; ++r) xch[(d * 16 + r) * 64 + cx.lane] = o[d][r] * inv; }
    __syncthreads();
    if (c == 0) {
        float ss = 0.f;
#pragma unroll
        for (int d = 0; d < 4; ++d)
#pragma unroll
            for (int r = 0; r < 16; ++r) { const float od = o[d][r] * inv - lam * xch[(d * 16 + r) * 64 + cx.lane]; o[d][r] = od; ss += od * od; }
        ss += __shfl_xor(ss, 32);
        const float rms = rsqrtf(ss * (1.f / 128.f) + 1e-5f) * 0.8f;
        if (valid) {
            const bf16_t* gate = PA + (size_t)row * NA + 1536 + h * 128; bf16_t* out = MIX + (size_t)row * DM + h * 128;
#pragma unroll
            for (int d = 0; d < 4; ++d)
#pragma unroll
                for (int g = 0; g < 4; ++g) { const int dv = 32 * d + 8 * g + 4 * cx.hi;
                    const f32x4 gn = *(const f32x4*)(gnorm + dv); const u32x2 gt = *(const u32x2*)(gate + dv);
                    f32x4 v; v.x = o[d][4 * g] * rms * gn.x * silu(bflo(gt.x)); v.y = o[d][4 * g + 1] * rms * gn.y * silu(bfhi(gt.x));
                    v.z = o[d][4 * g + 2] * rms * gn.z * silu(bflo(gt.y)); v.w = o[d][4 * g + 3] * rms * gn.w * silu(bfhi(gt.y));
                    st_bf4(out + dv, v); }
        }
    }
    __syncthreads();
}
__device__ __forceinline__ void diff_sample_item(const Ctx& cx, int b, int h, int sp, const float* CK, const float* CV, const bf16_t* PA, const bf16_t* KS, const bf16_t* VS,
                                                 bf16_t* MIX, const float* gnorm, float lam, float* PART, unsigned* cnt, volatile LAS unsigned* MISC) {
    int tid = threadIdx.x; asm volatile("" : "+v"(tid));
    const int lane = tid & 63, r32 = lane & 31, hi = lane >> 5, wid = __builtin_amdgcn_readfirstlane(tid >> 6);
    const int c = wid >> 2; const bool active = (wid & 3) == 0;
    const size_t row = NP + b * 16 + (r32 < 15 ? r32 : 15);
    bf16x8 qr[4];
    { const bf16_t* qptr = PA + row * NA + h * 128 + c * 64 + hi * 8;
#pragma unroll
      for (int d0 = 0; d0 < 4; ++d0) qr[d0] = *(const bf16x8*)(qptr + d0 * 16); }
    f32x16 o[4];
#pragma unroll
    for (int d = 0; d < 4; ++d) o[d] = f32x16{};
    float m_reg = -1e30f, l_reg = 0.f;
    const int ntl = 16 + (sp == 3 ? 1 : 0);
    const int sr = tid >> 4, sc = (tid & 15) * 8;
    const float* kg = CK + ((size_t)(b * 4096 + sp * 1024 + sr) * 4 + h) * 128 + sc;
    const float* vg = CV + ((size_t)(b * 4096 + sp * 1024 + sr) * 4 + h) * 128 + sc;
    const bf16_t* kn = KS + ((size_t)b * KSROWS + 4096 + sr) * 512 + h * 128 + sc;
    const bf16_t* vn = VS + ((size_t)b * KSROWS + 4096 + sr) * 512 + h * 128 + sc;
    const int vst0 = v_st(sr, sc), vst1 = v_st(32 + sr, sc), kst0 = 16384 + KSWZ(sr, sc * 2), kst1 = 16384 + KSWZ(32 + sr, sc * 2);
    int kad[4];
#pragma unroll
    for (int i = 0; i < 4; ++i) kad[i] = 16384 + r32 * 256 + ((c * 128 + (i * 16 + hi * 8) * 2) ^ ((r32 & 7) << 4));
    const int lds0 = (int)(uintptr_t)cx.lds, vrb = v_rd_base(lane);
    f32x4 kfA[4], vfA[4], kfB[4], vfB[4];
#define LOADT(t, kf, vf) do { if ((t) < 16) { const float* kp_ = kg + (size_t)(t) * 64 * 512; const float* vp_ = vg + (size_t)(t) * 64 * 512; \
        kf[0] = __builtin_nontemporal_load((const f32x4*)kp_); kf[1] = __builtin_nontemporal_load((const f32x4*)(kp_ + 4)); kf[2] = __builtin_nontemporal_load((const f32x4*)(kp_ + 32 * 512)); kf[3] = __builtin_nontemporal_load((const f32x4*)(kp_ + 32 * 512 + 4)); \
        vf[0] = __builtin_nontemporal_load((const f32x4*)vp_); vf[1] = __builtin_nontemporal_load((const f32x4*)(vp_ + 4)); vf[2] = __builtin_nontemporal_load((const f32x4*)(vp_ + 32 * 512)); vf[3] = __builtin_nontemporal_load((const f32x4*)(vp_ + 32 * 512 + 4)); } \
    else { kf[0] = *(const f32x4*)kn; kf[2] = *(const f32x4*)(kn + 32 * 512); vf[0] = *(const f32x4*)vn; vf[2] = *(const f32x4*)(vn + 32 * 512); } } while (0)
#define CV8(A, B) ((u32x4){cvtpk(A.x, A.y), cvtpk(A.z, A.w), cvtpk(B.x, B.y), cvtpk(B.z, B.w)})
#define WRITET(t, bf, kf, vf) do { u32x4 k0_, k1_, v0_, v1_; \
    if ((t) < 16) { k0_ = CV8(kf[0], kf[1]); k1_ = CV8(kf[2], kf[3]); v0_ = CV8(vf[0], vf[1]); v1_ = CV8(vf[2], vf[3]); } \
    else { k0_ = __builtin_bit_cast(u32x4, kf[0]); k1_ = __builtin_bit_cast(u32x4, kf[2]); v0_ = __builtin_bit_cast(u32x4, vf[0]); v1_ = __builtin_bit_cast(u32x4, vf[2]); } \
    LAS unsigned char* b_ = cx.lds + (bf) * RING; \
    *(LAS u32x4*)(b_ + vst0) = v0_; *(LAS u32x4*)(b_ + vst1) = v1_; *(LAS u32x4*)(b_ + kst0) = k0_; *(LAS u32x4*)(b_ + kst1) = k1_; } while (0)
#define SCORE(t, cur) do { if (active) { \
            f32x16 p0, p1; \
            { const int kb_ = lds0 + (cur) * RING; bf16x8 b0_[2], b1_[2]; \
              _Pragma("unroll") for (int i = 0; i < 2; ++i) { b0_[i] = lds_read128<0>(kb_ + kad[i]); b1_[i] = lds_read128<8192>(kb_ + kad[i]); } \
              asm volatile("s_waitcnt lgkmcnt(0)" ::: "memory"); SBAR(); \
              p0 = __builtin_amdgcn_mfma_f32_32x32x16_bf16(b0_[0], qr[0], f32x16{}, 0, 0, 0); p1 = __builtin_amdgcn_mfma_f32_32x32x16_bf16(b1_[0], qr[0], f32x16{}, 0, 0, 0); \
              p0 = __builtin_amdgcn_mfma_f32_32x32x16_bf16(b0_[1], qr[1], p0, 0, 0, 0); p1 = __builtin_amdgcn_mfma_f32_32x32x16_bf16(b1_[1], qr[1], p1, 0, 0, 0); SBAR(); \
              _Pragma("unroll") for (int i = 0; i < 2; ++i) { b0_[i] = lds_read128<0>(kb_ + kad[2 + i]); b1_[i] = lds_read128<8192>(kb_ + kad[2 + i]); } \
              asm volatile("s_waitcnt lgkmcnt(0)" ::: "memory"); SBAR(); \
              p0 = __builtin_amdgcn_mfma_f32_32x32x16_bf16(b0_[0], qr[2], p0, 0, 0, 0); p1 = __builtin_amdgcn_mfma_f32_32x32x16_bf16(b1_[0], qr[2], p1, 0, 0, 0); \
              p0 = __builtin_amdgcn_mfma_f32_32x32x16_bf16(b0_[1], qr[3], p0, 0, 0, 0); p1 = __builtin_amdgcn_mfma_f32_32x32x16_bf16(b1_[1], qr[3], p1, 0, 0, 0); } \
            if ((t) >= 16) { \
                _Pragma("unroll") for (int r = 0; r < 16; ++r) { const int kv = 4 * hi + (r & 3) + 8 * (r >> 2); if (kv >= 16) p0[r] = -1e30f; p1[r] = -1e30f; } } \
            float alpha; bf16x8 pa0, pa1, pa2, pa3; \
            partialSM(p0, p1, m_reg, alpha, C64, THR64); \
            finishSM(p0, p1, alpha, l_reg, pa0, pa1, pa2, pa3); \
            SBAR(); \
            if (__any(alpha < 1.f)) { \
                _Pragma("unroll") for (int d = 0; d < 4; ++d) _Pragma("unroll") for (int r = 0; r < 16; ++r) o[d][r] *= alpha; } \
            pv_ks<0, 4>(o, lds0 + (cur) * RING + vrb, pa0, pa1, pa2, pa3); } } while (0)
    LOADT(0, kfA, vfA); LOADT(1, kfB, vfB); WRITET(0, 0, kfA, vfA); __syncthreads();
    for (int t = 0; t < ntl; t += 2) {
        if (t + 2 < ntl) LOADT(t + 2, kfA, vfA);
        SCORE(t, 0);
        if (t + 1 < ntl) WRITET(t + 1, 1, kfB, vfB);
        __syncthreads();
        if (t + 1 < ntl) {
            if (t + 3 < ntl) LOADT(t + 3, kfB, vfB);
            SCORE(t + 1, 1);
            if (t + 2 < ntl) WRITET(t + 2, 0, kfA, vfA);
            __syncthreads();
        }
    }
#undef SCORE
#undef LOADT
#undef WRITET
#undef CV8
    const int bh = b * 4 + h;
    if (active) { float* pb = PART + ((size_t)(bh * 4 + sp) * 2 + c) * (66 * 64) + lane;
#pragma unroll
        for (int d = 0; d < 4; ++d)
#pragma unroll
            for (int r = 0; r < 16; ++r) pb[(d * 16 + r) * 64] = o[d][r];
        pb[64 * 64] = m_reg; pb[65 * 64] = l_reg; }
    asm volatile("s_waitcnt vmcnt(0)" ::: "memory"); __syncthreads();
    if (tid == 0) { __builtin_amdgcn_fence(__ATOMIC_RELEASE, "agent"); asm volatile("s_waitcnt vmcnt(0)" ::: "memory");
                    const unsigned old = __hip_atomic_fetch_add(cnt + bh, 1u, __ATOMIC_RELAXED, __HIP_MEMORY_SCOPE_AGENT);
                    if (old == 3u) { __builtin_amdgcn_fence(__ATOMIC_ACQUIRE, "agent"); asm volatile("s_waitcnt vmcnt(0)" ::: "memory"); }
                    MISC[1] = old; }
    __syncthreads();
    const bool last = MISC[1] == 3u;
    if (last && wid == 0) {
        const float* pp = PART + (size_t)(bh * 4) * 2 * (66 * 64) + lane;
        float e0[4], e1[4], L0 = 0.f, L1 = 0.f;
        { float m0[4], m1[4], M0 = -1e30f, M1 = -1e30f;
#pragma unroll
          for (int q = 0; q < 4; ++q) { m0[q] = pp[(size_t)(q * 2) * (66 * 64) + 64 * 64]; m1[q] = pp[(size_t)(q * 2 + 1) * (66 * 64) + 64 * 64]; M0 = fmaxf(M0, m0[q]); M1 = fmaxf(M1, m1[q]); }
#pragma unroll
          for (int q = 0; q < 4; ++q) { e0[q] = __builtin_amdgcn_exp2f((m0[q] - M0) * C64); e1[q] = __builtin_amdgcn_exp2f((m1[q] - M1) * C64);
              L0 += e0[q] * pp[(size_t)(q * 2) * (66 * 64) + 65 * 64]; L1 += e1[q] * pp[(size_t)(q * 2 + 1) * (66 * 64) + 65 * 64]; } }
        const float i0 = 1.f / L0, i1 = lam / L1;
#pragma unroll
        for (int q = 0; q < 4; ++q) { e0[q] *= i0; e1[q] *= i1; }
        float ss = 0.f;
#pragma unroll
        for (int d = 0; d < 4; ++d)
#pragma unroll
            for (int r = 0; r < 16; ++r) { float od = 0.f;
#pragma unroll
                for (int q = 0; q < 4; ++q) od += e0[q] * pp[(size_t)(q * 2) * (66 * 64) + (d * 16 + r) * 64] - e1[q] * pp[(size_t)(q * 2 + 1) * (66 * 64) + (d * 16 + r) * 64];
                o[d][r] = od; ss += od * od; }
        ss += __shfl_xor(ss, 32);
        const float rms = rsqrtf(ss * (1.f / 128.f) + 1e-5f) * 0.8f;
        if (r32 < 16) {
            const bf16_t* gate = PA + row * NA + 1536 + h * 128; bf16_t* out = MIX + row * DM + h * 128;
#pragma unroll
            for (int d = 0; d < 4; ++d)
#pragma unroll
                for (int g = 0; g < 4; ++g) { const int dv = 32 * d + 8 * g + 4 * hi;
                    const f32x4 gn = *(const f32x4*)(gnorm + dv); const u32x2 gt = *(const u32x2*)(gate + dv);
                    f32x4 v; v.x = o[d][4 * g] * rms * gn.x * silu(bflo(gt.x)); v.y = o[d][4 * g + 1] * rms * gn.y * silu(bfhi(gt.x));
                    v.z = o[d][4 * g + 2] * rms * gn.z * silu(bflo(gt.y)); v.w = o[d][4 * g + 3] * rms * gn.w * silu(bfhi(gt.y));
                    st_bf4(out + dv, v); }
        }
    }
    __syncthreads();
}
__device__ __forceinline__ void mem_unit(const Ctx& cx, bool samp, int b, int h, int qb, const bf16_t* P, int ldp, int qcol, int gcol,
                                         const bf16_t* Kb, const bf16_t* Vb, long ldk, bf16_t* MIX) {
    long row; bool valid; int wNT;
    if (!samp) { row = (long)b * 4096 + qb * 256 + cx.wid * 32 + cx.r32; valid = true; wNT = 4; }
    else { row = NP + b * 16 + (cx.r32 < 15 ? cx.r32 : 15); valid = (cx.wid == 0) && cx.r32 < 16; wNT = (cx.wid == 0) ? 4 : 0; }
    const bf16_t* qptr = P + (size_t)row * ldp + qcol + h * 128 + cx.hi * 8;
    f32x16 o[4]; float m, l;
    attn_core<8, false>(cx.lds, Kb, ldk, Vb, ldk, 4, 256, qptr, wNT, 0, 0, C128, THR128, o, m, l);
    const float inv = l > 0.f ? 1.f / l : 0.f;
    if (valid) store_gated<4>(o, inv, P + (size_t)row * ldp + gcol + h * 128, MIX + (size_t)row * DM + 512 + h * 128, cx.hi);
}
__device__ __forceinline__ void swa_unit(const Ctx& cx, bool samp, int b, int c, int half, const bf16_t* PB, const bf16_t* KSW, const bf16_t* VSW, bf16_t* MIX, const float* sinks) {
    const int head = cx.wid, kv = cx.wid >> 2;
    long row; bool valid; int NT, nkeys; const bf16_t* Kb; const bf16_t* Vb; long ldk;
    if (!samp) { row = (long)b * 4096 + c * 64 + half * 32 + cx.r32; valid = true; const int c0 = c > 2 ? c - 2 : 0; NT = c - c0 + 1; nkeys = NT * 64;
                 Kb = PB + ((size_t)b * 4096 + c0 * 64) * NB + 2048; Vb = Kb + 128; ldk = NB; }
    else { row = NP + b * 16 + (cx.r32 < 15 ? cx.r32 : 15); valid = cx.r32 < 16; NT = 3; nkeys = 144;
           Kb = KSW + (size_t)b * SWROWS * 128; Vb = VSW + (size_t)b * SWROWS * 128; ldk = 128; }
    const bf16_t* qptr = PB + (size_t)row * NB + head * 64 + cx.hi * 8;
    f32x16 o[4]; float m, l;
    attn_core_pipe<true>(cx.lds, Kb, ldk, Vb, ldk, NT, nkeys, qptr, NT, kv * 128, kv, C64, THR64, o, m, l);
    const float lt = l + __builtin_amdgcn_exp2f(sinks[head] * LOG2E - m * C64);
    const float inv = 1.f / lt;
    if (valid) store_gated<2>(o, inv, PB + (size_t)row * NB + 512 + head * 64, MIX + (size_t)row * DM + head * 64, cx.hi);
}
#undef KSWZ
#undef SBAR
}

__device__ __forceinline__ float wave_sum(float v) {
#pragma unroll
    for (int o = 1; o < 64; o <<= 1) v += __shfl_xor(v, o);
    return v;
}
__device__ __forceinline__ void p0_transpose_item(const float* W, int K, int N, bf16_t* WT, int row_off, LAS float* scr, int item, int lane) {
    const int nblk = N / 32, kb = item / nblk, nb = item % nblk, k0 = 64 * kb, n0 = 32 * nb;
#pragma unroll 8
    for (int i = 0; i < 32; ++i) { const int kk = 2 * i + (lane >> 5); scr[kk * 33 + (lane & 31)] = __builtin_nontemporal_load(W + (size_t)(k0 + kk) * N + n0 + (lane & 31)); }
    asm volatile("s_waitcnt lgkmcnt(0)" ::: "memory");
    const int c = lane & 7;
#pragma unroll
    for (int j = 0; j < 4; ++j) { const int n = (lane >> 3) + 8 * j; const LAS float* s = scr + (8 * c) * 33 + n;
        u32x4 o; o.x = cvtpk(s[0 * 33], s[1 * 33]); o.y = cvtpk(s[2 * 33], s[3 * 33]); o.z = cvtpk(s[4 * 33], s[5 * 33]); o.w = cvtpk(s[6 * 33], s[7 * 33]);
        *(u32x4*)(WT + (size_t)(row_off + n0 + n) * K + k0 + 8 * c) = o; }
    asm volatile("s_waitcnt lgkmcnt(0)" ::: "memory");
}
__device__ __forceinline__ void p0_transpose_item_ln(const float* W, int K, int N, bf16_t* WT, int row_off, LAS float* scr, int item, int lane, const float* g, const float* b, float* CS, float* BW) {
    const int nblk = N / 32, kb = item / nblk, nb = item % nblk, k0 = 64 * kb, n0 = 32 * nb;
    float csp = 0.f, bwp = 0.f;
#pragma unroll 8
    for (int i = 0; i < 32; ++i) { const int kk = 2 * i + (lane >> 5); const float w = __builtin_nontemporal_load(W + (size_t)(k0 + kk) * N + n0 + (lane & 31)); const float gw = g[k0 + kk] * w;
        scr[kk * 33 + (lane & 31)] = gw; csp += bflo(cvtpk(gw, 0.f)); bwp += b[k0 + kk] * w; }
    csp += __shfl_xor(csp, 32); bwp += __shfl_xor(bwp, 32);
    if (lane < 32) { atomicAdd(CS + row_off + n0 + lane, csp); atomicAdd(BW + row_off + n0 + lane, bwp); }
    asm volatile("s_waitcnt lgkmcnt(0)" ::: "memory");
    const int c = lane & 7;
#pragma unroll
    for (int j = 0; j < 4; ++j) { const int n = (lane >> 3) + 8 * j; const LAS float* sp = scr + (8 * c) * 33 + n;
        u32x4 o; o.x = cvtpk(sp[0 * 33], sp[1 * 33]); o.y = cvtpk(sp[2 * 33], sp[3 * 33]); o.z = cvtpk(sp[4 * 33], sp[5 * 33]); o.w = cvtpk(sp[6 * 33], sp[7 * 33]);
        *(u32x4*)(WT + (size_t)(row_off + n0 + n) * K + k0 + 8 * c) = o; }
    asm volatile("s_waitcnt lgkmcnt(0)" ::: "memory");
}
__device__ __forceinline__ void ln_rows(const float* zin, float* fout, bf16_t* bout, const float* g, const float* bta, int gw, int NGW, int lane) {
    f32x4 g4[4], b4[4];
#pragma unroll
    for (int j = 0; j < 4; ++j) { g4[j] = *(const f32x4*)(g + 4 * lane + 256 * j); b4[j] = *(const f32x4*)(bta + 4 * lane + 256 * j); }
    for (int m = gw; m < MA; m += NGW) {
        const float* zr = zin + (size_t)m * DM + 4 * lane;
        f32x4 v[4]; float s = 0.f;
#pragma unroll
        for (int j = 0; j < 4; ++j) { v[j] = *(const f32x4*)(zr + 256 * j); s += (v[j].x + v[j].y) + (v[j].z + v[j].w); }
        const float mean = wave_sum(s) * (1.f / DM); float s2 = 0.f;
#pragma unroll
        for (int j = 0; j < 4; ++j) { v[j] = v[j] - mean; s2 += (v[j].x * v[j].x + v[j].y * v[j].y) + (v[j].z * v[j].z + v[j].w * v[j].w); }
        const float rstd = rsqrtf(wave_sum(s2) * (1.f / DM) + 1e-5f);
#pragma unroll
        for (int j = 0; j < 4; ++j) { const f32x4 y = v[j] * rstd * g4[j] + b4[j];
            *(f32x4*)(fout + (size_t)m * DM + 4 * lane + 256 * j) = y;
            if (bout) st_bf4(bout + (size_t)m * DM + 4 * lane + 256 * j, y); }
    }
}

#define XB_TMO      128
#define XB_XCNT(j)  (256  + 64 * (j))
#define XB_XSUB(j)  (1280 + 64 * (j))
#define XB_XGEN(j)  (2304 + 64 * (j))
#define XB_TOP      3328
#define XB_TOPGEN   3392
#define XCD_BAR_WORDS 3456
#define XB_SPIN_CAP (1u << 18)

__device__ __forceinline__ unsigned xb_ld(unsigned* p)              { return __hip_atomic_load(p, __ATOMIC_RELAXED, __HIP_MEMORY_SCOPE_AGENT); }
__device__ __forceinline__ unsigned xb_add(unsigned* p, unsigned v) { return __hip_atomic_fetch_add(p, v, __ATOMIC_RELAXED, __HIP_MEMORY_SCOPE_AGENT); }
__device__ __forceinline__ unsigned xb_xcc_id() { return (unsigned)__builtin_amdgcn_s_getreg((3 << 11) | 20) & 0xFu; }
#define XB_SPIN(cond, bar) do { unsigned _sp = 0; while (cond) { __builtin_amdgcn_s_sleep(1); \
    if ((++_sp & 255u) == 0u) { if (xb_ld(&(bar)[XB_TMO])) break; if (_sp > XB_SPIN_CAP) { atomicAdd(&(bar)[XB_TMO], 1u); break; } } } } while (0)

struct XcdBarrier {
    unsigned* bar; unsigned x;
    volatile LAS unsigned* st;
};

__device__ __forceinline__ XcdBarrier xcd_barrier_post(unsigned* bar, volatile LAS unsigned* st) {
    XcdBarrier b; b.bar = bar; b.x = xb_xcc_id(); b.st = st;
    if (threadIdx.x == 0) (void)xb_add(&bar[XB_XCNT(b.x)], 1u);
    return b;
}
__device__ __forceinline__ void xcd_barrier_complete(unsigned* bar, unsigned x, unsigned& nloc, unsigned& nx) {
    const unsigned G = gridDim.x * gridDim.y * gridDim.z;
    unsigned sum, cnt, mine, sp = 0u;
    for (;;) {
        sum = 0u; cnt = 0u; mine = 0u;
#pragma unroll
        for (unsigned j = 0; j < 16; ++j) { const unsigned c = xb_ld(&bar[XB_XCNT(j)]); sum += c; cnt += (c > 0u) ? 1u : 0u; mine = (j == x) ? c : mine; }
        if (sum == G) break;
        __builtin_amdgcn_s_sleep(1);
        if ((++sp & 255u) == 0u) { if (xb_ld(&bar[XB_TMO])) break; if (sp > XB_SPIN_CAP) { atomicAdd(&bar[XB_TMO], 1u); break; } }
    }
    nloc = mine > 0u ? mine : 1u; nx = cnt > 0u ? cnt : 1u;
}

__device__ __forceinline__ void xcd_barrier(const XcdBarrier& b) {
    asm volatile("s_waitcnt vmcnt(0)" ::: "memory");
    __syncthreads();
    if (threadIdx.x == 0) {
        unsigned* bar = b.bar;
        __builtin_amdgcn_s_waitcnt(0);
        unsigned nloc = b.st[0], nx = b.st[1];
        if (nloc == 0u) { xcd_barrier_complete(bar, b.x, nloc, nx); b.st[0] = nloc; b.st[1] = nx; }
        const unsigned old = xb_add(&bar[XB_XSUB(b.x)], 1u);
        const unsigned gen = old / nloc;
        if (old + 1u == (gen + 1u) * nloc) {
            __builtin_amdgcn_fence(__ATOMIC_RELEASE, "agent");
            asm volatile("s_waitcnt vmcnt(0)" ::: "memory");
            const unsigned og = xb_add(&bar[XB_TOP], 1u);
            const unsigned tg = og / nx;
            if (og + 1u == (tg + 1u) * nx) xb_add(&bar[XB_TOPGEN], 1u);
            else XB_SPIN(xb_ld(&bar[XB_TOPGEN]) == tg, bar);
            __builtin_amdgcn_fence(__ATOMIC_ACQUIRE, "agent");
            xb_add(&bar[XB_XGEN(b.x)], 1u);
            asm volatile("s_waitcnt vmcnt(0)" ::: "memory");
        } else {
            XB_SPIN(xb_ld(&bar[XB_XGEN(b.x)]) == gen, bar);
            __builtin_amdgcn_fence(__ATOMIC_ACQUIRE, "agent");
            asm volatile("s_waitcnt vmcnt(0)" ::: "memory");
        }
    }
    __syncthreads();
}

struct Args { const float* in[22]; float* out; unsigned char* ws; int ph_lo, ph_hi, rep, pad; };
constexpr int NWAVES = 8, NPHASE = 9;

__global__ void __launch_bounds__(NWAVES * 64, 2) yoco_fwd(Args a) {
    extern __shared__ __attribute__((aligned(16))) unsigned char lds_raw[];
    LAS unsigned char* lds = (LAS unsigned char*)lds_raw;
    volatile LAS unsigned* MISC = (volatile LAS unsigned*)(lds + LDS_RING);
    cg::grid_group grid = cg::this_grid();
    const int tid = threadIdx.x, lane = tid & 63, wave = __builtin_amdgcn_readfirstlane(tid >> 6);
    const int G = gridDim.x, gw = blockIdx.x * NWAVES + wave, NGW = G * NWAVES;
    const long gtid = (long)blockIdx.x * (NWAVES * 64) + tid, NTHR = (long)G * (NWAVES * 64);
    unsigned char* ws = a.ws; float* dout = a.out;
    unsigned* ctl = (unsigned*)(ws + WS_CTL);
    float* ROPE = (float*)(ws + WS_ROPE);
    float* CSV = (float*)(ws + 32768); float* BWV = (float*)(ws + 49152); float* ST0 = (float*)(ws + 262144); float* ST1 = (float*)(ws + 524288);
    bf16_t* WA_t = (bf16_t*)(ws + WS_WA); bf16_t* WB_t = (bf16_t*)(ws + WS_WB); bf16_t* WM_t = (bf16_t*)(ws + WS_WM); bf16_t* WO_t = (bf16_t*)(ws + WS_WO);
    bf16_t* MEMB = (bf16_t*)(ws + WS_MEMB); bf16_t* MKV = (bf16_t*)(ws + WS_MKV); bf16_t* CMK = (bf16_t*)(ws + WS_CMK); bf16_t* CMV = (bf16_t*)(ws + WS_CMV);
    bf16_t* KSW = (bf16_t*)(ws + WS_KSW); bf16_t* VSW = (bf16_t*)(ws + WS_VSW); bf16_t* XA = (bf16_t*)(ws + WS_XA); bf16_t* ZB = XA;
    bf16_t* MIX = (bf16_t*)(ws + WS_MIX); bf16_t* Z1B = (bf16_t*)(ws + WS_Z0); bf16_t* PA = (bf16_t*)(ws + WS_PA); bf16_t* PB = PA;
    bf16_t* KS = (bf16_t*)(ws + WS_KS); bf16_t* VS = (bf16_t*)(ws + WS_VS);
    const int lo = a.ph_lo, hi_ph = a.ph_hi;
#define IN(k) (lo <= (k) && (k) < hi_ph)
    if (tid < 64) MISC[tid] = 0u;
    __syncthreads();
    XcdBarrier xbar = xcd_barrier_post(ctl + 1024, MISC + 8);
    if (a.ph_lo > 1000) grid.sync();
#define SEAM(k) do { if (IN(k) && IN((k) + 1)) xcd_barrier(xbar); } while (0)
    att::Ctx cx; cx.lds = lds; cx.lane = lane; cx.wid = wave; cx.r32 = lane & 31; cx.hi = lane >> 5;

    if (IN(0)) {
        LAS float* scr = (LAS float*)(lds + wave * 16384);
        for (int it = gw; it < 4736; it += NGW) {
            int r = it;
            if (r < 1536) { p0_transpose_item(a.in[9], DM, NA, WA_t, 0, scr, r, lane); continue; } r -= 1536;
            if (r < 1024) { p0_transpose_item_ln(a.in[15], DM, 2048, WB_t, 0, scr, r, lane, a.in[20], a.in[21], CSV, BWV); continue; } r -= 1024;
            if (r < 128) { p0_transpose_item_ln(a.in[17], DM, 256, WB_t, 2048, scr, r, lane, a.in[20], a.in[21], CSV, BWV); continue; } r -= 128;
            if (r < 1024) { const int l = r >> 9; p0_transpose_item(a.in[18] + (size_t)l * DM * DM, DM, DM, WM_t, l * 1024, scr, r & 511, lane); continue; } r -= 1024;
            { const int l = r >> 9; p0_transpose_item(a.in[19] + (size_t)l * DM * DM, DM, DM, WO_t, l * 1024, scr, r & 511, lane); }
        }
        for (long i = gtid; i < 2097152; i += NTHR) cvt8(a.in[0] + i * 8, XA + i * 8);
        for (long i = gtid; i < 32768; i += NTHR) cvt8(a.in[1] + i * 8, XA + (size_t)NP * DM + i * 8);
        for (long i = gtid; i < 131072; i += NTHR) cvt8(a.in[2] + i * 8, MEMB + i * 8);
        for (long i = gtid; i < 524288; i += NTHR) { cvt8(a.in[7] + i * 8, CMK + i * 8); cvt8(a.in[8] + i * 8, CMV + i * 8); }
        for (long i = gtid; i < 32768; i += NTHR) { const long b = i >> 11, r = i & 2047; const size_t d = (size_t)b * SWROWS * 128 + r * 8;
            cvt8(a.in[5] + i * 8, KSW + d); cvt8(a.in[6] + i * 8, VSW + d);
            const int rw = (int)(r >> 4);
            if (rw >= 16) { const size_t od = ((size_t)b * 128 + rw - 16) * 128 + (r & 15) * 8;
                *(f32x4*)(dout + OFF_SKS + od) = *(const f32x4*)(a.in[5] + i * 8); *(f32x4*)(dout + OFF_SKS + od + 4) = *(const f32x4*)(a.in[5] + i * 8 + 4);
                *(f32x4*)(dout + OFF_SVS + od) = *(const f32x4*)(a.in[6] + i * 8); *(f32x4*)(dout + OFF_SVS + od + 4) = *(const f32x4*)(a.in[6] + i * 8 + 4); } }
        for (long i = gtid; i < 49152; i += NTHR) { const long b = i / 3072, r = i % 3072; const size_t d = ((size_t)b * KSROWS + 4112) * 512 + r * 8;
            *(u32x4*)(KS + d) = (u32x4){0u, 0u, 0u, 0u}; *(u32x4*)(VS + d) = (u32x4){0u, 0u, 0u, 0u}; }
        for (long i = gtid; i < 12288; i += NTHR) { const long b = i / 768, r = i % 768; const size_t d = ((size_t)b * SWROWS + 144) * 128 + r * 8;
            *(u32x4*)(KSW + d) = (u32x4){0u, 0u, 0u, 0u}; *(u32x4*)(VSW + d) = (u32x4){0u, 0u, 0u, 0u}; }
        for (long i = gtid; i < 4112 * 8; i += NTHR) { const int pos = (int)(i >> 3), fi = (int)(i & 7);
            const double inv = fi == 0 ? 1.0 : fi == 1 ? 0.19392274474868576 : fi == 2 ? 0.03760603093086393 : fi == 3 ? 0.007292664737217109 :
                               fi == 4 ? 0.001414213562373095 : fi == 5 ? 0.0002742481756762073 : fi == 6 ? 5.318295896944988e-05 : 1.031338537721246e-05;
            const double rev = (double)pos * inv * 0.15915494309189535; const float fr = (float)(rev - __builtin_rint(rev));
            ROPE[i * 2] = __builtin_amdgcn_cosf(fr); ROPE[i * 2 + 1] = __builtin_amdgcn_sinf(fr); }
    }
    SEAM(0);
    if (IN(1)) {
        pg8::Gemm g{XA, WA_t, NP, NA, DM}; pg8::StaticOrder S; S.init(NP, NA, G, (int)blockIdx.x);
        EpiWrap<EpiAF> E{{PA, dout, KS, VS, ROPE, 0.f, 0.f}, 0, 0};
        pg8::gemm_phase<EpiWrap<EpiAF>, pg8::StaticOrder, true, true>(lds, g, S, E);
    }
    SEAM(1);
    if (IN(2)) {
        float s1 = 0.f, s2 = 0.f;
        for (int i = 0; i < 64; ++i) { s1 += a.in[10][i] * a.in[11][i]; s2 += a.in[12][i] * a.in[13][i]; }
        if (tid == 0) MISC[2] = __float_as_uint(__expf(s1) - __expf(s2) + 0.2f);
        __syncthreads();
        unsigned* gdone = ctl + 256 + 64 * a.rep;
        if (blockIdx.x < 44) {
            if (blockIdx.x < 32) { pg8::Gemm g{MEMB, WM_t, 1024, 2048, DM}; pg8::StaticOrder S; S.init(1024, 2048, 32, (int)blockIdx.x);
                EpiWrap<EpiMemF> E{{MKV, dout, 0.f, 0.f}, 0, 0};
                pg8::gemm_phase<EpiWrap<EpiMemF>, pg8::StaticOrder, true, true>(lds, g, S, E); }
            else { pg8::Gemm g{XA + (size_t)NP * DM, WA_t, 256, NA, DM}; pg8::StaticOrder S; S.init(256, NA, 12, (int)blockIdx.x - 32);
                EpiWrap<EpiAF> E{{PA, dout, KS, VS, ROPE, 0.f, 0.f}, NP, 0};
                pg8::gemm_phase<EpiWrap<EpiAF>, pg8::StaticOrder, true, true>(lds, g, S, E); }
            asm volatile("s_waitcnt vmcnt(0)" ::: "memory"); __syncthreads();
            if (tid == 0) { __builtin_amdgcn_fence(__ATOMIC_RELEASE, "agent"); asm volatile("s_waitcnt vmcnt(0)" ::: "memory");
                            __hip_atomic_fetch_add(gdone, 1u, __ATOMIC_RELAXED, __HIP_MEMORY_SCOPE_AGENT); }
        }
        bool ready = false;
        float* PART = (float*)(ws + WS_Z0 + 40 * MiB + (size_t)a.rep * (10 * MiB));
        for (;;) {
            if (tid == 0) MISC[0] = atomicAdd(ctl + 128 * a.rep, 1u);
            __syncthreads(); const unsigned u = MISC[0]; __syncthreads();
            if (u >= 1088u) break;
            const bool needs = (u >= 256u && u < 512u) || u >= 768u;
            if (needs && !ready) {
                if (tid == 0) { unsigned sp = 0; while (__hip_atomic_load(gdone, __ATOMIC_RELAXED, __HIP_MEMORY_SCOPE_AGENT) < 44u && ++sp < (1u << 24)) __builtin_amdgcn_s_sleep(8);
                                __builtin_amdgcn_fence(__ATOMIC_ACQUIRE, "agent"); asm volatile("s_waitcnt vmcnt(0)" ::: "memory"); }
                __syncthreads(); ready = true;
            }
            if (u < 768u) {
                const float lam = __uint_as_float(MISC[2]);
                if (u >= 256u && u < 512u) { const unsigned v = u - 256u;
                    att::diff_sample_item(cx, (int)(v >> 4), (int)((v >> 2) & 3u), (int)(v & 3u), a.in[3], a.in[4], PA, KS, VS, MIX, a.in[14], lam, PART, ctl + 512 + 64 * a.rep, MISC); }
                else { const unsigned v = u < 256u ? u : u - 256u;
                    att::diff_unit(cx, false, (int)((v & 15u) >> 2), (int)(v & 3u), 31 - (int)(v >> 4), PA, KS, VS, MIX, a.in[14], lam); } }
            else { const bool samp = u >= 1024u; const unsigned v = samp ? u - 1024u : u - 768u;
                const int b = samp ? (int)(v >> 2) : (int)(v >> 6), h = samp ? (int)(v & 3u) : (int)((v >> 4) & 3u), qb = samp ? 0 : (int)(v & 15u);
                const bf16_t* Kb = samp ? CMK + ((size_t)b * 256) * 512 + h * 128 : MKV + ((size_t)b * 256) * 2048 + h * 128;
                const bf16_t* Vb = samp ? CMV + ((size_t)b * 256) * 512 + h * 128 : Kb + 512;
                att::mem_unit(cx, samp, b, h, qb, PA, NA, 2048, 2560, Kb, Vb, samp ? 512 : 2048, MIX); }
        }
    }
    SEAM(2);
    if (IN(3)) {
        EpiMerge0F F0{ZB, ST0, 0.f, 0.f};
        { pg8::Gemm g{MIX, WO_t, NP, DM, DM}; pg8::StaticOrder S; S.init(NP, DM, G, (int)blockIdx.x);
          EpiWrap<EpiMerge0F> E{F0, 0, 0};
          pg8::gemm_phase<EpiWrap<EpiMerge0F>, pg8::StaticOrder, true, true>(lds, g, S, E); }
        gemm_small<EpiMerge0F>(lds, MIX + (size_t)NP * DM, WO_t, DM, NP, (int)blockIdx.x, G, F0);
    }
    SEAM(3);
    if (IN(5)) {
        EpiBF FB{PB, dout, KSW, VSW, ROPE, ST0, CSV, BWV, 0.f, 0.f, {0.f, 0.f}, {0.f, 0.f}};
        { pg8::Gemm g{ZB, WB_t, NP, 2048, DM}; pg8::StaticOrder S; S.init(NP, 2048, G, (int)blockIdx.x);
          EpiWrap<EpiBF> E{FB, 0, 0};
          pg8::gemm_phase<EpiWrap<EpiBF>, pg8::StaticOrder, true, true>(lds, g, S, E); }
    }
    SEAM(5);
    if (IN(6)) {
        unsigned* gdone = ctl + 384 + 64 * a.rep;
        {
            EpiBF FB{PB, dout, KSW, VSW, ROPE, ST0, CSV, BWV, 0.f, 0.f, {0.f, 0.f}, {0.f, 0.f}};
            if (blockIdx.x < 64) { pg8::Gemm g{ZB, WB_t + (size_t)2048 * DM, NP, 256, DM}; pg8::StaticOrder S; S.init(NP, 256, 64, (int)blockIdx.x);
                EpiWrap<EpiBF> E{FB, 0, 2048};
                pg8::gemm_phase<EpiWrap<EpiBF>, pg8::StaticOrder, true, true>(lds, g, S, E); }
            else { gemm_small<EpiBF>(lds, ZB + (size_t)NP * DM, WB_t, 2048, NP, (int)blockIdx.x - 64, 192, FB);
                   if (blockIdx.x >= 192) gemm_small<EpiBF>(lds, ZB + (size_t)NP * DM, WB_t + (size_t)2048 * DM, 256, NP, (int)blockIdx.x - 192, 64, FB, 2048); }
            asm volatile("s_waitcnt vmcnt(0)" ::: "memory"); __syncthreads();
            if (tid == 0) { __builtin_amdgcn_fence(__ATOMIC_RELEASE, "agent"); asm volatile("s_waitcnt vmcnt(0)" ::: "memory");
                            __hip_atomic_fetch_add(gdone + (blockIdx.x < 64 ? 0 : 16), 1u, __ATOMIC_RELAXED, __HIP_MEMORY_SCOPE_AGENT); }
        }
        bool ready1 = false, ready2 = false;
        for (;;) {
            if (tid == 0) MISC[0] = atomicAdd(ctl + 64 + 128 * a.rep, 1u);
            __syncthreads(); const unsigned u = MISC[0]; __syncthreads();
            if (u >= 848u) break;
            const bool need1 = u >= 256u && u < 768u, need2 = u >= 768u;
            if ((need1 && !ready1) || (need2 && !ready2)) {
                if (tid == 0) { unsigned sp = 0; unsigned* w = need1 ? gdone : gdone + 16; const unsigned want = need1 ? 64u : 192u;
                                while (__hip_atomic_load(w, __ATOMIC_RELAXED, __HIP_MEMORY_SCOPE_AGENT) < want && ++sp < (1u << 24)) __builtin_amdgcn_s_sleep(8);
                                __builtin_amdgcn_fence(__ATOMIC_ACQUIRE, "agent"); asm volatile("s_waitcnt vmcnt(0)" ::: "memory"); }
                __syncthreads(); if (need1) ready1 = true; else ready2 = true;
            }
            const bool is_mem = u < 256u || (u >= 768u && u < 832u);
            if (is_mem) { const bool samp = u >= 768u; const unsigned v = samp ? u - 768u : u;
                const int b = samp ? (int)(v >> 2) : (int)(v >> 6), h = samp ? (int)(v & 3u) : (int)((v >> 4) & 3u), qb = samp ? 0 : (int)(v & 15u);
                const bf16_t* Kb = samp ? CMK + ((size_t)(16 + b) * 256) * 512 + h * 128 : MKV + ((size_t)b * 256) * 2048 + 1024 + h * 128;
                const bf16_t* Vb = samp ? CMV + ((size_t)(16 + b) * 256) * 512 + h * 128 : Kb + 512;
                att::mem_unit(cx, samp, b, h, qb, PB, NB, 1024, 1536, Kb, Vb, samp ? 512 : 2048, MIX); }
            else { const bool samp = u >= 832u; const unsigned v = samp ? u - 832u : u - 256u;
                const int b = samp ? (int)v : (int)(v >> 7), c = samp ? 0 : (int)((v >> 1) & 63u), half = samp ? 0 : (int)(v & 1u);
                att::swa_unit(cx, samp, b, c, half, PB, KSW, VSW, MIX, a.in[16]); }
        }
    }
    SEAM(6);
    if (IN(7)) {
        EpiMerge1F F1{ZB, ST0, a.in[20], a.in[21], Z1B, ST1, 0.f, 0.f, {0.f, 0.f}, {0.f, 0.f}};
        { pg8::Gemm g{MIX, WO_t + (size_t)DM * DM, NP, DM, DM}; pg8::StaticOrder S; S.init(NP, DM, G, (int)blockIdx.x);
          EpiWrap<EpiMerge1F> E{F1, 0, 0};
          pg8::gemm_phase<EpiWrap<EpiMerge1F>, pg8::StaticOrder, true, true>(lds, g, S, E); }
        gemm_small<EpiMerge1F>(lds, MIX + (size_t)NP * DM, WO_t + (size_t)DM * DM, DM, NP, (int)blockIdx.x, G, F1);
    }
    SEAM(7);
    if (IN(8)) {
        const float* g1 = a.in[20] + DM; const float* b1 = a.in[21] + DM;
#pragma unroll 4
        for (long i = gtid; i < (long)MA * 256; i += NTHR) { const int row = (int)(i >> 8), c4 = (int)(i & 255) * 4;
            float mu, rstd; row_stats(ST1, row, mu, rstd);
            const u32x2 zz = __builtin_nontemporal_load((const u32x2*)(Z1B + (size_t)row * DM + c4));
            const f32x4 z = (f32x4){bflo(zz.x), bfhi(zz.x), bflo(zz.y), bfhi(zz.y)};
            __builtin_nontemporal_store((z - mu) * rstd * *(const f32x4*)(g1 + c4) + *(const f32x4*)(b1 + c4), (f32x4*)(dout + (size_t)row * DM + c4)); }
    }
#undef IN
#undef SEAM
}

#ifndef MK_N_LAUNCHES
#define MK_N_LAUNCHES 1
#endif
#ifndef PROBE_DUP
#define PROBE_DUP 0
#endif
extern "C" void kernel_launch(void* const* d_in, const int* in_sizes, int n_in, void* d_out, int out_size, void* d_ws, size_t ws_size, hipStream_t stream) {
    static int grid = 0;
    if (grid == 0) {
        if (n_in != 22 || ws_size < WS_END) { fprintf(stderr, "kernel_launch: unexpected n_in %d / ws %zu\n", n_in, ws_size); grid = -1; return; }
        int dev = 0, cus = 0, per_cu = 0;
        if (hipGetDevice(&dev) != hipSuccess || hipDeviceGetAttribute(&cus, hipDeviceAttributeMultiprocessorCount, dev) != hipSuccess) { grid = -1; return; }
        if (hipFuncSetAttribute((const void*)yoco_fwd, hipFuncAttributeMaxDynamicSharedMemorySize, LDS_BYTES) != hipSuccess) { fprintf(stderr, "kernel_launch: hipFuncSetAttribute failed\n"); grid = -1; return; }
        if (hipOccupancyMaxActiveBlocksPerMultiprocessor(&per_cu, (const void*)yoco_fwd, NWAVES * 64, LDS_BYTES) != hipSuccess || per_cu < 1) { fprintf(stderr, "kernel_launch: occupancy query says %d\n", per_cu); per_cu = 1; }
        (void)hipGetLastError();
        grid = cus;
    }
    if (grid < 0) return;
    (void)hipMemsetAsync((char*)d_ws + WS_CTL, 0, 1048576, stream);
    Args a{};
    for (int i = 0; i < 22; ++i) a.in[i] = (const float*)d_in[i];
    a.out = (float*)d_out; a.ws = (unsigned char*)d_ws;
#if MK_N_LAUNCHES == 1
    a.ph_lo = 0; a.ph_hi = NPHASE;
    void* args[] = {&a};
    hipError_t e = hipLaunchCooperativeKernel((const void*)yoco_fwd, dim3(grid), dim3(NWAVES * 64), args, LDS_BYTES, stream);
    if (e != hipSuccess) fprintf(stderr, "kernel_launch: cooperative launch failed: %s (grid %d)\n", hipGetErrorString(e), grid);
#else
    for (int p = 0; p < NPHASE; ++p) { a.ph_lo = p; a.ph_hi = p + 1;
        for (int r = 0; r < 1 + ((PROBE_DUP >> p) & 1); ++r) { a.rep = r; hipLaunchKernelGGL(yoco_fwd, dim3(grid), dim3(NWAVES * 64), LDS_BYTES, stream, a); } }
#endif
}
```

```cpp
#include <hip/hip_runtime.h>
#include <hip/hip_cooperative_groups.h>
#include <cstdio>
#include <cstdint>
namespace cg = cooperative_groups;
namespace pg8 {
#define PG8_LAS __attribute__((address_space(3)))
typedef unsigned short bf16_t;
typedef short bf16x8 __attribute__((ext_vector_type(8)));
typedef float f32x4 __attribute__((ext_vector_type(4)));
typedef unsigned u32x4 __attribute__((ext_vector_type(4)));
constexpr int BM = 256, BK = 64, HALF = 128, HTB = HALF * BK * 2  , STAGE_BYTES = 8 * HTB, NXCD = 8, WGM = 8;

__host__ __device__ __forceinline__ int lds_byte(int r, int c) { const int st = (r >> 4) * 2 + (c >> 5), rr = r & 15, cc = c & 31, ob = rr * 64 + cc * 2; return st * 1024 + (ob ^ (((ob >> 9) & 1) << 5)); }
__host__ __device__ __forceinline__ void stage_rc(int b, int& R, int& C) { const int st = b / 1024, sb = b % 1024, swz = sb ^ (((sb >> 9) & 1) << 5); R = (st >> 1) * 16 + swz / 64; C = (st & 1) * 32 + (swz % 64) / 2; }
__host__ __device__ __forceinline__ int perm32(int rho) { const int n = rho >> 4, i = rho & 15; return 8 * (i >> 2) + 4 * n + (i & 3); }

struct Unit { int pm, pn; };
struct Gemm { const bf16_t* A; const bf16_t* Bt; int M, N, K; };

struct StaticOrder {
    int nM, nN, nwg, G, c;
    __host__ __device__ void init(int M, int N, int G_, int c_) { nM = M / BM; nN = N / BM; nwg = nM * nN; G = G_; c = c_; }
    __host__ __device__ bool next(int i, Unit& u) const {
        const long L = (long)i * G + c; if (L >= nwg) return false;
        int wgid = (int)L; { const int q = nwg / NXCD, r = nwg % NXCD, xcd = wgid % NXCD, off = wgid / NXCD; wgid = (xcd < r ? xcd * (q + 1) : r * (q + 1) + (xcd - r) * q) + off; }
        const int nig = WGM * nN, gid = wgid / nig, fm = gid * WGM, gsz = (nM - fm) < WGM ? (nM - fm) : WGM;
        u.pm = fm + ((wgid % nig) % gsz); u.pn = (wgid % nig) / gsz; return true;
    }
    __device__ __forceinline__ void a_ready(const Unit&) const {}
    __device__ __forceinline__ void done(const Unit&) const {}
};
__device__ __forceinline__ unsigned cvt_pk_bf16(float lo, float hi) { unsigned r; asm volatile("v_cvt_pk_bf16_f32 %0, %1, %2" : "=v"(r) : "v"(lo), "v"(hi)); return r; }
typedef float f32x2 __attribute__((ext_vector_type(2)));
template <class Epi, class Sched, bool ALIGN_EPI = false, bool SP2 = false>
__device__ __forceinline__ void gemm_phase(PG8_LAS unsigned char* lds, const Gemm g, const Sched& S, const Epi& E) {
    const int tid = threadIdx.x, wid = __builtin_amdgcn_readfirstlane(tid >> 6), lane = tid & 63, wr = wid >> 2, wc = wid & 3, fr = lane & 15, fq = lane >> 4;
    const int K = g.K, nt = K / BK;
    unsigned voffA[2], voffB[2];
#pragma unroll
    for (int i = 0; i < 2; ++i) { int R, C; stage_rc(tid * 16 + i * 8192, R, C); const int Rb = Epi::PERM ? ((R & ~31) + perm32(R & 31)) : R;
        voffA[i] = (unsigned)(R * K + C) * 2u; voffB[i] = (unsigned)(Rb * K + C) * 2u; }
    const size_t kstep = (size_t)(BK * 2);
    const size_t hstep = (size_t)HALF * K * 2;
    const size_t tstep = 2 * hstep;
    const unsigned ldsw = (unsigned)wid * 1024u;
    const int aoff = lds_byte(wr * 64 + fr, fq * 8), boff = lds_byte(wc * 32 + fr, fq * 8);
#define PG8_SA(b, h) (((b) * 2 + (h)) * HTB)
#define PG8_SB(b, h) ((4 + (b) * 2 + (h)) * HTB)
#define PG8_STAGE(bufoff, gbase, voff) do { _Pragma("unroll") for (int _i = 0; _i < 2; ++_i) \
        __builtin_amdgcn_global_load_lds((const unsigned*)((const char*)(gbase) + (voff)[_i]), (PG8_LAS unsigned*)(lds + (bufoff) + ldsw + _i * 8192), 16, 0, 0); } while (0)
#define PG8_LDA(dst, b, h) do { _Pragma("unroll") for (int m = 0; m < 4; ++m) _Pragma("unroll") for (int k = 0; k < 2; ++k) dst[m][k] = *(const PG8_LAS bf16x8*)(lds + PG8_SA(b, h) + aoff + m * 2048 + k * 1024); } while (0)
#define PG8_LDB(dst, b, h) do { _Pragma("unroll") for (int n = 0; n < 2; ++n) _Pragma("unroll") for (int k = 0; k < 2; ++k) dst[n][k] = *(const PG8_LAS bf16x8*)(lds + PG8_SB(b, h) + boff + n * 2048 + k * 1024); } while (0)
#define PG8_MMA(ai, bj, At, Bt) do { __builtin_amdgcn_s_setprio(1); _Pragma("unroll") for (int m = 0; m < 4; ++m) _Pragma("unroll") for (int n = 0; n < 2; ++n) _Pragma("unroll") for (int k = 0; k < 2; ++k) \
        acc[ai][bj][m][n] = __builtin_amdgcn_mfma_f32_16x16x32_bf16(Bt[n][k], At[m][k], acc[ai][bj][m][n], 0, 0, 0); __builtin_amdgcn_s_setprio(0); } while (0)
#define PG8_WAIT_V(n) asm volatile("s_waitcnt vmcnt(" #n ")" ::: "memory")
#define PG8_WAIT_L(n) asm volatile("s_waitcnt lgkmcnt(" #n ")" ::: "memory")
#define PG8_BAR __builtin_amdgcn_s_barrier()
#define PG8_SCHED __builtin_amdgcn_sched_barrier(0)
    Unit cur, nxt; int ui = 0;
    if (!S.next(0, cur)) return;
    f32x4 acc[2][2][4][2];
#pragma unroll
    for (int a = 0; a < 2; ++a)
#pragma unroll
        for (int b = 0; b < 2; ++b)
#pragma unroll
            for (int m = 0; m < 4; ++m)
#pragma unroll
                for (int n = 0; n < 2; ++n) acc[a][b][m][n] = (f32x4){0.f, 0.f, 0.f, 0.f};
    bf16x8 At[4][2], B0[2][2], B1[2][2];
    const char* cA = (const char*)g.A + (size_t)cur.pm * tstep; const char* cB = (const char*)g.Bt + (size_t)cur.pn * tstep;
    S.a_ready(cur);
    if constexpr (SP2) {
        PG8_STAGE(PG8_SB(0, 0), cB, voffB); PG8_STAGE(PG8_SB(0, 1), cB + hstep, voffB); PG8_STAGE(PG8_SA(0, 0), cA, voffA); PG8_STAGE(PG8_SA(0, 1), cA + hstep, voffA);
        if (wr == 1) PG8_BAR;
        PG8_WAIT_V(2); PG8_BAR;
        PG8_STAGE(PG8_SB(1, 0), cB + kstep, voffB); PG8_STAGE(PG8_SA(1, 0), cA + kstep, voffA); PG8_STAGE(PG8_SB(1, 1), cB + hstep + kstep, voffB);
        PG8_WAIT_V(6); PG8_BAR;
    } else {
        PG8_STAGE(PG8_SB(0, 0), cB, voffB); PG8_STAGE(PG8_SA(0, 0), cA, voffA); PG8_STAGE(PG8_SB(0, 1), cB + hstep, voffB); PG8_STAGE(PG8_SA(0, 1), cA + hstep, voffA);
        if (wr == 1) PG8_BAR;
        PG8_WAIT_V(4); PG8_BAR;
        PG8_STAGE(PG8_SB(1, 0), cB + kstep, voffB); PG8_STAGE(PG8_SA(1, 0), cA + kstep, voffA); PG8_STAGE(PG8_SB(1, 1), cB + hstep + kstep, voffB);
        PG8_WAIT_V(6); PG8_BAR;
    }
    for (;;) {
        const bool has_next = S.next(ui + 1, nxt);
        const char* nA = has_next ? (const char*)g.A + (size_t)nxt.pm * tstep : cA; const char* nB = has_next ? (const char*)g.Bt + (size_t)nxt.pn * tstep : cB;
        for (int t = 0; t < nt; t += 2) {
            const bool last = (t == nt - 2);
            const char* a1 = cA + (size_t)(t + 1) * kstep;
            const char* a2 = last ? nA : cA + (size_t)(t + 2) * kstep; const char* b2 = last ? nB : cB + (size_t)(t + 2) * kstep;
            const char* a3 = a2 + kstep; const char* b3 = b2 + kstep;
            if (last && has_next) S.a_ready(nxt);
            if constexpr (SP2) {
            PG8_LDB(B0, 0, 0); PG8_LDB(B1, 0, 1); PG8_SCHED; PG8_LDA(At, 0, 0); PG8_STAGE(PG8_SA(1, 1), a1 + hstep, voffA);
            PG8_WAIT_V(8); PG8_WAIT_L(0); PG8_BAR; PG8_MMA(0, 0, At, B0); PG8_MMA(0, 1, At, B1); PG8_BAR; PG8_SCHED;
            PG8_LDA(At, 0, 1); PG8_STAGE(PG8_SB(0, 0), b2, voffB); PG8_STAGE(PG8_SB(0, 1), b2 + hstep, voffB); PG8_STAGE(PG8_SA(0, 0), a2, voffA);
            PG8_WAIT_V(8); PG8_WAIT_L(0); PG8_BAR; PG8_MMA(1, 0, At, B0); PG8_MMA(1, 1, At, B1); PG8_BAR; PG8_SCHED;
            PG8_LDB(B0, 1, 0); PG8_LDB(B1, 1, 1); PG8_SCHED; PG8_LDA(At, 1, 0); PG8_STAGE(PG8_SA(0, 1), a2 + hstep, voffA);
            PG8_WAIT_V(8); PG8_WAIT_L(0); PG8_BAR; PG8_MMA(0, 0, At, B0); PG8_MMA(0, 1, At, B1); PG8_BAR; PG8_SCHED;
            PG8_LDA(At, 1, 1); PG8_STAGE(PG8_SB(1, 0), b3, voffB); PG8_STAGE(PG8_SB(1, 1), b3 + hstep, voffB); PG8_STAGE(PG8_SA(1, 0), a3, voffA);
            PG8_WAIT_V(8); PG8_WAIT_L(0); PG8_BAR; PG8_MMA(1, 0, At, B0); PG8_MMA(1, 1, At, B1); PG8_BAR; PG8_SCHED;
            } else {
            PG8_LDB(B0, 0, 0); PG8_SCHED; PG8_LDA(At, 0, 0); PG8_STAGE(PG8_SA(1, 1), a1 + hstep, voffA);
            PG8_WAIT_L(8); PG8_BAR; PG8_WAIT_L(0); PG8_MMA(0, 0, At, B0); PG8_BAR; PG8_SCHED;
            PG8_LDB(B1, 0, 1); PG8_STAGE(PG8_SB(0, 0), b2, voffB);
            PG8_BAR; PG8_WAIT_L(0); PG8_MMA(0, 1, At, B1); PG8_BAR;
            PG8_LDA(At, 0, 1); PG8_STAGE(PG8_SA(0, 0), a2, voffA);
            PG8_BAR; PG8_WAIT_L(0); PG8_MMA(1, 0, At, B0); PG8_BAR; PG8_SCHED;
            PG8_STAGE(PG8_SB(0, 1), b2 + hstep, voffB);
            PG8_WAIT_V(6); PG8_BAR; PG8_MMA(1, 1, At, B1); PG8_BAR;
            PG8_LDB(B0, 1, 0); PG8_SCHED; PG8_LDA(At, 1, 0); PG8_STAGE(PG8_SA(0, 1), a2 + hstep, voffA);
            PG8_WAIT_L(8); PG8_BAR; PG8_WAIT_L(0); PG8_MMA(0, 0, At, B0); PG8_BAR; PG8_SCHED;
            PG8_LDB(B1, 1, 1); PG8_STAGE(PG8_SB(1, 0), b3, voffB);
            PG8_BAR; PG8_WAIT_L(0); PG8_MMA(0, 1, At, B1); PG8_BAR;
            PG8_LDA(At, 1, 1); PG8_STAGE(PG8_SA(1, 0), a3, voffA);
            PG8_BAR; PG8_WAIT_L(0); PG8_MMA(1, 0, At, B0); PG8_BAR; PG8_SCHED;
            PG8_STAGE(PG8_SB(1, 1), b3 + hstep, voffB);
            PG8_WAIT_V(6); PG8_BAR; PG8_MMA(1, 1, At, B1); PG8_BAR;
            }
        }
        if constexpr (ALIGN_EPI) { if (wr == 0) PG8_BAR; }
        if constexpr (!Epi::AFTER_DRAIN) { E(acc, cur, wr, wc, fr, fq); S.done(cur); }
        if (!has_next) break;
#pragma unroll
        for (int a = 0; a < 2; ++a)
#pragma unroll
            for (int b = 0; b < 2; ++b)
#pragma unroll
                for (int m = 0; m < 4; ++m)
#pragma unroll
                    for (int n = 0; n < 2; ++n) acc[a][b][m][n] = (f32x4){0.f, 0.f, 0.f, 0.f};
        cur = nxt; cA = nA; cB = nB; ++ui;
        if constexpr (ALIGN_EPI) { if (wr == 1) PG8_BAR; }
    }
    PG8_WAIT_V(0);
    if constexpr (!ALIGN_EPI) { if (wr == 0) PG8_BAR; }
    PG8_BAR;
    if constexpr (Epi::AFTER_DRAIN) { E.fused(acc, cur, wr, wc, fr, fq, lds, wid, lane); S.done(cur); }
#undef PG8_SA
#undef PG8_SB
#undef PG8_STAGE
#undef PG8_LDA
#undef PG8_LDB
#undef PG8_MMA
#undef PG8_WAIT_V
#undef PG8_WAIT_L
#undef PG8_BAR
#undef PG8_SCHED
}
}

typedef unsigned short bf16_t;
typedef short bf16x8 __attribute__((ext_vector_type(8)));
typedef short s16x4 __attribute__((ext_vector_type(4)));
typedef float f32x4 __attribute__((ext_vector_type(4)));
typedef float f32x16 __attribute__((ext_vector_type(16)));
typedef unsigned u32x4 __attribute__((ext_vector_type(4)));
typedef unsigned u32x2 __attribute__((ext_vector_type(2)));
#define LAS __attribute__((address_space(3)))

constexpr int DM = 1024, NP = 16384, NS = 256, MA = NP + NS;
constexpr int NA = 3072, NB = 2304;
constexpr int KSROWS = 4160, SWROWS = 192;
constexpr float DN_ALPHA = 1.41421356237309515f;
constexpr float LOG2E = 1.4426950408889634f;
constexpr float C64 = 0.125f * LOG2E, THR64 = 64.f;
constexpr float C128 = 0.088388347648318440f * LOG2E, THR128 = 90.5f;
constexpr size_t OFF_DKP = 17039360, OFF_DVP = 25427968, OFF_DKS = 33816576, OFF_DVS = 33947648, OFF_SKP = 34078720, OFF_SVP = 34144256,
                 OFF_SKS = 34209792, OFF_SVS = 34471936, OFF_MKP = 34734080, OFF_MVP = 35782656;
constexpr size_t MiB = 1u << 20;
constexpr size_t WS_CTL = 0, WS_ROPE = 1 * MiB, WS_WA = 2 * MiB, WS_WB = 8 * MiB, WS_WM = 13 * MiB, WS_WO = 17 * MiB, WS_MEMB = 21 * MiB, WS_MKV = 23 * MiB,
                 WS_CMK = 27 * MiB, WS_CMV = 35 * MiB, WS_KSW = 43 * MiB, WS_VSW = 44 * MiB, WS_XA = 46 * MiB, WS_MIX = 79 * MiB, WS_Z0 = 112 * MiB,
                 WS_PA = 177 * MiB, WS_KS = 275 * MiB, WS_VS = 340 * MiB, WS_END = 405 * MiB;
constexpr int LDS_RING = 131072, LDS_BYTES = LDS_RING + 256;

__device__ __forceinline__ unsigned cvtpk(float lo, float hi) { unsigned r; asm volatile("v_cvt_pk_bf16_f32 %0, %1, %2" : "=v"(r) : "v"(lo), "v"(hi)); return r; }
__device__ __forceinline__ float bflo(unsigned w) { return __uint_as_float(w << 16); }
__device__ __forceinline__ float bfhi(unsigned w) { return __uint_as_float(w & 0xffff0000u); }
__device__ __forceinline__ float silu(float x) { return x * __builtin_amdgcn_rcpf(1.f + __expf(-x)); }
__device__ __forceinline__ void cvt8(const float* s, bf16_t* d) {
    const f32x4 a = __builtin_nontemporal_load((const f32x4*)s), b = __builtin_nontemporal_load((const f32x4*)(s + 4));
    u32x4 w; w.x = cvtpk(a.x, a.y); w.y = cvtpk(a.z, a.w); w.z = cvtpk(b.x, b.y); w.w = cvtpk(b.z, b.w); __builtin_nontemporal_store(w, (u32x4*)d);
}

__device__ __forceinline__ f32x4 shfl4(f32x4 v, int m) { f32x4 p; p.x = __shfl_xor(v.x, m); p.y = __shfl_xor(v.y, m); p.z = __shfl_xor(v.z, m); p.w = __shfl_xor(v.w, m); return p; }
struct NoPre {};
template <class F> struct EpiWrap {
    static constexpr bool PERM = true, AFTER_DRAIN = false;
    F f; int rowbase, colbase;
    __device__ __forceinline__ void operator()(const f32x4 (&acc)[2][2][4][2], const pg8::Unit& u, int wr, int wc, int fr, int fq) const {
        F lf = f;
#pragma unroll
        for (int ai = 0; ai < 2; ++ai)
#pragma unroll
            for (int mp = 0; mp < 2; ++mp) {
                typename F::Pre pr[2][2][2]; f32x4 vv[2][2][2];
                const int row0 = rowbase + u.pm * 256 + ai * 128 + wr * 64 + mp * 32 + fr, colb = colbase + u.pn * 256 + wc * 32 + 8 * fq;
#pragma unroll
                for (int mm = 0; mm < 2; ++mm) { lf.row_begin(mm, row0 + mm * 16);
#pragma unroll
                    for (int bj = 0; bj < 2; ++bj)
#pragma unroll
                        for (int n = 0; n < 2; ++n) pr[mm][bj][n] = lf.pre(row0 + mm * 16, colb + bj * 128 + n * 4); }
#pragma unroll
                for (int mm = 0; mm < 2; ++mm)
#pragma unroll
                    for (int bj = 0; bj < 2; ++bj)
#pragma unroll
                        for (int n = 0; n < 2; ++n) vv[mm][bj][n] = lf.fix(mm, colb + bj * 128 + n * 4, acc[ai][bj][mp * 2 + mm][n], pr[mm][bj][n]);
#pragma unroll
                for (int mm = 0; mm < 2; ++mm) { const int row = row0 + mm * 16; lf.s = 0.f; lf.q = 0.f;
#pragma unroll
                    for (int bj = 0; bj < 2; ++bj) { const int col = colb + bj * 128; f32x4 p0 = vv[mm][bj][0], p1 = vv[mm][bj][1];
                        if constexpr (F::ROPE) { if (lf.need_rope(col - 8 * fq)) { p0 = shfl4(p0, 16); p1 = shfl4(p1, 16); } }
                        lf.oct(row, col, vv[mm][bj][0], vv[mm][bj][1], p0, p1); }
                    if constexpr (F::STATS) { float s = lf.s, q = lf.q; s += __shfl_xor(s, 16); s += __shfl_xor(s, 32); q += __shfl_xor(q, 16); q += __shfl_xor(q, 32);
                        if (fq == 0) lf.commit(row, s, q); } }
            }
    }
};
__device__ __forceinline__ f32x4 rope_apply(f32x4 v, f32x4 p, int col, int pos, const float* rope) {
    const float* t = rope + ((size_t)pos * 8 + (col & 4)) * 2;
    const f32x4 t0 = *(const f32x4*)t, t1 = *(const f32x4*)(t + 4);
    const float sg = (col & 8) ? 1.f : -1.f;
    f32x4 o; o.x = v.x * t0.x + sg * p.x * t0.y; o.y = v.y * t0.z + sg * p.y * t0.w; o.z = v.z * t1.x + sg * p.z * t1.y; o.w = v.w * t1.z + sg * p.w * t1.w;
    return o;
}
__device__ __forceinline__ void st_bf4(bf16_t* p, f32x4 v) { u32x2 w; w.x = cvtpk(v.x, v.y); w.y = cvtpk(v.z, v.w); *(u32x2*)p = w; }
__device__ __forceinline__ void st_bf8_nt(bf16_t* p, f32x4 a, f32x4 b) { u32x4 w; w.x = cvtpk(a.x, a.y); w.y = cvtpk(a.z, a.w); w.z = cvtpk(b.x, b.y); w.w = cvtpk(b.z, b.w); __builtin_nontemporal_store(w, (u32x4*)p); }
__device__ __forceinline__ void st_bf8(bf16_t* p, f32x4 a, f32x4 b) { u32x4 w; w.x = cvtpk(a.x, a.y); w.y = cvtpk(a.z, a.w); w.z = cvtpk(b.x, b.y); w.w = cvtpk(b.z, b.w); *(u32x4*)p = w; }
__device__ __forceinline__ void row_stats(const float* ST, int row, float& mu, float& rstd) {
    const float s = ST[2 * (size_t)row], q = ST[2 * (size_t)row + 1]; mu = s * (1.f / DM); rstd = rsqrtf(fmaxf(q * (1.f / DM) - mu * mu, 0.f) + 1e-5f);
}

struct EpiAF {
    static constexpr bool ROPE = true, STATS = false; typedef NoPre Pre;
    bf16_t* PA; float* dout; bf16_t* KS; bf16_t* VS; const float* rope; float s, q;
    __device__ __forceinline__ void row_begin(int, int) {}
    __device__ __forceinline__ Pre pre(int, int) const { return Pre{}; }
    __device__ __forceinline__ f32x4 fix(int, int, f32x4 v, const Pre&) const { return v; }
    __device__ __forceinline__ bool need_rope(int col) const { return (col >> 9) < 2 && ((col >> 4) & 3) == 0; }
    __device__ __forceinline__ void commit(int, float, float) {}
    __device__ __forceinline__ void oct(int row, int col, f32x4 v0, f32x4 v1, f32x4 p0, f32x4 p1) {
        const bool samp = row >= NP; const int rs = row - NP;
        const int pos = samp ? 4096 + (rs & 15) : (row & 4095);
        const int region = col >> 9;
        if (need_rope(col)) { v0 = rope_apply(v0, p0, col, pos, rope); v1 = rope_apply(v1, p1, col + 4, pos, rope); }
        st_bf8(PA + (size_t)row * NA + col, v0, v1);
        if (region == 1 || region == 2) {
            const int c = col & 511;
            if (!samp) { float* o = dout + (region == 1 ? OFF_DKP : OFF_DVP) + (size_t)row * 512 + c; __builtin_nontemporal_store(v0, (f32x4*)o); __builtin_nontemporal_store(v1, (f32x4*)(o + 4)); }
            else { float* o = dout + (region == 1 ? OFF_DKS : OFF_DVS) + (size_t)rs * 512 + c; *(f32x4*)o = v0; *(f32x4*)(o + 4) = v1;
                   st_bf8((region == 1 ? KS : VS) + ((size_t)(rs >> 4) * KSROWS + 4096 + (rs & 15)) * 512 + c, v0, v1); }
        }
    }
    __device__ __forceinline__ void quad(int row, int col, f32x4 v, f32x4 p) {
        const bool samp = row >= NP; const int rs = row - NP;
        const int pos = samp ? 4096 + (rs & 15) : (row & 4095);
        const int region = col >> 9;
        if (need_rope(col)) v = rope_apply(v, p, col, pos, rope);
        st_bf4(PA + (size_t)row * NA + col, v);
        if (region == 1 || region == 2) {
            const int c = col & 511;
            if (!samp) __builtin_nontemporal_store(v, (f32x4*)(dout + (region == 1 ? OFF_DKP : OFF_DVP) + (size_t)row * 512 + c));
            else { *(f32x4*)(dout + (region == 1 ? OFF_DKS : OFF_DVS) + (size_t)rs * 512 + c) = v;
                   st_bf4((region == 1 ? KS : VS) + ((size_t)(rs >> 4) * KSROWS + 4096 + (rs & 15)) * 512 + c, v); }
        }
    }
};
struct EpiMemF {
    static constexpr bool ROPE = false, STATS = false; typedef NoPre Pre;
    bf16_t* MKV; float* dout; float s, q;
    __device__ __forceinline__ void row_begin(int, int) {}
    __device__ __forceinline__ Pre pre(int, int) const { return Pre{}; }
    __device__ __forceinline__ f32x4 fix(int, int, f32x4 v, const Pre&) const { return v; }
    __device__ __forceinline__ void commit(int, float, float) {}
    __device__ __forceinline__ void oct(int row, int col, f32x4 v0, f32x4 v1, f32x4, f32x4) {
        st_bf8(MKV + (size_t)row * 2048 + col, v0, v1);
        const int l = col >> 10, c = col & 1023;
        float* o = dout + (c < 512 ? OFF_MKP : OFF_MVP) + (size_t)l * 524288 + (size_t)row * 512 + (c & 511);
        __builtin_nontemporal_store(v0, (f32x4*)o); __builtin_nontemporal_store(v1, (f32x4*)(o + 4));
    }
    __device__ __forceinline__ void quad(int row, int col, f32x4 v, f32x4) {
        st_bf4(MKV + (size_t)row * 2048 + col, v);
        const int l = col >> 10, c = col & 1023;
        __builtin_nontemporal_store(v, (f32x4*)(dout + (c < 512 ? OFF_MKP : OFF_MVP) + (size_t)l * 524288 + (size_t)row * 512 + (c & 511)));
    }
};
struct EpiMerge0F {
    static constexpr bool ROPE = false, STATS = true; typedef u32x2 Pre;
    bf16_t* ZB; float* ST; float s, q;
    __device__ __forceinline__ void row_begin(int, int) {}
    __device__ __forceinline__ Pre pre(int row, int col) const { return *(const u32x2*)(ZB + (size_t)row * DM + col); }
    __device__ __forceinline__ f32x4 fix(int, int, f32x4 v, const Pre& x) const { return (f32x4){bflo(x.x), bfhi(x.x), bflo(x.y), bfhi(x.y)} * DN_ALPHA + v; }
    __device__ __forceinline__ void commit(int row, float ss, float qq) { atomicAdd(ST + 2 * (size_t)row, ss); atomicAdd(ST + 2 * (size_t)row + 1, qq); }
    __device__ __forceinline__ void oct(int row, int col, f32x4 z0, f32x4 z1, f32x4, f32x4) {
        st_bf8(ZB + (size_t)row * DM + col, z0, z1);
        s += ((z0.x + z0.y) + (z0.z + z0.w)) + ((z1.x + z1.y) + (z1.z + z1.w));
        q += ((z0.x * z0.x + z0.y * z0.y) + (z0.z * z0.z + z0.w * z0.w)) + ((z1.x * z1.x + z1.y * z1.y) + (z1.z * z1.z + z1.w * z1.w));
    }
    __device__ __forceinline__ void quad(int row, int col, f32x4 z, f32x4) {
        st_bf4(ZB + (size_t)row * DM + col, z);
        s += (z.x + z.y) + (z.z + z.w); q += (z.x * z.x + z.y * z.y) + (z.z * z.z + z.w * z.w);
    }
};
struct EpiMerge1F {
    static constexpr bool ROPE = false, STATS = true; typedef u32x2 Pre;
    const bf16_t* ZB; const float* ST0; const float* g0; const float* b0; bf16_t* out; float* ST1; float s, q, mu[2], rstd[2];
    __device__ __forceinline__ void row_begin(int sl, int row) { row_stats(ST0, row, mu[sl], rstd[sl]); }
    __device__ __forceinline__ Pre pre(int row, int col) const { return *(const u32x2*)(ZB + (size_t)row * DM + col); }
    __device__ __forceinline__ f32x4 fix(int sl, int col, f32x4 v, const Pre& z) const {
        const f32x4 z0 = (f32x4){bflo(z.x), bfhi(z.x), bflo(z.y), bfhi(z.y)};
        const f32x4 g = *(const f32x4*)(g0 + col), b = *(const f32x4*)(b0 + col); return ((z0 - mu[sl]) * rstd[sl] * g + b) * DN_ALPHA + v; }
    __device__ __forceinline__ void commit(int row, float ss, float qq) { atomicAdd(ST1 + 2 * (size_t)row, ss); atomicAdd(ST1 + 2 * (size_t)row + 1, qq); }
    __device__ __forceinline__ void oct(int row, int col, f32x4 z0, f32x4 z1, f32x4, f32x4) {
        st_bf8(out + (size_t)row * DM + col, z0, z1);
        s += ((z0.x + z0.y) + (z0.z + z0.w)) + ((z1.x + z1.y) + (z1.z + z1.w));
        q += ((z0.x * z0.x + z0.y * z0.y) + (z0.z * z0.z + z0.w * z0.w)) + ((z1.x * z1.x + z1.y * z1.y) + (z1.z * z1.z + z1.w * z1.w));
    }
    __device__ __forceinline__ void quad(int row, int col, f32x4 z, f32x4) {
        st_bf4(out + (size_t)row * DM + col, z);
        s += (z.x + z.y) + (z.z + z.w); q += (z.x * z.x + z.y * z.y) + (z.z * z.z + z.w * z.w);
    }
};
struct PreB { f32x4 c, b; };
struct EpiBF {
    static constexpr bool ROPE = true, STATS = false; typedef PreB Pre;
    bf16_t* PB; float* dout; bf16_t* KSW; bf16_t* VSW; const float* rope; const float* ST0; const float* CS; const float* BW; float s, q, mu[2], rstd[2];
    __device__ __forceinline__ void row_begin(int sl, int row) { row_stats(ST0, row, mu[sl], rstd[sl]); }
    __device__ __forceinline__ Pre pre(int, int col) const { Pre p; p.c = *(const f32x4*)(CS + col); p.b = *(const f32x4*)(BW + col); return p; }
    __device__ __forceinline__ f32x4 fix(int sl, int, f32x4 v, const Pre& p) const { return (v - p.c * mu[sl]) * rstd[sl] + p.b; }
    __device__ __forceinline__ bool need_rope(int col) const { return (col < 512 || (col >= 2048 && col < 2176)) && ((col >> 4) & 3) == 0; }
    __device__ __forceinline__ void commit(int, float, float) {}
    __device__ __forceinline__ void oct(int row, int col, f32x4 v0, f32x4 v1, f32x4 p0, f32x4 p1) {
        const bool samp = row >= NP; const int rs = row - NP;
        const int t = samp ? (rs & 15) : (row & 4095);
        const int pos = samp ? 4096 + t : t;
        const bool isk = col >= 2048 && col < 2176;
        if (need_rope(col)) { v0 = rope_apply(v0, p0, col, pos, rope); v1 = rope_apply(v1, p1, col + 4, pos, rope); }
        st_bf8(PB + (size_t)row * NB + col, v0, v1);
        if (col >= 2048) {
            const int cc = col & 127;
            if (!samp) { if (t >= 3968) { float* o = dout + (isk ? OFF_SKP : OFF_SVP) + ((size_t)(row >> 12) * 128 + (t - 3968)) * 128 + cc; *(f32x4*)o = v0; *(f32x4*)(o + 4) = v1; } }
            else { const int b = rs >> 4;
                   float* o = dout + (isk ? OFF_SKS : OFF_SVS) + ((size_t)b * 128 + 112 + t) * 128 + cc; *(f32x4*)o = v0; *(f32x4*)(o + 4) = v1;
                   st_bf8((isk ? KSW : VSW) + ((size_t)b * SWROWS + 128 + t) * 128 + cc, v0, v1); }
        }
    }
    __device__ __forceinline__ void quad(int row, int col, f32x4 v, f32x4 p) {
        const bool samp = row >= NP; const int rs = row - NP;
        const int t = samp ? (rs & 15) : (row & 4095);
        const int pos = samp ? 4096 + t : t;
        const bool isk = col >= 2048 && col < 2176;
        if (need_rope(col)) v = rope_apply(v, p, col, pos, rope);
        st_bf4(PB + (size_t)row * NB + col, v);
        if (col >= 2048) {
            const int cc = col & 127;
            if (!samp) { if (t >= 3968) *(f32x4*)(dout + (isk ? OFF_SKP : OFF_SVP) + ((size_t)(row >> 12) * 128 + (t - 3968)) * 128 + cc) = v; }
            else { const int b = rs >> 4;
                   *(f32x4*)(dout + (isk ? OFF_SKS : OFF_SVS) + ((size_t)b * 128 + 112 + t) * 128 + cc) = v;
                   st_bf4((isk ? KSW : VSW) + ((size_t)b * SWROWS + 128 + t) * 128 + cc, v); }
        }
    }
};
template <class F> __device__ __forceinline__ void gemm_small(LAS unsigned char* lds, const bf16_t* A, const bf16_t* Bt, int N, int rowbase, int ustart, int G, const F& f, int colbase = 0) {
    const int tid = threadIdx.x, lane = tid & 63, r32 = lane & 31, hi = lane >> 5, wid = __builtin_amdgcn_readfirstlane(tid >> 6);
    const int nu = 8 * (N / 32);
    for (int u = ustart; u < nu; u += G) {
        const int row0 = (u & 7) * 32, colw = (u >> 3) * 32, col0 = colbase + colw;
        const bf16_t* ap = A + (size_t)(row0 + r32) * DM + wid * 128 + hi * 8; const bf16_t* bp = Bt + (size_t)(colw + r32) * DM + wid * 128 + hi * 8;
        bf16x8 af[8], bfr[8];
#pragma unroll
        for (int k = 0; k < 8; ++k) { af[k] = *(const bf16x8*)(ap + 16 * k); bfr[k] = *(const bf16x8*)(bp + 16 * k); }
        f32x16 acc = f32x16{};
#pragma unroll
        for (int k = 0; k < 8; ++k) acc = __builtin_amdgcn_mfma_f32_32x32x16_bf16(bfr[k], af[k], acc, 0, 0, 0);
        LAS float* part = (LAS float*)lds + wid * 1024;
#pragma unroll
        for (int r = 0; r < 16; ++r) part[r * 64 + lane] = acc[r];
        __syncthreads();
        if (wid < 2) {
            F lf = f; f32x4 qd[2];
#pragma unroll
            for (int e = 0; e < 2; ++e) { float t[4];
#pragma unroll
                for (int c = 0; c < 4; ++c) { const int r = 4 * (2 * wid + e) + c; float a = 0.f;
#pragma unroll
                    for (int w = 0; w < 8; ++w) a += ((LAS float*)lds)[w * 1024 + r * 64 + lane];
                    t[c] = a; }
                qd[e] = (f32x4){t[0], t[1], t[2], t[3]}; }
            const int row = rowbase + row0 + r32; typename F::Pre pr[2];
            lf.row_begin(0, row);
#pragma unroll
            for (int e = 0; e < 2; ++e) pr[e] = lf.pre(row, col0 + 8 * (2 * wid + e) + 4 * hi);
#pragma unroll
            for (int e = 0; e < 2; ++e) qd[e] = lf.fix(0, col0 + 8 * (2 * wid + e) + 4 * hi, qd[e], pr[e]);
            lf.s = 0.f; lf.q = 0.f;
#pragma unroll
            for (int e = 0; e < 2; ++e) lf.quad(row, col0 + 8 * (2 * wid + e) + 4 * hi, qd[e], qd[e ^ 1]);
            if constexpr (F::STATS) { float s = lf.s, q = lf.q; s += __shfl_xor(s, 32); q += __shfl_xor(q, 32); if (hi == 0) lf.commit(row, s, q); }
        }
        __syncthreads();
    }
}

namespace att {
#define KSWZ(row, colB) ((row) * 256 + ((colB) ^ (((row) & 7) << 4)))
#define SBAR() __builtin_amdgcn_sched_barrier(0)
__device__ __forceinline__ int v_st(int k, int c) { const int kk = (k & ~0xC) | ((k & 4) << 1) | ((k & 8) >> 1); return ((kk >> 3) * 4 + (c >> 5)) * 512 + ((kk & 7) * 32 + (c & 31)) * 2; }
__device__ __forceinline__ int v_rd_base(int lane) { return ((lane & 3) << 3) | (((lane >> 2) & 3) << 6) | (((lane >> 4) & 1) << 5) | (((lane >> 5) & 1) << 8); }
constexpr int v_rd_off(int d0, int ks, int half) { return d0 * 512 + ks * 4096 + half * 2048; }
template <int OFF> __device__ __forceinline__ s16x4 tr_read(int vb) {
    s16x4 r; asm volatile("ds_read_b64_tr_b16 %0, %1 offset:%2" : "=&v"(r) : "v"(vb), "i"(OFF) : "memory"); return r;
}
template <int OFF> __device__ __forceinline__ bf16x8 lds_read128(int ad) {
    bf16x8 r; asm volatile("ds_read_b128 %0, %1 offset:%2" : "=&v"(r) : "v"(ad), "i"(OFF) : "memory"); return r;
}
template <int D0> __device__ __forceinline__ void pv_one(f32x16& od, int vb, bf16x8 pa0, bf16x8 pa1, bf16x8 pa2, bf16x8 pa3) {
    const s16x4 l0 = tr_read<v_rd_off(D0, 0, 0)>(vb), h0 = tr_read<v_rd_off(D0, 0, 1)>(vb), l1 = tr_read<v_rd_off(D0, 1, 0)>(vb), h1 = tr_read<v_rd_off(D0, 1, 1)>(vb);
    const s16x4 l2 = tr_read<v_rd_off(D0, 2, 0)>(vb), h2 = tr_read<v_rd_off(D0, 2, 1)>(vb), l3 = tr_read<v_rd_off(D0, 3, 0)>(vb), h3 = tr_read<v_rd_off(D0, 3, 1)>(vb);
    asm volatile("s_waitcnt lgkmcnt(0)" ::: "memory"); SBAR();
#define PK(L, H) (bf16x8){L[0], L[1], L[2], L[3], H[0], H[1], H[2], H[3]}
    od = __builtin_amdgcn_mfma_f32_32x32x16_bf16(PK(l0, h0), pa0, od, 0, 0, 0);
    od = __builtin_amdgcn_mfma_f32_32x32x16_bf16(PK(l1, h1), pa1, od, 0, 0, 0);
    od = __builtin_amdgcn_mfma_f32_32x32x16_bf16(PK(l2, h2), pa2, od, 0, 0, 0);
    od = __builtin_amdgcn_mfma_f32_32x32x16_bf16(PK(l3, h3), pa3, od, 0, 0, 0);
#undef PK
}
template <int KSI, int DB, int ND> __device__ __forceinline__ void v_read(int vb, s16x4 (&l)[4], s16x4 (&h)[4]) {
    l[0] = tr_read<v_rd_off(DB, KSI, 0)>(vb); h[0] = tr_read<v_rd_off(DB, KSI, 1)>(vb);
    l[1] = tr_read<v_rd_off(DB + 1, KSI, 0)>(vb); h[1] = tr_read<v_rd_off(DB + 1, KSI, 1)>(vb);
    if constexpr (ND == 4) { l[2] = tr_read<v_rd_off(DB + 2, KSI, 0)>(vb); h[2] = tr_read<v_rd_off(DB + 2, KSI, 1)>(vb);
                             l[3] = tr_read<v_rd_off(DB + 3, KSI, 0)>(vb); h[3] = tr_read<v_rd_off(DB + 3, KSI, 1)>(vb); }
}
template <int ND> __device__ __forceinline__ void pv_mf(f32x16 (&o)[4], bf16x8 pa, const s16x4 (&l)[4], const s16x4 (&h)[4]) {
    __builtin_amdgcn_s_setprio(1);
#pragma unroll
    for (int d = 0; d < ND; ++d) o[d] = __builtin_amdgcn_mfma_f32_32x32x16_bf16((bf16x8){l[d][0], l[d][1], l[d][2], l[d][3], h[d][0], h[d][1], h[d][2], h[d][3]}, pa, o[d], 0, 0, 0);
    __builtin_amdgcn_s_setprio(0);
}
template <int DB, int ND> __device__ __forceinline__ void pv_ks(f32x16 (&o)[4], int vb, bf16x8 pa0, bf16x8 pa1, bf16x8 pa2, bf16x8 pa3) {
    s16x4 la[4], ha[4];
    v_read<0, DB, ND>(vb, la, ha); asm volatile("s_waitcnt lgkmcnt(0)" ::: "memory"); SBAR(); pv_mf<ND>(o, pa0, la, ha); SBAR();
    v_read<1, DB, ND>(vb, la, ha); asm volatile("s_waitcnt lgkmcnt(0)" ::: "memory"); SBAR(); pv_mf<ND>(o, pa1, la, ha); SBAR();
    v_read<2, DB, ND>(vb, la, ha); asm volatile("s_waitcnt lgkmcnt(0)" ::: "memory"); SBAR(); pv_mf<ND>(o, pa2, la, ha); SBAR();
    v_read<3, DB, ND>(vb, la, ha); asm volatile("s_waitcnt lgkmcnt(0)" ::: "memory"); SBAR(); pv_mf<ND>(o, pa3, la, ha);
}
template <int DB, int ND> __device__ __forceinline__ void pv_rest(f32x16 (&o)[4], int vb, bf16x8 pa0, bf16x8 pa1, bf16x8 pa2, bf16x8 pa3, s16x4 (&la)[4], s16x4 (&ha)[4]) {
    s16x4 lb[4], hb[4];
    asm volatile("s_waitcnt lgkmcnt(0)" ::: "memory"); SBAR(); v_read<1, DB, ND>(vb, lb, hb); SBAR(); pv_mf<ND>(o, pa0, la, ha); SBAR();
    asm volatile("s_waitcnt lgkmcnt(0)" ::: "memory"); SBAR(); v_read<2, DB, ND>(vb, la, ha); SBAR(); pv_mf<ND>(o, pa1, lb, hb); SBAR();
    asm volatile("s_waitcnt lgkmcnt(0)" ::: "memory"); SBAR(); v_read<3, DB, ND>(vb, lb, hb); SBAR(); pv_mf<ND>(o, pa2, la, ha); SBAR();
    asm volatile("s_waitcnt lgkmcnt(0)" ::: "memory"); SBAR(); pv_mf<ND>(o, pa3, lb, hb);
}
__device__ __forceinline__ void partialSM(f32x16& p0, f32x16& p1, float& m_reg, float& alpha, float C, float thr) {
    float pmax = p0[0];
#pragma unroll
    for (int r = 1; r < 16; ++r) pmax = fmaxf(pmax, p0[r]);
#pragma unroll
    for (int r = 0; r < 16; ++r) pmax = fmaxf(pmax, p1[r]);
    { auto rr = __builtin_amdgcn_permlane32_swap(__float_as_uint(pmax), __float_as_uint(pmax), false, false);
      pmax = fmaxf(__uint_as_float(rr[0]), __uint_as_float(rr[1])); }
    float mn;
    if (__all(pmax - m_reg <= thr)) { mn = m_reg; alpha = 1.f; }
    else { mn = fmaxf(m_reg, pmax); alpha = __builtin_amdgcn_exp2f((m_reg - mn) * C); m_reg = mn; }
    const float mnC = -mn * C;
#pragma unroll
    for (int r = 0; r < 16; ++r) p0[r] = __builtin_amdgcn_exp2f(fmaf(p0[r], C, mnC));
#pragma unroll
    for (int r = 0; r < 16; ++r) p1[r] = __builtin_amdgcn_exp2f(fmaf(p1[r], C, mnC));
}
__device__ __forceinline__ void finishSM(f32x16& p0, f32x16& p1, float alpha, float& l_reg, bf16x8& pa0, bf16x8& pa1, bf16x8& pa2, bf16x8& pa3) {
    float ps = 0;
#pragma unroll
    for (int r = 0; r < 16; ++r) ps += p0[r];
#pragma unroll
    for (int r = 0; r < 16; ++r) ps += p1[r];
    { auto rr = __builtin_amdgcn_permlane32_swap(__float_as_uint(ps), __float_as_uint(ps), false, false);
      ps = __uint_as_float(rr[0]) + __uint_as_float(rr[1]); }
    l_reg = l_reg * alpha + ps;
#define PK4(P, BASE, OUT) do { unsigned a0 = cvtpk(P[BASE + 0], P[BASE + 1]), a1 = cvtpk(P[BASE + 2], P[BASE + 3]);   \
    unsigned b0 = cvtpk(P[BASE + 4], P[BASE + 5]), b1 = cvtpk(P[BASE + 6], P[BASE + 7]);                              \
    auto r0 = __builtin_amdgcn_permlane32_swap(a0, b0, false, false); auto r1 = __builtin_amdgcn_permlane32_swap(a1, b1, false, false); \
    u32x4 w = {r0[0], r1[0], r0[1], r1[1]}; OUT = *reinterpret_cast<bf16x8*>(&w); } while (0)
    PK4(p0, 0, pa0); PK4(p0, 8, pa1); PK4(p1, 0, pa2); PK4(p1, 8, pa3);
#undef PK4
}
constexpr int RING = 32768;
template <int QS, bool PVHALF>
__device__ __forceinline__ void attn_core(LAS unsigned char* lds, const bf16_t* Kb, long ldk, const bf16_t* Vb, long ldv, int NT, int nkeys,
                                          const bf16_t* qptr, int wNT, int kcoffB, int pvsel, float C, float thr, f32x16 (&o)[4], float& m_reg, float& l_reg) {
    int tid = threadIdx.x; asm volatile("" : "+v"(tid));
    const int lane = tid & 63, r32 = lane & 31, hi = lane >> 5, wid = __builtin_amdgcn_readfirstlane(tid >> 6);
    bf16x8 qr[QS];
#pragma unroll
    for (int d0 = 0; d0 < QS; ++d0) qr[d0] = *(const bf16x8*)(qptr + d0 * 16);
#pragma unroll
    for (int d = 0; d < 4; ++d) o[d] = f32x16{};
    m_reg = -1e30f; l_reg = 0.f;
    long offK[2], offV[2];
#pragma unroll
    for (int i = 0; i < 2; ++i) { const int p = i * 8192 + wid * 1024 + lane * 16;
        const int row = p >> 8, colB = (p & 255) ^ ((row & 7) << 4); offK[i] = (long)row * ldk + (colB >> 1);
        const int sub = p >> 9, q = (p & 511) >> 1, kk = (sub >> 2) * 8 + (q >> 5), k = (kk & ~0xC) | ((kk & 4) << 1) | ((kk & 8) >> 1), c = (sub & 3) * 32 + (q & 31);
        offV[i] = (long)k * ldv + c; }
    const int vrb = v_rd_base(lane);
#define GLDS(t, bf) do { const bf16_t* kt_ = Kb + (long)(t) * 64 * ldk; const bf16_t* vt_ = Vb + (long)(t) * 64 * ldv; LAS unsigned char* b_ = lds + (bf) * RING + wid * 1024; \
    __builtin_amdgcn_global_load_lds((const unsigned*)(vt_ + offV[0]), (LAS unsigned*)(b_), 16, 0, 0); \
    __builtin_amdgcn_global_load_lds((const unsigned*)(vt_ + offV[1]), (LAS unsigned*)(b_ + 8192), 16, 0, 0); \
    __builtin_amdgcn_global_load_lds((const unsigned*)(kt_ + offK[0]), (LAS unsigned*)(b_ + 16384), 16, 0, 0); \
    __builtin_amdgcn_global_load_lds((const unsigned*)(kt_ + offK[1]), (LAS unsigned*)(b_ + 16384 + 8192), 16, 0, 0); } while (0)
    GLDS(0, 0);
#pragma unroll
    for (int d0 = 0; d0 < QS; ++d0) asm volatile("" :: "v"(qr[d0]));
    if (1 < NT) GLDS(1, 1); if (2 < NT) GLDS(2, 2);
    for (int j = 0; j < NT; ++j) {
        const int rem = NT - 1 - j;
        if (rem >= 2) asm volatile("s_waitcnt vmcnt(8)" ::: "memory"); else if (rem == 1) asm volatile("s_waitcnt vmcnt(4)" ::: "memory"); else asm volatile("s_waitcnt vmcnt(0)" ::: "memory");
        __builtin_amdgcn_s_barrier();
        asm volatile("" ::: "memory");
        if (j + 3 < NT) GLDS(j + 3, (j + 3) & 3);
        if (j < wNT) {
            const int cur = j & 3;
            f32x16 p0 = f32x16{}, p1 = f32x16{};
            const int kbase = (int)(uintptr_t)(lds + cur * RING + 16384) + r32 * 256;
            const int swz = (r32 & 7) << 4;
#pragma unroll
            for (int hq = 0; hq < QS / 4; ++hq) { bf16x8 b0[4], b1[4];
#pragma unroll
                for (int i = 0; i < 4; ++i) { const int cb = kcoffB + ((hq * 4 + i) * 16 + hi * 8) * 2; const int ad = kbase + (cb ^ swz);
                    b0[i] = lds_read128<0>(ad); b1[i] = lds_read128<8192>(ad); }
                asm volatile("s_waitcnt lgkmcnt(0)" ::: "memory"); SBAR();
#pragma unroll
                for (int i = 0; i < 4; ++i) { p0 = __builtin_amdgcn_mfma_f32_32x32x16_bf16(b0[i], qr[hq * 4 + i], p0, 0, 0, 0);
                    p1 = __builtin_amdgcn_mfma_f32_32x32x16_bf16(b1[i], qr[hq * 4 + i], p1, 0, 0, 0); } }
            if (__builtin_expect((j + 1) * 64 > nkeys, 0)) { const int kb = j * 64 + 4 * hi; asm volatile("" ::: "memory");
#pragma unroll
                for (int r = 0; r < 16; ++r) { const int kv = kb + (r & 3) + 8 * (r >> 2); if (kv >= nkeys) p0[r] = -1e30f; if (kv + 32 >= nkeys) p1[r] = -1e30f; } }
            float alpha; bf16x8 pa0, pa1, pa2, pa3;
            const int vb = (int)(uintptr_t)(lds + cur * RING) + vrb;
            s16x4 la[4], ha[4];
            partialSM(p0, p1, m_reg, alpha, C, thr);
            finishSM(p0, p1, alpha, l_reg, pa0, pa1, pa2, pa3);
            SBAR();
            if constexpr (QS == 4) { if constexpr (!PVHALF) v_read<0, 0, 4>(vb, la, ha); else { if (pvsel == 0) v_read<0, 0, 2>(vb, la, ha); else v_read<0, 2, 2>(vb, la, ha); } }
            SBAR();
            if (__any(alpha < 1.f)) {
#pragma unroll
                for (int d = 0; d < (PVHALF ? 2 : 4); ++d)
#pragma unroll
                    for (int r = 0; r < 16; ++r) o[d][r] *= alpha; }
            if constexpr (QS == 8) { pv_one<0>(o[0], vb, pa0, pa1, pa2, pa3); pv_one<1>(o[1], vb, pa0, pa1, pa2, pa3); pv_one<2>(o[2], vb, pa0, pa1, pa2, pa3); pv_one<3>(o[3], vb, pa0, pa1, pa2, pa3); }
            else if constexpr (!PVHALF) pv_rest<0, 4>(o, vb, pa0, pa1, pa2, pa3, la, ha);
            else { if (pvsel == 0) pv_rest<0, 2>(o, vb, pa0, pa1, pa2, pa3, la, ha); else pv_rest<2, 2>(o, vb, pa0, pa1, pa2, pa3, la, ha); }
        }
    }
#undef GLDS
    __syncthreads();
}

template <bool PVHALF>
__device__ __forceinline__ void attn_core_pipe(LAS unsigned char* lds, const bf16_t* Kb, long ldk, const bf16_t* Vb, long ldv, int NT, int nkeys,
                                               const bf16_t* qptr, int wNT, int kcoffB, int pvsel, float C, float thr, f32x16 (&o)[4], float& m_reg, float& l_reg) {
    int tid = threadIdx.x; asm volatile("" : "+v"(tid));
    const int lane = tid & 63, r32 = lane & 31, hi = lane >> 5, wid = __builtin_amdgcn_readfirstlane(tid >> 6);
    bf16x8 qr[4];
#pragma unroll
    for (int d0 = 0; d0 < 4; ++d0) qr[d0] = *(const bf16x8*)(qptr + d0 * 16);
#pragma unroll
    for (int d = 0; d < 4; ++d) o[d] = f32x16{};
    m_reg = -1e30f; l_reg = 0.f;
    int offK[2], offV[2];
#pragma unroll
    for (int i = 0; i < 2; ++i) { const int p = i * 8192 + wid * 1024 + lane * 16;
        const int row = p >> 8, colB = (p & 255) ^ ((row & 7) << 4); offK[i] = row * (int)ldk + (colB >> 1);
        const int sub = p >> 9, q = (p & 511) >> 1, kk = (sub >> 2) * 8 + (q >> 5), k = (kk & ~0xC) | ((kk & 4) << 1) | ((kk & 8) >> 1), c = (sub & 3) * 32 + (q & 31);
        offV[i] = k * (int)ldv + c; }
    const int vrb = v_rd_base(lane);
    int kad[4];
#pragma unroll
    for (int i = 0; i < 4; ++i) kad[i] = 16384 + r32 * 256 + ((kcoffB + (i * 16 + hi * 8) * 2) ^ ((r32 & 7) << 4));
    const int lds0 = (int)(uintptr_t)lds;
#define GLDS_V(t, bf) do { const bf16_t* vt_ = Vb + (long)(t) * 64 * ldv; LAS unsigned char* b_ = lds + (bf) * RING + wid * 1024; \
    __builtin_amdgcn_global_load_lds((const unsigned*)(vt_ + offV[0]), (LAS unsigned*)(b_), 16, 0, 0); \
    __builtin_amdgcn_global_load_lds((const unsigned*)(vt_ + offV[1]), (LAS unsigned*)(b_ + 8192), 16, 0, 0); } while (0)
#define GLDS_K(t, bf) do { const bf16_t* kt_ = Kb + (long)(t) * 64 * ldk; LAS unsigned char* b_ = lds + (bf) * RING + wid * 1024; \
    __builtin_amdgcn_global_load_lds((const unsigned*)(kt_ + offK[0]), (LAS unsigned*)(b_ + 16384), 16, 0, 0); \
    __builtin_amdgcn_global_load_lds((const unsigned*)(kt_ + offK[1]), (LAS unsigned*)(b_ + 16384 + 8192), 16, 0, 0); } while (0)
#define GLDS(t, bf) do { GLDS_V(t, bf); GLDS_K(t, bf); } while (0)
#define QK(P0, P1, bf) do { const int kb_ = lds0 + (bf) * RING; bf16x8 b0_[2], b1_[2]; \
    _Pragma("unroll") for (int i_ = 0; i_ < 2; ++i_) { b0_[i_] = lds_read128<0>(kb_ + kad[i_]); b1_[i_] = lds_read128<8192>(kb_ + kad[i_]); } \
    asm volatile("s_waitcnt lgkmcnt(0)" ::: "memory"); SBAR(); \
    P0 = __builtin_amdgcn_mfma_f32_32x32x16_bf16(b0_[0], qr[0], f32x16{}, 0, 0, 0); P1 = __builtin_amdgcn_mfma_f32_32x32x16_bf16(b1_[0], qr[0], f32x16{}, 0, 0, 0); \
    P0 = __builtin_amdgcn_mfma_f32_32x32x16_bf16(b0_[1], qr[1], P0, 0, 0, 0); P1 = __builtin_amdgcn_mfma_f32_32x32x16_bf16(b1_[1], qr[1], P1, 0, 0, 0); SBAR(); \
    _Pragma("unroll") for (int i_ = 0; i_ < 2; ++i_) { b0_[i_] = lds_read128<0>(kb_ + kad[2 + i_]); b1_[i_] = lds_read128<8192>(kb_ + kad[2 + i_]); } \
    asm volatile("s_waitcnt lgkmcnt(0)" ::: "memory"); SBAR(); \
    P0 = __builtin_amdgcn_mfma_f32_32x32x16_bf16(b0_[0], qr[2], P0, 0, 0, 0); P1 = __builtin_amdgcn_mfma_f32_32x32x16_bf16(b1_[0], qr[2], P1, 0, 0, 0); \
    P0 = __builtin_amdgcn_mfma_f32_32x32x16_bf16(b0_[1], qr[3], P0, 0, 0, 0); P1 = __builtin_amdgcn_mfma_f32_32x32x16_bf16(b1_[1], qr[3], P1, 0, 0, 0); \
    SBAR(); } while (0)
#define STEP(C0, C1, N0, N1, j) do { \
    if ((j) + 1 < NT) { \
        if ((j) + 2 < NT) asm volatile("s_waitcnt vmcnt(4)" ::: "memory"); else asm volatile("s_waitcnt vmcnt(0)" ::: "memory"); \
        __builtin_amdgcn_s_barrier(); asm volatile("" ::: "memory"); \
        if ((j) + 1 < wNT) QK(N0, N1, ((j) + 1) & 3); } \
    const bool iss_ = (j) + 3 < NT;                                 \
    if ((j) < wNT) { \
        if (__builtin_expect(((j) + 1) * 64 > nkeys, 0)) { const int kb = (j) * 64 + 4 * hi; asm volatile("" ::: "memory"); \
            _Pragma("unroll") for (int r = 0; r < 16; ++r) { const int kv = kb + (r & 3) + 8 * (r >> 2); if (kv >= nkeys) C0[r] = -1e30f; if (kv + 32 >= nkeys) C1[r] = -1e30f; } } \
        float alpha; bf16x8 pa0, pa1, pa2, pa3; const int vb = lds0 + ((j) & 3) * RING + vrb; \
        partialSM(C0, C1, m_reg, alpha, C, thr); \
        SBAR(); if (iss_) GLDS_V((j) + 3, ((j) + 3) & 3); SBAR(); \
        finishSM(C0, C1, alpha, l_reg, pa0, pa1, pa2, pa3); \
        SBAR(); if (iss_) GLDS_K((j) + 3, ((j) + 3) & 3); SBAR(); \
        if (__any(alpha < 1.f)) { \
            _Pragma("unroll") for (int d = 0; d < (PVHALF ? 2 : 4); ++d) _Pragma("unroll") for (int r = 0; r < 16; ++r) o[d][r] *= alpha; } \
        if constexpr (!PVHALF) pv_ks<0, 4>(o, vb, pa0, pa1, pa2, pa3); \
        else { if (pvsel == 0) pv_ks<0, 2>(o, vb, pa0, pa1, pa2, pa3); else pv_ks<2, 2>(o, vb, pa0, pa1, pa2, pa3); } } \
    else if (iss_) GLDS((j) + 3, ((j) + 3) & 3); \
    } while (0)
    GLDS(0, 0);
#pragma unroll
    for (int d0 = 0; d0 < 4; ++d0) asm volatile("" :: "v"(qr[d0]));
    if (1 < NT) GLDS(1, 1); if (2 < NT) GLDS(2, 2);
    if (NT > 2) asm volatile("s_waitcnt vmcnt(8)" ::: "memory"); else if (NT == 2) asm volatile("s_waitcnt vmcnt(4)" ::: "memory"); else asm volatile("s_waitcnt vmcnt(0)" ::: "memory");
    __builtin_amdgcn_s_barrier(); asm volatile("" ::: "memory");
    f32x16 pA0 = f32x16{}, pA1 = f32x16{}, pB0 = f32x16{}, pB1 = f32x16{};
    if (0 < wNT) QK(pA0, pA1, 0);
    for (int j = 0; j < NT; j += 2) {
        STEP(pA0, pA1, pB0, pB1, j);
        if (j + 1 < NT) STEP(pB0, pB1, pA0, pA1, j + 1);
    }
#undef STEP
#undef QK
#undef GLDS
#undef GLDS_V
#undef GLDS_K
    __syncthreads();
}

struct Ctx { LAS unsigned char* lds; int lane, wid, r32, hi; };

template <int ND> __device__ __forceinline__ void stage_piece(LAS unsigned char* stg, int lane, int d, int g, f32x4 v) {
    u32x2 w; w.x = cvtpk(v.x, v.y); w.y = cvtpk(v.z, v.w);
    *(LAS u32x2*)(stg + (lane & 31) * (64 * ND + 16) + (32 * d + 8 * g + 4 * (lane >> 5)) * 2) = w;
}
template <int ND> __device__ __forceinline__ void flush_rows(LAS unsigned char* stg, int lane, bf16_t* out_tile, int nvalid) {
    asm volatile("s_waitcnt lgkmcnt(0)" ::: "memory");
#pragma unroll
    for (int i = 0; i < 2 * ND; ++i) { const int c = i * 64 + lane, row = c / (4 * ND), ch = c % (4 * ND);
        const u32x4 w = *(const LAS u32x4*)(stg + row * (64 * ND + 16) + ch * 16);
        if (row < nvalid) *(u32x4*)(out_tile + (size_t)row * DM + ch * 8) = w; }
}
template <int ND> __device__ __forceinline__ void store_gated(const f32x16 (&o)[4], float scale, const bf16_t* gate, bf16_t* out_tile, int nvalid, LAS unsigned char* stg, int lane) {
    asm volatile("" : "+v"(lane));
    const int hi = lane >> 5;
#pragma unroll
    for (int d = 0; d < ND; ++d)
#pragma unroll
        for (int g = 0; g < 4; ++g) { const int dv = 32 * d + 8 * g + 4 * hi;
            const u32x2 gt = *(const u32x2*)(gate + dv);
            f32x4 v; v.x = o[d][4 * g] * scale * silu(bflo(gt.x)); v.y = o[d][4 * g + 1] * scale * silu(bfhi(gt.x));
            v.z = o[d][4 * g + 2] * scale * silu(bflo(gt.y)); v.w = o[d][4 * g + 3] * scale * silu(bfhi(gt.y));
            stage_piece<ND>(stg, lane, d, g, v); asm volatile("" ::: "memory"); }
    flush_rows<ND>(stg, lane, out_tile, nvalid);
}

__device__ __forceinline__ void diff_unit(const Ctx& cx, bool samp, int b, int h, int qb, const bf16_t* PA, const bf16_t* KS, const bf16_t* VS, bf16_t* MIX, const float* gnorm, float lam) {
    const int c = cx.wid >> 2, rb = cx.wid & 3;
    long row; bool valid; int NT, wNT, nkeys; const bf16_t* Kb; const bf16_t* Vb; long ldk;
    if (!samp) { row = (long)b * 4096 + qb * 128 + rb * 32 + cx.r32; valid = true; NT = 2 * qb + 2; wNT = 2 * qb + 1 + (rb >> 1); nkeys = NT * 64;
                 Kb = PA + (size_t)b * 4096 * NA + 512 + h * 128; Vb = Kb + 512; ldk = NA; }
    else { row = NP + b * 16 + (cx.r32 < 15 ? cx.r32 : 15); valid = (rb == 0) && cx.r32 < 16; NT = 65; wNT = (rb == 0) ? 65 : 0; nkeys = 4112;
           Kb = KS + (size_t)b * KSROWS * 512 + h * 128; Vb = VS + (size_t)b * KSROWS * 512 + h * 128; ldk = 512; }
    const bf16_t* qptr = PA + (size_t)row * NA + h * 128 + c * 64 + cx.hi * 8;
    f32x16 o[4]; float m, l;
    attn_core_pipe<false>(cx.lds, Kb, ldk, Vb, ldk, NT, nkeys, qptr, wNT, c * 128, 0, C64, THR64, o, m, l);
    const float inv = l > 0.f ? 1.f / l : 0.f;
    LAS float* xch = (LAS float*)cx.lds + rb * 4096;
    if (c == 1) {
#pragma unroll
        for (int d = 0; d < 4; ++d)
#pragma unroll
            for (int r = 0; r < 16; ++r) xch[(d * 16 + r) * 64 + cx.lane] = o[d][r] * inv; }
    __syncthreads();
    if (c == 0) {
        float ss = 0.f;
#pragma unroll
        for (int d = 0; d < 4; ++d)
#pragma unroll
            for (int r = 0; r < 16; ++r) { const float od = o[d][r] * inv - lam * xch[(d * 16 + r) * 64 + cx.lane]; o[d][r] = od; ss += od * od; }
        ss += __shfl_xor(ss, 32);
        const float rms = rsqrtf(ss * (1.f / 128.f) + 1e-5f) * 0.8f;
        {
            const bf16_t* gate = PA + (size_t)row * NA + 1536 + h * 128; LAS unsigned char* stg = cx.lds + 65536 + cx.wid * 9216;
            int ln = cx.lane; asm volatile("" : "+v"(ln));
#pragma unroll
            for (int d = 0; d < 4; ++d)
#pragma unroll
                for (int g = 0; g < 4; ++g) { const int dv = 32 * d + 8 * g + 4 * cx.hi;
                    const f32x4 gn = *(const f32x4*)(gnorm + dv); const u32x2 gt = *(const u32x2*)(gate + dv);
                    f32x4 v; v.x = o[d][4 * g] * rms * gn.x * silu(bflo(gt.x)); v.y = o[d][4 * g + 1] * rms * gn.y * silu(bfhi(gt.x));
                    v.z = o[d][4 * g + 2] * rms * gn.z * silu(bflo(gt.y)); v.w = o[d][4 * g + 3] * rms * gn.w * silu(bfhi(gt.y));
                    stage_piece<4>(stg, ln, d, g, v); asm volatile("" ::: "memory"); }
            flush_rows<4>(stg, ln, MIX + (size_t)(row - cx.r32) * DM + h * 128, valid ? 32 : 0);
        }
    }
    __syncthreads();
}
__device__ __forceinline__ void diff_sample_item(const Ctx& cx, int b, int h, int sp, const float* CK, const float* CV, const bf16_t* PA, const bf16_t* KS, const bf16_t* VS,
                                                 bf16_t* MIX, const float* gnorm, float lam, float* PART, unsigned* cnt, volatile LAS unsigned* MISC) {
    int tid = threadIdx.x; asm volatile("" : "+v"(tid));
    const int lane = tid & 63, r32 = lane & 31, hi = lane >> 5, wid = __builtin_amdgcn_readfirstlane(tid >> 6);
    const int c = wid >> 2; const bool active = (wid & 3) == 0;
    const size_t row = NP + b * 16 + (r32 < 15 ? r32 : 15);
    bf16x8 qr[4];
    { const bf16_t* qptr = PA + row * NA + h * 128 + c * 64 + hi * 8;
#pragma unroll
      for (int d0 = 0; d0 < 4; ++d0) qr[d0] = *(const bf16x8*)(qptr + d0 * 16); }
    f32x16 o[4];
#pragma unroll
    for (int d = 0; d < 4; ++d) o[d] = f32x16{};
    float m_reg = -1e30f, l_reg = 0.f;
    const int ntl = 16 + (sp == 3 ? 1 : 0);
    const int sr = tid >> 4, sc = (tid & 15) * 8;
    const float* kg = CK + ((size_t)(b * 4096 + sp * 1024 + sr) * 4 + h) * 128 + sc;
    const float* vg = CV + ((size_t)(b * 4096 + sp * 1024 + sr) * 4 + h) * 128 + sc;
    const bf16_t* kn = KS + ((size_t)b * KSROWS + 4096 + sr) * 512 + h * 128 + sc;
    const bf16_t* vn = VS + ((size_t)b * KSROWS + 4096 + sr) * 512 + h * 128 + sc;
    const int vst0 = v_st(sr, sc), vst1 = v_st(32 + sr, sc), kst0 = 16384 + KSWZ(sr, sc * 2), kst1 = 16384 + KSWZ(32 + sr, sc * 2);
    int kad[4];
#pragma unroll
    for (int i = 0; i < 4; ++i) kad[i] = 16384 + r32 * 256 + ((c * 128 + (i * 16 + hi * 8) * 2) ^ ((r32 & 7) << 4));
    const int lds0 = (int)(uintptr_t)cx.lds, vrb = v_rd_base(lane);
    f32x4 kfA[4], vfA[4], kfB[4], vfB[4];
#define LOADT(t, kf, vf) do { if ((t) < 16) { const float* kp_ = kg + (size_t)(t) * 64 * 512; const float* vp_ = vg + (size_t)(t) * 64 * 512; \
        kf[0] = __builtin_nontemporal_load((const f32x4*)kp_); kf[1] = __builtin_nontemporal_load((const f32x4*)(kp_ + 4)); kf[2] = __builtin_nontemporal_load((const f32x4*)(kp_ + 32 * 512)); kf[3] = __builtin_nontemporal_load((const f32x4*)(kp_ + 32 * 512 + 4)); \
        vf[0] = __builtin_nontemporal_load((const f32x4*)vp_); vf[1] = __builtin_nontemporal_load((const f32x4*)(vp_ + 4)); vf[2] = __builtin_nontemporal_load((const f32x4*)(vp_ + 32 * 512)); vf[3] = __builtin_nontemporal_load((const f32x4*)(vp_ + 32 * 512 + 4)); } \
    else { kf[0] = *(const f32x4*)kn; kf[2] = *(const f32x4*)(kn + 32 * 512); vf[0] = *(const f32x4*)vn; vf[2] = *(const f32x4*)(vn + 32 * 512); } } while (0)
#define CV8(A, B) ((u32x4){cvtpk(A.x, A.y), cvtpk(A.z, A.w), cvtpk(B.x, B.y), cvtpk(B.z, B.w)})
#define WRITET(t, bf, kf, vf) do { u32x4 k0_, k1_, v0_, v1_; \
    if ((t) < 16) { k0_ = CV8(kf[0], kf[1]); k1_ = CV8(kf[2], kf[3]); v0_ = CV8(vf[0], vf[1]); v1_ = CV8(vf[2], vf[3]); } \
    else { k0_ = __builtin_bit_cast(u32x4, kf[0]); k1_ = __builtin_bit_cast(u32x4, kf[2]); v0_ = __builtin_bit_cast(u32x4, vf[0]); v1_ = __builtin_bit_cast(u32x4, vf[2]); } \
    LAS unsigned char* b_ = cx.lds + (bf) * RING; \
    *(LAS u32x4*)(b_ + vst0) = v0_; *(LAS u32x4*)(b_ + vst1) = v1_; *(LAS u32x4*)(b_ + kst0) = k0_; *(LAS u32x4*)(b_ + kst1) = k1_; } while (0)
#define SCORE(t, cur) do { if (active) { \
            f32x16 p0, p1; \
            { const int kb_ = lds0 + (cur) * RING; bf16x8 b0_[2], b1_[2]; \
              _Pragma("unroll") for (int i = 0; i < 2; ++i) { b0_[i] = lds_read128<0>(kb_ + kad[i]); b1_[i] = lds_read128<8192>(kb_ + kad[i]); } \
              asm volatile("s_waitcnt lgkmcnt(0)" ::: "memory"); SBAR(); \
              p0 = __builtin_amdgcn_mfma_f32_32x32x16_bf16(b0_[0], qr[0], f32x16{}, 0, 0, 0); p1 = __builtin_amdgcn_mfma_f32_32x32x16_bf16(b1_[0], qr[0], f32x16{}, 0, 0, 0); \
              p0 = __builtin_amdgcn_mfma_f32_32x32x16_bf16(b0_[1], qr[1], p0, 0, 0, 0); p1 = __builtin_amdgcn_mfma_f32_32x32x16_bf16(b1_[1], qr[1], p1, 0, 0, 0); SBAR(); \
              _Pragma("unroll") for (int i = 0; i < 2; ++i) { b0_[i] = lds_read128<0>(kb_ + kad[2 + i]); b1_[i] = lds_read128<8192>(kb_ + kad[2 + i]); } \
              asm volatile("s_waitcnt lgkmcnt(0)" ::: "memory"); SBAR(); \
              p0 = __builtin_amdgcn_mfma_f32_32x32x16_bf16(b0_[0], qr[2], p0, 0, 0, 0); p1 = __builtin_amdgcn_mfma_f32_32x32x16_bf16(b1_[0], qr[2], p1, 0, 0, 0); \
              p0 = __builtin_amdgcn_mfma_f32_32x32x16_bf16(b0_[1], qr[3], p0, 0, 0, 0); p1 = __builtin_amdgcn_mfma_f32_32x32x16_bf16(b1_[1], qr[3], p1, 0, 0, 0); } \
            if ((t) >= 16) { \
                _Pragma("unroll") for (int r = 0; r < 16; ++r) { const int kv = 4 * hi + (r & 3) + 8 * (r >> 2); if (kv >= 16) p0[r] = -1e30f; p1[r] = -1e30f; } } \
            float alpha; bf16x8 pa0, pa1, pa2, pa3; \
            partialSM(p0, p1, m_reg, alpha, C64, THR64); \
            finishSM(p0, p1, alpha, l_reg, pa0, pa1, pa2, pa3); \
            SBAR(); \
            if (__any(alpha < 1.f)) { \
                _Pragma("unroll") for (int d = 0; d < 4; ++d) _Pragma("unroll") for (int r = 0; r < 16; ++r) o[d][r] *= alpha; } \
            pv_ks<0, 4>(o, lds0 + (cur) * RING + vrb, pa0, pa1, pa2, pa3); } } while (0)
    LOADT(0, kfA, vfA); LOADT(1, kfB, vfB); WRITET(0, 0, kfA, vfA); __syncthreads();
    for (int t = 0; t < ntl; t += 2) {
        if (t + 2 < ntl) LOADT(t + 2, kfA, vfA);
        SCORE(t, 0);
        if (t + 1 < ntl) WRITET(t + 1, 1, kfB, vfB);
        __syncthreads();
        if (t + 1 < ntl) {
            if (t + 3 < ntl) LOADT(t + 3, kfB, vfB);
            SCORE(t + 1, 1);
            if (t + 2 < ntl) WRITET(t + 2, 0, kfA, vfA);
            __syncthreads();
        }
    }
#undef SCORE
#undef LOADT
#undef WRITET
#undef CV8
    const int bh = b * 4 + h;
    if (active) { float* pb = PART + ((size_t)(bh * 4 + sp) * 2 + c) * (66 * 64) + lane;
#pragma unroll
        for (int d = 0; d < 4; ++d)
#pragma unroll
            for (int r = 0; r < 16; ++r) pb[(d * 16 + r) * 64] = o[d][r];
        pb[64 * 64] = m_reg; pb[65 * 64] = l_reg; }
    asm volatile("s_waitcnt vmcnt(0)" ::: "memory"); __syncthreads();
    if (tid == 0) { __builtin_amdgcn_fence(__ATOMIC_RELEASE, "agent"); asm volatile("s_waitcnt vmcnt(0)" ::: "memory");
                    const unsigned old = __hip_atomic_fetch_add(cnt + bh, 1u, __ATOMIC_RELAXED, __HIP_MEMORY_SCOPE_AGENT);
                    if (old == 3u) { __builtin_amdgcn_fence(__ATOMIC_ACQUIRE, "agent"); asm volatile("s_waitcnt vmcnt(0)" ::: "memory"); }
                    MISC[1] = old; }
    __syncthreads();
    const bool last = MISC[1] == 3u;
    if (last && wid == 0) {
        const float* pp = PART + (size_t)(bh * 4) * 2 * (66 * 64) + lane;
        float e0[4], e1[4], L0 = 0.f, L1 = 0.f;
        { float m0[4], m1[4], M0 = -1e30f, M1 = -1e30f;
#pragma unroll
          for (int q = 0; q < 4; ++q) { m0[q] = pp[(size_t)(q * 2) * (66 * 64) + 64 * 64]; m1[q] = pp[(size_t)(q * 2 + 1) * (66 * 64) + 64 * 64]; M0 = fmaxf(M0, m0[q]); M1 = fmaxf(M1, m1[q]); }
#pragma unroll
          for (int q = 0; q < 4; ++q) { e0[q] = __builtin_amdgcn_exp2f((m0[q] - M0) * C64); e1[q] = __builtin_amdgcn_exp2f((m1[q] - M1) * C64);
              L0 += e0[q] * pp[(size_t)(q * 2) * (66 * 64) + 65 * 64]; L1 += e1[q] * pp[(size_t)(q * 2 + 1) * (66 * 64) + 65 * 64]; } }
        const float i0 = 1.f / L0, i1 = lam / L1;
#pragma unroll
        for (int q = 0; q < 4; ++q) { e0[q] *= i0; e1[q] *= i1; }
        float ss = 0.f;
#pragma unroll
        for (int d = 0; d < 4; ++d)
#pragma unroll
            for (int r = 0; r < 16; ++r) { float od = 0.f;
#pragma unroll
                for (int q = 0; q < 4; ++q) od += e0[q] * pp[(size_t)(q * 2) * (66 * 64) + (d * 16 + r) * 64] - e1[q] * pp[(size_t)(q * 2 + 1) * (66 * 64) + (d * 16 + r) * 64];
                o[d][r] = od; ss += od * od; }
        ss += __shfl_xor(ss, 32);
        const float rms = rsqrtf(ss * (1.f / 128.f) + 1e-5f) * 0.8f;
        if (r32 < 16) {
            const bf16_t* gate = PA + row * NA + 1536 + h * 128; bf16_t* out = MIX + row * DM + h * 128;
#pragma unroll
            for (int d = 0; d < 4; ++d)
#pragma unroll
                for (int g = 0; g < 4; ++g) { const int dv = 32 * d + 8 * g + 4 * hi;
                    const f32x4 gn = *(const f32x4*)(gnorm + dv); const u32x2 gt = *(const u32x2*)(gate + dv);
                    f32x4 v; v.x = o[d][4 * g] * rms * gn.x * silu(bflo(gt.x)); v.y = o[d][4 * g + 1] * rms * gn.y * silu(bfhi(gt.x));
                    v.z = o[d][4 * g + 2] * rms * gn.z * silu(bflo(gt.y)); v.w = o[d][4 * g + 3] * rms * gn.w * silu(bfhi(gt.y));
                    st_bf4(out + dv, v); }
        }
    }
    __syncthreads();
}
__device__ __forceinline__ void mem_unit(const Ctx& cx, bool samp, int b, int h, int qb, const bf16_t* P, int ldp, int qcol, int gcol,
                                         const bf16_t* Kb, const bf16_t* Vb, long ldk, bf16_t* MIX) {
    long row; bool valid; int wNT;
    if (!samp) { row = (long)b * 4096 + qb * 256 + cx.wid * 32 + cx.r32; valid = true; wNT = 4; }
    else { row = NP + b * 16 + (cx.r32 < 15 ? cx.r32 : 15); valid = (cx.wid == 0) && cx.r32 < 16; wNT = (cx.wid == 0) ? 4 : 0; }
    const bf16_t* qptr = P + (size_t)row * ldp + qcol + h * 128 + cx.hi * 8;
    f32x16 o[4]; float m, l;
    attn_core<8, false>(cx.lds, Kb, ldk, Vb, ldk, 4, 256, qptr, wNT, 0, 0, C128, THR128, o, m, l);
    const float inv = l > 0.f ? 1.f / l : 0.f;
    store_gated<4>(o, inv, P + (size_t)row * ldp + gcol + h * 128, MIX + (size_t)(row - (samp ? (cx.r32 < 15 ? cx.r32 : 15) : cx.r32)) * DM + 512 + h * 128,
                   samp ? (cx.wid == 0 ? 16 : 0) : 32, cx.lds + cx.wid * 9216, cx.lane);
}
__device__ __forceinline__ void swa_unit(const Ctx& cx, bool samp, int b, int c, int half, const bf16_t* PB, const bf16_t* KSW, const bf16_t* VSW, bf16_t* MIX, const float* sinks) {
    const int head = cx.wid, kv = cx.wid >> 2;
    long row; bool valid; int NT, nkeys; const bf16_t* Kb; const bf16_t* Vb; long ldk;
    if (!samp) { row = (long)b * 4096 + c * 64 + half * 32 + cx.r32; valid = true; const int c0 = c > 2 ? c - 2 : 0; NT = c - c0 + 1; nkeys = NT * 64;
                 Kb = PB + ((size_t)b * 4096 + c0 * 64) * NB + 2048; Vb = Kb + 128; ldk = NB; }
    else { row = NP + b * 16 + (cx.r32 < 15 ? cx.r32 : 15); valid = cx.r32 < 16; NT = 3; nkeys = 144;
           Kb = KSW + (size_t)b * SWROWS * 128; Vb = VSW + (size_t)b * SWROWS * 128; ldk = 128; }
    const bf16_t* qptr = PB + (size_t)row * NB + head * 64 + cx.hi * 8;
    f32x16 o[4]; float m, l;
    attn_core_pipe<true>(cx.lds, Kb, ldk, Vb, ldk, NT, nkeys, qptr, NT, kv * 128, kv, C64, THR64, o, m, l);
    const float lt = l + __builtin_amdgcn_exp2f(sinks[head] * LOG2E - m * C64);
    const float inv = 1.f / lt;
    store_gated<2>(o, inv, PB + (size_t)row * NB + 512 + head * 64, MIX + (size_t)(row - (samp ? (cx.r32 < 15 ? cx.r32 : 15) : cx.r32)) * DM + head * 64, samp ? 16 : 32, cx.lds + cx.wid * 9216, cx.lane);
}
#undef KSWZ
#undef SBAR
}

__device__ __forceinline__ float wave_sum(float v) {
#pragma unroll
    for (int o = 1; o < 64; o <<= 1) v += __shfl_xor(v, o);
    return v;
}
__device__ __forceinline__ void p0_transpose_item(const float* W, int K, int N, bf16_t* WT, int row_off, LAS float* scr, int item, int lane) {
    const int nblk = N / 32, kb = item / nblk, nb = item % nblk, k0 = 64 * kb, n0 = 32 * nb;
#pragma unroll 8
    for (int i = 0; i < 32; ++i) { const int kk = 2 * i + (lane >> 5); scr[kk * 33 + (lane & 31)] = __builtin_nontemporal_load(W + (size_t)(k0 + kk) * N + n0 + (lane & 31)); }
    asm volatile("s_waitcnt lgkmcnt(0)" ::: "memory");
    const int c = lane & 7;
#pragma unroll
    for (int j = 0; j < 4; ++j) { const int n = (lane >> 3) + 8 * j; const LAS float* s = scr + (8 * c) * 33 + n;
        u32x4 o; o.x = cvtpk(s[0 * 33], s[1 * 33]); o.y = cvtpk(s[2 * 33], s[3 * 33]); o.z = cvtpk(s[4 * 33], s[5 * 33]); o.w = cvtpk(s[6 * 33], s[7 * 33]);
        *(u32x4*)(WT + (size_t)(row_off + n0 + n) * K + k0 + 8 * c) = o; }
    asm volatile("s_waitcnt lgkmcnt(0)" ::: "memory");
}
__device__ __forceinline__ void p0_transpose_item_ln(const float* W, int K, int N, bf16_t* WT, int row_off, LAS float* scr, int item, int lane, const float* g, const float* b, float* CS, float* BW) {
    const int nblk = N / 32, kb = item / nblk, nb = item % nblk, k0 = 64 * kb, n0 = 32 * nb;
    float csp = 0.f, bwp = 0.f;
#pragma unroll 8
    for (int i = 0; i < 32; ++i) { const int kk = 2 * i + (lane >> 5); const float w = __builtin_nontemporal_load(W + (size_t)(k0 + kk) * N + n0 + (lane & 31)); const float gw = g[k0 + kk] * w;
        scr[kk * 33 + (lane & 31)] = gw; csp += bflo(cvtpk(gw, 0.f)); bwp += b[k0 + kk] * w; }
    csp += __shfl_xor(csp, 32); bwp += __shfl_xor(bwp, 32);
    if (lane < 32) { atomicAdd(CS + row_off + n0 + lane, csp); atomicAdd(BW + row_off + n0 + lane, bwp); }
    asm volatile("s_waitcnt lgkmcnt(0)" ::: "memory");
    const int c = lane & 7;
#pragma unroll
    for (int j = 0; j < 4; ++j) { const int n = (lane >> 3) + 8 * j; const LAS float* sp = scr + (8 * c) * 33 + n;
        u32x4 o; o.x = cvtpk(sp[0 * 33], sp[1 * 33]); o.y = cvtpk(sp[2 * 33], sp[3 * 33]); o.z = cvtpk(sp[4 * 33], sp[5 * 33]); o.w = cvtpk(sp[6 * 33], sp[7 * 33]);
        *(u32x4*)(WT + (size_t)(row_off + n0 + n) * K + k0 + 8 * c) = o; }
    asm volatile("s_waitcnt lgkmcnt(0)" ::: "memory");
}
__device__ __forceinline__ void ln_rows(const float* zin, float* fout, bf16_t* bout, const float* g, const float* bta, int gw, int NGW, int lane) {
    f32x4 g4[4], b4[4];
#pragma unroll
    for (int j = 0; j < 4; ++j) { g4[j] = *(const f32x4*)(g + 4 * lane + 256 * j); b4[j] = *(const f32x4*)(bta + 4 * lane + 256 * j); }
    for (int m = gw; m < MA; m += NGW) {
        const float* zr = zin + (size_t)m * DM + 4 * lane;
        f32x4 v[4]; float s = 0.f;
#pragma unroll
        for (int j = 0; j < 4; ++j) { v[j] = *(const f32x4*)(zr + 256 * j); s += (v[j].x + v[j].y) + (v[j].z + v[j].w); }
        const float mean = wave_sum(s) * (1.f / DM); float s2 = 0.f;
#pragma unroll
        for (int j = 0; j < 4; ++j) { v[j] = v[j] - mean; s2 += (v[j].x * v[j].x + v[j].y * v[j].y) + (v[j].z * v[j].z + v[j].w * v[j].w); }
        const float rstd = rsqrtf(wave_sum(s2) * (1.f / DM) + 1e-5f);
#pragma unroll
        for (int j = 0; j < 4; ++j) { const f32x4 y = v[j] * rstd * g4[j] + b4[j];
            *(f32x4*)(fout + (size_t)m * DM + 4 * lane + 256 * j) = y;
            if (bout) st_bf4(bout + (size_t)m * DM + 4 * lane + 256 * j, y); }
    }
}

#define XB_TMO      128
#define XB_XCNT(j)  (256  + 64 * (j))
#define XB_XSUB(j)  (1280 + 64 * (j))
#define XB_XGEN(j)  (2304 + 64 * (j))
#define XB_TOP      3328
#define XB_TOPGEN   3392
#define XCD_BAR_WORDS 3456
#define XB_SPIN_CAP (1u << 18)

__device__ __forceinline__ unsigned xb_ld(unsigned* p)              { return __hip_atomic_load(p, __ATOMIC_RELAXED, __HIP_MEMORY_SCOPE_AGENT); }
__device__ __forceinline__ unsigned xb_add(unsigned* p, unsigned v) { return __hip_atomic_fetch_add(p, v, __ATOMIC_RELAXED, __HIP_MEMORY_SCOPE_AGENT); }
__device__ __forceinline__ unsigned xb_xcc_id() { return (unsigned)__builtin_amdgcn_s_getreg((3 << 11) | 20) & 0xFu; }
#define XB_SPIN(cond, bar) do { unsigned _sp = 0; while (cond) { __builtin_amdgcn_s_sleep(1); \
    if ((++_sp & 255u) == 0u) { if (xb_ld(&(bar)[XB_TMO])) break; if (_sp > XB_SPIN_CAP) { atomicAdd(&(bar)[XB_TMO], 1u); break; } } } } while (0)

struct XcdBarrier {
    unsigned* bar; unsigned x;
    volatile LAS unsigned* st;
};

__device__ __forceinline__ XcdBarrier xcd_barrier_post(unsigned* bar, volatile LAS unsigned* st) {
    XcdBarrier b; b.bar = bar; b.x = xb_xcc_id(); b.st = st;
    if (threadIdx.x == 0) (void)xb_add(&bar[XB_XCNT(b.x)], 1u);
    return b;
}
__device__ __forceinline__ void xcd_barrier_complete(unsigned* bar, unsigned x, unsigned& nloc, unsigned& nx) {
    const unsigned G = gridDim.x * gridDim.y * gridDim.z;
    unsigned sum, cnt, mine, sp = 0u;
    for (;;) {
        sum = 0u; cnt = 0u; mine = 0u;
#pragma unroll
        for (unsigned j = 0; j < 16; ++j) { const unsigned c = xb_ld(&bar[XB_XCNT(j)]); sum += c; cnt += (c > 0u) ? 1u : 0u; mine = (j == x) ? c : mine; }
        if (sum == G) break;
        __builtin_amdgcn_s_sleep(1);
        if ((++sp & 255u) == 0u) { if (xb_ld(&bar[XB_TMO])) break; if (sp > XB_SPIN_CAP) { atomicAdd(&bar[XB_TMO], 1u); break; } }
    }
    nloc = mine > 0u ? mine : 1u; nx = cnt > 0u ? cnt : 1u;
}

__device__ __forceinline__ void xcd_barrier(const XcdBarrier& b) {
    asm volatile("s_waitcnt vmcnt(0)" ::: "memory");
    __syncthreads();
    if (threadIdx.x == 0) {
        unsigned* bar = b.bar;
        __builtin_amdgcn_s_waitcnt(0);
        unsigned nloc = b.st[0], nx = b.st[1];
        if (nloc == 0u) { xcd_barrier_complete(bar, b.x, nloc, nx); b.st[0] = nloc; b.st[1] = nx; }
        const unsigned old = xb_add(&bar[XB_XSUB(b.x)], 1u);
        const unsigned gen = old / nloc;
        if (old + 1u == (gen + 1u) * nloc) {
            __builtin_amdgcn_fence(__ATOMIC_RELEASE, "agent");
            asm volatile("s_waitcnt vmcnt(0)" ::: "memory");
            const unsigned og = xb_add(&bar[XB_TOP], 1u);
            const unsigned tg = og / nx;
            if (og + 1u == (tg + 1u) * nx) xb_add(&bar[XB_TOPGEN], 1u);
            else XB_SPIN(xb_ld(&bar[XB_TOPGEN]) == tg, bar);
            __builtin_amdgcn_fence(__ATOMIC_ACQUIRE, "agent");
            xb_add(&bar[XB_XGEN(b.x)], 1u);
            asm volatile("s_waitcnt vmcnt(0)" ::: "memory");
        } else {
            XB_SPIN(xb_ld(&bar[XB_XGEN(b.x)]) == gen, bar);
            __builtin_amdgcn_fence(__ATOMIC_ACQUIRE, "agent");
            asm volatile("s_waitcnt vmcnt(0)" ::: "memory");
        }
    }
    __syncthreads();
}

struct Args { const float* in[22]; float* out; unsigned char* ws; int ph_lo, ph_hi, rep, pad; };
constexpr int NWAVES = 8, NPHASE = 9;

__global__ void __launch_bounds__(NWAVES * 64, 2) yoco_fwd(Args a) {
    extern __shared__ __attribute__((aligned(16))) unsigned char lds_raw[];
    LAS unsigned char* lds = (LAS unsigned char*)lds_raw;
    volatile LAS unsigned* MISC = (volatile LAS unsigned*)(lds + LDS_RING);
    cg::grid_group grid = cg::this_grid();
    const int tid = threadIdx.x, lane = tid & 63, wave = __builtin_amdgcn_readfirstlane(tid >> 6);
    const int G = gridDim.x, gw = blockIdx.x * NWAVES + wave, NGW = G * NWAVES;
    const long gtid = (long)blockIdx.x * (NWAVES * 64) + tid, NTHR = (long)G * (NWAVES * 64);
    unsigned char* ws = a.ws; float* dout = a.out;
    unsigned* ctl = (unsigned*)(ws + WS_CTL);
    float* ROPE = (float*)(ws + WS_ROPE);
    float* CSV = (float*)(ws + 32768); float* BWV = (float*)(ws + 49152); float* ST0 = (float*)(ws + 262144); float* ST1 = (float*)(ws + 524288);
    bf16_t* WA_t = (bf16_t*)(ws + WS_WA); bf16_t* WB_t = (bf16_t*)(ws + WS_WB); bf16_t* WM_t = (bf16_t*)(ws + WS_WM); bf16_t* WO_t = (bf16_t*)(ws + WS_WO);
    bf16_t* MEMB = (bf16_t*)(ws + WS_MEMB); bf16_t* MKV = (bf16_t*)(ws + WS_MKV); bf16_t* CMK = (bf16_t*)(ws + WS_CMK); bf16_t* CMV = (bf16_t*)(ws + WS_CMV);
    bf16_t* KSW = (bf16_t*)(ws + WS_KSW); bf16_t* VSW = (bf16_t*)(ws + WS_VSW); bf16_t* XA = (bf16_t*)(ws + WS_XA); bf16_t* ZB = XA;
    bf16_t* MIX = (bf16_t*)(ws + WS_MIX); bf16_t* Z1B = (bf16_t*)(ws + WS_Z0); bf16_t* PA = (bf16_t*)(ws + WS_PA); bf16_t* PB = PA;
    bf16_t* KS = (bf16_t*)(ws + WS_KS); bf16_t* VS = (bf16_t*)(ws + WS_VS);
    const int lo = a.ph_lo, hi_ph = a.ph_hi;
#define IN(k) (lo <= (k) && (k) < hi_ph)
    if (tid < 64) MISC[tid] = 0u;
    __syncthreads();
    XcdBarrier xbar = xcd_barrier_post(ctl + 1024, MISC + 8);
    if (a.ph_lo > 1000) grid.sync();
#define SEAM(k) do { if (IN(k) && IN((k) + 1)) xcd_barrier(xbar); } while (0)
    att::Ctx cx; cx.lds = lds; cx.lane = lane; cx.wid = wave; cx.r32 = lane & 31; cx.hi = lane >> 5;

    if (IN(0)) {
        LAS float* scr = (LAS float*)(lds + wave * 16384);
        for (int it = gw; it < 4736; it += NGW) {
            int r = it;
            if (r < 1536) { p0_transpose_item(a.in[9], DM, NA, WA_t, 0, scr, r, lane); continue; } r -= 1536;
            if (r < 1024) { p0_transpose_item_ln(a.in[15], DM, 2048, WB_t, 0, scr, r, lane, a.in[20], a.in[21], CSV, BWV); continue; } r -= 1024;
            if (r < 128) { p0_transpose_item_ln(a.in[17], DM, 256, WB_t, 2048, scr, r, lane, a.in[20], a.in[21], CSV, BWV); continue; } r -= 128;
            if (r < 1024) { const int l = r >> 9; p0_transpose_item(a.in[18] + (size_t)l * DM * DM, DM, DM, WM_t, l * 1024, scr, r & 511, lane); continue; } r -= 1024;
            { const int l = r >> 9; p0_transpose_item(a.in[19] + (size_t)l * DM * DM, DM, DM, WO_t, l * 1024, scr, r & 511, lane); }
        }
        for (long i = gtid; i < 2097152; i += NTHR) cvt8(a.in[0] + i * 8, XA + i * 8);
        for (long i = gtid; i < 32768; i += NTHR) cvt8(a.in[1] + i * 8, XA + (size_t)NP * DM + i * 8);
        for (long i = gtid; i < 131072; i += NTHR) cvt8(a.in[2] + i * 8, MEMB + i * 8);
        for (long i = gtid; i < 524288; i += NTHR) { cvt8(a.in[7] + i * 8, CMK + i * 8); cvt8(a.in[8] + i * 8, CMV + i * 8); }
        for (long i = gtid; i < 32768; i += NTHR) { const long b = i >> 11, r = i & 2047; const size_t d = (size_t)b * SWROWS * 128 + r * 8;
            cvt8(a.in[5] + i * 8, KSW + d); cvt8(a.in[6] + i * 8, VSW + d);
            const int rw = (int)(r >> 4);
            if (rw >= 16) { const size_t od = ((size_t)b * 128 + rw - 16) * 128 + (r & 15) * 8;
                *(f32x4*)(dout + OFF_SKS + od) = *(const f32x4*)(a.in[5] + i * 8); *(f32x4*)(dout + OFF_SKS + od + 4) = *(const f32x4*)(a.in[5] + i * 8 + 4);
                *(f32x4*)(dout + OFF_SVS + od) = *(const f32x4*)(a.in[6] + i * 8); *(f32x4*)(dout + OFF_SVS + od + 4) = *(const f32x4*)(a.in[6] + i * 8 + 4); } }
        for (long i = gtid; i < 49152; i += NTHR) { const long b = i / 3072, r = i % 3072; const size_t d = ((size_t)b * KSROWS + 4112) * 512 + r * 8;
            *(u32x4*)(KS + d) = (u32x4){0u, 0u, 0u, 0u}; *(u32x4*)(VS + d) = (u32x4){0u, 0u, 0u, 0u}; }
        for (long i = gtid; i < 12288; i += NTHR) { const long b = i / 768, r = i % 768; const size_t d = ((size_t)b * SWROWS + 144) * 128 + r * 8;
            *(u32x4*)(KSW + d) = (u32x4){0u, 0u, 0u, 0u}; *(u32x4*)(VSW + d) = (u32x4){0u, 0u, 0u, 0u}; }
        for (long i = gtid; i < 4112 * 8; i += NTHR) { const int pos = (int)(i >> 3), fi = (int)(i & 7);
            const double inv = fi == 0 ? 1.0 : fi == 1 ? 0.19392274474868576 : fi == 2 ? 0.03760603093086393 : fi == 3 ? 0.007292664737217109 :
                               fi == 4 ? 0.001414213562373095 : fi == 5 ? 0.0002742481756762073 : fi == 6 ? 5.318295896944988e-05 : 1.031338537721246e-05;
            const double rev = (double)pos * inv * 0.15915494309189535; const float fr = (float)(rev - __builtin_rint(rev));
            ROPE[i * 2] = __builtin_amdgcn_cosf(fr); ROPE[i * 2 + 1] = __builtin_amdgcn_sinf(fr); }
    }
    SEAM(0);
    if (IN(1)) {
        pg8::Gemm g{XA, WA_t, NP, NA, DM}; pg8::StaticOrder S; S.init(NP, NA, G, (int)blockIdx.x);
        EpiWrap<EpiAF> E{{PA, dout, KS, VS, ROPE, 0.f, 0.f}, 0, 0};
        pg8::gemm_phase<EpiWrap<EpiAF>, pg8::StaticOrder, true, true>(lds, g, S, E);
    }
    SEAM(1);
    if (IN(2)) {
        float s1 = 0.f, s2 = 0.f;
        for (int i = 0; i < 64; ++i) { s1 += a.in[10][i] * a.in[11][i]; s2 += a.in[12][i] * a.in[13][i]; }
        if (tid == 0) MISC[2] = __float_as_uint(__expf(s1) - __expf(s2) + 0.2f);
        __syncthreads();
        unsigned* gdone = ctl + 256 + 64 * a.rep;
        if (blockIdx.x < 44) {
            if (blockIdx.x < 32) { pg8::Gemm g{MEMB, WM_t, 1024, 2048, DM}; pg8::StaticOrder S; S.init(1024, 2048, 32, (int)blockIdx.x);
                EpiWrap<EpiMemF> E{{MKV, dout, 0.f, 0.f}, 0, 0};
                pg8::gemm_phase<EpiWrap<EpiMemF>, pg8::StaticOrder, true, true>(lds, g, S, E); }
            else { pg8::Gemm g{XA + (size_t)NP * DM, WA_t, 256, NA, DM}; pg8::StaticOrder S; S.init(256, NA, 12, (int)blockIdx.x - 32);
                EpiWrap<EpiAF> E{{PA, dout, KS, VS, ROPE, 0.f, 0.f}, NP, 0};
                pg8::gemm_phase<EpiWrap<EpiAF>, pg8::StaticOrder, true, true>(lds, g, S, E); }
            asm volatile("s_waitcnt vmcnt(0)" ::: "memory"); __syncthreads();
            if (tid == 0) { __builtin_amdgcn_fence(__ATOMIC_RELEASE, "agent"); asm volatile("s_waitcnt vmcnt(0)" ::: "memory");
                            __hip_atomic_fetch_add(gdone, 1u, __ATOMIC_RELAXED, __HIP_MEMORY_SCOPE_AGENT); }
        }
        bool ready = false;
        float* PART = (float*)(ws + WS_Z0 + 40 * MiB + (size_t)a.rep * (10 * MiB));
        for (;;) {
            if (tid == 0) MISC[0] = atomicAdd(ctl + 128 * a.rep, 1u);
            __syncthreads(); const unsigned u = MISC[0]; __syncthreads();
            if (u >= 1088u) break;
            const bool needs = (u >= 256u && u < 512u) || u >= 768u;
            if (needs && !ready) {
                if (tid == 0) { unsigned sp = 0; while (__hip_atomic_load(gdone, __ATOMIC_RELAXED, __HIP_MEMORY_SCOPE_AGENT) < 44u && ++sp < (1u << 24)) __builtin_amdgcn_s_sleep(8);
                                __builtin_amdgcn_fence(__ATOMIC_ACQUIRE, "agent"); asm volatile("s_waitcnt vmcnt(0)" ::: "memory"); }
                __syncthreads(); ready = true;
            }
            if (u < 768u) {
                const float lam = __uint_as_float(MISC[2]);
                if (u >= 256u && u < 512u) { const unsigned v = u - 256u;
                    att::diff_sample_item(cx, (int)(v >> 4), (int)((v >> 2) & 3u), (int)(v & 3u), a.in[3], a.in[4], PA, KS, VS, MIX, a.in[14], lam, PART, ctl + 512 + 64 * a.rep, MISC); }
                else { const unsigned v = u < 256u ? u : u - 256u;
                    att::diff_unit(cx, false, (int)((v & 15u) >> 2), (int)(v & 3u), 31 - (int)(v >> 4), PA, KS, VS, MIX, a.in[14], lam); } }
            else { const bool samp = u >= 1024u; const unsigned v = samp ? u - 1024u : u - 768u;
                const int b = samp ? (int)(v >> 2) : (int)(v >> 6), h = samp ? (int)(v & 3u) : (int)((v >> 4) & 3u), qb = samp ? 0 : (int)(v & 15u);
                const bf16_t* Kb = samp ? CMK + ((size_t)b * 256) * 512 + h * 128 : MKV + ((size_t)b * 256) * 2048 + h * 128;
                const bf16_t* Vb = samp ? CMV + ((size_t)b * 256) * 512 + h * 128 : Kb + 512;
                att::mem_unit(cx, samp, b, h, qb, PA, NA, 2048, 2560, Kb, Vb, samp ? 512 : 2048, MIX); }
        }
    }
    SEAM(2);
    if (IN(3)) {
        EpiMerge0F F0{ZB, ST0, 0.f, 0.f};
        { pg8::Gemm g{MIX, WO_t, NP, DM, DM}; pg8::StaticOrder S; S.init(NP, DM, G, (int)blockIdx.x);
          EpiWrap<EpiMerge0F> E{F0, 0, 0};
          pg8::gemm_phase<EpiWrap<EpiMerge0F>, pg8::StaticOrder, true, true>(lds, g, S, E); }
        gemm_small<EpiMerge0F>(lds, MIX + (size_t)NP * DM, WO_t, DM, NP, (int)blockIdx.x, G, F0);
    }
    SEAM(3);
    if (IN(5)) {
        EpiBF FB{PB, dout, KSW, VSW, ROPE, ST0, CSV, BWV, 0.f, 0.f, {0.f, 0.f}, {0.f, 0.f}};
        { pg8::Gemm g{ZB, WB_t, NP, 2048, DM}; pg8::StaticOrder S; S.init(NP, 2048, G, (int)blockIdx.x);
          EpiWrap<EpiBF> E{FB, 0, 0};
          pg8::gemm_phase<EpiWrap<EpiBF>, pg8::StaticOrder, true, true>(lds, g, S, E); }
    }
    SEAM(5);
    if (IN(6)) {
        unsigned* gdone = ctl + 384 + 64 * a.rep;
        {
            EpiBF FB{PB, dout, KSW, VSW, ROPE, ST0, CSV, BWV, 0.f, 0.f, {0.f, 0.f}, {0.f, 0.f}};
            if (blockIdx.x < 64) { pg8::Gemm g{ZB, WB_t + (size_t)2048 * DM, NP, 256, DM}; pg8::StaticOrder S; S.init(NP, 256, 64, (int)blockIdx.x);
                EpiWrap<EpiBF> E{FB, 0, 2048};
                pg8::gemm_phase<EpiWrap<EpiBF>, pg8::StaticOrder, true, true>(lds, g, S, E); }
            else { gemm_small<EpiBF>(lds, ZB + (size_t)NP * DM, WB_t, 2048, NP, (int)blockIdx.x - 64, 192, FB);
                   if (blockIdx.x >= 192) gemm_small<EpiBF>(lds, ZB + (size_t)NP * DM, WB_t + (size_t)2048 * DM, 256, NP, (int)blockIdx.x - 192, 64, FB, 2048); }
            asm volatile("s_waitcnt vmcnt(0)" ::: "memory"); __syncthreads();
            if (tid == 0) { __builtin_amdgcn_fence(__ATOMIC_RELEASE, "agent"); asm volatile("s_waitcnt vmcnt(0)" ::: "memory");
                            __hip_atomic_fetch_add(gdone + (blockIdx.x < 64 ? 0 : 16), 1u, __ATOMIC_RELAXED, __HIP_MEMORY_SCOPE_AGENT); }
        }
        bool ready1 = false, ready2 = false;
        for (;;) {
            if (tid == 0) MISC[0] = atomicAdd(ctl + 64 + 128 * a.rep, 1u);
            __syncthreads(); const unsigned u = MISC[0]; __syncthreads();
            if (u >= 848u) break;
            const bool need1 = u >= 256u && u < 768u, need2 = u >= 768u;
            if ((need1 && !ready1) || (need2 && !ready2)) {
                if (tid == 0) { unsigned sp = 0; unsigned* w = need1 ? gdone : gdone + 16; const unsigned want = need1 ? 64u : 192u;
                                while (__hip_atomic_load(w, __ATOMIC_RELAXED, __HIP_MEMORY_SCOPE_AGENT) < want && ++sp < (1u << 24)) __builtin_amdgcn_s_sleep(8);
                                __builtin_amdgcn_fence(__ATOMIC_ACQUIRE, "agent"); asm volatile("s_waitcnt vmcnt(0)" ::: "memory"); }
                __syncthreads(); if (need1) ready1 = true; else ready2 = true;
            }
            const bool is_mem = u < 256u || (u >= 768u && u < 832u);
            if (is_mem) { const bool samp = u >= 768u; const unsigned v = samp ? u - 768u : u;
                const int b = samp ? (int)(v >> 2) : (int)(v >> 6), h = samp ? (int)(v & 3u) : (int)((v >> 4) & 3u), qb = samp ? 0 : (int)(v & 15u);
                const bf16_t* Kb = samp ? CMK + ((size_t)(16 + b) * 256) * 512 + h * 128 : MKV + ((size_t)b * 256) * 2048 + 1024 + h * 128;
                const bf16_t* Vb = samp ? CMV + ((size_t)(16 + b) * 256) * 512 + h * 128 : Kb + 512;
                att::mem_unit(cx, samp, b, h, qb, PB, NB, 1024, 1536, Kb, Vb, samp ? 512 : 2048, MIX); }
            else { const bool samp = u >= 832u; const unsigned v = samp ? u - 832u : u - 256u;
                const int b = samp ? (int)v : (int)(v >> 7), c = samp ? 0 : (int)((v >> 1) & 63u), half = samp ? 0 : (int)(v & 1u);
                att::swa_unit(cx, samp, b, c, half, PB, KSW, VSW, MIX, a.in[16]); }
        }
    }
    SEAM(6);
    if (IN(7)) {
        EpiMerge1F F1{ZB, ST0, a.in[20], a.in[21], Z1B, ST1, 0.f, 0.f, {0.f, 0.f}, {0.f, 0.f}};
        { pg8::Gemm g{MIX, WO_t + (size_t)DM * DM, NP, DM, DM}; pg8::StaticOrder S; S.init(NP, DM, G, (int)blockIdx.x);
          EpiWrap<EpiMerge1F> E{F1, 0, 0};
          pg8::gemm_phase<EpiWrap<EpiMerge1F>, pg8::StaticOrder, true, true>(lds, g, S, E); }
        gemm_small<EpiMerge1F>(lds, MIX + (size_t)NP * DM, WO_t + (size_t)DM * DM, DM, NP, (int)blockIdx.x, G, F1);
    }
    SEAM(7);
    if (IN(8)) {
        const float* g1 = a.in[20] + DM; const float* b1 = a.in[21] + DM;
#pragma unroll 4
        for (long i = gtid; i < (long)MA * 256; i += NTHR) { const int row = (int)(i >> 8), c4 = (int)(i & 255) * 4;
            float mu, rstd; row_stats(ST1, row, mu, rstd);
            const u32x2 zz = __builtin_nontemporal_load((const u32x2*)(Z1B + (size_t)row * DM + c4));
            const f32x4 z = (f32x4){bflo(zz.x), bfhi(zz.x), bflo(zz.y), bfhi(zz.y)};
            __builtin_nontemporal_store((z - mu) * rstd * *(const f32x4*)(g1 + c4) + *(const f32x4*)(b1 + c4), (f32x4*)(dout + (size_t)row * DM + c4)); }
    }
#undef IN
#undef SEAM
}

#ifndef MK_N_LAUNCHES
#define MK_N_LAUNCHES 1
#endif
#ifndef PROBE_DUP
#define PROBE_DUP 0
#endif
extern "C" void kernel_launch(void* const* d_in, const int* in_sizes, int n_in, void* d_out, int out_size, void* d_ws, size_t ws_size, hipStream_t stream) {
    static int grid = 0;
    if (grid == 0) {
        if (n_in != 22 || ws_size < WS_END) { fprintf(stderr, "kernel_launch: unexpected n_in %d / ws %zu\n", n_in, ws_size); grid = -1; return; }
        int dev = 0, cus = 0, per_cu = 0;
        if (hipGetDevice(&dev) != hipSuccess || hipDeviceGetAttribute(&cus, hipDeviceAttributeMultiprocessorCount, dev) != hipSuccess) { grid = -1; return; }
        if (hipFuncSetAttribute((const void*)yoco_fwd, hipFuncAttributeMaxDynamicSharedMemorySize, LDS_BYTES) != hipSuccess) { fprintf(stderr, "kernel_launch: hipFuncSetAttribute failed\n"); grid = -1; return; }
        if (hipOccupancyMaxActiveBlocksPerMultiprocessor(&per_cu, (const void*)yoco_fwd, NWAVES * 64, LDS_BYTES) != hipSuccess || per_cu < 1) { fprintf(stderr, "kernel_launch: occupancy query says %d\n", per_cu); per_cu = 1; }
        (void)hipGetLastError();
        grid = cus;
    }
    if (grid < 0) return;
    (void)hipMemsetAsync((char*)d_ws + WS_CTL, 0, 1048576, stream);
    Args a{};
    for (int i = 0; i < 22; ++i) a.in[i] = (const float*)d_in[i];
    a.out = (float*)d_out; a.ws = (unsigned char*)d_ws;
#if MK_N_LAUNCHES == 1
    a.ph_lo = 0; a.ph_hi = NPHASE;
    void* args[] = {&a};
    hipError_t e = hipLaunchCooperativeKernel((const void*)yoco_fwd, dim3(grid), dim3(NWAVES * 64), args, LDS_BYTES, stream);
    if (e != hipSuccess) fprintf(stderr, "kernel_launch: cooperative launch failed: %s (grid %d)\n", hipGetErrorString(e), grid);
#else
    for (int p = 0; p < NPHASE; ++p) { a.ph_lo = p; a.ph_hi = p + 1;
        for (int r = 0; r < 1 + ((PROBE_DUP >> p) & 1); ++r) { a.rep = r; hipLaunchKernelGGL(yoco_fwd, dim3(grid), dim3(NWAVES * 64), LDS_BYTES, stream, a); } }
#endif
}
```

```cpp
#include <hip/hip_runtime.h>
#include <hip/hip_cooperative_groups.h>
#include <cstdio>
#include <cstdint>
namespace cg = cooperative_groups;
namespace pg8 {
#define PG8_LAS __attribute__((address_space(3)))
typedef unsigned short bf16_t;
typedef short bf16x8 __attribute__((ext_vector_type(8)));
typedef float f32x4 __attribute__((ext_vector_type(4)));
typedef unsigned u32x4 __attribute__((ext_vector_type(4)));
constexpr int BM = 256, BK = 64, HALF = 128, HTB = HALF * BK * 2  , STAGE_BYTES = 8 * HTB, NXCD = 8, WGM = 8;

__host__ __device__ __forceinline__ int lds_byte(int r, int c) { const int st = (r >> 4) * 2 + (c >> 5), rr = r & 15, cc = c & 31, ob = rr * 64 + cc * 2; return st * 1024 + (ob ^ (((ob >> 9) & 1) << 5)); }
__host__ __device__ __forceinline__ void stage_rc(int b, int& R, int& C) { const int st = b / 1024, sb = b % 1024, swz = sb ^ (((sb >> 9) & 1) << 5); R = (st >> 1) * 16 + swz / 64; C = (st & 1) * 32 + (swz % 64) / 2; }
__host__ __device__ __forceinline__ int perm32(int rho) { const int n = rho >> 4, i = rho & 15; return 8 * (i >> 2) + 4 * n + (i & 3); }

struct Unit { int pm, pn; };
struct Gemm { const bf16_t* A; const bf16_t* Bt; int M, N, K; };

struct StaticOrder {
    int nM, nN, nwg, G, c;
    __host__ __device__ void init(int M, int N, int G_, int c_) { nM = M / BM; nN = N / BM; nwg = nM * nN; G = G_; c = c_; }
    __host__ __device__ bool next(int i, Unit& u) const {
        const long L = (long)i * G + c; if (L >= nwg) return false;
        int wgid = (int)L; { const int q = nwg / NXCD, r = nwg % NXCD, xcd = wgid % NXCD, off = wgid / NXCD; wgid = (xcd < r ? xcd * (q + 1) : r * (q + 1) + (xcd - r) * q) + off; }
        const int nig = WGM * nN, gid = wgid / nig, fm = gid * WGM, gsz = (nM - fm) < WGM ? (nM - fm) : WGM;
        u.pm = fm + ((wgid % nig) % gsz); u.pn = (wgid % nig) / gsz; return true;
    }
    __device__ __forceinline__ void a_ready(const Unit&) const {}
    __device__ __forceinline__ void done(const Unit&) const {}
};
__device__ __forceinline__ unsigned cvt_pk_bf16(float lo, float hi) { unsigned r; asm volatile("v_cvt_pk_bf16_f32 %0, %1, %2" : "=v"(r) : "v"(lo), "v"(hi)); return r; }
typedef float f32x2 __attribute__((ext_vector_type(2)));
template <class Epi, class Sched, bool ALIGN_EPI = false, bool SP2 = false>
__device__ __forceinline__ void gemm_phase(PG8_LAS unsigned char* lds, const Gemm g, const Sched& S, const Epi& E) {
    const int tid = threadIdx.x, wid = __builtin_amdgcn_readfirstlane(tid >> 6), lane = tid & 63, wr = wid >> 2, wc = wid & 3, fr = lane & 15, fq = lane >> 4;
    const int K = g.K, nt = K / BK;
    unsigned voffA[2], voffB[2];
#pragma unroll
    for (int i = 0; i < 2; ++i) { int R, C; stage_rc(tid * 16 + i * 8192, R, C); const int Rb = Epi::PERM ? ((R & ~31) + perm32(R & 31)) : R;
        voffA[i] = (unsigned)(R * K + C) * 2u; voffB[i] = (unsigned)(Rb * K + C) * 2u; }
    const size_t kstep = (size_t)(BK * 2);
    const size_t hstep = (size_t)HALF * K * 2;
    const size_t tstep = 2 * hstep;
    const unsigned ldsw = (unsigned)wid * 1024u;
    const int aoff = lds_byte(wr * 64 + fr, fq * 8), boff = lds_byte(wc * 32 + fr, fq * 8);
#define PG8_SA(b, h) (((b) * 2 + (h)) * HTB)
#define PG8_SB(b, h) ((4 + (b) * 2 + (h)) * HTB)
#define PG8_STAGE(bufoff, gbase, voff) do { _Pragma("unroll") for (int _i = 0; _i < 2; ++_i) \
        __builtin_amdgcn_global_load_lds((const unsigned*)((const char*)(gbase) + (voff)[_i]), (PG8_LAS unsigned*)(lds + (bufoff) + ldsw + _i * 8192), 16, 0, 0); } while (0)
#define PG8_LDA(dst, b, h) do { _Pragma("unroll") for (int m = 0; m < 4; ++m) _Pragma("unroll") for (int k = 0; k < 2; ++k) dst[m][k] = *(const PG8_LAS bf16x8*)(lds + PG8_SA(b, h) + aoff + m * 2048 + k * 1024); } while (0)
#define PG8_LDB(dst, b, h) do { _Pragma("unroll") for (int n = 0; n < 2; ++n) _Pragma("unroll") for (int k = 0; k < 2; ++k) dst[n][k] = *(const PG8_LAS bf16x8*)(lds + PG8_SB(b, h) + boff + n * 2048 + k * 1024); } while (0)
#define PG8_MMA(ai, bj, At, Bt) do { __builtin_amdgcn_s_setprio(1); _Pragma("unroll") for (int m = 0; m < 4; ++m) _Pragma("unroll") for (int n = 0; n < 2; ++n) _Pragma("unroll") for (int k = 0; k < 2; ++k) \
        acc[ai][bj][m][n] = __builtin_amdgcn_mfma_f32_16x16x32_bf16(Bt[n][k], At[m][k], acc[ai][bj][m][n], 0, 0, 0); __builtin_amdgcn_s_setprio(0); } while (0)
#define PG8_WAIT_V(n) asm volatile("s_waitcnt vmcnt(" #n ")" ::: "memory")
#define PG8_WAIT_L(n) asm volatile("s_waitcnt lgkmcnt(" #n ")" ::: "memory")
#define PG8_BAR __builtin_amdgcn_s_barrier()
#define PG8_SCHED __builtin_amdgcn_sched_barrier(0)
    Unit cur, nxt; int ui = 0;
    if (!S.next(0, cur)) return;
    f32x4 acc[2][2][4][2];
#pragma unroll
    for (int a = 0; a < 2; ++a)
#pragma unroll
        for (int b = 0; b < 2; ++b)
#pragma unroll
            for (int m = 0; m < 4; ++m)
#pragma unroll
                for (int n = 0; n < 2; ++n) acc[a][b][m][n] = (f32x4){0.f, 0.f, 0.f, 0.f};
    bf16x8 At[4][2], B0[2][2], B1[2][2];
    const char* cA = (const char*)g.A + (size_t)cur.pm * tstep; const char* cB = (const char*)g.Bt + (size_t)cur.pn * tstep;
    S.a_ready(cur);
    if constexpr (SP2) {
        PG8_STAGE(PG8_SB(0, 0), cB, voffB); PG8_STAGE(PG8_SB(0, 1), cB + hstep, voffB); PG8_STAGE(PG8_SA(0, 0), cA, voffA); PG8_STAGE(PG8_SA(0, 1), cA + hstep, voffA);
        if (wr == 1) PG8_BAR;
        PG8_WAIT_V(2); PG8_BAR;
        PG8_STAGE(PG8_SB(1, 0), cB + kstep, voffB); PG8_STAGE(PG8_SA(1, 0), cA + kstep, voffA); PG8_STAGE(PG8_SB(1, 1), cB + hstep + kstep, voffB);
        PG8_WAIT_V(6); PG8_BAR;
    } else {
        PG8_STAGE(PG8_SB(0, 0), cB, voffB); PG8_STAGE(PG8_SA(0, 0), cA, voffA); PG8_STAGE(PG8_SB(0, 1), cB + hstep, voffB); PG8_STAGE(PG8_SA(0, 1), cA + hstep, voffA);
        if (wr == 1) PG8_BAR;
        PG8_WAIT_V(4); PG8_BAR;
        PG8_STAGE(PG8_SB(1, 0), cB + kstep, voffB); PG8_STAGE(PG8_SA(1, 0), cA + kstep, voffA); PG8_STAGE(PG8_SB(1, 1), cB + hstep + kstep, voffB);
        PG8_WAIT_V(6); PG8_BAR;
    }
    for (;;) {
        const bool has_next = S.next(ui + 1, nxt);
        const char* nA = has_next ? (const char*)g.A + (size_t)nxt.pm * tstep : cA; const char* nB = has_next ? (const char*)g.Bt + (size_t)nxt.pn * tstep : cB;
        for (int t = 0; t < nt; t += 2) {
            const bool last = (t == nt - 2);
            const char* a1 = cA + (size_t)(t + 1) * kstep;
            const char* a2 = last ? nA : cA + (size_t)(t + 2) * kstep; const char* b2 = last ? nB : cB + (size_t)(t + 2) * kstep;
            const char* a3 = a2 + kstep; const char* b3 = b2 + kstep;
            if (last && has_next) S.a_ready(nxt);
            if constexpr (SP2) {
            PG8_LDB(B0, 0, 0); PG8_LDB(B1, 0, 1); PG8_SCHED; PG8_LDA(At, 0, 0); PG8_STAGE(PG8_SA(1, 1), a1 + hstep, voffA);
            PG8_WAIT_V(8); PG8_WAIT_L(0); PG8_BAR; PG8_MMA(0, 0, At, B0); PG8_MMA(0, 1, At, B1); PG8_BAR; PG8_SCHED;
            PG8_LDA(At, 0, 1); PG8_STAGE(PG8_SB(0, 0), b2, voffB); PG8_STAGE(PG8_SB(0, 1), b2 + hstep, voffB); PG8_STAGE(PG8_SA(0, 0), a2, voffA);
            PG8_WAIT_V(8); PG8_WAIT_L(0); PG8_BAR; PG8_MMA(1, 0, At, B0); PG8_MMA(1, 1, At, B1); PG8_BAR; PG8_SCHED;
            PG8_LDB(B0, 1, 0); PG8_LDB(B1, 1, 1); PG8_SCHED; PG8_LDA(At, 1, 0); PG8_STAGE(PG8_SA(0, 1), a2 + hstep, voffA);
            PG8_WAIT_V(8); PG8_WAIT_L(0); PG8_BAR; PG8_MMA(0, 0, At, B0); PG8_MMA(0, 1, At, B1); PG8_BAR; PG8_SCHED;
            PG8_LDA(At, 1, 1); PG8_STAGE(PG8_SB(1, 0), b3, voffB); PG8_STAGE(PG8_SB(1, 1), b3 + hstep, voffB); PG8_STAGE(PG8_SA(1, 0), a3, voffA);
            PG8_WAIT_V(8); PG8_WAIT_L(0); PG8_BAR; PG8_MMA(1, 0, At, B0); PG8_MMA(1, 1, At, B1); PG8_BAR; PG8_SCHED;
            } else {
            PG8_LDB(B0, 0, 0); PG8_SCHED; PG8_LDA(At, 0, 0); PG8_STAGE(PG8_SA(1, 1), a1 + hstep, voffA);
            PG8_WAIT_L(8); PG8_BAR; PG8_WAIT_L(0); PG8_MMA(0, 0, At, B0); PG8_BAR; PG8_SCHED;
            PG8_LDB(B1, 0, 1); PG8_STAGE(PG8_SB(0, 0), b2, voffB);
            PG8_BAR; PG8_WAIT_L(0); PG8_MMA(0, 1, At, B1); PG8_BAR;
            PG8_LDA(At, 0, 1); PG8_STAGE(PG8_SA(0, 0), a2, voffA);
            PG8_BAR; PG8_WAIT_L(0); PG8_MMA(1, 0, At, B0); PG8_BAR; PG8_SCHED;
            PG8_STAGE(PG8_SB(0, 1), b2 + hstep, voffB);
            PG8_WAIT_V(6); PG8_BAR; PG8_MMA(1, 1, At, B1); PG8_BAR;
            PG8_LDB(B0, 1, 0); PG8_SCHED; PG8_LDA(At, 1, 0); PG8_STAGE(PG8_SA(0, 1), a2 + hstep, voffA);
            PG8_WAIT_L(8); PG8_BAR; PG8_WAIT_L(0); PG8_MMA(0, 0, At, B0); PG8_BAR; PG8_SCHED;
            PG8_LDB(B1, 1, 1); PG8_STAGE(PG8_SB(1, 0), b3, voffB);
            PG8_BAR; PG8_WAIT_L(0); PG8_MMA(0, 1, At, B1); PG8_BAR;
            PG8_LDA(At, 1, 1); PG8_STAGE(PG8_SA(1, 0), a3, voffA);
            PG8_BAR; PG8_WAIT_L(0); PG8_MMA(1, 0, At, B0); PG8_BAR; PG8_SCHED;
            PG8_STAGE(PG8_SB(1, 1), b3 + hstep, voffB);
            PG8_WAIT_V(6); PG8_BAR; PG8_MMA(1, 1, At, B1); PG8_BAR;
            }
        }
        if constexpr (ALIGN_EPI) { if (wr == 0) PG8_BAR; }
        if constexpr (!Epi::AFTER_DRAIN) { E(acc, cur, wr, wc, fr, fq); S.done(cur); }
        if (!has_next) break;
#pragma unroll
        for (int a = 0; a < 2; ++a)
#pragma unroll
            for (int b = 0; b < 2; ++b)
#pragma unroll
                for (int m = 0; m < 4; ++m)
#pragma unroll
                    for (int n = 0; n < 2; ++n) acc[a][b][m][n] = (f32x4){0.f, 0.f, 0.f, 0.f};
        cur = nxt; cA = nA; cB = nB; ++ui;
        if constexpr (ALIGN_EPI) { if (wr == 1) PG8_BAR; }
    }
    PG8_WAIT_V(0);
    if constexpr (!ALIGN_EPI) { if (wr == 0) PG8_BAR; }
    PG8_BAR;
    if constexpr (Epi::AFTER_DRAIN) { E.fused(acc, cur, wr, wc, fr, fq, lds, wid, lane); S.done(cur); }
#undef PG8_SA
#undef PG8_SB
#undef PG8_STAGE
#undef PG8_LDA
#undef PG8_LDB
#undef PG8_MMA
#undef PG8_WAIT_V
#undef PG8_WAIT_L
#undef PG8_BAR
#undef PG8_SCHED
}
}

typedef unsigned short bf16_t;
typedef short bf16x8 __attribute__((ext_vector_type(8)));
typedef short s16x4 __attribute__((ext_vector_type(4)));
typedef float f32x4 __attribute__((ext_vector_type(4)));
typedef float f32x16 __attribute__((ext_vector_type(16)));
typedef unsigned u32x4 __attribute__((ext_vector_type(4)));
typedef unsigned u32x2 __attribute__((ext_vector_type(2)));
#define LAS __attribute__((address_space(3)))

constexpr int DM = 1024, NP = 16384, NS = 256, MA = NP + NS;
constexpr int NA = 3072, NB = 2304;
constexpr int KSROWS = 4160, SWROWS = 192;
constexpr float DN_ALPHA = 1.41421356237309515f;
constexpr float LOG2E = 1.4426950408889634f;
constexpr float C64 = 0.125f * LOG2E, THR64 = 64.f;
constexpr float C128 = 0.088388347648318440f * LOG2E, THR128 = 90.5f;
constexpr size_t OFF_DKP = 17039360, OFF_DVP = 25427968, OFF_DKS = 33816576, OFF_DVS = 33947648, OFF_SKP = 34078720, OFF_SVP = 34144256,
                 OFF_SKS = 34209792, OFF_SVS = 34471936, OFF_MKP = 34734080, OFF_MVP = 35782656;
constexpr size_t MiB = 1u << 20;
constexpr size_t WS_CTL = 0, WS_ROPE = 1 * MiB, WS_WA = 2 * MiB, WS_WB = 8 * MiB, WS_WM = 13 * MiB, WS_WO = 17 * MiB, WS_MEMB = 21 * MiB, WS_MKV = 23 * MiB,
                 WS_CMK = 27 * MiB, WS_CMV = 35 * MiB, WS_KSW = 43 * MiB, WS_VSW = 44 * MiB, WS_XA = 46 * MiB, WS_MIX = 79 * MiB, WS_Z0 = 112 * MiB,
                 WS_PA = 177 * MiB, WS_KS = 275 * MiB, WS_VS = 340 * MiB, WS_END = 405 * MiB;
constexpr int LDS_RING = 131072, LDS_BYTES = LDS_RING + 256;

__device__ __forceinline__ unsigned cvtpk(float lo, float hi) { unsigned r; asm volatile("v_cvt_pk_bf16_f32 %0, %1, %2" : "=v"(r) : "v"(lo), "v"(hi)); return r; }
__device__ __forceinline__ float bflo(unsigned w) { return __uint_as_float(w << 16); }
__device__ __forceinline__ float bfhi(unsigned w) { return __uint_as_float(w & 0xffff0000u); }
__device__ __forceinline__ float silu(float x) { return x * __builtin_amdgcn_rcpf(1.f + __expf(-x)); }
__device__ __forceinline__ void cvt8(const float* s, bf16_t* d) {
    const f32x4 a = __builtin_nontemporal_load((const f32x4*)s), b = __builtin_nontemporal_load((const f32x4*)(s + 4));
    u32x4 w; w.x = cvtpk(a.x, a.y); w.y = cvtpk(a.z, a.w); w.z = cvtpk(b.x, b.y); w.w = cvtpk(b.z, b.w); __builtin_nontemporal_store(w, (u32x4*)d);
}

__device__ __forceinline__ f32x4 shfl4(f32x4 v, int m) { f32x4 p; p.x = __shfl_xor(v.x, m); p.y = __shfl_xor(v.y, m); p.z = __shfl_xor(v.z, m); p.w = __shfl_xor(v.w, m); return p; }
struct NoPre {};
template <class F> struct EpiWrap {
    static constexpr bool PERM = true, AFTER_DRAIN = false;
    F f; int rowbase, colbase;
    __device__ __forceinline__ void operator()(const f32x4 (&acc)[2][2][4][2], const pg8::Unit& u, int wr, int wc, int fr, int fq) const {
        F lf = f;
#pragma unroll
        for (int ai = 0; ai < 2; ++ai)
#pragma unroll
            for (int mp = 0; mp < 2; ++mp) {
                typename F::Pre pr[2][2][2]; f32x4 vv[2][2][2];
                const int row0 = rowbase + u.pm * 256 + ai * 128 + wr * 64 + mp * 32 + fr, colb = colbase + u.pn * 256 + wc * 32 + 8 * fq;
                u32x4 p8[2][2];
#pragma unroll
                for (int mm = 0; mm < 2; ++mm) { lf.row_begin(mm, row0 + mm * 16);
#pragma unroll
                    for (int bj = 0; bj < 2; ++bj) {
                        if constexpr (F::PRE8) p8[mm][bj] = lf.pre8(row0 + mm * 16, colb + bj * 128);
                        else {
#pragma unroll
                            for (int n = 0; n < 2; ++n) pr[mm][bj][n] = lf.pre(row0 + mm * 16, colb + bj * 128 + n * 4); } } }
#pragma unroll
                for (int mm = 0; mm < 2; ++mm)
#pragma unroll
                    for (int bj = 0; bj < 2; ++bj)
#pragma unroll
                        for (int n = 0; n < 2; ++n) {
                            if constexpr (F::PRE8) vv[mm][bj][n] = lf.fix8(mm, colb + bj * 128 + n * 4, acc[ai][bj][mp * 2 + mm][n], p8[mm][bj], n);
                            else vv[mm][bj][n] = lf.fix(mm, colb + bj * 128 + n * 4, acc[ai][bj][mp * 2 + mm][n], pr[mm][bj][n]); }
#pragma unroll
                for (int mm = 0; mm < 2; ++mm) { const int row = row0 + mm * 16; lf.s = 0.f; lf.q = 0.f;
#pragma unroll
                    for (int bj = 0; bj < 2; ++bj) { const int col = colb + bj * 128; f32x4 p0 = vv[mm][bj][0], p1 = vv[mm][bj][1];
                        if constexpr (F::ROPE) { if (lf.need_rope(col - 8 * fq)) { p0 = shfl4(p0, 16); p1 = shfl4(p1, 16); } }
                        lf.oct(row, col, vv[mm][bj][0], vv[mm][bj][1], p0, p1); }
                    if constexpr (F::STATS) { float s = lf.s, q = lf.q; s += __shfl_xor(s, 16); s += __shfl_xor(s, 32); q += __shfl_xor(q, 16); q += __shfl_xor(q, 32);
                        if (fq == 0) lf.commit(row, s, q); } }
            }
    }
};
__device__ __forceinline__ f32x4 rope_apply(f32x4 v, f32x4 p, int col, int pos, const float* rope) {
    const float* t = rope + ((size_t)pos * 8 + (col & 4)) * 2;
    const f32x4 t0 = *(const f32x4*)t, t1 = *(const f32x4*)(t + 4);
    const float sg = (col & 8) ? 1.f : -1.f;
    f32x4 o; o.x = v.x * t0.x + sg * p.x * t0.y; o.y = v.y * t0.z + sg * p.y * t0.w; o.z = v.z * t1.x + sg * p.z * t1.y; o.w = v.w * t1.z + sg * p.w * t1.w;
    return o;
}
__device__ __forceinline__ void st_bf4(bf16_t* p, f32x4 v) { u32x2 w; w.x = cvtpk(v.x, v.y); w.y = cvtpk(v.z, v.w); *(u32x2*)p = w; }
__device__ __forceinline__ void st_bf8_nt(bf16_t* p, f32x4 a, f32x4 b) { u32x4 w; w.x = cvtpk(a.x, a.y); w.y = cvtpk(a.z, a.w); w.z = cvtpk(b.x, b.y); w.w = cvtpk(b.z, b.w); __builtin_nontemporal_store(w, (u32x4*)p); }
__device__ __forceinline__ void st_bf8(bf16_t* p, f32x4 a, f32x4 b) { u32x4 w; w.x = cvtpk(a.x, a.y); w.y = cvtpk(a.z, a.w); w.z = cvtpk(b.x, b.y); w.w = cvtpk(b.z, b.w); *(u32x4*)p = w; }
__device__ __forceinline__ void row_stats(const float* ST, int row, float& mu, float& rstd) {
    const float s = ST[2 * (size_t)row], q = ST[2 * (size_t)row + 1]; mu = s * (1.f / DM); rstd = rsqrtf(fmaxf(q * (1.f / DM) - mu * mu, 0.f) + 1e-5f);
}

struct EpiAF {
    static constexpr bool PRE8 = false; static constexpr bool ROPE = true, STATS = false; typedef NoPre Pre;
    bf16_t* PA; float* dout; bf16_t* KS; bf16_t* VS; const float* rope; float s, q;
    __device__ __forceinline__ void row_begin(int, int) {}
    __device__ __forceinline__ Pre pre(int, int) const { return Pre{}; }
    __device__ __forceinline__ f32x4 fix(int, int, f32x4 v, const Pre&) const { return v; }
    __device__ __forceinline__ bool need_rope(int col) const { return (col >> 9) < 2 && ((col >> 4) & 3) == 0; }
    __device__ __forceinline__ void commit(int, float, float) {}
    __device__ __forceinline__ void oct(int row, int col, f32x4 v0, f32x4 v1, f32x4 p0, f32x4 p1) {
        const bool samp = row >= NP; const int rs = row - NP;
        const int pos = samp ? 4096 + (rs & 15) : (row & 4095);
        const int region = col >> 9;
        if (need_rope(col)) { v0 = rope_apply(v0, p0, col, pos, rope); v1 = rope_apply(v1, p1, col + 4, pos, rope); }
        st_bf8(PA + (size_t)row * NA + col, v0, v1);
        if (region == 1 || region == 2) {
            const int c = col & 511;
            if (!samp) { float* o = dout + (region == 1 ? OFF_DKP : OFF_DVP) + (size_t)row * 512 + c; __builtin_nontemporal_store(v0, (f32x4*)o); __builtin_nontemporal_store(v1, (f32x4*)(o + 4)); }
            else { float* o = dout + (region == 1 ? OFF_DKS : OFF_DVS) + (size_t)rs * 512 + c; *(f32x4*)o = v0; *(f32x4*)(o + 4) = v1;
                   st_bf8((region == 1 ? KS : VS) + ((size_t)(rs >> 4) * KSROWS + 4096 + (rs & 15)) * 512 + c, v0, v1); }
        }
    }
    __device__ __forceinline__ void quad(int row, int col, f32x4 v, f32x4 p) {
        const bool samp = row >= NP; const int rs = row - NP;
        const int pos = samp ? 4096 + (rs & 15) : (row & 4095);
        const int region = col >> 9;
        if (need_rope(col)) v = rope_apply(v, p, col, pos, rope);
        st_bf4(PA + (size_t)row * NA + col, v);
        if (region == 1 || region == 2) {
            const int c = col & 511;
            if (!samp) __builtin_nontemporal_store(v, (f32x4*)(dout + (region == 1 ? OFF_DKP : OFF_DVP) + (size_t)row * 512 + c));
            else { *(f32x4*)(dout + (region == 1 ? OFF_DKS : OFF_DVS) + (size_t)rs * 512 + c) = v;
                   st_bf4((region == 1 ? KS : VS) + ((size_t)(rs >> 4) * KSROWS + 4096 + (rs & 15)) * 512 + c, v); }
        }
    }
};
struct EpiMemF {
    static constexpr bool PRE8 = false; static constexpr bool ROPE = false, STATS = false; typedef NoPre Pre;
    bf16_t* MKV; float* dout; float s, q;
    __device__ __forceinline__ void row_begin(int, int) {}
    __device__ __forceinline__ Pre pre(int, int) const { return Pre{}; }
    __device__ __forceinline__ f32x4 fix(int, int, f32x4 v, const Pre&) const { return v; }
    __device__ __forceinline__ void commit(int, float, float) {}
    __device__ __forceinline__ void oct(int row, int col, f32x4 v0, f32x4 v1, f32x4, f32x4) {
        st_bf8(MKV + (size_t)row * 2048 + col, v0, v1);
        const int l = col >> 10, c = col & 1023;
        float* o = dout + (c < 512 ? OFF_MKP : OFF_MVP) + (size_t)l * 524288 + (size_t)row * 512 + (c & 511);
        __builtin_nontemporal_store(v0, (f32x4*)o); __builtin_nontemporal_store(v1, (f32x4*)(o + 4));
    }
    __device__ __forceinline__ void quad(int row, int col, f32x4 v, f32x4) {
        st_bf4(MKV + (size_t)row * 2048 + col, v);
        const int l = col >> 10, c = col & 1023;
        __builtin_nontemporal_store(v, (f32x4*)(dout + (c < 512 ? OFF_MKP : OFF_MVP) + (size_t)l * 524288 + (size_t)row * 512 + (c & 511)));
    }
};
struct EpiMerge0F {
    static constexpr bool PRE8 = true; static constexpr bool ROPE = false, STATS = true; typedef u32x2 Pre;
    bf16_t* ZB; float* ST; float s, q;
    __device__ __forceinline__ void row_begin(int, int) {}
    __device__ __forceinline__ Pre pre(int row, int col) const { return *(const u32x2*)(ZB + (size_t)row * DM + col); }
    __device__ __forceinline__ f32x4 fix(int, int, f32x4 v, const Pre& x) const { return (f32x4){bflo(x.x), bfhi(x.x), bflo(x.y), bfhi(x.y)} * DN_ALPHA + v; }
    __device__ __forceinline__ u32x4 pre8(int row, int col) const { return *(const u32x4*)(ZB + (size_t)row * DM + col); }
    __device__ __forceinline__ f32x4 fix8(int, int, f32x4 v, const u32x4& x, int n) const { const unsigned a = n ? x.z : x.x, b = n ? x.w : x.y; return (f32x4){bflo(a), bfhi(a), bflo(b), bfhi(b)} * DN_ALPHA + v; }
    __device__ __forceinline__ void commit(int row, float ss, float qq) { atomicAdd(ST + 2 * (size_t)row, ss); atomicAdd(ST + 2 * (size_t)row + 1, qq); }
    __device__ __forceinline__ void oct(int row, int col, f32x4 z0, f32x4 z1, f32x4, f32x4) {
        st_bf8(ZB + (size_t)row * DM + col, z0, z1);
        s += ((z0.x + z0.y) + (z0.z + z0.w)) + ((z1.x + z1.y) + (z1.z + z1.w));
        q += ((z0.x * z0.x + z0.y * z0.y) + (z0.z * z0.z + z0.w * z0.w)) + ((z1.x * z1.x + z1.y * z1.y) + (z1.z * z1.z + z1.w * z1.w));
    }
    __device__ __forceinline__ void quad(int row, int col, f32x4 z, f32x4) {
        st_bf4(ZB + (size_t)row * DM + col, z);
        s += (z.x + z.y) + (z.z + z.w); q += (z.x * z.x + z.y * z.y) + (z.z * z.z + z.w * z.w);
    }
};
struct EpiMerge1F {
    static constexpr bool PRE8 = true; static constexpr bool ROPE = false, STATS = true; typedef u32x2 Pre;
    const bf16_t* ZB; const float* ST0; const float* g0; const float* b0; bf16_t* out; float* ST1; float s, q, mu[2], rstd[2];
    __device__ __forceinline__ void row_begin(int sl, int row) { row_stats(ST0, row, mu[sl], rstd[sl]); }
    __device__ __forceinline__ Pre pre(int row, int col) const { return *(const u32x2*)(ZB + (size_t)row * DM + col); }
    __device__ __forceinline__ f32x4 fix(int sl, int col, f32x4 v, const Pre& z) const {
        const f32x4 z0 = (f32x4){bflo(z.x), bfhi(z.x), bflo(z.y), bfhi(z.y)};
        const f32x4 g = *(const f32x4*)(g0 + col), b = *(const f32x4*)(b0 + col); return ((z0 - mu[sl]) * rstd[sl] * g + b) * DN_ALPHA + v; }
    __device__ __forceinline__ u32x4 pre8(int row, int col) const { return *(const u32x4*)(ZB + (size_t)row * DM + col); }
    __device__ __forceinline__ f32x4 fix8(int sl, int col, f32x4 v, const u32x4& z, int n) const { const unsigned a = n ? z.z : z.x, b = n ? z.w : z.y;
        const f32x4 z0 = (f32x4){bflo(a), bfhi(a), bflo(b), bfhi(b)};
        const f32x4 g = *(const f32x4*)(g0 + col), bb = *(const f32x4*)(b0 + col); return ((z0 - mu[sl]) * rstd[sl] * g + bb) * DN_ALPHA + v; }
    __device__ __forceinline__ void commit(int row, float ss, float qq) { atomicAdd(ST1 + 2 * (size_t)row, ss); atomicAdd(ST1 + 2 * (size_t)row + 1, qq); }
    __device__ __forceinline__ void oct(int row, int col, f32x4 z0, f32x4 z1, f32x4, f32x4) {
        st_bf8(out + (size_t)row * DM + col, z0, z1);
        s += ((z0.x + z0.y) + (z0.z + z0.w)) + ((z1.x + z1.y) + (z1.z + z1.w));
        q += ((z0.x * z0.x + z0.y * z0.y) + (z0.z * z0.z + z0.w * z0.w)) + ((z1.x * z1.x + z1.y * z1.y) + (z1.z * z1.z + z1.w * z1.w));
    }
    __device__ __forceinline__ void quad(int row, int col, f32x4 z, f32x4) {
        st_bf4(out + (size_t)row * DM + col, z);
        s += (z.x + z.y) + (z.z + z.w); q += (z.x * z.x + z.y * z.y) + (z.z * z.z + z.w * z.w);
    }
};
struct PreB { f32x4 c, b; };
struct EpiBF {
    static constexpr bool PRE8 = false; static constexpr bool ROPE = true, STATS = false; typedef PreB Pre;
    bf16_t* PB; float* dout; bf16_t* KSW; bf16_t* VSW; const float* rope; const float* ST0; const float* CS; const float* BW; float s, q, mu[2], rstd[2];
    __device__ __forceinline__ void row_begin(int sl, int row) { row_stats(ST0, row, mu[sl], rstd[sl]); }
    __device__ __forceinline__ Pre pre(int, int col) const { Pre p; p.c = *(const f32x4*)(CS + col); p.b = *(const f32x4*)(BW + col); return p; }
    __device__ __forceinline__ f32x4 fix(int sl, int, f32x4 v, const Pre& p) const { return (v - p.c * mu[sl]) * rstd[sl] + p.b; }
    __device__ __forceinline__ bool need_rope(int col) const { return (col < 512 || (col >= 2048 && col < 2176)) && ((col >> 4) & 3) == 0; }
    __device__ __forceinline__ void commit(int, float, float) {}
    __device__ __forceinline__ void oct(int row, int col, f32x4 v0, f32x4 v1, f32x4 p0, f32x4 p1) {
        const bool samp = row >= NP; const int rs = row - NP;
        const int t = samp ? (rs & 15) : (row & 4095);
        const int pos = samp ? 4096 + t : t;
        const bool isk = col >= 2048 && col < 2176;
        if (need_rope(col)) { v0 = rope_apply(v0, p0, col, pos, rope); v1 = rope_apply(v1, p1, col + 4, pos, rope); }
        st_bf8(PB + (size_t)row * NB + col, v0, v1);
        if (col >= 2048) {
            const int cc = col & 127;
            if (!samp) { if (t >= 3968) { float* o = dout + (isk ? OFF_SKP : OFF_SVP) + ((size_t)(row >> 12) * 128 + (t - 3968)) * 128 + cc; *(f32x4*)o = v0; *(f32x4*)(o + 4) = v1; } }
            else { const int b = rs >> 4;
                   float* o = dout + (isk ? OFF_SKS : OFF_SVS) + ((size_t)b * 128 + 112 + t) * 128 + cc; *(f32x4*)o = v0; *(f32x4*)(o + 4) = v1;
                   st_bf8((isk ? KSW : VSW) + ((size_t)b * SWROWS + 128 + t) * 128 + cc, v0, v1); }
        }
    }
    __device__ __forceinline__ void quad(int row, int col, f32x4 v, f32x4 p) {
        const bool samp = row >= NP; const int rs = row - NP;
        const int t = samp ? (rs & 15) : (row & 4095);
        const int pos = samp ? 4096 + t : t;
        const bool isk = col >= 2048 && col < 2176;
        if (need_rope(col)) v = rope_apply(v, p, col, pos, rope);
        st_bf4(PB + (size_t)row * NB + col, v);
        if (col >= 2048) {
            const int cc = col & 127;
            if (!samp) { if (t >= 3968) *(f32x4*)(dout + (isk ? OFF_SKP : OFF_SVP) + ((size_t)(row >> 12) * 128 + (t - 3968)) * 128 + cc) = v; }
            else { const int b = rs >> 4;
                   *(f32x4*)(dout + (isk ? OFF_SKS : OFF_SVS) + ((size_t)b * 128 + 112 + t) * 128 + cc) = v;
                   st_bf4((isk ? KSW : VSW) + ((size_t)b * SWROWS + 128 + t) * 128 + cc, v); }
        }
    }
};
template <class F> __device__ __forceinline__ void gemm_small(LAS unsigned char* lds, const bf16_t* A, const bf16_t* Bt, int N, int rowbase, int ustart, int G, const F& f, int colbase = 0) {
    const int tid = threadIdx.x, lane = tid & 63, r32 = lane & 31, hi = lane >> 5, wid = __builtin_amdgcn_readfirstlane(tid >> 6);
    const int nu = 8 * (N / 32);
    for (int u = ustart; u < nu; u += G) {
        const int row0 = (u & 7) * 32, colw = (u >> 3) * 32, col0 = colbase + colw;
        const bf16_t* ap = A + (size_t)(row0 + r32) * DM + wid * 128 + hi * 8; const bf16_t* bp = Bt + (size_t)(colw + r32) * DM + wid * 128 + hi * 8;
        bf16x8 af[8], bfr[8];
#pragma unroll
        for (int k = 0; k < 8; ++k) { af[k] = *(const bf16x8*)(ap + 16 * k); bfr[k] = *(const bf16x8*)(bp + 16 * k); }
        f32x16 acc = f32x16{};
#pragma unroll
        for (int k = 0; k < 8; ++k) acc = __builtin_amdgcn_mfma_f32_32x32x16_bf16(bfr[k], af[k], acc, 0, 0, 0);
        LAS float* part = (LAS float*)lds + wid * 1024;
#pragma unroll
        for (int r = 0; r < 16; ++r) part[r * 64 + lane] = acc[r];
        __syncthreads();
        if (wid < 2) {
            F lf = f; f32x4 qd[2];
#pragma unroll
            for (int e = 0; e < 2; ++e) { float t[4];
#pragma unroll
                for (int c = 0; c < 4; ++c) { const int r = 4 * (2 * wid + e) + c; float a = 0.f;
#pragma unroll
                    for (int w = 0; w < 8; ++w) a += ((LAS float*)lds)[w * 1024 + r * 64 + lane];
                    t[c] = a; }
                qd[e] = (f32x4){t[0], t[1], t[2], t[3]}; }
            const int row = rowbase + row0 + r32; typename F::Pre pr[2];
            lf.row_begin(0, row);
#pragma unroll
            for (int e = 0; e < 2; ++e) pr[e] = lf.pre(row, col0 + 8 * (2 * wid + e) + 4 * hi);
#pragma unroll
            for (int e = 0; e < 2; ++e) qd[e] = lf.fix(0, col0 + 8 * (2 * wid + e) + 4 * hi, qd[e], pr[e]);
            lf.s = 0.f; lf.q = 0.f;
#pragma unroll
            for (int e = 0; e < 2; ++e) lf.quad(row, col0 + 8 * (2 * wid + e) + 4 * hi, qd[e], qd[e ^ 1]);
            if constexpr (F::STATS) { float s = lf.s, q = lf.q; s += __shfl_xor(s, 32); q += __shfl_xor(q, 32); if (hi == 0) lf.commit(row, s, q); }
        }
        __syncthreads();
    }
}

namespace att {
#define KSWZ(row, colB) ((row) * 256 + ((colB) ^ (((row) & 7) << 4)))
#define SBAR() __builtin_amdgcn_sched_barrier(0)
__device__ __forceinline__ int v_st(int k, int c) { const int kk = (k & ~0xC) | ((k & 4) << 1) | ((k & 8) >> 1); return ((kk >> 3) * 4 + (c >> 5)) * 512 + ((kk & 7) * 32 + (c & 31)) * 2; }
__device__ __forceinline__ int v_rd_base(int lane) { return ((lane & 3) << 3) | (((lane >> 2) & 3) << 6) | (((lane >> 4) & 1) << 5) | (((lane >> 5) & 1) << 8); }
constexpr int v_rd_off(int d0, int ks, int half) { return d0 * 512 + ks * 4096 + half * 2048; }
template <int OFF> __device__ __forceinline__ s16x4 tr_read(int vb) {
    s16x4 r; asm volatile("ds_read_b64_tr_b16 %0, %1 offset:%2" : "=&v"(r) : "v"(vb), "i"(OFF) : "memory"); return r;
}
template <int OFF> __device__ __forceinline__ bf16x8 lds_read128(int ad) {
    bf16x8 r; asm volatile("ds_read_b128 %0, %1 offset:%2" : "=&v"(r) : "v"(ad), "i"(OFF) : "memory"); return r;
}
template <int D0> __device__ __forceinline__ void pv_one(f32x16& od, int vb, bf16x8 pa0, bf16x8 pa1, bf16x8 pa2, bf16x8 pa3) {
    const s16x4 l0 = tr_read<v_rd_off(D0, 0, 0)>(vb), h0 = tr_read<v_rd_off(D0, 0, 1)>(vb), l1 = tr_read<v_rd_off(D0, 1, 0)>(vb), h1 = tr_read<v_rd_off(D0, 1, 1)>(vb);
    const s16x4 l2 = tr_read<v_rd_off(D0, 2, 0)>(vb), h2 = tr_read<v_rd_off(D0, 2, 1)>(vb), l3 = tr_read<v_rd_off(D0, 3, 0)>(vb), h3 = tr_read<v_rd_off(D0, 3, 1)>(vb);
    asm volatile("s_waitcnt lgkmcnt(0)" ::: "memory"); SBAR();
#define PK(L, H) (bf16x8){L[0], L[1], L[2], L[3], H[0], H[1], H[2], H[3]}
    od = __builtin_amdgcn_mfma_f32_32x32x16_bf16(PK(l0, h0), pa0, od, 0, 0, 0);
    od = __builtin_amdgcn_mfma_f32_32x32x16_bf16(PK(l1, h1), pa1, od, 0, 0, 0);
    od = __builtin_amdgcn_mfma_f32_32x32x16_bf16(PK(l2, h2), pa2, od, 0, 0, 0);
    od = __builtin_amdgcn_mfma_f32_32x32x16_bf16(PK(l3, h3), pa3, od, 0, 0, 0);
#undef PK
}
template <int KSI, int DB, int ND> __device__ __forceinline__ void v_read(int vb, s16x4 (&l)[4], s16x4 (&h)[4]) {
    l[0] = tr_read<v_rd_off(DB, KSI, 0)>(vb); h[0] = tr_read<v_rd_off(DB, KSI, 1)>(vb);
    l[1] = tr_read<v_rd_off(DB + 1, KSI, 0)>(vb); h[1] = tr_read<v_rd_off(DB + 1, KSI, 1)>(vb);
    if constexpr (ND == 4) { l[2] = tr_read<v_rd_off(DB + 2, KSI, 0)>(vb); h[2] = tr_read<v_rd_off(DB + 2, KSI, 1)>(vb);
                             l[3] = tr_read<v_rd_off(DB + 3, KSI, 0)>(vb); h[3] = tr_read<v_rd_off(DB + 3, KSI, 1)>(vb); }
}
template <int ND> __device__ __forceinline__ void pv_mf(f32x16 (&o)[4], bf16x8 pa, const s16x4 (&l)[4], const s16x4 (&h)[4]) {
    __builtin_amdgcn_s_setprio(1);
#pragma unroll
    for (int d = 0; d < ND; ++d) o[d] = __builtin_amdgcn_mfma_f32_32x32x16_bf16((bf16x8){l[d][0], l[d][1], l[d][2], l[d][3], h[d][0], h[d][1], h[d][2], h[d][3]}, pa, o[d], 0, 0, 0);
    __builtin_amdgcn_s_setprio(0);
}
template <int DB, int ND> __device__ __forceinline__ void pv_ks(f32x16 (&o)[4], int vb, bf16x8 pa0, bf16x8 pa1, bf16x8 pa2, bf16x8 pa3) {
    s16x4 la[4], ha[4];
    v_read<0, DB, ND>(vb, la, ha); asm volatile("s_waitcnt lgkmcnt(0)" ::: "memory"); SBAR(); pv_mf<ND>(o, pa0, la, ha); SBAR();
    v_read<1, DB, ND>(vb, la, ha); asm volatile("s_waitcnt lgkmcnt(0)" ::: "memory"); SBAR(); pv_mf<ND>(o, pa1, la, ha); SBAR();
    v_read<2, DB, ND>(vb, la, ha); asm volatile("s_waitcnt lgkmcnt(0)" ::: "memory"); SBAR(); pv_mf<ND>(o, pa2, la, ha); SBAR();
    v_read<3, DB, ND>(vb, la, ha); asm volatile("s_waitcnt lgkmcnt(0)" ::: "memory"); SBAR(); pv_mf<ND>(o, pa3, la, ha);
}
template <int DB, int ND> __device__ __forceinline__ void pv_rest(f32x16 (&o)[4], int vb, bf16x8 pa0, bf16x8 pa1, bf16x8 pa2, bf16x8 pa3, s16x4 (&la)[4], s16x4 (&ha)[4]) {
    s16x4 lb[4], hb[4];
    asm volatile("s_waitcnt lgkmcnt(0)" ::: "memory"); SBAR(); v_read<1, DB, ND>(vb, lb, hb); SBAR(); pv_mf<ND>(o, pa0, la, ha); SBAR();
    asm volatile("s_waitcnt lgkmcnt(0)" ::: "memory"); SBAR(); v_read<2, DB, ND>(vb, la, ha); SBAR(); pv_mf<ND>(o, pa1, lb, hb); SBAR();
    asm volatile("s_waitcnt lgkmcnt(0)" ::: "memory"); SBAR(); v_read<3, DB, ND>(vb, lb, hb); SBAR(); pv_mf<ND>(o, pa2, la, ha); SBAR();
    asm volatile("s_waitcnt lgkmcnt(0)" ::: "memory"); SBAR(); pv_mf<ND>(o, pa3, lb, hb);
}
__device__ __forceinline__ void partialSM(f32x16& p0, f32x16& p1, float& m_reg, float& alpha, float C, float thr) {
    float pmax = p0[0];
#pragma unroll
    for (int r = 1; r < 16; ++r) pmax = fmaxf(pmax, p0[r]);
#pragma unroll
    for (int r = 0; r < 16; ++r) pmax = fmaxf(pmax, p1[r]);
    { auto rr = __builtin_amdgcn_permlane32_swap(__float_as_uint(pmax), __float_as_uint(pmax), false, false);
      pmax = fmaxf(__uint_as_float(rr[0]), __uint_as_float(rr[1])); }
    float mn;
    if (__all(pmax - m_reg <= thr)) { mn = m_reg; alpha = 1.f; }
    else { mn = fmaxf(m_reg, pmax); alpha = __builtin_amdgcn_exp2f((m_reg - mn) * C); m_reg = mn; }
    const float mnC = -mn * C;
#pragma unroll
    for (int r = 0; r < 16; ++r) p0[r] = __builtin_amdgcn_exp2f(fmaf(p0[r], C, mnC));
#pragma unroll
    for (int r = 0; r < 16; ++r) p1[r] = __builtin_amdgcn_exp2f(fmaf(p1[r], C, mnC));
}
__device__ __forceinline__ void finishSM(f32x16& p0, f32x16& p1, float alpha, float& l_reg, bf16x8& pa0, bf16x8& pa1, bf16x8& pa2, bf16x8& pa3) {
    float ps = 0;
#pragma unroll
    for (int r = 0; r < 16; ++r) ps += p0[r];
#pragma unroll
    for (int r = 0; r < 16; ++r) ps += p1[r];
    { auto rr = __builtin_amdgcn_permlane32_swap(__float_as_uint(ps), __float_as_uint(ps), false, false);
      ps = __uint_as_float(rr[0]) + __uint_as_float(rr[1]); }
    l_reg = l_reg * alpha + ps;
#define PK4(P, BASE, OUT) do { unsigned a0 = cvtpk(P[BASE + 0], P[BASE + 1]), a1 = cvtpk(P[BASE + 2], P[BASE + 3]);   \
    unsigned b0 = cvtpk(P[BASE + 4], P[BASE + 5]), b1 = cvtpk(P[BASE + 6], P[BASE + 7]);                              \
    auto r0 = __builtin_amdgcn_permlane32_swap(a0, b0, false, false); auto r1 = __builtin_amdgcn_permlane32_swap(a1, b1, false, false); \
    u32x4 w = {r0[0], r1[0], r0[1], r1[1]}; OUT = *reinterpret_cast<bf16x8*>(&w); } while (0)
    PK4(p0, 0, pa0); PK4(p0, 8, pa1); PK4(p1, 0, pa2); PK4(p1, 8, pa3);
#undef PK4
}
constexpr int RING = 32768;
template <int QS, bool PVHALF>
__device__ __forceinline__ void attn_core(LAS unsigned char* lds, const bf16_t* Kb, long ldk, const bf16_t* Vb, long ldv, int NT, int nkeys,
                                          const bf16_t* qptr, int wNT, int kcoffB, int pvsel, float C, float thr, f32x16 (&o)[4], float& m_reg, float& l_reg) {
    int tid = threadIdx.x; asm volatile("" : "+v"(tid));
    const int lane = tid & 63, r32 = lane & 31, hi = lane >> 5, wid = __builtin_amdgcn_readfirstlane(tid >> 6);
    bf16x8 qr[QS];
#pragma unroll
    for (int d0 = 0; d0 < QS; ++d0) qr[d0] = *(const bf16x8*)(qptr + d0 * 16);
#pragma unroll
    for (int d = 0; d < 4; ++d) o[d] = f32x16{};
    m_reg = -1e30f; l_reg = 0.f;
    long offK[2], offV[2];
#pragma unroll
    for (int i = 0; i < 2; ++i) { const int p = i * 8192 + wid * 1024 + lane * 16;
        const int row = p >> 8, colB = (p & 255) ^ ((row & 7) << 4); offK[i] = (long)row * ldk + (colB >> 1);
        const int sub = p >> 9, q = (p & 511) >> 1, kk = (sub >> 2) * 8 + (q >> 5), k = (kk & ~0xC) | ((kk & 4) << 1) | ((kk & 8) >> 1), c = (sub & 3) * 32 + (q & 31);
        offV[i] = (long)k * ldv + c; }
    const int vrb = v_rd_base(lane);
#define GLDS(t, bf) do { const bf16_t* kt_ = Kb + (long)(t) * 64 * ldk; const bf16_t* vt_ = Vb + (long)(t) * 64 * ldv; LAS unsigned char* b_ = lds + (bf) * RING + wid * 1024; \
    __builtin_amdgcn_global_load_lds((const unsigned*)(vt_ + offV[0]), (LAS unsigned*)(b_), 16, 0, 0); \
    __builtin_amdgcn_global_load_lds((const unsigned*)(vt_ + offV[1]), (LAS unsigned*)(b_ + 8192), 16, 0, 0); \
    __builtin_amdgcn_global_load_lds((const unsigned*)(kt_ + offK[0]), (LAS unsigned*)(b_ + 16384), 16, 0, 0); \
    __builtin_amdgcn_global_load_lds((const unsigned*)(kt_ + offK[1]), (LAS unsigned*)(b_ + 16384 + 8192), 16, 0, 0); } while (0)
    GLDS(0, 0);
#pragma unroll
    for (int d0 = 0; d0 < QS; ++d0) asm volatile("" :: "v"(qr[d0]));
    if (1 < NT) GLDS(1, 1); if (2 < NT) GLDS(2, 2);
    for (int j = 0; j < NT; ++j) {
        const int rem = NT - 1 - j;
        if (rem >= 2) asm volatile("s_waitcnt vmcnt(8)" ::: "memory"); else if (rem == 1) asm volatile("s_waitcnt vmcnt(4)" ::: "memory"); else asm volatile("s_waitcnt vmcnt(0)" ::: "memory");
        __builtin_amdgcn_s_barrier();
        asm volatile("" ::: "memory");
        if (j + 3 < NT) GLDS(j + 3, (j + 3) & 3);
        if (j < wNT) {
            const int cur = j & 3;
            f32x16 p0 = f32x16{}, p1 = f32x16{};
            const int kbase = (int)(uintptr_t)(lds + cur * RING + 16384) + r32 * 256;
            const int swz = (r32 & 7) << 4;
#pragma unroll
            for (int hq = 0; hq < QS / 4; ++hq) { bf16x8 b0[4], b1[4];
#pragma unroll
                for (int i = 0; i < 4; ++i) { const int cb = kcoffB + ((hq * 4 + i) * 16 + hi * 8) * 2; const int ad = kbase + (cb ^ swz);
                    b0[i] = lds_read128<0>(ad); b1[i] = lds_read128<8192>(ad); }
                asm volatile("s_waitcnt lgkmcnt(0)" ::: "memory"); SBAR();
#pragma unroll
                for (int i = 0; i < 4; ++i) { p0 = __builtin_amdgcn_mfma_f32_32x32x16_bf16(b0[i], qr[hq * 4 + i], p0, 0, 0, 0);
                    p1 = __builtin_amdgcn_mfma_f32_32x32x16_bf16(b1[i], qr[hq * 4 + i], p1, 0, 0, 0); } }
            if (__builtin_expect((j + 1) * 64 > nkeys, 0)) { const int kb = j * 64 + 4 * hi; asm volatile("" ::: "memory");
#pragma unroll
                for (int r = 0; r < 16; ++r) { const int kv = kb + (r & 3) + 8 * (r >> 2); if (kv >= nkeys) p0[r] = -1e30f; if (kv + 32 >= nkeys) p1[r] = -1e30f; } }
            float alpha; bf16x8 pa0, pa1, pa2, pa3;
            const int vb = (int)(uintptr_t)(lds + cur * RING) + vrb;
            s16x4 la[4], ha[4];
            partialSM(p0, p1, m_reg, alpha, C, thr);
            finishSM(p0, p1, alpha, l_reg, pa0, pa1, pa2, pa3);
            SBAR();
            if constexpr (QS == 4) { if constexpr (!PVHALF) v_read<0, 0, 4>(vb, la, ha); else { if (pvsel == 0) v_read<0, 0, 2>(vb, la, ha); else v_read<0, 2, 2>(vb, la, ha); } }
            SBAR();
            if (__any(alpha < 1.f)) {
#pragma unroll
                for (int d = 0; d < (PVHALF ? 2 : 4); ++d)
#pragma unroll
                    for (int r = 0; r < 16; ++r) o[d][r] *= alpha; }
            if constexpr (QS == 8) { pv_one<0>(o[0], vb, pa0, pa1, pa2, pa3); pv_one<1>(o[1], vb, pa0, pa1, pa2, pa3); pv_one<2>(o[2], vb, pa0, pa1, pa2, pa3); pv_one<3>(o[3], vb, pa0, pa1, pa2, pa3); }
            else if constexpr (!PVHALF) pv_rest<0, 4>(o, vb, pa0, pa1, pa2, pa3, la, ha);
            else { if (pvsel == 0) pv_rest<0, 2>(o, vb, pa0, pa1, pa2, pa3, la, ha); else pv_rest<2, 2>(o, vb, pa0, pa1, pa2, pa3, la, ha); }
        }
    }
#undef GLDS
    __syncthreads();
}

template <bool PVHALF>
__device__ __forceinline__ void attn_core_pipe(LAS unsigned char* lds, const bf16_t* Kb, long ldk, const bf16_t* Vb, long ldv, int NT, int nkeys,
                                               const bf16_t* qptr, int wNT, int kcoffB, int pvsel, float C, float thr, f32x16 (&o)[4], float& m_reg, float& l_reg) {
    int tid = threadIdx.x; asm volatile("" : "+v"(tid));
    const int lane = tid & 63, r32 = lane & 31, hi = lane >> 5, wid = __builtin_amdgcn_readfirstlane(tid >> 6);
    bf16x8 qr[4];
#pragma unroll
    for (int d0 = 0; d0 < 4; ++d0) qr[d0] = *(const bf16x8*)(qptr + d0 * 16);
#pragma unroll
    for (int d = 0; d < 4; ++d) o[d] = f32x16{};
    m_reg = -1e30f; l_reg = 0.f;
    int offK[2], offV[2];
#pragma unroll
    for (int i = 0; i < 2; ++i) { const int p = i * 8192 + wid * 1024 + lane * 16;
        const int row = p >> 8, colB = (p & 255) ^ ((row & 7) << 4); offK[i] = row * (int)ldk + (colB >> 1);
        const int sub = p >> 9, q = (p & 511) >> 1, kk = (sub >> 2) * 8 + (q >> 5), k = (kk & ~0xC) | ((kk & 4) << 1) | ((kk & 8) >> 1), c = (sub & 3) * 32 + (q & 31);
        offV[i] = k * (int)ldv + c; }
    const int vrb = v_rd_base(lane);
    int kad[4];
#pragma unroll
    for (int i = 0; i < 4; ++i) kad[i] = 16384 + r32 * 256 + ((kcoffB + (i * 16 + hi * 8) * 2) ^ ((r32 & 7) << 4));
    const int lds0 = (int)(uintptr_t)lds;
#define GLDS_V(t, bf) do { const bf16_t* vt_ = Vb + (long)(t) * 64 * ldv; LAS unsigned char* b_ = lds + (bf) * RING + wid * 1024; \
    __builtin_amdgcn_global_load_lds((const unsigned*)(vt_ + offV[0]), (LAS unsigned*)(b_), 16, 0, 0); \
    __builtin_amdgcn_global_load_lds((const unsigned*)(vt_ + offV[1]), (LAS unsigned*)(b_ + 8192), 16, 0, 0); } while (0)
#define GLDS_K(t, bf) do { const bf16_t* kt_ = Kb + (long)(t) * 64 * ldk; LAS unsigned char* b_ = lds + (bf) * RING + wid * 1024; \
    __builtin_amdgcn_global_load_lds((const unsigned*)(kt_ + offK[0]), (LAS unsigned*)(b_ + 16384), 16, 0, 0); \
    __builtin_amdgcn_global_load_lds((const unsigned*)(kt_ + offK[1]), (LAS unsigned*)(b_ + 16384 + 8192), 16, 0, 0); } while (0)
#define GLDS(t, bf) do { GLDS_V(t, bf); GLDS_K(t, bf); } while (0)
#define QK(P0, P1, bf) do { const int kb_ = lds0 + (bf) * RING; bf16x8 b0_[2], b1_[2]; \
    _Pragma("unroll") for (int i_ = 0; i_ < 2; ++i_) { b0_[i_] = lds_read128<0>(kb_ + kad[i_]); b1_[i_] = lds_read128<8192>(kb_ + kad[i_]); } \
    asm volatile("s_waitcnt lgkmcnt(0)" ::: "memory"); SBAR(); \
    P0 = __builtin_amdgcn_mfma_f32_32x32x16_bf16(b0_[0], qr[0], f32x16{}, 0, 0, 0); P1 = __builtin_amdgcn_mfma_f32_32x32x16_bf16(b1_[0], qr[0], f32x16{}, 0, 0, 0); \
    P0 = __builtin_amdgcn_mfma_f32_32x32x16_bf16(b0_[1], qr[1], P0, 0, 0, 0); P1 = __builtin_amdgcn_mfma_f32_32x32x16_bf16(b1_[1], qr[1], P1, 0, 0, 0); SBAR(); \
    _Pragma("unroll") for (int i_ = 0; i_ < 2; ++i_) { b0_[i_] = lds_read128<0>(kb_ + kad[2 + i_]); b1_[i_] = lds_read128<8192>(kb_ + kad[2 + i_]); } \
    asm volatile("s_waitcnt lgkmcnt(0)" ::: "memory"); SBAR(); \
    P0 = __builtin_amdgcn_mfma_f32_32x32x16_bf16(b0_[0], qr[2], P0, 0, 0, 0); P1 = __builtin_amdgcn_mfma_f32_32x32x16_bf16(b1_[0], qr[2], P1, 0, 0, 0); \
    P0 = __builtin_amdgcn_mfma_f32_32x32x16_bf16(b0_[1], qr[3], P0, 0, 0, 0); P1 = __builtin_amdgcn_mfma_f32_32x32x16_bf16(b1_[1], qr[3], P1, 0, 0, 0); \
    SBAR(); } while (0)
#define STEP(C0, C1, N0, N1, j) do { \
    if ((j) + 1 < NT) { \
        if ((j) + 2 < NT) asm volatile("s_waitcnt vmcnt(4)" ::: "memory"); else asm volatile("s_waitcnt vmcnt(0)" ::: "memory"); \
        __builtin_amdgcn_s_barrier(); asm volatile("" ::: "memory"); \
        if ((j) + 1 < wNT) QK(N0, N1, ((j) + 1) & 3); } \
    const bool iss_ = (j) + 3 < NT;                                 \
    if ((j) < wNT) { \
        if (__builtin_expect(((j) + 1) * 64 > nkeys, 0)) { const int kb = (j) * 64 + 4 * hi; asm volatile("" ::: "memory"); \
            _Pragma("unroll") for (int r = 0; r < 16; ++r) { const int kv = kb + (r & 3) + 8 * (r >> 2); if (kv >= nkeys) C0[r] = -1e30f; if (kv + 32 >= nkeys) C1[r] = -1e30f; } } \
        float alpha; bf16x8 pa0, pa1, pa2, pa3; const int vb = lds0 + ((j) & 3) * RING + vrb; \
        partialSM(C0, C1, m_reg, alpha, C, thr); \
        SBAR(); if (iss_) GLDS_V((j) + 3, ((j) + 3) & 3); SBAR(); \
        finishSM(C0, C1, alpha, l_reg, pa0, pa1, pa2, pa3); \
        SBAR(); if (iss_) GLDS_K((j) + 3, ((j) + 3) & 3); SBAR(); \
        if (__any(alpha < 1.f)) { \
            _Pragma("unroll") for (int d = 0; d < (PVHALF ? 2 : 4); ++d) _Pragma("unroll") for (int r = 0; r < 16; ++r) o[d][r] *= alpha; } \
        if constexpr (!PVHALF) pv_ks<0, 4>(o, vb, pa0, pa1, pa2, pa3); \
        else { if (pvsel == 0) pv_ks<0, 2>(o, vb, pa0, pa1, pa2, pa3); else pv_ks<2, 2>(o, vb, pa0, pa1, pa2, pa3); } } \
    else if (iss_) GLDS((j) + 3, ((j) + 3) & 3); \
    } while (0)
    GLDS(0, 0);
#pragma unroll
    for (int d0 = 0; d0 < 4; ++d0) asm volatile("" :: "v"(qr[d0]));
    if (1 < NT) GLDS(1, 1); if (2 < NT) GLDS(2, 2);
    if (NT > 2) asm volatile("s_waitcnt vmcnt(8)" ::: "memory"); else if (NT == 2) asm volatile("s_waitcnt vmcnt(4)" ::: "memory"); else asm volatile("s_waitcnt vmcnt(0)" ::: "memory");
    __builtin_amdgcn_s_barrier(); asm volatile("" ::: "memory");
    f32x16 pA0 = f32x16{}, pA1 = f32x16{}, pB0 = f32x16{}, pB1 = f32x16{};
    if (0 < wNT) QK(pA0, pA1, 0);
    for (int j = 0; j < NT; j += 2) {
        STEP(pA0, pA1, pB0, pB1, j);
        if (j + 1 < NT) STEP(pB0, pB1, pA0, pA1, j + 1);
    }
#undef STEP
#undef QK
#undef GLDS
#undef GLDS_V
#undef GLDS_K
    __syncthreads();
}

struct Ctx { LAS unsigned char* lds; int lane, wid, r32, hi; };

template <int ND> __device__ __forceinline__ void stage_piece(LAS unsigned char* stg, int lane, int d, int g, f32x4 v) {
    u32x2 w; w.x = cvtpk(v.x, v.y); w.y = cvtpk(v.z, v.w);
    *(LAS u32x2*)(stg + (lane & 31) * (64 * ND + 16) + (32 * d + 8 * g + 4 * (lane >> 5)) * 2) = w;
}
template <int ND> __device__ __forceinline__ void flush_rows(LAS unsigned char* stg, int lane, bf16_t* out_tile, int nvalid) {
    asm volatile("s_waitcnt lgkmcnt(0)" ::: "memory");
#pragma unroll
    for (int i = 0; i < 2 * ND; ++i) { const int c = i * 64 + lane, row = c / (4 * ND), ch = c % (4 * ND);
        const u32x4 w = *(const LAS u32x4*)(stg + row * (64 * ND + 16) + ch * 16);
        if (row < nvalid) *(u32x4*)(out_tile + (size_t)row * DM + ch * 8) = w; }
}
template <int ND> __device__ __forceinline__ void store_gated(const f32x16 (&o)[4], float scale, const bf16_t* gate, bf16_t* out_tile, int nvalid, LAS unsigned char* stg, int lane) {
    asm volatile("" : "+v"(lane));
    const int hi = lane >> 5;
#pragma unroll
    for (int d = 0; d < ND; ++d)
#pragma unroll
        for (int g = 0; g < 4; ++g) { const int dv = 32 * d + 8 * g + 4 * hi;
            const u32x2 gt = *(const u32x2*)(gate + dv);
            f32x4 v; v.x = o[d][4 * g] * scale * silu(bflo(gt.x)); v.y = o[d][4 * g + 1] * scale * silu(bfhi(gt.x));
            v.z = o[d][4 * g + 2] * scale * silu(bflo(gt.y)); v.w = o[d][4 * g + 3] * scale * silu(bfhi(gt.y));
            stage_piece<ND>(stg, lane, d, g, v); asm volatile("" ::: "memory"); }
    flush_rows<ND>(stg, lane, out_tile, nvalid);
}

__device__ __forceinline__ void diff_unit(const Ctx& cx, bool samp, int b, int h, int qb, const bf16_t* PA, const bf16_t* KS, const bf16_t* VS, bf16_t* MIX, const float* gnorm, float lam) {
    const int c = cx.wid >> 2, rb = cx.wid & 3;
    long row; bool valid; int NT, wNT, nkeys; const bf16_t* Kb; const bf16_t* Vb; long ldk;
    if (!samp) { row = (long)b * 4096 + qb * 128 + rb * 32 + cx.r32; valid = true; NT = 2 * qb + 2; wNT = 2 * qb + 1 + (rb >> 1); nkeys = NT * 64;
                 Kb = PA + (size_t)b * 4096 * NA + 512 + h * 128; Vb = Kb + 512; ldk = NA; }
    else { row = NP + b * 16 + (cx.r32 < 15 ? cx.r32 : 15); valid = (rb == 0) && cx.r32 < 16; NT = 65; wNT = (rb == 0) ? 65 : 0; nkeys = 4112;
           Kb = KS + (size_t)b * KSROWS * 512 + h * 128; Vb = VS + (size_t)b * KSROWS * 512 + h * 128; ldk = 512; }
    const bf16_t* qptr = PA + (size_t)row * NA + h * 128 + c * 64 + cx.hi * 8;
    f32x16 o[4]; float m, l;
    attn_core_pipe<false>(cx.lds, Kb, ldk, Vb, ldk, NT, nkeys, qptr, wNT, c * 128, 0, C64, THR64, o, m, l);
    const float inv = l > 0.f ? 1.f / l : 0.f;
    LAS float* xch = (LAS float*)cx.lds + rb * 4096;
    if (c == 1) {
#pragma unroll
        for (int d = 0; d < 4; ++d)
#pragma unroll
            for (int r = 0; r < 16; ++r) xch[(d * 16 + r) * 64 + cx.lane] = o[d][r] * inv; }
    __syncthreads();
    if (c == 0) {
        float ss = 0.f;
#pragma unroll
        for (int d = 0; d < 4; ++d)
#pragma unroll
            for (int r = 0; r < 16; ++r) { const float od = o[d][r] * inv - lam * xch[(d * 16 + r) * 64 + cx.lane]; o[d][r] = od; ss += od * od; }
        ss += __shfl_xor(ss, 32);
        const float rms = rsqrtf(ss * (1.f / 128.f) + 1e-5f) * 0.8f;
        {
            const bf16_t* gate = PA + (size_t)row * NA + 1536 + h * 128; LAS unsigned char* stg = cx.lds + 65536 + cx.wid * 9216;
            int ln = cx.lane; asm volatile("" : "+v"(ln));
#pragma unroll
            for (int d = 0; d < 4; ++d)
#pragma unroll
                for (int g = 0; g < 4; ++g) { const int dv = 32 * d + 8 * g + 4 * cx.hi;
                    const f32x4 gn = *(const f32x4*)(gnorm + dv); const u32x2 gt = *(const u32x2*)(gate + dv);
                    f32x4 v; v.x = o[d][4 * g] * rms * gn.x * silu(bflo(gt.x)); v.y = o[d][4 * g + 1] * rms * gn.y * silu(bfhi(gt.x));
                    v.z = o[d][4 * g + 2] * rms * gn.z * silu(bflo(gt.y)); v.w = o[d][4 * g + 3] * rms * gn.w * silu(bfhi(gt.y));
                    stage_piece<4>(stg, ln, d, g, v); asm volatile("" ::: "memory"); }
            flush_rows<4>(stg, ln, MIX + (size_t)(row - cx.r32) * DM + h * 128, valid ? 32 : 0);
        }
    }
    __syncthreads();
}
__device__ __forceinline__ void diff_sample_item(const Ctx& cx, int b, int h, int sp, const float* CK, const float* CV, const bf16_t* PA, const bf16_t* KS, const bf16_t* VS,
                                                 bf16_t* MIX, const float* gnorm, float lam, float* PART, unsigned* cnt, volatile LAS unsigned* MISC) {
    int tid = threadIdx.x; asm volatile("" : "+v"(tid));
    const int lane = tid & 63, r32 = lane & 31, hi = lane >> 5, wid = __builtin_amdgcn_readfirstlane(tid >> 6);
    const int c = wid >> 2; const bool active = (wid & 3) == 0;
    const size_t row = NP + b * 16 + (r32 < 15 ? r32 : 15);
    bf16x8 qr[4];
    { const bf16_t* qptr = PA + row * NA + h * 128 + c * 64 + hi * 8;
#pragma unroll
      for (int d0 = 0; d0 < 4; ++d0) qr[d0] = *(const bf16x8*)(qptr + d0 * 16); }
    f32x16 o[4];
#pragma unroll
    for (int d = 0; d < 4; ++d) o[d] = f32x16{};
    float m_reg = -1e30f, l_reg = 0.f;
    const int ntl = 16 + (sp == 3 ? 1 : 0);
    const int sr = tid >> 4, sc = (tid & 15) * 8;
    const float* kg = CK + ((size_t)(b * 4096 + sp * 1024 + sr) * 4 + h) * 128 + sc;
    const float* vg = CV + ((size_t)(b * 4096 + sp * 1024 + sr) * 4 + h) * 128 + sc;
    const bf16_t* kn = KS + ((size_t)b * KSROWS + 4096 + sr) * 512 + h * 128 + sc;
    const bf16_t* vn = VS + ((size_t)b * KSROWS + 4096 + sr) * 512 + h * 128 + sc;
    const int vst0 = v_st(sr, sc), vst1 = v_st(32 + sr, sc), kst0 = 16384 + KSWZ(sr, sc * 2), kst1 = 16384 + KSWZ(32 + sr, sc * 2);
    int kad[4];
#pragma unroll
    for (int i = 0; i < 4; ++i) kad[i] = 16384 + r32 * 256 + ((c * 128 + (i * 16 + hi * 8) * 2) ^ ((r32 & 7) << 4));
    const int lds0 = (int)(uintptr_t)cx.lds, vrb = v_rd_base(lane);
    f32x4 kfA[4], vfA[4], kfB[4], vfB[4];
#define LOADT(t, kf, vf) do { if ((t) < 16) { const float* kp_ = kg + (size_t)(t) * 64 * 512; const float* vp_ = vg + (size_t)(t) * 64 * 512; \
        kf[0] = __builtin_nontemporal_load((const f32x4*)kp_); kf[1] = __builtin_nontemporal_load((const f32x4*)(kp_ + 4)); kf[2] = __builtin_nontemporal_load((const f32x4*)(kp_ + 32 * 512)); kf[3] = __builtin_nontemporal_load((const f32x4*)(kp_ + 32 * 512 + 4)); \
        vf[0] = __builtin_nontemporal_load((const f32x4*)vp_); vf[1] = __builtin_nontemporal_load((const f32x4*)(vp_ + 4)); vf[2] = __builtin_nontemporal_load((const f32x4*)(vp_ + 32 * 512)); vf[3] = __builtin_nontemporal_load((const f32x4*)(vp_ + 32 * 512 + 4)); } \
    else { kf[0] = *(const f32x4*)kn; kf[2] = *(const f32x4*)(kn + 32 * 512); vf[0] = *(const f32x4*)vn; vf[2] = *(const f32x4*)(vn + 32 * 512); } } while (0)
#define CV8(A, B) ((u32x4){cvtpk(A.x, A.y), cvtpk(A.z, A.w), cvtpk(B.x, B.y), cvtpk(B.z, B.w)})
#define WRITET(t, bf, kf, vf) do { u32x4 k0_, k1_, v0_, v1_; \
    if ((t) < 16) { k0_ = CV8(kf[0], kf[1]); k1_ = CV8(kf[2], kf[3]); v0_ = CV8(vf[0], vf[1]); v1_ = CV8(vf[2], vf[3]); } \
    else { k0_ = __builtin_bit_cast(u32x4, kf[0]); k1_ = __builtin_bit_cast(u32x4, kf[2]); v0_ = __builtin_bit_cast(u32x4, vf[0]); v1_ = __builtin_bit_cast(u32x4, vf[2]); } \
    LAS unsigned char* b_ = cx.lds + (bf) * RING; \
    *(LAS u32x4*)(b_ + vst0) = v0_; *(LAS u32x4*)(b_ + vst1) = v1_; *(LAS u32x4*)(b_ + kst0) = k0_; *(LAS u32x4*)(b_ + kst1) = k1_; } while (0)
#define SCORE(t, cur) do { if (active) { \
            f32x16 p0, p1; \
            { const int kb_ = lds0 + (cur) * RING; bf16x8 b0_[2], b1_[2]; \
              _Pragma("unroll") for (int i = 0; i < 2; ++i) { b0_[i] = lds_read128<0>(kb_ + kad[i]); b1_[i] = lds_read128<8192>(kb_ + kad[i]); } \
              asm volatile("s_waitcnt lgkmcnt(0)" ::: "memory"); SBAR(); \
              p0 = __builtin_amdgcn_mfma_f32_32x32x16_bf16(b0_[0], qr[0], f32x16{}, 0, 0, 0); p1 = __builtin_amdgcn_mfma_f32_32x32x16_bf16(b1_[0], qr[0], f32x16{}, 0, 0, 0); \
              p0 = __builtin_amdgcn_mfma_f32_32x32x16_bf16(b0_[1], qr[1], p0, 0, 0, 0); p1 = __builtin_amdgcn_mfma_f32_32x32x16_bf16(b1_[1], qr[1], p1, 0, 0, 0); SBAR(); \
              _Pragma("unroll") for (int i = 0; i < 2; ++i) { b0_[i] = lds_read128<0>(kb_ + kad[2 + i]); b1_[i] = lds_read128<8192>(kb_ + kad[2 + i]); } \
              asm volatile("s_waitcnt lgkmcnt(0)" ::: "memory"); SBAR(); \
              p0 = __builtin_amdgcn_mfma_f32_32x32x16_bf16(b0_[0], qr[2], p0, 0, 0, 0); p1 = __builtin_amdgcn_mfma_f32_32x32x16_bf16(b1_[0], qr[2], p1, 0, 0, 0); \
              p0 = __builtin_amdgcn_mfma_f32_32x32x16_bf16(b0_[1], qr[3], p0, 0, 0, 0); p1 = __builtin_amdgcn_mfma_f32_32x32x16_bf16(b1_[1], qr[3], p1, 0, 0, 0); } \
            if ((t) >= 16) { \
                _Pragma("unroll") for (int r = 0; r < 16; ++r) { const int kv = 4 * hi + (r & 3) + 8 * (r >> 2); if (kv >= 16) p0[r] = -1e30f; p1[r] = -1e30f; } } \
            float alpha; bf16x8 pa0, pa1, pa2, pa3; \
            partialSM(p0, p1, m_reg, alpha, C64, THR64); \
            finishSM(p0, p1, alpha, l_reg, pa0, pa1, pa2, pa3); \
            SBAR(); \
            if (__any(alpha < 1.f)) { \
                _Pragma("unroll") for (int d = 0; d < 4; ++d) _Pragma("unroll") for (int r = 0; r < 16; ++r) o[d][r] *= alpha; } \
            pv_ks<0, 4>(o, lds0 + (cur) * RING + vrb, pa0, pa1, pa2, pa3); } } while (0)
    LOADT(0, kfA, vfA); LOADT(1, kfB, vfB); WRITET(0, 0, kfA, vfA); __syncthreads();
    for (int t = 0; t < ntl; t += 2) {
        if (t + 2 < ntl) LOADT(t + 2, kfA, vfA);
        SCORE(t, 0);
        if (t + 1 < ntl) WRITET(t + 1, 1, kfB, vfB);
        __syncthreads();
        if (t + 1 < ntl) {
            if (t + 3 < ntl) LOADT(t + 3, kfB, vfB);
            SCORE(t + 1, 1);
            if (t + 2 < ntl) WRITET(t + 2, 0, kfA, vfA);
            __syncthreads();
        }
    }
#undef SCORE
#undef LOADT
#undef WRITET
#undef CV8
    const int bh = b * 4 + h;
    if (active) { float* pb = PART + ((size_t)(bh * 4 + sp) * 2 + c) * (66 * 64) + lane;
#pragma unroll
        for (int d = 0; d < 4; ++d)
#pragma unroll
            for (int r = 0; r < 16; ++r) pb[(d * 16 + r) * 64] = o[d][r];
        pb[64 * 64] = m_reg; pb[65 * 64] = l_reg; }
    asm volatile("s_waitcnt vmcnt(0)" ::: "memory"); __syncthreads();
    if (tid == 0) { __builtin_amdgcn_fence(__ATOMIC_RELEASE, "agent"); asm volatile("s_waitcnt vmcnt(0)" ::: "memory");
                    const unsigned old = __hip_atomic_fetch_add(cnt + bh, 1u, __ATOMIC_RELAXED, __HIP_MEMORY_SCOPE_AGENT);
                    if (old == 3u) { __builtin_amdgcn_fence(__ATOMIC_ACQUIRE, "agent"); asm volatile("s_waitcnt vmcnt(0)" ::: "memory"); }
                    MISC[1] = old; }
    __syncthreads();
    const bool last = MISC[1] == 3u;
    if (last && wid == 0) {
        const float* pp = PART + (size_t)(bh * 4) * 2 * (66 * 64) + lane;
        float e0[4], e1[4], L0 = 0.f, L1 = 0.f;
        { float m0[4], m1[4], M0 = -1e30f, M1 = -1e30f;
#pragma unroll
          for (int q = 0; q < 4; ++q) { m0[q] = pp[(size_t)(q * 2) * (66 * 64) + 64 * 64]; m1[q] = pp[(size_t)(q * 2 + 1) * (66 * 64) + 64 * 64]; M0 = fmaxf(M0, m0[q]); M1 = fmaxf(M1, m1[q]); }
#pragma unroll
          for (int q = 0; q < 4; ++q) { e0[q] = __builtin_amdgcn_exp2f((m0[q] - M0) * C64); e1[q] = __builtin_amdgcn_exp2f((m1[q] - M1) * C64);
              L0 += e0[q] * pp[(size_t)(q * 2) * (66 * 64) + 65 * 64]; L1 += e1[q] * pp[(size_t)(q * 2 + 1) * (66 * 64) + 65 * 64]; } }
        const float i0 = 1.f / L0, i1 = lam / L1;
#pragma unroll
        for (int q = 0; q < 4; ++q) { e0[q] *= i0; e1[q] *= i1; }
        float ss = 0.f;
#pragma unroll
        for (int d = 0; d < 4; ++d)
#pragma unroll
            for (int r = 0; r < 16; ++r) { float od = 0.f;
#pragma unroll
                for (int q = 0; q < 4; ++q) od += e0[q] * pp[(size_t)(q * 2) * (66 * 64) + (d * 16 + r) * 64] - e1[q] * pp[(size_t)(q * 2 + 1) * (66 * 64) + (d * 16 + r) * 64];
                o[d][r] = od; ss += od * od; }
        ss += __shfl_xor(ss, 32);
        const float rms = rsqrtf(ss * (1.f / 128.f) + 1e-5f) * 0.8f;
        if (r32 < 16) {
            const bf16_t* gate = PA + row * NA + 1536 + h * 128; bf16_t* out = MIX + row * DM + h * 128;
#pragma unroll
            for (int d = 0; d < 4; ++d)
#pragma unroll
                for (int g = 0; g < 4; ++g) { const int dv = 32 * d + 8 * g + 4 * hi;
                    const f32x4 gn = *(const f32x4*)(gnorm + dv); const u32x2 gt = *(const u32x2*)(gate + dv);
                    f32x4 v; v.x = o[d][4 * g] * rms * gn.x * silu(bflo(gt.x)); v.y = o[d][4 * g + 1] * rms * gn.y * silu(bfhi(gt.x));
                    v.z = o[d][4 * g + 2] * rms * gn.z * silu(bflo(gt.y)); v.w = o[d][4 * g + 3] * rms * gn.w * silu(bfhi(gt.y));
                    st_bf4(out + dv, v); }
        }
    }
    __syncthreads();
}
__device__ __forceinline__ void mem_unit(const Ctx& cx, bool samp, int b, int h, int qb, const bf16_t* P, int ldp, int qcol, int gcol,
                                         const bf16_t* Kb, const bf16_t* Vb, long ldk, bf16_t* MIX) {
    long row; bool valid; int wNT;
    if (!samp) { row = (long)b * 4096 + qb * 256 + cx.wid * 32 + cx.r32; valid = true; wNT = 4; }
    else { row = NP + b * 16 + (cx.r32 < 15 ? cx.r32 : 15); valid = (cx.wid == 0) && cx.r32 < 16; wNT = (cx.wid == 0) ? 4 : 0; }
    const bf16_t* qptr = P + (size_t)row * ldp + qcol + h * 128 + cx.hi * 8;
    f32x16 o[4]; float m, l;
    attn_core<8, false>(cx.lds, Kb, ldk, Vb, ldk, 4, 256, qptr, wNT, 0, 0, C128, THR128, o, m, l);
    const float inv = l > 0.f ? 1.f / l : 0.f;
    store_gated<4>(o, inv, P + (size_t)row * ldp + gcol + h * 128, MIX + (size_t)(row - (samp ? (cx.r32 < 15 ? cx.r32 : 15) : cx.r32)) * DM + 512 + h * 128,
                   samp ? (cx.wid == 0 ? 16 : 0) : 32, cx.lds + cx.wid * 9216, cx.lane);
}
__device__ __forceinline__ void swa_unit(const Ctx& cx, bool samp, int b, int c, int half, const bf16_t* PB, const bf16_t* KSW, const bf16_t* VSW, bf16_t* MIX, const float* sinks) {
    const int head = cx.wid, kv = cx.wid >> 2;
    long row; bool valid; int NT, nkeys; const bf16_t* Kb; const bf16_t* Vb; long ldk;
    if (!samp) { row = (long)b * 4096 + c * 64 + half * 32 + cx.r32; valid = true; const int c0 = c > 2 ? c - 2 : 0; NT = c - c0 + 1; nkeys = NT * 64;
                 Kb = PB + ((size_t)b * 4096 + c0 * 64) * NB + 2048; Vb = Kb + 128; ldk = NB; }
    else { row = NP + b * 16 + (cx.r32 < 15 ? cx.r32 : 15); valid = cx.r32 < 16; NT = 3; nkeys = 144;
           Kb = KSW + (size_t)b * SWROWS * 128; Vb = VSW + (size_t)b * SWROWS * 128; ldk = 128; }
    const bf16_t* qptr = PB + (size_t)row * NB + head * 64 + cx.hi * 8;
    f32x16 o[4]; float m, l;
    attn_core_pipe<true>(cx.lds, Kb, ldk, Vb, ldk, NT, nkeys, qptr, NT, kv * 128, kv, C64, THR64, o, m, l);
    const float lt = l + __builtin_amdgcn_exp2f(sinks[head] * LOG2E - m * C64);
    const float inv = 1.f / lt;
    store_gated<2>(o, inv, PB + (size_t)row * NB + 512 + head * 64, MIX + (size_t)(row - (samp ? (cx.r32 < 15 ? cx.r32 : 15) : cx.r32)) * DM + head * 64, samp ? 16 : 32, cx.lds + cx.wid * 9216, cx.lane);
}
#undef KSWZ
#undef SBAR
}

__device__ __forceinline__ float wave_sum(float v) {
#pragma unroll
    for (int o = 1; o < 64; o <<= 1) v += __shfl_xor(v, o);
    return v;
}
__device__ __forceinline__ void p0_transpose_item(const float* W, int K, int N, bf16_t* WT, int row_off, LAS float* scr, int item, int lane) {
    const int nblk = N / 32, kb = item / nblk, nb = item % nblk, k0 = 64 * kb, n0 = 32 * nb;
#pragma unroll 8
    for (int i = 0; i < 32; ++i) { const int kk = 2 * i + (lane >> 5); scr[kk * 33 + (lane & 31)] = __builtin_nontemporal_load(W + (size_t)(k0 + kk) * N + n0 + (lane & 31)); }
    asm volatile("s_waitcnt lgkmcnt(0)" ::: "memory");
    const int c = lane & 7;
#pragma unroll
    for (int j = 0; j < 4; ++j) { const int n = (lane >> 3) + 8 * j; const LAS float* s = scr + (8 * c) * 33 + n;
        u32x4 o; o.x = cvtpk(s[0 * 33], s[1 * 33]); o.y = cvtpk(s[2 * 33], s[3 * 33]); o.z = cvtpk(s[4 * 33], s[5 * 33]); o.w = cvtpk(s[6 * 33], s[7 * 33]);
        *(u32x4*)(WT + (size_t)(row_off + n0 + n) * K + k0 + 8 * c) = o; }
    asm volatile("s_waitcnt lgkmcnt(0)" ::: "memory");
}
__device__ __forceinline__ void p0_transpose_item_ln(const float* W, int K, int N, bf16_t* WT, int row_off, LAS float* scr, int item, int lane, const float* g, const float* b, float* CS, float* BW) {
    const int nblk = N / 32, kb = item / nblk, nb = item % nblk, k0 = 64 * kb, n0 = 32 * nb;
    float csp = 0.f, bwp = 0.f;
#pragma unroll 8
    for (int i = 0; i < 32; ++i) { const int kk = 2 * i + (lane >> 5); const float w = __builtin_nontemporal_load(W + (size_t)(k0 + kk) * N + n0 + (lane & 31)); const float gw = g[k0 + kk] * w;
        scr[kk * 33 + (lane & 31)] = gw; csp += bflo(cvtpk(gw, 0.f)); bwp += b[k0 + kk] * w; }
    csp += __shfl_xor(csp, 32); bwp += __shfl_xor(bwp, 32);
    if (lane < 32) { atomicAdd(CS + row_off + n0 + lane, csp); atomicAdd(BW + row_off + n0 + lane, bwp); }
    asm volatile("s_waitcnt lgkmcnt(0)" ::: "memory");
    const int c = lane & 7;
#pragma unroll
    for (int j = 0; j < 4; ++j) { const int n = (lane >> 3) + 8 * j; const LAS float* sp = scr + (8 * c) * 33 + n;
        u32x4 o; o.x = cvtpk(sp[0 * 33], sp[1 * 33]); o.y = cvtpk(sp[2 * 33], sp[3 * 33]); o.z = cvtpk(sp[4 * 33], sp[5 * 33]); o.w = cvtpk(sp[6 * 33], sp[7 * 33]);
        *(u32x4*)(WT + (size_t)(row_off + n0 + n) * K + k0 + 8 * c) = o; }
    asm volatile("s_waitcnt lgkmcnt(0)" ::: "memory");
}
__device__ __forceinline__ void ln_rows(const float* zin, float* fout, bf16_t* bout, const float* g, const float* bta, int gw, int NGW, int lane) {
    f32x4 g4[4], b4[4];
#pragma unroll
    for (int j = 0; j < 4; ++j) { g4[j] = *(const f32x4*)(g + 4 * lane + 256 * j); b4[j] = *(const f32x4*)(bta + 4 * lane + 256 * j); }
    for (int m = gw; m < MA; m += NGW) {
        const float* zr = zin + (size_t)m * DM + 4 * lane;
        f32x4 v[4]; float s = 0.f;
#pragma unroll
        for (int j = 0; j < 4; ++j) { v[j] = *(const f32x4*)(zr + 256 * j); s += (v[j].x + v[j].y) + (v[j].z + v[j].w); }
        const float mean = wave_sum(s) * (1.f / DM); float s2 = 0.f;
#pragma unroll
        for (int j = 0; j < 4; ++j) { v[j] = v[j] - mean; s2 += (v[j].x * v[j].x + v[j].y * v[j].y) + (v[j].z * v[j].z + v[j].w * v[j].w); }
        const float rstd = rsqrtf(wave_sum(s2) * (1.f / DM) + 1e-5f);
#pragma unroll
        for (int j = 0; j < 4; ++j) { const f32x4 y = v[j] * rstd * g4[j] + b4[j];
            *(f32x4*)(fout + (size_t)m * DM + 4 * lane + 256 * j) = y;
            if (bout) st_bf4(bout + (size_t)m * DM + 4 * lane + 256 * j, y); }
    }
}

#define XB_TMO      128
#define XB_XCNT(j)  (256  + 64 * (j))
#define XB_XSUB(j)  (1280 + 64 * (j))
#define XB_XGEN(j)  (2304 + 64 * (j))
#define XB_TOP      3328
#define XB_TOPGEN   3392
#define XCD_BAR_WORDS 3456
#define XB_SPIN_CAP (1u << 18)

__device__ __forceinline__ unsigned xb_ld(unsigned* p)              { return __hip_atomic_load(p, __ATOMIC_RELAXED, __HIP_MEMORY_SCOPE_AGENT); }
__device__ __forceinline__ unsigned xb_add(unsigned* p, unsigned v) { return __hip_atomic_fetch_add(p, v, __ATOMIC_RELAXED, __HIP_MEMORY_SCOPE_AGENT); }
__device__ __forceinline__ unsigned xb_xcc_id() { return (unsigned)__builtin_amdgcn_s_getreg((3 << 11) | 20) & 0xFu; }
#define XB_SPIN(cond, bar) do { unsigned _sp = 0; while (cond) { __builtin_amdgcn_s_sleep(1); \
    if ((++_sp & 255u) == 0u) { if (xb_ld(&(bar)[XB_TMO])) break; if (_sp > XB_SPIN_CAP) { atomicAdd(&(bar)[XB_TMO], 1u); break; } } } } while (0)

struct XcdBarrier {
    unsigned* bar; unsigned x;
    volatile LAS unsigned* st;
};

__device__ __forceinline__ XcdBarrier xcd_barrier_post(unsigned* bar, volatile LAS unsigned* st) {
    XcdBarrier b; b.bar = bar; b.x = xb_xcc_id(); b.st = st;
    if (threadIdx.x == 0) (void)xb_add(&bar[XB_XCNT(b.x)], 1u);
    return b;
}
__device__ __forceinline__ void xcd_barrier_complete(unsigned* bar, unsigned x, unsigned& nloc, unsigned& nx) {
    const unsigned G = gridDim.x * gridDim.y * gridDim.z;
    unsigned sum, cnt, mine, sp = 0u;
    for (;;) {
        sum = 0u; cnt = 0u; mine = 0u;
#pragma unroll
        for (unsigned j = 0; j < 16; ++j) { const unsigned c = xb_ld(&bar[XB_XCNT(j)]); sum += c; cnt += (c > 0u) ? 1u : 0u; mine = (j == x) ? c : mine; }
        if (sum == G) break;
        __builtin_amdgcn_s_sleep(1);
        if ((++sp & 255u) == 0u) { if (xb_ld(&bar[XB_TMO])) break; if (sp > XB_SPIN_CAP) { atomicAdd(&bar[XB_TMO], 1u); break; } }
    }
    nloc = mine > 0u ? mine : 1u; nx = cnt > 0u ? cnt : 1u;
}

__device__ __forceinline__ void xcd_barrier(const XcdBarrier& b) {
    asm volatile("s_waitcnt vmcnt(0)" ::: "memory");
    __syncthreads();
    if (threadIdx.x == 0) {
        unsigned* bar = b.bar;
        __builtin_amdgcn_s_waitcnt(0);
        unsigned nloc = b.st[0], nx = b.st[1];
        if (nloc == 0u) { xcd_barrier_complete(bar, b.x, nloc, nx); b.st[0] = nloc; b.st[1] = nx; }
        const unsigned old = xb_add(&bar[XB_XSUB(b.x)], 1u);
        const unsigned gen = old / nloc;
        if (old + 1u == (gen + 1u) * nloc) {
            __builtin_amdgcn_fence(__ATOMIC_RELEASE, "agent");
            asm volatile("s_waitcnt vmcnt(0)" ::: "memory");
            const unsigned og = xb_add(&bar[XB_TOP], 1u);
            const unsigned tg = og / nx;
            if (og + 1u == (tg + 1u) * nx) xb_add(&bar[XB_TOPGEN], 1u);
            else XB_SPIN(xb_ld(&bar[XB_TOPGEN]) == tg, bar);
            __builtin_amdgcn_fence(__ATOMIC_ACQUIRE, "agent");
            xb_add(&bar[XB_XGEN(b.x)], 1u);
            asm volatile("s_waitcnt vmcnt(0)" ::: "memory");
        } else {
            XB_SPIN(xb_ld(&bar[XB_XGEN(b.x)]) == gen, bar);
            __builtin_amdgcn_fence(__ATOMIC_ACQUIRE, "agent");
            asm volatile("s_waitcnt vmcnt(0)" ::: "memory");
        }
    }
    __syncthreads();
}

struct Args { const float* in[22]; float* out; unsigned char* ws; int ph_lo, ph_hi, rep, pad; };
constexpr int NWAVES = 8, NPHASE = 9;

__global__ void __launch_bounds__(NWAVES * 64, 2) yoco_fwd(Args a) {
    extern __shared__ __attribute__((aligned(16))) unsigned char lds_raw[];
    LAS unsigned char* lds = (LAS unsigned char*)lds_raw;
    volatile LAS unsigned* MISC = (volatile LAS unsigned*)(lds + LDS_RING);
    cg::grid_group grid = cg::this_grid();
    const int tid = threadIdx.x, lane = tid & 63, wave = __builtin_amdgcn_readfirstlane(tid >> 6);
    const int G = gridDim.x, gw = blockIdx.x * NWAVES + wave, NGW = G * NWAVES;
    const long gtid = (long)blockIdx.x * (NWAVES * 64) + tid, NTHR = (long)G * (NWAVES * 64);
    unsigned char* ws = a.ws; float* dout = a.out;
    unsigned* ctl = (unsigned*)(ws + WS_CTL);
    float* ROPE = (float*)(ws + WS_ROPE);
    float* CSV = (float*)(ws + 32768); float* BWV = (float*)(ws + 49152); float* ST0 = (float*)(ws + 262144); float* ST1 = (float*)(ws + 524288);
    bf16_t* WA_t = (bf16_t*)(ws + WS_WA); bf16_t* WB_t = (bf16_t*)(ws + WS_WB); bf16_t* WM_t = (bf16_t*)(ws + WS_WM); bf16_t* WO_t = (bf16_t*)(ws + WS_WO);
    bf16_t* MEMB = (bf16_t*)(ws + WS_MEMB); bf16_t* MKV = (bf16_t*)(ws + WS_MKV); bf16_t* CMK = (bf16_t*)(ws + WS_CMK); bf16_t* CMV = (bf16_t*)(ws + WS_CMV);
    bf16_t* KSW = (bf16_t*)(ws + WS_KSW); bf16_t* VSW = (bf16_t*)(ws + WS_VSW); bf16_t* XA = (bf16_t*)(ws + WS_XA); bf16_t* ZB = XA;
    bf16_t* MIX = (bf16_t*)(ws + WS_MIX); bf16_t* Z1B = (bf16_t*)(ws + WS_Z0); bf16_t* PA = (bf16_t*)(ws + WS_PA); bf16_t* PB = PA;
    bf16_t* KS = (bf16_t*)(ws + WS_KS); bf16_t* VS = (bf16_t*)(ws + WS_VS);
    const int lo = a.ph_lo, hi_ph = a.ph_hi;
#define IN(k) (lo <= (k) && (k) < hi_ph)
    if (tid < 64) MISC[tid] = 0u;
    __syncthreads();
    XcdBarrier xbar = xcd_barrier_post(ctl + 1024, MISC + 8);
    if (a.ph_lo > 1000) grid.sync();
#define SEAM(k) do { if (IN(k) && IN((k) + 1)) xcd_barrier(xbar); } while (0)
    att::Ctx cx; cx.lds = lds; cx.lane = lane; cx.wid = wave; cx.r32 = lane & 31; cx.hi = lane >> 5;

    if (IN(0)) {
        LAS float* scr = (LAS float*)(lds + wave * 16384);
        for (int it = gw; it < 4736; it += NGW) {
            int r = it;
            if (r < 1536) { p0_transpose_item(a.in[9], DM, NA, WA_t, 0, scr, r, lane); continue; } r -= 1536;
            if (r < 1024) { p0_transpose_item_ln(a.in[15], DM, 2048, WB_t, 0, scr, r, lane, a.in[20], a.in[21], CSV, BWV); continue; } r -= 1024;
            if (r < 128) { p0_transpose_item_ln(a.in[17], DM, 256, WB_t, 2048, scr, r, lane, a.in[20], a.in[21], CSV, BWV); continue; } r -= 128;
            if (r < 1024) { const int l = r >> 9; p0_transpose_item(a.in[18] + (size_t)l * DM * DM, DM, DM, WM_t, l * 1024, scr, r & 511, lane); continue; } r -= 1024;
            { const int l = r >> 9; p0_transpose_item(a.in[19] + (size_t)l * DM * DM, DM, DM, WO_t, l * 1024, scr, r & 511, lane); }
        }
        for (long i = gtid; i < 2097152; i += NTHR) cvt8(a.in[0] + i * 8, XA + i * 8);
        for (long i = gtid; i < 32768; i += NTHR) cvt8(a.in[1] + i * 8, XA + (size_t)NP * DM + i * 8);
        for (long i = gtid; i < 131072; i += NTHR) cvt8(a.in[2] + i * 8, MEMB + i * 8);
        for (long i = gtid; i < 524288; i += NTHR) { cvt8(a.in[7] + i * 8, CMK + i * 8); cvt8(a.in[8] + i * 8, CMV + i * 8); }
        for (long i = gtid; i < 32768; i += NTHR) { const long b = i >> 11, r = i & 2047; const size_t d = (size_t)b * SWROWS * 128 + r * 8;
            cvt8(a.in[5] + i * 8, KSW + d); cvt8(a.in[6] + i * 8, VSW + d);
            const int rw = (int)(r >> 4);
            if (rw >= 16) { const size_t od = ((size_t)b * 128 + rw - 16) * 128 + (r & 15) * 8;
                *(f32x4*)(dout + OFF_SKS + od) = *(const f32x4*)(a.in[5] + i * 8); *(f32x4*)(dout + OFF_SKS + od + 4) = *(const f32x4*)(a.in[5] + i * 8 + 4);
                *(f32x4*)(dout + OFF_SVS + od) = *(const f32x4*)(a.in[6] + i * 8); *(f32x4*)(dout + OFF_SVS + od + 4) = *(const f32x4*)(a.in[6] + i * 8 + 4); } }
        for (long i = gtid; i < 49152; i += NTHR) { const long b = i / 3072, r = i % 3072; const size_t d = ((size_t)b * KSROWS + 4112) * 512 + r * 8;
            *(u32x4*)(KS + d) = (u32x4){0u, 0u, 0u, 0u}; *(u32x4*)(VS + d) = (u32x4){0u, 0u, 0u, 0u}; }
        for (long i = gtid; i < 12288; i += NTHR) { const long b = i / 768, r = i % 768; const size_t d = ((size_t)b * SWROWS + 144) * 128 + r * 8;
            *(u32x4*)(KSW + d) = (u32x4){0u, 0u, 0u, 0u}; *(u32x4*)(VSW + d) = (u32x4){0u, 0u, 0u, 0u}; }
        for (long i = gtid; i < 4112 * 8; i += NTHR) { const int pos = (int)(i >> 3), fi = (int)(i & 7);
            const double inv = fi == 0 ? 1.0 : fi == 1 ? 0.19392274474868576 : fi == 2 ? 0.03760603093086393 : fi == 3 ? 0.007292664737217109 :
                               fi == 4 ? 0.001414213562373095 : fi == 5 ? 0.0002742481756762073 : fi == 6 ? 5.318295896944988e-05 : 1.031338537721246e-05;
            const double rev = (double)pos * inv * 0.15915494309189535; const float fr = (float)(rev - __builtin_rint(rev));
            ROPE[i * 2] = __builtin_amdgcn_cosf(fr); ROPE[i * 2 + 1] = __builtin_amdgcn_sinf(fr); }
    }
    SEAM(0);
    if (IN(1)) {
        pg8::Gemm g{XA, WA_t, NP, NA, DM}; pg8::StaticOrder S; S.init(NP, NA, G, (int)blockIdx.x);
        EpiWrap<EpiAF> E{{PA, dout, KS, VS, ROPE, 0.f, 0.f}, 0, 0};
        pg8::gemm_phase<EpiWrap<EpiAF>, pg8::StaticOrder, true, true>(lds, g, S, E);
    }
    SEAM(1);
    if (IN(2)) {
        float s1 = 0.f, s2 = 0.f;
        for (int i = 0; i < 64; ++i) { s1 += a.in[10][i] * a.in[11][i]; s2 += a.in[12][i] * a.in[13][i]; }
        if (tid == 0) MISC[2] = __float_as_uint(__expf(s1) - __expf(s2) + 0.2f);
        __syncthreads();
        unsigned* gdone = ctl + 256 + 64 * a.rep;
        if (blockIdx.x < 44) {
            if (blockIdx.x < 32) { pg8::Gemm g{MEMB, WM_t, 1024, 2048, DM}; pg8::StaticOrder S; S.init(1024, 2048, 32, (int)blockIdx.x);
                EpiWrap<EpiMemF> E{{MKV, dout, 0.f, 0.f}, 0, 0};
                pg8::gemm_phase<EpiWrap<EpiMemF>, pg8::StaticOrder, true, true>(lds, g, S, E); }
            else { pg8::Gemm g{XA + (size_t)NP * DM, WA_t, 256, NA, DM}; pg8::StaticOrder S; S.init(256, NA, 12, (int)blockIdx.x - 32);
                EpiWrap<EpiAF> E{{PA, dout, KS, VS, ROPE, 0.f, 0.f}, NP, 0};
                pg8::gemm_phase<EpiWrap<EpiAF>, pg8::StaticOrder, true, true>(lds, g, S, E); }
            asm volatile("s_waitcnt vmcnt(0)" ::: "memory"); __syncthreads();
            if (tid == 0) { __builtin_amdgcn_fence(__ATOMIC_RELEASE, "agent"); asm volatile("s_waitcnt vmcnt(0)" ::: "memory");
                            __hip_atomic_fetch_add(gdone, 1u, __ATOMIC_RELAXED, __HIP_MEMORY_SCOPE_AGENT); }
        }
        bool ready = false;
        float* PART = (float*)(ws + WS_Z0 + 40 * MiB + (size_t)a.rep * (10 * MiB));
        for (;;) {
            if (tid == 0) MISC[0] = atomicAdd(ctl + 128 * a.rep, 1u);
            __syncthreads(); const unsigned u = MISC[0]; __syncthreads();
            if (u >= 1088u) break;
            const bool needs = (u >= 256u && u < 512u) || u >= 768u;
            if (needs && !ready) {
                if (tid == 0) { unsigned sp = 0; while (__hip_atomic_load(gdone, __ATOMIC_RELAXED, __HIP_MEMORY_SCOPE_AGENT) < 44u && ++sp < (1u << 24)) __builtin_amdgcn_s_sleep(8);
                                __builtin_amdgcn_fence(__ATOMIC_ACQUIRE, "agent"); asm volatile("s_waitcnt vmcnt(0)" ::: "memory"); }
                __syncthreads(); ready = true;
            }
            if (u < 768u) {
                const float lam = __uint_as_float(MISC[2]);
                if (u >= 256u && u < 512u) { const unsigned v = u - 256u;
                    att::diff_sample_item(cx, (int)(v >> 4), (int)((v >> 2) & 3u), (int)(v & 3u), a.in[3], a.in[4], PA, KS, VS, MIX, a.in[14], lam, PART, ctl + 512 + 64 * a.rep, MISC); }
                else { const unsigned v = u < 256u ? u : u - 256u;
                    att::diff_unit(cx, false, (int)((v & 15u) >> 2), (int)(v & 3u), 31 - (int)(v >> 4), PA, KS, VS, MIX, a.in[14], lam); } }
            else { const bool samp = u >= 1024u; const unsigned v = samp ? u - 1024u : u - 768u;
                const int b = samp ? (int)(v >> 2) : (int)(v >> 6), h = samp ? (int)(v & 3u) : (int)((v >> 4) & 3u), qb = samp ? 0 : (int)(v & 15u);
                const bf16_t* Kb = samp ? CMK + ((size_t)b * 256) * 512 + h * 128 : MKV + ((size_t)b * 256) * 2048 + h * 128;
                const bf16_t* Vb = samp ? CMV + ((size_t)b * 256) * 512 + h * 128 : Kb + 512;
                att::mem_unit(cx, samp, b, h, qb, PA, NA, 2048, 2560, Kb, Vb, samp ? 512 : 2048, MIX); }
        }
    }
    SEAM(2);
    if (IN(3)) {
        EpiMerge0F F0{ZB, ST0, 0.f, 0.f};
        { pg8::Gemm g{MIX, WO_t, NP, DM, DM}; pg8::StaticOrder S; S.init(NP, DM, G, (int)blockIdx.x);
          EpiWrap<EpiMerge0F> E{F0, 0, 0};
          pg8::gemm_phase<EpiWrap<EpiMerge0F>, pg8::StaticOrder, true, true>(lds, g, S, E); }
        gemm_small<EpiMerge0F>(lds, MIX + (size_t)NP * DM, WO_t, DM, NP, (int)blockIdx.x, G, F0);
    }
    SEAM(3);
    if (IN(5)) {
        EpiBF FB{PB, dout, KSW, VSW, ROPE, ST0, CSV, BWV, 0.f, 0.f, {0.f, 0.f}, {0.f, 0.f}};
        { pg8::Gemm g{ZB, WB_t, NP, 2048, DM}; pg8::StaticOrder S; S.init(NP, 2048, G, (int)blockIdx.x);
          EpiWrap<EpiBF> E{FB, 0, 0};
          pg8::gemm_phase<EpiWrap<EpiBF>, pg8::StaticOrder, true, true>(lds, g, S, E); }
    }
    SEAM(5);
    if (IN(6)) {
        unsigned* gdone = ctl + 384 + 64 * a.rep;
        {
            EpiBF FB{PB, dout, KSW, VSW, ROPE, ST0, CSV, BWV, 0.f, 0.f, {0.f, 0.f}, {0.f, 0.f}};
            if (blockIdx.x < 64) { pg8::Gemm g{ZB, WB_t + (size_t)2048 * DM, NP, 256, DM}; pg8::StaticOrder S; S.init(NP, 256, 64, (int)blockIdx.x);
                EpiWrap<EpiBF> E{FB, 0, 2048};
                pg8::gemm_phase<EpiWrap<EpiBF>, pg8::StaticOrder, true, true>(lds, g, S, E); }
            else { gemm_small<EpiBF>(lds, ZB + (size_t)NP * DM, WB_t, 2048, NP, (int)blockIdx.x - 64, 192, FB);
                   if (blockIdx.x >= 192) gemm_small<EpiBF>(lds, ZB + (size_t)NP * DM, WB_t + (size_t)2048 * DM, 256, NP, (int)blockIdx.x - 192, 64, FB, 2048); }
            asm volatile("s_waitcnt vmcnt(0)" ::: "memory"); __syncthreads();
            if (tid == 0) { __builtin_amdgcn_fence(__ATOMIC_RELEASE, "agent"); asm volatile("s_waitcnt vmcnt(0)" ::: "memory");
                            __hip_atomic_fetch_add(gdone + (blockIdx.x < 64 ? 0 : 16), 1u, __ATOMIC_RELAXED, __HIP_MEMORY_SCOPE_AGENT); }
        }
        bool ready1 = false, ready2 = false;
        for (;;) {
            if (tid == 0) MISC[0] = atomicAdd(ctl + 64 + 128 * a.rep, 1u);
            __syncthreads(); const unsigned u = MISC[0]; __syncthreads();
            if (u >= 848u) break;
            const bool need1 = u >= 256u && u < 768u, need2 = u >= 768u;
            if ((need1 && !ready1) || (need2 && !ready2)) {
                if (tid == 0) { unsigned sp = 0; unsigned* w = need1 ? gdone : gdone + 16; const unsigned want = need1 ? 64u : 192u;
                                while (__hip_atomic_load(w, __ATOMIC_RELAXED, __HIP_MEMORY_SCOPE_AGENT) < want && ++sp < (1u << 24)) __builtin_amdgcn_s_sleep(8);
                                __builtin_amdgcn_fence(__ATOMIC_ACQUIRE, "agent"); asm volatile("s_waitcnt vmcnt(0)" ::: "memory"); }
                __syncthreads(); if (need1) ready1 = true; else ready2 = true;
            }
            const bool is_mem = u < 256u || (u >= 768u && u < 832u);
            if (is_mem) { const bool samp = u >= 768u; const unsigned v = samp ? u - 768u : u;
                const int b = samp ? (int)(v >> 2) : (int)(v >> 6), h = samp ? (int)(v & 3u) : (int)((v >> 4) & 3u), qb = samp ? 0 : (int)(v & 15u);
                const bf16_t* Kb = samp ? CMK + ((size_t)(16 + b) * 256) * 512 + h * 128 : MKV + ((size_t)b * 256) * 2048 + 1024 + h * 128;
                const bf16_t* Vb = samp ? CMV + ((size_t)(16 + b) * 256) * 512 + h * 128 : Kb + 512;
                att::mem_unit(cx, samp, b, h, qb, PB, NB, 1024, 1536, Kb, Vb, samp ? 512 : 2048, MIX); }
            else { const bool samp = u >= 832u; const unsigned v = samp ? u - 832u : u - 256u;
                const int b = samp ? (int)v : (int)(v >> 7), c = samp ? 0 : (int)((v >> 1) & 63u), half = samp ? 0 : (int)(v & 1u);
                att::swa_unit(cx, samp, b, c, half, PB, KSW, VSW, MIX, a.in[16]); }
        }
    }
    SEAM(6);
    if (IN(7)) {
        EpiMerge1F F1{ZB, ST0, a.in[20], a.in[21], Z1B, ST1, 0.f, 0.f, {0.f, 0.f}, {0.f, 0.f}};
        { pg8::Gemm g{MIX, WO_t + (size_t)DM * DM, NP, DM, DM}; pg8::StaticOrder S; S.init(NP, DM, G, (int)blockIdx.x);
          EpiWrap<EpiMerge1F> E{F1, 0, 0};
          pg8::gemm_phase<EpiWrap<EpiMerge1F>, pg8::StaticOrder, true, true>(lds, g, S, E); }
        gemm_small<EpiMerge1F>(lds, MIX + (size_t)NP * DM, WO_t + (size_t)DM * DM, DM, NP, (int)blockIdx.x, G, F1);
    }
    SEAM(7);
    if (IN(8)) {
        const float* g1 = a.in[20] + DM; const float* b1 = a.in[21] + DM;
#pragma unroll 4
        for (long i = gtid; i < (long)MA * 256; i += NTHR) { const int row = (int)(i >> 8), c4 = (int)(i & 255) * 4;
            float mu, rstd; row_stats(ST1, row, mu, rstd);
            const u32x2 zz = __builtin_nontemporal_load((const u32x2*)(Z1B + (size_t)row * DM + c4));
            const f32x4 z = (f32x4){bflo(zz.x), bfhi(zz.x), bflo(zz.y), bfhi(zz.y)};
            __builtin_nontemporal_store((z - mu) * rstd * *(const f32x4*)(g1 + c4) + *(const f32x4*)(b1 + c4), (f32x4*)(dout + (size_t)row * DM + c4)); }
    }
#undef IN
#undef SEAM
}

#ifndef MK_N_LAUNCHES
#define MK_N_LAUNCHES 1
#endif
#ifndef PROBE_DUP
#define PROBE_DUP 0
#endif
extern "C" void kernel_launch(void* const* d_in, const int* in_sizes, int n_in, void* d_out, int out_size, void* d_ws, size_t ws_size, hipStream_t stream) {
    static int grid = 0;
    if (grid == 0) {
        if (n_in != 22 || ws_size < WS_END) { fprintf(stderr, "kernel_launch: unexpected n_in %d / ws %zu\n", n_in, ws_size); grid = -1; return; }
        int dev = 0, cus = 0, per_cu = 0;
        if (hipGetDevice(&dev) != hipSuccess || hipDeviceGetAttribute(&cus, hipDeviceAttributeMultiprocessorCount, dev) != hipSuccess) { grid = -1; return; }
        if (hipFuncSetAttribute((const void*)yoco_fwd, hipFuncAttributeMaxDynamicSharedMemorySize, LDS_BYTES) != hipSuccess) { fprintf(stderr, "kernel_launch: hipFuncSetAttribute failed\n"); grid = -1; return; }
        if (hipOccupancyMaxActiveBlocksPerMultiprocessor(&per_cu, (const void*)yoco_fwd, NWAVES * 64, LDS_BYTES) != hipSuccess || per_cu < 1) { fprintf(stderr, "kernel_launch: occupancy query says %d\n", per_cu); per_cu = 1; }
        (void)hipGetLastError();
        grid = cus;
    }
    if (grid < 0) return;
    (void)hipMemsetAsync((char*)d_ws + WS_CTL, 0, 1048576, stream);
    Args a{};
    for (int i = 0; i < 22; ++i) a.in[i] = (const float*)d_in[i];
    a.out = (float*)d_out; a.ws = (unsigned char*)d_ws;
#if MK_N_LAUNCHES == 1
    a.ph_lo = 0; a.ph_hi = NPHASE;
    void* args[] = {&a};
    hipError_t e = hipLaunchCooperativeKernel((const void*)yoco_fwd, dim3(grid), dim3(NWAVES * 64), args, LDS_BYTES, stream);
    if (e != hipSuccess) fprintf(stderr, "kernel_launch: cooperative launch failed: %s (grid %d)\n", hipGetErrorString(e), grid);
#else
    for (int p = 0; p < NPHASE; ++p) { a.ph_lo = p; a.ph_hi = p + 1;
        for (int r = 0; r < 1 + ((PROBE_DUP >> p) & 1); ++r) { a.rep = r; hipLaunchKernelGGL(yoco_fwd, dim3(grid), dim3(NWAVES * 64), LDS_BYTES, stream, a); } }
#endif
}
```

```cpp
#include <hip/hip_runtime.h>
#include <hip/hip_cooperative_groups.h>
#include <cstdio>
#include <cstdint>
namespace cg = cooperative_groups;
namespace pg8 {
#define PG8_LAS __attribute__((address_space(3)))
typedef unsigned short bf16_t;
typedef short bf16x8 __attribute__((ext_vector_type(8)));
typedef float f32x4 __attribute__((ext_vector_type(4)));
typedef unsigned u32x4 __attribute__((ext_vector_type(4)));
constexpr int BM = 256, BK = 64, HALF = 128, HTB = HALF * BK * 2  , STAGE_BYTES = 8 * HTB, NXCD = 8, WGM = 8;

__host__ __device__ __forceinline__ int lds_byte(int r, int c) { const int st = (r >> 4) * 2 + (c >> 5), rr = r & 15, cc = c & 31, ob = rr * 64 + cc * 2; return st * 1024 + (ob ^ (((ob >> 9) & 1) << 5)); }
__host__ __device__ __forceinline__ void stage_rc(int b, int& R, int& C) { const int st = b / 1024, sb = b % 1024, swz = sb ^ (((sb >> 9) & 1) << 5); R = (st >> 1) * 16 + swz / 64; C = (st & 1) * 32 + (swz % 64) / 2; }
__host__ __device__ __forceinline__ int perm32(int rho) { const int n = rho >> 4, i = rho & 15; return 8 * (i >> 2) + 4 * n + (i & 3); }

struct Unit { int pm, pn; };
struct Gemm { const bf16_t* A; const bf16_t* Bt; int M, N, K; };

struct StaticOrder {
    int nM, nN, nwg, G, c;
    __host__ __device__ void init(int M, int N, int G_, int c_) { nM = M / BM; nN = N / BM; nwg = nM * nN; G = G_; c = c_; }
    __host__ __device__ bool next(int i, Unit& u) const {
        const long L = (long)i * G + c; if (L >= nwg) return false;
        int wgid = (int)L; { const int q = nwg / NXCD, r = nwg % NXCD, xcd = wgid % NXCD, off = wgid / NXCD; wgid = (xcd < r ? xcd * (q + 1) : r * (q + 1) + (xcd - r) * q) + off; }
        const int nig = WGM * nN, gid = wgid / nig, fm = gid * WGM, gsz = (nM - fm) < WGM ? (nM - fm) : WGM;
        u.pm = fm + ((wgid % nig) % gsz); u.pn = (wgid % nig) / gsz; return true;
    }
    __device__ __forceinline__ void a_ready(const Unit&) const {}
    __device__ __forceinline__ void done(const Unit&) const {}
};
__device__ __forceinline__ unsigned cvt_pk_bf16(float lo, float hi) { unsigned r; asm volatile("v_cvt_pk_bf16_f32 %0, %1, %2" : "=v"(r) : "v"(lo), "v"(hi)); return r; }
typedef float f32x2 __attribute__((ext_vector_type(2)));
template <class Epi, class Sched, bool ALIGN_EPI = false, bool SP2 = false>
__device__ __forceinline__ void gemm_phase(PG8_LAS unsigned char* lds, const Gemm g, const Sched& S, const Epi& E) {
    const int tid = threadIdx.x, wid = __builtin_amdgcn_readfirstlane(tid >> 6), lane = tid & 63, wr = wid >> 2, wc = wid & 3, fr = lane & 15, fq = lane >> 4;
    const int K = g.K, nt = K / BK;
    unsigned voffA[2], voffB[2];
#pragma unroll
    for (int i = 0; i < 2; ++i) { int R, C; stage_rc(tid * 16 + i * 8192, R, C); const int Rb = Epi::PERM ? ((R & ~31) + perm32(R & 31)) : R;
        voffA[i] = (unsigned)(R * K + C) * 2u; voffB[i] = (unsigned)(Rb * K + C) * 2u; }
    const size_t kstep = (size_t)(BK * 2);
    const size_t hstep = (size_t)HALF * K * 2;
    const size_t tstep = 2 * hstep;
    const unsigned ldsw = (unsigned)wid * 1024u;
    const int aoff = lds_byte(wr * 64 + fr, fq * 8), boff = lds_byte(wc * 32 + fr, fq * 8);
#define PG8_SA(b, h) (((b) * 2 + (h)) * HTB)
#define PG8_SB(b, h) ((4 + (b) * 2 + (h)) * HTB)
#define PG8_STAGE(bufoff, gbase, voff) do { _Pragma("unroll") for (int _i = 0; _i < 2; ++_i) \
        __builtin_amdgcn_global_load_lds((const unsigned*)((const char*)(gbase) + (voff)[_i]), (PG8_LAS unsigned*)(lds + (bufoff) + ldsw + _i * 8192), 16, 0, 0); } while (0)
#define PG8_LDA(dst, b, h) do { _Pragma("unroll") for (int m = 0; m < 4; ++m) _Pragma("unroll") for (int k = 0; k < 2; ++k) dst[m][k] = *(const PG8_LAS bf16x8*)(lds + PG8_SA(b, h) + aoff + m * 2048 + k * 1024); } while (0)
#define PG8_LDB(dst, b, h) do { _Pragma("unroll") for (int n = 0; n < 2; ++n) _Pragma("unroll") for (int k = 0; k < 2; ++k) dst[n][k] = *(const PG8_LAS bf16x8*)(lds + PG8_SB(b, h) + boff + n * 2048 + k * 1024); } while (0)
#define PG8_MMA(ai, bj, At, Bt) do { __builtin_amdgcn_s_setprio(1); _Pragma("unroll") for (int m = 0; m < 4; ++m) _Pragma("unroll") for (int n = 0; n < 2; ++n) _Pragma("unroll") for (int k = 0; k < 2; ++k) \
        acc[ai][bj][m][n] = __builtin_amdgcn_mfma_f32_16x16x32_bf16(Bt[n][k], At[m][k], acc[ai][bj][m][n], 0, 0, 0); __builtin_amdgcn_s_setprio(0); } while (0)
#define PG8_WAIT_V(n) asm volatile("s_waitcnt vmcnt(" #n ")" ::: "memory")
#define PG8_WAIT_L(n) asm volatile("s_waitcnt lgkmcnt(" #n ")" ::: "memory")
#define PG8_BAR __builtin_amdgcn_s_barrier()
#define PG8_SCHED __builtin_amdgcn_sched_barrier(0)
    Unit cur, nxt; int ui = 0;
    if (!S.next(0, cur)) return;
    f32x4 acc[2][2][4][2];
#pragma unroll
    for (int a = 0; a < 2; ++a)
#pragma unroll
        for (int b = 0; b < 2; ++b)
#pragma unroll
            for (int m = 0; m < 4; ++m)
#pragma unroll
                for (int n = 0; n < 2; ++n) acc[a][b][m][n] = (f32x4){0.f, 0.f, 0.f, 0.f};
    bf16x8 At[4][2], B0[2][2], B1[2][2];
    const char* cA = (const char*)g.A + (size_t)cur.pm * tstep; const char* cB = (const char*)g.Bt + (size_t)cur.pn * tstep;
    S.a_ready(cur);
    if constexpr (SP2) {
        PG8_STAGE(PG8_SB(0, 0), cB, voffB); PG8_STAGE(PG8_SB(0, 1), cB + hstep, voffB); PG8_STAGE(PG8_SA(0, 0), cA, voffA); PG8_STAGE(PG8_SA(0, 1), cA + hstep, voffA);
        if (wr == 1) PG8_BAR;
        PG8_WAIT_V(2); PG8_BAR;
        PG8_STAGE(PG8_SB(1, 0), cB + kstep, voffB); PG8_STAGE(PG8_SA(1, 0), cA + kstep, voffA); PG8_STAGE(PG8_SB(1, 1), cB + hstep + kstep, voffB);
        PG8_WAIT_V(6); PG8_BAR;
    } else {
        PG8_STAGE(PG8_SB(0, 0), cB, voffB); PG8_STAGE(PG8_SA(0, 0), cA, voffA); PG8_STAGE(PG8_SB(0, 1), cB + hstep, voffB); PG8_STAGE(PG8_SA(0, 1), cA + hstep, voffA);
        if (wr == 1) PG8_BAR;
        PG8_WAIT_V(4); PG8_BAR;
        PG8_STAGE(PG8_SB(1, 0), cB + kstep, voffB); PG8_STAGE(PG8_SA(1, 0), cA + kstep, voffA); PG8_STAGE(PG8_SB(1, 1), cB + hstep + kstep, voffB);
        PG8_WAIT_V(6); PG8_BAR;
    }
    for (;;) {
        const bool has_next = S.next(ui + 1, nxt);
        const char* nA = has_next ? (const char*)g.A + (size_t)nxt.pm * tstep : cA; const char* nB = has_next ? (const char*)g.Bt + (size_t)nxt.pn * tstep : cB;
        for (int t = 0; t < nt; t += 2) {
            const bool last = (t == nt - 2);
            const char* a1 = cA + (size_t)(t + 1) * kstep;
            const char* a2 = last ? nA : cA + (size_t)(t + 2) * kstep; const char* b2 = last ? nB : cB + (size_t)(t + 2) * kstep;
            const char* a3 = a2 + kstep; const char* b3 = b2 + kstep;
            if (last && has_next) S.a_ready(nxt);
            if constexpr (SP2) {
            PG8_LDB(B0, 0, 0); PG8_LDB(B1, 0, 1); PG8_SCHED; PG8_LDA(At, 0, 0); PG8_STAGE(PG8_SA(1, 1), a1 + hstep, voffA);
            PG8_WAIT_V(8); PG8_WAIT_L(0); PG8_BAR; PG8_MMA(0, 0, At, B0); PG8_MMA(0, 1, At, B1); PG8_BAR; PG8_SCHED;
            PG8_LDA(At, 0, 1); PG8_STAGE(PG8_SB(0, 0), b2, voffB); PG8_STAGE(PG8_SB(0, 1), b2 + hstep, voffB); PG8_STAGE(PG8_SA(0, 0), a2, voffA);
            PG8_WAIT_V(8); PG8_WAIT_L(0); PG8_BAR; PG8_MMA(1, 0, At, B0); PG8_MMA(1, 1, At, B1); PG8_BAR; PG8_SCHED;
            PG8_LDB(B0, 1, 0); PG8_LDB(B1, 1, 1); PG8_SCHED; PG8_LDA(At, 1, 0); PG8_STAGE(PG8_SA(0, 1), a2 + hstep, voffA);
            PG8_WAIT_V(8); PG8_WAIT_L(0); PG8_BAR; PG8_MMA(0, 0, At, B0); PG8_MMA(0, 1, At, B1); PG8_BAR; PG8_SCHED;
            PG8_LDA(At, 1, 1); PG8_STAGE(PG8_SB(1, 0), b3, voffB); PG8_STAGE(PG8_SB(1, 1), b3 + hstep, voffB); PG8_STAGE(PG8_SA(1, 0), a3, voffA);
            PG8_WAIT_V(8); PG8_WAIT_L(0); PG8_BAR; PG8_MMA(1, 0, At, B0); PG8_MMA(1, 1, At, B1); PG8_BAR; PG8_SCHED;
            } else {
            PG8_LDB(B0, 0, 0); PG8_SCHED; PG8_LDA(At, 0, 0); PG8_STAGE(PG8_SA(1, 1), a1 + hstep, voffA);
            PG8_WAIT_L(8); PG8_BAR; PG8_WAIT_L(0); PG8_MMA(0, 0, At, B0); PG8_BAR; PG8_SCHED;
            PG8_LDB(B1, 0, 1); PG8_STAGE(PG8_SB(0, 0), b2, voffB);
            PG8_BAR; PG8_WAIT_L(0); PG8_MMA(0, 1, At, B1); PG8_BAR;
            PG8_LDA(At, 0, 1); PG8_STAGE(PG8_SA(0, 0), a2, voffA);
            PG8_BAR; PG8_WAIT_L(0); PG8_MMA(1, 0, At, B0); PG8_BAR; PG8_SCHED;
            PG8_STAGE(PG8_SB(0, 1), b2 + hstep, voffB);
            PG8_WAIT_V(6); PG8_BAR; PG8_MMA(1, 1, At, B1); PG8_BAR;
            PG8_LDB(B0, 1, 0); PG8_SCHED; PG8_LDA(At, 1, 0); PG8_STAGE(PG8_SA(0, 1), a2 + hstep, voffA);
            PG8_WAIT_L(8); PG8_BAR; PG8_WAIT_L(0); PG8_MMA(0, 0, At, B0); PG8_BAR; PG8_SCHED;
            PG8_LDB(B1, 1, 1); PG8_STAGE(PG8_SB(1, 0), b3, voffB);
            PG8_BAR; PG8_WAIT_L(0); PG8_MMA(0, 1, At, B1); PG8_BAR;
            PG8_LDA(At, 1, 1); PG8_STAGE(PG8_SA(1, 0), a3, voffA);
            PG8_BAR; PG8_WAIT_L(0); PG8_MMA(1, 0, At, B0); PG8_BAR; PG8_SCHED;
            PG8_STAGE(PG8_SB(1, 1), b3 + hstep, voffB);
            PG8_WAIT_V(6); PG8_BAR; PG8_MMA(1, 1, At, B1); PG8_BAR;
            }
        }
        if constexpr (ALIGN_EPI) { if (wr == 0) PG8_BAR; }
        if constexpr (!Epi::AFTER_DRAIN) { E(acc, cur, wr, wc, fr, fq); S.done(cur); }
        if (!has_next) break;
#pragma unroll
        for (int a = 0; a < 2; ++a)
#pragma unroll
            for (int b = 0; b < 2; ++b)
#pragma unroll
                for (int m = 0; m < 4; ++m)
#pragma unroll
                    for (int n = 0; n < 2; ++n) acc[a][b][m][n] = (f32x4){0.f, 0.f, 0.f, 0.f};
        cur = nxt; cA = nA; cB = nB; ++ui;
        if constexpr (ALIGN_EPI) { if (wr == 1) PG8_BAR; }
    }
    PG8_WAIT_V(0);
    if constexpr (!ALIGN_EPI) { if (wr == 0) PG8_BAR; }
    PG8_BAR;
    if constexpr (Epi::AFTER_DRAIN) { E.fused(acc, cur, wr, wc, fr, fq, lds, wid, lane); S.done(cur); }
#undef PG8_SA
#undef PG8_SB
#undef PG8_STAGE
#undef PG8_LDA
#undef PG8_LDB
#undef PG8_MMA
#undef PG8_WAIT_V
#undef PG8_WAIT_L
#undef PG8_BAR
#undef PG8_SCHED
}
}

typedef unsigned short bf16_t;
typedef short bf16x8 __attribute__((ext_vector_type(8)));
typedef short s16x4 __attribute__((ext_vector_type(4)));
typedef float f32x4 __attribute__((ext_vector_type(4)));
typedef float f32x16 __attribute__((ext_vector_type(16)));
typedef unsigned u32x4 __attribute__((ext_vector_type(4)));
typedef unsigned u32x2 __attribute__((ext_vector_type(2)));
#define LAS __attribute__((address_space(3)))

constexpr int DM = 1024, NP = 16384, NS = 256, MA = NP + NS;
constexpr int NA = 3072, NB = 2304;
constexpr int KSROWS = 4160, SWROWS = 192;
constexpr float DN_ALPHA = 1.41421356237309515f;
constexpr float LOG2E = 1.4426950408889634f;
constexpr float C64 = 0.125f * LOG2E, THR64 = 64.f;
constexpr float C128 = 0.088388347648318440f * LOG2E, THR128 = 90.5f;
constexpr size_t OFF_DKP = 17039360, OFF_DVP = 25427968, OFF_DKS = 33816576, OFF_DVS = 33947648, OFF_SKP = 34078720, OFF_SVP = 34144256,
                 OFF_SKS = 34209792, OFF_SVS = 34471936, OFF_MKP = 34734080, OFF_MVP = 35782656;
constexpr size_t MiB = 1u << 20;
constexpr size_t WS_CTL = 0, WS_ROPE = 1 * MiB, WS_WA = 2 * MiB, WS_WB = 8 * MiB, WS_WM = 13 * MiB, WS_WO = 17 * MiB, WS_MEMB = 21 * MiB, WS_MKV = 23 * MiB,
                 WS_CMK = 27 * MiB, WS_CMV = 35 * MiB, WS_KSW = 43 * MiB, WS_VSW = 44 * MiB, WS_XA = 46 * MiB, WS_MIX = 79 * MiB, WS_Z0 = 112 * MiB,
                 WS_PA = 177 * MiB, WS_KS = 275 * MiB, WS_VS = 340 * MiB, WS_END = 405 * MiB;
constexpr int LDS_RING = 131072, LDS_BYTES = LDS_RING + 256;

__device__ __forceinline__ unsigned cvtpk(float lo, float hi) { unsigned r; asm volatile("v_cvt_pk_bf16_f32 %0, %1, %2" : "=v"(r) : "v"(lo), "v"(hi)); return r; }
__device__ __forceinline__ float bflo(unsigned w) { return __uint_as_float(w << 16); }
__device__ __forceinline__ float bfhi(unsigned w) { return __uint_as_float(w & 0xffff0000u); }
__device__ __forceinline__ float silu(float x) { return x * __builtin_amdgcn_rcpf(1.f + __expf(-x)); }
__device__ __forceinline__ void cvt8(const float* s, bf16_t* d) {
    const f32x4 a = __builtin_nontemporal_load((const f32x4*)s), b = __builtin_nontemporal_load((const f32x4*)(s + 4));
    u32x4 w; w.x = cvtpk(a.x, a.y); w.y = cvtpk(a.z, a.w); w.z = cvtpk(b.x, b.y); w.w = cvtpk(b.z, b.w); __builtin_nontemporal_store(w, (u32x4*)d);
}

__device__ __forceinline__ f32x4 shfl4(f32x4 v, int m) { f32x4 p; p.x = __shfl_xor(v.x, m); p.y = __shfl_xor(v.y, m); p.z = __shfl_xor(v.z, m); p.w = __shfl_xor(v.w, m); return p; }
struct NoPre {};
template <class F> struct EpiWrap {
    static constexpr bool PERM = true, AFTER_DRAIN = false;
    F f; int rowbase, colbase;
    __device__ __forceinline__ void operator()(const f32x4 (&acc)[2][2][4][2], const pg8::Unit& u, int wr, int wc, int fr, int fq) const {
        F lf = f;
#pragma unroll
        for (int ai = 0; ai < 2; ++ai)
#pragma unroll
            for (int mp = 0; mp < 2; ++mp) {
                typename F::Pre pr[2][2][2]; f32x4 vv[2][2][2];
                const int row0 = rowbase + u.pm * 256 + ai * 128 + wr * 64 + mp * 32 + fr, colb = colbase + u.pn * 256 + wc * 32 + 8 * fq;
                u32x4 p8[2][2];
#pragma unroll
                for (int mm = 0; mm < 2; ++mm) { lf.row_begin(mm, row0 + mm * 16);
#pragma unroll
                    for (int bj = 0; bj < 2; ++bj) {
                        if constexpr (F::PRE8) p8[mm][bj] = lf.pre8(row0 + mm * 16, colb + bj * 128);
                        else {
#pragma unroll
                            for (int n = 0; n < 2; ++n) pr[mm][bj][n] = lf.pre(row0 + mm * 16, colb + bj * 128 + n * 4); } } }
#pragma unroll
                for (int mm = 0; mm < 2; ++mm)
#pragma unroll
                    for (int bj = 0; bj < 2; ++bj)
#pragma unroll
                        for (int n = 0; n < 2; ++n) {
                            if constexpr (F::PRE8) vv[mm][bj][n] = lf.fix8(mm, colb + bj * 128 + n * 4, acc[ai][bj][mp * 2 + mm][n], p8[mm][bj], n);
                            else vv[mm][bj][n] = lf.fix(mm, colb + bj * 128 + n * 4, acc[ai][bj][mp * 2 + mm][n], pr[mm][bj][n]); }
#pragma unroll
                for (int mm = 0; mm < 2; ++mm) { const int row = row0 + mm * 16; lf.s = 0.f; lf.q = 0.f;
#pragma unroll
                    for (int bj = 0; bj < 2; ++bj) { const int col = colb + bj * 128; f32x4 p0 = vv[mm][bj][0], p1 = vv[mm][bj][1];
                        if constexpr (F::ROPE) { if (lf.need_rope(col - 8 * fq)) { p0 = shfl4(p0, 16); p1 = shfl4(p1, 16); } }
                        lf.oct(row, col, vv[mm][bj][0], vv[mm][bj][1], p0, p1); }
                    if constexpr (F::STATS) { float s = lf.s, q = lf.q; s += __shfl_xor(s, 16); s += __shfl_xor(s, 32); q += __shfl_xor(q, 16); q += __shfl_xor(q, 32);
                        if (fq == 0) lf.commit(row, s, q); } }
            }
    }
};
__device__ __forceinline__ f32x4 rope_apply(f32x4 v, f32x4 p, int col, int pos, const float* rope) {
    const float* t = rope + ((size_t)pos * 8 + (col & 4)) * 2;
    const f32x4 t0 = *(const f32x4*)t, t1 = *(const f32x4*)(t + 4);
    const float sg = (col & 8) ? 1.f : -1.f;
    f32x4 o; o.x = v.x * t0.x + sg * p.x * t0.y; o.y = v.y * t0.z + sg * p.y * t0.w; o.z = v.z * t1.x + sg * p.z * t1.y; o.w = v.w * t1.z + sg * p.w * t1.w;
    return o;
}
__device__ __forceinline__ void st_bf4(bf16_t* p, f32x4 v) { u32x2 w; w.x = cvtpk(v.x, v.y); w.y = cvtpk(v.z, v.w); *(u32x2*)p = w; }
__device__ __forceinline__ void st_bf8_nt(bf16_t* p, f32x4 a, f32x4 b) { u32x4 w; w.x = cvtpk(a.x, a.y); w.y = cvtpk(a.z, a.w); w.z = cvtpk(b.x, b.y); w.w = cvtpk(b.z, b.w); __builtin_nontemporal_store(w, (u32x4*)p); }
__device__ __forceinline__ void st_bf8(bf16_t* p, f32x4 a, f32x4 b) { u32x4 w; w.x = cvtpk(a.x, a.y); w.y = cvtpk(a.z, a.w); w.z = cvtpk(b.x, b.y); w.w = cvtpk(b.z, b.w); *(u32x4*)p = w; }
__device__ __forceinline__ void row_stats(const float* ST, int row, float& mu, float& rstd) {
    const float s = ST[2 * (size_t)row], q = ST[2 * (size_t)row + 1]; mu = s * (1.f / DM); rstd = rsqrtf(fmaxf(q * (1.f / DM) - mu * mu, 0.f) + 1e-5f);
}

struct EpiAF {
    static constexpr bool PRE8 = false; static constexpr bool ROPE = true, STATS = false; typedef NoPre Pre;
    bf16_t* PA; float* dout; bf16_t* KS; bf16_t* VS; const float* rope; float s, q;
    __device__ __forceinline__ void row_begin(int, int) {}
    __device__ __forceinline__ Pre pre(int, int) const { return Pre{}; }
    __device__ __forceinline__ f32x4 fix(int, int, f32x4 v, const Pre&) const { return v; }
    __device__ __forceinline__ bool need_rope(int col) const { return (col >> 9) < 2 && ((col >> 4) & 3) == 0; }
    __device__ __forceinline__ void commit(int, float, float) {}
    __device__ __forceinline__ void oct(int row, int col, f32x4 v0, f32x4 v1, f32x4 p0, f32x4 p1) {
        const bool samp = row >= NP; const int rs = row - NP;
        const int pos = samp ? 4096 + (rs & 15) : (row & 4095);
        const int region = col >> 9;
        if (need_rope(col)) { v0 = rope_apply(v0, p0, col, pos, rope); v1 = rope_apply(v1, p1, col + 4, pos, rope); }
        st_bf8(PA + (size_t)row * NA + col, v0, v1);
        if (region == 1 || region == 2) {
            const int c = col & 511;
            if (!samp) { float* o = dout + (region == 1 ? OFF_DKP : OFF_DVP) + (size_t)row * 512 + c; __builtin_nontemporal_store(v0, (f32x4*)o); __builtin_nontemporal_store(v1, (f32x4*)(o + 4)); }
            else { float* o = dout + (region == 1 ? OFF_DKS : OFF_DVS) + (size_t)rs * 512 + c; *(f32x4*)o = v0; *(f32x4*)(o + 4) = v1;
                   st_bf8((region == 1 ? KS : VS) + ((size_t)(rs >> 4) * KSROWS + 4096 + (rs & 15)) * 512 + c, v0, v1); }
        }
    }
    __device__ __forceinline__ void quad(int row, int col, f32x4 v, f32x4 p) {
        const bool samp = row >= NP; const int rs = row - NP;
        const int pos = samp ? 4096 + (rs & 15) : (row & 4095);
        const int region = col >> 9;
        if (need_rope(col)) v = rope_apply(v, p, col, pos, rope);
        st_bf4(PA + (size_t)row * NA + col, v);
        if (region == 1 || region == 2) {
            const int c = col & 511;
            if (!samp) __builtin_nontemporal_store(v, (f32x4*)(dout + (region == 1 ? OFF_DKP : OFF_DVP) + (size_t)row * 512 + c));
            else { *(f32x4*)(dout + (region == 1 ? OFF_DKS : OFF_DVS) + (size_t)rs * 512 + c) = v;
                   st_bf4((region == 1 ? KS : VS) + ((size_t)(rs >> 4) * KSROWS + 4096 + (rs & 15)) * 512 + c, v); }
        }
    }
};
struct EpiMemF {
    static constexpr bool PRE8 = false; static constexpr bool ROPE = false, STATS = false; typedef NoPre Pre;
    bf16_t* MKV; float* dout; float s, q;
    __device__ __forceinline__ void row_begin(int, int) {}
    __device__ __forceinline__ Pre pre(int, int) const { return Pre{}; }
    __device__ __forceinline__ f32x4 fix(int, int, f32x4 v, const Pre&) const { return v; }
    __device__ __forceinline__ void commit(int, float, float) {}
    __device__ __forceinline__ void oct(int row, int col, f32x4 v0, f32x4 v1, f32x4, f32x4) {
        st_bf8(MKV + (size_t)row * 2048 + col, v0, v1);
        const int l = col >> 10, c = col & 1023;
        float* o = dout + (c < 512 ? OFF_MKP : OFF_MVP) + (size_t)l * 524288 + (size_t)row * 512 + (c & 511);
        __builtin_nontemporal_store(v0, (f32x4*)o); __builtin_nontemporal_store(v1, (f32x4*)(o + 4));
    }
    __device__ __forceinline__ void quad(int row, int col, f32x4 v, f32x4) {
        st_bf4(MKV + (size_t)row * 2048 + col, v);
        const int l = col >> 10, c = col & 1023;
        __builtin_nontemporal_store(v, (f32x4*)(dout + (c < 512 ? OFF_MKP : OFF_MVP) + (size_t)l * 524288 + (size_t)row * 512 + (c & 511)));
    }
};
struct EpiMerge0F {
    static constexpr bool PRE8 = true; static constexpr bool ROPE = false, STATS = true; typedef u32x2 Pre;
    bf16_t* ZB; float* ST; float s, q;
    __device__ __forceinline__ void row_begin(int, int) {}
    __device__ __forceinline__ Pre pre(int row, int col) const { return *(const u32x2*)(ZB + (size_t)row * DM + col); }
    __device__ __forceinline__ f32x4 fix(int, int, f32x4 v, const Pre& x) const { return (f32x4){bflo(x.x), bfhi(x.x), bflo(x.y), bfhi(x.y)} * DN_ALPHA + v; }
    __device__ __forceinline__ u32x4 pre8(int row, int col) const { return *(const u32x4*)(ZB + (size_t)row * DM + col); }
    __device__ __forceinline__ f32x4 fix8(int, int, f32x4 v, const u32x4& x, int n) const { const unsigned a = n ? x.z : x.x, b = n ? x.w : x.y; return (f32x4){bflo(a), bfhi(a), bflo(b), bfhi(b)} * DN_ALPHA + v; }
    __device__ __forceinline__ void commit(int row, float ss, float qq) { atomicAdd(ST + 2 * (size_t)row, ss); atomicAdd(ST + 2 * (size_t)row + 1, qq); }
    __device__ __forceinline__ void oct(int row, int col, f32x4 z0, f32x4 z1, f32x4, f32x4) {
        st_bf8(ZB + (size_t)row * DM + col, z0, z1);
        s += ((z0.x + z0.y) + (z0.z + z0.w)) + ((z1.x + z1.y) + (z1.z + z1.w));
        q += ((z0.x * z0.x + z0.y * z0.y) + (z0.z * z0.z + z0.w * z0.w)) + ((z1.x * z1.x + z1.y * z1.y) + (z1.z * z1.z + z1.w * z1.w));
    }
    __device__ __forceinline__ void quad(int row, int col, f32x4 z, f32x4) {
        st_bf4(ZB + (size_t)row * DM + col, z);
        s += (z.x + z.y) + (z.z + z.w); q += (z.x * z.x + z.y * z.y) + (z.z * z.z + z.w * z.w);
    }
};
struct EpiMerge1F {
    static constexpr bool PRE8 = true; static constexpr bool ROPE = false, STATS = true; typedef u32x2 Pre;
    const bf16_t* ZB; const float* ST0; const float* g0; const float* b0; bf16_t* out; float* ST1; float s, q, mu[2], rstd[2];
    __device__ __forceinline__ void row_begin(int sl, int row) { row_stats(ST0, row, mu[sl], rstd[sl]); }
    __device__ __forceinline__ Pre pre(int row, int col) const { return *(const u32x2*)(ZB + (size_t)row * DM + col); }
    __device__ __forceinline__ f32x4 fix(int sl, int col, f32x4 v, const Pre& z) const {
        const f32x4 z0 = (f32x4){bflo(z.x), bfhi(z.x), bflo(z.y), bfhi(z.y)};
        const f32x4 g = *(const f32x4*)(g0 + col), b = *(const f32x4*)(b0 + col); return ((z0 - mu[sl]) * rstd[sl] * g + b) * DN_ALPHA + v; }
    __device__ __forceinline__ u32x4 pre8(int row, int col) const { return *(const u32x4*)(ZB + (size_t)row * DM + col); }
    __device__ __forceinline__ f32x4 fix8(int sl, int col, f32x4 v, const u32x4& z, int n) const { const unsigned a = n ? z.z : z.x, b = n ? z.w : z.y;
        const f32x4 z0 = (f32x4){bflo(a), bfhi(a), bflo(b), bfhi(b)};
        const f32x4 g = *(const f32x4*)(g0 + col), bb = *(const f32x4*)(b0 + col); return ((z0 - mu[sl]) * rstd[sl] * g + bb) * DN_ALPHA + v; }
    __device__ __forceinline__ void commit(int row, float ss, float qq) { atomicAdd(ST1 + 2 * (size_t)row, ss); atomicAdd(ST1 + 2 * (size_t)row + 1, qq); }
    __device__ __forceinline__ void oct(int row, int col, f32x4 z0, f32x4 z1, f32x4, f32x4) {
        st_bf8(out + (size_t)row * DM + col, z0, z1);
        s += ((z0.x + z0.y) + (z0.z + z0.w)) + ((z1.x + z1.y) + (z1.z + z1.w));
        q += ((z0.x * z0.x + z0.y * z0.y) + (z0.z * z0.z + z0.w * z0.w)) + ((z1.x * z1.x + z1.y * z1.y) + (z1.z * z1.z + z1.w * z1.w));
    }
    __device__ __forceinline__ void quad(int row, int col, f32x4 z, f32x4) {
        st_bf4(out + (size_t)row * DM + col, z);
        s += (z.x + z.y) + (z.z + z.w); q += (z.x * z.x + z.y * z.y) + (z.z * z.z + z.w * z.w);
    }
};
struct PreB { f32x4 c, b; };
struct EpiBF {
    static constexpr bool PRE8 = false; static constexpr bool ROPE = true, STATS = false; typedef PreB Pre;
    bf16_t* PB; float* dout; bf16_t* KSW; bf16_t* VSW; const float* rope; const float* ST0; const float* CS; const float* BW; float s, q, mu[2], rstd[2];
    __device__ __forceinline__ void row_begin(int sl, int row) { row_stats(ST0, row, mu[sl], rstd[sl]); }
    __device__ __forceinline__ Pre pre(int, int col) const { Pre p; p.c = *(const f32x4*)(CS + col); p.b = *(const f32x4*)(BW + col); return p; }
    __device__ __forceinline__ f32x4 fix(int sl, int, f32x4 v, const Pre& p) const { return (v - p.c * mu[sl]) * rstd[sl] + p.b; }
    __device__ __forceinline__ bool need_rope(int col) const { return (col < 512 || (col >= 2048 && col < 2176)) && ((col >> 4) & 3) == 0; }
    __device__ __forceinline__ void commit(int, float, float) {}
    __device__ __forceinline__ void oct(int row, int col, f32x4 v0, f32x4 v1, f32x4 p0, f32x4 p1) {
        const bool samp = row >= NP; const int rs = row - NP;
        const int t = samp ? (rs & 15) : (row & 4095);
        const int pos = samp ? 4096 + t : t;
        const bool isk = col >= 2048 && col < 2176;
        if (need_rope(col)) { v0 = rope_apply(v0, p0, col, pos, rope); v1 = rope_apply(v1, p1, col + 4, pos, rope); }
        st_bf8(PB + (size_t)row * NB + col, v0, v1);
        if (col >= 2048) {
            const int cc = col & 127;
            if (!samp) { if (t >= 3968) { float* o = dout + (isk ? OFF_SKP : OFF_SVP) + ((size_t)(row >> 12) * 128 + (t - 3968)) * 128 + cc; *(f32x4*)o = v0; *(f32x4*)(o + 4) = v1; } }
            else { const int b = rs >> 4;
                   float* o = dout + (isk ? OFF_SKS : OFF_SVS) + ((size_t)b * 128 + 112 + t) * 128 + cc; *(f32x4*)o = v0; *(f32x4*)(o + 4) = v1;
                   st_bf8((isk ? KSW : VSW) + ((size_t)b * SWROWS + 128 + t) * 128 + cc, v0, v1); }
        }
    }
    __device__ __forceinline__ void quad(int row, int col, f32x4 v, f32x4 p) {
        const bool samp = row >= NP; const int rs = row - NP;
        const int t = samp ? (rs & 15) : (row & 4095);
        const int pos = samp ? 4096 + t : t;
        const bool isk = col >= 2048 && col < 2176;
        if (need_rope(col)) v = rope_apply(v, p, col, pos, rope);
        st_bf4(PB + (size_t)row * NB + col, v);
        if (col >= 2048) {
            const int cc = col & 127;
            if (!samp) { if (t >= 3968) *(f32x4*)(dout + (isk ? OFF_SKP : OFF_SVP) + ((size_t)(row >> 12) * 128 + (t - 3968)) * 128 + cc) = v; }
            else { const int b = rs >> 4;
                   *(f32x4*)(dout + (isk ? OFF_SKS : OFF_SVS) + ((size_t)b * 128 + 112 + t) * 128 + cc) = v;
                   st_bf4((isk ? KSW : VSW) + ((size_t)b * SWROWS + 128 + t) * 128 + cc, v); }
        }
    }
};
template <class F> __device__ __forceinline__ void gemm_small(LAS unsigned char* lds, const bf16_t* A, const bf16_t* Bt, int N, int rowbase, int ustart, int G, const F& f, int colbase = 0) {
    const int tid = threadIdx.x, lane = tid & 63, r32 = lane & 31, hi = lane >> 5, wid = __builtin_amdgcn_readfirstlane(tid >> 6);
    const int nu = 8 * (N / 32);
    for (int u = ustart; u < nu; u += G) {
        const int row0 = (u & 7) * 32, colw = (u >> 3) * 32, col0 = colbase + colw;
        const bf16_t* ap = A + (size_t)(row0 + r32) * DM + wid * 128 + hi * 8; const bf16_t* bp = Bt + (size_t)(colw + r32) * DM + wid * 128 + hi * 8;
        bf16x8 af[8], bfr[8];
#pragma unroll
        for (int k = 0; k < 8; ++k) { af[k] = *(const bf16x8*)(ap + 16 * k); bfr[k] = *(const bf16x8*)(bp + 16 * k); }
        f32x16 acc = f32x16{};
#pragma unroll
        for (int k = 0; k < 8; ++k) acc = __builtin_amdgcn_mfma_f32_32x32x16_bf16(bfr[k], af[k], acc, 0, 0, 0);
        LAS float* part = (LAS float*)lds + wid * 1024;
#pragma unroll
        for (int r = 0; r < 16; ++r) part[r * 64 + lane] = acc[r];
        __syncthreads();
        if (wid < 2) {
            F lf = f; f32x4 qd[2];
#pragma unroll
            for (int e = 0; e < 2; ++e) { float t[4];
#pragma unroll
                for (int c = 0; c < 4; ++c) { const int r = 4 * (2 * wid + e) + c; float a = 0.f;
#pragma unroll
                    for (int w = 0; w < 8; ++w) a += ((LAS float*)lds)[w * 1024 + r * 64 + lane];
                    t[c] = a; }
                qd[e] = (f32x4){t[0], t[1], t[2], t[3]}; }
            const int row = rowbase + row0 + r32; typename F::Pre pr[2];
            lf.row_begin(0, row);
#pragma unroll
            for (int e = 0; e < 2; ++e) pr[e] = lf.pre(row, col0 + 8 * (2 * wid + e) + 4 * hi);
#pragma unroll
            for (int e = 0; e < 2; ++e) qd[e] = lf.fix(0, col0 + 8 * (2 * wid + e) + 4 * hi, qd[e], pr[e]);
            lf.s = 0.f; lf.q = 0.f;
#pragma unroll
            for (int e = 0; e < 2; ++e) lf.quad(row, col0 + 8 * (2 * wid + e) + 4 * hi, qd[e], qd[e ^ 1]);
            if constexpr (F::STATS) { float s = lf.s, q = lf.q; s += __shfl_xor(s, 32); q += __shfl_xor(q, 32); if (hi == 0) lf.commit(row, s, q); }
        }
        __syncthreads();
    }
}

namespace att {
#define KSWZ(row, colB) ((row) * 256 + ((colB) ^ (((row) & 15) << 4)))
#define SBAR() __builtin_amdgcn_sched_barrier(0)
__device__ __forceinline__ int v_st(int k, int c) { const int kk = (k & ~0xC) | ((k & 4) << 1) | ((k & 8) >> 1); return ((kk >> 3) * 4 + (c >> 5)) * 512 + ((kk & 7) * 32 + (c & 31)) * 2; }
__device__ __forceinline__ int v_rd_base(int lane) { return ((lane & 3) << 3) | (((lane >> 2) & 3) << 6) | (((lane >> 4) & 1) << 5) | (((lane >> 5) & 1) << 8); }
constexpr int v_rd_off(int d0, int ks, int half) { return d0 * 512 + ks * 4096 + half * 2048; }
template <int OFF> __device__ __forceinline__ s16x4 tr_read(int vb) {
    s16x4 r; asm volatile("ds_read_b64_tr_b16 %0, %1 offset:%2" : "=&v"(r) : "v"(vb), "i"(OFF) : "memory"); return r;
}
template <int OFF> __device__ __forceinline__ bf16x8 lds_read128(int ad) {
    bf16x8 r; asm volatile("ds_read_b128 %0, %1 offset:%2" : "=&v"(r) : "v"(ad), "i"(OFF) : "memory"); return r;
}
template <int D0> __device__ __forceinline__ void pv_one(f32x16& od, int vb, bf16x8 pa0, bf16x8 pa1, bf16x8 pa2, bf16x8 pa3) {
    const s16x4 l0 = tr_read<v_rd_off(D0, 0, 0)>(vb), h0 = tr_read<v_rd_off(D0, 0, 1)>(vb), l1 = tr_read<v_rd_off(D0, 1, 0)>(vb), h1 = tr_read<v_rd_off(D0, 1, 1)>(vb);
    const s16x4 l2 = tr_read<v_rd_off(D0, 2, 0)>(vb), h2 = tr_read<v_rd_off(D0, 2, 1)>(vb), l3 = tr_read<v_rd_off(D0, 3, 0)>(vb), h3 = tr_read<v_rd_off(D0, 3, 1)>(vb);
    asm volatile("s_waitcnt lgkmcnt(0)" ::: "memory"); SBAR();
#define PK(L, H) (bf16x8){L[0], L[1], L[2], L[3], H[0], H[1], H[2], H[3]}
    od = __builtin_amdgcn_mfma_f32_32x32x16_bf16(PK(l0, h0), pa0, od, 0, 0, 0);
    od = __builtin_amdgcn_mfma_f32_32x32x16_bf16(PK(l1, h1), pa1, od, 0, 0, 0);
    od = __builtin_amdgcn_mfma_f32_32x32x16_bf16(PK(l2, h2), pa2, od, 0, 0, 0);
    od = __builtin_amdgcn_mfma_f32_32x32x16_bf16(PK(l3, h3), pa3, od, 0, 0, 0);
#undef PK
}
template <int KSI, int DB, int ND> __device__ __forceinline__ void v_read(int vb, s16x4 (&l)[4], s16x4 (&h)[4]) {
    l[0] = tr_read<v_rd_off(DB, KSI, 0)>(vb); h[0] = tr_read<v_rd_off(DB, KSI, 1)>(vb);
    l[1] = tr_read<v_rd_off(DB + 1, KSI, 0)>(vb); h[1] = tr_read<v_rd_off(DB + 1, KSI, 1)>(vb);
    if constexpr (ND == 4) { l[2] = tr_read<v_rd_off(DB + 2, KSI, 0)>(vb); h[2] = tr_read<v_rd_off(DB + 2, KSI, 1)>(vb);
                             l[3] = tr_read<v_rd_off(DB + 3, KSI, 0)>(vb); h[3] = tr_read<v_rd_off(DB + 3, KSI, 1)>(vb); }
}
template <int ND> __device__ __forceinline__ void pv_mf(f32x16 (&o)[4], bf16x8 pa, const s16x4 (&l)[4], const s16x4 (&h)[4]) {
    __builtin_amdgcn_s_setprio(1);
#pragma unroll
    for (int d = 0; d < ND; ++d) o[d] = __builtin_amdgcn_mfma_f32_32x32x16_bf16((bf16x8){l[d][0], l[d][1], l[d][2], l[d][3], h[d][0], h[d][1], h[d][2], h[d][3]}, pa, o[d], 0, 0, 0);
    __builtin_amdgcn_s_setprio(0);
}
template <int DB, int ND> __device__ __forceinline__ void pv_ks(f32x16 (&o)[4], int vb, bf16x8 pa0, bf16x8 pa1, bf16x8 pa2, bf16x8 pa3) {
    s16x4 la[4], ha[4];
    v_read<0, DB, ND>(vb, la, ha); asm volatile("s_waitcnt lgkmcnt(0)" ::: "memory"); SBAR(); pv_mf<ND>(o, pa0, la, ha); SBAR();
    v_read<1, DB, ND>(vb, la, ha); asm volatile("s_waitcnt lgkmcnt(0)" ::: "memory"); SBAR(); pv_mf<ND>(o, pa1, la, ha); SBAR();
    v_read<2, DB, ND>(vb, la, ha); asm volatile("s_waitcnt lgkmcnt(0)" ::: "memory"); SBAR(); pv_mf<ND>(o, pa2, la, ha); SBAR();
    v_read<3, DB, ND>(vb, la, ha); asm volatile("s_waitcnt lgkmcnt(0)" ::: "memory"); SBAR(); pv_mf<ND>(o, pa3, la, ha);
}
template <int DB, int ND> __device__ __forceinline__ void pv_rest(f32x16 (&o)[4], int vb, bf16x8 pa0, bf16x8 pa1, bf16x8 pa2, bf16x8 pa3, s16x4 (&la)[4], s16x4 (&ha)[4]) {
    s16x4 lb[4], hb[4];
    asm volatile("s_waitcnt lgkmcnt(0)" ::: "memory"); SBAR(); v_read<1, DB, ND>(vb, lb, hb); SBAR(); pv_mf<ND>(o, pa0, la, ha); SBAR();
    asm volatile("s_waitcnt lgkmcnt(0)" ::: "memory"); SBAR(); v_read<2, DB, ND>(vb, la, ha); SBAR(); pv_mf<ND>(o, pa1, lb, hb); SBAR();
    asm volatile("s_waitcnt lgkmcnt(0)" ::: "memory"); SBAR(); v_read<3, DB, ND>(vb, lb, hb); SBAR(); pv_mf<ND>(o, pa2, la, ha); SBAR();
    asm volatile("s_waitcnt lgkmcnt(0)" ::: "memory"); SBAR(); pv_mf<ND>(o, pa3, lb, hb);
}
__device__ __forceinline__ void partialSM(f32x16& p0, f32x16& p1, float& m_reg, float& alpha, float C, float thr) {
    float pmax = p0[0];
#pragma unroll
    for (int r = 1; r < 16; ++r) pmax = fmaxf(pmax, p0[r]);
#pragma unroll
    for (int r = 0; r < 16; ++r) pmax = fmaxf(pmax, p1[r]);
    { auto rr = __builtin_amdgcn_permlane32_swap(__float_as_uint(pmax), __float_as_uint(pmax), false, false);
      pmax = fmaxf(__uint_as_float(rr[0]), __uint_as_float(rr[1])); }
    float mn;
    if (__all(pmax - m_reg <= thr)) { mn = m_reg; alpha = 1.f; }
    else { mn = fmaxf(m_reg, pmax); alpha = __builtin_amdgcn_exp2f((m_reg - mn) * C); m_reg = mn; }
    const float mnC = -mn * C;
#pragma unroll
    for (int r = 0; r < 16; ++r) p0[r] = __builtin_amdgcn_exp2f(fmaf(p0[r], C, mnC));
#pragma unroll
    for (int r = 0; r < 16; ++r) p1[r] = __builtin_amdgcn_exp2f(fmaf(p1[r], C, mnC));
}
__device__ __forceinline__ void finishSM(f32x16& p0, f32x16& p1, float alpha, float& l_reg, bf16x8& pa0, bf16x8& pa1, bf16x8& pa2, bf16x8& pa3) {
    float ps = 0;
#pragma unroll
    for (int r = 0; r < 16; ++r) ps += p0[r];
#pragma unroll
    for (int r = 0; r < 16; ++r) ps += p1[r];
    { auto rr = __builtin_amdgcn_permlane32_swap(__float_as_uint(ps), __float_as_uint(ps), false, false);
      ps = __uint_as_float(rr[0]) + __uint_as_float(rr[1]); }
    l_reg = l_reg * alpha + ps;
#define PK4(P, BASE, OUT) do { unsigned a0 = cvtpk(P[BASE + 0], P[BASE + 1]), a1 = cvtpk(P[BASE + 2], P[BASE + 3]);   \
    unsigned b0 = cvtpk(P[BASE + 4], P[BASE + 5]), b1 = cvtpk(P[BASE + 6], P[BASE + 7]);                              \
    auto r0 = __builtin_amdgcn_permlane32_swap(a0, b0, false, false); auto r1 = __builtin_amdgcn_permlane32_swap(a1, b1, false, false); \
    u32x4 w = {r0[0], r1[0], r0[1], r1[1]}; OUT = *reinterpret_cast<bf16x8*>(&w); } while (0)
    PK4(p0, 0, pa0); PK4(p0, 8, pa1); PK4(p1, 0, pa2); PK4(p1, 8, pa3);
#undef PK4
}
constexpr int RING = 32768;
template <int QS, bool PVHALF>
__device__ __forceinline__ void attn_core(LAS unsigned char* lds, const bf16_t* Kb, long ldk, const bf16_t* Vb, long ldv, int NT, int nkeys,
                                          const bf16_t* qptr, int wNT, int kcoffB, int pvsel, float C, float thr, f32x16 (&o)[4], float& m_reg, float& l_reg) {
    int tid = threadIdx.x; asm volatile("" : "+v"(tid));
    const int lane = tid & 63, r32 = lane & 31, hi = lane >> 5, wid = __builtin_amdgcn_readfirstlane(tid >> 6);
    bf16x8 qr[QS];
#pragma unroll
    for (int d0 = 0; d0 < QS; ++d0) qr[d0] = *(const bf16x8*)(qptr + d0 * 16);
#pragma unroll
    for (int d = 0; d < 4; ++d) o[d] = f32x16{};
    m_reg = -1e30f; l_reg = 0.f;
    long offK[2], offV[2];
#pragma unroll
    for (int i = 0; i < 2; ++i) { const int p = i * 8192 + wid * 1024 + lane * 16;
        const int row = p >> 8, colB = (p & 255) ^ ((row & 15) << 4); offK[i] = (long)row * ldk + (colB >> 1);
        const int sub = p >> 9, q = (p & 511) >> 1, kk = (sub >> 2) * 8 + (q >> 5), k = (kk & ~0xC) | ((kk & 4) << 1) | ((kk & 8) >> 1), c = (sub & 3) * 32 + (q & 31);
        offV[i] = (long)k * ldv + c; }
    const int vrb = v_rd_base(lane);
#define GLDS(t, bf) do { const bf16_t* kt_ = Kb + (long)(t) * 64 * ldk; const bf16_t* vt_ = Vb + (long)(t) * 64 * ldv; LAS unsigned char* b_ = lds + (bf) * RING + wid * 1024; \
    __builtin_amdgcn_global_load_lds((const unsigned*)(vt_ + offV[0]), (LAS unsigned*)(b_), 16, 0, 0); \
    __builtin_amdgcn_global_load_lds((const unsigned*)(vt_ + offV[1]), (LAS unsigned*)(b_ + 8192), 16, 0, 0); \
    __builtin_amdgcn_global_load_lds((const unsigned*)(kt_ + offK[0]), (LAS unsigned*)(b_ + 16384), 16, 0, 0); \
    __builtin_amdgcn_global_load_lds((const unsigned*)(kt_ + offK[1]), (LAS unsigned*)(b_ + 16384 + 8192), 16, 0, 0); } while (0)
    GLDS(0, 0);
#pragma unroll
    for (int d0 = 0; d0 < QS; ++d0) asm volatile("" :: "v"(qr[d0]));
    if (1 < NT) GLDS(1, 1); if (2 < NT) GLDS(2, 2);
    for (int j = 0; j < NT; ++j) {
        const int rem = NT - 1 - j;
        if (rem >= 2) asm volatile("s_waitcnt vmcnt(8)" ::: "memory"); else if (rem == 1) asm volatile("s_waitcnt vmcnt(4)" ::: "memory"); else asm volatile("s_waitcnt vmcnt(0)" ::: "memory");
        __builtin_amdgcn_s_barrier();
        asm volatile("" ::: "memory");
        if (j + 3 < NT) GLDS(j + 3, (j + 3) & 3);
        if (j < wNT) {
            const int cur = j & 3;
            f32x16 p0 = f32x16{}, p1 = f32x16{};
            const int kbase = (int)(uintptr_t)(lds + cur * RING + 16384) + r32 * 256;
            const int swz = (r32 & 15) << 4;
#pragma unroll
            for (int hq = 0; hq < QS / 4; ++hq) { bf16x8 b0[4], b1[4];
#pragma unroll
                for (int i = 0; i < 4; ++i) { const int cb = kcoffB + ((hq * 4 + i) * 16 + hi * 8) * 2; const int ad = kbase + (cb ^ swz);
                    b0[i] = lds_read128<0>(ad); b1[i] = lds_read128<8192>(ad); }
                asm volatile("s_waitcnt lgkmcnt(0)" ::: "memory"); SBAR();
#pragma unroll
                for (int i = 0; i < 4; ++i) { p0 = __builtin_amdgcn_mfma_f32_32x32x16_bf16(b0[i], qr[hq * 4 + i], p0, 0, 0, 0);
                    p1 = __builtin_amdgcn_mfma_f32_32x32x16_bf16(b1[i], qr[hq * 4 + i], p1, 0, 0, 0); } }
            if (__builtin_expect((j + 1) * 64 > nkeys, 0)) { const int kb = j * 64 + 4 * hi; asm volatile("" ::: "memory");
#pragma unroll
                for (int r = 0; r < 16; ++r) { const int kv = kb + (r & 3) + 8 * (r >> 2); if (kv >= nkeys) p0[r] = -1e30f; if (kv + 32 >= nkeys) p1[r] = -1e30f; } }
            float alpha; bf16x8 pa0, pa1, pa2, pa3;
            const int vb = (int)(uintptr_t)(lds + cur * RING) + vrb;
            s16x4 la[4], ha[4];
            partialSM(p0, p1, m_reg, alpha, C, thr);
            finishSM(p0, p1, alpha, l_reg, pa0, pa1, pa2, pa3);
            SBAR();
            if constexpr (QS == 4) { if constexpr (!PVHALF) v_read<0, 0, 4>(vb, la, ha); else { if (pvsel == 0) v_read<0, 0, 2>(vb, la, ha); else v_read<0, 2, 2>(vb, la, ha); } }
            SBAR();
            if (__any(alpha < 1.f)) {
#pragma unroll
                for (int d = 0; d < (PVHALF ? 2 : 4); ++d)
#pragma unroll
                    for (int r = 0; r < 16; ++r) o[d][r] *= alpha; }
            if constexpr (QS == 8) { pv_one<0>(o[0], vb, pa0, pa1, pa2, pa3); pv_one<1>(o[1], vb, pa0, pa1, pa2, pa3); pv_one<2>(o[2], vb, pa0, pa1, pa2, pa3); pv_one<3>(o[3], vb, pa0, pa1, pa2, pa3); }
            else if constexpr (!PVHALF) pv_rest<0, 4>(o, vb, pa0, pa1, pa2, pa3, la, ha);
            else { if (pvsel == 0) pv_rest<0, 2>(o, vb, pa0, pa1, pa2, pa3, la, ha); else pv_rest<2, 2>(o, vb, pa0, pa1, pa2, pa3, la, ha); }
        }
    }
#undef GLDS
    __syncthreads();
}

template <bool PVHALF>
__device__ __forceinline__ void attn_core_pipe(LAS unsigned char* lds, const bf16_t* Kb, long ldk, const bf16_t* Vb, long ldv, int NT, int nkeys,
                                               const bf16_t* qptr, int wNT, int kcoffB, int pvsel, float C, float thr, f32x16 (&o)[4], float& m_reg, float& l_reg) {
    int tid = threadIdx.x; asm volatile("" : "+v"(tid));
    const int lane = tid & 63, r32 = lane & 31, hi = lane >> 5, wid = __builtin_amdgcn_readfirstlane(tid >> 6);
    bf16x8 qr[4];
#pragma unroll
    for (int d0 = 0; d0 < 4; ++d0) qr[d0] = *(const bf16x8*)(qptr + d0 * 16);
#pragma unroll
    for (int d = 0; d < 4; ++d) o[d] = f32x16{};
    m_reg = -1e30f; l_reg = 0.f;
    int offK[2], offV[2];
#pragma unroll
    for (int i = 0; i < 2; ++i) { const int p = i * 8192 + wid * 1024 + lane * 16;
        const int row = p >> 8, colB = (p & 255) ^ ((row & 15) << 4); offK[i] = row * (int)ldk + (colB >> 1);
        const int sub = p >> 9, q = (p & 511) >> 1, kk = (sub >> 2) * 8 + (q >> 5), k = (kk & ~0xC) | ((kk & 4) << 1) | ((kk & 8) >> 1), c = (sub & 3) * 32 + (q & 31);
        offV[i] = k * (int)ldv + c; }
    const int vrb = v_rd_base(lane);
    int kad[4];
#pragma unroll
    for (int i = 0; i < 4; ++i) kad[i] = 16384 + r32 * 256 + ((kcoffB + (i * 16 + hi * 8) * 2) ^ ((r32 & 15) << 4));
    const int lds0 = (int)(uintptr_t)lds;
#define GLDS_V(t, bf) do { const bf16_t* vt_ = Vb + (long)(t) * 64 * ldv; LAS unsigned char* b_ = lds + (bf) * RING + wid * 1024; \
    __builtin_amdgcn_global_load_lds((const unsigned*)(vt_ + offV[0]), (LAS unsigned*)(b_), 16, 0, 0); \
    __builtin_amdgcn_global_load_lds((const unsigned*)(vt_ + offV[1]), (LAS unsigned*)(b_ + 8192), 16, 0, 0); } while (0)
#define GLDS_K(t, bf) do { const bf16_t* kt_ = Kb + (long)(t) * 64 * ldk; LAS unsigned char* b_ = lds + (bf) * RING + wid * 1024; \
    __builtin_amdgcn_global_load_lds((const unsigned*)(kt_ + offK[0]), (LAS unsigned*)(b_ + 16384), 16, 0, 0); \
    __builtin_amdgcn_global_load_lds((const unsigned*)(kt_ + offK[1]), (LAS unsigned*)(b_ + 16384 + 8192), 16, 0, 0); } while (0)
#define GLDS(t, bf) do { GLDS_V(t, bf); GLDS_K(t, bf); } while (0)
#define QK(P0, P1, bf) do { const int kb_ = lds0 + (bf) * RING; bf16x8 b0_[2], b1_[2]; \
    _Pragma("unroll") for (int i_ = 0; i_ < 2; ++i_) { b0_[i_] = lds_read128<0>(kb_ + kad[i_]); b1_[i_] = lds_read128<8192>(kb_ + kad[i_]); } \
    asm volatile("s_waitcnt lgkmcnt(0)" ::: "memory"); SBAR(); \
    P0 = __builtin_amdgcn_mfma_f32_32x32x16_bf16(b0_[0], qr[0], f32x16{}, 0, 0, 0); P1 = __builtin_amdgcn_mfma_f32_32x32x16_bf16(b1_[0], qr[0], f32x16{}, 0, 0, 0); \
    P0 = __builtin_amdgcn_mfma_f32_32x32x16_bf16(b0_[1], qr[1], P0, 0, 0, 0); P1 = __builtin_amdgcn_mfma_f32_32x32x16_bf16(b1_[1], qr[1], P1, 0, 0, 0); SBAR(); \
    _Pragma("unroll") for (int i_ = 0; i_ < 2; ++i_) { b0_[i_] = lds_read128<0>(kb_ + kad[2 + i_]); b1_[i_] = lds_read128<8192>(kb_ + kad[2 + i_]); } \
    asm volatile("s_waitcnt lgkmcnt(0)" ::: "memory"); SBAR(); \
    P0 = __builtin_amdgcn_mfma_f32_32x32x16_bf16(b0_[0], qr[2], P0, 0, 0, 0); P1 = __builtin_amdgcn_mfma_f32_32x32x16_bf16(b1_[0], qr[2], P1, 0, 0, 0); \
    P0 = __builtin_amdgcn_mfma_f32_32x32x16_bf16(b0_[1], qr[3], P0, 0, 0, 0); P1 = __builtin_amdgcn_mfma_f32_32x32x16_bf16(b1_[1], qr[3], P1, 0, 0, 0); \
    SBAR(); } while (0)
#define STEP(C0, C1, N0, N1, j) do { \
    if ((j) + 1 < NT) { \
        if ((j) + 2 < NT) asm volatile("s_waitcnt vmcnt(4)" ::: "memory"); else asm volatile("s_waitcnt vmcnt(0)" ::: "memory"); \
        __builtin_amdgcn_s_barrier(); asm volatile("" ::: "memory"); \
        if ((j) + 1 < wNT) QK(N0, N1, ((j) + 1) & 3); } \
    const bool iss_ = (j) + 3 < NT;                                 \
    if ((j) < wNT) { \
        if (__builtin_expect(((j) + 1) * 64 > nkeys, 0)) { const int kb = (j) * 64 + 4 * hi; asm volatile("" ::: "memory"); \
            _Pragma("unroll") for (int r = 0; r < 16; ++r) { const int kv = kb + (r & 3) + 8 * (r >> 2); if (kv >= nkeys) C0[r] = -1e30f; if (kv + 32 >= nkeys) C1[r] = -1e30f; } } \
        float alpha; bf16x8 pa0, pa1, pa2, pa3; const int vb = lds0 + ((j) & 3) * RING + vrb; \
        partialSM(C0, C1, m_reg, alpha, C, thr); \
        SBAR(); if (iss_) GLDS_V((j) + 3, ((j) + 3) & 3); SBAR(); \
        finishSM(C0, C1, alpha, l_reg, pa0, pa1, pa2, pa3); \
        SBAR(); if (iss_) GLDS_K((j) + 3, ((j) + 3) & 3); SBAR(); \
        if (__any(alpha < 1.f)) { \
            _Pragma("unroll") for (int d = 0; d < (PVHALF ? 2 : 4); ++d) _Pragma("unroll") for (int r = 0; r < 16; ++r) o[d][r] *= alpha; } \
        if constexpr (!PVHALF) pv_ks<0, 4>(o, vb, pa0, pa1, pa2, pa3); \
        else { if (pvsel == 0) pv_ks<0, 2>(o, vb, pa0, pa1, pa2, pa3); else pv_ks<2, 2>(o, vb, pa0, pa1, pa2, pa3); } } \
    else if (iss_) GLDS((j) + 3, ((j) + 3) & 3); \
    } while (0)
    GLDS(0, 0);
#pragma unroll
    for (int d0 = 0; d0 < 4; ++d0) asm volatile("" :: "v"(qr[d0]));
    if (1 < NT) GLDS(1, 1); if (2 < NT) GLDS(2, 2);
    if (NT > 2) asm volatile("s_waitcnt vmcnt(8)" ::: "memory"); else if (NT == 2) asm volatile("s_waitcnt vmcnt(4)" ::: "memory"); else asm volatile("s_waitcnt vmcnt(0)" ::: "memory");
    __builtin_amdgcn_s_barrier(); asm volatile("" ::: "memory");
    f32x16 pA0 = f32x16{}, pA1 = f32x16{}, pB0 = f32x16{}, pB1 = f32x16{};
    if (0 < wNT) QK(pA0, pA1, 0);
    for (int j = 0; j < NT; j += 2) {
        STEP(pA0, pA1, pB0, pB1, j);
        if (j + 1 < NT) STEP(pB0, pB1, pA0, pA1, j + 1);
    }
#undef STEP
#undef QK
#undef GLDS
#undef GLDS_V
#undef GLDS_K
    __syncthreads();
}

struct Ctx { LAS unsigned char* lds; int lane, wid, r32, hi; };

template <int ND> __device__ __forceinline__ void stage_piece(LAS unsigned char* stg, int lane, int d, int g, f32x4 v) {
    u32x2 w; w.x = cvtpk(v.x, v.y); w.y = cvtpk(v.z, v.w);
    *(LAS u32x2*)(stg + (lane & 31) * (64 * ND + 16) + (32 * d + 8 * g + 4 * (lane >> 5)) * 2) = w;
}
template <int ND> __device__ __forceinline__ void flush_rows(LAS unsigned char* stg, int lane, bf16_t* out_tile, int nvalid) {
    asm volatile("s_waitcnt lgkmcnt(0)" ::: "memory");
#pragma unroll
    for (int i = 0; i < 2 * ND; ++i) { const int c = i * 64 + lane, row = c / (4 * ND), ch = c % (4 * ND);
        const u32x4 w = *(const LAS u32x4*)(stg + row * (64 * ND + 16) + ch * 16);
        if (row < nvalid) *(u32x4*)(out_tile + (size_t)row * DM + ch * 8) = w; }
}
template <int ND> __device__ __forceinline__ void store_gated(const f32x16 (&o)[4], float scale, const bf16_t* gate, bf16_t* out_tile, int nvalid, LAS unsigned char* stg, int lane) {
    asm volatile("" : "+v"(lane));
    const int hi = lane >> 5;
#pragma unroll
    for (int d = 0; d < ND; ++d)
#pragma unroll
        for (int g = 0; g < 4; ++g) { const int dv = 32 * d + 8 * g + 4 * hi;
            const u32x2 gt = *(const u32x2*)(gate + dv);
            f32x4 v; v.x = o[d][4 * g] * scale * silu(bflo(gt.x)); v.y = o[d][4 * g + 1] * scale * silu(bfhi(gt.x));
            v.z = o[d][4 * g + 2] * scale * silu(bflo(gt.y)); v.w = o[d][4 * g + 3] * scale * silu(bfhi(gt.y));
            stage_piece<ND>(stg, lane, d, g, v); asm volatile("" ::: "memory"); }
    flush_rows<ND>(stg, lane, out_tile, nvalid);
}

__device__ __forceinline__ void diff_unit(const Ctx& cx, bool samp, int b, int h, int qb, const bf16_t* PA, const bf16_t* KS, const bf16_t* VS, bf16_t* MIX, const float* gnorm, float lam) {
    const int c = cx.wid >> 2, rb = cx.wid & 3;
    long row; bool valid; int NT, wNT, nkeys; const bf16_t* Kb; const bf16_t* Vb; long ldk;
    if (!samp) { row = (long)b * 4096 + qb * 128 + rb * 32 + cx.r32; valid = true; NT = 2 * qb + 2; wNT = 2 * qb + 1 + (rb >> 1); nkeys = NT * 64;
                 Kb = PA + (size_t)b * 4096 * NA + 512 + h * 128; Vb = Kb + 512; ldk = NA; }
    else { row = NP + b * 16 + (cx.r32 < 15 ? cx.r32 : 15); valid = (rb == 0) && cx.r32 < 16; NT = 65; wNT = (rb == 0) ? 65 : 0; nkeys = 4112;
           Kb = KS + (size_t)b * KSROWS * 512 + h * 128; Vb = VS + (size_t)b * KSROWS * 512 + h * 128; ldk = 512; }
    const bf16_t* qptr = PA + (size_t)row * NA + h * 128 + c * 64 + cx.hi * 8;
    f32x16 o[4]; float m, l;
    attn_core_pipe<false>(cx.lds, Kb, ldk, Vb, ldk, NT, nkeys, qptr, wNT, c * 128, 0, C64, THR64, o, m, l);
    const float inv = l > 0.f ? 1.f / l : 0.f;
    LAS float* xch = (LAS float*)cx.lds + rb * 4096;
    if (c == 1) {
#pragma unroll
        for (int d = 0; d < 4; ++d)
#pragma unroll
            for (int r = 0; r < 16; ++r) xch[(d * 16 + r) * 64 + cx.lane] = o[d][r] * inv; }
    __syncthreads();
    if (c == 0) {
        float ss = 0.f;
#pragma unroll
        for (int d = 0; d < 4; ++d)
#pragma unroll
            for (int r = 0; r < 16; ++r) { const float od = o[d][r] * inv - lam * xch[(d * 16 + r) * 64 + cx.lane]; o[d][r] = od; ss += od * od; }
        ss += __shfl_xor(ss, 32);
        const float rms = rsqrtf(ss * (1.f / 128.f) + 1e-5f) * 0.8f;
        {
            const bf16_t* gate = PA + (size_t)row * NA + 1536 + h * 128; LAS unsigned char* stg = cx.lds + 65536 + cx.wid * 9216;
            int ln = cx.lane; asm volatile("" : "+v"(ln));
#pragma unroll
            for (int d = 0; d < 4; ++d)
#pragma unroll
                for (int g = 0; g < 4; ++g) { const int dv = 32 * d + 8 * g + 4 * cx.hi;
                    const f32x4 gn = *(const f32x4*)(gnorm + dv); const u32x2 gt = *(const u32x2*)(gate + dv);
                    f32x4 v; v.x = o[d][4 * g] * rms * gn.x * silu(bflo(gt.x)); v.y = o[d][4 * g + 1] * rms * gn.y * silu(bfhi(gt.x));
                    v.z = o[d][4 * g + 2] * rms * gn.z * silu(bflo(gt.y)); v.w = o[d][4 * g + 3] * rms * gn.w * silu(bfhi(gt.y));
                    stage_piece<4>(stg, ln, d, g, v); asm volatile("" ::: "memory"); }
            flush_rows<4>(stg, ln, MIX + (size_t)(row - cx.r32) * DM + h * 128, valid ? 32 : 0);
        }
    }
    __syncthreads();
}
__device__ __forceinline__ void diff_sample_item(const Ctx& cx, int b, int h, int sp, const float* CK, const float* CV, const bf16_t* PA, const bf16_t* KS, const bf16_t* VS,
                                                 bf16_t* MIX, const float* gnorm, float lam, float* PART, unsigned* cnt, volatile LAS unsigned* MISC) {
    int tid = threadIdx.x; asm volatile("" : "+v"(tid));
    const int lane = tid & 63, r32 = lane & 31, hi = lane >> 5, wid = __builtin_amdgcn_readfirstlane(tid >> 6);
    const int c = wid >> 2; const bool active = (wid & 3) == 0;
    const size_t row = NP + b * 16 + (r32 < 15 ? r32 : 15);
    bf16x8 qr[4];
    { const bf16_t* qptr = PA + row * NA + h * 128 + c * 64 + hi * 8;
#pragma unroll
      for (int d0 = 0; d0 < 4; ++d0) qr[d0] = *(const bf16x8*)(qptr + d0 * 16); }
    f32x16 o[4];
#pragma unroll
    for (int d = 0; d < 4; ++d) o[d] = f32x16{};
    float m_reg = -1e30f, l_reg = 0.f;
    const int ntl = 16 + (sp == 3 ? 1 : 0);
    const int sr = tid >> 4, sc = (tid & 15) * 8;
    const float* kg = CK + ((size_t)(b * 4096 + sp * 1024 + sr) * 4 + h) * 128 + sc;
    const float* vg = CV + ((size_t)(b * 4096 + sp * 1024 + sr) * 4 + h) * 128 + sc;
    const bf16_t* kn = KS + ((size_t)b * KSROWS + 4096 + sr) * 512 + h * 128 + sc;
    const bf16_t* vn = VS + ((size_t)b * KSROWS + 4096 + sr) * 512 + h * 128 + sc;
    const int vst0 = v_st(sr, sc), vst1 = v_st(32 + sr, sc), kst0 = 16384 + KSWZ(sr, sc * 2), kst1 = 16384 + KSWZ(32 + sr, sc * 2);
    int kad[4];
#pragma unroll
    for (int i = 0; i < 4; ++i) kad[i] = 16384 + r32 * 256 + ((c * 128 + (i * 16 + hi * 8) * 2) ^ ((r32 & 15) << 4));
    const int lds0 = (int)(uintptr_t)cx.lds, vrb = v_rd_base(lane);
    f32x4 kfA[4], vfA[4], kfB[4], vfB[4];
#define LOADT(t, kf, vf) do { if ((t) < 16) { const float* kp_ = kg + (size_t)(t) * 64 * 512; const float* vp_ = vg + (size_t)(t) * 64 * 512; \
        kf[0] = __builtin_nontemporal_load((const f32x4*)kp_); kf[1] = __builtin_nontemporal_load((const f32x4*)(kp_ + 4)); kf[2] = __builtin_nontemporal_load((const f32x4*)(kp_ + 32 * 512)); kf[3] = __builtin_nontemporal_load((const f32x4*)(kp_ + 32 * 512 + 4)); \
        vf[0] = __builtin_nontemporal_load((const f32x4*)vp_); vf[1] = __builtin_nontemporal_load((const f32x4*)(vp_ + 4)); vf[2] = __builtin_nontemporal_load((const f32x4*)(vp_ + 32 * 512)); vf[3] = __builtin_nontemporal_load((const f32x4*)(vp_ + 32 * 512 + 4)); } \
    else { kf[0] = *(const f32x4*)kn; kf[2] = *(const f32x4*)(kn + 32 * 512); vf[0] = *(const f32x4*)vn; vf[2] = *(const f32x4*)(vn + 32 * 512); } } while (0)
#define CV8(A, B) ((u32x4){cvtpk(A.x, A.y), cvtpk(A.z, A.w), cvtpk(B.x, B.y), cvtpk(B.z, B.w)})
#define WRITET(t, bf, kf, vf) do { u32x4 k0_, k1_, v0_, v1_; \
    if ((t) < 16) { k0_ = CV8(kf[0], kf[1]); k1_ = CV8(kf[2], kf[3]); v0_ = CV8(vf[0], vf[1]); v1_ = CV8(vf[2], vf[3]); } \
    else { k0_ = __builtin_bit_cast(u32x4, kf[0]); k1_ = __builtin_bit_cast(u32x4, kf[2]); v0_ = __builtin_bit_cast(u32x4, vf[0]); v1_ = __builtin_bit_cast(u32x4, vf[2]); } \
    LAS unsigned char* b_ = cx.lds + (bf) * RING; \
    *(LAS u32x4*)(b_ + vst0) = v0_; *(LAS u32x4*)(b_ + vst1) = v1_; *(LAS u32x4*)(b_ + kst0) = k0_; *(LAS u32x4*)(b_ + kst1) = k1_; } while (0)
#define SCORE(t, cur) do { if (active) { \
            f32x16 p0, p1; \
            { const int kb_ = lds0 + (cur) * RING; bf16x8 b0_[2], b1_[2]; \
              _Pragma("unroll") for (int i = 0; i < 2; ++i) { b0_[i] = lds_read128<0>(kb_ + kad[i]); b1_[i] = lds_read128<8192>(kb_ + kad[i]); } \
              asm volatile("s_waitcnt lgkmcnt(0)" ::: "memory"); SBAR(); \
              p0 = __builtin_amdgcn_mfma_f32_32x32x16_bf16(b0_[0], qr[0], f32x16{}, 0, 0, 0); p1 = __builtin_amdgcn_mfma_f32_32x32x16_bf16(b1_[0], qr[0], f32x16{}, 0, 0, 0); \
              p0 = __builtin_amdgcn_mfma_f32_32x32x16_bf16(b0_[1], qr[1], p0, 0, 0, 0); p1 = __builtin_amdgcn_mfma_f32_32x32x16_bf16(b1_[1], qr[1], p1, 0, 0, 0); SBAR(); \
              _Pragma("unroll") for (int i = 0; i < 2; ++i) { b0_[i] = lds_read128<0>(kb_ + kad[2 + i]); b1_[i] = lds_read128<8192>(kb_ + kad[2 + i]); } \
              asm volatile("s_waitcnt lgkmcnt(0)" ::: "memory"); SBAR(); \
              p0 = __builtin_amdgcn_mfma_f32_32x32x16_bf16(b0_[0], qr[2], p0, 0, 0, 0); p1 = __builtin_amdgcn_mfma_f32_32x32x16_bf16(b1_[0], qr[2], p1, 0, 0, 0); \
              p0 = __builtin_amdgcn_mfma_f32_32x32x16_bf16(b0_[1], qr[3], p0, 0, 0, 0); p1 = __builtin_amdgcn_mfma_f32_32x32x16_bf16(b1_[1], qr[3], p1, 0, 0, 0); } \
            if ((t) >= 16) { \
                _Pragma("unroll") for (int r = 0; r < 16; ++r) { const int kv = 4 * hi + (r & 3) + 8 * (r >> 2); if (kv >= 16) p0[r] = -1e30f; p1[r] = -1e30f; } } \
            float alpha; bf16x8 pa0, pa1, pa2, pa3; \
            partialSM(p0, p1, m_reg, alpha, C64, THR64); \
            finishSM(p0, p1, alpha, l_reg, pa0, pa1, pa2, pa3); \
            SBAR(); \
            if (__any(alpha < 1.f)) { \
                _Pragma("unroll") for (int d = 0; d < 4; ++d) _Pragma("unroll") for (int r = 0; r < 16; ++r) o[d][r] *= alpha; } \
            pv_ks<0, 4>(o, lds0 + (cur) * RING + vrb, pa0, pa1, pa2, pa3); } } while (0)
    LOADT(0, kfA, vfA); LOADT(1, kfB, vfB); WRITET(0, 0, kfA, vfA); __syncthreads();
    for (int t = 0; t < ntl; t += 2) {
        if (t + 2 < ntl) LOADT(t + 2, kfA, vfA);
        SCORE(t, 0);
        if (t + 1 < ntl) WRITET(t + 1, 1, kfB, vfB);
        __syncthreads();
        if (t + 1 < ntl) {
            if (t + 3 < ntl) LOADT(t + 3, kfB, vfB);
            SCORE(t + 1, 1);
            if (t + 2 < ntl) WRITET(t + 2, 0, kfA, vfA);
            __syncthreads();
        }
    }
#undef SCORE
#undef LOADT
#undef WRITET
#undef CV8
    const int bh = b * 4 + h;
    if (active) { float* pb = PART + ((size_t)(bh * 4 + sp) * 2 + c) * (66 * 64) + lane;
#pragma unroll
        for (int d = 0; d < 4; ++d)
#pragma unroll
            for (int r = 0; r < 16; ++r) pb[(d * 16 + r) * 64] = o[d][r];
        pb[64 * 64] = m_reg; pb[65 * 64] = l_reg; }
    asm volatile("s_waitcnt vmcnt(0)" ::: "memory"); __syncthreads();
    if (tid == 0) { __builtin_amdgcn_fence(__ATOMIC_RELEASE, "agent"); asm volatile("s_waitcnt vmcnt(0)" ::: "memory");
                    const unsigned old = __hip_atomic_fetch_add(cnt + bh, 1u, __ATOMIC_RELAXED, __HIP_MEMORY_SCOPE_AGENT);
                    if (old == 3u) { __builtin_amdgcn_fence(__ATOMIC_ACQUIRE, "agent"); asm volatile("s_waitcnt vmcnt(0)" ::: "memory"); }
                    MISC[1] = old; }
    __syncthreads();
    const bool last = MISC[1] == 3u;
    if (last && wid == 0) {
        const float* pp = PART + (size_t)(bh * 4) * 2 * (66 * 64) + lane;
        float e0[4], e1[4], L0 = 0.f, L1 = 0.f;
        { float m0[4], m1[4], M0 = -1e30f, M1 = -1e30f;
#pragma unroll
          for (int q = 0; q < 4; ++q) { m0[q] = pp[(size_t)(q * 2) * (66 * 64) + 64 * 64]; m1[q] = pp[(size_t)(q * 2 + 1) * (66 * 64) + 64 * 64]; M0 = fmaxf(M0, m0[q]); M1 = fmaxf(M1, m1[q]); }
#pragma unroll
          for (int q = 0; q < 4; ++q) { e0[q] = __builtin_amdgcn_exp2f((m0[q] - M0) * C64); e1[q] = __builtin_amdgcn_exp2f((m1[q] - M1) * C64);
              L0 += e0[q] * pp[(size_t)(q * 2) * (66 * 64) + 65 * 64]; L1 += e1[q] * pp[(size_t)(q * 2 + 1) * (66 * 64) + 65 * 64]; } }
        const float i0 = 1.f / L0, i1 = lam / L1;
#pragma unroll
        for (int q = 0; q < 4; ++q) { e0[q] *= i0; e1[q] *= i1; }
        float ss = 0.f;
#pragma unroll
        for (int d = 0; d < 4; ++d)
#pragma unroll
            for (int r = 0; r < 16; ++r) { float od = 0.f;
#pragma unroll
                for (int q = 0; q < 4; ++q) od += e0[q] * pp[(size_t)(q * 2) * (66 * 64) + (d * 16 + r) * 64] - e1[q] * pp[(size_t)(q * 2 + 1) * (66 * 64) + (d * 16 + r) * 64];
                o[d][r] = od; ss += od * od; }
        ss += __shfl_xor(ss, 32);
        const float rms = rsqrtf(ss * (1.f / 128.f) + 1e-5f) * 0.8f;
        if (r32 < 16) {
            const bf16_t* gate = PA + row * NA + 1536 + h * 128; bf16_t* out = MIX + row * DM + h * 128;
#pragma unroll
            for (int d = 0; d < 4; ++d)
#pragma unroll
                for (int g = 0; g < 4; ++g) { const int dv = 32 * d + 8 * g + 4 * hi;
                    const f32x4 gn = *(const f32x4*)(gnorm + dv); const u32x2 gt = *(const u32x2*)(gate + dv);
                    f32x4 v; v.x = o[d][4 * g] * rms * gn.x * silu(bflo(gt.x)); v.y = o[d][4 * g + 1] * rms * gn.y * silu(bfhi(gt.x));
                    v.z = o[d][4 * g + 2] * rms * gn.z * silu(bflo(gt.y)); v.w = o[d][4 * g + 3] * rms * gn.w * silu(bfhi(gt.y));
                    st_bf4(out + dv, v); }
        }
    }
    __syncthreads();
}
__device__ __forceinline__ void mem_unit(const Ctx& cx, bool samp, int b, int h, int qb, const bf16_t* P, int ldp, int qcol, int gcol,
                                         const bf16_t* Kb, const bf16_t* Vb, long ldk, bf16_t* MIX) {
    long row; bool valid; int wNT;
    if (!samp) { row = (long)b * 4096 + qb * 256 + cx.wid * 32 + cx.r32; valid = true; wNT = 4; }
    else { row = NP + b * 16 + (cx.r32 < 15 ? cx.r32 : 15); valid = (cx.wid == 0) && cx.r32 < 16; wNT = (cx.wid == 0) ? 4 : 0; }
    const bf16_t* qptr = P + (size_t)row * ldp + qcol + h * 128 + cx.hi * 8;
    f32x16 o[4]; float m, l;
    attn_core<8, false>(cx.lds, Kb, ldk, Vb, ldk, 4, 256, qptr, wNT, 0, 0, C128, THR128, o, m, l);
    const float inv = l > 0.f ? 1.f / l : 0.f;
    store_gated<4>(o, inv, P + (size_t)row * ldp + gcol + h * 128, MIX + (size_t)(row - (samp ? (cx.r32 < 15 ? cx.r32 : 15) : cx.r32)) * DM + 512 + h * 128,
                   samp ? (cx.wid == 0 ? 16 : 0) : 32, cx.lds + cx.wid * 9216, cx.lane);
}
__device__ __forceinline__ void swa_unit(const Ctx& cx, bool samp, int b, int c, int half, const bf16_t* PB, const bf16_t* KSW, const bf16_t* VSW, bf16_t* MIX, const float* sinks) {
    const int head = cx.wid, kv = cx.wid >> 2;
    long row; bool valid; int NT, nkeys; const bf16_t* Kb; const bf16_t* Vb; long ldk;
    if (!samp) { row = (long)b * 4096 + c * 64 + half * 32 + cx.r32; valid = true; const int c0 = c > 2 ? c - 2 : 0; NT = c - c0 + 1; nkeys = NT * 64;
                 Kb = PB + ((size_t)b * 4096 + c0 * 64) * NB + 2048; Vb = Kb + 128; ldk = NB; }
    else { row = NP + b * 16 + (cx.r32 < 15 ? cx.r32 : 15); valid = cx.r32 < 16; NT = 3; nkeys = 144;
           Kb = KSW + (size_t)b * SWROWS * 128; Vb = VSW + (size_t)b * SWROWS * 128; ldk = 128; }
    const bf16_t* qptr = PB + (size_t)row * NB + head * 64 + cx.hi * 8;
    f32x16 o[4]; float m, l;
    attn_core_pipe<true>(cx.lds, Kb, ldk, Vb, ldk, NT, nkeys, qptr, NT, kv * 128, kv, C64, THR64, o, m, l);
    const float lt = l + __builtin_amdgcn_exp2f(sinks[head] * LOG2E - m * C64);
    const float inv = 1.f / lt;
    store_gated<2>(o, inv, PB + (size_t)row * NB + 512 + head * 64, MIX + (size_t)(row - (samp ? (cx.r32 < 15 ? cx.r32 : 15) : cx.r32)) * DM + head * 64, samp ? 16 : 32, cx.lds + cx.wid * 9216, cx.lane);
}
#undef KSWZ
#undef SBAR
}

__device__ __forceinline__ float wave_sum(float v) {
#pragma unroll
    for (int o = 1; o < 64; o <<= 1) v += __shfl_xor(v, o);
    return v;
}
__device__ __forceinline__ void p0_transpose_item(const float* W, int K, int N, bf16_t* WT, int row_off, LAS float* scr, int item, int lane) {
    const int nblk = N / 32, kb = item / nblk, nb = item % nblk, k0 = 64 * kb, n0 = 32 * nb;
#pragma unroll 8
    for (int i = 0; i < 32; ++i) { const int kk = 2 * i + (lane >> 5); scr[kk * 33 + (lane & 31)] = __builtin_nontemporal_load(W + (size_t)(k0 + kk) * N + n0 + (lane & 31)); }
    asm volatile("s_waitcnt lgkmcnt(0)" ::: "memory");
    const int c = lane & 7;
#pragma unroll
    for (int j = 0; j < 4; ++j) { const int n = (lane >> 3) + 8 * j; const LAS float* s = scr + (8 * c) * 33 + n;
        u32x4 o; o.x = cvtpk(s[0 * 33], s[1 * 33]); o.y = cvtpk(s[2 * 33], s[3 * 33]); o.z = cvtpk(s[4 * 33], s[5 * 33]); o.w = cvtpk(s[6 * 33], s[7 * 33]);
        *(u32x4*)(WT + (size_t)(row_off + n0 + n) * K + k0 + 8 * c) = o; }
    asm volatile("s_waitcnt lgkmcnt(0)" ::: "memory");
}
__device__ __forceinline__ void p0_transpose_item_ln(const float* W, int K, int N, bf16_t* WT, int row_off, LAS float* scr, int item, int lane, const float* g, const float* b, float* CS, float* BW) {
    const int nblk = N / 32, kb = item / nblk, nb = item % nblk, k0 = 64 * kb, n0 = 32 * nb;
    float csp = 0.f, bwp = 0.f;
#pragma unroll 8
    for (int i = 0; i < 32; ++i) { const int kk = 2 * i + (lane >> 5); const float w = __builtin_nontemporal_load(W + (size_t)(k0 + kk) * N + n0 + (lane & 31)); const float gw = g[k0 + kk] * w;
        scr[kk * 33 + (lane & 31)] = gw; csp += bflo(cvtpk(gw, 0.f)); bwp += b[k0 + kk] * w; }
    csp += __shfl_xor(csp, 32); bwp += __shfl_xor(bwp, 32);
    if (lane < 32) { atomicAdd(CS + row_off + n0 + lane, csp); atomicAdd(BW + row_off + n0 + lane, bwp); }
    asm volatile("s_waitcnt lgkmcnt(0)" ::: "memory");
    const int c = lane & 7;
#pragma unroll
    for (int j = 0; j < 4; ++j) { const int n = (lane >> 3) + 8 * j; const LAS float* sp = scr + (8 * c) * 33 + n;
        u32x4 o; o.x = cvtpk(sp[0 * 33], sp[1 * 33]); o.y = cvtpk(sp[2 * 33], sp[3 * 33]); o.z = cvtpk(sp[4 * 33], sp[5 * 33]); o.w = cvtpk(sp[6 * 33], sp[7 * 33]);
        *(u32x4*)(WT + (size_t)(row_off + n0 + n) * K + k0 + 8 * c) = o; }
    asm volatile("s_waitcnt lgkmcnt(0)" ::: "memory");
}
__device__ __forceinline__ void ln_rows(const float* zin, float* fout, bf16_t* bout, const float* g, const float* bta, int gw, int NGW, int lane) {
    f32x4 g4[4], b4[4];
#pragma unroll
    for (int j = 0; j < 4; ++j) { g4[j] = *(const f32x4*)(g + 4 * lane + 256 * j); b4[j] = *(const f32x4*)(bta + 4 * lane + 256 * j); }
    for (int m = gw; m < MA; m += NGW) {
        const float* zr = zin + (size_t)m * DM + 4 * lane;
        f32x4 v[4]; float s = 0.f;
#pragma unroll
        for (int j = 0; j < 4; ++j) { v[j] = *(const f32x4*)(zr + 256 * j); s += (v[j].x + v[j].y) + (v[j].z + v[j].w); }
        const float mean = wave_sum(s) * (1.f / DM); float s2 = 0.f;
#pragma unroll
        for (int j = 0; j < 4; ++j) { v[j] = v[j] - mean; s2 += (v[j].x * v[j].x + v[j].y * v[j].y) + (v[j].z * v[j].z + v[j].w * v[j].w); }
        const float rstd = rsqrtf(wave_sum(s2) * (1.f / DM) + 1e-5f);
#pragma unroll
        for (int j = 0; j < 4; ++j) { const f32x4 y = v[j] * rstd * g4[j] + b4[j];
            *(f32x4*)(fout + (size_t)m * DM + 4 * lane + 256 * j) = y;
            if (bout) st_bf4(bout + (size_t)m * DM + 4 * lane + 256 * j, y); }
    }
}

#define XB_TMO      128
#define XB_XCNT(j)  (256  + 64 * (j))
#define XB_XSUB(j)  (1280 + 64 * (j))
#define XB_XGEN(j)  (2304 + 64 * (j))
#define XB_TOP      3328
#define XB_TOPGEN   3392
#define XCD_BAR_WORDS 3456
#define XB_SPIN_CAP (1u << 18)

__device__ __forceinline__ unsigned xb_ld(unsigned* p)              { return __hip_atomic_load(p, __ATOMIC_RELAXED, __HIP_MEMORY_SCOPE_AGENT); }
__device__ __forceinline__ unsigned xb_add(unsigned* p, unsigned v) { return __hip_atomic_fetch_add(p, v, __ATOMIC_RELAXED, __HIP_MEMORY_SCOPE_AGENT); }
__device__ __forceinline__ unsigned xb_xcc_id() { return (unsigned)__builtin_amdgcn_s_getreg((3 << 11) | 20) & 0xFu; }
#define XB_SPIN(cond, bar) do { unsigned _sp = 0; while (cond) { __builtin_amdgcn_s_sleep(1); \
    if ((++_sp & 255u) == 0u) { if (xb_ld(&(bar)[XB_TMO])) break; if (_sp > XB_SPIN_CAP) { atomicAdd(&(bar)[XB_TMO], 1u); break; } } } } while (0)

struct XcdBarrier {
    unsigned* bar; unsigned x;
    volatile LAS unsigned* st;
};

__device__ __forceinline__ XcdBarrier xcd_barrier_post(unsigned* bar, volatile LAS unsigned* st) {
    XcdBarrier b; b.bar = bar; b.x = xb_xcc_id(); b.st = st;
    if (threadIdx.x == 0) (void)xb_add(&bar[XB_XCNT(b.x)], 1u);
    return b;
}
__device__ __forceinline__ void xcd_barrier_complete(unsigned* bar, unsigned x, unsigned& nloc, unsigned& nx) {
    const unsigned G = gridDim.x * gridDim.y * gridDim.z;
    unsigned sum, cnt, mine, sp = 0u;
    for (;;) {
        sum = 0u; cnt = 0u; mine = 0u;
#pragma unroll
        for (unsigned j = 0; j < 16; ++j) { const unsigned c = xb_ld(&bar[XB_XCNT(j)]); sum += c; cnt += (c > 0u) ? 1u : 0u; mine = (j == x) ? c : mine; }
        if (sum == G) break;
        __builtin_amdgcn_s_sleep(1);
        if ((++sp & 255u) == 0u) { if (xb_ld(&bar[XB_TMO])) break; if (sp > XB_SPIN_CAP) { atomicAdd(&bar[XB_TMO], 1u); break; } }
    }
    nloc = mine > 0u ? mine : 1u; nx = cnt > 0u ? cnt : 1u;
}

__device__ __forceinline__ void xcd_barrier(const XcdBarrier& b) {
    asm volatile("s_waitcnt vmcnt(0)" ::: "memory");
    __syncthreads();
    if (threadIdx.x == 0) {
        unsigned* bar = b.bar;
        __builtin_amdgcn_s_waitcnt(0);
        unsigned nloc = b.st[0], nx = b.st[1];
        if (nloc == 0u) { xcd_barrier_complete(bar, b.x, nloc, nx); b.st[0] = nloc; b.st[1] = nx; }
        const unsigned old = xb_add(&bar[XB_XSUB(b.x)], 1u);
        const unsigned gen = old / nloc;
        if (old + 1u == (gen + 1u) * nloc) {
            __builtin_amdgcn_fence(__ATOMIC_RELEASE, "agent");
            asm volatile("s_waitcnt vmcnt(0)" ::: "memory");
            const unsigned og = xb_add(&bar[XB_TOP], 1u);
            const unsigned tg = og / nx;
            if (og + 1u == (tg + 1u) * nx) xb_add(&bar[XB_TOPGEN], 1u);
            else XB_SPIN(xb_ld(&bar[XB_TOPGEN]) == tg, bar);
            __builtin_amdgcn_fence(__ATOMIC_ACQUIRE, "agent");
            xb_add(&bar[XB_XGEN(b.x)], 1u);
            asm volatile("s_waitcnt vmcnt(0)" ::: "memory");
        } else {
            XB_SPIN(xb_ld(&bar[XB_XGEN(b.x)]) == gen, bar);
            __builtin_amdgcn_fence(__ATOMIC_ACQUIRE, "agent");
            asm volatile("s_waitcnt vmcnt(0)" ::: "memory");
        }
    }
    __syncthreads();
}

struct Args { const float* in[22]; float* out; unsigned char* ws; int ph_lo, ph_hi, rep, pad; };
constexpr int NWAVES = 8, NPHASE = 9;

__global__ void __launch_bounds__(NWAVES * 64, 2) yoco_fwd(Args a) {
    extern __shared__ __attribute__((aligned(16))) unsigned char lds_raw[];
    LAS unsigned char* lds = (LAS unsigned char*)lds_raw;
    volatile LAS unsigned* MISC = (volatile LAS unsigned*)(lds + LDS_RING);
    cg::grid_group grid = cg::this_grid();
    const int tid = threadIdx.x, lane = tid & 63, wave = __builtin_amdgcn_readfirstlane(tid >> 6);
    const int G = gridDim.x, gw = blockIdx.x * NWAVES + wave, NGW = G * NWAVES;
    const long gtid = (long)blockIdx.x * (NWAVES * 64) + tid, NTHR = (long)G * (NWAVES * 64);
    unsigned char* ws = a.ws; float* dout = a.out;
    unsigned* ctl = (unsigned*)(ws + WS_CTL);
    float* ROPE = (float*)(ws + WS_ROPE);
    float* CSV = (float*)(ws + 32768); float* BWV = (float*)(ws + 49152); float* ST0 = (float*)(ws + 262144); float* ST1 = (float*)(ws + 524288);
    bf16_t* WA_t = (bf16_t*)(ws + WS_WA); bf16_t* WB_t = (bf16_t*)(ws + WS_WB); bf16_t* WM_t = (bf16_t*)(ws + WS_WM); bf16_t* WO_t = (bf16_t*)(ws + WS_WO);
    bf16_t* MEMB = (bf16_t*)(ws + WS_MEMB); bf16_t* MKV = (bf16_t*)(ws + WS_MKV); bf16_t* CMK = (bf16_t*)(ws + WS_CMK); bf16_t* CMV = (bf16_t*)(ws + WS_CMV);
    bf16_t* KSW = (bf16_t*)(ws + WS_KSW); bf16_t* VSW = (bf16_t*)(ws + WS_VSW); bf16_t* XA = (bf16_t*)(ws + WS_XA); bf16_t* ZB = XA;
    bf16_t* MIX = (bf16_t*)(ws + WS_MIX); bf16_t* Z1B = (bf16_t*)(ws + WS_Z0); bf16_t* PA = (bf16_t*)(ws + WS_PA); bf16_t* PB = PA;
    bf16_t* KS = (bf16_t*)(ws + WS_KS); bf16_t* VS = (bf16_t*)(ws + WS_VS);
    const int lo = a.ph_lo, hi_ph = a.ph_hi;
#define IN(k) (lo <= (k) && (k) < hi_ph)
    if (tid < 64) MISC[tid] = 0u;
    __syncthreads();
    XcdBarrier xbar = xcd_barrier_post(ctl + 1024, MISC + 8);
    if (a.ph_lo > 1000) grid.sync();
#define SEAM(k) do { if (IN(k) && IN((k) + 1)) xcd_barrier(xbar); } while (0)
    att::Ctx cx; cx.lds = lds; cx.lane = lane; cx.wid = wave; cx.r32 = lane & 31; cx.hi = lane >> 5;

    if (IN(0)) {
        LAS float* scr = (LAS float*)(lds + wave * 16384);
        for (int it = gw; it < 4736; it += NGW) {
            int r = it;
            if (r < 1536) { p0_transpose_item(a.in[9], DM, NA, WA_t, 0, scr, r, lane); continue; } r -= 1536;
            if (r < 1024) { p0_transpose_item_ln(a.in[15], DM, 2048, WB_t, 0, scr, r, lane, a.in[20], a.in[21], CSV, BWV); continue; } r -= 1024;
            if (r < 128) { p0_transpose_item_ln(a.in[17], DM, 256, WB_t, 2048, scr, r, lane, a.in[20], a.in[21], CSV, BWV); continue; } r -= 128;
            if (r < 1024) { const int l = r >> 9; p0_transpose_item(a.in[18] + (size_t)l * DM * DM, DM, DM, WM_t, l * 1024, scr, r & 511, lane); continue; } r -= 1024;
            { const int l = r >> 9; p0_transpose_item(a.in[19] + (size_t)l * DM * DM, DM, DM, WO_t, l * 1024, scr, r & 511, lane); }
        }
        for (long i = gtid; i < 2097152; i += NTHR) cvt8(a.in[0] + i * 8, XA + i * 8);
        for (long i = gtid; i < 32768; i += NTHR) cvt8(a.in[1] + i * 8, XA + (size_t)NP * DM + i * 8);
        for (long i = gtid; i < 131072; i += NTHR) cvt8(a.in[2] + i * 8, MEMB + i * 8);
        for (long i = gtid; i < 524288; i += NTHR) { cvt8(a.in[7] + i * 8, CMK + i * 8); cvt8(a.in[8] + i * 8, CMV + i * 8); }
        for (long i = gtid; i < 32768; i += NTHR) { const long b = i >> 11, r = i & 2047; const size_t d = (size_t)b * SWROWS * 128 + r * 8;
            cvt8(a.in[5] + i * 8, KSW + d); cvt8(a.in[6] + i * 8, VSW + d);
            const int rw = (int)(r >> 4);
            if (rw >= 16) { const size_t od = ((size_t)b * 128 + rw - 16) * 128 + (r & 15) * 8;
                *(f32x4*)(dout + OFF_SKS + od) = *(const f32x4*)(a.in[5] + i * 8); *(f32x4*)(dout + OFF_SKS + od + 4) = *(const f32x4*)(a.in[5] + i * 8 + 4);
                *(f32x4*)(dout + OFF_SVS + od) = *(const f32x4*)(a.in[6] + i * 8); *(f32x4*)(dout + OFF_SVS + od + 4) = *(const f32x4*)(a.in[6] + i * 8 + 4); } }
        for (long i = gtid; i < 49152; i += NTHR) { const long b = i / 3072, r = i % 3072; const size_t d = ((size_t)b * KSROWS + 4112) * 512 + r * 8;
            *(u32x4*)(KS + d) = (u32x4){0u, 0u, 0u, 0u}; *(u32x4*)(VS + d) = (u32x4){0u, 0u, 0u, 0u}; }
        for (long i = gtid; i < 12288; i += NTHR) { const long b = i / 768, r = i % 768; const size_t d = ((size_t)b * SWROWS + 144) * 128 + r * 8;
            *(u32x4*)(KSW + d) = (u32x4){0u, 0u, 0u, 0u}; *(u32x4*)(VSW + d) = (u32x4){0u, 0u, 0u, 0u}; }
        for (long i = gtid; i < 4112 * 8; i += NTHR) { const int pos = (int)(i >> 3), fi = (int)(i & 7);
            const double inv = fi == 0 ? 1.0 : fi == 1 ? 0.19392274474868576 : fi == 2 ? 0.03760603093086393 : fi == 3 ? 0.007292664737217109 :
                               fi == 4 ? 0.001414213562373095 : fi == 5 ? 0.0002742481756762073 : fi == 6 ? 5.318295896944988e-05 : 1.031338537721246e-05;
            const double rev = (double)pos * inv * 0.15915494309189535; const float fr = (float)(rev - __builtin_rint(rev));
            ROPE[i * 2] = __builtin_amdgcn_cosf(fr); ROPE[i * 2 + 1] = __builtin_amdgcn_sinf(fr); }
    }
    SEAM(0);
    if (IN(1)) {
        pg8::Gemm g{XA, WA_t, NP, NA, DM}; pg8::StaticOrder S; S.init(NP, NA, G, (int)blockIdx.x);
        EpiWrap<EpiAF> E{{PA, dout, KS, VS, ROPE, 0.f, 0.f}, 0, 0};
        pg8::gemm_phase<EpiWrap<EpiAF>, pg8::StaticOrder, true, true>(lds, g, S, E);
    }
    SEAM(1);
    if (IN(2)) {
        float s1 = 0.f, s2 = 0.f;
        for (int i = 0; i < 64; ++i) { s1 += a.in[10][i] * a.in[11][i]; s2 += a.in[12][i] * a.in[13][i]; }
        if (tid == 0) MISC[2] = __float_as_uint(__expf(s1) - __expf(s2) + 0.2f);
        __syncthreads();
        unsigned* gdone = ctl + 256 + 64 * a.rep;
        if (blockIdx.x < 44) {
            if (blockIdx.x < 32) { pg8::Gemm g{MEMB, WM_t, 1024, 2048, DM}; pg8::StaticOrder S; S.init(1024, 2048, 32, (int)blockIdx.x);
                EpiWrap<EpiMemF> E{{MKV, dout, 0.f, 0.f}, 0, 0};
                pg8::gemm_phase<EpiWrap<EpiMemF>, pg8::StaticOrder, true, true>(lds, g, S, E); }
            else { pg8::Gemm g{XA + (size_t)NP * DM, WA_t, 256, NA, DM}; pg8::StaticOrder S; S.init(256, NA, 12, (int)blockIdx.x - 32);
                EpiWrap<EpiAF> E{{PA, dout, KS, VS, ROPE, 0.f, 0.f}, NP, 0};
                pg8::gemm_phase<EpiWrap<EpiAF>, pg8::StaticOrder, true, true>(lds, g, S, E); }
            asm volatile("s_waitcnt vmcnt(0)" ::: "memory"); __syncthreads();
            if (tid == 0) { __builtin_amdgcn_fence(__ATOMIC_RELEASE, "agent"); asm volatile("s_waitcnt vmcnt(0)" ::: "memory");
                            __hip_atomic_fetch_add(gdone, 1u, __ATOMIC_RELAXED, __HIP_MEMORY_SCOPE_AGENT); }
        }
        bool ready = false;
        float* PART = (float*)(ws + WS_Z0 + 40 * MiB + (size_t)a.rep * (10 * MiB));
        for (;;) {
            if (tid == 0) MISC[0] = atomicAdd(ctl + 128 * a.rep, 1u);
            __syncthreads(); const unsigned u = MISC[0]; __syncthreads();
            if (u >= 1088u) break;
            const bool needs = (u >= 256u && u < 512u) || u >= 768u;
            if (needs && !ready) {
                if (tid == 0) { unsigned sp = 0; while (__hip_atomic_load(gdone, __ATOMIC_RELAXED, __HIP_MEMORY_SCOPE_AGENT) < 44u && ++sp < (1u << 24)) __builtin_amdgcn_s_sleep(8);
                                __builtin_amdgcn_fence(__ATOMIC_ACQUIRE, "agent"); asm volatile("s_waitcnt vmcnt(0)" ::: "memory"); }
                __syncthreads(); ready = true;
            }
            if (u < 768u) {
                const float lam = __uint_as_float(MISC[2]);
                if (u >= 256u && u < 512u) { const unsigned v = u - 256u;
                    att::diff_sample_item(cx, (int)(v >> 4), (int)((v >> 2) & 3u), (int)(v & 3u), a.in[3], a.in[4], PA, KS, VS, MIX, a.in[14], lam, PART, ctl + 512 + 64 * a.rep, MISC); }
                else { const unsigned v = u < 256u ? u : u - 256u;
                    att::diff_unit(cx, false, (int)((v & 15u) >> 2), (int)(v & 3u), 31 - (int)(v >> 4), PA, KS, VS, MIX, a.in[14], lam); } }
            else { const bool samp = u >= 1024u; const unsigned v = samp ? u - 1024u : u - 768u;
                const int b = samp ? (int)(v >> 2) : (int)(v >> 6), h = samp ? (int)(v & 3u) : (int)((v >> 4) & 3u), qb = samp ? 0 : (int)(v & 15u);
                const bf16_t* Kb = samp ? CMK + ((size_t)b * 256) * 512 + h * 128 : MKV + ((size_t)b * 256) * 2048 + h * 128;
                const bf16_t* Vb = samp ? CMV + ((size_t)b * 256) * 512 + h * 128 : Kb + 512;
                att::mem_unit(cx, samp, b, h, qb, PA, NA, 2048, 2560, Kb, Vb, samp ? 512 : 2048, MIX); }
        }
    }
    SEAM(2);
    if (IN(3)) {
        EpiMerge0F F0{ZB, ST0, 0.f, 0.f};
        { pg8::Gemm g{MIX, WO_t, NP, DM, DM}; pg8::StaticOrder S; S.init(NP, DM, G, (int)blockIdx.x);
          EpiWrap<EpiMerge0F> E{F0, 0, 0};
          pg8::gemm_phase<EpiWrap<EpiMerge0F>, pg8::StaticOrder, true, true>(lds, g, S, E); }
        gemm_small<EpiMerge0F>(lds, MIX + (size_t)NP * DM, WO_t, DM, NP, (int)blockIdx.x, G, F0);
    }
    SEAM(3);
    if (IN(5)) {
        EpiBF FB{PB, dout, KSW, VSW, ROPE, ST0, CSV, BWV, 0.f, 0.f, {0.f, 0.f}, {0.f, 0.f}};
        { pg8::Gemm g{ZB, WB_t, NP, 2048, DM}; pg8::StaticOrder S; S.init(NP, 2048, G, (int)blockIdx.x);
          EpiWrap<EpiBF> E{FB, 0, 0};
          pg8::gemm_phase<EpiWrap<EpiBF>, pg8::StaticOrder, true, true>(lds, g, S, E); }
    }
    SEAM(5);
    if (IN(6)) {
        unsigned* gdone = ctl + 384 + 64 * a.rep;
        {
            EpiBF FB{PB, dout, KSW, VSW, ROPE, ST0, CSV, BWV, 0.f, 0.f, {0.f, 0.f}, {0.f, 0.f}};
            if (blockIdx.x < 64) { pg8::Gemm g{ZB, WB_t + (size_t)2048 * DM, NP, 256, DM}; pg8::StaticOrder S; S.init(NP, 256, 64, (int)blockIdx.x);
                EpiWrap<EpiBF> E{FB, 0, 2048};
                pg8::gemm_phase<EpiWrap<EpiBF>, pg8::StaticOrder, true, true>(lds, g, S, E); }
            else { gemm_small<EpiBF>(lds, ZB + (size_t)NP * DM, WB_t, 2048, NP, (int)blockIdx.x - 64, 192, FB);
                   if (blockIdx.x >= 192) gemm_small<EpiBF>(lds, ZB + (size_t)NP * DM, WB_t + (size_t)2048 * DM, 256, NP, (int)blockIdx.x - 192, 64, FB, 2048); }
            asm volatile("s_waitcnt vmcnt(0)" ::: "memory"); __syncthreads();
            if (tid == 0) { __builtin_amdgcn_fence(__ATOMIC_RELEASE, "agent"); asm volatile("s_waitcnt vmcnt(0)" ::: "memory");
                            __hip_atomic_fetch_add(gdone + (blockIdx.x < 64 ? 0 : 16), 1u, __ATOMIC_RELAXED, __HIP_MEMORY_SCOPE_AGENT); }
        }
        bool ready1 = false, ready2 = false;
        for (;;) {
            if (tid == 0) MISC[0] = atomicAdd(ctl + 64 + 128 * a.rep, 1u);
            __syncthreads(); const unsigned u = MISC[0]; __syncthreads();
            if (u >= 848u) break;
            const bool need1 = u >= 256u && u < 768u, need2 = u >= 768u;
            if ((need1 && !ready1) || (need2 && !ready2)) {
                if (tid == 0) { unsigned sp = 0; unsigned* w = need1 ? gdone : gdone + 16; const unsigned want = need1 ? 64u : 192u;
                                while (__hip_atomic_load(w, __ATOMIC_RELAXED, __HIP_MEMORY_SCOPE_AGENT) < want && ++sp < (1u << 24)) __builtin_amdgcn_s_sleep(8);
                                __builtin_amdgcn_fence(__ATOMIC_ACQUIRE, "agent"); asm volatile("s_waitcnt vmcnt(0)" ::: "memory"); }
                __syncthreads(); if (need1) ready1 = true; else ready2 = true;
            }
            const bool is_mem = u < 256u || (u >= 768u && u < 832u);
            if (is_mem) { const bool samp = u >= 768u; const unsigned v = samp ? u - 768u : u;
                const int b = samp ? (int)(v >> 2) : (int)(v >> 6), h = samp ? (int)(v & 3u) : (int)((v >> 4) & 3u), qb = samp ? 0 : (int)(v & 15u);
                const bf16_t* Kb = samp ? CMK + ((size_t)(16 + b) * 256) * 512 + h * 128 : MKV + ((size_t)b * 256) * 2048 + 1024 + h * 128;
                const bf16_t* Vb = samp ? CMV + ((size_t)(16 + b) * 256) * 512 + h * 128 : Kb + 512;
                att::mem_unit(cx, samp, b, h, qb, PB, NB, 1024, 1536, Kb, Vb, samp ? 512 : 2048, MIX); }
            else { const bool samp = u >= 832u; const unsigned v = samp ? u - 832u : u - 256u;
                const int b = samp ? (int)v : (int)(v >> 7), c = samp ? 0 : (int)((v >> 1) & 63u), half = samp ? 0 : (int)(v & 1u);
                att::swa_unit(cx, samp, b, c, half, PB, KSW, VSW, MIX, a.in[16]); }
        }
    }
    SEAM(6);
    if (IN(7)) {
        EpiMerge1F F1{ZB, ST0, a.in[20], a.in[21], Z1B, ST1, 0.f, 0.f, {0.f, 0.f}, {0.f, 0.f}};
        { pg8::Gemm g{MIX, WO_t + (size_t)DM * DM, NP, DM, DM}; pg8::StaticOrder S; S.init(NP, DM, G, (int)blockIdx.x);
          EpiWrap<EpiMerge1F> E{F1, 0, 0};
          pg8::gemm_phase<EpiWrap<EpiMerge1F>, pg8::StaticOrder, true, true>(lds, g, S, E); }
        gemm_small<EpiMerge1F>(lds, MIX + (size_t)NP * DM, WO_t + (size_t)DM * DM, DM, NP, (int)blockIdx.x, G, F1);
    }
    SEAM(7);
    if (IN(8)) {
        const float* g1 = a.in[20] + DM; const float* b1 = a.in[21] + DM;
#pragma unroll 4
        for (long i = gtid; i < (long)MA * 256; i += NTHR) { const int row = (int)(i >> 8), c4 = (int)(i & 255) * 4;
            float mu, rstd; row_stats(ST1, row, mu, rstd);
            const u32x2 zz = __builtin_nontemporal_load((const u32x2*)(Z1B + (size_t)row * DM + c4));
            const f32x4 z = (f32x4){bflo(zz.x), bfhi(zz.x), bflo(zz.y), bfhi(zz.y)};
            __builtin_nontemporal_store((z - mu) * rstd * *(const f32x4*)(g1 + c4) + *(const f32x4*)(b1 + c4), (f32x4*)(dout + (size_t)row * DM + c4)); }
    }
#undef IN
#undef SEAM
}

#ifndef MK_N_LAUNCHES
#define MK_N_LAUNCHES 1
#endif
#ifndef PROBE_DUP
#define PROBE_DUP 0
#endif
extern "C" void kernel_launch(void* const* d_in, const int* in_sizes, int n_in, void* d_out, int out_size, void* d_ws, size_t ws_size, hipStream_t stream) {
    static int grid = 0;
    if (grid == 0) {
        if (n_in != 22 || ws_size < WS_END) { fprintf(stderr, "kernel_launch: unexpected n_in %d / ws %zu\n", n_in, ws_size); grid = -1; return; }
        int dev = 0, cus = 0, per_cu = 0;
        if (hipGetDevice(&dev) != hipSuccess || hipDeviceGetAttribute(&cus, hipDeviceAttributeMultiprocessorCount, dev) != hipSuccess) { grid = -1; return; }
        if (hipFuncSetAttribute((const void*)yoco_fwd, hipFuncAttributeMaxDynamicSharedMemorySize, LDS_BYTES) != hipSuccess) { fprintf(stderr, "kernel_launch: hipFuncSetAttribute failed\n"); grid = -1; return; }
        if (hipOccupancyMaxActiveBlocksPerMultiprocessor(&per_cu, (const void*)yoco_fwd, NWAVES * 64, LDS_BYTES) != hipSuccess || per_cu < 1) { fprintf(stderr, "kernel_launch: occupancy query says %d\n", per_cu); per_cu = 1; }
        (void)hipGetLastError();
        grid = cus;
    }
    if (grid < 0) return;
    (void)hipMemsetAsync((char*)d_ws + WS_CTL, 0, 1048576, stream);
    Args a{};
    for (int i = 0; i < 22; ++i) a.in[i] = (const float*)d_in[i];
    a.out = (float*)d_out; a.ws = (unsigned char*)d_ws;
#if MK_N_LAUNCHES == 1
    a.ph_lo = 0; a.ph_hi = NPHASE;
    void* args[] = {&a};
    hipError_t e = hipLaunchCooperativeKernel((const void*)yoco_fwd, dim3(grid), dim3(NWAVES * 64), args, LDS_BYTES, stream);
    if (e != hipSuccess) fprintf(stderr, "kernel_launch: cooperative launch failed: %s (grid %d)\n", hipGetErrorString(e), grid);
#else
    for (int p = 0; p < NPHASE; ++p) { a.ph_lo = p; a.ph_hi = p + 1;
        for (int r = 0; r < 1 + ((PROBE_DUP >> p) & 1); ++r) { a.rep = r; hipLaunchKernelGGL(yoco_fwd, dim3(grid), dim3(NWAVES * 64), LDS_BYTES, stream, a); } }
#endif
}
```
